# Optimizing an MI355X kernel written in HIP

```python
import math
import jax
import jax.numpy as jnp
from jax import lax
import numpy as np

D_MODEL = 1024
BATCH = 1
SEQ = 16384
DEPTH = 2

GRID_W = 64
CTX_LEN = 256
ROPE_THETA = 10000.0
Q_BLOCK = 128
NORM_EPS = 1e-6
N_MOD = 6

MLA_HEADS = 8
MLA_NOPE = 64
MLA_ROPE = 32
MLA_V = 64
MLA_Q_RANK = 256
MLA_KV_RANK = 128
MLA_W = MLA_HEADS * MLA_V
MLA_SCALE = (MLA_NOPE + MLA_ROPE) ** -0.5

SSM_GROUP = 16
SSM_GROUPS = 32
SSM_STATE = 64
SSM_W = SSM_GROUP * SSM_GROUPS
SSM_DIRS = 2
DT_MIN = 1e-3
DT_MAX = 1e-1

GQA_HEADS = 8
GQA_KV_HEADS = 2
GQA_HD = 64
GQA_W = GQA_HEADS * GQA_HD
GQA_SCALE = GQA_HD ** -0.5

IN_MLA = MLA_Q_RANK + MLA_KV_RANK + MLA_ROPE
IN_SSM = SSM_W
IN_GQA = (GQA_HEADS + 2 * GQA_KV_HEADS) * GQA_HD
IN_GATE = 3 * D_MODEL
IN_COLS = IN_MLA + IN_SSM + IN_GQA + IN_GATE

N_GROUPS = 4
EXPERTS_PER_GROUP = 4
N_EXPERTS = N_GROUPS * EXPERTS_PER_GROUP
TOP_K = 2
D_EXPERT = 512

kernel_name = "hybrid_mla_s5_gqa_hmoe_diffusion_block"


def rms_norm(x, g):
    xf = x.astype(jnp.float32)
    y = xf * lax.rsqrt(jnp.mean(xf * xf, axis=-1, keepdims=True) + NORM_EPS)
    return (y * g.astype(jnp.float32)).astype(x.dtype)


def rope_1d(x, pos):
    half = x.shape[-1] // 2
    freqs = ROPE_THETA ** (-jnp.arange(half, dtype=jnp.float32) / half)
    ang = pos.astype(jnp.float32)[:, None] * freqs[None, :]
    shape = (1, pos.shape[0]) + (1,) * (x.ndim - 3) + (half,)
    cos = jnp.cos(ang).reshape(shape)
    sin = jnp.sin(ang).reshape(shape)
    xf = x.astype(jnp.float32)
    x1, x2 = xf[..., :half], xf[..., half:]
    return jnp.concatenate([x1 * cos - x2 * sin, x1 * sin + x2 * cos], axis=-1).astype(x.dtype)


def rope_2d(x, rows, cols):
    h = x.shape[-1] // 2
    return jnp.concatenate([rope_1d(x[..., :h], rows), rope_1d(x[..., h:], cols)], axis=-1)


def block_attention(q, k, v, scale):
    b, sq, hk, g, dk = q.shape
    nb = sq // Q_BLOCK
    qb = jnp.moveaxis(q.reshape(b, nb, Q_BLOCK, hk, g, dk), 1, 0)

    def attend(qblk):
        s = jnp.einsum('bqhgd,bkhd->bhgqk', qblk, k).astype(jnp.float32) * scale
        p = jax.nn.softmax(s, axis=-1).astype(v.dtype)
        return jnp.einsum('bhgqk,bkhd->bqhgd', p, v)

    o = lax.map(attend, qb)
    return jnp.moveaxis(o, 0, 1).reshape(b, sq, hk * g * v.shape[-1])


def mla_qkv(pm, p, pos):
    b, s, _ = pm.shape
    cq, ckv, kr = jnp.split(pm, [MLA_Q_RANK, MLA_Q_RANK + MLA_KV_RANK], axis=-1)
    q = (rms_norm(cq, p['g_cq']) @ p['w_uq']).reshape(b, s, MLA_HEADS, MLA_NOPE + MLA_ROPE)
    kv = (rms_norm(ckv, p['g_ckv']) @ p['w_ukv']).reshape(b, s, MLA_HEADS, MLA_NOPE + MLA_V)
    q_nope, q_rope = q[..., :MLA_NOPE], q[..., MLA_NOPE:]
    k_nope, v = kv[..., :MLA_NOPE], kv[..., MLA_NOPE:]
    if pos is not None:
        q_rope = rope_2d(q_rope, pos[0], pos[1])
        kr = rope_2d(kr, pos[0], pos[1])
    k_rope = jnp.broadcast_to(kr[:, :, None, :], (b, s, MLA_HEADS, MLA_ROPE))
    q = jnp.concatenate([q_nope, q_rope], axis=-1)[:, :, :, None, :]
    k = jnp.concatenate([k_nope, k_rope], axis=-1)
    return q, k, v


def gqa_qkv(pg, p, pos):
    b, s, _ = pg.shape
    q, k, v = jnp.split(pg, [GQA_W, GQA_W + GQA_KV_HEADS * GQA_HD], axis=-1)
    q = rms_norm(q.reshape(b, s, GQA_HEADS, GQA_HD), p['g_qn'])
    k = rms_norm(k.reshape(b, s, GQA_KV_HEADS, GQA_HD), p['g_kn'])
    v = v.reshape(b, s, GQA_KV_HEADS, GQA_HD)
    if pos is not None:
        q = rope_2d(q, pos[0], pos[1])
        k = rope_2d(k, pos[0], pos[1])
    q = q.reshape(b, s, GQA_KV_HEADS, GQA_HEADS // GQA_KV_HEADS, GQA_HD)
    return q, k, v


def s5_discretize(a_re, a_im, log_dt, b_re, b_im):
    a_re = a_re.astype(jnp.float32)
    a_im = a_im.astype(jnp.float32)
    b_re = b_re.astype(jnp.float32)
    b_im = b_im.astype(jnp.float32)
    dt = jnp.exp(log_dt.astype(jnp.float32))[:, None]
    mag = jnp.exp(a_re * dt)
    lr = mag * jnp.cos(a_im * dt)
    li = mag * jnp.sin(a_im * dt)
    den = a_re * a_re + a_im * a_im
    cr = ((lr - 1.0) * a_re + li * a_im) / den
    ci = (li * a_re - (lr - 1.0) * a_im) / den
    bbr = cr[..., None] * b_re - ci[..., None] * b_im
    bbi = cr[..., None] * b_im + ci[..., None] * b_re
    return lr, li, bbr, bbi


def s5_combine(e1, e2):
    a1r, a1i, b1r, b1i = e1
    a2r, a2i, b2r, b2i = e2
    return (a1r * a2r - a1i * a2i,
            a1r * a2i + a1i * a2r,
            a2r * b1r - a2i * b1i + b2r,
            a2r * b1i + a2i * b1r + b2i)


def s5_scan(bu_r, bu_i, lr, li, s0, reverse):
    if s0 is not None:
        s0r, s0i = s0
        idx = -1 if reverse else 0
        bu_r = bu_r.at[:, idx].add(lr * s0r - li * s0i)
        bu_i = bu_i.at[:, idx].add(lr * s0i + li * s0r)
    ar = jnp.broadcast_to(lr, bu_r.shape)
    ai = jnp.broadcast_to(li, bu_i.shape)
    _, _, sr, si = lax.associative_scan(s5_combine, (ar, ai, bu_r, bu_i), reverse=reverse, axis=1)
    return sr, si


def s5_readout(sr, si, c_re, c_im):
    return jnp.einsum('bsgp,gcp->bsgc', sr, c_re) - jnp.einsum('bsgp,gcp->bsgc', si, c_im)


def s5_mixer(u_lat, u_ctx, p, with_ctx_out):
    b, s, _ = u_lat.shape
    lc = u_ctx.shape[1]
    ux = u_lat.astype(jnp.float32).reshape(b, s, SSM_GROUPS, SSM_GROUP)
    uc = u_ctx.astype(jnp.float32).reshape(b, lc, SSM_GROUPS, SSM_GROUP)
    d = p['ssm_d'].astype(jnp.float32).reshape(SSM_GROUPS, SSM_GROUP)
    yx = d * ux
    yc = d * uc
    for dr in range(SSM_DIRS):
        reverse = dr == 1
        lr, li, bbr, bbi = s5_discretize(p['ssm_a_re'][dr], p['ssm_a_im'][dr], p['ssm_log_dt'][dr],
                                         p['ssm_b_re'][dr], p['ssm_b_im'][dr])
        c_re = p['ssm_c_re'][dr].astype(jnp.float32)
        c_im = p['ssm_c_im'][dr].astype(jnp.float32)
        scr, sci = s5_scan(jnp.einsum('bsgc,gpc->bsgp', uc, bbr), jnp.einsum('bsgc,gpc->bsgp', uc, bbi),
                           lr, li, None, reverse)
        end = 0 if reverse else -1
        sxr, sxi = s5_scan(jnp.einsum('bsgc,gpc->bsgp', ux, bbr), jnp.einsum('bsgc,gpc->bsgp', ux, bbi),
                           lr, li, (scr[:, end], sci[:, end]), reverse)
        yx = yx + s5_readout(sxr, sxi, c_re, c_im)
        if with_ctx_out:
            yc = yc + s5_readout(scr, sci, c_re, c_im)

    def glu(y):
        y1 = jax.nn.gelu(y.reshape(y.shape[0], y.shape[1], SSM_W))
        return y1 * jax.nn.sigmoid(y1 @ p['w_glu'] + p['b_glu'])

    out_x = glu(yx).astype(u_lat.dtype)
    out_c = glu(yc).astype(u_ctx.dtype) if with_ctx_out else None
    return out_x, out_c


def merge_branches(o_mla, o_ssm, o_gqa, gate_logits, p):
    g_mla, g_ssm, g_gqa = jnp.split(jax.nn.sigmoid(gate_logits), 3, axis=-1)
    m = (g_mla * (o_mla @ p['w_br_mla'])
         + g_ssm * (o_ssm @ p['w_br_ssm'])
         + g_gqa * (o_gqa @ p['w_br_gqa']))
    return m @ p['w_out']


def mixer_sublayer(hx, hc, pos, p, with_ctx_out):
    splits = [IN_MLA, IN_MLA + IN_SSM, IN_MLA + IN_SSM + IN_GQA]
    mla_in_x, ssm_in_x, gqa_in_x, gate_x = jnp.split(hx @ p['w_in'], splits, axis=-1)
    mla_in_c, ssm_in_c, gqa_in_c, gate_c = jnp.split(hc @ p['w_in'], splits, axis=-1)
    mq_x, mk_x, mv_x = mla_qkv(mla_in_x, p, pos)
    mq_c, mk_c, mv_c = mla_qkv(mla_in_c, p, None)
    mla_x = block_attention(mq_x, jnp.concatenate([mk_c, mk_x], axis=1),
                            jnp.concatenate([mv_c, mv_x], axis=1), MLA_SCALE)
    ssm_x, ssm_c = s5_mixer(ssm_in_x, ssm_in_c, p, with_ctx_out)
    gq_x, gk_x, gv_x = gqa_qkv(gqa_in_x, p, pos)
    gq_c, gk_c, gv_c = gqa_qkv(gqa_in_c, p, None)
    gqa_x = block_attention(gq_x, jnp.concatenate([gk_c, gk_x], axis=1),
                            jnp.concatenate([gv_c, gv_x], axis=1), GQA_SCALE)
    y_x = merge_branches(mla_x, ssm_x, gqa_x, gate_x, p)
    if not with_ctx_out:
        return y_x, None
    mla_c = block_attention(mq_c, mk_c, mv_c, MLA_SCALE)
    gqa_c = block_attention(gq_c, gk_c, gv_c, GQA_SCALE)
    return y_x, merge_branches(mla_c, ssm_c, gqa_c, gate_c, p)


def moe_sublayer(h, p):
    b, s, d = h.shape
    t = h.reshape(b * s, d)
    lg = (t @ p['w_group'] + p['b_group']).astype(jnp.float32)
    pg = jax.nn.softmax(lg, axis=-1)
    g_sel = jnp.argmax(lg, axis=-1)
    le = (t @ p['w_router'] + p['b_router']).astype(jnp.float32)
    le = le.reshape(b * s, N_GROUPS, EXPERTS_PER_GROUP)
    le_sel = jnp.take_along_axis(le, g_sel[:, None, None], axis=1)[:, 0]
    pe = jax.nn.softmax(le_sel, axis=-1)
    top_v, top_i = lax.top_k(pe, TOP_K)
    top_v = top_v / jnp.sum(top_v, axis=-1, keepdims=True)
    wts = jnp.take_along_axis(pg, g_sel[:, None], axis=1) * top_v
    expert_id = g_sel[:, None] * EXPERTS_PER_GROUP + top_i
    combine = jnp.sum(jax.nn.one_hot(expert_id, N_EXPERTS, dtype=jnp.float32) * wts[..., None], axis=1)
    out = jnp.zeros((b * s, d), jnp.float32)
    for e in range(N_EXPERTS):
        hid = jax.nn.silu(t @ p['w_exp_gate'][e]) * (t @ p['w_exp_up'][e])
        out = out + combine[:, e:e + 1] * (hid @ p['w_exp_down'][e]).astype(jnp.float32)
    return out.astype(h.dtype).reshape(b, s, d)


def modulation(cond, w_mod, b_mod):
    return jnp.split(jax.nn.silu(cond) @ w_mod + b_mod, N_MOD, axis=-1)


def modulate(x, g, shift, scale):
    return rms_norm(x, g) * (1.0 + scale) + shift


def setup_inputs(seed: int = 0) -> dict:
    key = jax.random.key(seed)
    ks = iter(jax.random.split(key, 48))

    def nrm(shape, scale):
        return jax.random.normal(next(ks), shape, jnp.float32) * scale

    def gain(shape):
        return 1.0 + nrm(shape, 0.05)

    L, D = DEPTH, D_MODEL
    ssm_shape = (L, SSM_DIRS, SSM_GROUPS, SSM_STATE)
    n_idx = jnp.arange(SSM_STATE, dtype=jnp.float32)
    return {
        'x': nrm((BATCH, SEQ, D), 1.0),
        'c': nrm((BATCH, D), 1.0),
        'ctx': nrm((BATCH, CTX_LEN, D), 1.0),
        'c_ctx': nrm((D,), 1.0),
        'w_mod': nrm((L, D, N_MOD * D), 0.5 * D ** -0.5),
        'b_mod': nrm((L, N_MOD * D), 0.01),
        'g_pre_mix': gain((L, D)),
        'g_post_mix': gain((L, D)),
        'g_pre_ffn': gain((L, D)),
        'g_post_ffn': gain((L, D)),
        'w_in': nrm((L, D, IN_COLS), D ** -0.5),
        'g_cq': gain((L, MLA_Q_RANK)),
        'g_ckv': gain((L, MLA_KV_RANK)),
        'w_uq': nrm((L, MLA_Q_RANK, MLA_HEADS * (MLA_NOPE + MLA_ROPE)), MLA_Q_RANK ** -0.5),
        'w_ukv': nrm((L, MLA_KV_RANK, MLA_HEADS * (MLA_NOPE + MLA_V)), MLA_KV_RANK ** -0.5),
        'g_qn': gain((L, GQA_HD)),
        'g_kn': gain((L, GQA_HD)),
        'ssm_a_re': -0.5 + nrm(ssm_shape, 0.01),
        'ssm_a_im': math.pi * n_idx + nrm(ssm_shape, 0.01),
        'ssm_log_dt': jax.random.uniform(next(ks), (L, SSM_DIRS, SSM_GROUPS), jnp.float32,
                                         minval=math.log(DT_MIN), maxval=math.log(DT_MAX)),
        'ssm_b_re': nrm((L, SSM_DIRS, SSM_GROUPS, SSM_STATE, SSM_GROUP), (2 * SSM_GROUP) ** -0.5),
        'ssm_b_im': nrm((L, SSM_DIRS, SSM_GROUPS, SSM_STATE, SSM_GROUP), (2 * SSM_GROUP) ** -0.5),
        'ssm_c_re': nrm((L, SSM_DIRS, SSM_GROUPS, SSM_GROUP, SSM_STATE), 0.5),
        'ssm_c_im': nrm((L, SSM_DIRS, SSM_GROUPS, SSM_GROUP, SSM_STATE), 0.5),
        'ssm_d': nrm((L, SSM_W), 1.0),
        'w_glu': nrm((L, SSM_W, SSM_W), SSM_W ** -0.5),
        'b_glu': nrm((L, SSM_W), 0.01),
        'w_br_mla': nrm((L, MLA_W, D), MLA_W ** -0.5),
        'w_br_ssm': nrm((L, SSM_W, D), SSM_W ** -0.5),
        'w_br_gqa': nrm((L, GQA_W, D), GQA_W ** -0.5),
        'w_out': nrm((L, D, D), D ** -0.5),
        'w_group': nrm((L, D, N_GROUPS), D ** -0.5),
        'b_group': nrm((L, N_GROUPS), 0.01),
        'w_router': nrm((L, D, N_EXPERTS), D ** -0.5),
        'b_router': nrm((L, N_EXPERTS), 0.01),
        'w_exp_gate': nrm((L, N_EXPERTS, D, D_EXPERT), D ** -0.5),
        'w_exp_up': nrm((L, N_EXPERTS, D, D_EXPERT), D ** -0.5),
        'w_exp_down': nrm((L, N_EXPERTS, D_EXPERT, D), D_EXPERT ** -0.5),
    }


def reference(x, c, ctx, c_ctx, w_mod, b_mod, g_pre_mix, g_post_mix, g_pre_ffn, g_post_ffn,
              w_in, g_cq, g_ckv, w_uq, w_ukv, g_qn, g_kn,
              ssm_a_re, ssm_a_im, ssm_log_dt, ssm_b_re, ssm_b_im, ssm_c_re, ssm_c_im, ssm_d,
              w_glu, b_glu, w_br_mla, w_br_ssm, w_br_gqa, w_out,
              w_group, b_group, w_router, b_router, w_exp_gate, w_exp_up, w_exp_down):
    s = x.shape[1]
    lc = ctx.shape[1]
    rows_n = s // GRID_W
    rows = jnp.repeat(jnp.arange(rows_n, dtype=jnp.int32), GRID_W)
    cols = jnp.tile(jnp.arange(GRID_W, dtype=jnp.int32), rows_n)
    pos = (rows, cols)
    for l in range(DEPTH):
        last = l == DEPTH - 1
        p = dict(w_in=w_in[l], g_cq=g_cq[l], g_ckv=g_ckv[l], w_uq=w_uq[l], w_ukv=w_ukv[l],
                 g_qn=g_qn[l], g_kn=g_kn[l],
                 ssm_a_re=ssm_a_re[l], ssm_a_im=ssm_a_im[l], ssm_log_dt=ssm_log_dt[l],
                 ssm_b_re=ssm_b_re[l], ssm_b_im=ssm_b_im[l], ssm_c_re=ssm_c_re[l], ssm_c_im=ssm_c_im[l],
                 ssm_d=ssm_d[l], w_glu=w_glu[l], b_glu=b_glu[l],
                 w_br_mla=w_br_mla[l], w_br_ssm=w_br_ssm[l], w_br_gqa=w_br_gqa[l], w_out=w_out[l],
                 w_group=w_group[l], b_group=b_group[l], w_router=w_router[l], b_router=b_router[l],
                 w_exp_gate=w_exp_gate[l], w_exp_up=w_exp_up[l], w_exp_down=w_exp_down[l])
        sh1, sc1, ga1, sh2, sc2, ga2 = [m[:, None, :] for m in modulation(c, w_mod[l], b_mod[l])]
        csh1, csc1, cga1, csh2, csc2, cga2 = modulation(c_ctx, w_mod[l], b_mod[l])
        hx = modulate(x, g_pre_mix[l], sh1, sc1)
        hc = modulate(ctx, g_pre_mix[l], csh1, csc1)
        y_x, y_c = mixer_sublayer(hx, hc, pos, p, not last)
        x = x + ga1 * rms_norm(y_x, g_post_mix[l])
        if last:
            hx = modulate(x, g_pre_ffn[l], sh2, sc2)
            x = x + ga2 * rms_norm(moe_sublayer(hx, p), g_post_ffn[l])
        else:
            ctx = ctx + cga1 * rms_norm(y_c, g_post_mix[l])
            hx = modulate(x, g_pre_ffn[l], sh2, sc2)
            hc = modulate(ctx, g_pre_ffn[l], csh2, csc2)
            y = moe_sublayer(jnp.concatenate([hc, hx], axis=1), p)
            x = x + ga2 * rms_norm(y[:, lc:], g_post_ffn[l])
            ctx = ctx + cga2 * rms_norm(y[:, :lc], g_post_ffn[l])
    return x
```

```cpp
#include <hip/hip_runtime.h>
#include <hip/hip_cooperative_groups.h>
#include <cstdio>
#include <cstdint>
namespace cg = cooperative_groups;

#ifndef MULTI_LAUNCH
#define MULTI_LAUNCH 0
#endif

typedef unsigned short bf16_t;

constexpr int D = 1024, S = 16384, LC = 256, T = S + LC, NL = 2;
constexpr int NIN = 4768, NINP = 4864;
constexpr int C_CQ = 0, C_CKV = 256, C_KR = 384, C_SSM = 416, C_GQ = 928, C_GK = 1440, C_GV = 1568, C_GATE = 1696;
constexpr int TP = 2 * T + 16 * 128;
constexpr float EPS = 1e-6f;
constexpr float LOG2E = 1.4426950408889634f;

enum { I_X = 0, I_C, I_CTX, I_CCTX, I_WMOD, I_BMOD, I_GPREMIX, I_GPOSTMIX, I_GPREFFN, I_GPOSTFFN, I_WIN, I_GCQ, I_GCKV, I_WUQ, I_WUKV,
       I_GQN, I_GKN, I_ARE, I_AIM, I_LOGDT, I_BRE, I_BIM, I_CRE, I_CIM, I_SSMD, I_WGLU, I_BGLU, I_WBRM, I_WBRS, I_WBRG, I_WOUT,
       I_WGROUP, I_BGROUP, I_WROUTER, I_BROUTER, I_WEG, I_WEU, I_WED, N_IN };

constexpr size_t al256(size_t x) { return (x + 255) & ~(size_t)255; }
constexpr size_t WB_IN = 0;
constexpr size_t WB_UQ = WB_IN + (size_t)NINP * 1024 * 2;
constexpr size_t WB_UKV = WB_UQ + (size_t)768 * 256 * 2;
constexpr size_t WB_GLU = WB_UKV + (size_t)1024 * 128 * 2;
constexpr size_t WB_BR = WB_GLU + (size_t)512 * 512 * 2;
constexpr size_t WB_OUT = WB_BR + (size_t)3 * 1024 * 512 * 2;
constexpr size_t WB_EG = WB_OUT + (size_t)1024 * 1024 * 2;
constexpr size_t WB_EU = WB_EG + (size_t)16 * 512 * 1024 * 2;
constexpr size_t WB_ED = WB_EU + (size_t)16 * 512 * 1024 * 2;
constexpr size_t WB_BYTES = WB_ED + (size_t)16 * 1024 * 512 * 2;

constexpr size_t OFF_WB = 0;
constexpr size_t OFF_P = al256(OFF_WB + WB_BYTES);
constexpr size_t P_BYTES = (size_t)T * NIN * 2;
constexpr size_t OFF_Y = OFF_P;
constexpr size_t OFF_SLOTS = OFF_P;
constexpr size_t OFF_HID = OFF_P + (size_t)TP * 1024 * 2;
constexpr size_t OFF_H = al256(OFF_P + P_BYTES);
constexpr size_t OFF_KN = al256(OFF_H + (size_t)T * 1024 * 2);
constexpr size_t OFF_V = al256(OFF_KN + (size_t)T * 512 * 2);
constexpr size_t OFF_OM = al256(OFF_V + (size_t)T * 512 * 2);
constexpr size_t OFF_OG = OFF_OM + (size_t)T * 512 * 2;
constexpr size_t OFF_OS = OFF_OG + (size_t)T * 512 * 2;
constexpr size_t OFF_XC = al256(OFF_OS + (size_t)T * 512 * 2);
constexpr size_t OFF_MOD = al256(OFF_XC + (size_t)LC * 1024 * 4);
constexpr size_t OFF_TOKE = al256(OFF_MOD + (size_t)NL * 2 * 6144 * 4);
constexpr size_t OFF_TOKW = al256(OFF_TOKE + (size_t)T * 2 * 4);
constexpr size_t OFF_TOKS = al256(OFF_TOKW + (size_t)T * 2 * 4);
constexpr size_t OFF_SLTOK = al256(OFF_TOKS + (size_t)T * 2 * 4);
constexpr size_t OFF_SLW = al256(OFF_SLTOK + (size_t)TP * 4);
constexpr size_t OFF_CNT = al256(OFF_SLW + (size_t)TP * 4);
constexpr size_t OFF_BAR = al256(OFF_CNT + 256);
constexpr size_t WS_NEED = al256(OFF_BAR + 256);
static_assert(OFF_HID + (size_t)TP * 512 * 2 <= OFF_P + P_BYTES, "overlay");
static_assert((size_t)T * 1024 * 4 <= P_BYTES, "overlay Y");
static_assert(WS_NEED < 380000000ull, "ws");

struct Params {
    const float* in[N_IN];
    float* out;
    char* ws;
};

__device__ __forceinline__ float bf2f(bf16_t v) { return __uint_as_float(((unsigned)v) << 16); }
__device__ __forceinline__ bf16_t f2bf(float f) { unsigned u = __float_as_uint(f); u += 0x7FFFu + ((u >> 16) & 1u); return (bf16_t)(u >> 16); }
__device__ __forceinline__ float bflo(unsigned u) { return __uint_as_float(u << 16); }
__device__ __forceinline__ float bfhi(unsigned u) { return __uint_as_float(u & 0xFFFF0000u); }
__device__ __forceinline__ unsigned pack2(float lo, float hi) { return (unsigned)f2bf(lo) | ((unsigned)f2bf(hi) << 16); }
__device__ __forceinline__ float wave_sum(float v) {
#pragma unroll
    for (int o = 32; o > 0; o >>= 1) v += __shfl_xor(v, o);
    return v;
}
__device__ __forceinline__ float transpose_reduce16(const float (&t16)[16], int lane) {
    float t8[8], t4[4], t2[2];
#pragma unroll
    for (int i = 0; i < 8; ++i) { const float a = t16[2 * i], b = t16[2 * i + 1]; const bool o = lane & 1; const float keep = o ? b : a, send = o ? a : b; t8[i] = keep + __shfl_xor(send, 1); }
#pragma unroll
    for (int i = 0; i < 4; ++i) { const float a = t8[2 * i], b = t8[2 * i + 1]; const bool o = lane & 2; const float keep = o ? b : a, send = o ? a : b; t4[i] = keep + __shfl_xor(send, 2); }
#pragma unroll
    for (int i = 0; i < 2; ++i) { const float a = t4[2 * i], b = t4[2 * i + 1]; const bool o = lane & 4; const float keep = o ? b : a, send = o ? a : b; t2[i] = keep + __shfl_xor(send, 4); }
    float y; { const float a = t2[0], b = t2[1]; const bool o = lane & 8; const float keep = o ? b : a, send = o ? a : b; y = keep + __shfl_xor(send, 8); }
    y += __shfl_xor(y, 16); y += __shfl_xor(y, 32);
    return y;
}
__device__ __forceinline__ float sigmoidf_(float x) { return 1.0f / (1.0f + __expf(-x)); }
__device__ __forceinline__ float siluf_(float x) { return x / (1.0f + __expf(-x)); }
__device__ __forceinline__ float gelu_tanh(float x) {
    const float u = 0.7978845608028654f * (x + 0.044715f * x * x * x);
    return 0.5f * x * (1.0f + tanhf(u));
}
__device__ __forceinline__ float dot8(uint4 a, uint4 b, float acc) {
    acc = fmaf(bflo(a.x), bflo(b.x), acc); acc = fmaf(bfhi(a.x), bfhi(b.x), acc);
    acc = fmaf(bflo(a.y), bflo(b.y), acc); acc = fmaf(bfhi(a.y), bfhi(b.y), acc);
    acc = fmaf(bflo(a.z), bflo(b.z), acc); acc = fmaf(bfhi(a.z), bfhi(b.z), acc);
    acc = fmaf(bflo(a.w), bflo(b.w), acc); acc = fmaf(bfhi(a.w), bfhi(b.w), acc);
    return acc;
}
__device__ __forceinline__ float dotrow(const bf16_t* a, const bf16_t* b, int K) {
    float acc = 0.f;
    const uint4* a4 = (const uint4*)a; const uint4* b4 = (const uint4*)b;
    for (int k = 0; k < K / 8; ++k) acc = dot8(a4[k], b4[k], acc);
    return acc;
}

#define WSP(type, off) ((type*)(p.ws + (off)))

template <class AF, class BF, class EF>
__device__ __forceinline__ void gemm_naive(int M, int N, int K, AF arow, BF brow, EF epi, int bid, int nb) {
    const long total = (long)M * N;
    for (long idx = (long)bid * 256 + threadIdx.x; idx < total; idx += (long)nb * 256) {
        const int m = (int)(idx / N), n = (int)(idx % N);
        const float acc = dotrow(arow(m), brow(m, n), K);
        epi(m, n, acc);
    }
}

__device__ void st_prologue(const Params& p, int bid, int nb, float* smem) {
    const int tid = threadIdx.x;
    {   const float4* x4 = (const float4*)p.in[I_X]; float4* o4 = (float4*)p.out;
        for (long i = (long)bid * 256 + tid; i < (long)S * D / 4; i += (long)nb * 256) o4[i] = x4[i];
        const float4* c4 = (const float4*)p.in[I_CTX]; float4* xc4 = WSP(float4, OFF_XC);
        for (long i = (long)bid * 256 + tid; i < (long)LC * D / 4; i += (long)nb * 256) xc4[i] = c4[i]; }
    for (int k = tid; k < 1024; k += 256) { smem[k] = siluf_(p.in[I_C][k]); smem[1024 + k] = siluf_(p.in[I_CCTX][k]); }
    __syncthreads();
    float* mod = WSP(float, OFF_MOD);
    for (int idx = bid * 256 + tid; idx < NL * 6144; idx += nb * 256) {
        const int l = idx / 6144, j = idx % 6144;
        const float* w = p.in[I_WMOD] + (size_t)l * 1024 * 6144 + j;
        float a0 = 0.f, a1 = 0.f;
        for (int k = 0; k < 1024; ++k) { const float wv = w[(size_t)k * 6144]; a0 = fmaf(smem[k], wv, a0); a1 = fmaf(smem[1024 + k], wv, a1); }
        const float b = p.in[I_BMOD][l * 6144 + j];
        mod[(l * 2 + 0) * 6144 + j] = a0 + b; mod[(l * 2 + 1) * 6144 + j] = a1 + b;
    }
    __syncthreads();
}

__device__ void conv_t(const float* W, bf16_t* Wt, int K, int N, int Npad, int nmat, int bid, int nb, float* smem) {
    const int tid = threadIdx.x, tx = tid & 63, ty = tid >> 6;
    const int tn = Npad / 64, tk = K / 64;
    const int ntile = tn * tk * nmat;
    for (int t = bid; t < ntile; t += nb) {
        const int mat = t / (tn * tk), r = t % (tn * tk), n0 = (r / tk) * 64, k0 = (r % tk) * 64;
        const float* Wm = W + (size_t)mat * K * N; bf16_t* Wtm = Wt + (size_t)mat * Npad * K;
        __syncthreads();
#pragma unroll
        for (int i = 0; i < 16; ++i) { const int kk = ty + 4 * i, n = n0 + tx; smem[kk * 65 + tx] = (n < N) ? Wm[(size_t)(k0 + kk) * N + n] : 0.f; }
        __syncthreads();
#pragma unroll
        for (int i = 0; i < 16; ++i) { const int nn = ty + 4 * i; Wtm[(size_t)(n0 + nn) * K + k0 + tx] = f2bf(smem[tx * 65 + nn]); }
    }
    __syncthreads();
}
__device__ void st_conv(const Params& p, int l, int bid, int nb, float* smem) {
    bf16_t* wb = WSP(bf16_t, OFF_WB);
    conv_t(p.in[I_WIN] + (size_t)l * 1024 * NIN, (bf16_t*)((char*)wb + WB_IN), 1024, NIN, NINP, 1, bid, nb, smem);
    conv_t(p.in[I_WUQ] + (size_t)l * 256 * 768, (bf16_t*)((char*)wb + WB_UQ), 256, 768, 768, 1, bid, nb, smem);
    conv_t(p.in[I_WUKV] + (size_t)l * 128 * 1024, (bf16_t*)((char*)wb + WB_UKV), 128, 1024, 1024, 1, bid, nb, smem);
    conv_t(p.in[I_WGLU] + (size_t)l * 512 * 512, (bf16_t*)((char*)wb + WB_GLU), 512, 512, 512, 1, bid, nb, smem);
    conv_t(p.in[I_WBRM] + (size_t)l * 512 * 1024, (bf16_t*)((char*)wb + WB_BR), 512, 1024, 1024, 1, bid, nb, smem);
    conv_t(p.in[I_WBRS] + (size_t)l * 512 * 1024, (bf16_t*)((char*)wb + WB_BR + (size_t)1024 * 512 * 2), 512, 1024, 1024, 1, bid, nb, smem);
    conv_t(p.in[I_WBRG] + (size_t)l * 512 * 1024, (bf16_t*)((char*)wb + WB_BR + (size_t)2 * 1024 * 512 * 2), 512, 1024, 1024, 1, bid, nb, smem);
    conv_t(p.in[I_WOUT] + (size_t)l * 1024 * 1024, (bf16_t*)((char*)wb + WB_OUT), 1024, 1024, 1024, 1, bid, nb, smem);
    conv_t(p.in[I_WEG] + (size_t)l * 16 * 1024 * 512, (bf16_t*)((char*)wb + WB_EG), 1024, 512, 512, 16, bid, nb, smem);
    conv_t(p.in[I_WEU] + (size_t)l * 16 * 1024 * 512, (bf16_t*)((char*)wb + WB_EU), 1024, 512, 512, 16, bid, nb, smem);
    conv_t(p.in[I_WED] + (size_t)l * 16 * 512 * 1024, (bf16_t*)((char*)wb + WB_ED), 512, 1024, 1024, 16, bid, nb, smem);
}

__device__ __forceinline__ const float* xrow_c(const Params& p, int r) { return (r < LC) ? (WSP(float, OFF_XC) + (size_t)r * D) : (p.out + (size_t)(r - LC) * D); }
__device__ __forceinline__ float* xrow(const Params& p, int r) { return (r < LC) ? (WSP(float, OFF_XC) + (size_t)r * D) : (p.out + (size_t)(r - LC) * D); }
__device__ void st_modulate(const Params& p, int l, int bid, int nb) {
    const int lane = threadIdx.x & 63, wid = threadIdx.x >> 6;
    bf16_t* Hb = WSP(bf16_t, OFF_H);
    const float* g = p.in[I_GPREMIX] + l * D;
    for (int r = bid * 4 + wid; r < T; r += nb * 4) {
        const float* xr = xrow_c(p, r);
        const float* md = WSP(float, OFF_MOD) + (size_t)(l * 2 + (r < LC ? 1 : 0)) * 6144;
        float4 v[4]; float ss = 0.f;
#pragma unroll
        for (int i = 0; i < 4; ++i) { v[i] = *(const float4*)(xr + i * 256 + lane * 4); ss += v[i].x * v[i].x + v[i].y * v[i].y + v[i].z * v[i].z + v[i].w * v[i].w; }
        ss = wave_sum(ss);
        const float rstd = rsqrtf(ss * (1.0f / D) + EPS);
#pragma unroll
        for (int i = 0; i < 4; ++i) {
            const int c = i * 256 + lane * 4;
            const float4 gg = *(const float4*)(g + c), sh = *(const float4*)(md + c), sc = *(const float4*)(md + 1024 + c);
            const float h0 = v[i].x * rstd * gg.x * (1.f + sc.x) + sh.x, h1 = v[i].y * rstd * gg.y * (1.f + sc.y) + sh.y;
            const float h2 = v[i].z * rstd * gg.z * (1.f + sc.z) + sh.z, h3 = v[i].w * rstd * gg.w * (1.f + sc.w) + sh.w;
            uint2 o; o.x = pack2(h0, h1); o.y = pack2(h2, h3);
            *(uint2*)(Hb + (size_t)r * D + c) = o;
        }
    }
}

__device__ void st_gemm_in(const Params& p, int bid, int nb) {
    const bf16_t* Hb = WSP(bf16_t, OFF_H); const bf16_t* Wt = WSP(bf16_t, OFF_WB + WB_IN); bf16_t* P = WSP(bf16_t, OFF_P);
    gemm_naive(T, NIN, 1024,
        [&](int m) { return Hb + (size_t)m * 1024; },
        [&](int, int n) { return Wt + (size_t)n * 1024; },
        [&](int m, int n, float acc) { P[(size_t)m * NIN + n] = f2bf(acc); }, bid, nb);
}

__device__ __forceinline__ void rope_pair(float& a, float& b, int pos, int i, int half) {
    const float freq = powf(10000.0f, -(float)i / (float)half);
    const float ang = (float)pos * freq;
    float sn, cs; sincosf(ang, &sn, &cs);
    const float na = a * cs - b * sn, nb_ = a * sn + b * cs; a = na; b = nb_;
}

__device__ void st_postproj(const Params& p, int l, int bid, int nb) {
    const int lane = threadIdx.x & 63, wid = threadIdx.x >> 6;
    bf16_t* P = WSP(bf16_t, OFF_P);
    const float* gcq = p.in[I_GCQ] + l * 256; const float* gckv = p.in[I_GCKV] + l * 128;
    for (int r = bid * 4 + wid; r < T; r += nb * 4) {
        bf16_t* pr = P + (size_t)r * NIN;
        {
            uint2 raw = *(const uint2*)(pr + C_CQ + lane * 4);
            float a0 = bflo(raw.x), a1 = bfhi(raw.x), a2 = bflo(raw.y), a3 = bfhi(raw.y);
            float ss = wave_sum(a0 * a0 + a1 * a1 + a2 * a2 + a3 * a3);
            const float rstd = rsqrtf(ss * (1.0f / 256.0f) + EPS);
            const float4 gg = *(const float4*)(gcq + lane * 4);
            uint2 o; o.x = pack2(a0 * rstd * gg.x, a1 * rstd * gg.y); o.y = pack2(a2 * rstd * gg.z, a3 * rstd * gg.w);
            *(uint2*)(pr + C_CQ + lane * 4) = o; }
        {
            unsigned raw = *(const unsigned*)(pr + C_CKV + lane * 2);
            float a0 = bflo(raw), a1 = bfhi(raw);
            float ss = wave_sum(a0 * a0 + a1 * a1);
            const float rstd = rsqrtf(ss * (1.0f / 128.0f) + EPS);
            *(unsigned*)(pr + C_CKV + lane * 2) = pack2(a0 * rstd * gckv[lane * 2], a1 * rstd * gckv[lane * 2 + 1]); }
        if (r >= LC && lane < 16) {
            const int t = r - LC, i = lane & 7, base = (lane < 8) ? 0 : 16, pos = (lane < 8) ? (t >> 6) : (t & 63);
            float a = bf2f(pr[C_KR + base + i]), b = bf2f(pr[C_KR + base + 8 + i]);
            rope_pair(a, b, pos, i, 8);
            pr[C_KR + base + i] = f2bf(a); pr[C_KR + base + 8 + i] = f2bf(b); }
    }
    const float* gqn = p.in[I_GQN] + l * 64; const float* gkn = p.in[I_GKN] + l * 64;
    for (long idx = (long)bid * 256 + threadIdx.x; idx < (long)T * 10; idx += (long)nb * 256) {
        const int r = (int)(idx / 10), h = (int)(idx % 10);
        bf16_t* ptr = P + (size_t)r * NIN + (h < 8 ? C_GQ + h * 64 : C_GK + (h - 8) * 64);
        const float* gg = (h < 8) ? gqn : gkn;
        float v[64]; float ss = 0.f;
#pragma unroll
        for (int i = 0; i < 8; ++i) { const uint4 raw = ((const uint4*)ptr)[i];
            v[8 * i + 0] = bflo(raw.x); v[8 * i + 1] = bfhi(raw.x); v[8 * i + 2] = bflo(raw.y); v[8 * i + 3] = bfhi(raw.y);
            v[8 * i + 4] = bflo(raw.z); v[8 * i + 5] = bfhi(raw.z); v[8 * i + 6] = bflo(raw.w); v[8 * i + 7] = bfhi(raw.w); }
#pragma unroll
        for (int i = 0; i < 64; ++i) ss += v[i] * v[i];
        const float rstd = rsqrtf(ss * (1.0f / 64.0f) + EPS);
#pragma unroll
        for (int i = 0; i < 64; ++i) v[i] = v[i] * rstd * gg[i];
        if (r >= LC) { const int t = r - LC, prow = t >> 6, pcol = t & 63;
#pragma unroll
            for (int i = 0; i < 16; ++i) { rope_pair(v[i], v[16 + i], prow, i, 16); rope_pair(v[32 + i], v[48 + i], pcol, i, 16); } }
#pragma unroll
        for (int i = 0; i < 8; ++i) { uint4 o; o.x = pack2(v[8 * i], v[8 * i + 1]); o.y = pack2(v[8 * i + 2], v[8 * i + 3]); o.z = pack2(v[8 * i + 4], v[8 * i + 5]); o.w = pack2(v[8 * i + 6], v[8 * i + 7]);
            ((uint4*)ptr)[i] = o; }
    }
}

__device__ void st_s5_scan(const Params& p, int l, int bid, int nb) {
    const int lane = threadIdx.x & 63, wid = threadIdx.x >> 6;
    const bf16_t* P = WSP(bf16_t, OFF_P);
    for (int gw = bid * 4 + wid; gw < 64; gw += nb * 4) {
        const int dir = gw >> 5, g = gw & 31;
        float* Yo = dir == 0 ? WSP(float, OFF_OM) : WSP(float, OFF_H);
        const int gi = (l * 2 + dir) * 32 + g, pi = gi * 64 + lane;
        const float are = p.in[I_ARE][pi], aim = p.in[I_AIM][pi], dt = expf(p.in[I_LOGDT][gi]);
        const float mag = expf(are * dt); float sn, cs; sincosf(aim * dt, &sn, &cs);
        const float lr = mag * cs, li = mag * sn, den = are * are + aim * aim;
        const float cr = ((lr - 1.0f) * are + li * aim) / den, ci = (li * are - (lr - 1.0f) * aim) / den;
        float bbr[16], bbi[16], cre[16], cim[16];
#pragma unroll
        for (int c = 0; c < 16; ++c) { const float br = p.in[I_BRE][(size_t)pi * 16 + c], bi = p.in[I_BIM][(size_t)pi * 16 + c];
            bbr[c] = cr * br - ci * bi; bbi[c] = cr * bi + ci * br;
            cre[c] = p.in[I_CRE][((size_t)gi * 16 + c) * 64 + lane]; cim[c] = p.in[I_CIM][((size_t)gi * 16 + c) * 64 + lane]; }
        const float dsk = p.in[I_SSMD][l * 512 + g * 16 + (lane & 15)];
        float sr = 0.f, si = 0.f;
        for (int j0 = 0; j0 < T; j0 += 8) {
            uint4 ua[8], ub[8];
#pragma unroll
            for (int q = 0; q < 8; ++q) { const int j = j0 + q; const int r = dir == 0 ? j : (j < LC ? LC - 1 - j : T + LC - 1 - j);
                const uint4* up = (const uint4*)(P + (size_t)r * NIN + C_SSM + g * 16); ua[q] = up[0]; ub[q] = up[1]; }
#pragma unroll
            for (int q = 0; q < 8; ++q) { const int j = j0 + q; const int r = dir == 0 ? j : (j < LC ? LC - 1 - j : T + LC - 1 - j);
                float u[16];
                u[0] = bflo(ua[q].x); u[1] = bfhi(ua[q].x); u[2] = bflo(ua[q].y); u[3] = bfhi(ua[q].y); u[4] = bflo(ua[q].z); u[5] = bfhi(ua[q].z); u[6] = bflo(ua[q].w); u[7] = bfhi(ua[q].w);
                u[8] = bflo(ub[q].x); u[9] = bfhi(ub[q].x); u[10] = bflo(ub[q].y); u[11] = bfhi(ub[q].y); u[12] = bflo(ub[q].z); u[13] = bfhi(ub[q].z); u[14] = bflo(ub[q].w); u[15] = bfhi(ub[q].w);
                float bur = 0.f, bui = 0.f;
#pragma unroll
                for (int c = 0; c < 16; ++c) { bur = fmaf(bbr[c], u[c], bur); bui = fmaf(bbi[c], u[c], bui); }
                const float nsr = lr * sr - li * si + bur, nsi = lr * si + li * sr + bui; sr = nsr; si = nsi;
                float t16[16];
#pragma unroll
                for (int c = 0; c < 16; ++c) t16[c] = cre[c] * sr - cim[c] * si;
                float y = transpose_reduce16(t16, lane);
                if (lane < 16) {
                    if (dir == 0) y += dsk * bf2f(P[(size_t)r * NIN + C_SSM + g * 16 + lane]);
                    Yo[(size_t)r * 512 + g * 16 + lane] = y; }
            }
        }
    }
}
__device__ void st_s5_fin(const Params& p, int bid, int nb) {
    const float* Yf = WSP(float, OFF_OM); const float* Yb = WSP(float, OFF_H); bf16_t* P = WSP(bf16_t, OFF_P);
    for (long idx = (long)bid * 256 + threadIdx.x; idx < (long)T * 512; idx += (long)nb * 256) {
        const int r = (int)(idx >> 9), c = (int)(idx & 511);
        P[(size_t)r * NIN + C_SSM + c] = f2bf(gelu_tanh(Yf[idx] + Yb[idx]));
    }
}

__device__ void st_proj2(const Params& p, int l, int bid, int nb) {
    bf16_t* P = WSP(bf16_t, OFF_P);
    {   const bf16_t* Wt = WSP(bf16_t, OFF_WB + WB_UQ); bf16_t* Qm = WSP(bf16_t, OFF_H);
        gemm_naive(T, 768, 256, [&](int m) { return P + (size_t)m * NIN + C_CQ; }, [&](int, int n) { return Wt + (size_t)n * 256; },
                   [&](int m, int n, float acc) { Qm[(size_t)m * 768 + n] = f2bf(acc); }, bid, nb); }
    {   const bf16_t* Wt = WSP(bf16_t, OFF_WB + WB_UKV); bf16_t* Kn = WSP(bf16_t, OFF_KN); bf16_t* Vm = WSP(bf16_t, OFF_V);
        gemm_naive(T, 1024, 128, [&](int m) { return P + (size_t)m * NIN + C_CKV; }, [&](int, int n) { return Wt + (size_t)n * 128; },
                   [&](int m, int n, float acc) { const int h = n >> 7, j = n & 127; if (j < 64) Kn[(size_t)m * 512 + h * 64 + j] = f2bf(acc); else Vm[(size_t)m * 512 + h * 64 + j - 64] = f2bf(acc); }, bid, nb); }
    {   const bf16_t* Wt = WSP(bf16_t, OFF_WB + WB_GLU); bf16_t* Os = WSP(bf16_t, OFF_OS); const float* bg = p.in[I_BGLU] + l * 512;
        gemm_naive(T, 512, 512, [&](int m) { return P + (size_t)m * NIN + C_SSM; }, [&](int, int n) { return Wt + (size_t)n * 512; },
                   [&](int m, int n, float acc) { const float y1 = bf2f(P[(size_t)m * NIN + C_SSM + n]); Os[(size_t)m * 512 + n] = f2bf(y1 * sigmoidf_(acc + bg[n])); }, bid, nb); }
}
__device__ void st_ropeq(const Params& p, int bid, int nb) {
    bf16_t* Qm = WSP(bf16_t, OFF_H);
    for (long idx = (long)bid * 256 + threadIdx.x; idx < (long)S * 8 * 16; idx += (long)nb * 256) {
        const int pr = (int)(idx & 15), h = (int)((idx >> 4) & 7), t = (int)(idx >> 7);
        const int i = pr & 7, base = (pr < 8) ? 0 : 16, pos = (pr < 8) ? (t >> 6) : (t & 63);
        bf16_t* q = Qm + (size_t)(t + LC) * 768 + h * 96 + 64;
        float a = bf2f(q[base + i]), b = bf2f(q[base + 8 + i]);
        rope_pair(a, b, pos, i, 8);
        q[base + i] = f2bf(a); q[base + 8 + i] = f2bf(b);
    }
}

template <int DQK>
__device__ __forceinline__ void attn_naive_item(const bf16_t* qp, const bf16_t* kA, int pitchA, const bf16_t* kB, int pitchB, const bf16_t* vp, int pitchV, int nkeys, float scale, bf16_t* op) {
    float q[DQK], o[64];
#pragma unroll
    for (int i = 0; i < DQK / 8; ++i) { const uint4 raw = ((const uint4*)qp)[i];
        q[8 * i + 0] = bflo(raw.x) * scale; q[8 * i + 1] = bfhi(raw.x) * scale; q[8 * i + 2] = bflo(raw.y) * scale; q[8 * i + 3] = bfhi(raw.y) * scale;
        q[8 * i + 4] = bflo(raw.z) * scale; q[8 * i + 5] = bfhi(raw.z) * scale; q[8 * i + 6] = bflo(raw.w) * scale; q[8 * i + 7] = bfhi(raw.w) * scale; }
#pragma unroll
    for (int i = 0; i < 64; ++i) o[i] = 0.f;
    float m = -INFINITY, lsum = 0.f;
    for (int j = 0; j < nkeys; ++j) {
        float s = 0.f;
        const uint4* k4 = (const uint4*)(kA + (size_t)j * pitchA);
#pragma unroll
        for (int i = 0; i < 8; ++i) { const uint4 raw = k4[i];
            s = fmaf(q[8 * i + 0], bflo(raw.x), s); s = fmaf(q[8 * i + 1], bfhi(raw.x), s); s = fmaf(q[8 * i + 2], bflo(raw.y), s); s = fmaf(q[8 * i + 3], bfhi(raw.y), s);
            s = fmaf(q[8 * i + 4], bflo(raw.z), s); s = fmaf(q[8 * i + 5], bfhi(raw.z), s); s = fmaf(q[8 * i + 6], bflo(raw.w), s); s = fmaf(q[8 * i + 7], bfhi(raw.w), s); }
        if (DQK > 64) {
            const uint4* kb4 = (const uint4*)(kB + (size_t)j * pitchB);
#pragma unroll
            for (int i = 0; i < (DQK - 64) / 8; ++i) { const uint4 raw = kb4[i]; const int b = 64 + 8 * i;
                s = fmaf(q[b + 0], bflo(raw.x), s); s = fmaf(q[b + 1], bfhi(raw.x), s); s = fmaf(q[b + 2], bflo(raw.y), s); s = fmaf(q[b + 3], bfhi(raw.y), s);
                s = fmaf(q[b + 4], bflo(raw.z), s); s = fmaf(q[b + 5], bfhi(raw.z), s); s = fmaf(q[b + 6], bflo(raw.w), s); s = fmaf(q[b + 7], bfhi(raw.w), s); }
        }
        if (s > m) { const float c = exp2f(m - s); lsum *= c;
#pragma unroll
            for (int i = 0; i < 64; ++i) o[i] *= c;
            m = s; }
        const float pe = exp2f(s - m); lsum += pe;
        const uint4* v4 = (const uint4*)(vp + (size_t)j * pitchV);
#pragma unroll
        for (int i = 0; i < 8; ++i) { const uint4 raw = v4[i];
            o[8 * i + 0] = fmaf(pe, bflo(raw.x), o[8 * i + 0]); o[8 * i + 1] = fmaf(pe, bfhi(raw.x), o[8 * i + 1]); o[8 * i + 2] = fmaf(pe, bflo(raw.y), o[8 * i + 2]); o[8 * i + 3] = fmaf(pe, bfhi(raw.y), o[8 * i + 3]);
            o[8 * i + 4] = fmaf(pe, bflo(raw.z), o[8 * i + 4]); o[8 * i + 5] = fmaf(pe, bfhi(raw.z), o[8 * i + 5]); o[8 * i + 6] = fmaf(pe, bflo(raw.w), o[8 * i + 6]); o[8 * i + 7] = fmaf(pe, bfhi(raw.w), o[8 * i + 7]); }
    }
    const float inv = 1.0f / lsum;
#pragma unroll
    for (int i = 0; i < 8; ++i) { uint4 w; w.x = pack2(o[8 * i] * inv, o[8 * i + 1] * inv); w.y = pack2(o[8 * i + 2] * inv, o[8 * i + 3] * inv); w.z = pack2(o[8 * i + 4] * inv, o[8 * i + 5] * inv); w.w = pack2(o[8 * i + 6] * inv, o[8 * i + 7] * inv);
        ((uint4*)op)[i] = w; }
}
__device__ void st_attn(const Params& p, int bid, int nb) {
    const bf16_t* P = WSP(bf16_t, OFF_P); const bf16_t* Qm = WSP(bf16_t, OFF_H); const bf16_t* Kn = WSP(bf16_t, OFF_KN); const bf16_t* Vm = WSP(bf16_t, OFF_V);
    bf16_t* Om = WSP(bf16_t, OFF_OM); bf16_t* Og = WSP(bf16_t, OFF_OG);
    constexpr int NQT = T / 256;
    for (int w = bid; w < 2 * NQT * 8; w += nb) {
        const int ty = w / (NQT * 8), rem = w % (NQT * 8), qt = rem >> 3, h = rem & 7;
        const int r = qt * 256 + threadIdx.x, nkeys = (qt == 0) ? LC : T;
        if (ty == 0)
            attn_naive_item<96>(Qm + (size_t)r * 768 + h * 96, Kn + h * 64, 512, P + C_KR, NIN, Vm + h * 64, 512, nkeys, 0.10206207261596575f * LOG2E, Om + (size_t)r * 512 + h * 64);
        else
            attn_naive_item<64>(P + (size_t)r * NIN + C_GQ + h * 64, P + C_GK + (h >> 2) * 64, NIN, nullptr, 0, P + C_GV + (h >> 2) * 64, NIN, nkeys, 0.125f * LOG2E, Og + (size_t)r * 512 + h * 64);
    }
}

__device__ void st_merge(const Params& p, int bid, int nb) {
    const bf16_t* P = WSP(bf16_t, OFF_P); bf16_t* Mb = WSP(bf16_t, OFF_H);
    const bf16_t* Ob[3] = { WSP(bf16_t, OFF_OM), WSP(bf16_t, OFF_OS), WSP(bf16_t, OFF_OG) };
    const bf16_t* Wb = WSP(bf16_t, OFF_WB + WB_BR);
    for (long idx = (long)bid * 256 + threadIdx.x; idx < (long)T * 1024; idx += (long)nb * 256) {
        const int m = (int)(idx >> 10), n = (int)(idx & 1023);
        float tot = 0.f;
#pragma unroll
        for (int b = 0; b < 3; ++b) {
            const float acc = dotrow(Ob[b] + (size_t)m * 512, Wb + ((size_t)b * 1024 + n) * 512, 512);
            tot += sigmoidf_(bf2f(P[(size_t)m * NIN + C_GATE + b * 1024 + n])) * acc;
        }
        Mb[idx] = f2bf(tot);
    }
}
__device__ void st_wout(const Params& p, int bid, int nb) {
    const bf16_t* Mb = WSP(bf16_t, OFF_H); const bf16_t* Wt = WSP(bf16_t, OFF_WB + WB_OUT); float* Y = WSP(float, OFF_Y);
    gemm_naive(T, 1024, 1024, [&](int m) { return Mb + (size_t)m * 1024; }, [&](int, int n) { return Wt + (size_t)n * 1024; },
               [&](int m, int n, float acc) { Y[(size_t)m * 1024 + n] = acc; }, bid, nb);
    int* sltok = WSP(int, OFF_SLTOK); float* slw = WSP(float, OFF_SLW); int* cnt = WSP(int, OFF_CNT);
    for (int i = bid * 256 + threadIdx.x; i < TP; i += nb * 256) { sltok[i] = 0; slw[i] = 0.f; }
    if (bid == 0 && threadIdx.x < 32) cnt[threadIdx.x] = 0;
}

__device__ void st_postmix(const Params& p, int l, int bid, int nb) {
    const int lane = threadIdx.x & 63, wid = threadIdx.x >> 6;
    const float* Y = WSP(float, OFF_Y); bf16_t* H2 = WSP(bf16_t, OFF_H);
    const float* gpost = p.in[I_GPOSTMIX] + l * D; const float* gpre = p.in[I_GPREFFN] + l * D;
    const float* wg = p.in[I_WGROUP] + (size_t)l * D * 4; const float* wr = p.in[I_WROUTER] + (size_t)l * D * 16;
    int* toke = WSP(int, OFF_TOKE); float* tokw = WSP(float, OFF_TOKW); int* cnt = WSP(int, OFF_CNT);
    for (int r = bid * 4 + wid; r < T; r += nb * 4) {
        float* xr = xrow(p, r);
        const float* md = WSP(float, OFF_MOD) + (size_t)(l * 2 + (r < LC ? 1 : 0)) * 6144;
        float4 y[4], x[4]; float ss = 0.f;
#pragma unroll
        for (int i = 0; i < 4; ++i) { y[i] = *(const float4*)(Y + (size_t)r * D + i * 256 + lane * 4); ss += y[i].x * y[i].x + y[i].y * y[i].y + y[i].z * y[i].z + y[i].w * y[i].w; }
        ss = wave_sum(ss);
        const float rstd = rsqrtf(ss * (1.0f / D) + EPS);
        float ss2 = 0.f;
#pragma unroll
        for (int i = 0; i < 4; ++i) { const int c = i * 256 + lane * 4;
            const float4 gg = *(const float4*)(gpost + c), ga = *(const float4*)(md + 2048 + c); x[i] = *(const float4*)(xr + c);
            x[i].x += ga.x * y[i].x * rstd * gg.x; x[i].y += ga.y * y[i].y * rstd * gg.y; x[i].z += ga.z * y[i].z * rstd * gg.z; x[i].w += ga.w * y[i].w * rstd * gg.w;
            *(float4*)(xr + c) = x[i];
            ss2 += x[i].x * x[i].x + x[i].y * x[i].y + x[i].z * x[i].z + x[i].w * x[i].w; }
        ss2 = wave_sum(ss2);
        const float rstd2 = rsqrtf(ss2 * (1.0f / D) + EPS);
        float lg[4] = {0.f, 0.f, 0.f, 0.f}, le[16];
#pragma unroll
        for (int e = 0; e < 16; ++e) le[e] = 0.f;
#pragma unroll
        for (int i = 0; i < 4; ++i) { const int c = i * 256 + lane * 4;
            const float4 gg = *(const float4*)(gpre + c), sh = *(const float4*)(md + 3072 + c), sc = *(const float4*)(md + 4096 + c);
            float h[4];
            h[0] = x[i].x * rstd2 * gg.x * (1.f + sc.x) + sh.x; h[1] = x[i].y * rstd2 * gg.y * (1.f + sc.y) + sh.y;
            h[2] = x[i].z * rstd2 * gg.z * (1.f + sc.z) + sh.z; h[3] = x[i].w * rstd2 * gg.w * (1.f + sc.w) + sh.w;
            uint2 o; o.x = pack2(h[0], h[1]); o.y = pack2(h[2], h[3]);
            *(uint2*)(H2 + (size_t)r * D + c) = o;
#pragma unroll
            for (int q = 0; q < 4; ++q) {
                const float4 w4 = *(const float4*)(wg + (size_t)(c + q) * 4);
                lg[0] = fmaf(h[q], w4.x, lg[0]); lg[1] = fmaf(h[q], w4.y, lg[1]); lg[2] = fmaf(h[q], w4.z, lg[2]); lg[3] = fmaf(h[q], w4.w, lg[3]);
#pragma unroll
                for (int e4 = 0; e4 < 4; ++e4) { const float4 r4 = *(const float4*)(wr + (size_t)(c + q) * 16 + e4 * 4);
                    le[e4 * 4 + 0] = fmaf(h[q], r4.x, le[e4 * 4 + 0]); le[e4 * 4 + 1] = fmaf(h[q], r4.y, le[e4 * 4 + 1]); le[e4 * 4 + 2] = fmaf(h[q], r4.z, le[e4 * 4 + 2]); le[e4 * 4 + 3] = fmaf(h[q], r4.w, le[e4 * 4 + 3]); }
            } }
#pragma unroll
        for (int g = 0; g < 4; ++g) lg[g] = wave_sum(lg[g]) + p.in[I_BGROUP][l * 4 + g];
        const float myle = transpose_reduce16(le, lane) + p.in[I_BROUTER][l * 16 + (lane & 15)];
        int gs = 0; float gm = lg[0];
#pragma unroll
        for (int g = 1; g < 4; ++g) if (lg[g] > gm) { gm = lg[g]; gs = g; }
        float ls[4];
#pragma unroll
        for (int i = 0; i < 4; ++i) ls[i] = __shfl(myle, gs * 4 + i);
        if (lane == 0) {
            float den = 0.f;
#pragma unroll
            for (int g = 0; g < 4; ++g) den += __expf(lg[g] - gm);
            const float pg = 1.0f / den;
            int i0 = 0; float m0 = ls[0];
#pragma unroll
            for (int i = 1; i < 4; ++i) if (ls[i] > m0) { m0 = ls[i]; i0 = i; }
            int i1 = -1; float m1 = -INFINITY;
#pragma unroll
            for (int i = 0; i < 4; ++i) if (i != i0 && ls[i] > m1) { m1 = ls[i]; i1 = i; }
            const float e1 = __expf(m1 - m0), w0 = pg / (1.f + e1), w1 = pg * e1 / (1.f + e1);
            const int ex0 = gs * 4 + i0, ex1 = gs * 4 + i1;
            toke[r * 2] = ex0; toke[r * 2 + 1] = ex1; tokw[r * 2] = w0; tokw[r * 2 + 1] = w1;
            atomicAdd(&cnt[ex0], 1); atomicAdd(&cnt[ex1], 1);
        }
    }
}

__device__ __forceinline__ void moe_offsets(const int* cnt, int* off) {
    int a = 0;
#pragma unroll
    for (int e = 0; e < 16; ++e) { off[e] = a; a += (cnt[e] + 127) & ~127; }
    off[16] = a;
}
__device__ __forceinline__ int moe_expert_of(const int* off, int j) {
    int e = 0;
#pragma unroll
    for (int k = 1; k < 16; ++k) e += (j >= off[k]) ? 1 : 0;
    return e;
}
__device__ void st_moe_build(const Params& p, int bid, int nb) {
    int* cnt = WSP(int, OFF_CNT); int* cnt2 = cnt + 16;
    const int* toke = WSP(int, OFF_TOKE); const float* tokw = WSP(float, OFF_TOKW); int* toks = WSP(int, OFF_TOKS);
    int* sltok = WSP(int, OFF_SLTOK); float* slw = WSP(float, OFF_SLW);
    int off[17]; moe_offsets(cnt, off);
    for (int idx = bid * 256 + threadIdx.x; idx < T * 2; idx += nb * 256) {
        const int e = toke[idx];
        int o = 0;
#pragma unroll
        for (int k = 0; k < 16; ++k) o = (e == k) ? off[k] : o;
        const int pos = o + atomicAdd(&cnt2[e], 1);
        sltok[pos] = idx >> 1; slw[pos] = tokw[idx]; toks[idx] = pos;
    }
}
__device__ void st_moe_up(const Params& p, int bid, int nb) {
    const int* cnt = WSP(int, OFF_CNT); const int* sltok = WSP(int, OFF_SLTOK);
    const bf16_t* H2 = WSP(bf16_t, OFF_H); const bf16_t* Wg = WSP(bf16_t, OFF_WB + WB_EG); const bf16_t* Wu = WSP(bf16_t, OFF_WB + WB_EU); bf16_t* Hid = WSP(bf16_t, OFF_HID);
    int off[17]; moe_offsets(cnt, off);
    const long total = (long)off[16] * 512;
    for (long idx = (long)bid * 256 + threadIdx.x; idx < total; idx += (long)nb * 256) {
        const int j = (int)(idx >> 9), n = (int)(idx & 511);
        const int e = moe_expert_of(off, j);
        const bf16_t* a = H2 + (size_t)sltok[j] * 1024;
        const float g = dotrow(a, Wg + ((size_t)e * 512 + n) * 1024, 1024), u = dotrow(a, Wu + ((size_t)e * 512 + n) * 1024, 1024);
        Hid[idx] = f2bf(siluf_(g) * u);
    }
}
__device__ void st_moe_down(const Params& p, int bid, int nb) {
    const int* cnt = WSP(int, OFF_CNT); const float* slw = WSP(float, OFF_SLW);
    const bf16_t* Hid = WSP(bf16_t, OFF_HID); const bf16_t* Wd = WSP(bf16_t, OFF_WB + WB_ED); bf16_t* Sl = WSP(bf16_t, OFF_SLOTS);
    int off[17]; moe_offsets(cnt, off);
    const long total = (long)off[16] * 1024;
    for (long idx = (long)bid * 256 + threadIdx.x; idx < total; idx += (long)nb * 256) {
        const int j = (int)(idx >> 10), n = (int)(idx & 1023);
        const int e = moe_expert_of(off, j);
        const float acc = dotrow(Hid + (size_t)j * 512, Wd + ((size_t)e * 1024 + n) * 512, 512);
        Sl[idx] = f2bf(slw[j] * acc);
    }
}
__device__ void st_postffn(const Params& p, int l, int bid, int nb) {
    const int lane = threadIdx.x & 63, wid = threadIdx.x >> 6;
    const bf16_t* Sl = WSP(bf16_t, OFF_SLOTS); const int* toks = WSP(int, OFF_TOKS);
    const float* gpost = p.in[I_GPOSTFFN] + l * D;
    for (int r = bid * 4 + wid; r < T; r += nb * 4) {
        float* xr = xrow(p, r);
        const float* md = WSP(float, OFF_MOD) + (size_t)(l * 2 + (r < LC ? 1 : 0)) * 6144;
        const bf16_t* s0 = Sl + (size_t)toks[r * 2] * 1024; const bf16_t* s1 = Sl + (size_t)toks[r * 2 + 1] * 1024;
        float v[16]; float ss = 0.f;
#pragma unroll
        for (int i = 0; i < 4; ++i) { const int c = i * 256 + lane * 4; const uint2 a = *(const uint2*)(s0 + c), b = *(const uint2*)(s1 + c);
            v[4 * i] = bflo(a.x) + bflo(b.x); v[4 * i + 1] = bfhi(a.x) + bfhi(b.x); v[4 * i + 2] = bflo(a.y) + bflo(b.y); v[4 * i + 3] = bfhi(a.y) + bfhi(b.y);
            ss += v[4 * i] * v[4 * i] + v[4 * i + 1] * v[4 * i + 1] + v[4 * i + 2] * v[4 * i + 2] + v[4 * i + 3] * v[4 * i + 3]; }
        ss = wave_sum(ss);
        const float rstd = rsqrtf(ss * (1.0f / D) + EPS);
#pragma unroll
        for (int i = 0; i < 4; ++i) { const int c = i * 256 + lane * 4;
            const float4 gg = *(const float4*)(gpost + c), ga = *(const float4*)(md + 5120 + c); float4 x = *(const float4*)(xr + c);
            x.x += ga.x * v[4 * i] * rstd * gg.x; x.y += ga.y * v[4 * i + 1] * rstd * gg.y; x.z += ga.z * v[4 * i + 2] * rstd * gg.z; x.w += ga.w * v[4 * i + 3] * rstd * gg.w;
            *(float4*)(xr + c) = x; }
    }
}

__device__ __forceinline__ void gsync(unsigned* bar, unsigned& epoch) {
    asm volatile("s_waitcnt vmcnt(0) lgkmcnt(0)" ::: "memory");
    __syncthreads();
    if (threadIdx.x == 0) {
        __builtin_amdgcn_fence(__ATOMIC_RELEASE, "agent");
        asm volatile("s_waitcnt vmcnt(0)" ::: "memory");
        epoch += 1;
        __hip_atomic_fetch_add(bar, 1u, __ATOMIC_RELAXED, __HIP_MEMORY_SCOPE_AGENT);
        const unsigned target = epoch * gridDim.x;
        while (__hip_atomic_load(bar, __ATOMIC_RELAXED, __HIP_MEMORY_SCOPE_AGENT) < target) __builtin_amdgcn_s_sleep(2);
        __builtin_amdgcn_fence(__ATOMIC_ACQUIRE, "agent");
        asm volatile("s_waitcnt vmcnt(0)" ::: "memory");
    }
    __syncthreads();
}

constexpr int NSTL = 15;
constexpr int NSTAGES = 1 + NL * NSTL;
__device__ __forceinline__ void do_stage(const Params& p, int s, int bid, int nb, float* smem, int lfix = -1) {
    if (s == 0) { st_prologue(p, bid, nb, smem); return; }
    const int l = lfix >= 0 ? lfix : (s - 1) / NSTL, k = (s - 1) % NSTL;
    switch (k) {
        case 0: st_conv(p, l, bid, nb, smem); st_modulate(p, l, bid, nb); break;
        case 1: st_gemm_in(p, bid, nb); break;
        case 2: st_postproj(p, l, bid, nb); break;
        case 3: st_s5_scan(p, l, bid, nb); break;
        case 4: st_s5_fin(p, bid, nb); break;
        case 5: st_proj2(p, l, bid, nb); break;
        case 6: st_ropeq(p, bid, nb); break;
        case 7: st_attn(p, bid, nb); break;
        case 8: st_merge(p, bid, nb); break;
        case 9: st_wout(p, bid, nb); break;
        case 10: st_postmix(p, l, bid, nb); break;
        case 11: st_moe_build(p, bid, nb); break;
        case 12: st_moe_up(p, bid, nb); break;
        case 13: st_moe_down(p, bid, nb); break;
        case 14: st_postffn(p, l, bid, nb); break;
    }
}

template <int K>
__global__ void __launch_bounds__(256) k_stage(Params p, int l) {
    __shared__ __attribute__((aligned(16))) float smem[64 * 65];
    if (K < 0) do_stage(p, 0, blockIdx.x, gridDim.x, smem);
    else do_stage(p, 1 + K, blockIdx.x, gridDim.x, smem, l);
}
#if !MULTI_LAUNCH
__global__ void __launch_bounds__(256) k_mega(Params p) {
    __shared__ __attribute__((aligned(16))) float smem[64 * 65];
    cg::grid_group grid = cg::this_grid();
    grid.sync();
    const int bid = blockIdx.x, nb = gridDim.x;
    unsigned* bar = WSP(unsigned, OFF_BAR); unsigned epoch = 0;
#define GS() gsync(bar, epoch)
    st_prologue(p, bid, nb, smem); GS();
#pragma unroll 1
    for (int l = 0; l < NL; ++l) {
        st_conv(p, l, bid, nb, smem); st_modulate(p, l, bid, nb); GS();
        st_gemm_in(p, bid, nb); GS();
        st_postproj(p, l, bid, nb); GS();
        st_s5_scan(p, l, bid, nb); GS();
        st_s5_fin(p, bid, nb); GS();
        st_proj2(p, l, bid, nb); GS();
        st_ropeq(p, bid, nb); GS();
        st_attn(p, bid, nb); GS();
        st_merge(p, bid, nb); GS();
        st_wout(p, bid, nb); GS();
        st_postmix(p, l, bid, nb); GS();
        st_moe_build(p, bid, nb); GS();
        st_moe_up(p, bid, nb); GS();
        st_moe_down(p, bid, nb); GS();
        st_postffn(p, l, bid, nb); GS();
    }
#undef GS
}
#endif

extern "C" void kernel_launch(void* const* d_in, const int* in_sizes, int n_in, void* d_out, int out_size, void* d_ws, size_t ws_size, hipStream_t stream) {
    Params p{};
    for (int i = 0; i < N_IN; ++i) p.in[i] = (const float*)d_in[i];
    p.out = (float*)d_out; p.ws = (char*)d_ws;
    if (ws_size < WS_NEED) { fprintf(stderr, "workspace too small: %zu < %zu\n", ws_size, (size_t)WS_NEED); return; }
    static int grid_blocks = 0;
    if (!grid_blocks) {
        int dev = 0, cus = 0, per_cu = 0;
        hipGetDevice(&dev);
        hipDeviceGetAttribute(&cus, hipDeviceAttributeMultiprocessorCount, dev);
#if MULTI_LAUNCH
        per_cu = 2;
#else
        hipOccupancyMaxActiveBlocksPerMultiprocessor(&per_cu, k_mega, 256, 0);
#endif
        if (per_cu > 2) per_cu = 2;
        if (per_cu < 1) per_cu = 1;
        grid_blocks = cus * per_cu;
    }
#if MULTI_LAUNCH
    hipLaunchKernelGGL(k_stage<-1>, dim3(grid_blocks), dim3(256), 0, stream, p, 0);
    for (int l = 0; l < NL; ++l) {
#define LS(K) hipLaunchKernelGGL(k_stage<K>, dim3(grid_blocks), dim3(256), 0, stream, p, l)
        LS(0); LS(1); LS(2); LS(3); LS(4); LS(5); LS(6); LS(7); LS(8); LS(9); LS(10); LS(11); LS(12); LS(13); LS(14);
#undef LS
    }
#else
    hipMemsetAsync((char*)d_ws + OFF_BAR, 0, 256, stream);
    void* args[] = { &p };
    hipError_t e = hipLaunchCooperativeKernel((void*)k_mega, dim3(grid_blocks), dim3(256), args, 0, stream);
    if (e != hipSuccess) fprintf(stderr, "cooperative launch failed: %s (grid %d)\n", hipGetErrorString(e), grid_blocks);
#endif
}
```

```cpp
#include <hip/hip_runtime.h>
#include <hip/hip_cooperative_groups.h>
#include <cstdio>
#include <cstdint>
namespace cg = cooperative_groups;


typedef unsigned short bf16_t;
typedef short bf16x8 __attribute__((ext_vector_type(8)));
typedef float f32x16 __attribute__((ext_vector_type(16)));
typedef float f32x4 __attribute__((ext_vector_type(4)));
constexpr int NTH = 512, NWV = 8;

constexpr int D = 1024, S = 16384, LC = 256, T = S + LC, NL = 2;
constexpr int NIN = 4768, NINP = 4864;
constexpr int C_CQ = 0, C_CKV = 256, C_KR = 384, C_SSM = 416, C_GQ = 928, C_GK = 1440, C_GV = 1568, C_GATE = 1696;
constexpr int TP = 2 * T + 16 * 256;
constexpr float EPS = 1e-6f;
constexpr float LOG2E = 1.4426950408889634f;

enum { I_X = 0, I_C, I_CTX, I_CCTX, I_WMOD, I_BMOD, I_GPREMIX, I_GPOSTMIX, I_GPREFFN, I_GPOSTFFN, I_WIN, I_GCQ, I_GCKV, I_WUQ, I_WUKV,
       I_GQN, I_GKN, I_ARE, I_AIM, I_LOGDT, I_BRE, I_BIM, I_CRE, I_CIM, I_SSMD, I_WGLU, I_BGLU, I_WBRM, I_WBRS, I_WBRG, I_WOUT,
       I_WGROUP, I_BGROUP, I_WROUTER, I_BROUTER, I_WEG, I_WEU, I_WED, N_IN };

constexpr size_t al256(size_t x) { return (x + 255) & ~(size_t)255; }
constexpr size_t WB_IN = 0;
constexpr size_t WB_UQ = WB_IN + (size_t)NINP * 1024 * 2;
constexpr size_t WB_UKV = WB_UQ + (size_t)768 * 256 * 2;
constexpr size_t WB_GLU = WB_UKV + (size_t)1024 * 128 * 2;
constexpr size_t WB_BR = WB_GLU + (size_t)512 * 512 * 2;
constexpr size_t WB_OUT = WB_BR + (size_t)3 * 1024 * 512 * 2;
constexpr size_t WB_EG = WB_OUT + (size_t)1024 * 1024 * 2;
constexpr size_t WB_EU = WB_EG + (size_t)16 * 512 * 1024 * 2;
constexpr size_t WB_ED = WB_EU + (size_t)16 * 512 * 1024 * 2;
constexpr size_t WB_BYTES = WB_ED + (size_t)16 * 1024 * 512 * 2;

constexpr size_t OFF_WB = 0;
constexpr size_t OFF_P = al256(OFF_WB + WB_BYTES);
constexpr size_t P_BYTES = (size_t)T * NIN * 2;
constexpr size_t OFF_Y = OFF_P;
constexpr size_t OFF_SLOTS = OFF_P;
constexpr size_t OFF_HID = OFF_P + (size_t)TP * 1024 * 2;
constexpr size_t OFF_H = al256(OFF_P + P_BYTES);
constexpr size_t OFF_KN = al256(OFF_H + (size_t)T * 1024 * 2);
constexpr size_t OFF_V = al256(OFF_KN + (size_t)T * 512 * 2);
constexpr size_t OFF_OM = al256(OFF_V + (size_t)T * 512 * 2);
constexpr size_t OFF_OG = OFF_OM + (size_t)T * 512 * 2;
constexpr size_t OFF_OS = OFF_OG + (size_t)T * 512 * 2;
constexpr size_t OFF_XC = al256(OFF_OS + (size_t)T * 512 * 2);
constexpr size_t OFF_MOD = al256(OFF_XC + (size_t)LC * 1024 * 4);
constexpr size_t OFF_TOKE = al256(OFF_MOD + (size_t)NL * 2 * 6144 * 4);
constexpr size_t OFF_TOKW = al256(OFF_TOKE + (size_t)T * 2 * 4);
constexpr size_t OFF_TOKS = al256(OFF_TOKW + (size_t)T * 2 * 4);
constexpr size_t OFF_SLTOK = al256(OFF_TOKS + (size_t)T * 2 * 4);
constexpr size_t OFF_SLW = al256(OFF_SLTOK + (size_t)TP * 4);
constexpr size_t OFF_CNT = al256(OFF_SLW + (size_t)TP * 4);
constexpr size_t OFF_BAR = al256(OFF_CNT + 256);
constexpr size_t WS_NEED = al256(OFF_BAR + 256);
static_assert(OFF_HID + (size_t)TP * 512 * 2 <= OFF_P + P_BYTES, "overlay");
static_assert((size_t)T * 1024 * 4 <= P_BYTES, "overlay Y");
static_assert(WS_NEED < 380000000ull, "ws");

struct Params {
    const float* in[N_IN];
    float* out;
    char* ws;
};
typedef const __attribute__((address_space(4))) Params* kparams_t;
struct KP {
    kparams_t k;
    __device__ __forceinline__ const float* in(int i) const { return *(const float* const volatile __attribute__((address_space(4)))*)(&k->in[i]); }
    __device__ __forceinline__ float* out() const { return *(float* const volatile __attribute__((address_space(4)))*)(&k->out); }
    __device__ __forceinline__ char* ws() const { return *(char* const volatile __attribute__((address_space(4)))*)(&k->ws); }
};

__device__ __forceinline__ float bf2f(bf16_t v) { return __uint_as_float(((unsigned)v) << 16); }
typedef __bf16 bf16x2_t __attribute__((ext_vector_type(2)));
__device__ __forceinline__ bf16_t f2bf(float f) { const __bf16 b = (__bf16)f; return __builtin_bit_cast(bf16_t, b); }
__device__ __forceinline__ float bflo(unsigned u) { return __uint_as_float(u << 16); }
__device__ __forceinline__ float bfhi(unsigned u) { return __uint_as_float(u & 0xFFFF0000u); }
__device__ __forceinline__ unsigned pack2(float lo, float hi) { bf16x2_t v; v[0] = (__bf16)lo; v[1] = (__bf16)hi; return __builtin_bit_cast(unsigned, v); }
__device__ __forceinline__ float wave_sum(float v) {
#pragma unroll
    for (int o = 32; o > 0; o >>= 1) v += __shfl_xor(v, o);
    return v;
}
__device__ __forceinline__ float transpose_reduce16(const float (&t16)[16], int lane) {
    float t8[8], t4[4], t2[2];
#pragma unroll
    for (int i = 0; i < 8; ++i) { const float a = t16[2 * i], b = t16[2 * i + 1]; const bool o = lane & 1; const float keep = o ? b : a, send = o ? a : b; t8[i] = keep + __shfl_xor(send, 1); }
#pragma unroll
    for (int i = 0; i < 4; ++i) { const float a = t8[2 * i], b = t8[2 * i + 1]; const bool o = lane & 2; const float keep = o ? b : a, send = o ? a : b; t4[i] = keep + __shfl_xor(send, 2); }
#pragma unroll
    for (int i = 0; i < 2; ++i) { const float a = t4[2 * i], b = t4[2 * i + 1]; const bool o = lane & 4; const float keep = o ? b : a, send = o ? a : b; t2[i] = keep + __shfl_xor(send, 4); }
    float y; { const float a = t2[0], b = t2[1]; const bool o = lane & 8; const float keep = o ? b : a, send = o ? a : b; y = keep + __shfl_xor(send, 8); }
    y += __shfl_xor(y, 16); y += __shfl_xor(y, 32);
    return y;
}
__device__ __forceinline__ float sigmoidf_(float x) { return 1.0f / (1.0f + __expf(-x)); }
__device__ __forceinline__ float siluf_(float x) { return x / (1.0f + __expf(-x)); }
__device__ __forceinline__ float gelu_tanh(float x) {
    const float u = 0.7978845608028654f * (x + 0.044715f * x * x * x);
    return 0.5f * x * (1.0f + tanhf(u));
}
__device__ __forceinline__ float dot8(uint4 a, uint4 b, float acc) {
    acc = fmaf(bflo(a.x), bflo(b.x), acc); acc = fmaf(bfhi(a.x), bfhi(b.x), acc);
    acc = fmaf(bflo(a.y), bflo(b.y), acc); acc = fmaf(bfhi(a.y), bfhi(b.y), acc);
    acc = fmaf(bflo(a.z), bflo(b.z), acc); acc = fmaf(bfhi(a.z), bfhi(b.z), acc);
    acc = fmaf(bflo(a.w), bflo(b.w), acc); acc = fmaf(bfhi(a.w), bfhi(b.w), acc);
    return acc;
}
__device__ __forceinline__ float dotrow(const bf16_t* a, const bf16_t* b, int K) {
    float acc = 0.f;
    const uint4* a4 = (const uint4*)a; const uint4* b4 = (const uint4*)b;
    for (int k = 0; k < K / 8; ++k) acc = dot8(a4[k], b4[k], acc);
    return acc;
}

__device__ __forceinline__ int opaque_tid() { int t = threadIdx.x; asm volatile("" : "+v"(t)); return t; }
#define WSP(type, off) ((type*)(p.ws() + (off)))

template <class AF, class BF, class EF>
__device__ __forceinline__ void gemm_naive(int M, int N, int K, AF arow, BF brow, EF epi, int bid, int nb) {
    const int tidx = opaque_tid();
    const long total = (long)M * N;
    for (long idx = (long)bid * NTH + tidx; idx < total; idx += (long)nb * NTH) {
        const int m = (int)(idx / N), n = (int)(idx % N);
        const float acc = dotrow(arow(m), brow(m, n), K);
        epi(m, n, acc);
    }
}

constexpr int G_A_BYTES = 256 * 128, G_W_BYTES = 128 * 128, G_BUF = G_A_BYTES + G_W_BYTES;
constexpr int LDS_BYTES = 2 * G_BUF;
#define MFMA32(a, b, c) __builtin_amdgcn_mfma_f32_32x32x16_bf16(a, b, c, 0, 0, 0)

template <class AROW, class WROW>
__device__ __forceinline__ void gemm_core(f32x16 (&acc)[2][2], AROW arow, WROW wrow, int K, char* lds) {
    const int tidx = opaque_tid();
    const int tid = tidx, lane = tid & 63, wid = tid >> 6, wm = wid >> 1, wn = wid & 1, r32 = lane & 31, hi = lane >> 5;
    const int srow = tid >> 3, sch = tid & 7;
    const bf16_t* pa[4]; const bf16_t* pw[2];
#pragma unroll
    for (int i = 0; i < 4; ++i) pa[i] = arow(srow + 64 * i) + sch * 8;
#pragma unroll
    for (int i = 0; i < 2; ++i) pw[i] = wrow(srow + 64 * i) + sch * 8;
    const int soff = srow * 128 + ((sch ^ ((srow >> 1) & 7)) << 4);
    const int xoff = (wm * 64 + r32) * 128, woff = G_A_BYTES + (wn * 64 + r32) * 128, sw7 = (r32 >> 1) & 7;
    uint4 ra[4], rw[2];
    const int nk = K >> 6;
#pragma unroll
    for (int i = 0; i < 4; ++i) ra[i] = *(const uint4*)(pa[i]);
#pragma unroll
    for (int i = 0; i < 2; ++i) rw[i] = *(const uint4*)(pw[i]);
#pragma unroll
    for (int i = 0; i < 4; ++i) *(uint4*)(lds + soff + i * 64 * 128) = ra[i];
#pragma unroll
    for (int i = 0; i < 2; ++i) *(uint4*)(lds + G_A_BYTES + soff + i * 64 * 128) = rw[i];
    __syncthreads();
    for (int kt = 0; kt < nk; ++kt) {
        char* cur = lds + (kt & 1) * G_BUF; char* nxt = lds + ((kt + 1) & 1) * G_BUF;
        const bool more = (kt + 1 < nk);
        if (more) {
#pragma unroll
            for (int i = 0; i < 4; ++i) ra[i] = *(const uint4*)(pa[i] + (kt + 1) * 64);
#pragma unroll
            for (int i = 0; i < 2; ++i) rw[i] = *(const uint4*)(pw[i] + (kt + 1) * 64);
        }
#pragma unroll
        for (int ks = 0; ks < 4; ++ks) {
            const int co = ((ks * 2 + hi) ^ sw7) << 4;
            const bf16x8 x0 = *(const bf16x8*)(cur + xoff + co), x1 = *(const bf16x8*)(cur + xoff + 32 * 128 + co);
            const bf16x8 w0 = *(const bf16x8*)(cur + woff + co), w1 = *(const bf16x8*)(cur + woff + 32 * 128 + co);
            acc[0][0] = MFMA32(w0, x0, acc[0][0]); acc[0][1] = MFMA32(w0, x1, acc[0][1]);
            acc[1][0] = MFMA32(w1, x0, acc[1][0]); acc[1][1] = MFMA32(w1, x1, acc[1][1]);
        }
        if (more) {
#pragma unroll
            for (int i = 0; i < 4; ++i) *(uint4*)(nxt + soff + i * 64 * 128) = ra[i];
#pragma unroll
            for (int i = 0; i < 2; ++i) *(uint4*)(nxt + G_A_BYTES + soff + i * 64 * 128) = rw[i];
        }
        __syncthreads();
    }
}
__device__ __forceinline__ void acc_zero(f32x16 (&acc)[2][2]) {
#pragma unroll
    for (int a = 0; a < 2; ++a)
#pragma unroll
        for (int b = 0; b < 2; ++b)
#pragma unroll
            for (int r = 0; r < 16; ++r) acc[a][b][r] = 0.f;
}
template <class F>
__device__ __forceinline__ void acc_visit(const f32x16 (&acc)[2][2], F f) {
    const int tidx = opaque_tid();
    const int lane = tidx & 63, wid = tidx >> 6, wm = wid >> 1, wn = wid & 1, r32 = lane & 31, hi = lane >> 5;
#pragma unroll
    for (int in = 0; in < 2; ++in)
#pragma unroll
        for (int im = 0; im < 2; ++im)
#pragma unroll
            for (int rg = 0; rg < 4; ++rg) {
                f32x4 v; v[0] = acc[in][im][4 * rg]; v[1] = acc[in][im][4 * rg + 1]; v[2] = acc[in][im][4 * rg + 2]; v[3] = acc[in][im][4 * rg + 3];
                f(wm * 64 + im * 32 + r32, wn * 64 + in * 32 + 8 * rg + 4 * hi, v);
            }
}
template <class F>
__device__ __forceinline__ void acc_visit_add(const f32x16 (&acc)[2][2], f32x16 (&tot)[2][2], F f) {
    const int tidx = opaque_tid();
    const int lane = tidx & 63, wid = tidx >> 6, wm = wid >> 1, wn = wid & 1, r32 = lane & 31, hi = lane >> 5;
#pragma unroll
    for (int in = 0; in < 2; ++in)
#pragma unroll
        for (int im = 0; im < 2; ++im)
#pragma unroll
            for (int rg = 0; rg < 4; ++rg) {
                f32x4 v; v[0] = acc[in][im][4 * rg]; v[1] = acc[in][im][4 * rg + 1]; v[2] = acc[in][im][4 * rg + 2]; v[3] = acc[in][im][4 * rg + 3];
                const f32x4 r = f(wm * 64 + im * 32 + r32, wn * 64 + in * 32 + 8 * rg + 4 * hi, v);
                tot[in][im][4 * rg] += r[0]; tot[in][im][4 * rg + 1] += r[1]; tot[in][im][4 * rg + 2] += r[2]; tot[in][im][4 * rg + 3] += r[3];
            }
}
__device__ __forceinline__ uint2 pack4(f32x4 v) { uint2 o; o.x = pack2(v[0], v[1]); o.y = pack2(v[2], v[3]); return o; }
__device__ __forceinline__ bool dense_tile(int it, int NT, bool with_ctx, int bid, int nb, int& mt, int& nt) {
    const int x = bid & 7, j = bid >> 3, jb = nb >> 3;
    int v = it * jb + j;
    if (v < 8 * NT) { mt = 1 + x * 8 + (v & 7); nt = v >> 3; return true; }
    if (!with_ctx) return false;
    v -= 8 * NT; nt = x + 8 * v; mt = 0;
    return nt < NT;
}

__device__ __forceinline__ void st_prologue(const KP& p, int bid, int nb, float* smem) {
    const int tidx = opaque_tid();
    const int tid = tidx;
    {   const float4* x4 = (const float4*)p.in(I_X); float4* o4 = (float4*)p.out();
        for (long i = (long)bid * NTH + tid; i < (long)S * D / 4; i += (long)nb * NTH) o4[i] = x4[i];
        const float4* c4 = (const float4*)p.in(I_CTX); float4* xc4 = WSP(float4, OFF_XC);
        for (long i = (long)bid * NTH + tid; i < (long)LC * D / 4; i += (long)nb * NTH) xc4[i] = c4[i]; }
    for (int k = tid; k < 1024; k += NTH) { smem[k] = siluf_(p.in(I_C)[k]); smem[1024 + k] = siluf_(p.in(I_CCTX)[k]); }
    __syncthreads();
    float* mod = WSP(float, OFF_MOD);
    for (int idx = bid * NTH + tid; idx < NL * 6144; idx += nb * NTH) {
        const int l = idx / 6144, j = idx % 6144;
        const float* w = p.in(I_WMOD) + (size_t)l * 1024 * 6144 + j;
        float a0 = 0.f, a1 = 0.f;
        for (int k = 0; k < 1024; ++k) { const float wv = w[(size_t)k * 6144]; a0 = fmaf(smem[k], wv, a0); a1 = fmaf(smem[1024 + k], wv, a1); }
        const float b = p.in(I_BMOD)[l * 6144 + j];
        mod[(l * 2 + 0) * 6144 + j] = a0 + b; mod[(l * 2 + 1) * 6144 + j] = a1 + b;
    }
    __syncthreads();
}

__device__ __forceinline__ void conv_t(const float* W, bf16_t* Wt, int K, int N, int Npad, int nmat, int bid, int nb, float* smem) {
    const int tidx = opaque_tid();
    const int tid = tidx, tx = tid & 63, ty = tid >> 6;
    const int tn = Npad / 64, tk = K / 64;
    const int ntile = tn * tk * nmat;
    for (int t = bid; t < ntile; t += nb) {
        const int mat = t / (tn * tk), r = t % (tn * tk), n0 = (r / tk) * 64, k0 = (r % tk) * 64;
        const float* Wm = W + (size_t)mat * K * N; bf16_t* Wtm = Wt + (size_t)mat * Npad * K;
        __syncthreads();
#pragma unroll
        for (int i = 0; i < 8; ++i) { const int kk = ty + 8 * i, n = n0 + tx; smem[kk * 65 + tx] = (n < N) ? Wm[(size_t)(k0 + kk) * N + n] : 0.f; }
        __syncthreads();
#pragma unroll
        for (int i = 0; i < 8; ++i) { const int nn = ty + 8 * i; Wtm[(size_t)(n0 + nn) * K + k0 + tx] = f2bf(smem[tx * 65 + nn]); }
    }
    __syncthreads();
}
__device__ __forceinline__ void st_conv(const KP& p, int l, int bid, int nb, float* smem) {
    const int tidx = opaque_tid();
    bf16_t* wb = WSP(bf16_t, OFF_WB);
    conv_t(p.in(I_WIN) + (size_t)l * 1024 * NIN, (bf16_t*)((char*)wb + WB_IN), 1024, NIN, NINP, 1, bid, nb, smem);
    conv_t(p.in(I_WUQ) + (size_t)l * 256 * 768, (bf16_t*)((char*)wb + WB_UQ), 256, 768, 768, 1, bid, nb, smem);
    conv_t(p.in(I_WUKV) + (size_t)l * 128 * 1024, (bf16_t*)((char*)wb + WB_UKV), 128, 1024, 1024, 1, bid, nb, smem);
    conv_t(p.in(I_WGLU) + (size_t)l * 512 * 512, (bf16_t*)((char*)wb + WB_GLU), 512, 512, 512, 1, bid, nb, smem);
    conv_t(p.in(I_WBRM) + (size_t)l * 512 * 1024, (bf16_t*)((char*)wb + WB_BR), 512, 1024, 1024, 1, bid, nb, smem);
    conv_t(p.in(I_WBRS) + (size_t)l * 512 * 1024, (bf16_t*)((char*)wb + WB_BR + (size_t)1024 * 512 * 2), 512, 1024, 1024, 1, bid, nb, smem);
    conv_t(p.in(I_WBRG) + (size_t)l * 512 * 1024, (bf16_t*)((char*)wb + WB_BR + (size_t)2 * 1024 * 512 * 2), 512, 1024, 1024, 1, bid, nb, smem);
    conv_t(p.in(I_WOUT) + (size_t)l * 1024 * 1024, (bf16_t*)((char*)wb + WB_OUT), 1024, 1024, 1024, 1, bid, nb, smem);
    conv_t(p.in(I_WEG) + (size_t)l * 16 * 1024 * 512, (bf16_t*)((char*)wb + WB_EG), 1024, 512, 512, 16, bid, nb, smem);
    conv_t(p.in(I_WEU) + (size_t)l * 16 * 1024 * 512, (bf16_t*)((char*)wb + WB_EU), 1024, 512, 512, 16, bid, nb, smem);
    conv_t(p.in(I_WED) + (size_t)l * 16 * 512 * 1024, (bf16_t*)((char*)wb + WB_ED), 512, 1024, 1024, 16, bid, nb, smem);
}

__device__ __forceinline__ const float* xrow_c(const KP& p, int r) { return (r < LC) ? (WSP(float, OFF_XC) + (size_t)r * D) : (p.out() + (size_t)(r - LC) * D); }
__device__ __forceinline__ float* xrow(const KP& p, int r) { return (r < LC) ? (WSP(float, OFF_XC) + (size_t)r * D) : (p.out() + (size_t)(r - LC) * D); }
__device__ __forceinline__ void st_modulate(const KP& p, int l, int bid, int nb) {
    const int tidx = opaque_tid();
    const int lane = tidx & 63, wid = tidx >> 6;
    bf16_t* Hb = WSP(bf16_t, OFF_H);
    const float* g = p.in(I_GPREMIX) + l * D;
    for (int r = bid * NWV + wid; r < T; r += nb * NWV) {
        const float* xr = xrow_c(p, r);
        const float* md = WSP(float, OFF_MOD) + (size_t)(l * 2 + (r < LC ? 1 : 0)) * 6144;
        float4 v[4]; float ss = 0.f;
#pragma unroll
        for (int i = 0; i < 4; ++i) { v[i] = *(const float4*)(xr + i * 256 + lane * 4); ss += v[i].x * v[i].x + v[i].y * v[i].y + v[i].z * v[i].z + v[i].w * v[i].w; }
        ss = wave_sum(ss);
        const float rstd = rsqrtf(ss * (1.0f / D) + EPS);
#pragma unroll
        for (int i = 0; i < 4; ++i) {
            const int c = i * 256 + lane * 4;
            const float4 gg = *(const float4*)(g + c), sh = *(const float4*)(md + c), sc = *(const float4*)(md + 1024 + c);
            const float h0 = v[i].x * rstd * gg.x * (1.f + sc.x) + sh.x, h1 = v[i].y * rstd * gg.y * (1.f + sc.y) + sh.y;
            const float h2 = v[i].z * rstd * gg.z * (1.f + sc.z) + sh.z, h3 = v[i].w * rstd * gg.w * (1.f + sc.w) + sh.w;
            uint2 o; o.x = pack2(h0, h1); o.y = pack2(h2, h3);
            *(uint2*)(Hb + (size_t)r * D + c) = o;
        }
    }
}

__device__ __forceinline__ void st_gemm_in(const KP& p, int bid, int nb, char* lds) {
    const int tidx = opaque_tid();
    const bf16_t* Hb = WSP(bf16_t, OFF_H); const bf16_t* Wt = WSP(bf16_t, OFF_WB + WB_IN); bf16_t* P = WSP(bf16_t, OFF_P);
    int mt, nt;
    for (int it = 0; dense_tile(it, NINP / 128, true, bid, nb, mt, nt); ++it) {
        f32x16 acc[2][2]; acc_zero(acc);
        gemm_core(acc, [&](int r) { return Hb + (size_t)(mt * 256 + r) * 1024; }, [&](int r) { return Wt + (size_t)(nt * 128 + r) * 1024; }, 1024, lds);
        acc_visit(acc, [&](int ml, int nl, f32x4 v) {
            const int n = nt * 128 + nl;
            if (n < NIN) *(uint2*)(P + (size_t)(mt * 256 + ml) * NIN + n) = pack4(v); });
    }
}

__device__ __forceinline__ void rope_pair(float& a, float& b, int pos, int i, int half) {
    const float freq = powf(10000.0f, -(float)i / (float)half);
    const float ang = (float)pos * freq;
    float sn, cs; sincosf(ang, &sn, &cs);
    const float na = a * cs - b * sn, nb_ = a * sn + b * cs; a = na; b = nb_;
}

__device__ __forceinline__ void st_postproj(const KP& p, int l, int bid, int nb) {
    const int tidx = opaque_tid();
    const int lane = tidx & 63, wid = tidx >> 6;
    bf16_t* P = WSP(bf16_t, OFF_P);
    const float* gcq = p.in(I_GCQ) + l * 256; const float* gckv = p.in(I_GCKV) + l * 128;
    for (int r = bid * NWV + wid; r < T; r += nb * NWV) {
        bf16_t* pr = P + (size_t)r * NIN;
        {
            uint2 raw = *(const uint2*)(pr + C_CQ + lane * 4);
            float a0 = bflo(raw.x), a1 = bfhi(raw.x), a2 = bflo(raw.y), a3 = bfhi(raw.y);
            float ss = wave_sum(a0 * a0 + a1 * a1 + a2 * a2 + a3 * a3);
            const float rstd = rsqrtf(ss * (1.0f / 256.0f) + EPS);
            const float4 gg = *(const float4*)(gcq + lane * 4);
            uint2 o; o.x = pack2(a0 * rstd * gg.x, a1 * rstd * gg.y); o.y = pack2(a2 * rstd * gg.z, a3 * rstd * gg.w);
            *(uint2*)(pr + C_CQ + lane * 4) = o; }
        {
            unsigned raw = *(const unsigned*)(pr + C_CKV + lane * 2);
            float a0 = bflo(raw), a1 = bfhi(raw);
            float ss = wave_sum(a0 * a0 + a1 * a1);
            const float rstd = rsqrtf(ss * (1.0f / 128.0f) + EPS);
            *(unsigned*)(pr + C_CKV + lane * 2) = pack2(a0 * rstd * gckv[lane * 2], a1 * rstd * gckv[lane * 2 + 1]); }
        if (r >= LC && lane < 16) {
            const int t = r - LC, i = lane & 7, base = (lane < 8) ? 0 : 16, pos = (lane < 8) ? (t >> 6) : (t & 63);
            float a = bf2f(pr[C_KR + base + i]), b = bf2f(pr[C_KR + base + 8 + i]);
            rope_pair(a, b, pos, i, 8);
            pr[C_KR + base + i] = f2bf(a); pr[C_KR + base + 8 + i] = f2bf(b); }
    }
    const float* gqn = p.in(I_GQN) + l * 64; const float* gkn = p.in(I_GKN) + l * 64;
    for (long idx = (long)bid * NTH + tidx; idx < (long)T * 10; idx += (long)nb * NTH) {
        const int r = (int)(idx / 10), h = (int)(idx % 10);
        bf16_t* ptr = P + (size_t)r * NIN + (h < 8 ? C_GQ + h * 64 : C_GK + (h - 8) * 64);
        const float* gg = (h < 8) ? gqn : gkn;
        float v[64]; float ss = 0.f;
#pragma unroll
        for (int i = 0; i < 8; ++i) { const uint4 raw = ((const uint4*)ptr)[i];
            v[8 * i + 0] = bflo(raw.x); v[8 * i + 1] = bfhi(raw.x); v[8 * i + 2] = bflo(raw.y); v[8 * i + 3] = bfhi(raw.y);
            v[8 * i + 4] = bflo(raw.z); v[8 * i + 5] = bfhi(raw.z); v[8 * i + 6] = bflo(raw.w); v[8 * i + 7] = bfhi(raw.w); }
#pragma unroll
        for (int i = 0; i < 64; ++i) ss += v[i] * v[i];
        const float rstd = rsqrtf(ss * (1.0f / 64.0f) + EPS);
#pragma unroll
        for (int i = 0; i < 64; ++i) v[i] = v[i] * rstd * gg[i];
        if (r >= LC) { const int t = r - LC, prow = t >> 6, pcol = t & 63;
#pragma unroll
            for (int i = 0; i < 16; ++i) { rope_pair(v[i], v[16 + i], prow, i, 16); rope_pair(v[32 + i], v[48 + i], pcol, i, 16); } }
#pragma unroll
        for (int i = 0; i < 8; ++i) { uint4 o; o.x = pack2(v[8 * i], v[8 * i + 1]); o.y = pack2(v[8 * i + 2], v[8 * i + 3]); o.z = pack2(v[8 * i + 4], v[8 * i + 5]); o.w = pack2(v[8 * i + 6], v[8 * i + 7]);
            ((uint4*)ptr)[i] = o; }
    }
}

__device__ __forceinline__ void st_s5_scan(const KP& p, int l, int bid, int nb) {
    const int tidx = opaque_tid();
    const int lane = tidx & 63, wid = tidx >> 6;
    const bf16_t* P = WSP(bf16_t, OFF_P);
    for (int gw = bid * NWV + wid; gw < 64; gw += nb * NWV) {
        const int dir = gw >> 5, g = gw & 31;
        float* Yo = dir == 0 ? WSP(float, OFF_OM) : WSP(float, OFF_H);
        const int gi = (l * 2 + dir) * 32 + g, pi = gi * 64 + lane;
        const float are = p.in(I_ARE)[pi], aim = p.in(I_AIM)[pi], dt = expf(p.in(I_LOGDT)[gi]);
        const float mag = expf(are * dt); float sn, cs; sincosf(aim * dt, &sn, &cs);
        const float lr = mag * cs, li = mag * sn, den = are * are + aim * aim;
        const float cr = ((lr - 1.0f) * are + li * aim) / den, ci = (li * are - (lr - 1.0f) * aim) / den;
        float bbr[16], bbi[16], cre[16], cim[16];
#pragma unroll
        for (int c = 0; c < 16; ++c) { const float br = p.in(I_BRE)[(size_t)pi * 16 + c], bi = p.in(I_BIM)[(size_t)pi * 16 + c];
            bbr[c] = cr * br - ci * bi; bbi[c] = cr * bi + ci * br;
            cre[c] = p.in(I_CRE)[((size_t)gi * 16 + c) * 64 + lane]; cim[c] = p.in(I_CIM)[((size_t)gi * 16 + c) * 64 + lane]; }
        const float dsk = p.in(I_SSMD)[l * 512 + g * 16 + (lane & 15)];
        float sr = 0.f, si = 0.f;
        for (int j0 = 0; j0 < T; j0 += 8) {
            uint4 ua[8], ub[8];
#pragma unroll
            for (int q = 0; q < 8; ++q) { const int j = j0 + q; const int r = dir == 0 ? j : (j < LC ? LC - 1 - j : T + LC - 1 - j);
                const uint4* up = (const uint4*)(P + (size_t)r * NIN + C_SSM + g * 16); ua[q] = up[0]; ub[q] = up[1]; }
#pragma unroll
            for (int q = 0; q < 8; ++q) { const int j = j0 + q; const int r = dir == 0 ? j : (j < LC ? LC - 1 - j : T + LC - 1 - j);
                float u[16];
                u[0] = bflo(ua[q].x); u[1] = bfhi(ua[q].x); u[2] = bflo(ua[q].y); u[3] = bfhi(ua[q].y); u[4] = bflo(ua[q].z); u[5] = bfhi(ua[q].z); u[6] = bflo(ua[q].w); u[7] = bfhi(ua[q].w);
                u[8] = bflo(ub[q].x); u[9] = bfhi(ub[q].x); u[10] = bflo(ub[q].y); u[11] = bfhi(ub[q].y); u[12] = bflo(ub[q].z); u[13] = bfhi(ub[q].z); u[14] = bflo(ub[q].w); u[15] = bfhi(ub[q].w);
                float bur = 0.f, bui = 0.f;
#pragma unroll
                for (int c = 0; c < 16; ++c) { bur = fmaf(bbr[c], u[c], bur); bui = fmaf(bbi[c], u[c], bui); }
                const float nsr = lr * sr - li * si + bur, nsi = lr * si + li * sr + bui; sr = nsr; si = nsi;
                float t16[16];
#pragma unroll
                for (int c = 0; c < 16; ++c) t16[c] = cre[c] * sr - cim[c] * si;
                float y = transpose_reduce16(t16, lane);
                if (lane < 16) {
                    if (dir == 0) y += dsk * bf2f(P[(size_t)r * NIN + C_SSM + g * 16 + lane]);
                    Yo[(size_t)r * 512 + g * 16 + lane] = y; }
            }
        }
    }
}
__device__ __forceinline__ void st_s5_fin(const KP& p, int bid, int nb) {
    const int tidx = opaque_tid();
    const float* Yf = WSP(float, OFF_OM); const float* Yb = WSP(float, OFF_H); bf16_t* P = WSP(bf16_t, OFF_P);
    for (long idx = (long)bid * NTH + tidx; idx < (long)T * 512; idx += (long)nb * NTH) {
        const int r = (int)(idx >> 9), c = (int)(idx & 511);
        P[(size_t)r * NIN + C_SSM + c] = f2bf(gelu_tanh(Yf[idx] + Yb[idx]));
    }
}

__device__ __forceinline__ void st_proj2(const KP& p, int l, int bid, int nb, char* lds) {
    const int tidx = opaque_tid();
    bf16_t* P = WSP(bf16_t, OFF_P);
    const bf16_t* Wuq = WSP(bf16_t, OFF_WB + WB_UQ); bf16_t* Qm = WSP(bf16_t, OFF_H);
    const bf16_t* Wukv = WSP(bf16_t, OFF_WB + WB_UKV); bf16_t* Kn = WSP(bf16_t, OFF_KN); bf16_t* Vm = WSP(bf16_t, OFF_V);
    const bf16_t* Wglu = WSP(bf16_t, OFF_WB + WB_GLU); bf16_t* Os = WSP(bf16_t, OFF_OS); const float* bg = p.in(I_BGLU) + l * 512;
    int mt, ntv;
    for (int it = 0; dense_tile(it, 6 + 8 + 4, true, bid, nb, mt, ntv); ++it) {
        const int which = ntv < 6 ? 0 : (ntv < 14 ? 1 : 2), nt = ntv - (which == 0 ? 0 : (which == 1 ? 6 : 14));
        const int K = which == 0 ? 256 : (which == 1 ? 128 : 512);
        const bf16_t* abase = P + (size_t)mt * 256 * NIN + (which == 0 ? C_CQ : (which == 1 ? C_CKV : C_SSM));
        const bf16_t* wbase = (which == 0 ? Wuq : (which == 1 ? Wukv : Wglu)) + (size_t)nt * 128 * K;
        f32x16 acc[2][2]; acc_zero(acc);
        gemm_core(acc, [&](int r) { return abase + (size_t)r * NIN; }, [&](int r) { return wbase + (size_t)r * K; }, K, lds);
        if (which == 0) {
            acc_visit(acc, [&](int ml, int nl, f32x4 v) { *(uint2*)(Qm + (size_t)(mt * 256 + ml) * 768 + nt * 128 + nl) = pack4(v); });
        } else if (which == 1) {
            acc_visit(acc, [&](int ml, int nl, f32x4 v) {
                bf16_t* dst = (nl < 64) ? (Kn + (size_t)(mt * 256 + ml) * 512 + nt * 64 + nl) : (Vm + (size_t)(mt * 256 + ml) * 512 + nt * 64 + nl - 64);
                *(uint2*)dst = pack4(v); });
        } else {
            acc_visit(acc, [&](int ml, int nl, f32x4 v) {
                const int n = nt * 128 + nl;
                const uint2 yr = *(const uint2*)(P + (size_t)(mt * 256 + ml) * NIN + C_SSM + n); const float4 b4 = *(const float4*)(bg + n);
                uint2 o; o.x = pack2(bflo(yr.x) * sigmoidf_(v[0] + b4.x), bfhi(yr.x) * sigmoidf_(v[1] + b4.y));
                o.y = pack2(bflo(yr.y) * sigmoidf_(v[2] + b4.z), bfhi(yr.y) * sigmoidf_(v[3] + b4.w));
                *(uint2*)(Os + (size_t)(mt * 256 + ml) * 512 + n) = o; });
        }
    }
}
__device__ __forceinline__ void st_ropeq(const KP& p, int bid, int nb) {
    const int tidx = opaque_tid();
    bf16_t* Qm = WSP(bf16_t, OFF_H);
    for (long idx = (long)bid * NTH + tidx; idx < (long)S * 8 * 16; idx += (long)nb * NTH) {
        const int pr = (int)(idx & 15), h = (int)((idx >> 4) & 7), t = (int)(idx >> 7);
        const int i = pr & 7, base = (pr < 8) ? 0 : 16, pos = (pr < 8) ? (t >> 6) : (t & 63);
        bf16_t* q = Qm + (size_t)(t + LC) * 768 + h * 96 + 64;
        float a = bf2f(q[base + i]), b = bf2f(q[base + 8 + i]);
        rope_pair(a, b, pos, i, 8);
        q[base + i] = f2bf(a); q[base + 8 + i] = f2bf(b);
    }
}

typedef short s16x4 __attribute__((ext_vector_type(4)));
typedef short v4i16_t __attribute__((ext_vector_type(4)));
typedef __attribute__((address_space(3))) const char* lds_cptr;
__device__ __forceinline__ s16x4 vtr(lds_cptr q) { return __builtin_bit_cast(s16x4, __builtin_amdgcn_ds_read_tr16_b64_v4i16((__attribute__((address_space(3))) v4i16_t*)q)); }
__device__ __forceinline__ unsigned cvtpk(float lo, float hi) { return pack2(lo, hi); }
__device__ __forceinline__ float xhalf_max(float m) { auto rr = __builtin_amdgcn_permlane32_swap(__float_as_uint(m), __float_as_uint(m), false, false); return fmaxf(__uint_as_float(rr[0]), __uint_as_float(rr[1])); }
__device__ __forceinline__ float xhalf_sum(float m) { auto rr = __builtin_amdgcn_permlane32_swap(__float_as_uint(m), __float_as_uint(m), false, false); return __uint_as_float(rr[0]) + __uint_as_float(rr[1]); }
constexpr int AT_K = 0, AT_V = 8192, AT_KR = 16384, AT_BUF = 20480;

template <int DQK>
__device__ __forceinline__ void attn_item(const bf16_t* Q, int qpitch, const bf16_t* KA, int kapitch, const bf16_t* KB, int kbpitch,
                                          const bf16_t* V, int vpitch, int ntiles, float C, bf16_t* O, char* lds) {
    const int tid = opaque_tid(), lane = tid & 63, wid = tid >> 6, r32 = lane & 31, hi = lane >> 5;
    constexpr int ND0 = DQK / 16;
    bf16x8 qr[ND0];
    { const bf16_t* qp = Q + (size_t)(wid * 32 + r32) * qpitch + hi * 8;
#pragma unroll
      for (int d0 = 0; d0 < ND0; ++d0) qr[d0] = *(const bf16x8*)(qp + d0 * 16); }
    const int srow = tid >> 3, sch = tid & 7;
    const bf16_t* gk = KA + (size_t)srow * kapitch + sch * 8;
    const bf16_t* gv = V + (size_t)srow * vpitch + sch * 8;
    const bf16_t* gr = (DQK > 64) ? (KB + (size_t)(tid >> 2) * kbpitch + (tid & 3) * 8) : nullptr;
    const int sk_off = AT_K + srow * 128 + ((sch ^ ((srow >> 1) & 7)) << 4);
    const int sv_off = AT_V + (sch >> 2) * 4096 + srow * 64 + (sch & 3) * 16;
    const int sr_off = AT_KR + (tid >> 2) * 64 + (((tid & 3) ^ (((tid >> 2) >> 2) & 3)) << 4);
    const bool do_r = (DQK > 64) && (tid < 256);
    const int kf_off = AT_K + r32 * 128, ksw = (r32 >> 1) & 7;
    const int rf_off = AT_KR + r32 * 64, rsw = (r32 >> 2) & 3;
    const int vf_off = AT_V + (4 * hi + ((lane & 15) >> 2)) * 64 + ((lane >> 4) & 1) * 32 + (lane & 3) * 8;
    uint4 rk, rv, rr; rr = make_uint4(0, 0, 0, 0);
    rk = *(const uint4*)gk; rv = *(const uint4*)gv; if (do_r) rr = *(const uint4*)gr;
    *(uint4*)(lds + sk_off) = rk; *(uint4*)(lds + sv_off) = rv; if (do_r) *(uint4*)(lds + sr_off) = rr;
    __syncthreads();
    f32x16 o0, o1;
#pragma unroll
    for (int r = 0; r < 16; ++r) { o0[r] = 0.f; o1[r] = 0.f; }
    float mrun = -INFINITY, lrun = 0.f;
    for (int t = 0; t < ntiles; ++t) {
        const char* cur = lds + (t & 1) * AT_BUF; char* nxt = lds + ((t + 1) & 1) * AT_BUF;
        const bool more = (t + 1 < ntiles);
        if (more) { rk = *(const uint4*)(gk + (size_t)(t + 1) * 64 * kapitch); rv = *(const uint4*)(gv + (size_t)(t + 1) * 64 * vpitch); if (do_r) rr = *(const uint4*)(gr + (size_t)(t + 1) * 64 * kbpitch); }
        f32x16 p0, p1;
#pragma unroll
        for (int r = 0; r < 16; ++r) { p0[r] = 0.f; p1[r] = 0.f; }
#pragma unroll
        for (int d0 = 0; d0 < 4; ++d0) {
            const int co = ((2 * d0 + hi) ^ ksw) << 4;
            const bf16x8 k0 = *(const bf16x8*)(cur + kf_off + co), k1 = *(const bf16x8*)(cur + kf_off + 32 * 128 + co);
            p0 = MFMA32(k0, qr[d0], p0); p1 = MFMA32(k1, qr[d0], p1);
        }
        if (DQK > 64) {
#pragma unroll
            for (int d0 = 4; d0 < ND0; ++d0) {
                const int co = ((2 * (d0 - 4) + hi) ^ rsw) << 4;
                const bf16x8 k0 = *(const bf16x8*)(cur + rf_off + co), k1 = *(const bf16x8*)(cur + rf_off + 32 * 64 + co);
                p0 = MFMA32(k0, qr[d0], p0); p1 = MFMA32(k1, qr[d0], p1);
            }
        }
        float mx = fmaxf(p0[0], p1[0]);
#pragma unroll
        for (int r = 1; r < 16; ++r) mx = fmaxf(mx, fmaxf(p0[r], p1[r]));
        mx = xhalf_max(mx) * C;
        const float mnew = fmaxf(mrun, mx);
        if (__any(mnew > mrun)) {
            const float alpha = __builtin_amdgcn_exp2f(mrun - mnew);
            lrun *= alpha;
#pragma unroll
            for (int r = 0; r < 16; ++r) { o0[r] *= alpha; o1[r] *= alpha; }
            mrun = mnew;
        }
        const float nm = -mrun;
        float ls = 0.f;
#pragma unroll
        for (int r = 0; r < 16; ++r) { p0[r] = __builtin_amdgcn_exp2f(fmaf(p0[r], C, nm)); p1[r] = __builtin_amdgcn_exp2f(fmaf(p1[r], C, nm)); ls += p0[r] + p1[r]; }
        lrun += ls;
#pragma unroll
        for (int s = 0; s < 4; ++s) {
            bf16x8 pf;
            {   unsigned w0, w1, w2, w3;
                if (s < 2) { w0 = cvtpk(p0[8 * s], p0[8 * s + 1]); w1 = cvtpk(p0[8 * s + 2], p0[8 * s + 3]); w2 = cvtpk(p0[8 * s + 4], p0[8 * s + 5]); w3 = cvtpk(p0[8 * s + 6], p0[8 * s + 7]); }
                else { const int s2 = s - 2; w0 = cvtpk(p1[8 * s2], p1[8 * s2 + 1]); w1 = cvtpk(p1[8 * s2 + 2], p1[8 * s2 + 3]); w2 = cvtpk(p1[8 * s2 + 4], p1[8 * s2 + 5]); w3 = cvtpk(p1[8 * s2 + 6], p1[8 * s2 + 7]); }
                uint4 u = make_uint4(w0, w1, w2, w3); pf = __builtin_bit_cast(bf16x8, u); }
            const lds_cptr vb = (lds_cptr)cur + vf_off + s * 1024;
            const s16x4 a0 = vtr(vb), a1 = vtr(vb + 512), b0 = vtr(vb + 4096), b1 = vtr(vb + 4096 + 512);
            const bf16x8 v0 = (bf16x8){a0[0], a0[1], a0[2], a0[3], a1[0], a1[1], a1[2], a1[3]};
            const bf16x8 v1 = (bf16x8){b0[0], b0[1], b0[2], b0[3], b1[0], b1[1], b1[2], b1[3]};
            o0 = MFMA32(v0, pf, o0); o1 = MFMA32(v1, pf, o1);
        }
        if (more) { *(uint4*)(nxt + sk_off) = rk; *(uint4*)(nxt + sv_off) = rv; if (do_r) *(uint4*)(nxt + sr_off) = rr; }
        __syncthreads();
    }
    const float inv = 1.0f / xhalf_sum(lrun);
    bf16_t* op = O + (size_t)(wid * 32 + r32) * 512 + 4 * hi;
#pragma unroll
    for (int rg = 0; rg < 4; ++rg) {
        uint2 a; a.x = pack2(o0[4 * rg] * inv, o0[4 * rg + 1] * inv); a.y = pack2(o0[4 * rg + 2] * inv, o0[4 * rg + 3] * inv);
        uint2 b; b.x = pack2(o1[4 * rg] * inv, o1[4 * rg + 1] * inv); b.y = pack2(o1[4 * rg + 2] * inv, o1[4 * rg + 3] * inv);
        *(uint2*)(op + 8 * rg) = a; *(uint2*)(op + 32 + 8 * rg) = b;
    }
}
__device__ __forceinline__ void attn_dispatch(const KP& p, int ty, int h, int qt, char* lds) {
    const bf16_t* P = WSP(bf16_t, OFF_P); const bf16_t* Qm = WSP(bf16_t, OFF_H); const bf16_t* Kn = WSP(bf16_t, OFF_KN); const bf16_t* Vm = WSP(bf16_t, OFF_V);
    const int ntiles = (qt == 0) ? (LC / 64) : (T / 64);
    const size_t r0 = (size_t)qt * 256;
    if (ty == 0)
        attn_item<96>(Qm + r0 * 768 + h * 96, 768, Kn + h * 64, 512, P + C_KR, NIN, Vm + h * 64, 512, ntiles, 0.10206207261596575f * LOG2E, WSP(bf16_t, OFF_OM) + r0 * 512 + h * 64, lds);
    else
        attn_item<64>(P + r0 * NIN + C_GQ + h * 64, NIN, P + C_GK + (h >> 2) * 64, NIN, nullptr, 0, P + C_GV + (h >> 2) * 64, NIN, ntiles, 0.125f * LOG2E, WSP(bf16_t, OFF_OG) + r0 * 512 + h * 64, lds);
}
__device__ __forceinline__ void st_attn(const KP& p, int bid, int nb, char* lds) {
    for (int ty = 0; ty < 2; ++ty)
        for (int u = bid; u < 512; u += nb) attn_dispatch(p, ty, u & 7, 1 + (u >> 3), lds);
    for (int u = bid; u < 16; u += nb) attn_dispatch(p, u >> 3, u & 7, 0, lds);
}

__device__ __forceinline__ void st_merge(const KP& p, int bid, int nb, char* lds) {
    const int tidx = opaque_tid();
    const bf16_t* P = WSP(bf16_t, OFF_P); bf16_t* Mb = WSP(bf16_t, OFF_H);
    const bf16_t* Wb = WSP(bf16_t, OFF_WB + WB_BR);
    int mt, nt;
    for (int it = 0; dense_tile(it, 8, true, bid, nb, mt, nt); ++it) {
        f32x16 tot[2][2]; acc_zero(tot);
#pragma unroll 1
        for (int b = 0; b < 3; ++b) {
            const bf16_t* Ob = WSP(bf16_t, b == 0 ? OFF_OM : (b == 1 ? OFF_OS : OFF_OG));
            f32x16 acc[2][2]; acc_zero(acc);
            gemm_core(acc, [&](int r) { return Ob + (size_t)(mt * 256 + r) * 512; }, [&](int r) { return Wb + ((size_t)b * 1024 + nt * 128 + r) * 512; }, 512, lds);
            acc_visit_add(acc, tot, [&](int ml, int nl, f32x4 v) {
                const uint2 gr = *(const uint2*)(P + (size_t)(mt * 256 + ml) * NIN + C_GATE + b * 1024 + nt * 128 + nl);
                f32x4 r; r[0] = sigmoidf_(bflo(gr.x)) * v[0]; r[1] = sigmoidf_(bfhi(gr.x)) * v[1]; r[2] = sigmoidf_(bflo(gr.y)) * v[2]; r[3] = sigmoidf_(bfhi(gr.y)) * v[3];
                return r; });
        }
        acc_visit(tot, [&](int ml, int nl, f32x4 v) { *(uint2*)(Mb + (size_t)(mt * 256 + ml) * 1024 + nt * 128 + nl) = pack4(v); });
    }
}
__device__ __forceinline__ void st_wout(const KP& p, int bid, int nb, char* lds) {
    const int tidx = opaque_tid();
    const bf16_t* Mb = WSP(bf16_t, OFF_H); const bf16_t* Wt = WSP(bf16_t, OFF_WB + WB_OUT); float* Y = WSP(float, OFF_Y);
    int mt, nt;
    for (int it = 0; dense_tile(it, 8, true, bid, nb, mt, nt); ++it) {
        f32x16 acc[2][2]; acc_zero(acc);
        gemm_core(acc, [&](int r) { return Mb + (size_t)(mt * 256 + r) * 1024; }, [&](int r) { return Wt + (size_t)(nt * 128 + r) * 1024; }, 1024, lds);
        acc_visit(acc, [&](int ml, int nl, f32x4 v) { *(f32x4*)(Y + (size_t)(mt * 256 + ml) * 1024 + nt * 128 + nl) = v; });
    }
    int* sltok = WSP(int, OFF_SLTOK); float* slw = WSP(float, OFF_SLW); int* cnt = WSP(int, OFF_CNT);
    for (int i = bid * NTH + tidx; i < TP; i += nb * NTH) { sltok[i] = 0; slw[i] = 0.f; }
    if (bid == 0 && tidx < 32) cnt[tidx] = 0;
}

__device__ __forceinline__ void st_postmix(const KP& p, int l, int bid, int nb) {
    const int tidx = opaque_tid();
    const int lane = tidx & 63, wid = tidx >> 6;
    const float* Y = WSP(float, OFF_Y); bf16_t* H2 = WSP(bf16_t, OFF_H);
    const float* gpost = p.in(I_GPOSTMIX) + l * D; const float* gpre = p.in(I_GPREFFN) + l * D;
    const float* wg = p.in(I_WGROUP) + (size_t)l * D * 4; const float* wr = p.in(I_WROUTER) + (size_t)l * D * 16;
    int* toke = WSP(int, OFF_TOKE); float* tokw = WSP(float, OFF_TOKW); int* cnt = WSP(int, OFF_CNT);
    for (int r = bid * NWV + wid; r < T; r += nb * NWV) {
        float* xr = xrow(p, r);
        const float* md = WSP(float, OFF_MOD) + (size_t)(l * 2 + (r < LC ? 1 : 0)) * 6144;
        float4 y[4], x[4]; float ss = 0.f;
#pragma unroll
        for (int i = 0; i < 4; ++i) { y[i] = *(const float4*)(Y + (size_t)r * D + i * 256 + lane * 4); ss += y[i].x * y[i].x + y[i].y * y[i].y + y[i].z * y[i].z + y[i].w * y[i].w; }
        ss = wave_sum(ss);
        const float rstd = rsqrtf(ss * (1.0f / D) + EPS);
        float ss2 = 0.f;
#pragma unroll
        for (int i = 0; i < 4; ++i) { const int c = i * 256 + lane * 4;
            const float4 gg = *(const float4*)(gpost + c), ga = *(const float4*)(md + 2048 + c); x[i] = *(const float4*)(xr + c);
            x[i].x += ga.x * y[i].x * rstd * gg.x; x[i].y += ga.y * y[i].y * rstd * gg.y; x[i].z += ga.z * y[i].z * rstd * gg.z; x[i].w += ga.w * y[i].w * rstd * gg.w;
            *(float4*)(xr + c) = x[i];
            ss2 += x[i].x * x[i].x + x[i].y * x[i].y + x[i].z * x[i].z + x[i].w * x[i].w; }
        ss2 = wave_sum(ss2);
        const float rstd2 = rsqrtf(ss2 * (1.0f / D) + EPS);
        float lg[4] = {0.f, 0.f, 0.f, 0.f}, le[16];
#pragma unroll
        for (int e = 0; e < 16; ++e) le[e] = 0.f;
#pragma unroll
        for (int i = 0; i < 4; ++i) { const int c = i * 256 + lane * 4;
            const float4 gg = *(const float4*)(gpre + c), sh = *(const float4*)(md + 3072 + c), sc = *(const float4*)(md + 4096 + c);
            float h[4];
            h[0] = x[i].x * rstd2 * gg.x * (1.f + sc.x) + sh.x; h[1] = x[i].y * rstd2 * gg.y * (1.f + sc.y) + sh.y;
            h[2] = x[i].z * rstd2 * gg.z * (1.f + sc.z) + sh.z; h[3] = x[i].w * rstd2 * gg.w * (1.f + sc.w) + sh.w;
            uint2 o; o.x = pack2(h[0], h[1]); o.y = pack2(h[2], h[3]);
            *(uint2*)(H2 + (size_t)r * D + c) = o;
#pragma unroll
            for (int q = 0; q < 4; ++q) {
                const float4 w4 = *(const float4*)(wg + (size_t)(c + q) * 4);
                lg[0] = fmaf(h[q], w4.x, lg[0]); lg[1] = fmaf(h[q], w4.y, lg[1]); lg[2] = fmaf(h[q], w4.z, lg[2]); lg[3] = fmaf(h[q], w4.w, lg[3]);
#pragma unroll
                for (int e4 = 0; e4 < 4; ++e4) { const float4 r4 = *(const float4*)(wr + (size_t)(c + q) * 16 + e4 * 4);
                    le[e4 * 4 + 0] = fmaf(h[q], r4.x, le[e4 * 4 + 0]); le[e4 * 4 + 1] = fmaf(h[q], r4.y, le[e4 * 4 + 1]); le[e4 * 4 + 2] = fmaf(h[q], r4.z, le[e4 * 4 + 2]); le[e4 * 4 + 3] = fmaf(h[q], r4.w, le[e4 * 4 + 3]); }
            } }
#pragma unroll
        for (int g = 0; g < 4; ++g) lg[g] = wave_sum(lg[g]) + p.in(I_BGROUP)[l * 4 + g];
        const float myle = transpose_reduce16(le, lane) + p.in(I_BROUTER)[l * 16 + (lane & 15)];
        int gs = 0; float gm = lg[0];
#pragma unroll
        for (int g = 1; g < 4; ++g) if (lg[g] > gm) { gm = lg[g]; gs = g; }
        float ls[4];
#pragma unroll
        for (int i = 0; i < 4; ++i) ls[i] = __shfl(myle, gs * 4 + i);
        if (lane == 0) {
            float den = 0.f;
#pragma unroll
            for (int g = 0; g < 4; ++g) den += __expf(lg[g] - gm);
            const float pg = 1.0f / den;
            int i0 = 0; float m0 = ls[0];
#pragma unroll
            for (int i = 1; i < 4; ++i) if (ls[i] > m0) { m0 = ls[i]; i0 = i; }
            int i1 = -1; float m1 = -INFINITY;
#pragma unroll
            for (int i = 0; i < 4; ++i) if (i != i0 && ls[i] > m1) { m1 = ls[i]; i1 = i; }
            const float e1 = __expf(m1 - m0), w0 = pg / (1.f + e1), w1 = pg * e1 / (1.f + e1);
            const int ex0 = gs * 4 + i0, ex1 = gs * 4 + i1;
            toke[r * 2] = ex0; toke[r * 2 + 1] = ex1; tokw[r * 2] = w0; tokw[r * 2 + 1] = w1;
            atomicAdd(&cnt[ex0], 1); atomicAdd(&cnt[ex1], 1);
        }
    }
}

__device__ __forceinline__ void moe_offsets(const int* cnt, int* off) {
    int a = 0;
#pragma unroll
    for (int e = 0; e < 16; ++e) { off[e] = a; a += (cnt[e] + 255) & ~255; }
    off[16] = a;
}
__device__ __forceinline__ int moe_expert_of(const int* off, int j) {
    int e = 0;
#pragma unroll
    for (int k = 1; k < 16; ++k) e += (j >= off[k]) ? 1 : 0;
    return e;
}
__device__ __forceinline__ void st_moe_build(const KP& p, int bid, int nb) {
    const int tidx = opaque_tid();
    int* cnt = WSP(int, OFF_CNT); int* cnt2 = cnt + 16;
    const int* toke = WSP(int, OFF_TOKE); const float* tokw = WSP(float, OFF_TOKW); int* toks = WSP(int, OFF_TOKS);
    int* sltok = WSP(int, OFF_SLTOK); float* slw = WSP(float, OFF_SLW);
    int off[17]; moe_offsets(cnt, off);
    for (int idx = bid * NTH + tidx; idx < T * 2; idx += nb * NTH) {
        const int e = toke[idx];
        int o = 0;
#pragma unroll
        for (int k = 0; k < 16; ++k) o = (e == k) ? off[k] : o;
        const int pos = o + atomicAdd(&cnt2[e], 1);
        sltok[pos] = idx >> 1; slw[pos] = tokw[idx]; toks[idx] = pos;
    }
}
__device__ __forceinline__ void st_moe_up(const KP& p, int bid, int nb, char* lds) {
    const int tidx = opaque_tid();
    const int* cnt = WSP(int, OFF_CNT); const int* sltok = WSP(int, OFF_SLTOK);
    const bf16_t* H2 = WSP(bf16_t, OFF_H); const bf16_t* Wg = WSP(bf16_t, OFF_WB + WB_EG); const bf16_t* Wu = WSP(bf16_t, OFF_WB + WB_EU); bf16_t* Hid = WSP(bf16_t, OFF_HID);
    int off[17]; moe_offsets(cnt, off);
    const int ntiles = (off[16] >> 8) * 8;
    for (int L = bid; L < ntiles; L += nb) {
        const int mt = L >> 3, nt = L & 7, e = moe_expert_of(off, mt * 256);
        f32x16 acc[2][2]; acc_zero(acc);
        gemm_core(acc, [&](int r) { return H2 + (size_t)sltok[mt * 256 + r] * 1024; },
                  [&](int r) { const int wn = r >> 6, in = (r >> 5) & 1, j = r & 31; return (in ? Wu : Wg) + ((size_t)e * 512 + nt * 64 + wn * 32 + j) * 1024; }, 1024, lds);
        const int lane = tidx & 63, wid = tidx >> 6, wm = wid >> 1, wn = wid & 1, r32 = lane & 31, hi = lane >> 5;
#pragma unroll
        for (int im = 0; im < 2; ++im)
#pragma unroll
            for (int rg = 0; rg < 4; ++rg) {
                const int ml = wm * 64 + im * 32 + r32, col = nt * 64 + wn * 32 + 8 * rg + 4 * hi;
                float h[4];
#pragma unroll
                for (int q = 0; q < 4; ++q) h[q] = siluf_(acc[0][im][4 * rg + q]) * acc[1][im][4 * rg + q];
                uint2 o; o.x = pack2(h[0], h[1]); o.y = pack2(h[2], h[3]);
                *(uint2*)(Hid + (size_t)(mt * 256 + ml) * 512 + col) = o;
            }
    }
}
__device__ __forceinline__ void st_moe_down(const KP& p, int bid, int nb, char* lds) {
    const int tidx = opaque_tid();
    const int* cnt = WSP(int, OFF_CNT); const float* slw = WSP(float, OFF_SLW);
    const bf16_t* Hid = WSP(bf16_t, OFF_HID); const bf16_t* Wd = WSP(bf16_t, OFF_WB + WB_ED); bf16_t* Sl = WSP(bf16_t, OFF_SLOTS);
    int off[17]; moe_offsets(cnt, off);
    const int ntiles = (off[16] >> 8) * 8;
    for (int L = bid; L < ntiles; L += nb) {
        const int mt = L >> 3, nt = L & 7, e = moe_expert_of(off, mt * 256);
        f32x16 acc[2][2]; acc_zero(acc);
        gemm_core(acc, [&](int r) { return Hid + (size_t)(mt * 256 + r) * 512; }, [&](int r) { return Wd + ((size_t)e * 1024 + nt * 128 + r) * 512; }, 512, lds);
        acc_visit(acc, [&](int ml, int nl, f32x4 v) {
            const float w = slw[mt * 256 + ml];
            *(uint2*)(Sl + (size_t)(mt * 256 + ml) * 1024 + nt * 128 + nl) = pack4(v * w); });
    }
}
__device__ __forceinline__ void st_postffn(const KP& p, int l, int bid, int nb) {
    const int tidx = opaque_tid();
    const int lane = tidx & 63, wid = tidx >> 6;
    const bf16_t* Sl = WSP(bf16_t, OFF_SLOTS); const int* toks = WSP(int, OFF_TOKS);
    const float* gpost = p.in(I_GPOSTFFN) + l * D;
    for (int r = bid * NWV + wid; r < T; r += nb * NWV) {
        float* xr = xrow(p, r);
        const float* md = WSP(float, OFF_MOD) + (size_t)(l * 2 + (r < LC ? 1 : 0)) * 6144;
        const bf16_t* s0 = Sl + (size_t)toks[r * 2] * 1024; const bf16_t* s1 = Sl + (size_t)toks[r * 2 + 1] * 1024;
        float v[16]; float ss = 0.f;
#pragma unroll
        for (int i = 0; i < 4; ++i) { const int c = i * 256 + lane * 4; const uint2 a = *(const uint2*)(s0 + c), b = *(const uint2*)(s1 + c);
            v[4 * i] = bflo(a.x) + bflo(b.x); v[4 * i + 1] = bfhi(a.x) + bfhi(b.x); v[4 * i + 2] = bflo(a.y) + bflo(b.y); v[4 * i + 3] = bfhi(a.y) + bfhi(b.y);
            ss += v[4 * i] * v[4 * i] + v[4 * i + 1] * v[4 * i + 1] + v[4 * i + 2] * v[4 * i + 2] + v[4 * i + 3] * v[4 * i + 3]; }
        ss = wave_sum(ss);
        const float rstd = rsqrtf(ss * (1.0f / D) + EPS);
#pragma unroll
        for (int i = 0; i < 4; ++i) { const int c = i * 256 + lane * 4;
            const float4 gg = *(const float4*)(gpost + c), ga = *(const float4*)(md + 5120 + c); float4 x = *(const float4*)(xr + c);
            x.x += ga.x * v[4 * i] * rstd * gg.x; x.y += ga.y * v[4 * i + 1] * rstd * gg.y; x.z += ga.z * v[4 * i + 2] * rstd * gg.z; x.w += ga.w * v[4 * i + 3] * rstd * gg.w;
            *(float4*)(xr + c) = x; }
    }
}

__device__ __forceinline__ void gsync(unsigned* bar, unsigned& epoch) {
    asm volatile("s_waitcnt vmcnt(0) lgkmcnt(0)" ::: "memory");
    __syncthreads();
    if (threadIdx.x == 0) {
        __builtin_amdgcn_fence(__ATOMIC_RELEASE, "agent");
        asm volatile("s_waitcnt vmcnt(0)" ::: "memory");
        epoch += 1;
        __hip_atomic_fetch_add(bar, 1u, __ATOMIC_RELAXED, __HIP_MEMORY_SCOPE_AGENT);
        const unsigned target = epoch * gridDim.x;
        while (__hip_atomic_load(bar, __ATOMIC_RELAXED, __HIP_MEMORY_SCOPE_AGENT) < target) __builtin_amdgcn_s_sleep(2);
        __builtin_amdgcn_fence(__ATOMIC_ACQUIRE, "agent");
        asm volatile("s_waitcnt vmcnt(0)" ::: "memory");
    }
    __syncthreads();
}

__global__ void __launch_bounds__(NTH) k_mega(Params p_unused) {
    KP p; p.k = (kparams_t)__builtin_amdgcn_kernarg_segment_ptr();
    __shared__ __attribute__((aligned(16))) char lds[LDS_BYTES]; float* smem = (float*)lds;
    cg::grid_group grid = cg::this_grid();
    grid.sync();
    const int bid = blockIdx.x, nb = gridDim.x;
    unsigned* bar = WSP(unsigned, OFF_BAR); unsigned epoch = 0;
#define GS() gsync(bar, epoch)
    st_prologue(p, bid, nb, smem); GS();
#pragma unroll 1
    for (int l = 0; l < NL; ++l) {
        st_conv(p, l, bid, nb, smem); st_modulate(p, l, bid, nb); GS();
        st_gemm_in(p, bid, nb, lds); GS();
        st_postproj(p, l, bid, nb); GS();
        st_s5_scan(p, l, bid, nb); GS();
        st_s5_fin(p, bid, nb); GS();
        st_proj2(p, l, bid, nb, lds); GS();
        st_ropeq(p, bid, nb); GS();
        st_attn(p, bid, nb, lds); GS();
        st_merge(p, bid, nb, lds); GS();
        st_wout(p, bid, nb, lds); GS();
        st_postmix(p, l, bid, nb); GS();
        st_moe_build(p, bid, nb); GS();
        st_moe_up(p, bid, nb, lds); GS();
        st_moe_down(p, bid, nb, lds); GS();
        st_postffn(p, l, bid, nb); GS();
    }
#undef GS
}

extern "C" void kernel_launch(void* const* d_in, const int* in_sizes, int n_in, void* d_out, int out_size, void* d_ws, size_t ws_size, hipStream_t stream) {
    Params p{};
    for (int i = 0; i < N_IN; ++i) p.in[i] = (const float*)d_in[i];
    p.out = (float*)d_out; p.ws = (char*)d_ws;
    if (ws_size < WS_NEED) { fprintf(stderr, "workspace too small: %zu < %zu\n", ws_size, (size_t)WS_NEED); return; }
    static int grid_blocks = 0;
    if (!grid_blocks) {
        int dev = 0, cus = 0, per_cu = 0;
        hipGetDevice(&dev);
        hipDeviceGetAttribute(&cus, hipDeviceAttributeMultiprocessorCount, dev);
        hipOccupancyMaxActiveBlocksPerMultiprocessor(&per_cu, k_mega, NTH, 0);
        if (per_cu > 1) per_cu = 1;
        if (per_cu < 1) per_cu = 1;
        grid_blocks = cus * per_cu;
    }
    hipMemsetAsync((char*)d_ws + OFF_BAR, 0, 256, stream);
    void* args[] = { &p };
    hipError_t e = hipLaunchCooperativeKernel((void*)k_mega, dim3(grid_blocks), dim3(NTH), args, 0, stream);
    if (e != hipSuccess) fprintf(stderr, "cooperative launch failed: %s (grid %d)\n", hipGetErrorString(e), grid_blocks);
}

#ifdef STAGE_TEST
template <int K> __global__ void __launch_bounds__(NTH) k_test(Params p_unused, int l) {
    KP p; p.k = (kparams_t)__builtin_amdgcn_kernarg_segment_ptr();
    __shared__ __attribute__((aligned(16))) char lds[LDS_BYTES]; float* smem = (float*)lds;
    const int bid = blockIdx.x, nb = gridDim.x;
    if (K == 0) { st_conv(p, l, bid, nb, smem); st_modulate(p, l, bid, nb); }
    if (K == 1) st_gemm_in(p, bid, nb, lds);
    if (K == 2) st_postproj(p, l, bid, nb);
    if (K == 3) st_s5_scan(p, l, bid, nb);
    if (K == 4) st_s5_fin(p, bid, nb);
    if (K == 5) st_proj2(p, l, bid, nb, lds);
    if (K == 6) st_ropeq(p, bid, nb);
    if (K == 7) st_attn(p, bid, nb, lds);
    if (K == 8) st_merge(p, bid, nb, lds);
    if (K == 9) st_wout(p, bid, nb, lds);
    if (K == 10) st_postmix(p, l, bid, nb);
    if (K == 11) st_moe_build(p, bid, nb);
    if (K == 12) st_moe_up(p, bid, nb, lds);
    if (K == 13) st_moe_down(p, bid, nb, lds);
    if (K == 14) st_postffn(p, l, bid, nb);
    if (K == 15) st_prologue(p, bid, nb, smem);
}
template __global__ void k_test<0>(Params, int); template __global__ void k_test<1>(Params, int); template __global__ void k_test<2>(Params, int);
template __global__ void k_test<3>(Params, int); template __global__ void k_test<4>(Params, int); template __global__ void k_test<5>(Params, int);
template __global__ void k_test<6>(Params, int); template __global__ void k_test<7>(Params, int); template __global__ void k_test<8>(Params, int);
template __global__ void k_test<9>(Params, int); template __global__ void k_test<10>(Params, int); template __global__ void k_test<11>(Params, int);
template __global__ void k_test<12>(Params, int); template __global__ void k_test<13>(Params, int); template __global__ void k_test<14>(Params, int);
template __global__ void k_test<15>(Params, int);
#endif
```

```cpp
#include <hip/hip_runtime.h>
#include <hip/hip_cooperative_groups.h>
#include <cstdio>
#include <cstdint>
namespace cg = cooperative_groups;


typedef unsigned short bf16_t;
typedef short bf16x8 __attribute__((ext_vector_type(8)));
typedef float f32x16 __attribute__((ext_vector_type(16)));
typedef float f32x4 __attribute__((ext_vector_type(4)));
constexpr int NTH = 512, NWV = 8;
#ifndef REP_CONV
#define REP_CONV 1
#endif
#ifndef REP_G1
#define REP_G1 1
#endif
#ifndef REP_G2
#define REP_G2 1
#endif
#ifndef REP_G3
#define REP_G3 1
#endif
#ifndef REP_S5
#define REP_S5 1
#endif
#ifndef REP_ATTN
#define REP_ATTN 1
#endif

constexpr int D = 1024, S = 16384, LC = 256, T = S + LC, NL = 2;
constexpr int NIN = 4768, NINP = 4864;
constexpr int C_CQ = 0, C_CKV = 256, C_KR = 384, C_SSM = 416, C_GQ = 928, C_GK = 1440, C_GV = 1568, C_GATE = 1696;
constexpr int TP = 2 * T + 16 * 256;
constexpr float EPS = 1e-6f;
constexpr float LOG2E = 1.4426950408889634f;

enum { I_X = 0, I_C, I_CTX, I_CCTX, I_WMOD, I_BMOD, I_GPREMIX, I_GPOSTMIX, I_GPREFFN, I_GPOSTFFN, I_WIN, I_GCQ, I_GCKV, I_WUQ, I_WUKV,
       I_GQN, I_GKN, I_ARE, I_AIM, I_LOGDT, I_BRE, I_BIM, I_CRE, I_CIM, I_SSMD, I_WGLU, I_BGLU, I_WBRM, I_WBRS, I_WBRG, I_WOUT,
       I_WGROUP, I_BGROUP, I_WROUTER, I_BROUTER, I_WEG, I_WEU, I_WED, N_IN };

constexpr size_t al256(size_t x) { return (x + 255) & ~(size_t)255; }
constexpr size_t WB_IN = 0;
constexpr size_t WB_UQ = WB_IN + (size_t)NINP * 1024 * 2;
constexpr size_t WB_UKV = WB_UQ + (size_t)768 * 256 * 2;
constexpr size_t WB_GLU = WB_UKV + (size_t)1024 * 128 * 2;
constexpr size_t WB_BR = WB_GLU + (size_t)512 * 512 * 2;
constexpr size_t WB_OUT = WB_BR + (size_t)3 * 1024 * 512 * 2;
constexpr size_t WB_EG = WB_OUT + (size_t)1024 * 1024 * 2;
constexpr size_t WB_EU = WB_EG + (size_t)16 * 512 * 1024 * 2;
constexpr size_t WB_ED = WB_EU + (size_t)16 * 512 * 1024 * 2;
constexpr size_t WB_BYTES = WB_ED + (size_t)16 * 1024 * 512 * 2;

constexpr size_t OFF_WB = 0;
constexpr size_t OFF_P = al256(OFF_WB + WB_BYTES);
constexpr size_t P_BYTES = (size_t)T * NIN * 2;
constexpr size_t OFF_Y = OFF_P;
constexpr size_t OFF_SLOTS = OFF_P;
constexpr size_t OFF_HID = OFF_P + (size_t)TP * 1024 * 2;
constexpr size_t OFF_H = al256(OFF_P + P_BYTES);
constexpr size_t OFF_KN = al256(OFF_H + (size_t)T * 1024 * 2);
constexpr size_t OFF_V = al256(OFF_KN + (size_t)T * 512 * 2);
constexpr size_t OFF_OM = al256(OFF_V + (size_t)T * 512 * 2);
constexpr size_t OFF_OG = OFF_OM + (size_t)T * 512 * 2;
constexpr size_t OFF_OS = OFF_OG + (size_t)T * 512 * 2;
constexpr size_t OFF_XC = al256(OFF_OS + (size_t)T * 512 * 2);
constexpr size_t OFF_MOD = al256(OFF_XC + (size_t)LC * 1024 * 4);
constexpr size_t OFF_TOKE = al256(OFF_MOD + (size_t)NL * 2 * 6144 * 4);
constexpr size_t OFF_TOKW = al256(OFF_TOKE + (size_t)T * 2 * 4);
constexpr size_t OFF_TOKS = al256(OFF_TOKW + (size_t)T * 2 * 4);
constexpr size_t OFF_SLTOK = al256(OFF_TOKS + (size_t)T * 2 * 4);
constexpr size_t OFF_SLW = al256(OFF_SLTOK + (size_t)TP * 4);
constexpr size_t OFF_CNT = al256(OFF_SLW + (size_t)TP * 4);
constexpr size_t OFF_S5 = al256(OFF_CNT + 256);
constexpr size_t OFF_BAR = al256(OFF_S5 + (size_t)(T / 64) * 4096 * 8);
constexpr size_t WS_NEED = al256(OFF_BAR + 256);
static_assert(OFF_HID + (size_t)TP * 512 * 2 <= OFF_P + P_BYTES, "overlay");
static_assert((size_t)T * 1024 * 4 <= P_BYTES, "overlay Y");
static_assert(WS_NEED < 380000000ull, "ws");

struct Params {
    const float* in[N_IN];
    float* out;
    char* ws;
};
typedef const __attribute__((address_space(4))) Params* kparams_t;
struct KP {
    kparams_t k;
    __device__ __forceinline__ const float* in(int i) const { return *(const float* const volatile __attribute__((address_space(4)))*)(&k->in[i]); }
    __device__ __forceinline__ float* out() const { return *(float* const volatile __attribute__((address_space(4)))*)(&k->out); }
    __device__ __forceinline__ char* ws() const { return *(char* const volatile __attribute__((address_space(4)))*)(&k->ws); }
};

__device__ __forceinline__ float bf2f(bf16_t v) { return __uint_as_float(((unsigned)v) << 16); }
typedef __bf16 bf16x2_t __attribute__((ext_vector_type(2)));
__device__ __forceinline__ bf16_t f2bf(float f) { const __bf16 b = (__bf16)f; return __builtin_bit_cast(bf16_t, b); }
__device__ __forceinline__ float bflo(unsigned u) { return __uint_as_float(u << 16); }
__device__ __forceinline__ float bfhi(unsigned u) { return __uint_as_float(u & 0xFFFF0000u); }
__device__ __forceinline__ unsigned pack2(float lo, float hi) { bf16x2_t v; v[0] = (__bf16)lo; v[1] = (__bf16)hi; return __builtin_bit_cast(unsigned, v); }
__device__ __forceinline__ float wave_sum(float v) {
#pragma unroll
    for (int o = 32; o > 0; o >>= 1) v += __shfl_xor(v, o);
    return v;
}
__device__ __forceinline__ float transpose_reduce16(const float (&t16)[16], int lane) {
    float t8[8], t4[4], t2[2];
#pragma unroll
    for (int i = 0; i < 8; ++i) { const float a = t16[2 * i], b = t16[2 * i + 1]; const bool o = lane & 1; const float keep = o ? b : a, send = o ? a : b; t8[i] = keep + __shfl_xor(send, 1); }
#pragma unroll
    for (int i = 0; i < 4; ++i) { const float a = t8[2 * i], b = t8[2 * i + 1]; const bool o = lane & 2; const float keep = o ? b : a, send = o ? a : b; t4[i] = keep + __shfl_xor(send, 2); }
#pragma unroll
    for (int i = 0; i < 2; ++i) { const float a = t4[2 * i], b = t4[2 * i + 1]; const bool o = lane & 4; const float keep = o ? b : a, send = o ? a : b; t2[i] = keep + __shfl_xor(send, 4); }
    float y; { const float a = t2[0], b = t2[1]; const bool o = lane & 8; const float keep = o ? b : a, send = o ? a : b; y = keep + __shfl_xor(send, 8); }
    y += __shfl_xor(y, 16); y += __shfl_xor(y, 32);
    return y;
}
__device__ __forceinline__ float sigmoidf_(float x) { return 1.0f / (1.0f + __expf(-x)); }
__device__ __forceinline__ float siluf_(float x) { return x / (1.0f + __expf(-x)); }
__device__ __forceinline__ float gelu_tanh(float x) {
    const float u = 0.7978845608028654f * (x + 0.044715f * x * x * x);
    return 0.5f * x * (1.0f + tanhf(u));
}
__device__ __forceinline__ float dot8(uint4 a, uint4 b, float acc) {
    acc = fmaf(bflo(a.x), bflo(b.x), acc); acc = fmaf(bfhi(a.x), bfhi(b.x), acc);
    acc = fmaf(bflo(a.y), bflo(b.y), acc); acc = fmaf(bfhi(a.y), bfhi(b.y), acc);
    acc = fmaf(bflo(a.z), bflo(b.z), acc); acc = fmaf(bfhi(a.z), bfhi(b.z), acc);
    acc = fmaf(bflo(a.w), bflo(b.w), acc); acc = fmaf(bfhi(a.w), bfhi(b.w), acc);
    return acc;
}
__device__ __forceinline__ float dotrow(const bf16_t* a, const bf16_t* b, int K) {
    float acc = 0.f;
    const uint4* a4 = (const uint4*)a; const uint4* b4 = (const uint4*)b;
    for (int k = 0; k < K / 8; ++k) acc = dot8(a4[k], b4[k], acc);
    return acc;
}

__device__ __forceinline__ int opaque_tid() { int t = threadIdx.x; asm volatile("" : "+v"(t)); return t; }
#define WSP(type, off) ((type*)(p.ws() + (off)))

template <class AF, class BF, class EF>
__device__ __forceinline__ void gemm_naive(int M, int N, int K, AF arow, BF brow, EF epi, int bid, int nb) {
    const int tidx = opaque_tid();
    const long total = (long)M * N;
    for (long idx = (long)bid * NTH + tidx; idx < total; idx += (long)nb * NTH) {
        const int m = (int)(idx / N), n = (int)(idx % N);
        const float acc = dotrow(arow(m), brow(m, n), K);
        epi(m, n, acc);
    }
}

constexpr int G_A_BYTES = 256 * 128, G_W_BYTES = 128 * 128, G_BUF = G_A_BYTES + G_W_BYTES;
constexpr int LDS_BYTES = 3 * G_BUF;
#define MFMA32(a, b, c) __builtin_amdgcn_mfma_f32_32x32x16_bf16(a, b, c, 0, 0, 0)

#define GLDS16(gptr, lptr) __builtin_amdgcn_global_load_lds((const __attribute__((address_space(1))) void*)(gptr), (__attribute__((address_space(3))) void*)(lptr), 16, 0, 0)
template <class APTR, class WPTR>
__device__ __forceinline__ void gemm_core_g(f32x16 (&acc)[2][2], APTR aptr, WPTR wptr, int nk, char* lds) {
    const int tidx = opaque_tid();
    const int tid = tidx, lane = tid & 63, wid = tid >> 6, wm = wid >> 1, wn = wid & 1, r32 = lane & 31, hi = lane >> 5;
    const int wu = __builtin_amdgcn_readfirstlane(wid);
    char* sdst = lds + wu * 1024;
    const int xoff = (wm * 64 + r32) * 128, woff = G_A_BYTES + (wn * 64 + r32) * 128, sw7 = (r32 >> 1) & 7;
    asm volatile("s_waitcnt vmcnt(0)" ::: "memory");
#pragma unroll
    for (int i = 0; i < 4; ++i) GLDS16(aptr(i, 0), sdst + i * 8192);
#pragma unroll
    for (int i = 0; i < 2; ++i) GLDS16(wptr(i, 0), sdst + G_A_BYTES + i * 8192);
    if (nk > 1) {
#pragma unroll
        for (int i = 0; i < 4; ++i) GLDS16(aptr(i, 1), sdst + G_BUF + i * 8192);
#pragma unroll
        for (int i = 0; i < 2; ++i) GLDS16(wptr(i, 1), sdst + G_BUF + G_A_BYTES + i * 8192);
        asm volatile("s_waitcnt vmcnt(6)" ::: "memory");
    } else asm volatile("s_waitcnt vmcnt(0)" ::: "memory");
    __builtin_amdgcn_s_barrier();
    int slot = 0;
    for (int kt = 0; kt < nk; ++kt) {
        const char* cur = lds + slot * G_BUF;
        const int s2 = slot >= 1 ? slot - 1 : 2;
        const bool more2 = (kt + 2 < nk);
        char* nxt = sdst + s2 * G_BUF;
#pragma unroll
        for (int ks = 0; ks < 4; ++ks) {
            const int co = ((ks * 2 + hi) ^ sw7) << 4;
            const bf16x8 x0 = *(const bf16x8*)(cur + xoff + co), x1 = *(const bf16x8*)(cur + xoff + 32 * 128 + co);
            const bf16x8 w0 = *(const bf16x8*)(cur + woff + co), w1 = *(const bf16x8*)(cur + woff + 32 * 128 + co);
            acc[0][0] = MFMA32(w0, x0, acc[0][0]); acc[0][1] = MFMA32(w0, x1, acc[0][1]);
            acc[1][0] = MFMA32(w1, x0, acc[1][0]); acc[1][1] = MFMA32(w1, x1, acc[1][1]);
            __builtin_amdgcn_sched_barrier(0);
            if (more2) {
                if (ks == 0) { GLDS16(aptr(0, kt + 2), nxt); GLDS16(aptr(1, kt + 2), nxt + 8192); }
                if (ks == 1) { GLDS16(aptr(2, kt + 2), nxt + 2 * 8192); GLDS16(aptr(3, kt + 2), nxt + 3 * 8192); }
                if (ks == 2) { GLDS16(wptr(0, kt + 2), nxt + G_A_BYTES); GLDS16(wptr(1, kt + 2), nxt + G_A_BYTES + 8192); }
            }
            __builtin_amdgcn_sched_barrier(0);
        }
        if (more2) asm volatile("s_waitcnt vmcnt(6) lgkmcnt(0)" ::: "memory");
        else asm volatile("s_waitcnt vmcnt(0) lgkmcnt(0)" ::: "memory");
        __builtin_amdgcn_s_barrier();
        slot = slot == 2 ? 0 : slot + 1;
    }
}
template <class AROW, class WROW>
__device__ __forceinline__ void gemm_core(f32x16 (&acc)[2][2], AROW arow, WROW wrow, int K, char* lds) {
    const int tidx = opaque_tid();
    const int srow = tidx >> 3, gch = (tidx & 7) ^ ((srow >> 1) & 7);
    const bf16_t* pa[4]; const bf16_t* pw[2];
#pragma unroll
    for (int i = 0; i < 4; ++i) pa[i] = arow(srow + 64 * i) + gch * 8;
#pragma unroll
    for (int i = 0; i < 2; ++i) pw[i] = wrow(srow + 64 * i) + gch * 8;
    gemm_core_g(acc, [&](int i, int kt) { return pa[i] + kt * 64; }, [&](int i, int kt) { return pw[i] + kt * 64; }, K >> 6, lds);
}
__device__ __forceinline__ void acc_zero(f32x16 (&acc)[2][2]) {
#pragma unroll
    for (int a = 0; a < 2; ++a)
#pragma unroll
        for (int b = 0; b < 2; ++b)
#pragma unroll
            for (int r = 0; r < 16; ++r) acc[a][b][r] = 0.f;
}
template <class F>
__device__ __forceinline__ void acc_visit(const f32x16 (&acc)[2][2], F f) {
    const int tidx = opaque_tid();
    const int lane = tidx & 63, wid = tidx >> 6, wm = wid >> 1, wn = wid & 1, r32 = lane & 31, hi = lane >> 5;
#pragma unroll
    for (int in = 0; in < 2; ++in)
#pragma unroll
        for (int im = 0; im < 2; ++im)
#pragma unroll
            for (int rg = 0; rg < 4; ++rg) {
                f32x4 v; v[0] = acc[in][im][4 * rg]; v[1] = acc[in][im][4 * rg + 1]; v[2] = acc[in][im][4 * rg + 2]; v[3] = acc[in][im][4 * rg + 3];
                f(wm * 64 + im * 32 + r32, wn * 64 + in * 32 + 8 * rg + 4 * hi, v);
            }
}
template <class F>
__device__ __forceinline__ void acc_visit_add(const f32x16 (&acc)[2][2], f32x16 (&tot)[2][2], F f) {
    const int tidx = opaque_tid();
    const int lane = tidx & 63, wid = tidx >> 6, wm = wid >> 1, wn = wid & 1, r32 = lane & 31, hi = lane >> 5;
#pragma unroll
    for (int in = 0; in < 2; ++in)
#pragma unroll
        for (int im = 0; im < 2; ++im)
#pragma unroll
            for (int rg = 0; rg < 4; ++rg) {
                f32x4 v; v[0] = acc[in][im][4 * rg]; v[1] = acc[in][im][4 * rg + 1]; v[2] = acc[in][im][4 * rg + 2]; v[3] = acc[in][im][4 * rg + 3];
                const f32x4 r = f(wm * 64 + im * 32 + r32, wn * 64 + in * 32 + 8 * rg + 4 * hi, v);
                tot[in][im][4 * rg] += r[0]; tot[in][im][4 * rg + 1] += r[1]; tot[in][im][4 * rg + 2] += r[2]; tot[in][im][4 * rg + 3] += r[3];
            }
}
__device__ __forceinline__ uint2 pack4(f32x4 v) { uint2 o; o.x = pack2(v[0], v[1]); o.y = pack2(v[2], v[3]); return o; }
__device__ __forceinline__ bool dense_tile(int it, int NT, bool with_ctx, int bid, int nb, int& mt, int& nt) {
    const int x = bid & 7, j = bid >> 3, jb = nb >> 3;
    int v = it * jb + j;
    if (v < 8 * NT) { mt = 1 + x * 8 + (v & 7); nt = v >> 3; return true; }
    if (!with_ctx) return false;
    v -= 8 * NT; nt = x + 8 * v; mt = 0;
    return nt < NT;
}

__device__ __forceinline__ void st_prologue(const KP& p, int bid, int nb, float* smem) {
    const int tidx = opaque_tid();
    const int tid = tidx;
    {   const float4* x4 = (const float4*)p.in(I_X); float4* o4 = (float4*)p.out();
        for (long i = (long)bid * NTH + tid; i < (long)S * D / 4; i += (long)nb * NTH) o4[i] = x4[i];
        const float4* c4 = (const float4*)p.in(I_CTX); float4* xc4 = WSP(float4, OFF_XC);
        for (long i = (long)bid * NTH + tid; i < (long)LC * D / 4; i += (long)nb * NTH) xc4[i] = c4[i]; }
    for (int k = tid; k < 1024; k += NTH) { smem[k] = siluf_(p.in(I_C)[k]); smem[1024 + k] = siluf_(p.in(I_CCTX)[k]); }
    __syncthreads();
    float* mod = WSP(float, OFF_MOD);
    float4* red = (float4*)(smem + 2048);
    for (int jb = bid; jb < 256; jb += nb) {
        const int l = jb >> 7, j0 = (jb & 127) * 48, jj = tid % 12, kk = tid / 12;
        float4 a0 = make_float4(0.f, 0.f, 0.f, 0.f), a1 = a0;
        if (kk < 42) {
            const float* w = p.in(I_WMOD) + (size_t)l * 1024 * 6144 + j0 + jj * 4;
            for (int k = kk; k < 1024; k += 42) { const float4 wv = *(const float4*)(w + (size_t)k * 6144); const float s0 = smem[k], s1 = smem[1024 + k];
                a0.x = fmaf(s0, wv.x, a0.x); a0.y = fmaf(s0, wv.y, a0.y); a0.z = fmaf(s0, wv.z, a0.z); a0.w = fmaf(s0, wv.w, a0.w);
                a1.x = fmaf(s1, wv.x, a1.x); a1.y = fmaf(s1, wv.y, a1.y); a1.z = fmaf(s1, wv.z, a1.z); a1.w = fmaf(s1, wv.w, a1.w); }
            red[(kk * 12 + jj) * 2] = a0; red[(kk * 12 + jj) * 2 + 1] = a1;
        }
        __syncthreads();
        if (tid < 24) {
            const int cj = tid >> 1, cond = tid & 1;
            float4 s = make_float4(0.f, 0.f, 0.f, 0.f);
            for (int q = 0; q < 42; ++q) { const float4 v = red[(q * 12 + cj) * 2 + cond]; s.x += v.x; s.y += v.y; s.z += v.z; s.w += v.w; }
            const float4 b = *(const float4*)(p.in(I_BMOD) + l * 6144 + j0 + cj * 4);
            s.x += b.x; s.y += b.y; s.z += b.z; s.w += b.w;
            *(float4*)(mod + (size_t)(l * 2 + cond) * 6144 + j0 + cj * 4) = s;
        }
        __syncthreads();
    }
}

__device__ __forceinline__ void conv_t(const float* W, bf16_t* Wt, int K, int N, int Npad, int nmat, int bid, int nb, float* smem) {
    const int tidx = opaque_tid();
    const int tid = tidx, tx = tid & 63, ty = tid >> 6;
    const int tn = Npad / 64, tk = K / 64;
    const int ntile = tn * tk * nmat;
    for (int t = bid; t < ntile; t += nb) {
        const int mat = t / (tn * tk), r = t % (tn * tk), n0 = (r / tk) * 64, k0 = (r % tk) * 64;
        const float* Wm = W + (size_t)mat * K * N; bf16_t* Wtm = Wt + (size_t)mat * Npad * K;
        __syncthreads();
#pragma unroll
        for (int i = 0; i < 8; ++i) { const int kk = ty + 8 * i, n = n0 + tx; smem[kk * 65 + tx] = (n < N) ? Wm[(size_t)(k0 + kk) * N + n] : 0.f; }
        __syncthreads();
#pragma unroll
        for (int i = 0; i < 8; ++i) { const int nn = ty + 8 * i; Wtm[(size_t)(n0 + nn) * K + k0 + tx] = f2bf(smem[tx * 65 + nn]); }
    }
    __syncthreads();
}
__device__ __forceinline__ void st_conv(const KP& p, int l, int bid, int nb, float* smem) {
    const int tidx = opaque_tid(); (void)tidx;
    bf16_t* wb = WSP(bf16_t, OFF_WB);
    conv_t(p.in(I_WIN) + (size_t)l * 1024 * NIN, (bf16_t*)((char*)wb + WB_IN), 1024, NIN, NINP, 1, bid, nb, smem);
    conv_t(p.in(I_WUQ) + (size_t)l * 256 * 768, (bf16_t*)((char*)wb + WB_UQ), 256, 768, 768, 1, bid, nb, smem);
    conv_t(p.in(I_WUKV) + (size_t)l * 128 * 1024, (bf16_t*)((char*)wb + WB_UKV), 128, 1024, 1024, 1, bid, nb, smem);
    conv_t(p.in(I_WGLU) + (size_t)l * 512 * 512, (bf16_t*)((char*)wb + WB_GLU), 512, 512, 512, 1, bid, nb, smem);
    conv_t(p.in(I_WBRM) + (size_t)l * 512 * 1024, (bf16_t*)((char*)wb + WB_BR), 512, 1024, 1024, 1, bid, nb, smem);
    conv_t(p.in(I_WBRS) + (size_t)l * 512 * 1024, (bf16_t*)((char*)wb + WB_BR + (size_t)1024 * 512 * 2), 512, 1024, 1024, 1, bid, nb, smem);
    conv_t(p.in(I_WBRG) + (size_t)l * 512 * 1024, (bf16_t*)((char*)wb + WB_BR + (size_t)2 * 1024 * 512 * 2), 512, 1024, 1024, 1, bid, nb, smem);
    conv_t(p.in(I_WOUT) + (size_t)l * 1024 * 1024, (bf16_t*)((char*)wb + WB_OUT), 1024, 1024, 1024, 1, bid, nb, smem);
}
__device__ __forceinline__ void st_conv_experts(const KP& p, int l, int bid, int nb, float* smem) {
    const int tidx = opaque_tid(); (void)tidx;
    bf16_t* wb = WSP(bf16_t, OFF_WB);
    conv_t(p.in(I_WEG) + (size_t)l * 16 * 1024 * 512, (bf16_t*)((char*)wb + WB_EG), 1024, 512, 512, 16, bid, nb, smem);
    conv_t(p.in(I_WEU) + (size_t)l * 16 * 1024 * 512, (bf16_t*)((char*)wb + WB_EU), 1024, 512, 512, 16, bid, nb, smem);
    conv_t(p.in(I_WED) + (size_t)l * 16 * 512 * 1024, (bf16_t*)((char*)wb + WB_ED), 512, 1024, 1024, 16, bid, nb, smem);
}

__device__ __forceinline__ const float* xrow_c(const KP& p, int r) { return (r < LC) ? (WSP(float, OFF_XC) + (size_t)r * D) : (p.out() + (size_t)(r - LC) * D); }
__device__ __forceinline__ float* xrow(const KP& p, int r) { return (r < LC) ? (WSP(float, OFF_XC) + (size_t)r * D) : (p.out() + (size_t)(r - LC) * D); }
__device__ __forceinline__ void st_modulate(const KP& p, int l, int bid, int nb) {
    const int tidx = opaque_tid();
    const int lane = tidx & 63, wid = tidx >> 6;
    bf16_t* Hb = WSP(bf16_t, OFF_H);
    const float* g = p.in(I_GPREMIX) + l * D;
    for (int r = bid * NWV + wid; r < T; r += nb * NWV) {
        const float* xr = xrow_c(p, r);
        const float* md = WSP(float, OFF_MOD) + (size_t)(l * 2 + (r < LC ? 1 : 0)) * 6144;
        float4 v[4]; float ss = 0.f;
#pragma unroll
        for (int i = 0; i < 4; ++i) { v[i] = *(const float4*)(xr + i * 256 + lane * 4); ss += v[i].x * v[i].x + v[i].y * v[i].y + v[i].z * v[i].z + v[i].w * v[i].w; }
        ss = wave_sum(ss);
        const float rstd = rsqrtf(ss * (1.0f / D) + EPS);
#pragma unroll
        for (int i = 0; i < 4; ++i) {
            const int c = i * 256 + lane * 4;
            const float4 gg = *(const float4*)(g + c), sh = *(const float4*)(md + c), sc = *(const float4*)(md + 1024 + c);
            const float h0 = v[i].x * rstd * gg.x * (1.f + sc.x) + sh.x, h1 = v[i].y * rstd * gg.y * (1.f + sc.y) + sh.y;
            const float h2 = v[i].z * rstd * gg.z * (1.f + sc.z) + sh.z, h3 = v[i].w * rstd * gg.w * (1.f + sc.w) + sh.w;
            uint2 o; o.x = pack2(h0, h1); o.y = pack2(h2, h3);
            *(uint2*)(Hb + (size_t)r * D + c) = o;
        }
    }
}

__device__ __forceinline__ void st_gemm_in(const KP& p, int bid, int nb, char* lds) {
    const int tidx = opaque_tid();
    const bf16_t* Hb = WSP(bf16_t, OFF_H); const bf16_t* Wt = WSP(bf16_t, OFF_WB + WB_IN); bf16_t* P = WSP(bf16_t, OFF_P);
    int mt, nt;
    for (int it = 0; dense_tile(it, NINP / 128, true, bid, nb, mt, nt); ++it) {
        f32x16 acc[2][2]; acc_zero(acc);
        gemm_core(acc, [&](int r) { return Hb + (size_t)(mt * 256 + r) * 1024; }, [&](int r) { return Wt + (size_t)(nt * 128 + r) * 1024; }, 1024, lds);
        acc_visit(acc, [&](int ml, int nl, f32x4 v) {
            const int n = nt * 128 + nl;
            if (n < NIN) *(uint2*)(P + (size_t)(mt * 256 + ml) * NIN + n) = pack4(v); });
    }
}

__device__ __forceinline__ void rope_pair(float& a, float& b, int pos, int i, int half) {
    const float freq = powf(10000.0f, -(float)i / (float)half);
    const float ang = (float)pos * freq;
    float sn, cs; sincosf(ang, &sn, &cs);
    const float na = a * cs - b * sn, nb_ = a * sn + b * cs; a = na; b = nb_;
}

__device__ __forceinline__ void st_postproj(const KP& p, int l, int bid, int nb) {
    const int tidx = opaque_tid();
    const int lane = tidx & 63, wid = tidx >> 6;
    bf16_t* P = WSP(bf16_t, OFF_P);
    const float* gcq = p.in(I_GCQ) + l * 256; const float* gckv = p.in(I_GCKV) + l * 128;
    for (int r = bid * NWV + wid; r < T; r += nb * NWV) {
        bf16_t* pr = P + (size_t)r * NIN;
        {
            uint2 raw = *(const uint2*)(pr + C_CQ + lane * 4);
            float a0 = bflo(raw.x), a1 = bfhi(raw.x), a2 = bflo(raw.y), a3 = bfhi(raw.y);
            float ss = wave_sum(a0 * a0 + a1 * a1 + a2 * a2 + a3 * a3);
            const float rstd = rsqrtf(ss * (1.0f / 256.0f) + EPS);
            const float4 gg = *(const float4*)(gcq + lane * 4);
            uint2 o; o.x = pack2(a0 * rstd * gg.x, a1 * rstd * gg.y); o.y = pack2(a2 * rstd * gg.z, a3 * rstd * gg.w);
            *(uint2*)(pr + C_CQ + lane * 4) = o; }
        {
            unsigned raw = *(const unsigned*)(pr + C_CKV + lane * 2);
            float a0 = bflo(raw), a1 = bfhi(raw);
            float ss = wave_sum(a0 * a0 + a1 * a1);
            const float rstd = rsqrtf(ss * (1.0f / 128.0f) + EPS);
            *(unsigned*)(pr + C_CKV + lane * 2) = pack2(a0 * rstd * gckv[lane * 2], a1 * rstd * gckv[lane * 2 + 1]); }
        if (r >= LC && lane < 16) {
            const int t = r - LC, i = lane & 7, base = (lane < 8) ? 0 : 16, pos = (lane < 8) ? (t >> 6) : (t & 63);
            float a = bf2f(pr[C_KR + base + i]), b = bf2f(pr[C_KR + base + 8 + i]);
            rope_pair(a, b, pos, i, 8);
            pr[C_KR + base + i] = f2bf(a); pr[C_KR + base + 8 + i] = f2bf(b); }
    }
    const float* gqn = p.in(I_GQN) + l * 64; const float* gkn = p.in(I_GKN) + l * 64;
    for (long idx = (long)bid * NTH + tidx; idx < (long)T * 10; idx += (long)nb * NTH) {
        const int r = (int)(idx / 10), h = (int)(idx % 10);
        bf16_t* ptr = P + (size_t)r * NIN + (h < 8 ? C_GQ + h * 64 : C_GK + (h - 8) * 64);
        const float* gg = (h < 8) ? gqn : gkn;
        float v[64]; float ss = 0.f;
#pragma unroll
        for (int i = 0; i < 8; ++i) { const uint4 raw = ((const uint4*)ptr)[i];
            v[8 * i + 0] = bflo(raw.x); v[8 * i + 1] = bfhi(raw.x); v[8 * i + 2] = bflo(raw.y); v[8 * i + 3] = bfhi(raw.y);
            v[8 * i + 4] = bflo(raw.z); v[8 * i + 5] = bfhi(raw.z); v[8 * i + 6] = bflo(raw.w); v[8 * i + 7] = bfhi(raw.w); }
#pragma unroll
        for (int i = 0; i < 64; ++i) ss += v[i] * v[i];
        const float rstd = rsqrtf(ss * (1.0f / 64.0f) + EPS);
#pragma unroll
        for (int i = 0; i < 64; ++i) v[i] = v[i] * rstd * gg[i];
        if (r >= LC) { const int t = r - LC, prow = t >> 6, pcol = t & 63;
#pragma unroll
            for (int i = 0; i < 16; ++i) { rope_pair(v[i], v[16 + i], prow, i, 16); rope_pair(v[32 + i], v[48 + i], pcol, i, 16); } }
#pragma unroll
        for (int i = 0; i < 8; ++i) { uint4 o; o.x = pack2(v[8 * i], v[8 * i + 1]); o.y = pack2(v[8 * i + 2], v[8 * i + 3]); o.z = pack2(v[8 * i + 4], v[8 * i + 5]); o.w = pack2(v[8 * i + 6], v[8 * i + 7]);
            ((uint4*)ptr)[i] = o; }
    }
}

constexpr int S5C = 64, NCH = T / S5C;
constexpr size_t S5_ZERO = OFF_WB + WB_EG;
constexpr size_t S5_KTAB = S5_ZERO + 256;
constexpr size_t S5_FTAB = S5_KTAB + (size_t)64 * 64 * 256 * 2;
constexpr size_t S5_GTAB = S5_FTAB + (size_t)64 * 128 * 1024 * 2;
constexpr size_t S5_SINB = S5_GTAB + (size_t)64 * 1024 * 128 * 2;
static_assert(S5_SINB + (size_t)NCH * 64 * 128 * 2 <= OFF_WB + WB_BYTES, "s5 tables overlay");
__device__ __forceinline__ int s5_row(int dir, int j) { return dir == 0 ? j : (j < LC ? LC - 1 - j : T + LC - 1 - j); }
__device__ __forceinline__ void s5_consts(const KP& p, int l, int dir, int g, int lane, float& lr, float& li, float (&bbr)[16], float (&bbi)[16]) {
    const int gi = (l * 2 + dir) * 32 + g, pi = gi * 64 + lane;
    const float are = p.in(I_ARE)[pi], aim = p.in(I_AIM)[pi], dt = expf(p.in(I_LOGDT)[gi]);
    const float mag = expf(are * dt); float sn, cs; sincosf(aim * dt, &sn, &cs);
    lr = mag * cs; li = mag * sn; const float den = are * are + aim * aim;
    const float cr = ((lr - 1.0f) * are + li * aim) / den, ci = (li * are - (lr - 1.0f) * aim) / den;
    const float4* br4 = (const float4*)(p.in(I_BRE) + (size_t)pi * 16); const float4* bi4 = (const float4*)(p.in(I_BIM) + (size_t)pi * 16);
#pragma unroll
    for (int q = 0; q < 4; ++q) { const float4 br = br4[q], bi = bi4[q];
        bbr[4 * q] = cr * br.x - ci * bi.x; bbi[4 * q] = cr * bi.x + ci * br.x; bbr[4 * q + 1] = cr * br.y - ci * bi.y; bbi[4 * q + 1] = cr * bi.y + ci * br.y;
        bbr[4 * q + 2] = cr * br.z - ci * bi.z; bbi[4 * q + 2] = cr * bi.z + ci * br.z; bbr[4 * q + 3] = cr * br.w - ci * bi.w; bbi[4 * q + 3] = cr * bi.w + ci * br.w; }
}
__device__ __forceinline__ void s5_unpack(uint4 a, uint4 b, float (&u)[16]) {
    u[0] = bflo(a.x); u[1] = bfhi(a.x); u[2] = bflo(a.y); u[3] = bfhi(a.y); u[4] = bflo(a.z); u[5] = bfhi(a.z); u[6] = bflo(a.w); u[7] = bfhi(a.w);
    u[8] = bflo(b.x); u[9] = bfhi(b.x); u[10] = bflo(b.y); u[11] = bfhi(b.y); u[12] = bflo(b.z); u[13] = bfhi(b.z); u[14] = bflo(b.w); u[15] = bfhi(b.w);
}
__device__ __forceinline__ void st_s5_local(const KP& p, int l, int bid, int nb) {
    const int tidx = opaque_tid();
    const int lane = tidx & 63, wid = tidx >> 6;
    const bf16_t* P = WSP(bf16_t, OFF_P); float2* F = WSP(float2, OFF_S5);
    const int gw = bid * NWV + wid, nw = nb * NWV;
    if (gw >= (nw / 64) * 64) return;
    const int gd = gw & 63, dir = gd >> 5, g = gd & 31, part = gw >> 6, nparts = nw >> 6;
    if (part >= 4) return;
    float lr, li, bbr[16], bbi[16]; s5_consts(p, l, dir, g, lane, lr, li, bbr, bbi);
    for (int c = part; c < 4; c += nparts) {
        float sr = 0.f, si = 0.f;
        for (int j0 = 0; j0 < S5C; j0 += 8) {
            uint4 ua[8], ub[8];
#pragma unroll
            for (int q = 0; q < 8; ++q) { const int r = s5_row(dir, c * S5C + j0 + q); const uint4* up = (const uint4*)(P + (size_t)r * NIN + C_SSM + g * 16); ua[q] = up[0]; ub[q] = up[1]; }
#pragma unroll
            for (int q = 0; q < 8; ++q) { float u[16]; s5_unpack(ua[q], ub[q], u);
                float bur = 0.f, bui = 0.f;
#pragma unroll
                for (int cc = 0; cc < 16; ++cc) { bur = fmaf(bbr[cc], u[cc], bur); bui = fmaf(bbi[cc], u[cc], bui); }
                const float nsr = lr * sr - li * si + bur, nsi = lr * si + li * sr + bui; sr = nsr; si = nsi; }
        }
        F[((size_t)(c * 2 + dir) * 32 + g) * 64 + lane] = make_float2(sr, si);
    }
}
__device__ __forceinline__ void st_s5_carry(const KP& p, int l, int bid, int nb) {
    const int tidx = opaque_tid();
    float2* F = WSP(float2, OFF_S5);
    const int idx = bid * NTH + tidx;
    if (idx >= 4096) return;
    const int gi = l * 64 + (idx >> 6);
    const float are = p.in(I_ARE)[gi * 64 + (idx & 63)], aim = p.in(I_AIM)[gi * 64 + (idx & 63)], dt = expf(p.in(I_LOGDT)[gi]);
    const float mag = expf(are * dt); float sn, cs; sincosf(aim * dt, &sn, &cs);
    float pr = mag * cs, pi_ = mag * sn;
#pragma unroll
    for (int q = 0; q < 6; ++q) { const float nr = pr * pr - pi_ * pi_, ni = 2.f * pr * pi_; pr = nr; pi_ = ni; }
    float sr = 0.f, si = 0.f;
    for (int c0 = 0; c0 < NCH; c0 += 20) {
        float2 f[20];
#pragma unroll
        for (int q = 0; q < 20; ++q) f[q] = F[(size_t)(c0 + q) * 4096 + idx];
#pragma unroll
        for (int q = 0; q < 20; ++q) { F[(size_t)(c0 + q) * 4096 + idx] = make_float2(sr, si);
            { bf16_t* sb = WSP(bf16_t, S5_SINB) + ((size_t)(c0 + q) * 64 + (idx >> 6)) * 128 + (idx & 63); sb[0] = f2bf(sr); sb[64] = f2bf(si); }
            const float nr = pr * sr - pi_ * si + f[q].x, ni = pr * si + pi_ * sr + f[q].y; sr = nr; si = ni; }
    }
}
__device__ __forceinline__ void st_s5_scan(const KP& p, int l, int bid, int nb) {
    const int tidx = opaque_tid();
    const int lane = tidx & 63, wid = tidx >> 6;
    const bf16_t* P = WSP(bf16_t, OFF_P); const float2* F = WSP(float2, OFF_S5);
    const int gw = bid * NWV + wid, nw = nb * NWV;
    if (gw >= (nw / 64) * 64) return;
    const int gd = gw & 63, dir = gd >> 5, g = gd & 31, part = gw >> 6, nparts = nw >> 6;
    if (part >= 4) return;
    float* Yo = dir == 0 ? WSP(float, OFF_OM) : WSP(float, OFF_H);
    float lr, li, bbr[16], bbi[16]; s5_consts(p, l, dir, g, lane, lr, li, bbr, bbi);
    const int gi = (l * 2 + dir) * 32 + g;
    float cre[16], cim[16];
#pragma unroll
    for (int cc = 0; cc < 16; ++cc) { cre[cc] = p.in(I_CRE)[((size_t)gi * 16 + cc) * 64 + lane]; cim[cc] = p.in(I_CIM)[((size_t)gi * 16 + cc) * 64 + lane]; }
    const float dsk = p.in(I_SSMD)[l * 512 + g * 16 + (lane & 15)];
    for (int c = part; c < 4; c += nparts) {
        const float2 s0 = F[((size_t)(c * 2 + dir) * 32 + g) * 64 + lane];
        float sr = s0.x, si = s0.y;
        for (int j0 = 0; j0 < S5C; j0 += 8) {
            uint4 ua[8], ub[8];
#pragma unroll
            for (int q = 0; q < 8; ++q) { const int r = s5_row(dir, c * S5C + j0 + q); const uint4* up = (const uint4*)(P + (size_t)r * NIN + C_SSM + g * 16); ua[q] = up[0]; ub[q] = up[1]; }
#pragma unroll
            for (int q = 0; q < 8; ++q) { const int r = s5_row(dir, c * S5C + j0 + q);
                float u[16]; s5_unpack(ua[q], ub[q], u);
                float bur = 0.f, bui = 0.f;
#pragma unroll
                for (int cc = 0; cc < 16; ++cc) { bur = fmaf(bbr[cc], u[cc], bur); bui = fmaf(bbi[cc], u[cc], bui); }
                const float nsr = lr * sr - li * si + bur, nsi = lr * si + li * sr + bui; sr = nsr; si = nsi;
                float t16[16];
#pragma unroll
                for (int cc = 0; cc < 16; ++cc) t16[cc] = cre[cc] * sr - cim[cc] * si;
                float y = transpose_reduce16(t16, lane);
                if (lane < 16) {
                    if (dir == 0) y += dsk * bf2f(P[(size_t)r * NIN + C_SSM + g * 16 + lane]);
                    Yo[(size_t)r * 512 + g * 16 + lane] = y; }
            }
        }
    }
}

__device__ __forceinline__ void st_s5_tables(const KP& p, int l, int bid, int nb, char* lds) {
    const int tidx = opaque_tid();
    float* pwr = (float*)lds; float* pwi = pwr + 65 * 64; float* bbr = pwi + 65 * 64; float* bbi = bbr + 1024; float* cre = bbi + 1024; float* cim = cre + 1024;
    bf16_t* Ktab = WSP(bf16_t, S5_KTAB); bf16_t* Ftab = WSP(bf16_t, S5_FTAB); bf16_t* Gtab = WSP(bf16_t, S5_GTAB);
    if (bid == 0 && tidx < 64) WSP(unsigned, S5_ZERO)[tidx] = 0u;
    for (int item = bid; item < 256; item += nb) {
        const int gd = item >> 2, q = item & 3, dir = gd >> 5, g = gd & 31, gi = (l * 2 + dir) * 32 + g;
        __syncthreads();
        if (tidx < 64) {
            const int pp = tidx, pi = gi * 64 + pp;
            const float are = p.in(I_ARE)[pi], aim = p.in(I_AIM)[pi], dt = expf(p.in(I_LOGDT)[gi]);
            const float mag = expf(are * dt); float sn, cs; sincosf(aim * dt, &sn, &cs);
            const float lr = mag * cs, li = mag * sn, den = are * are + aim * aim;
            const float cr = ((lr - 1.0f) * are + li * aim) / den, ci = (li * are - (lr - 1.0f) * aim) / den;
            for (int c = 0; c < 16; ++c) { const float br = p.in(I_BRE)[(size_t)pi * 16 + c], bi = p.in(I_BIM)[(size_t)pi * 16 + c];
                bbr[pp * 16 + c] = cr * br - ci * bi; bbi[pp * 16 + c] = cr * bi + ci * br; }
            float ar = 1.f, ai = 0.f;
            for (int n = 0; n <= 64; ++n) { pwr[n * 64 + pp] = ar; pwi[n * 64 + pp] = ai; const float nr = ar * lr - ai * li, ni = ar * li + ai * lr; ar = nr; ai = ni; }
        } else {
            for (int i = tidx - 64; i < 1024; i += NTH - 64) { cre[i] = p.in(I_CRE)[(size_t)gi * 1024 + i]; cim[i] = p.in(I_CIM)[(size_t)gi * 1024 + i]; }
        }
        __syncthreads();
        for (int e = 0; e < 8; ++e) {
            const int idx = tidx + NTH * e, tau = 16 * q + (idx >> 8), c = (idx >> 4) & 15, c2 = idx & 15;
            float s = 0.f;
            for (int pp = 0; pp < 64; ++pp) {
                const float xr = cre[c * 64 + pp], xi = cim[c * 64 + pp], wr = pwr[tau * 64 + pp], wi = pwi[tau * 64 + pp];
                const float zr = xr * wr - xi * wi, zi = xr * wi + xi * wr;
                s += zr * bbr[pp * 16 + c2] - zi * bbi[pp * 16 + c2];
            }
            Ktab[(((size_t)gd * 64 + tau) * 16 + c) * 16 + c2] = f2bf(s);
        }
        for (int e = 0; e < 32; ++e) {
            const int idx2 = tidx + NTH * e, n = 32 * q + (idx2 >> 9), k = (idx2 & 511) * 2, pp = n & 63, comp = n >> 6, i = k >> 4, c2 = k & 15;
            const float wr = pwr[(63 - i) * 64 + pp], wi = pwi[(63 - i) * 64 + pp];
            const float b0r = bbr[pp * 16 + c2], b0i = bbi[pp * 16 + c2], b1r = bbr[pp * 16 + c2 + 1], b1i = bbi[pp * 16 + c2 + 1];
            const float v0 = comp ? (wr * b0i + wi * b0r) : (wr * b0r - wi * b0i), v1 = comp ? (wr * b1i + wi * b1r) : (wr * b1r - wi * b1i);
            *(unsigned*)(Ftab + ((size_t)gd * 128 + n) * 1024 + k) = pack2(v0, v1);
        }
        for (int e = 0; e < 32; ++e) {
            const int idx2 = tidx + NTH * e, row = 256 * q + (idx2 >> 6), n = (idx2 & 63) * 2, t = row >> 4, c = row & 15, comp = n >> 6, pp = n & 63;
            float v[2];
#pragma unroll
            for (int h = 0; h < 2; ++h) { const float xr = cre[c * 64 + pp + h], xi = cim[c * 64 + pp + h], wr = pwr[(t + 1) * 64 + pp + h], wi = pwi[(t + 1) * 64 + pp + h];
                v[h] = comp ? -(xr * wi + xi * wr) : (xr * wr - xi * wi); }
            *(unsigned*)(Gtab + ((size_t)gd * 1024 + row) * 128 + n) = pack2(v[0], v[1]);
        }
    }
    __syncthreads();
}
__device__ __forceinline__ void st_s5_fgemm(const KP& p, int bid, int nb, char* lds) {
    const int tidx = opaque_tid();
    const bf16_t* P = WSP(bf16_t, OFF_P); const bf16_t* Ftab = WSP(bf16_t, S5_FTAB); float* F = WSP(float, OFF_S5);
    const int srow = tidx >> 3, gch = (tidx & 7) ^ ((srow >> 1) & 7);
    for (int gd = bid; gd < 64; gd += nb) {
        const int dir = gd >> 5, g = gd & 31;
        f32x16 acc[2][2]; acc_zero(acc);
        gemm_core_g(acc,
            [&](int i, int kt) { const int m = srow + 64 * i, tok = kt * 4 + (gch >> 1); return P + (size_t)s5_row(dir, 64 * (4 + m) + tok) * NIN + C_SSM + 16 * g + 8 * (gch & 1); },
            [&](int i, int kt) { return Ftab + ((size_t)gd * 128 + srow + 64 * i) * 1024 + kt * 64 + gch * 8; }, 16, lds);
        acc_visit(acc, [&](int ml, int nl, f32x4 v) {
            float* dst = F + (((size_t)(4 + ml) * 2 + dir) * 32 + g) * 128 + (nl & 63) * 2 + (nl >> 6);
            dst[0] = v[0]; dst[2] = v[1]; dst[4] = v[2]; dst[6] = v[3]; });
    }
}
__device__ __forceinline__ void st_s5_ygemm(const KP& p, int l, int bid, int nb, char* lds) {
    const int tidx = opaque_tid();
    const bf16_t* P = WSP(bf16_t, OFF_P); const bf16_t* Ktab = WSP(bf16_t, S5_KTAB); const bf16_t* Gtab = WSP(bf16_t, S5_GTAB);
    const bf16_t* Sinb = WSP(bf16_t, S5_SINB); const bf16_t* Zero = WSP(bf16_t, S5_ZERO);
    const int srow = tidx >> 3, gch = (tidx & 7) ^ ((srow >> 1) & 7);
    for (int u = bid; u < 256; u += nb) {
        const int gd = u >> 2, dir = gd >> 5, g = gd & 31;
        float* Yo = dir == 0 ? WSP(float, OFF_OM) : WSP(float, OFF_H);
#pragma unroll 1
        for (int half = 0; half < 2; ++half) {
            const int nt = half == 0 ? (u & 3) : 7 - (u & 3), nkt = 2 * (nt + 1);
            f32x16 acc[2][2]; acc_zero(acc);
            gemm_core_g(acc,
                [&](int i, int kt) { const int m = srow + 64 * i;
                    if (kt < nkt) { const int tok = kt * 4 + (gch >> 1); return P + (size_t)s5_row(dir, 64 * (4 + m) + tok) * NIN + C_SSM + 16 * g + 8 * (gch & 1); }
                    return Sinb + ((size_t)(4 + m) * 64 + gd) * 128 + (kt - nkt) * 64 + gch * 8; },
                [&](int i, int kt) { const int n = nt * 128 + srow + 64 * i, t = n >> 4, c = n & 15;
                    if (kt < nkt) { const int tau = t - (kt * 4 + (gch >> 1)); return tau >= 0 ? Ktab + (((size_t)gd * 64 + tau) * 16 + c) * 16 + 8 * (gch & 1) : Zero; }
                    return Gtab + ((size_t)gd * 1024 + n) * 128 + (kt - nkt) * 64 + gch * 8; }, nkt + 2, lds);
            acc_visit(acc, [&](int ml, int nl, f32x4 v) {
                const int n = nt * 128 + nl, t = n >> 4, c0 = n & 15, r = s5_row(dir, 64 * (4 + ml) + t);
                if (dir == 0) { const float4 dsk = *(const float4*)(p.in(I_SSMD) + l * 512 + g * 16 + c0); const uint2 ur = *(const uint2*)(P + (size_t)r * NIN + C_SSM + g * 16 + c0);
                    v[0] += dsk.x * bflo(ur.x); v[1] += dsk.y * bfhi(ur.x); v[2] += dsk.z * bflo(ur.y); v[3] += dsk.w * bfhi(ur.y); }
                *(f32x4*)(Yo + (size_t)r * 512 + g * 16 + c0) = v; });
        }
    }
}
__device__ __forceinline__ void st_s5_fin(const KP& p, int bid, int nb) {
    const int tidx = opaque_tid();
    const float* Yf = WSP(float, OFF_OM); const float* Yb = WSP(float, OFF_H); bf16_t* P = WSP(bf16_t, OFF_P);
    for (long idx = (long)bid * NTH + tidx; idx < (long)T * 512; idx += (long)nb * NTH) {
        const int r = (int)(idx >> 9), c = (int)(idx & 511);
        P[(size_t)r * NIN + C_SSM + c] = f2bf(gelu_tanh(Yf[idx] + Yb[idx]));
    }
}

__device__ __forceinline__ void st_proj2(const KP& p, int l, int bid, int nb, char* lds) {
    const int tidx = opaque_tid();
    bf16_t* P = WSP(bf16_t, OFF_P);
    const bf16_t* Wuq = WSP(bf16_t, OFF_WB + WB_UQ); bf16_t* Qm = WSP(bf16_t, OFF_H);
    const bf16_t* Wukv = WSP(bf16_t, OFF_WB + WB_UKV); bf16_t* Kn = WSP(bf16_t, OFF_KN); bf16_t* Vm = WSP(bf16_t, OFF_V);
    const bf16_t* Wglu = WSP(bf16_t, OFF_WB + WB_GLU); bf16_t* Os = WSP(bf16_t, OFF_OS); const float* bg = p.in(I_BGLU) + l * 512;
    int mt, ntv;
    for (int it = 0; dense_tile(it, 6 + 8 + 4, true, bid, nb, mt, ntv); ++it) {
        const int which = ntv < 6 ? 0 : (ntv < 14 ? 1 : 2), nt = ntv - (which == 0 ? 0 : (which == 1 ? 6 : 14));
        const int K = which == 0 ? 256 : (which == 1 ? 128 : 512);
        const bf16_t* abase = P + (size_t)mt * 256 * NIN + (which == 0 ? C_CQ : (which == 1 ? C_CKV : C_SSM));
        const bf16_t* wbase = (which == 0 ? Wuq : (which == 1 ? Wukv : Wglu)) + (size_t)nt * 128 * K;
        f32x16 acc[2][2]; acc_zero(acc);
        gemm_core(acc, [&](int r) { return abase + (size_t)r * NIN; }, [&](int r) { return wbase + (size_t)r * K; }, K, lds);
        if (which == 0) {
            acc_visit(acc, [&](int ml, int nl, f32x4 v) { *(uint2*)(Qm + (size_t)(mt * 256 + ml) * 768 + nt * 128 + nl) = pack4(v); });
        } else if (which == 1) {
            acc_visit(acc, [&](int ml, int nl, f32x4 v) {
                bf16_t* dst = (nl < 64) ? (Kn + (size_t)(mt * 256 + ml) * 512 + nt * 64 + nl) : (Vm + (size_t)(mt * 256 + ml) * 512 + nt * 64 + nl - 64);
                *(uint2*)dst = pack4(v); });
        } else {
            acc_visit(acc, [&](int ml, int nl, f32x4 v) {
                const int n = nt * 128 + nl;
                const uint2 yr = *(const uint2*)(P + (size_t)(mt * 256 + ml) * NIN + C_SSM + n); const float4 b4 = *(const float4*)(bg + n);
                uint2 o; o.x = pack2(bflo(yr.x) * sigmoidf_(v[0] + b4.x), bfhi(yr.x) * sigmoidf_(v[1] + b4.y));
                o.y = pack2(bflo(yr.y) * sigmoidf_(v[2] + b4.z), bfhi(yr.y) * sigmoidf_(v[3] + b4.w));
                *(uint2*)(Os + (size_t)(mt * 256 + ml) * 512 + n) = o; });
        }
    }
}
__device__ __forceinline__ void st_ropeq(const KP& p, int bid, int nb) {
    const int tidx = opaque_tid();
    bf16_t* Qm = WSP(bf16_t, OFF_H);
    for (long idx = (long)bid * NTH + tidx; idx < (long)S * 8 * 16; idx += (long)nb * NTH) {
        const int pr = (int)(idx & 15), h = (int)((idx >> 4) & 7), t = (int)(idx >> 7);
        const int i = pr & 7, base = (pr < 8) ? 0 : 16, pos = (pr < 8) ? (t >> 6) : (t & 63);
        bf16_t* q = Qm + (size_t)(t + LC) * 768 + h * 96 + 64;
        float a = bf2f(q[base + i]), b = bf2f(q[base + 8 + i]);
        rope_pair(a, b, pos, i, 8);
        q[base + i] = f2bf(a); q[base + 8 + i] = f2bf(b);
    }
}

typedef short s16x4 __attribute__((ext_vector_type(4)));
typedef short v4i16_t __attribute__((ext_vector_type(4)));
typedef __attribute__((address_space(3))) const char* lds_cptr;
__device__ __forceinline__ s16x4 vtr(lds_cptr q) { return __builtin_bit_cast(s16x4, __builtin_amdgcn_ds_read_tr16_b64_v4i16((__attribute__((address_space(3))) v4i16_t*)q)); }
__device__ __forceinline__ unsigned cvtpk(float lo, float hi) { return pack2(lo, hi); }
__device__ __forceinline__ float xhalf_max(float m) { auto rr = __builtin_amdgcn_permlane32_swap(__float_as_uint(m), __float_as_uint(m), false, false); return fmaxf(__uint_as_float(rr[0]), __uint_as_float(rr[1])); }
__device__ __forceinline__ float xhalf_sum(float m) { auto rr = __builtin_amdgcn_permlane32_swap(__float_as_uint(m), __float_as_uint(m), false, false); return __uint_as_float(rr[0]) + __uint_as_float(rr[1]); }
constexpr int AT_K = 0, AT_V = 8192, AT_KR = 16384, AT_BUF = 20480;

template <int DQK>
__device__ __forceinline__ void attn_item(const bf16_t* Q, int qpitch, const bf16_t* KA, int kapitch, const bf16_t* KB, int kbpitch,
                                          const bf16_t* V, int vpitch, int ntiles, float C, bf16_t* O, char* lds) {
    const int tid = opaque_tid(), lane = tid & 63, wid = tid >> 6, r32 = lane & 31, hi = lane >> 5;
    constexpr int ND0 = DQK / 16;
    bf16x8 qr[ND0];
    { const bf16_t* qp = Q + (size_t)(wid * 32 + r32) * qpitch + hi * 8;
#pragma unroll
      for (int d0 = 0; d0 < ND0; ++d0) qr[d0] = *(const bf16x8*)(qp + d0 * 16); }
    const int srow = tid >> 3, sch = tid & 7;
    const bf16_t* gk = KA + (size_t)srow * kapitch + sch * 8;
    const bf16_t* gv = V + (size_t)srow * vpitch + sch * 8;
    const bf16_t* gr = (DQK > 64) ? (KB + (size_t)(tid >> 2) * kbpitch + (tid & 3) * 8) : nullptr;
    const int sk_off = AT_K + srow * 128 + ((sch ^ ((srow >> 1) & 7)) << 4);
    const int sv_off = AT_V + (sch >> 2) * 4096 + srow * 64 + (sch & 3) * 16;
    const int sr_off = AT_KR + (tid >> 2) * 64 + (((tid & 3) ^ (((tid >> 2) >> 2) & 3)) << 4);
    const bool do_r = (DQK > 64) && (tid < 256);
    const int kf_off = AT_K + r32 * 128, ksw = (r32 >> 1) & 7;
    const int rf_off = AT_KR + r32 * 64, rsw = (r32 >> 2) & 3;
    const int vf_off = AT_V + (4 * hi + ((lane & 15) >> 2)) * 64 + ((lane >> 4) & 1) * 32 + (lane & 3) * 8;
    uint4 rk, rv, rr; rr = make_uint4(0, 0, 0, 0);
    rk = *(const uint4*)gk; rv = *(const uint4*)gv; if (do_r) rr = *(const uint4*)gr;
    *(uint4*)(lds + sk_off) = rk; *(uint4*)(lds + sv_off) = rv; if (do_r) *(uint4*)(lds + sr_off) = rr;
    __syncthreads();
    f32x16 o0, o1;
#pragma unroll
    for (int r = 0; r < 16; ++r) { o0[r] = 0.f; o1[r] = 0.f; }
    float mrun = -INFINITY, lrun = 0.f;
    for (int t = 0; t < ntiles; ++t) {
        const char* cur = lds + (t & 1) * AT_BUF; char* nxt = lds + ((t + 1) & 1) * AT_BUF;
        const bool more = (t + 1 < ntiles);
        if (more) { rk = *(const uint4*)(gk + (size_t)(t + 1) * 64 * kapitch); rv = *(const uint4*)(gv + (size_t)(t + 1) * 64 * vpitch); if (do_r) rr = *(const uint4*)(gr + (size_t)(t + 1) * 64 * kbpitch); }
        f32x16 p0, p1;
#pragma unroll
        for (int r = 0; r < 16; ++r) { p0[r] = 0.f; p1[r] = 0.f; }
#pragma unroll
        for (int d0 = 0; d0 < 4; ++d0) {
            const int co = ((2 * d0 + hi) ^ ksw) << 4;
            const bf16x8 k0 = *(const bf16x8*)(cur + kf_off + co), k1 = *(const bf16x8*)(cur + kf_off + 32 * 128 + co);
            p0 = MFMA32(k0, qr[d0], p0); p1 = MFMA32(k1, qr[d0], p1);
        }
        if (DQK > 64) {
#pragma unroll
            for (int d0 = 4; d0 < ND0; ++d0) {
                const int co = ((2 * (d0 - 4) + hi) ^ rsw) << 4;
                const bf16x8 k0 = *(const bf16x8*)(cur + rf_off + co), k1 = *(const bf16x8*)(cur + rf_off + 32 * 64 + co);
                p0 = MFMA32(k0, qr[d0], p0); p1 = MFMA32(k1, qr[d0], p1);
            }
        }
        float mx = fmaxf(p0[0], p1[0]);
#pragma unroll
        for (int r = 1; r < 16; ++r) mx = fmaxf(mx, fmaxf(p0[r], p1[r]));
        mx = xhalf_max(mx) * C;
        const float mnew = fmaxf(mrun, mx);
        if (__any(mnew > mrun)) {
            const float alpha = __builtin_amdgcn_exp2f(mrun - mnew);
            lrun *= alpha;
#pragma unroll
            for (int r = 0; r < 16; ++r) { o0[r] *= alpha; o1[r] *= alpha; }
            mrun = mnew;
        }
        const float nm = -mrun;
        float ls = 0.f;
#pragma unroll
        for (int r = 0; r < 16; ++r) { p0[r] = __builtin_amdgcn_exp2f(fmaf(p0[r], C, nm)); p1[r] = __builtin_amdgcn_exp2f(fmaf(p1[r], C, nm)); ls += p0[r] + p1[r]; }
        lrun += ls;
#pragma unroll
        for (int s = 0; s < 4; ++s) {
            bf16x8 pf;
            {   unsigned w0, w1, w2, w3;
                if (s < 2) { w0 = cvtpk(p0[8 * s], p0[8 * s + 1]); w1 = cvtpk(p0[8 * s + 2], p0[8 * s + 3]); w2 = cvtpk(p0[8 * s + 4], p0[8 * s + 5]); w3 = cvtpk(p0[8 * s + 6], p0[8 * s + 7]); }
                else { const int s2 = s - 2; w0 = cvtpk(p1[8 * s2], p1[8 * s2 + 1]); w1 = cvtpk(p1[8 * s2 + 2], p1[8 * s2 + 3]); w2 = cvtpk(p1[8 * s2 + 4], p1[8 * s2 + 5]); w3 = cvtpk(p1[8 * s2 + 6], p1[8 * s2 + 7]); }
                uint4 u = make_uint4(w0, w1, w2, w3); pf = __builtin_bit_cast(bf16x8, u); }
            const lds_cptr vb = (lds_cptr)cur + vf_off + s * 1024;
            const s16x4 a0 = vtr(vb), a1 = vtr(vb + 512), b0 = vtr(vb + 4096), b1 = vtr(vb + 4096 + 512);
            const bf16x8 v0 = (bf16x8){a0[0], a0[1], a0[2], a0[3], a1[0], a1[1], a1[2], a1[3]};
            const bf16x8 v1 = (bf16x8){b0[0], b0[1], b0[2], b0[3], b1[0], b1[1], b1[2], b1[3]};
            o0 = MFMA32(v0, pf, o0); o1 = MFMA32(v1, pf, o1);
        }
        if (more) { *(uint4*)(nxt + sk_off) = rk; *(uint4*)(nxt + sv_off) = rv; if (do_r) *(uint4*)(nxt + sr_off) = rr; }
        __syncthreads();
    }
    const float inv = 1.0f / xhalf_sum(lrun);
    bf16_t* op = O + (size_t)(wid * 32 + r32) * 512 + 4 * hi;
#pragma unroll
    for (int rg = 0; rg < 4; ++rg) {
        uint2 a; a.x = pack2(o0[4 * rg] * inv, o0[4 * rg + 1] * inv); a.y = pack2(o0[4 * rg + 2] * inv, o0[4 * rg + 3] * inv);
        uint2 b; b.x = pack2(o1[4 * rg] * inv, o1[4 * rg + 1] * inv); b.y = pack2(o1[4 * rg + 2] * inv, o1[4 * rg + 3] * inv);
        *(uint2*)(op + 8 * rg) = a; *(uint2*)(op + 32 + 8 * rg) = b;
    }
}
__device__ __forceinline__ void attn_dispatch(const KP& p, int ty, int h, int qt, char* lds) {
    const bf16_t* P = WSP(bf16_t, OFF_P); const bf16_t* Qm = WSP(bf16_t, OFF_H); const bf16_t* Kn = WSP(bf16_t, OFF_KN); const bf16_t* Vm = WSP(bf16_t, OFF_V);
    const int ntiles = (qt == 0) ? (LC / 64) : (T / 64);
    const size_t r0 = (size_t)qt * 256;
    if (ty == 0)
        attn_item<96>(Qm + r0 * 768 + h * 96, 768, Kn + h * 64, 512, P + C_KR, NIN, Vm + h * 64, 512, ntiles, 0.10206207261596575f * LOG2E, WSP(bf16_t, OFF_OM) + r0 * 512 + h * 64, lds);
    else
        attn_item<64>(P + r0 * NIN + C_GQ + h * 64, NIN, P + C_GK + (h >> 2) * 64, NIN, nullptr, 0, P + C_GV + (h >> 2) * 64, NIN, ntiles, 0.125f * LOG2E, WSP(bf16_t, OFF_OG) + r0 * 512 + h * 64, lds);
}
__device__ __forceinline__ void st_attn(const KP& p, int bid, int nb, char* lds) {
    for (int ty = 0; ty < 2; ++ty)
        for (int u = bid; u < 512; u += nb) attn_dispatch(p, ty, u & 7, 1 + (u >> 3), lds);
    for (int u = bid; u < 16; u += nb) attn_dispatch(p, u >> 3, u & 7, 0, lds);
}

__device__ __forceinline__ void st_merge(const KP& p, int bid, int nb, char* lds) {
    const int tidx = opaque_tid();
    const bf16_t* P = WSP(bf16_t, OFF_P); bf16_t* Mb = WSP(bf16_t, OFF_H);
    const bf16_t* Wb = WSP(bf16_t, OFF_WB + WB_BR);
    int mt, nt;
    for (int it = 0; dense_tile(it, 8, true, bid, nb, mt, nt); ++it) {
        f32x16 tot[2][2]; acc_zero(tot);
#pragma unroll 1
        for (int b = 0; b < 3; ++b) {
            const bf16_t* Ob = WSP(bf16_t, b == 0 ? OFF_OM : (b == 1 ? OFF_OS : OFF_OG));
            f32x16 acc[2][2]; acc_zero(acc);
            gemm_core(acc, [&](int r) { return Ob + (size_t)(mt * 256 + r) * 512; }, [&](int r) { return Wb + ((size_t)b * 1024 + nt * 128 + r) * 512; }, 512, lds);
            acc_visit_add(acc, tot, [&](int ml, int nl, f32x4 v) {
                const uint2 gr = *(const uint2*)(P + (size_t)(mt * 256 + ml) * NIN + C_GATE + b * 1024 + nt * 128 + nl);
                f32x4 r; r[0] = sigmoidf_(bflo(gr.x)) * v[0]; r[1] = sigmoidf_(bfhi(gr.x)) * v[1]; r[2] = sigmoidf_(bflo(gr.y)) * v[2]; r[3] = sigmoidf_(bfhi(gr.y)) * v[3];
                return r; });
        }
        acc_visit(tot, [&](int ml, int nl, f32x4 v) { *(uint2*)(Mb + (size_t)(mt * 256 + ml) * 1024 + nt * 128 + nl) = pack4(v); });
    }
}
__device__ __forceinline__ void st_wout(const KP& p, int bid, int nb, char* lds) {
    const int tidx = opaque_tid();
    const bf16_t* Mb = WSP(bf16_t, OFF_H); const bf16_t* Wt = WSP(bf16_t, OFF_WB + WB_OUT); float* Y = WSP(float, OFF_Y);
    int mt, nt;
    for (int it = 0; dense_tile(it, 8, true, bid, nb, mt, nt); ++it) {
        f32x16 acc[2][2]; acc_zero(acc);
        gemm_core(acc, [&](int r) { return Mb + (size_t)(mt * 256 + r) * 1024; }, [&](int r) { return Wt + (size_t)(nt * 128 + r) * 1024; }, 1024, lds);
        acc_visit(acc, [&](int ml, int nl, f32x4 v) { *(f32x4*)(Y + (size_t)(mt * 256 + ml) * 1024 + nt * 128 + nl) = v; });
    }
    int* sltok = WSP(int, OFF_SLTOK); float* slw = WSP(float, OFF_SLW); int* cnt = WSP(int, OFF_CNT);
    for (int i = bid * NTH + tidx; i < TP; i += nb * NTH) { sltok[i] = 0; slw[i] = 0.f; }
    if (bid == 0 && tidx < 32) cnt[tidx] = 0;
}

__device__ __forceinline__ void st_postmix(const KP& p, int l, int bid, int nb, char* lds) {
    const int tidx = opaque_tid();
    const int lane = tidx & 63, wid = tidx >> 6;
    const float* Y = WSP(float, OFF_Y); bf16_t* H2 = WSP(bf16_t, OFF_H);
    const float* gpost = p.in(I_GPOSTMIX) + l * D; const float* gpre = p.in(I_GPREFFN) + l * D;
    int* toke = WSP(int, OFF_TOKE); float* tokw = WSP(float, OFF_TOKW); int* cnt = WSP(int, OFF_CNT);
    float* wl = (float*)lds; int* hist = (int*)(lds + 20 * 1024 * 4);
    {   const float* wg = p.in(I_WGROUP) + (size_t)l * D * 4; const float* wr = p.in(I_WROUTER) + (size_t)l * D * 16;
        for (int k = tidx; k < 1024; k += NTH) {
            const float4 g4 = *(const float4*)(wg + (size_t)k * 4);
            wl[0 * 1024 + k] = g4.x; wl[1 * 1024 + k] = g4.y; wl[2 * 1024 + k] = g4.z; wl[3 * 1024 + k] = g4.w;
#pragma unroll
            for (int e4 = 0; e4 < 4; ++e4) { const float4 r4 = *(const float4*)(wr + (size_t)k * 16 + e4 * 4);
                wl[(4 + e4 * 4 + 0) * 1024 + k] = r4.x; wl[(4 + e4 * 4 + 1) * 1024 + k] = r4.y; wl[(4 + e4 * 4 + 2) * 1024 + k] = r4.z; wl[(4 + e4 * 4 + 3) * 1024 + k] = r4.w; }
        }
        if (tidx < 16) hist[tidx] = 0;
        __syncthreads(); }
    for (int r = bid * NWV + wid; r < T; r += nb * NWV) {
        float* xr = xrow(p, r);
        const float* md = WSP(float, OFF_MOD) + (size_t)(l * 2 + (r < LC ? 1 : 0)) * 6144;
        float4 y[4], x[4]; float ss = 0.f;
#pragma unroll
        for (int i = 0; i < 4; ++i) { y[i] = *(const float4*)(Y + (size_t)r * D + i * 256 + lane * 4); ss += y[i].x * y[i].x + y[i].y * y[i].y + y[i].z * y[i].z + y[i].w * y[i].w; }
        ss = wave_sum(ss);
        const float rstd = rsqrtf(ss * (1.0f / D) + EPS);
        float ss2 = 0.f;
#pragma unroll
        for (int i = 0; i < 4; ++i) { const int c = i * 256 + lane * 4;
            const float4 gg = *(const float4*)(gpost + c), ga = *(const float4*)(md + 2048 + c); x[i] = *(const float4*)(xr + c);
            x[i].x += ga.x * y[i].x * rstd * gg.x; x[i].y += ga.y * y[i].y * rstd * gg.y; x[i].z += ga.z * y[i].z * rstd * gg.z; x[i].w += ga.w * y[i].w * rstd * gg.w;
            *(float4*)(xr + c) = x[i];
            ss2 += x[i].x * x[i].x + x[i].y * x[i].y + x[i].z * x[i].z + x[i].w * x[i].w; }
        ss2 = wave_sum(ss2);
        const float rstd2 = rsqrtf(ss2 * (1.0f / D) + EPS);
        float lg[4] = {0.f, 0.f, 0.f, 0.f}, le[16];
#pragma unroll
        for (int e = 0; e < 16; ++e) le[e] = 0.f;
#pragma unroll
        for (int i = 0; i < 4; ++i) { const int c = i * 256 + lane * 4;
            const float4 gg = *(const float4*)(gpre + c), sh = *(const float4*)(md + 3072 + c), sc = *(const float4*)(md + 4096 + c);
            float h[4];
            h[0] = x[i].x * rstd2 * gg.x * (1.f + sc.x) + sh.x; h[1] = x[i].y * rstd2 * gg.y * (1.f + sc.y) + sh.y;
            h[2] = x[i].z * rstd2 * gg.z * (1.f + sc.z) + sh.z; h[3] = x[i].w * rstd2 * gg.w * (1.f + sc.w) + sh.w;
            uint2 o; o.x = pack2(h[0], h[1]); o.y = pack2(h[2], h[3]);
            *(uint2*)(H2 + (size_t)r * D + c) = o;
#pragma unroll
            for (int e = 0; e < 4; ++e) { const float4 w4 = *(const float4*)(wl + e * 1024 + c);
                lg[e] = fmaf(h[0], w4.x, lg[e]); lg[e] = fmaf(h[1], w4.y, lg[e]); lg[e] = fmaf(h[2], w4.z, lg[e]); lg[e] = fmaf(h[3], w4.w, lg[e]); }
#pragma unroll
            for (int e = 0; e < 16; ++e) { const float4 w4 = *(const float4*)(wl + (4 + e) * 1024 + c);
                le[e] = fmaf(h[0], w4.x, le[e]); le[e] = fmaf(h[1], w4.y, le[e]); le[e] = fmaf(h[2], w4.z, le[e]); le[e] = fmaf(h[3], w4.w, le[e]); }
        }
#pragma unroll
        for (int g = 0; g < 4; ++g) lg[g] = wave_sum(lg[g]) + p.in(I_BGROUP)[l * 4 + g];
        const float myle = transpose_reduce16(le, lane) + p.in(I_BROUTER)[l * 16 + (lane & 15)];
        int gs = 0; float gm = lg[0];
#pragma unroll
        for (int g = 1; g < 4; ++g) if (lg[g] > gm) { gm = lg[g]; gs = g; }
        float ls[4];
#pragma unroll
        for (int i = 0; i < 4; ++i) ls[i] = __shfl(myle, gs * 4 + i);
        if (lane == 0) {
            float den = 0.f;
#pragma unroll
            for (int g = 0; g < 4; ++g) den += __expf(lg[g] - gm);
            const float pg = 1.0f / den;
            int i0 = 0; float m0 = ls[0];
#pragma unroll
            for (int i = 1; i < 4; ++i) if (ls[i] > m0) { m0 = ls[i]; i0 = i; }
            int i1 = -1; float m1 = -INFINITY;
#pragma unroll
            for (int i = 0; i < 4; ++i) if (i != i0 && ls[i] > m1) { m1 = ls[i]; i1 = i; }
            const float e1 = __expf(m1 - m0), w0 = pg / (1.f + e1), w1 = pg * e1 / (1.f + e1);
            const int ex0 = gs * 4 + i0, ex1 = gs * 4 + i1;
            toke[r * 2] = ex0; toke[r * 2 + 1] = ex1; tokw[r * 2] = w0; tokw[r * 2 + 1] = w1;
            atomicAdd(&hist[ex0], 1); atomicAdd(&hist[ex1], 1);
        }
    }
    __syncthreads();
    if (tidx < 16 && hist[tidx] != 0) atomicAdd(&cnt[tidx], hist[tidx]);
}

__device__ __forceinline__ void moe_offsets(const int* cnt, int* off) {
    int a = 0;
#pragma unroll
    for (int e = 0; e < 16; ++e) { off[e] = a; a += (cnt[e] + 255) & ~255; }
    off[16] = a;
}
__device__ __forceinline__ int moe_expert_of(const int* off, int j) {
    int e = 0;
#pragma unroll
    for (int k = 1; k < 16; ++k) e += (j >= off[k]) ? 1 : 0;
    return e;
}
__device__ __forceinline__ void st_moe_build(const KP& p, int bid, int nb) {
    const int tidx = opaque_tid();
    int* cnt = WSP(int, OFF_CNT); int* cnt2 = cnt + 16;
    const int* toke = WSP(int, OFF_TOKE); const float* tokw = WSP(float, OFF_TOKW); int* toks = WSP(int, OFF_TOKS);
    int* sltok = WSP(int, OFF_SLTOK); float* slw = WSP(float, OFF_SLW);
    int off[17]; moe_offsets(cnt, off);
    for (int idx = bid * NTH + tidx; idx < T * 2; idx += nb * NTH) {
        const int e = toke[idx];
        int o = 0;
#pragma unroll
        for (int k = 0; k < 16; ++k) o = (e == k) ? off[k] : o;
        const int pos = o + atomicAdd(&cnt2[e], 1);
        sltok[pos] = idx >> 1; slw[pos] = tokw[idx]; toks[idx] = pos;
    }
}
__device__ __forceinline__ void st_moe_up(const KP& p, int bid, int nb, char* lds) {
    const int tidx = opaque_tid();
    const int* cnt = WSP(int, OFF_CNT); const int* sltok = WSP(int, OFF_SLTOK);
    const bf16_t* H2 = WSP(bf16_t, OFF_H); const bf16_t* Wg = WSP(bf16_t, OFF_WB + WB_EG); const bf16_t* Wu = WSP(bf16_t, OFF_WB + WB_EU); bf16_t* Hid = WSP(bf16_t, OFF_HID);
    int off[17]; moe_offsets(cnt, off);
    const int ntiles = (off[16] >> 8) * 8;
    for (int L = bid; L < ntiles; L += nb) {
        const int mt = L >> 3, nt = L & 7, e = moe_expert_of(off, mt * 256);
        f32x16 acc[2][2]; acc_zero(acc);
        gemm_core(acc, [&](int r) { return H2 + (size_t)sltok[mt * 256 + r] * 1024; },
                  [&](int r) { const int wn = r >> 6, in = (r >> 5) & 1, j = r & 31; return (in ? Wu : Wg) + ((size_t)e * 512 + nt * 64 + wn * 32 + j) * 1024; }, 1024, lds);
        const int lane = tidx & 63, wid = tidx >> 6, wm = wid >> 1, wn = wid & 1, r32 = lane & 31, hi = lane >> 5;
#pragma unroll
        for (int im = 0; im < 2; ++im)
#pragma unroll
            for (int rg = 0; rg < 4; ++rg) {
                const int ml = wm * 64 + im * 32 + r32, col = nt * 64 + wn * 32 + 8 * rg + 4 * hi;
                float h[4];
#pragma unroll
                for (int q = 0; q < 4; ++q) h[q] = siluf_(acc[0][im][4 * rg + q]) * acc[1][im][4 * rg + q];
                uint2 o; o.x = pack2(h[0], h[1]); o.y = pack2(h[2], h[3]);
                *(uint2*)(Hid + (size_t)(mt * 256 + ml) * 512 + col) = o;
            }
    }
}
__device__ __forceinline__ void st_moe_down(const KP& p, int bid, int nb, char* lds) {
    const int tidx = opaque_tid();
    const int* cnt = WSP(int, OFF_CNT); const float* slw = WSP(float, OFF_SLW);
    const bf16_t* Hid = WSP(bf16_t, OFF_HID); const bf16_t* Wd = WSP(bf16_t, OFF_WB + WB_ED); bf16_t* Sl = WSP(bf16_t, OFF_SLOTS);
    int off[17]; moe_offsets(cnt, off);
    const int ntiles = (off[16] >> 8) * 8;
    for (int L = bid; L < ntiles; L += nb) {
        const int mt = L >> 3, nt = L & 7, e = moe_expert_of(off, mt * 256);
        f32x16 acc[2][2]; acc_zero(acc);
        gemm_core(acc, [&](int r) { return Hid + (size_t)(mt * 256 + r) * 512; }, [&](int r) { return Wd + ((size_t)e * 1024 + nt * 128 + r) * 512; }, 512, lds);
        acc_visit(acc, [&](int ml, int nl, f32x4 v) {
            const float w = slw[mt * 256 + ml];
            *(uint2*)(Sl + (size_t)(mt * 256 + ml) * 1024 + nt * 128 + nl) = pack4(v * w); });
    }
}
__device__ __forceinline__ void st_postffn(const KP& p, int l, int bid, int nb) {
    const int tidx = opaque_tid();
    const int lane = tidx & 63, wid = tidx >> 6;
    const bf16_t* Sl = WSP(bf16_t, OFF_SLOTS); const int* toks = WSP(int, OFF_TOKS);
    const float* gpost = p.in(I_GPOSTFFN) + l * D;
    for (int r = bid * NWV + wid; r < T; r += nb * NWV) {
        float* xr = xrow(p, r);
        const float* md = WSP(float, OFF_MOD) + (size_t)(l * 2 + (r < LC ? 1 : 0)) * 6144;
        const bf16_t* s0 = Sl + (size_t)toks[r * 2] * 1024; const bf16_t* s1 = Sl + (size_t)toks[r * 2 + 1] * 1024;
        float v[16]; float ss = 0.f;
#pragma unroll
        for (int i = 0; i < 4; ++i) { const int c = i * 256 + lane * 4; const uint2 a = *(const uint2*)(s0 + c), b = *(const uint2*)(s1 + c);
            v[4 * i] = bflo(a.x) + bflo(b.x); v[4 * i + 1] = bfhi(a.x) + bfhi(b.x); v[4 * i + 2] = bflo(a.y) + bflo(b.y); v[4 * i + 3] = bfhi(a.y) + bfhi(b.y);
            ss += v[4 * i] * v[4 * i] + v[4 * i + 1] * v[4 * i + 1] + v[4 * i + 2] * v[4 * i + 2] + v[4 * i + 3] * v[4 * i + 3]; }
        ss = wave_sum(ss);
        const float rstd = rsqrtf(ss * (1.0f / D) + EPS);
#pragma unroll
        for (int i = 0; i < 4; ++i) { const int c = i * 256 + lane * 4;
            const float4 gg = *(const float4*)(gpost + c), ga = *(const float4*)(md + 5120 + c); float4 x = *(const float4*)(xr + c);
            x.x += ga.x * v[4 * i] * rstd * gg.x; x.y += ga.y * v[4 * i + 1] * rstd * gg.y; x.z += ga.z * v[4 * i + 2] * rstd * gg.z; x.w += ga.w * v[4 * i + 3] * rstd * gg.w;
            *(float4*)(xr + c) = x; }
    }
}

__device__ __forceinline__ void gsync(unsigned* bar, unsigned& epoch) {
    asm volatile("s_waitcnt vmcnt(0) lgkmcnt(0)" ::: "memory");
    __syncthreads();
    if (threadIdx.x == 0) {
        __builtin_amdgcn_fence(__ATOMIC_RELEASE, "agent");
        asm volatile("s_waitcnt vmcnt(0)" ::: "memory");
        epoch += 1;
        __hip_atomic_fetch_add(bar, 1u, __ATOMIC_RELAXED, __HIP_MEMORY_SCOPE_AGENT);
        const unsigned target = epoch * gridDim.x;
        while (__hip_atomic_load(bar, __ATOMIC_RELAXED, __HIP_MEMORY_SCOPE_AGENT) < target) __builtin_amdgcn_s_sleep(2);
        __builtin_amdgcn_fence(__ATOMIC_ACQUIRE, "agent");
        asm volatile("s_waitcnt vmcnt(0)" ::: "memory");
    }
    __syncthreads();
}

__global__ void __launch_bounds__(NTH) k_mega(Params p_unused) {
    KP p; p.k = (kparams_t)__builtin_amdgcn_kernarg_segment_ptr();
    __shared__ __attribute__((aligned(16))) char lds[LDS_BYTES]; float* smem = (float*)lds;
    cg::grid_group grid = cg::this_grid();
    grid.sync();
    const int bid = blockIdx.x, nb = gridDim.x;
    unsigned* bar = WSP(unsigned, OFF_BAR); unsigned epoch = 0;
#define GS() gsync(bar, epoch)
    st_prologue(p, bid, nb, smem); GS();
#pragma unroll 1
    for (int l = 0; l < NL; ++l) {
        st_conv(p, l, bid, nb, smem); st_s5_tables(p, l, bid, nb, lds); st_modulate(p, l, bid, nb); GS();
        st_gemm_in(p, bid, nb, lds); GS();
        st_postproj(p, l, bid, nb); st_s5_local(p, l, bid, nb); st_s5_fgemm(p, bid, nb, lds); GS();
        st_s5_carry(p, l, bid, nb); GS();
        st_s5_ygemm(p, l, bid, nb, lds); st_s5_scan(p, l, bid, nb); GS();
        st_s5_fin(p, bid, nb); GS();
        st_proj2(p, l, bid, nb, lds); GS();
        st_ropeq(p, bid, nb); GS();
        st_attn(p, bid, nb, lds); GS();
        st_merge(p, bid, nb, lds); GS();
        st_wout(p, bid, nb, lds); st_conv_experts(p, l, bid, nb, smem); GS();
        st_postmix(p, l, bid, nb, lds); GS();
        st_moe_build(p, bid, nb); GS();
        st_moe_up(p, bid, nb, lds); GS();
        st_moe_down(p, bid, nb, lds); GS();
        st_postffn(p, l, bid, nb); GS();
    }
#undef GS
}

extern "C" void kernel_launch(void* const* d_in, const int* in_sizes, int n_in, void* d_out, int out_size, void* d_ws, size_t ws_size, hipStream_t stream) {
    Params p{};
    for (int i = 0; i < N_IN; ++i) p.in[i] = (const float*)d_in[i];
    p.out = (float*)d_out; p.ws = (char*)d_ws;
    if (ws_size < WS_NEED) { fprintf(stderr, "workspace too small: %zu < %zu\n", ws_size, (size_t)WS_NEED); return; }
    static int grid_blocks = 0;
    if (!grid_blocks) {
        int dev = 0, cus = 0, per_cu = 0;
        hipGetDevice(&dev);
        hipDeviceGetAttribute(&cus, hipDeviceAttributeMultiprocessorCount, dev);
        hipOccupancyMaxActiveBlocksPerMultiprocessor(&per_cu, k_mega, NTH, 0);
        if (per_cu > 1) per_cu = 1;
        if (per_cu < 1) per_cu = 1;
        grid_blocks = cus * per_cu;
    }
    hipMemsetAsync((char*)d_ws + OFF_BAR, 0, 256, stream);
    void* args[] = { &p };
    hipError_t e = hipLaunchCooperativeKernel((void*)k_mega, dim3(grid_blocks), dim3(NTH), args, 0, stream);
    if (e != hipSuccess) fprintf(stderr, "cooperative launch failed: %s (grid %d)\n", hipGetErrorString(e), grid_blocks);
}
```

```cpp
#include <hip/hip_runtime.h>
#include <hip/hip_cooperative_groups.h>
#include <cstdio>
#include <cstdint>
#include <type_traits>
namespace cg = cooperative_groups;


typedef unsigned short bf16_t;
typedef short bf16x8 __attribute__((ext_vector_type(8)));
typedef float f32x16 __attribute__((ext_vector_type(16)));
typedef float f32x4 __attribute__((ext_vector_type(4)));
typedef unsigned u32x4 __attribute__((ext_vector_type(4)));
constexpr int NTH = 512, NWV = 8;
#ifndef REP_CONV
#define REP_CONV 1
#endif
#ifndef REP_G1
#define REP_G1 1
#endif
#ifndef REP_G2
#define REP_G2 1
#endif
#ifndef REP_G3
#define REP_G3 1
#endif
#ifndef REP_S5
#define REP_S5 1
#endif
#ifndef REP_ATTN
#define REP_ATTN 1
#endif

constexpr int D = 1024, S = 16384, LC = 256, T = S + LC, NL = 2;
constexpr int NIN = 4768, NINP = 4864;
constexpr int C_GQ = 0, C_GK = 512, C_GV = 640, C_CQ = 768, C_CKV = 1024, C_KR = 1152, C_SSM = 1184, C_GATE = 1696;
__host__ __device__ constexpr int win_col_old(int n) {
    return n < 512 ? 928 + n : n < 640 ? 1440 + (n - 512) : n < 768 ? 1568 + (n - 640) : n < 1024 ? (n - 768) : n < 1152 ? 256 + (n - 1024) : n < 1184 ? 384 + (n - 1152) : n < 1696 ? 416 + (n - 1184) : n;
}
constexpr int TP = 2 * T + 16 * 256;
constexpr float EPS = 1e-6f;
constexpr float LOG2E = 1.4426950408889634f;
constexpr float SC_MLA = 0.10206207261596575f * LOG2E, SC_GQA = 0.125f * LOG2E;

enum { I_X = 0, I_C, I_CTX, I_CCTX, I_WMOD, I_BMOD, I_GPREMIX, I_GPOSTMIX, I_GPREFFN, I_GPOSTFFN, I_WIN, I_GCQ, I_GCKV, I_WUQ, I_WUKV,
       I_GQN, I_GKN, I_ARE, I_AIM, I_LOGDT, I_BRE, I_BIM, I_CRE, I_CIM, I_SSMD, I_WGLU, I_BGLU, I_WBRM, I_WBRS, I_WBRG, I_WOUT,
       I_WGROUP, I_BGROUP, I_WROUTER, I_BROUTER, I_WEG, I_WEU, I_WED, N_IN };

constexpr size_t al256(size_t x) { return (x + 255) & ~(size_t)255; }
constexpr size_t WB_IN = 0;
constexpr size_t WB_UQ = WB_IN + (size_t)NINP * 1024 * 2;
constexpr size_t WB_UKV = WB_UQ + (size_t)768 * 256 * 2;
constexpr size_t WB_GLU = WB_UKV + (size_t)1024 * 128 * 2;
constexpr size_t WB_BR = WB_GLU + (size_t)512 * 512 * 2;
constexpr size_t WB_OUT = WB_BR + (size_t)3 * 1024 * 512 * 2;
constexpr size_t WB_EG = WB_OUT + (size_t)1024 * 1024 * 2;
constexpr size_t WB_EU = WB_EG + (size_t)16 * 512 * 1024 * 2;
constexpr size_t WB_ED = WB_EU + (size_t)16 * 512 * 1024 * 2;
constexpr size_t WB_BYTES = WB_ED + (size_t)16 * 1024 * 512 * 2;

constexpr size_t OFF_WB = 0;
constexpr size_t OFF_P = al256(OFF_WB + WB_BYTES);
constexpr size_t P_BYTES = (size_t)T * NIN * 2;
constexpr size_t OFF_Y = OFF_P;
constexpr size_t OFF_SLOTS = OFF_P;
constexpr size_t OFF_HID = OFF_P + (size_t)TP * 1024 * 2;
constexpr size_t OFF_H = al256(OFF_P + P_BYTES);
constexpr size_t OFF_KN = al256(OFF_H + (size_t)T * 1024 * 2);
constexpr size_t OFF_V = al256(OFF_KN + (size_t)T * 512 * 2);
constexpr size_t OFF_OM = al256(OFF_V + (size_t)T * 512 * 2);
constexpr size_t OFF_OG = OFF_OM + (size_t)T * 512 * 2;
constexpr size_t OFF_OS = OFF_OG + (size_t)T * 512 * 2;
constexpr size_t OFF_XC = al256(OFF_OS + (size_t)T * 512 * 2);
constexpr size_t OFF_MOD = al256(OFF_XC + (size_t)LC * 1024 * 4);
constexpr size_t OFF_TOKE = al256(OFF_MOD + (size_t)NL * 2 * 6144 * 4);
constexpr size_t OFF_TOKW = al256(OFF_TOKE + (size_t)T * 2 * 4);
constexpr size_t OFF_TOKS = al256(OFF_TOKW + (size_t)T * 2 * 4);
constexpr size_t OFF_SLTOK = al256(OFF_TOKS + (size_t)T * 2 * 4);
constexpr size_t OFF_SLW = al256(OFF_SLTOK + (size_t)TP * 4);
constexpr size_t OFF_CNT = al256(OFF_SLW + (size_t)TP * 4);
constexpr size_t OFF_S5 = al256(OFF_CNT + 256);
constexpr size_t OFF_ROPE = al256(OFF_S5 + (size_t)(T / 64) * 4096 * 8);
constexpr size_t OFF_SSQ = al256(OFF_ROPE + 256 * 24 * 8);
constexpr size_t OFF_BAR = al256(OFF_SSQ + (size_t)T * 8 * 4);
constexpr size_t WS_NEED = al256(OFF_BAR + 256);
static_assert(OFF_HID + (size_t)TP * 512 * 2 <= OFF_P + P_BYTES, "overlay");
static_assert((size_t)T * 1024 * 4 <= P_BYTES, "overlay Y");
static_assert(WS_NEED < 380000000ull, "ws");

struct Params {
    const float* in[N_IN];
    float* out;
    char* ws;
};
typedef const __attribute__((address_space(4))) Params* kparams_t;
struct KP {
    kparams_t k;
    __device__ __forceinline__ const float* in(int i) const { return *(const float* const volatile __attribute__((address_space(4)))*)(&k->in[i]); }
    __device__ __forceinline__ float* out() const { return *(float* const volatile __attribute__((address_space(4)))*)(&k->out); }
    __device__ __forceinline__ char* ws() const { return *(char* const volatile __attribute__((address_space(4)))*)(&k->ws); }
};

__device__ __forceinline__ float bf2f(bf16_t v) { return __uint_as_float(((unsigned)v) << 16); }
typedef __bf16 bf16x2_t __attribute__((ext_vector_type(2)));
__device__ __forceinline__ bf16_t f2bf(float f) { const __bf16 b = (__bf16)f; return __builtin_bit_cast(bf16_t, b); }
__device__ __forceinline__ float bflo(unsigned u) { return __uint_as_float(u << 16); }
__device__ __forceinline__ float bfhi(unsigned u) { return __uint_as_float(u & 0xFFFF0000u); }
__device__ __forceinline__ unsigned pack2(float lo, float hi) { bf16x2_t v; v[0] = (__bf16)lo; v[1] = (__bf16)hi; return __builtin_bit_cast(unsigned, v); }
__device__ __forceinline__ float wave_sum(float v) {
#pragma unroll
    for (int o = 32; o > 0; o >>= 1) v += __shfl_xor(v, o);
    return v;
}
__device__ __forceinline__ float xhalf_max(float m) { auto rr = __builtin_amdgcn_permlane32_swap(__float_as_uint(m), __float_as_uint(m), false, false); return fmaxf(__uint_as_float(rr[0]), __uint_as_float(rr[1])); }
__device__ __forceinline__ float xhalf_sum(float m) { auto rr = __builtin_amdgcn_permlane32_swap(__float_as_uint(m), __float_as_uint(m), false, false); return __uint_as_float(rr[0]) + __uint_as_float(rr[1]); }
__device__ __forceinline__ void rope_tab(float& a, float& b, float2 cs) { const float na = a * cs.x - b * cs.y, nb_ = a * cs.y + b * cs.x; a = na; b = nb_; }
__device__ __forceinline__ float transpose_reduce16(const float (&t16)[16], int lane) {
    float t8[8], t4[4], t2[2];
#pragma unroll
    for (int i = 0; i < 8; ++i) { const float a = t16[2 * i], b = t16[2 * i + 1]; const bool o = lane & 1; const float keep = o ? b : a, send = o ? a : b; t8[i] = keep + __shfl_xor(send, 1); }
#pragma unroll
    for (int i = 0; i < 4; ++i) { const float a = t8[2 * i], b = t8[2 * i + 1]; const bool o = lane & 2; const float keep = o ? b : a, send = o ? a : b; t4[i] = keep + __shfl_xor(send, 2); }
#pragma unroll
    for (int i = 0; i < 2; ++i) { const float a = t4[2 * i], b = t4[2 * i + 1]; const bool o = lane & 4; const float keep = o ? b : a, send = o ? a : b; t2[i] = keep + __shfl_xor(send, 4); }
    float y; { const float a = t2[0], b = t2[1]; const bool o = lane & 8; const float keep = o ? b : a, send = o ? a : b; y = keep + __shfl_xor(send, 8); }
    y += __shfl_xor(y, 16); y += __shfl_xor(y, 32);
    return y;
}
__device__ __forceinline__ float sigmoidf_(float x) { return 1.0f / (1.0f + __expf(-x)); }
__device__ __forceinline__ float siluf_(float x) { return x / (1.0f + __expf(-x)); }
__device__ __forceinline__ float gelu_tanh(float x) {
    const float u = 0.7978845608028654f * (x + 0.044715f * x * x * x);
    return 0.5f * x * (1.0f + tanhf(u));
}
__device__ __forceinline__ float dot8(uint4 a, uint4 b, float acc) {
    acc = fmaf(bflo(a.x), bflo(b.x), acc); acc = fmaf(bfhi(a.x), bfhi(b.x), acc);
    acc = fmaf(bflo(a.y), bflo(b.y), acc); acc = fmaf(bfhi(a.y), bfhi(b.y), acc);
    acc = fmaf(bflo(a.z), bflo(b.z), acc); acc = fmaf(bfhi(a.z), bfhi(b.z), acc);
    acc = fmaf(bflo(a.w), bflo(b.w), acc); acc = fmaf(bfhi(a.w), bfhi(b.w), acc);
    return acc;
}
__device__ __forceinline__ float dotrow(const bf16_t* a, const bf16_t* b, int K) {
    float acc = 0.f;
    const uint4* a4 = (const uint4*)a; const uint4* b4 = (const uint4*)b;
    for (int k = 0; k < K / 8; ++k) acc = dot8(a4[k], b4[k], acc);
    return acc;
}

__device__ __forceinline__ int opaque_tid() { int t = threadIdx.x; asm volatile("" : "+v"(t)); return t; }
#define WSP(type, off) ((type*)(p.ws() + (off)))

template <class AF, class BF, class EF>
__device__ __forceinline__ void gemm_naive(int M, int N, int K, AF arow, BF brow, EF epi, int bid, int nb) {
    const int tidx = opaque_tid();
    const long total = (long)M * N;
    for (long idx = (long)bid * NTH + tidx; idx < total; idx += (long)nb * NTH) {
        const int m = (int)(idx / N), n = (int)(idx % N);
        const float acc = dotrow(arow(m), brow(m, n), K);
        epi(m, n, acc);
    }
}

constexpr int G_A_BYTES = 256 * 128, G_W_BYTES = 128 * 128, G_BUF = G_A_BYTES + G_W_BYTES;
constexpr int LDS_BYTES = 3 * G_BUF;
#define MFMA32(a, b, c) __builtin_amdgcn_mfma_f32_32x32x16_bf16(a, b, c, 0, 0, 0)

#define GLDS16(gptr, lptr) __builtin_amdgcn_global_load_lds((const __attribute__((address_space(1))) void*)(gptr), (__attribute__((address_space(3))) void*)(lptr), 16, 0, 0)
template <class APTR, class WPTR>
__device__ __forceinline__ void gemm_core_g(f32x16 (&acc)[2][2], APTR aptr, WPTR wptr, int nk, char* lds) {
    const int tidx = opaque_tid();
    const int tid = tidx, lane = tid & 63, wid = tid >> 6, wm = wid >> 1, wn = wid & 1, r32 = lane & 31, hi = lane >> 5;
    const int wu = __builtin_amdgcn_readfirstlane(wid);
    char* sdst = lds + wu * 1024;
    const int xoff = (wm * 64 + r32) * 128, woff = G_A_BYTES + (wn * 64 + r32) * 128, sw7 = (r32 >> 1) & 7;
    asm volatile("s_waitcnt vmcnt(0)" ::: "memory");
#pragma unroll
    for (int i = 0; i < 4; ++i) GLDS16(aptr(i, 0), sdst + i * 8192);
#pragma unroll
    for (int i = 0; i < 2; ++i) GLDS16(wptr(i, 0), sdst + G_A_BYTES + i * 8192);
    if (nk > 1) {
#pragma unroll
        for (int i = 0; i < 4; ++i) GLDS16(aptr(i, 1), sdst + G_BUF + i * 8192);
#pragma unroll
        for (int i = 0; i < 2; ++i) GLDS16(wptr(i, 1), sdst + G_BUF + G_A_BYTES + i * 8192);
        asm volatile("s_waitcnt vmcnt(6)" ::: "memory");
    } else asm volatile("s_waitcnt vmcnt(0)" ::: "memory");
    __builtin_amdgcn_s_barrier();
    int slot = 0;
    for (int kt = 0; kt < nk; ++kt) {
        const char* cur = lds + slot * G_BUF;
        const int s2 = slot >= 1 ? slot - 1 : 2;
        const bool more2 = (kt + 2 < nk);
        char* nxt = sdst + s2 * G_BUF;
#pragma unroll
        for (int ks = 0; ks < 4; ++ks) {
            const int co = ((ks * 2 + hi) ^ sw7) << 4;
            const bf16x8 x0 = *(const bf16x8*)(cur + xoff + co), x1 = *(const bf16x8*)(cur + xoff + 32 * 128 + co);
            const bf16x8 w0 = *(const bf16x8*)(cur + woff + co), w1 = *(const bf16x8*)(cur + woff + 32 * 128 + co);
            acc[0][0] = MFMA32(w0, x0, acc[0][0]); acc[0][1] = MFMA32(w0, x1, acc[0][1]);
            acc[1][0] = MFMA32(w1, x0, acc[1][0]); acc[1][1] = MFMA32(w1, x1, acc[1][1]);
            __builtin_amdgcn_sched_barrier(0);
            if (more2) {
                if (ks == 0) { GLDS16(aptr(0, kt + 2), nxt); GLDS16(aptr(1, kt + 2), nxt + 8192); }
                if (ks == 1) { GLDS16(aptr(2, kt + 2), nxt + 2 * 8192); GLDS16(aptr(3, kt + 2), nxt + 3 * 8192); }
                if (ks == 2) { GLDS16(wptr(0, kt + 2), nxt + G_A_BYTES); GLDS16(wptr(1, kt + 2), nxt + G_A_BYTES + 8192); }
            }
            __builtin_amdgcn_sched_barrier(0);
        }
        if (more2) asm volatile("s_waitcnt vmcnt(6) lgkmcnt(0)" ::: "memory");
        else asm volatile("s_waitcnt vmcnt(0) lgkmcnt(0)" ::: "memory");
        __builtin_amdgcn_s_barrier();
        slot = slot == 2 ? 0 : slot + 1;
    }
}
template <class AROW, class WROW>
__device__ __forceinline__ void gemm_core(f32x16 (&acc)[2][2], AROW arow, WROW wrow, int K, char* lds) {
    const int tidx = opaque_tid();
    const int srow = tidx >> 3, gch = (tidx & 7) ^ ((srow >> 1) & 7);
    const bf16_t* pa[4]; const bf16_t* pw[2];
#pragma unroll
    for (int i = 0; i < 4; ++i) pa[i] = arow(srow + 64 * i) + gch * 8;
#pragma unroll
    for (int i = 0; i < 2; ++i) pw[i] = wrow(srow + 64 * i) + gch * 8;
    gemm_core_g(acc, [&](int i, int kt) { return pa[i] + kt * 64; }, [&](int i, int kt) { return pw[i] + kt * 64; }, K >> 6, lds);
}
__device__ __forceinline__ void acc_zero(f32x16 (&acc)[2][2]) {
#pragma unroll
    for (int a = 0; a < 2; ++a)
#pragma unroll
        for (int b = 0; b < 2; ++b)
#pragma unroll
            for (int r = 0; r < 16; ++r) acc[a][b][r] = 0.f;
}
template <class F>
__device__ __forceinline__ void acc_visit(const f32x16 (&acc)[2][2], F f) {
    const int tidx = opaque_tid();
    const int lane = tidx & 63, wid = tidx >> 6, wm = wid >> 1, wn = wid & 1, r32 = lane & 31, hi = lane >> 5;
#pragma unroll
    for (int in = 0; in < 2; ++in)
#pragma unroll
        for (int im = 0; im < 2; ++im)
#pragma unroll
            for (int rg = 0; rg < 4; ++rg) {
                f32x4 v; v[0] = acc[in][im][4 * rg]; v[1] = acc[in][im][4 * rg + 1]; v[2] = acc[in][im][4 * rg + 2]; v[3] = acc[in][im][4 * rg + 3];
                f(wm * 64 + im * 32 + r32, wn * 64 + in * 32 + 8 * rg + 4 * hi, v);
            }
}
template <class F>
__device__ __forceinline__ void acc_visit_add(const f32x16 (&acc)[2][2], f32x16 (&tot)[2][2], F f) {
    const int tidx = opaque_tid();
    const int lane = tidx & 63, wid = tidx >> 6, wm = wid >> 1, wn = wid & 1, r32 = lane & 31, hi = lane >> 5;
#pragma unroll
    for (int in = 0; in < 2; ++in)
#pragma unroll
        for (int im = 0; im < 2; ++im)
#pragma unroll
            for (int rg = 0; rg < 4; ++rg) {
                f32x4 v; v[0] = acc[in][im][4 * rg]; v[1] = acc[in][im][4 * rg + 1]; v[2] = acc[in][im][4 * rg + 2]; v[3] = acc[in][im][4 * rg + 3];
                const f32x4 r = f(wm * 64 + im * 32 + r32, wn * 64 + in * 32 + 8 * rg + 4 * hi, v);
                tot[in][im][4 * rg] += r[0]; tot[in][im][4 * rg + 1] += r[1]; tot[in][im][4 * rg + 2] += r[2]; tot[in][im][4 * rg + 3] += r[3];
            }
}
__device__ __forceinline__ uint2 pack4(f32x4 v) { uint2 o; o.x = pack2(v[0], v[1]); o.y = pack2(v[2], v[3]); return o; }
__device__ __forceinline__ bool dense_tile(int it, int NT, bool with_ctx, int bid, int nb, int& mt, int& nt) {
    const int x = bid & 7, j = bid >> 3, jb = nb >> 3;
    int v = it * jb + j;
    if (v < 8 * NT) { mt = 1 + x * 8 + (v & 7); nt = v >> 3; return true; }
    if (!with_ctx) return false;
    v -= 8 * NT; nt = x + 8 * v; mt = 0;
    return nt < NT;
}

__device__ __forceinline__ void st_prologue(const KP& p, int bid, int nb, float* smem) {
    const int tidx = opaque_tid();
    const int tid = tidx;
    {   float2* t16 = WSP(float2, OFF_ROPE); float2* t8 = t16 + 256 * 16;
        for (int idx = bid * NTH + tid; idx < 256 * 24; idx += nb * NTH) {
            const bool big = idx < 256 * 16; const int j = big ? idx : idx - 256 * 16, half = big ? 16 : 8, pos = j / half, i = j % half;
            const float ang = (float)pos * powf(10000.0f, -(float)i / (float)half);
            float sn, cs; sincosf(ang, &sn, &cs);
            (big ? t16 : t8)[j] = make_float2(cs, sn);
        } }
    for (int k = tid; k < 1024; k += NTH) { smem[k] = siluf_(p.in(I_C)[k]); smem[1024 + k] = siluf_(p.in(I_CCTX)[k]); }
    __syncthreads();
    float* mod = WSP(float, OFF_MOD);
    float4* red = (float4*)(smem + 2048);
    for (int jb = bid; jb < 256; jb += nb) {
        const int l = jb >> 7, j0 = (jb & 127) * 48, jj = tid % 12, kk = tid / 12;
        float4 a0 = make_float4(0.f, 0.f, 0.f, 0.f), a1 = a0;
        if (kk < 42) {
            const float* w = p.in(I_WMOD) + (size_t)l * 1024 * 6144 + j0 + jj * 4;
            for (int k = kk; k < 1024; k += 42) { const float4 wv = *(const float4*)(w + (size_t)k * 6144); const float s0 = smem[k], s1 = smem[1024 + k];
                a0.x = fmaf(s0, wv.x, a0.x); a0.y = fmaf(s0, wv.y, a0.y); a0.z = fmaf(s0, wv.z, a0.z); a0.w = fmaf(s0, wv.w, a0.w);
                a1.x = fmaf(s1, wv.x, a1.x); a1.y = fmaf(s1, wv.y, a1.y); a1.z = fmaf(s1, wv.z, a1.z); a1.w = fmaf(s1, wv.w, a1.w); }
            red[(kk * 12 + jj) * 2] = a0; red[(kk * 12 + jj) * 2 + 1] = a1;
        }
        __syncthreads();
        if (tid < 24) {
            const int cj = tid >> 1, cond = tid & 1;
            float4 s = make_float4(0.f, 0.f, 0.f, 0.f);
            for (int q = 0; q < 42; ++q) { const float4 v = red[(q * 12 + cj) * 2 + cond]; s.x += v.x; s.y += v.y; s.z += v.z; s.w += v.w; }
            const float4 b = *(const float4*)(p.in(I_BMOD) + l * 6144 + j0 + cj * 4);
            s.x += b.x; s.y += b.y; s.z += b.z; s.w += b.w;
            *(float4*)(mod + (size_t)(l * 2 + cond) * 6144 + j0 + cj * 4) = s;
        }
        __syncthreads();
    }
}

template <class COLF, class KSF>
__device__ __forceinline__ void conv_t_g(const float* W, bf16_t* Wt, int K, int N, int Npad, int nmat, int bid, int nb, float* smem, COLF colf, KSF ksf) {
    const int tidx = opaque_tid();
    const int tid = tidx, tx = tid & 63, ty = tid >> 6;
    const int tn = Npad / 64, tk = K / 64;
    const int ntile = tn * tk * nmat;
    for (int t = bid; t < ntile; t += nb) {
        const int mat = t / (tn * tk), r = t % (tn * tk), n0 = (r / tk) * 64, k0 = (r % tk) * 64;
        const float* Wm = W + (size_t)mat * K * N; bf16_t* Wtm = Wt + (size_t)mat * Npad * K;
        __syncthreads();
#pragma unroll
        for (int i = 0; i < 8; ++i) { const int kk = ty + 8 * i, n = n0 + tx; smem[kk * 65 + tx] = (n < N) ? Wm[(size_t)(k0 + kk) * N + colf(n)] * ksf(k0 + kk) : 0.f; }
        __syncthreads();
#pragma unroll
        for (int i = 0; i < 8; ++i) { const int nn = ty + 8 * i; Wtm[(size_t)(n0 + nn) * K + k0 + tx] = f2bf(smem[tx * 65 + nn]); }
    }
    __syncthreads();
}
__device__ __forceinline__ void conv_t(const float* W, bf16_t* Wt, int K, int N, int Npad, int nmat, int bid, int nb, float* smem) {
    conv_t_g(W, Wt, K, N, Npad, nmat, bid, nb, smem, [](int n) { return n; }, [](int) { return 1.0f; });
}
__device__ __forceinline__ void st_conv(const KP& p, int l, int bid, int nb, float* smem) {
    const int tidx = opaque_tid(); (void)tidx;
    bf16_t* wb = WSP(bf16_t, OFF_WB);
    conv_t_g(p.in(I_WIN) + (size_t)l * 1024 * NIN, (bf16_t*)((char*)wb + WB_IN), 1024, NIN, NINP, 1, bid, nb, smem, [](int n) { return win_col_old(n); }, [](int) { return 1.0f; });
    {   const float* gcq = p.in(I_GCQ) + l * 256; const float* gckv = p.in(I_GCKV) + l * 128;
        conv_t_g(p.in(I_WUQ) + (size_t)l * 256 * 768, (bf16_t*)((char*)wb + WB_UQ), 256, 768, 768, 1, bid, nb, smem, [](int n) { return n; }, [&](int k) { return gcq[k]; });
        conv_t_g(p.in(I_WUKV) + (size_t)l * 128 * 1024, (bf16_t*)((char*)wb + WB_UKV), 128, 1024, 1024, 1, bid, nb, smem, [](int n) { return n; }, [&](int k) { return gckv[k]; }); }
    conv_t(p.in(I_WGLU) + (size_t)l * 512 * 512, (bf16_t*)((char*)wb + WB_GLU), 512, 512, 512, 1, bid, nb, smem);
    conv_t(p.in(I_WBRM) + (size_t)l * 512 * 1024, (bf16_t*)((char*)wb + WB_BR), 512, 1024, 1024, 1, bid, nb, smem);
    conv_t(p.in(I_WBRS) + (size_t)l * 512 * 1024, (bf16_t*)((char*)wb + WB_BR + (size_t)1024 * 512 * 2), 512, 1024, 1024, 1, bid, nb, smem);
    conv_t(p.in(I_WBRG) + (size_t)l * 512 * 1024, (bf16_t*)((char*)wb + WB_BR + (size_t)2 * 1024 * 512 * 2), 512, 1024, 1024, 1, bid, nb, smem);
    conv_t(p.in(I_WOUT) + (size_t)l * 1024 * 1024, (bf16_t*)((char*)wb + WB_OUT), 1024, 1024, 1024, 1, bid, nb, smem);
}
__device__ __forceinline__ void st_conv_experts(const KP& p, int l, int bid, int nb, float* smem) {
    const int tidx = opaque_tid(); (void)tidx;
    bf16_t* wb = WSP(bf16_t, OFF_WB);
    conv_t(p.in(I_WEG) + (size_t)l * 16 * 1024 * 512, (bf16_t*)((char*)wb + WB_EG), 1024, 512, 512, 16, bid, nb, smem);
    conv_t(p.in(I_WEU) + (size_t)l * 16 * 1024 * 512, (bf16_t*)((char*)wb + WB_EU), 1024, 512, 512, 16, bid, nb, smem);
    conv_t(p.in(I_WED) + (size_t)l * 16 * 512 * 1024, (bf16_t*)((char*)wb + WB_ED), 512, 1024, 1024, 16, bid, nb, smem);
}

__device__ __forceinline__ const float* xrow_c(const KP& p, int r) { return (r < LC) ? (WSP(float, OFF_XC) + (size_t)r * D) : (p.out() + (size_t)(r - LC) * D); }
__device__ __forceinline__ const float* xrow_in(const KP& p, int r) { return (r < LC) ? (p.in(I_CTX) + (size_t)r * D) : (p.in(I_X) + (size_t)(r - LC) * D); }
__device__ __forceinline__ float* xrow(const KP& p, int r) { return (r < LC) ? (WSP(float, OFF_XC) + (size_t)r * D) : (p.out() + (size_t)(r - LC) * D); }
__device__ __forceinline__ void st_modulate(const KP& p, int l, int bid, int nb) {
    const int tidx = opaque_tid();
    const int lane = tidx & 63, wid = tidx >> 6;
    bf16_t* Hb = WSP(bf16_t, OFF_H);
    const float* g = p.in(I_GPREMIX) + l * D;
    for (int r = bid * NWV + wid; r < T; r += nb * NWV) {
        const float* xr = l == 0 ? xrow_in(p, r) : xrow_c(p, r);
        const float* md = WSP(float, OFF_MOD) + (size_t)(l * 2 + (r < LC ? 1 : 0)) * 6144;
        float4 v[4]; float ss = 0.f;
#pragma unroll
        for (int i = 0; i < 4; ++i) { v[i] = *(const float4*)(xr + i * 256 + lane * 4); ss += v[i].x * v[i].x + v[i].y * v[i].y + v[i].z * v[i].z + v[i].w * v[i].w; }
        ss = wave_sum(ss);
        const float rstd = rsqrtf(ss * (1.0f / D) + EPS);
#pragma unroll
        for (int i = 0; i < 4; ++i) {
            const int c = i * 256 + lane * 4;
            const float4 gg = *(const float4*)(g + c), sh = *(const float4*)(md + c), sc = *(const float4*)(md + 1024 + c);
            const float h0 = v[i].x * rstd * gg.x * (1.f + sc.x) + sh.x, h1 = v[i].y * rstd * gg.y * (1.f + sc.y) + sh.y;
            const float h2 = v[i].z * rstd * gg.z * (1.f + sc.z) + sh.z, h3 = v[i].w * rstd * gg.w * (1.f + sc.w) + sh.w;
            uint2 o; o.x = pack2(h0, h1); o.y = pack2(h2, h3);
            *(uint2*)(Hb + (size_t)r * D + c) = o;
        }
    }
}

__device__ __forceinline__ void st_gemm_in(const KP& p, int l, int bid, int nb, char* lds) {
    const int tidx = opaque_tid();
    if (bid == 0 && tidx < 8) WSP(unsigned, OFF_CNT)[32 + tidx] = 0u;
    const bf16_t* Hb = WSP(bf16_t, OFF_H); const bf16_t* Wt = WSP(bf16_t, OFF_WB + WB_IN); bf16_t* P = WSP(bf16_t, OFF_P);
    float* ssq = WSP(float, OFF_SSQ); const float2* t16 = WSP(float2, OFF_ROPE); const float2* t8 = t16 + 256 * 16;
    const float* gqn = p.in(I_GQN) + l * 64; const float* gkn = p.in(I_GKN) + l * 64;
    const int lane = tidx & 63, wid = tidx >> 6, wm = wid >> 1, wn = wid & 1, r32 = lane & 31, hi = lane >> 5;
    int mt, nt;
    for (int it = 0; dense_tile(it, NINP / 128, true, bid, nb, mt, nt); ++it) {
        f32x16 acc[2][2]; acc_zero(acc);
        gemm_core(acc, [&](int r) { return Hb + (size_t)(mt * 256 + r) * 1024; }, [&](int r) { return Wt + (size_t)(nt * 128 + r) * 1024; }, 1024, lds);
#pragma unroll
        for (int im = 0; im < 2; ++im) {
            const int row = mt * 256 + wm * 64 + im * 32 + r32;
            bf16_t* prow_ = P + (size_t)row * NIN + nt * 128 + wn * 64 + 4 * hi;
            const bool lat = row >= LC; const int tpos = row - LC, prow = lat ? (tpos >> 6) : 0, pcol = lat ? (tpos & 63) : 0;
            float v[2][16];
#pragma unroll
            for (int in = 0; in < 2; ++in)
#pragma unroll
                for (int r = 0; r < 16; ++r) v[in][r] = acc[in][im][r];
            if (nt <= 4) {
                float ss = 0.f;
#pragma unroll
                for (int in = 0; in < 2; ++in)
#pragma unroll
                    for (int r = 0; r < 16; ++r) ss = fmaf(v[in][r], v[in][r], ss);
                ss = xhalf_sum(ss);
                const float sc = rsqrtf(ss * (1.0f / 64.0f) + EPS) * (nt < 4 ? SC_GQA : 1.0f);
                const float* gg = (nt < 4 ? gqn : gkn) + 4 * hi;
#pragma unroll
                for (int in = 0; in < 2; ++in)
#pragma unroll
                    for (int rg = 0; rg < 4; ++rg) { const float4 g4 = *(const float4*)(gg + in * 32 + 8 * rg);
                        v[in][4 * rg] *= sc * g4.x; v[in][4 * rg + 1] *= sc * g4.y; v[in][4 * rg + 2] *= sc * g4.z; v[in][4 * rg + 3] *= sc * g4.w; }
                if (lat) {
#pragma unroll
                    for (int in = 0; in < 2; ++in)
#pragma unroll
                        for (int rg = 0; rg < 2; ++rg) { const float4* cs = (const float4*)(t16 + (in == 0 ? prow : pcol) * 16 + 8 * rg + 4 * hi);
                            const float4 c01 = cs[0], c23 = cs[1];
                            rope_tab(v[in][4 * rg], v[in][4 * rg + 8], make_float2(c01.x, c01.y)); rope_tab(v[in][4 * rg + 1], v[in][4 * rg + 9], make_float2(c01.z, c01.w));
                            rope_tab(v[in][4 * rg + 2], v[in][4 * rg + 10], make_float2(c23.x, c23.y)); rope_tab(v[in][4 * rg + 3], v[in][4 * rg + 11], make_float2(c23.z, c23.w)); }
                }
            } else if (nt >= 6 && nt <= 8) {
                float ss = 0.f;
#pragma unroll
                for (int in = 0; in < 2; ++in)
#pragma unroll
                    for (int r = 0; r < 16; ++r) ss = fmaf(v[in][r], v[in][r], ss);
                ss = xhalf_sum(ss);
                if (hi == 0) ssq[(size_t)row * 8 + (nt - 6) * 2 + wn] = ss;
            } else if (nt == 9 && wn == 0 && lat) {
#pragma unroll
                for (int hlf = 0; hlf < 2; ++hlf) { const float4* cs = (const float4*)(t8 + (hlf == 0 ? prow : pcol) * 8 + 4 * hi);
                    const float4 c01 = cs[0], c23 = cs[1];
                    rope_tab(v[0][8 * hlf], v[0][8 * hlf + 4], make_float2(c01.x, c01.y)); rope_tab(v[0][8 * hlf + 1], v[0][8 * hlf + 5], make_float2(c01.z, c01.w));
                    rope_tab(v[0][8 * hlf + 2], v[0][8 * hlf + 6], make_float2(c23.x, c23.y)); rope_tab(v[0][8 * hlf + 3], v[0][8 * hlf + 7], make_float2(c23.z, c23.w)); }
            }
#pragma unroll
            for (int in = 0; in < 2; ++in)
#pragma unroll
                for (int rg = 0; rg < 4; ++rg) {
                    const int n = nt * 128 + wn * 64 + in * 32 + 8 * rg + 4 * hi;
                    if (n < NIN) { uint2 o; o.x = pack2(v[in][4 * rg], v[in][4 * rg + 1]); o.y = pack2(v[in][4 * rg + 2], v[in][4 * rg + 3]); *(uint2*)(prow_ + in * 32 + 8 * rg) = o; }
                }
        }
    }
}

__device__ __forceinline__ void rope_pair(float& a, float& b, int pos, int i, int half) {
    const float freq = powf(10000.0f, -(float)i / (float)half);
    const float ang = (float)pos * freq;
    float sn, cs; sincosf(ang, &sn, &cs);
    const float na = a * cs - b * sn, nb_ = a * sn + b * cs; a = na; b = nb_;
}

constexpr int S5C = 64, NCH = T / S5C;
constexpr size_t S5_ZERO = OFF_WB + WB_EG;
constexpr size_t S5_KTAB = S5_ZERO + 256;
constexpr size_t S5_FTAB = S5_KTAB + (size_t)64 * 64 * 256 * 2;
constexpr size_t S5_GTAB = S5_FTAB + (size_t)64 * 128 * 1024 * 2;
constexpr size_t S5_SINB = S5_GTAB + (size_t)64 * 1024 * 128 * 2;
static_assert(S5_SINB + (size_t)NCH * 64 * 128 * 2 <= OFF_WB + WB_BYTES, "s5 tables overlay");
__device__ __forceinline__ int s5_row(int dir, int j) { return dir == 0 ? j : (j < LC ? LC - 1 - j : T + LC - 1 - j); }
__device__ __forceinline__ void s5_consts(const KP& p, int l, int dir, int g, int lane, float& lr, float& li, float (&bbr)[16], float (&bbi)[16]) {
    const int gi = (l * 2 + dir) * 32 + g, pi = gi * 64 + lane;
    const float are = p.in(I_ARE)[pi], aim = p.in(I_AIM)[pi], dt = expf(p.in(I_LOGDT)[gi]);
    const float mag = expf(are * dt); float sn, cs; sincosf(aim * dt, &sn, &cs);
    lr = mag * cs; li = mag * sn; const float den = are * are + aim * aim;
    const float cr = ((lr - 1.0f) * are + li * aim) / den, ci = (li * are - (lr - 1.0f) * aim) / den;
    const float4* br4 = (const float4*)(p.in(I_BRE) + (size_t)pi * 16); const float4* bi4 = (const float4*)(p.in(I_BIM) + (size_t)pi * 16);
#pragma unroll
    for (int q = 0; q < 4; ++q) { const float4 br = br4[q], bi = bi4[q];
        bbr[4 * q] = cr * br.x - ci * bi.x; bbi[4 * q] = cr * bi.x + ci * br.x; bbr[4 * q + 1] = cr * br.y - ci * bi.y; bbi[4 * q + 1] = cr * bi.y + ci * br.y;
        bbr[4 * q + 2] = cr * br.z - ci * bi.z; bbi[4 * q + 2] = cr * bi.z + ci * br.z; bbr[4 * q + 3] = cr * br.w - ci * bi.w; bbi[4 * q + 3] = cr * bi.w + ci * br.w; }
}
__device__ __forceinline__ void s5_unpack(uint4 a, uint4 b, float (&u)[16]) {
    u[0] = bflo(a.x); u[1] = bfhi(a.x); u[2] = bflo(a.y); u[3] = bfhi(a.y); u[4] = bflo(a.z); u[5] = bfhi(a.z); u[6] = bflo(a.w); u[7] = bfhi(a.w);
    u[8] = bflo(b.x); u[9] = bfhi(b.x); u[10] = bflo(b.y); u[11] = bfhi(b.y); u[12] = bflo(b.z); u[13] = bfhi(b.z); u[14] = bflo(b.w); u[15] = bfhi(b.w);
}
__device__ __forceinline__ void st_s5_local(const KP& p, int l, int bid, int nb) {
    const int tidx = opaque_tid();
    const int lane = tidx & 63, wid = tidx >> 6;
    const bf16_t* P = WSP(bf16_t, OFF_P); float2* F = WSP(float2, OFF_S5);
    const int gw = bid * NWV + wid, nw = nb * NWV;
    if (gw >= (nw / 64) * 64) return;
    const int gd = gw & 63, dir = gd >> 5, g = gd & 31, part = gw >> 6, nparts = nw >> 6;
    if (part >= 4) return;
    float lr, li, bbr[16], bbi[16]; s5_consts(p, l, dir, g, lane, lr, li, bbr, bbi);
    for (int c = part; c < 4; c += nparts) {
        float sr = 0.f, si = 0.f;
        for (int j0 = 0; j0 < S5C; j0 += 8) {
            uint4 ua[8], ub[8];
#pragma unroll
            for (int q = 0; q < 8; ++q) { const int r = s5_row(dir, c * S5C + j0 + q); const uint4* up = (const uint4*)(P + (size_t)r * NIN + C_SSM + g * 16); ua[q] = up[0]; ub[q] = up[1]; }
#pragma unroll
            for (int q = 0; q < 8; ++q) { float u[16]; s5_unpack(ua[q], ub[q], u);
                float bur = 0.f, bui = 0.f;
#pragma unroll
                for (int cc = 0; cc < 16; ++cc) { bur = fmaf(bbr[cc], u[cc], bur); bui = fmaf(bbi[cc], u[cc], bui); }
                const float nsr = lr * sr - li * si + bur, nsi = lr * si + li * sr + bui; sr = nsr; si = nsi; }
        }
        F[((size_t)(c * 2 + dir) * 32 + g) * 64 + lane] = make_float2(sr, si);
    }
}
__device__ __forceinline__ void st_s5_carry(const KP& p, int l, int bid, int nb) {
    const int tidx = opaque_tid();
    float2* F = WSP(float2, OFF_S5);
    const int idx = bid * NTH + tidx;
    if (idx >= 4096) return;
    const int gi = l * 64 + (idx >> 6);
    const float are = p.in(I_ARE)[gi * 64 + (idx & 63)], aim = p.in(I_AIM)[gi * 64 + (idx & 63)], dt = expf(p.in(I_LOGDT)[gi]);
    const float mag = expf(are * dt); float sn, cs; sincosf(aim * dt, &sn, &cs);
    float pr = mag * cs, pi_ = mag * sn;
#pragma unroll
    for (int q = 0; q < 6; ++q) { const float nr = pr * pr - pi_ * pi_, ni = 2.f * pr * pi_; pr = nr; pi_ = ni; }
    float sr = 0.f, si = 0.f;
    for (int c0 = 0; c0 < NCH; c0 += 20) {
        float2 f[20];
#pragma unroll
        for (int q = 0; q < 20; ++q) f[q] = F[(size_t)(c0 + q) * 4096 + idx];
#pragma unroll
        for (int q = 0; q < 20; ++q) { F[(size_t)(c0 + q) * 4096 + idx] = make_float2(sr, si);
            { bf16_t* sb = WSP(bf16_t, S5_SINB) + ((size_t)(c0 + q) * 64 + (idx >> 6)) * 128 + (idx & 63); sb[0] = f2bf(sr); sb[64] = f2bf(si); }
            const float nr = pr * sr - pi_ * si + f[q].x, ni = pr * si + pi_ * sr + f[q].y; sr = nr; si = ni; }
    }
}
__device__ __forceinline__ void st_s5_scan(const KP& p, int l, int bid, int nb) {
    const int tidx = opaque_tid();
    const int lane = tidx & 63, wid = tidx >> 6;
    const bf16_t* P = WSP(bf16_t, OFF_P); const float2* F = WSP(float2, OFF_S5);
    const int gw = bid * NWV + wid, nw = nb * NWV;
    if (gw >= (nw / 64) * 64) return;
    const int gd = gw & 63, dir = gd >> 5, g = gd & 31, part = gw >> 6, nparts = nw >> 6;
    if (part >= 4) return;
    float* Yo = dir == 0 ? WSP(float, OFF_OM) : WSP(float, OFF_H);
    float lr, li, bbr[16], bbi[16]; s5_consts(p, l, dir, g, lane, lr, li, bbr, bbi);
    const int gi = (l * 2 + dir) * 32 + g;
    float cre[16], cim[16];
#pragma unroll
    for (int cc = 0; cc < 16; ++cc) { cre[cc] = p.in(I_CRE)[((size_t)gi * 16 + cc) * 64 + lane]; cim[cc] = p.in(I_CIM)[((size_t)gi * 16 + cc) * 64 + lane]; }
    const float dsk = p.in(I_SSMD)[l * 512 + g * 16 + (lane & 15)];
    for (int c = part; c < 4; c += nparts) {
        const float2 s0 = F[((size_t)(c * 2 + dir) * 32 + g) * 64 + lane];
        float sr = s0.x, si = s0.y;
        for (int j0 = 0; j0 < S5C; j0 += 8) {
            uint4 ua[8], ub[8];
#pragma unroll
            for (int q = 0; q < 8; ++q) { const int r = s5_row(dir, c * S5C + j0 + q); const uint4* up = (const uint4*)(P + (size_t)r * NIN + C_SSM + g * 16); ua[q] = up[0]; ub[q] = up[1]; }
#pragma unroll
            for (int q = 0; q < 8; ++q) { const int r = s5_row(dir, c * S5C + j0 + q);
                float u[16]; s5_unpack(ua[q], ub[q], u);
                float bur = 0.f, bui = 0.f;
#pragma unroll
                for (int cc = 0; cc < 16; ++cc) { bur = fmaf(bbr[cc], u[cc], bur); bui = fmaf(bbi[cc], u[cc], bui); }
                const float nsr = lr * sr - li * si + bur, nsi = lr * si + li * sr + bui; sr = nsr; si = nsi;
                float t16[16];
#pragma unroll
                for (int cc = 0; cc < 16; ++cc) t16[cc] = cre[cc] * sr - cim[cc] * si;
                float y = transpose_reduce16(t16, lane);
                if (lane < 16) {
                    if (dir == 0) y += dsk * bf2f(P[(size_t)r * NIN + C_SSM + g * 16 + lane]);
                    Yo[(size_t)r * 512 + g * 16 + lane] = y; }
            }
        }
    }
}

__device__ __forceinline__ void st_s5_tables(const KP& p, int l, int bid, int nb, char* lds) {
    const int tidx = opaque_tid();
    float* pwr = (float*)lds; float* pwi = pwr + 65 * 64; float* bbr = pwi + 65 * 64; float* bbi = bbr + 1024; float* cre = bbi + 1024; float* cim = cre + 1024;
    bf16_t* Ktab = WSP(bf16_t, S5_KTAB); bf16_t* Ftab = WSP(bf16_t, S5_FTAB); bf16_t* Gtab = WSP(bf16_t, S5_GTAB);
    if (bid == 0 && tidx < 64) WSP(unsigned, S5_ZERO)[tidx] = 0u;
    for (int item = bid; item < 256; item += nb) {
        const int gd = item >> 2, q = item & 3, dir = gd >> 5, g = gd & 31, gi = (l * 2 + dir) * 32 + g;
        __syncthreads();
        if (tidx < 64) {
            const int pp = tidx, pi = gi * 64 + pp;
            const float are = p.in(I_ARE)[pi], aim = p.in(I_AIM)[pi], dt = expf(p.in(I_LOGDT)[gi]);
            const float mag = expf(are * dt); float sn, cs; sincosf(aim * dt, &sn, &cs);
            const float lr = mag * cs, li = mag * sn, den = are * are + aim * aim;
            const float cr = ((lr - 1.0f) * are + li * aim) / den, ci = (li * are - (lr - 1.0f) * aim) / den;
            for (int c = 0; c < 16; ++c) { const float br = p.in(I_BRE)[(size_t)pi * 16 + c], bi = p.in(I_BIM)[(size_t)pi * 16 + c];
                bbr[pp * 16 + c] = cr * br - ci * bi; bbi[pp * 16 + c] = cr * bi + ci * br; }
            float ar = 1.f, ai = 0.f;
            for (int n = 0; n <= 64; ++n) { pwr[n * 64 + pp] = ar; pwi[n * 64 + pp] = ai; const float nr = ar * lr - ai * li, ni = ar * li + ai * lr; ar = nr; ai = ni; }
        } else {
            for (int i = tidx - 64; i < 1024; i += NTH - 64) { cre[i] = p.in(I_CRE)[(size_t)gi * 1024 + i]; cim[i] = p.in(I_CIM)[(size_t)gi * 1024 + i]; }
        }
        __syncthreads();
        for (int e = 0; e < 8; ++e) {
            const int idx = tidx + NTH * e, tau = 16 * q + (idx >> 8), c = (idx >> 4) & 15, c2 = idx & 15;
            float s = 0.f;
            for (int pp = 0; pp < 64; ++pp) {
                const float xr = cre[c * 64 + pp], xi = cim[c * 64 + pp], wr = pwr[tau * 64 + pp], wi = pwi[tau * 64 + pp];
                const float zr = xr * wr - xi * wi, zi = xr * wi + xi * wr;
                s += zr * bbr[pp * 16 + c2] - zi * bbi[pp * 16 + c2];
            }
            Ktab[(((size_t)gd * 64 + tau) * 16 + c) * 16 + c2] = f2bf(s);
        }
        for (int e = 0; e < 32; ++e) {
            const int idx2 = tidx + NTH * e, n = 32 * q + (idx2 >> 9), k = (idx2 & 511) * 2, pp = n & 63, comp = n >> 6, i = k >> 4, c2 = k & 15;
            const float wr = pwr[(63 - i) * 64 + pp], wi = pwi[(63 - i) * 64 + pp];
            const float b0r = bbr[pp * 16 + c2], b0i = bbi[pp * 16 + c2], b1r = bbr[pp * 16 + c2 + 1], b1i = bbi[pp * 16 + c2 + 1];
            const float v0 = comp ? (wr * b0i + wi * b0r) : (wr * b0r - wi * b0i), v1 = comp ? (wr * b1i + wi * b1r) : (wr * b1r - wi * b1i);
            *(unsigned*)(Ftab + ((size_t)gd * 128 + n) * 1024 + k) = pack2(v0, v1);
        }
        for (int e = 0; e < 32; ++e) {
            const int idx2 = tidx + NTH * e, row = 256 * q + (idx2 >> 6), n = (idx2 & 63) * 2, t = row >> 4, c = row & 15, comp = n >> 6, pp = n & 63;
            float v[2];
#pragma unroll
            for (int h = 0; h < 2; ++h) { const float xr = cre[c * 64 + pp + h], xi = cim[c * 64 + pp + h], wr = pwr[(t + 1) * 64 + pp + h], wi = pwi[(t + 1) * 64 + pp + h];
                v[h] = comp ? -(xr * wi + xi * wr) : (xr * wr - xi * wi); }
            *(unsigned*)(Gtab + ((size_t)gd * 1024 + row) * 128 + n) = pack2(v[0], v[1]);
        }
    }
    __syncthreads();
}
__device__ __forceinline__ void st_s5_fgemm(const KP& p, int bid, int nb, char* lds) {
    const int tidx = opaque_tid();
    const bf16_t* P = WSP(bf16_t, OFF_P); const bf16_t* Ftab = WSP(bf16_t, S5_FTAB); float* F = WSP(float, OFF_S5);
    const int srow = tidx >> 3, gch = (tidx & 7) ^ ((srow >> 1) & 7);
    for (int gd = bid; gd < 64; gd += nb) {
        const int dir = gd >> 5, g = gd & 31;
        f32x16 acc[2][2]; acc_zero(acc);
        gemm_core_g(acc,
            [&](int i, int kt) { const int m = srow + 64 * i, tok = kt * 4 + (gch >> 1); return P + (size_t)s5_row(dir, 64 * (4 + m) + tok) * NIN + C_SSM + 16 * g + 8 * (gch & 1); },
            [&](int i, int kt) { return Ftab + ((size_t)gd * 128 + srow + 64 * i) * 1024 + kt * 64 + gch * 8; }, 16, lds);
        acc_visit(acc, [&](int ml, int nl, f32x4 v) {
            float* dst = F + (((size_t)(4 + ml) * 2 + dir) * 32 + g) * 128 + (nl & 63) * 2 + (nl >> 6);
            dst[0] = v[0]; dst[2] = v[1]; dst[4] = v[2]; dst[6] = v[3]; });
    }
}
__device__ __forceinline__ void st_s5_ygemm(const KP& p, int l, int bid, int nb, char* lds) {
    const int tidx = opaque_tid();
    const bf16_t* P = WSP(bf16_t, OFF_P); const bf16_t* Ktab = WSP(bf16_t, S5_KTAB); const bf16_t* Gtab = WSP(bf16_t, S5_GTAB);
    const bf16_t* Sinb = WSP(bf16_t, S5_SINB); const bf16_t* Zero = WSP(bf16_t, S5_ZERO); bf16_t* Y1 = WSP(bf16_t, OFF_OS);
    const int srow = tidx >> 3, gch = (tidx & 7) ^ ((srow >> 1) & 7);
    for (int u = bid; u < 256; u += nb) {
        const int g = u >> 3, nt = u & 7;
        f32x16 acc[2][2]; acc_zero(acc);
        {   const int gd = g, nkt = 2 * (nt + 1);
            gemm_core_g(acc,
                [&](int i, int kt) { const int m = srow + 64 * i;
                    if (kt < nkt) { const int tok = kt * 4 + (gch >> 1); return P + (size_t)(64 * (4 + m) + tok) * NIN + C_SSM + 16 * g + 8 * (gch & 1); }
                    return Sinb + ((size_t)(4 + m) * 64 + gd) * 128 + (kt - nkt) * 64 + gch * 8; },
                [&](int i, int kt) { const int n = nt * 128 + srow + 64 * i, t = n >> 4, c = n & 15;
                    if (kt < nkt) { const int tau = t - (kt * 4 + (gch >> 1)); return tau >= 0 ? Ktab + (((size_t)gd * 64 + tau) * 16 + c) * 16 + 8 * (gch & 1) : Zero; }
                    return Gtab + ((size_t)gd * 1024 + n) * 128 + (kt - nkt) * 64 + gch * 8; }, nkt + 2, lds); }
        {   const int gd = 32 + g, nkt = 2 * (8 - nt);
            gemm_core_g(acc,
                [&](int i, int kt) { const int m = srow + 64 * i, cx = 259 - m;
                    if (kt < nkt) { const int tok = kt * 4 + (gch >> 1); return P + (size_t)(T + LC - 1 - (64 * cx + tok)) * NIN + C_SSM + 16 * g + 8 * (gch & 1); }
                    return Sinb + ((size_t)cx * 64 + gd) * 128 + (kt - nkt) * 64 + gch * 8; },
                [&](int i, int kt) { const int n = nt * 128 + srow + 64 * i, t = 63 - (n >> 4), c = n & 15;
                    if (kt < nkt) { const int tau = t - (kt * 4 + (gch >> 1)); return tau >= 0 ? Ktab + (((size_t)gd * 64 + tau) * 16 + c) * 16 + 8 * (gch & 1) : Zero; }
                    return Gtab + ((size_t)gd * 1024 + t * 16 + c) * 128 + (kt - nkt) * 64 + gch * 8; }, nkt + 2, lds); }
        acc_visit(acc, [&](int ml, int nl, f32x4 v) {
            const int n = nt * 128 + nl, t = n >> 4, c0 = n & 15, r = 64 * (4 + ml) + t;
            const float4 dsk = *(const float4*)(p.in(I_SSMD) + l * 512 + g * 16 + c0); const uint2 ur = *(const uint2*)(P + (size_t)r * NIN + C_SSM + g * 16 + c0);
            uint2 o; o.x = pack2(gelu_tanh(v[0] + dsk.x * bflo(ur.x)), gelu_tanh(v[1] + dsk.y * bfhi(ur.x))); o.y = pack2(gelu_tanh(v[2] + dsk.z * bflo(ur.y)), gelu_tanh(v[3] + dsk.w * bfhi(ur.y)));
            *(uint2*)(Y1 + (size_t)r * 512 + g * 16 + c0) = o; });
    }
}
__device__ __forceinline__ void st_s5_ctx_y(const KP& p, int l, int bid, int nb) {
    const int tidx = opaque_tid();
    const bf16_t* P = WSP(bf16_t, OFF_P); const bf16_t* Ktab = WSP(bf16_t, S5_KTAB); const bf16_t* Gtab = WSP(bf16_t, S5_GTAB);
    const float* SIN = WSP(float, OFF_S5); bf16_t* Y1 = WSP(bf16_t, OFF_OS);
    for (int idx = bid * NTH + tidx; idx < 32 * 256 * 16; idx += nb * NTH) {
        const int ch = idx & 15, r = (idx >> 4) & 255, g = idx >> 12;
        float y = p.in(I_SSMD)[l * 512 + g * 16 + ch] * bf2f(P[(size_t)r * NIN + C_SSM + g * 16 + ch]);
#pragma unroll 1
        for (int dir = 0; dir < 2; ++dir) {
            const int gd = dir * 32 + g, j = dir == 0 ? r : (LC - 1 - r), cx = j >> 6, t = j & 63;
            const bf16_t* kt_ = Ktab + ((size_t)gd * 64 * 16 + ch) * 16;
            float a = 0.f;
            for (int i = 0; i <= t; ++i) {
                const int jr = 64 * cx + i, rr = dir == 0 ? jr : (LC - 1 - jr);
                const uint4* up = (const uint4*)(P + (size_t)rr * NIN + C_SSM + g * 16); const uint4* kp = (const uint4*)(kt_ + (size_t)(t - i) * 256);
                a = dot8(up[0], kp[0], a); a = dot8(up[1], kp[1], a);
            }
            const bf16_t* gp = Gtab + ((size_t)gd * 1024 + t * 16 + ch) * 128; const float* sp = SIN + (((size_t)cx * 2 + dir) * 32 + g) * 128;
            for (int q = 0; q < 64; q += 2) { const unsigned gre = *(const unsigned*)(gp + q), gim = *(const unsigned*)(gp + 64 + q); const float4 s4 = *(const float4*)(sp + 2 * q);
                a = fmaf(bflo(gre), s4.x, a); a = fmaf(bflo(gim), s4.y, a); a = fmaf(bfhi(gre), s4.z, a); a = fmaf(bfhi(gim), s4.w, a); }
            y += a;
        }
        Y1[(size_t)r * 512 + g * 16 + ch] = f2bf(gelu_tanh(y));
    }
}
__device__ __forceinline__ void st_s5_fin(const KP& p, int bid, int nb) {
    const int tidx = opaque_tid();
    const float* Yf = WSP(float, OFF_OM); const float* Yb = WSP(float, OFF_H); bf16_t* P = WSP(bf16_t, OFF_P);
    for (long idx = (long)bid * NTH + tidx; idx < (long)T * 512; idx += (long)nb * NTH) {
        const int r = (int)(idx >> 9), c = (int)(idx & 511);
        P[(size_t)r * NIN + C_SSM + c] = f2bf(gelu_tanh(Yf[idx] + Yb[idx]));
    }
}

template <int SET>
__device__ __forceinline__ void st_proj2(const KP& p, int l, int bid, int nb, char* lds) {
    const int tidx = opaque_tid();
    bf16_t* P = WSP(bf16_t, OFF_P);
    const bf16_t* Wuq = WSP(bf16_t, OFF_WB + WB_UQ); bf16_t* Qm = WSP(bf16_t, OFF_H);
    const bf16_t* Wukv = WSP(bf16_t, OFF_WB + WB_UKV); bf16_t* Kn = WSP(bf16_t, OFF_KN); bf16_t* Vm = WSP(bf16_t, OFF_V);
    const bf16_t* Wglu = WSP(bf16_t, OFF_WB + WB_GLU); bf16_t* Os = WSP(bf16_t, OFF_OS); const float* bg = p.in(I_BGLU) + l * 512;
    int mt, ntv;
    for (int it = 0; dense_tile(it, SET == 0 ? 14 : 4, true, bid, nb, mt, ntv); ++it) {
        if (SET == 1) ntv += 14;
        const int which = ntv < 6 ? 0 : (ntv < 14 ? 1 : 2), nt = ntv - (which == 0 ? 0 : (which == 1 ? 6 : 14));
        const int K = which == 0 ? 256 : (which == 1 ? 128 : 512);
        const bf16_t* abase = which == 2 ? (const bf16_t*)Os + (size_t)mt * 256 * 512 : P + (size_t)mt * 256 * NIN + (which == 0 ? C_CQ : C_CKV);
        const int apitch = which == 2 ? 512 : NIN;
        const bf16_t* wbase = (which == 0 ? Wuq : (which == 1 ? Wukv : Wglu)) + (size_t)nt * 128 * K;
        f32x16 acc[2][2]; acc_zero(acc);
        gemm_core(acc, [&](int r) { return abase + (size_t)r * apitch; }, [&](int r) { return wbase + (size_t)r * K; }, K, lds);
        if (which == 0) {
            const float* ssq = WSP(float, OFF_SSQ); const float2* t8 = WSP(float2, OFF_ROPE) + 256 * 16;
            const int lane_ = tidx & 63, wid_ = tidx >> 6, wm_ = wid_ >> 1, wn_ = wid_ & 1, r32_ = lane_ & 31, hi_ = lane_ >> 5;
#pragma unroll
            for (int im = 0; im < 2; ++im) {
                const int row = mt * 256 + wm_ * 64 + im * 32 + r32_;
                const float4 s4 = *(const float4*)(ssq + (size_t)row * 8);
                const float sc = rsqrtf(((s4.x + s4.y) + (s4.z + s4.w)) * (1.0f / 256.0f) + EPS) * SC_MLA;
                const bool lat = row >= LC; const int tpos = row - LC, prow = lat ? (tpos >> 6) : 0, pcol = lat ? (tpos & 63) : 0;
#pragma unroll
                for (int in = 0; in < 2; ++in) {
                    float v[16];
#pragma unroll
                    for (int r = 0; r < 16; ++r) v[r] = acc[in][im][r] * sc;
                    if (lat && ((nt * 4 + wn_ * 2 + in) % 3) == 2) {
#pragma unroll
                        for (int hlf = 0; hlf < 2; ++hlf) { const float4* cs = (const float4*)(t8 + (hlf == 0 ? prow : pcol) * 8 + 4 * hi_);
                            const float4 c01 = cs[0], c23 = cs[1];
                            rope_tab(v[8 * hlf], v[8 * hlf + 4], make_float2(c01.x, c01.y)); rope_tab(v[8 * hlf + 1], v[8 * hlf + 5], make_float2(c01.z, c01.w));
                            rope_tab(v[8 * hlf + 2], v[8 * hlf + 6], make_float2(c23.x, c23.y)); rope_tab(v[8 * hlf + 3], v[8 * hlf + 7], make_float2(c23.z, c23.w)); }
                    }
#pragma unroll
                    for (int rg = 0; rg < 4; ++rg) { uint2 o; o.x = pack2(v[4 * rg], v[4 * rg + 1]); o.y = pack2(v[4 * rg + 2], v[4 * rg + 3]);
                        *(uint2*)(Qm + (size_t)row * 768 + nt * 128 + wn_ * 64 + in * 32 + 8 * rg + 4 * hi_) = o; }
                }
            }
        } else if (which == 1) {
            const float* ssq = WSP(float, OFF_SSQ);
            acc_visit(acc, [&](int ml, int nl, f32x4 v) {
                const float2 s2 = *(const float2*)(ssq + (size_t)(mt * 256 + ml) * 8 + 4);
                const float sc = rsqrtf((s2.x + s2.y) * (1.0f / 128.0f) + EPS);
                bf16_t* dst = (nl < 64) ? (Kn + (size_t)(mt * 256 + ml) * 512 + nt * 64 + nl) : (Vm + (size_t)(mt * 256 + ml) * 512 + nt * 64 + nl - 64);
                *(uint2*)dst = pack4(v * sc); });
        } else {
            acc_visit(acc, [&](int ml, int nl, f32x4 v) {
                const int n = nt * 128 + nl;
                const uint2 yr = *(const uint2*)(Os + (size_t)(mt * 256 + ml) * 512 + n); const float4 b4 = *(const float4*)(bg + n);
                uint2 o; o.x = pack2(bflo(yr.x) * sigmoidf_(v[0] + b4.x), bfhi(yr.x) * sigmoidf_(v[1] + b4.y));
                o.y = pack2(bflo(yr.y) * sigmoidf_(v[2] + b4.z), bfhi(yr.y) * sigmoidf_(v[3] + b4.w));
                *(uint2*)(P + (size_t)(mt * 256 + ml) * NIN + C_SSM + n) = o; });
        }
    }
}
__device__ __forceinline__ void st_ropeq(const KP& p, int bid, int nb, char* lds) {
    const int tidx = opaque_tid();
    {   const int lane = tidx & 63, wid = tidx >> 6;
        const bf16_t* Kn = WSP(bf16_t, OFF_KN); const bf16_t* P = WSP(bf16_t, OFF_P);
        float runmax = 0.f;
        for (int r = bid * NWV + wid; r < T; r += nb * NWV) {
            const uint4 kv = *(const uint4*)(Kn + (size_t)r * 512 + lane * 8);
            float s = bflo(kv.x) * bflo(kv.x) + bfhi(kv.x) * bfhi(kv.x) + bflo(kv.y) * bflo(kv.y) + bfhi(kv.y) * bfhi(kv.y)
                    + bflo(kv.z) * bflo(kv.z) + bfhi(kv.z) * bfhi(kv.z) + bflo(kv.w) * bflo(kv.w) + bfhi(kv.w) * bfhi(kv.w);
            s += __shfl_xor(s, 1); s += __shfl_xor(s, 2); s += __shfl_xor(s, 4);
            float sr = 0.f;
            if (lane < 4) { const uint4 rv = *(const uint4*)(P + (size_t)r * NIN + C_KR + lane * 8);
                sr = bflo(rv.x) * bflo(rv.x) + bfhi(rv.x) * bfhi(rv.x) + bflo(rv.y) * bflo(rv.y) + bfhi(rv.y) * bfhi(rv.y)
                   + bflo(rv.z) * bflo(rv.z) + bfhi(rv.z) * bfhi(rv.z) + bflo(rv.w) * bflo(rv.w) + bfhi(rv.w) * bfhi(rv.w); }
            sr += __shfl_xor(sr, 1); sr += __shfl_xor(sr, 2);
            sr = __shfl(sr, 0);
            runmax = fmaxf(runmax, s + sr);
        }
        unsigned* lmax = (unsigned*)lds;
        __syncthreads();
        if (tidx < 8) lmax[tidx] = 0u;
        __syncthreads();
        if ((lane & 7) == 0) atomicMax(&lmax[lane >> 3], __float_as_uint(runmax));
        __syncthreads();
        if (tidx < 8) atomicMax(WSP(unsigned, OFF_CNT) + 32 + tidx, lmax[tidx]);
    }
}

typedef short s16x4 __attribute__((ext_vector_type(4)));
typedef short v4i16_t __attribute__((ext_vector_type(4)));
typedef __attribute__((address_space(3))) const char* lds_cptr;
__device__ __forceinline__ s16x4 vtr(lds_cptr q) { return __builtin_bit_cast(s16x4, __builtin_amdgcn_ds_read_tr16_b64_v4i16((__attribute__((address_space(3))) v4i16_t*)q)); }
__device__ __forceinline__ unsigned cvtpk(float lo, float hi) { return pack2(lo, hi); }
constexpr int AT_K = 0, AT_V = 8192, AT_KR = 16384, AT_BUF = 20480;

template <int DQK, int VAR = 0>
__device__ __forceinline__ void attn_item(const bf16_t* Q, int qpitch, const bf16_t* KA, int kapitch, const bf16_t* KB, int kbpitch,
                                          const bf16_t* V, int vpitch, int ntiles, float C, bf16_t* O, char* lds) {
    const int tid = opaque_tid(), lane = tid & 63, wid = tid >> 6, r32 = lane & 31, hi = lane >> 5;
    constexpr int ND0 = DQK / 16;
    bf16x8 qr[ND0];
    { const bf16_t* qp = Q + (size_t)(wid * 32 + r32) * qpitch + hi * 8;
#pragma unroll
      for (int d0 = 0; d0 < ND0; ++d0) qr[d0] = *(const bf16x8*)(qp + d0 * 16); }
    const int srow = tid >> 3, sch = tid & 7;
    const bf16_t* gk = KA + (size_t)srow * kapitch + sch * 8;
    const bf16_t* gv = V + (size_t)srow * vpitch + sch * 8;
    const bf16_t* gr = (DQK > 64) ? (KB + (size_t)(tid >> 2) * kbpitch + (tid & 3) * 8) : nullptr;
    const int sk_off = AT_K + srow * 128 + ((sch ^ ((srow >> 1) & 7)) << 4);
    const int sv_off = AT_V + (sch >> 2) * 4096 + srow * 64 + (sch & 3) * 16;
    const int sr_off = AT_KR + (tid >> 2) * 64 + (((tid & 3) ^ (((tid >> 2) >> 2) & 3)) << 4);
    const bool do_r = (DQK > 64) && (tid < 256);
    const int kf_off = AT_K + r32 * 128, ksw = (r32 >> 1) & 7;
    const int rf_off = AT_KR + r32 * 64, rsw = (r32 >> 2) & 3;
    const int vf_off = AT_V + (4 * hi + ((lane & 15) >> 2)) * 64 + ((lane >> 4) & 1) * 32 + (lane & 3) * 8;
    uint4 rk, rv, rr; rr = make_uint4(0, 0, 0, 0);
    rk = *(const uint4*)gk; rv = *(const uint4*)gv; if (do_r) rr = *(const uint4*)gr;
    *(uint4*)(lds + sk_off) = rk; *(uint4*)(lds + sv_off) = rv; if (do_r) *(uint4*)(lds + sr_off) = rr;
    __syncthreads();
    f32x16 o0, o1;
#pragma unroll
    for (int r = 0; r < 16; ++r) { o0[r] = 0.f; o1[r] = 0.f; }
    float mrun = -INFINITY, lrun = 0.f;
    for (int t = 0; t < ntiles; ++t) {
        const char* cur = lds + (VAR == 2 ? 0 : (t & 1)) * AT_BUF; char* nxt = lds + ((t + 1) & 1) * AT_BUF;
        const bool more = (t + 1 < ntiles);
        if (more && VAR != 2) { rk = *(const uint4*)(gk + (size_t)(t + 1) * 64 * kapitch); rv = *(const uint4*)(gv + (size_t)(t + 1) * 64 * vpitch); if (do_r) rr = *(const uint4*)(gr + (size_t)(t + 1) * 64 * kbpitch); }
        f32x16 p0, p1;
#pragma unroll
        for (int r = 0; r < 16; ++r) { p0[r] = 0.f; p1[r] = 0.f; }
#pragma unroll
        for (int d0 = 0; d0 < 4; ++d0) {
            const int co = ((2 * d0 + hi) ^ ksw) << 4;
            const bf16x8 k0 = *(const bf16x8*)(cur + kf_off + co), k1 = *(const bf16x8*)(cur + kf_off + 32 * 128 + co);
            p0 = MFMA32(k0, qr[d0], p0); p1 = MFMA32(k1, qr[d0], p1);
        }
        if (DQK > 64) {
#pragma unroll
            for (int d0 = 4; d0 < ND0; ++d0) {
                const int co = ((2 * (d0 - 4) + hi) ^ rsw) << 4;
                const bf16x8 k0 = *(const bf16x8*)(cur + rf_off + co), k1 = *(const bf16x8*)(cur + rf_off + 32 * 64 + co);
                p0 = MFMA32(k0, qr[d0], p0); p1 = MFMA32(k1, qr[d0], p1);
            }
        }
        if (VAR != 1) {
        float mx = fmaxf(p0[0], p1[0]);
#pragma unroll
        for (int r = 1; r < 16; ++r) mx = fmaxf(mx, fmaxf(p0[r], p1[r]));
        mx = xhalf_max(mx) * C;
        const float mnew = fmaxf(mrun, mx);
        if (__any(mnew > mrun)) {
            const float alpha = __builtin_amdgcn_exp2f(mrun - mnew);
            lrun *= alpha;
#pragma unroll
            for (int r = 0; r < 16; ++r) { o0[r] *= alpha; o1[r] *= alpha; }
            mrun = mnew;
        }
        const float nm = -mrun;
        float ls = 0.f;
#pragma unroll
        for (int r = 0; r < 16; ++r) { p0[r] = __builtin_amdgcn_exp2f(fmaf(p0[r], C, nm)); p1[r] = __builtin_amdgcn_exp2f(fmaf(p1[r], C, nm)); ls += p0[r] + p1[r]; }
        lrun += ls;
        }
#pragma unroll
        for (int s = 0; s < 4; ++s) {
            bf16x8 pf;
            {   unsigned w0, w1, w2, w3;
                if (s < 2) { w0 = cvtpk(p0[8 * s], p0[8 * s + 1]); w1 = cvtpk(p0[8 * s + 2], p0[8 * s + 3]); w2 = cvtpk(p0[8 * s + 4], p0[8 * s + 5]); w3 = cvtpk(p0[8 * s + 6], p0[8 * s + 7]); }
                else { const int s2 = s - 2; w0 = cvtpk(p1[8 * s2], p1[8 * s2 + 1]); w1 = cvtpk(p1[8 * s2 + 2], p1[8 * s2 + 3]); w2 = cvtpk(p1[8 * s2 + 4], p1[8 * s2 + 5]); w3 = cvtpk(p1[8 * s2 + 6], p1[8 * s2 + 7]); }
                uint4 u = make_uint4(w0, w1, w2, w3); pf = __builtin_bit_cast(bf16x8, u); }
            const lds_cptr vb = (lds_cptr)cur + vf_off + s * 1024;
            const s16x4 a0 = vtr(vb), a1 = vtr(vb + 512), b0 = vtr(vb + 4096), b1 = vtr(vb + 4096 + 512);
            const bf16x8 v0 = (bf16x8){a0[0], a0[1], a0[2], a0[3], a1[0], a1[1], a1[2], a1[3]};
            const bf16x8 v1 = (bf16x8){b0[0], b0[1], b0[2], b0[3], b1[0], b1[1], b1[2], b1[3]};
            o0 = MFMA32(v0, pf, o0); o1 = MFMA32(v1, pf, o1);
        }
        if (VAR != 2) { if (more) { *(uint4*)(nxt + sk_off) = rk; *(uint4*)(nxt + sv_off) = rv; if (do_r) *(uint4*)(nxt + sr_off) = rr; }
        __syncthreads(); }
    }
    const float inv = 1.0f / xhalf_sum(lrun);
    bf16_t* op = O + (size_t)(wid * 32 + r32) * 512 + 4 * hi;
#pragma unroll
    for (int rg = 0; rg < 4; ++rg) {
        uint2 a; a.x = pack2(o0[4 * rg] * inv, o0[4 * rg + 1] * inv); a.y = pack2(o0[4 * rg + 2] * inv, o0[4 * rg + 3] * inv);
        uint2 b; b.x = pack2(o1[4 * rg] * inv, o1[4 * rg + 1] * inv); b.y = pack2(o1[4 * rg + 2] * inv, o1[4 * rg + 3] * inv);
        *(uint2*)(op + 8 * rg) = a; *(uint2*)(op + 32 + 8 * rg) = b;
    }
}
#define SBAR() __builtin_amdgcn_sched_barrier(0)
#define PINV(x) asm volatile("" : "+v"(x))
constexpr float ATT_THR = 6.0f;
template <int DQK>
__device__ __forceinline__ void attn_item2(const bf16_t* Q, int qpitch, const bf16_t* KA, int kapitch, const bf16_t* KB, int kbpitch,
                                           const bf16_t* V, int vpitch, int ntiles, bf16_t* O, char* lds) {
    const int tid = opaque_tid(), lane = tid & 63, wid = tid >> 6, r32 = lane & 31, hi = lane >> 5;
    const int wu = __builtin_amdgcn_readfirstlane(wid);
    constexpr int ND0 = DQK / 16, NQK = 2 * ND0;
    constexpr bool ROPE = DQK > 64;
    const int krow = 8 * wu + (lane >> 3);
    const bf16_t* gk = KA + (size_t)krow * kapitch + (((lane & 7) ^ ((krow >> 1) & 7)) << 3);
    const bf16_t* gv = V + (size_t)(16 * (wu & 3) + (lane >> 2)) * vpitch + (wu >> 2) * 32 + (lane & 3) * 8;
    const int rrow = 16 * (wu & 3) + (lane >> 2);
    const bf16_t* gr = ROPE ? (KB + (size_t)rrow * kbpitch + (((lane & 3) ^ ((rrow >> 2) & 3)) << 3)) : nullptr;
    char* dk = lds + AT_K + wu * 1024; char* dv = lds + AT_V + wu * 1024; char* dr = lds + AT_KR + (wu & 3) * 1024;
    auto issue = [&](int t, int slot) {
        GLDS16(gk + (size_t)t * 64 * kapitch, dk + slot * AT_BUF); GLDS16(gv + (size_t)t * 64 * vpitch, dv + slot * AT_BUF);
        if (ROPE) GLDS16(gr + (size_t)t * 64 * kbpitch, dr + slot * AT_BUF);
    };
    asm volatile("s_waitcnt vmcnt(0)" ::: "memory");
    issue(0, 0);
    if (ntiles > 1) issue(1, 1);
    bf16x8 qr[ND0];
    { const bf16_t* qp = Q + (size_t)(wid * 32 + r32) * qpitch + hi * 8;
#pragma unroll
      for (int d0 = 0; d0 < ND0; ++d0) qr[d0] = *(const bf16x8*)(qp + d0 * 16); }
    const int kf_off = AT_K + r32 * 128, ksw = (r32 >> 1) & 7;
    const int rf_off = AT_KR + r32 * 64, rsw = (r32 >> 2) & 3;
    const int vf_off = AT_V + (4 * hi + ((lane & 15) >> 2)) * 64 + ((lane >> 4) & 1) * 32 + (lane & 3) * 8;
    auto kfrag = [&](const char* slot, int g) -> bf16x8 {
        const int d0 = g >> 1, n = g & 1;
        if (d0 < 4) return *(const bf16x8*)(slot + kf_off + n * 32 * 128 + (((2 * d0 + hi) ^ ksw) << 4));
        return *(const bf16x8*)(slot + rf_off + n * 32 * 64 + (((2 * (d0 - 4) + hi) ^ rsw) << 4));
    };
    auto vfrag = [&](const char* slot, int g) -> bf16x8 {
        const lds_cptr vb = (lds_cptr)slot + vf_off + (g >> 1) * 1024 + (g & 1) * 4096;
        const s16x4 a0 = vtr(vb), a1 = vtr(vb + 512);
        return (bf16x8){a0[0], a0[1], a0[2], a0[3], a1[0], a1[1], a1[2], a1[3]};
    };
    f32x16 o0, o1, sA0, sA1, sB0, sB1;
    const f32x16 zero16 = {0.f, 0.f, 0.f, 0.f, 0.f, 0.f, 0.f, 0.f, 0.f, 0.f, 0.f, 0.f, 0.f, 0.f, 0.f, 0.f};
#pragma unroll
    for (int r = 0; r < 16; ++r) { o0[r] = 0.f; o1[r] = 0.f; }
    float mref, lrun = 0.f;
    if (ntiles > 1) asm volatile("s_waitcnt vmcnt(%0)" :: "n"(ROPE ? 3 : 2) : "memory"); else asm volatile("s_waitcnt vmcnt(0)" ::: "memory");
    __builtin_amdgcn_s_barrier();
    {
#pragma unroll
        for (int g = 0; g < NQK; ++g) { const bf16x8 kf = kfrag(lds, g);
            if (g & 1) sA1 = MFMA32(kf, qr[g >> 1], g < 2 ? zero16 : sA1); else sA0 = MFMA32(kf, qr[g >> 1], g < 2 ? zero16 : sA0); }
        float mx = fmaxf(sA0[0], sA1[0]);
#pragma unroll
        for (int r = 1; r < 16; ++r) mx = fmaxf(mx, fmaxf(sA0[r], sA1[r]));
        mref = xhalf_max(mx);
    }
    asm volatile("s_waitcnt vmcnt(0) lgkmcnt(0)" ::: "memory");
    __builtin_amdgcn_s_barrier();
    auto step = [&](auto HN, f32x16& c0, f32x16& c1, f32x16& n0, f32x16& n1, int t) __attribute__((always_inline)) {
        const int sl = t % 3, sl1 = (t + 1) % 3, sl2 = (t + 2) % 3;
        const char* cs = lds + sl * AT_BUF; const char* ns = lds + sl1 * AT_BUF;
        constexpr bool has_next = decltype(HN)::value;
        if (t + 2 < ntiles) issue(t + 2, sl2);
        u32x4 pw[4];
        float ls = 0.f;
        bf16x8 kf;
        if (has_next) kf = kfrag(ns, 0);
        SBAR();
#pragma unroll
        for (int g = 0; g < (NQK > 8 ? NQK : 8); ++g) {
            bf16x8 kcur = kf;
            if (has_next && g + 1 < NQK) kf = kfrag(ns, g + 1);
            SBAR();
            if (g < 8) {
                float e0, e1, e2, e3;
                if (g < 4) { e0 = __builtin_amdgcn_exp2f(c0[4 * g] - mref); e1 = __builtin_amdgcn_exp2f(c0[4 * g + 1] - mref); e2 = __builtin_amdgcn_exp2f(c0[4 * g + 2] - mref); e3 = __builtin_amdgcn_exp2f(c0[4 * g + 3] - mref); }
                else { e0 = __builtin_amdgcn_exp2f(c1[4 * (g - 4)] - mref); e1 = __builtin_amdgcn_exp2f(c1[4 * (g - 4) + 1] - mref); e2 = __builtin_amdgcn_exp2f(c1[4 * (g - 4) + 2] - mref); e3 = __builtin_amdgcn_exp2f(c1[4 * (g - 4) + 3] - mref); }
                ls += (e0 + e1) + (e2 + e3);
                const unsigned w0 = cvtpk(e0, e1), w1 = cvtpk(e2, e3);
                if ((g & 1) == 0) { pw[g >> 1][0] = w0; pw[g >> 1][1] = w1; } else { pw[g >> 1][2] = w0; pw[g >> 1][3] = w1; }
                PINV(ls); PINV(pw[g >> 1]);
            }
            SBAR();
            if (has_next && g < NQK) { if (g & 1) n1 = MFMA32(kcur, qr[g >> 1], g < 2 ? zero16 : n1); else n0 = MFMA32(kcur, qr[g >> 1], g < 2 ? zero16 : n0); }
            SBAR();
        }
        lrun += ls;
        float mx = -INFINITY;
        bf16x8 vf = vfrag(cs, 0);
        SBAR();
#pragma unroll
        for (int g = 0; g < 8; ++g) {
            const bf16x8 vcur = vf;
            if (g + 1 < 8) vf = vfrag(cs, g + 1);
            SBAR();
            if (has_next) {
                if (g < 4) mx = fmaxf(fmaxf(mx, fmaxf(n0[4 * g], n0[4 * g + 1])), fmaxf(n0[4 * g + 2], n0[4 * g + 3]));
                else mx = fmaxf(fmaxf(mx, fmaxf(n1[4 * (g - 4)], n1[4 * (g - 4) + 1])), fmaxf(n1[4 * (g - 4) + 2], n1[4 * (g - 4) + 3]));
                PINV(mx);
            }
            SBAR();
            const bf16x8 pf = __builtin_bit_cast(bf16x8, pw[g >> 1]);
            if (g & 1) o1 = MFMA32(vcur, pf, o1); else o0 = MFMA32(vcur, pf, o0);
            SBAR();
        }
        if (has_next) {
            const float gr_ = xhalf_max(mx) - mref;
            if (__any(gr_ > ATT_THR)) {
                const float d = fmaxf(gr_, 0.f), a = __builtin_amdgcn_exp2f(-d);
                mref += d; lrun *= a;
#pragma unroll
                for (int r = 0; r < 16; ++r) { o0[r] *= a; o1[r] *= a; }
            }
        }
        asm volatile("s_waitcnt vmcnt(0) lgkmcnt(0)" ::: "memory");
        __builtin_amdgcn_s_barrier();
    };
    {   const std::integral_constant<bool, true> yes; const std::integral_constant<bool, false> no;
        int t = 0;
        for (; t + 2 < ntiles; t += 2) { step(yes, sA0, sA1, sB0, sB1, t); step(yes, sB0, sB1, sA0, sA1, t + 1); }
        step(yes, sA0, sA1, sB0, sB1, t); step(no, sB0, sB1, sA0, sA1, t + 1); }
    const float inv = 1.0f / xhalf_sum(lrun);
    bf16_t* op = O + (size_t)(wid * 32 + r32) * 512 + 4 * hi;
#pragma unroll
    for (int rg = 0; rg < 4; ++rg) {
        uint2 a; a.x = pack2(o0[4 * rg] * inv, o0[4 * rg + 1] * inv); a.y = pack2(o0[4 * rg + 2] * inv, o0[4 * rg + 3] * inv);
        uint2 b; b.x = pack2(o1[4 * rg] * inv, o1[4 * rg + 1] * inv); b.y = pack2(o1[4 * rg + 2] * inv, o1[4 * rg + 3] * inv);
        *(uint2*)(op + 8 * rg) = a; *(uint2*)(op + 32 + 8 * rg) = b;
    }
}
constexpr int A3_K = 0, A3_KR = 16384, A3_V = 24576, A3_BYTES = 24576 + 3 * 8192;
template <int DQK>
__device__ __forceinline__ void attn_item3(const bf16_t* Q, int qpitch, const bf16_t* KA, int kapitch, const bf16_t* KB, int kbpitch,
                                           const bf16_t* V, int vpitch, int ntiles, bf16_t* O, char* lds) {
    const int tid = opaque_tid(), lane = tid & 63, wid = tid >> 6, r32 = lane & 31, hi = lane >> 5;
    const bool grpB = __builtin_amdgcn_readfirstlane(wid) >= 4;
    constexpr int ND0 = DQK / 16;
    bf16x8 qr[ND0];
    { const bf16_t* qp = Q + (size_t)(wid * 32 + r32) * qpitch + hi * 8;
#pragma unroll
      for (int d0 = 0; d0 < ND0; ++d0) qr[d0] = *(const bf16x8*)(qp + d0 * 16); }
    const int srow = tid >> 3, sch = tid & 7;
    const bf16_t* gk = KA + (size_t)srow * kapitch + sch * 8;
    const bf16_t* gv = V + (size_t)srow * vpitch + sch * 8;
    const bf16_t* gr = (DQK > 64) ? (KB + (size_t)(tid >> 2) * kbpitch + (tid & 3) * 8) : nullptr;
    const int sk_off = A3_K + srow * 128 + ((sch ^ ((srow >> 1) & 7)) << 4);
    const int sv_off = A3_V + (sch >> 2) * 4096 + srow * 64 + (sch & 3) * 16;
    const int sr_off = A3_KR + (tid >> 2) * 64 + (((tid & 3) ^ (((tid >> 2) >> 2) & 3)) << 4);
    const bool do_r = (DQK > 64) && (tid < 256);
    const int kf_off = A3_K + r32 * 128, ksw = (r32 >> 1) & 7;
    const int rf_off = A3_KR + r32 * 64, rsw = (r32 >> 2) & 3;
    const int vf_off = A3_V + (4 * hi + ((lane & 15) >> 2)) * 64 + ((lane >> 4) & 1) * 32 + (lane & 3) * 8;
    uint4 rk, rv, rr; rr = make_uint4(0, 0, 0, 0);
    rk = *(const uint4*)gk; rv = *(const uint4*)gv; if (do_r) rr = *(const uint4*)gr;
    *(uint4*)(lds + sk_off) = rk; *(uint4*)(lds + sv_off) = rv; if (do_r) *(uint4*)(lds + sr_off) = rr;
    __syncthreads();
    f32x16 o0, o1, p0, p1;
#pragma unroll
    for (int r = 0; r < 16; ++r) { o0[r] = 0.f; o1[r] = 0.f; p0[r] = 0.f; p1[r] = 0.f; }
    float mrun = -INFINITY, lrun = 0.f;
    auto H1 = [&](int t) __attribute__((always_inline)) {
        const char* ks = lds + (t & 1) * 8192; const char* rs = lds + (t & 1) * 4096;
#pragma unroll
        for (int r = 0; r < 16; ++r) { p0[r] = 0.f; p1[r] = 0.f; }
#pragma unroll
        for (int d0 = 0; d0 < 4; ++d0) {
            const int co = ((2 * d0 + hi) ^ ksw) << 4;
            const bf16x8 k0 = *(const bf16x8*)(ks + kf_off + co), k1 = *(const bf16x8*)(ks + kf_off + 32 * 128 + co);
            p0 = MFMA32(k0, qr[d0], p0); p1 = MFMA32(k1, qr[d0], p1);
        }
        if (DQK > 64) {
#pragma unroll
            for (int d0 = 4; d0 < ND0; ++d0) {
                const int co = ((2 * (d0 - 4) + hi) ^ rsw) << 4;
                const bf16x8 k0 = *(const bf16x8*)(rs + rf_off + co), k1 = *(const bf16x8*)(rs + rf_off + 32 * 64 + co);
                p0 = MFMA32(k0, qr[d0], p0); p1 = MFMA32(k1, qr[d0], p1);
            }
        }
        float mx = fmaxf(p0[0], p1[0]);
#pragma unroll
        for (int r = 1; r < 16; ++r) mx = fmaxf(mx, fmaxf(p0[r], p1[r]));
        mx = xhalf_max(mx);
        if (__any(mx > mrun + ATT_THR)) {
            const float mnew = fmaxf(mrun, mx), alpha = __builtin_amdgcn_exp2f(mrun - mnew);
            lrun *= alpha;
#pragma unroll
            for (int r = 0; r < 16; ++r) { o0[r] *= alpha; o1[r] *= alpha; }
            mrun = mnew;
        }
    };
    auto H2 = [&](int t) __attribute__((always_inline)) {
        const char* vs = lds + (t % 3) * 8192;
        float ls = 0.f;
#pragma unroll
        for (int r = 0; r < 16; ++r) { p0[r] = __builtin_amdgcn_exp2f(p0[r] - mrun); p1[r] = __builtin_amdgcn_exp2f(p1[r] - mrun); ls += p0[r] + p1[r]; }
        lrun += ls;
#pragma unroll
        for (int s = 0; s < 4; ++s) {
            bf16x8 pf;
            {   unsigned w0, w1, w2, w3;
                if (s < 2) { w0 = cvtpk(p0[8 * s], p0[8 * s + 1]); w1 = cvtpk(p0[8 * s + 2], p0[8 * s + 3]); w2 = cvtpk(p0[8 * s + 4], p0[8 * s + 5]); w3 = cvtpk(p0[8 * s + 6], p0[8 * s + 7]); }
                else { const int s2 = s - 2; w0 = cvtpk(p1[8 * s2], p1[8 * s2 + 1]); w1 = cvtpk(p1[8 * s2 + 2], p1[8 * s2 + 3]); w2 = cvtpk(p1[8 * s2 + 4], p1[8 * s2 + 5]); w3 = cvtpk(p1[8 * s2 + 6], p1[8 * s2 + 7]); }
                u32x4 u = {w0, w1, w2, w3}; pf = __builtin_bit_cast(bf16x8, u); }
            const lds_cptr vb = (lds_cptr)vs + vf_off + s * 1024;
            const s16x4 a0 = vtr(vb), a1 = vtr(vb + 512), b0 = vtr(vb + 4096), b1 = vtr(vb + 4096 + 512);
            const bf16x8 v0 = (bf16x8){a0[0], a0[1], a0[2], a0[3], a1[0], a1[1], a1[2], a1[3]};
            const bf16x8 v1 = (bf16x8){b0[0], b0[1], b0[2], b0[3], b1[0], b1[1], b1[2], b1[3]};
            o0 = MFMA32(v0, pf, o0); o1 = MFMA32(v1, pf, o1);
        }
    };
#define A3_LOAD(t) do { rk = *(const uint4*)(gk + (size_t)((t) + 1) * 64 * kapitch); rv = *(const uint4*)(gv + (size_t)((t) + 1) * 64 * vpitch); if (do_r) rr = *(const uint4*)(gr + (size_t)((t) + 1) * 64 * kbpitch); } while (0)
#define A3_WRITE(t) do { const int kn = ((t) + 1) & 1, vn = ((t) + 1) % 3; *(uint4*)(lds + kn * 8192 + sk_off) = rk; *(uint4*)(lds + vn * 8192 + sv_off) = rv; if (do_r) *(uint4*)(lds + kn * 4096 + sr_off) = rr; } while (0)
    if (grpB) {
        { const bool more = (1 < ntiles); if (more) A3_LOAD(0); H1(0); if (more) A3_WRITE(0); __syncthreads(); }
        for (int t = 1; t < ntiles; ++t) {
            const bool more = (t + 1 < ntiles);
            if (more) A3_LOAD(t);
            H2(t - 1); H1(t);
            if (more) A3_WRITE(t);
            __syncthreads();
        }
    } else {
        for (int t = 0; t < ntiles; ++t) {
            const bool more = (t + 1 < ntiles);
            if (more) A3_LOAD(t);
            H1(t); H2(t);
            if (more) A3_WRITE(t);
            __syncthreads();
        }
    }
#undef A3_LOAD
#undef A3_WRITE
    if (grpB) H2(ntiles - 1);
    const float inv = 1.0f / xhalf_sum(lrun);
    bf16_t* op = O + (size_t)(wid * 32 + r32) * 512 + 4 * hi;
#pragma unroll
    for (int rg = 0; rg < 4; ++rg) {
        uint2 a; a.x = pack2(o0[4 * rg] * inv, o0[4 * rg + 1] * inv); a.y = pack2(o0[4 * rg + 2] * inv, o0[4 * rg + 3] * inv);
        uint2 b; b.x = pack2(o1[4 * rg] * inv, o1[4 * rg + 1] * inv); b.y = pack2(o1[4 * rg + 2] * inv, o1[4 * rg + 3] * inv);
        *(uint2*)(op + 8 * rg) = a; *(uint2*)(op + 32 + 8 * rg) = b;
    }
    __syncthreads();
}
template <int DQK>
__device__ __forceinline__ void attn_item4(const bf16_t* Q, int qpitch, const bf16_t* KA, int kapitch, const bf16_t* KB, int kbpitch,
                                           const bf16_t* V, int vpitch, int ntiles, float ref_const, float kmax2, bf16_t* O, char* lds) {
    const int tid = opaque_tid(), lane = tid & 63, wid = tid >> 6, r32 = lane & 31, hi = lane >> 5;
    constexpr int ND0 = DQK / 16;
    bf16x8 qr[ND0];
    { const bf16_t* qp = Q + (size_t)(wid * 32 + r32) * qpitch + hi * 8;
#pragma unroll
      for (int d0 = 0; d0 < ND0; ++d0) qr[d0] = *(const bf16x8*)(qp + d0 * 16); }
    float mref = ref_const;
    if (DQK > 64) {
        float qn2 = 0.f;
#pragma unroll
        for (int d0 = 0; d0 < ND0; ++d0)
#pragma unroll
            for (int j = 0; j < 8; ++j) { const float v = bf2f((bf16_t)qr[d0][j]); qn2 = fmaf(v, v, qn2); }
        qn2 = xhalf_sum(qn2);
        mref = sqrtf(qn2 * kmax2) * 1.01f + 0.01f;
    }
    f32x16 negm;
#pragma unroll
    for (int r = 0; r < 16; ++r) negm[r] = -mref;
    const int srow = tid >> 3, sch = tid & 7;
    const bf16_t* gk = KA + (size_t)srow * kapitch + sch * 8;
    const bf16_t* gv = V + (size_t)srow * vpitch + sch * 8;
    const bf16_t* gr = (DQK > 64) ? (KB + (size_t)(tid >> 2) * kbpitch + (tid & 3) * 8) : nullptr;
    const int sk_off = AT_K + srow * 128 + ((sch ^ ((srow >> 1) & 7)) << 4);
    const int sv_off = AT_V + (sch >> 2) * 4096 + srow * 64 + (sch & 3) * 16;
    const int sr_off = AT_KR + (tid >> 2) * 64 + (((tid & 3) ^ (((tid >> 2) >> 2) & 3)) << 4);
    const bool do_r = (DQK > 64) && (tid < 256);
    const int kf_off = AT_K + r32 * 128, ksw = (r32 >> 1) & 7;
    const int rf_off = AT_KR + r32 * 64, rsw = (r32 >> 2) & 3;
    const int vf_off = AT_V + (4 * hi + ((lane & 15) >> 2)) * 64 + ((lane >> 4) & 1) * 32 + (lane & 3) * 8;
    uint4 rk, rv, rr; rr = make_uint4(0, 0, 0, 0);
    rk = *(const uint4*)gk; rv = *(const uint4*)gv; if (do_r) rr = *(const uint4*)gr;
    *(uint4*)(lds + sk_off) = rk; *(uint4*)(lds + sv_off) = rv; if (do_r) *(uint4*)(lds + sr_off) = rr;
    __syncthreads();
    f32x16 o0, o1;
#pragma unroll
    for (int r = 0; r < 16; ++r) { o0[r] = 0.f; o1[r] = 0.f; }
    float lrun = 0.f;
#pragma unroll 1
    for (int t = 0; t < ntiles; ++t) {
        const char* cur = lds + (t & 1) * AT_BUF; char* nxt = lds + ((t + 1) & 1) * AT_BUF;
        const bool more = (t + 1 < ntiles);
        if (more) { rk = *(const uint4*)(gk + (size_t)(t + 1) * 64 * kapitch); rv = *(const uint4*)(gv + (size_t)(t + 1) * 64 * vpitch); if (do_r) rr = *(const uint4*)(gr + (size_t)(t + 1) * 64 * kbpitch); }
        bf16x8 kf[8];
#pragma unroll
        for (int d0 = 0; d0 < 4; ++d0) { const int co = ((2 * d0 + hi) ^ ksw) << 4; kf[2 * d0] = *(const bf16x8*)(cur + kf_off + co); kf[2 * d0 + 1] = *(const bf16x8*)(cur + kf_off + 32 * 128 + co); }
        f32x16 p0, p1;
        p0 = MFMA32(kf[0], qr[0], negm); p1 = MFMA32(kf[1], qr[0], negm);
        p0 = MFMA32(kf[2], qr[1], p0); p1 = MFMA32(kf[3], qr[1], p1);
        if (DQK > 64) {
            __builtin_amdgcn_sched_barrier(0);
#pragma unroll
            for (int d0 = 4; d0 < ND0; ++d0) { const int co = ((2 * (d0 - 4) + hi) ^ rsw) << 4; kf[2 * (d0 - 4)] = *(const bf16x8*)(cur + rf_off + co); kf[2 * (d0 - 4) + 1] = *(const bf16x8*)(cur + rf_off + 32 * 64 + co); }
        }
        p0 = MFMA32(kf[4], qr[2], p0); p1 = MFMA32(kf[5], qr[2], p1);
        p0 = MFMA32(kf[6], qr[3], p0); p1 = MFMA32(kf[7], qr[3], p1);
        if (DQK > 64) {
#pragma unroll
            for (int d0 = 4; d0 < ND0; ++d0) { p0 = MFMA32(kf[2 * (d0 - 4)], qr[d0], p0); p1 = MFMA32(kf[2 * (d0 - 4) + 1], qr[d0], p1); }
        }
        bf16x8 vf[8];
        auto vload = [&](int s) __attribute__((always_inline)) {
            const lds_cptr vb = (lds_cptr)cur + vf_off + s * 1024;
            const s16x4 a0 = vtr(vb), a1 = vtr(vb + 512), b0 = vtr(vb + 4096), b1 = vtr(vb + 4096 + 512);
            vf[2 * s] = (bf16x8){a0[0], a0[1], a0[2], a0[3], a1[0], a1[1], a1[2], a1[3]};
            vf[2 * s + 1] = (bf16x8){b0[0], b0[1], b0[2], b0[3], b1[0], b1[1], b1[2], b1[3]};
        };
        vload(0); vload(1);
        float ls = 0.f;
#pragma unroll
        for (int s = 0; s < 4; ++s) {
            float e[8];
#pragma unroll
            for (int j = 0; j < 8; ++j) e[j] = __builtin_amdgcn_exp2f(s < 2 ? p0[8 * s + j] : p1[8 * (s - 2) + j]);
            ls += ((e[0] + e[1]) + (e[2] + e[3])) + ((e[4] + e[5]) + (e[6] + e[7]));
            u32x4 u = {cvtpk(e[0], e[1]), cvtpk(e[2], e[3]), cvtpk(e[4], e[5]), cvtpk(e[6], e[7])};
            const bf16x8 pf = __builtin_bit_cast(bf16x8, u);
            if (s + 2 < 4) vload(s + 2);
            o0 = MFMA32(vf[2 * s], pf, o0); o1 = MFMA32(vf[2 * s + 1], pf, o1);
        }
        lrun += ls;
        if (more) { *(uint4*)(nxt + sk_off) = rk; *(uint4*)(nxt + sv_off) = rv; if (do_r) *(uint4*)(nxt + sr_off) = rr; }
        __syncthreads();
    }
    const float inv = 1.0f / xhalf_sum(lrun);
    bf16_t* op = O + (size_t)(wid * 32 + r32) * 512 + 4 * hi;
#pragma unroll
    for (int rg = 0; rg < 4; ++rg) {
        uint2 a; a.x = pack2(o0[4 * rg] * inv, o0[4 * rg + 1] * inv); a.y = pack2(o0[4 * rg + 2] * inv, o0[4 * rg + 3] * inv);
        uint2 b; b.x = pack2(o1[4 * rg] * inv, o1[4 * rg + 1] * inv); b.y = pack2(o1[4 * rg + 2] * inv, o1[4 * rg + 3] * inv);
        *(uint2*)(op + 8 * rg) = a; *(uint2*)(op + 32 + 8 * rg) = b;
    }
}
__device__ __forceinline__ void attn_dispatch(const KP& p, int ty, int h, int qt, float gqa_ref, char* lds) {
    const bf16_t* P = WSP(bf16_t, OFF_P); const bf16_t* Qm = WSP(bf16_t, OFF_H); const bf16_t* Kn = WSP(bf16_t, OFF_KN); const bf16_t* Vm = WSP(bf16_t, OFF_V);
    const int ntiles = (qt == 0) ? (LC / 64) : (T / 64);
    const size_t r0 = (size_t)qt * 256;
    bf16_t* Om = WSP(bf16_t, OFF_OM); bf16_t* Og = WSP(bf16_t, OFF_OG);
    if (ty == 0) {
        const float kmax2 = __uint_as_float(WSP(unsigned, OFF_CNT)[32 + h]);
        attn_item4<96>(Qm + r0 * 768 + h * 96, 768, Kn + h * 64, 512, P + C_KR, NIN, Vm + h * 64, 512, ntiles, 0.f, kmax2, Om + r0 * 512 + h * 64, lds);
    } else
        attn_item4<64>(P + r0 * NIN + C_GQ + h * 64, NIN, P + C_GK + (h >> 2) * 64, NIN, nullptr, 0, P + C_GV + (h >> 2) * 64, NIN, ntiles, gqa_ref, 0.f, Og + r0 * 512 + h * 64, lds);
}
__device__ __forceinline__ void st_attn(const KP& p, int l, int bid, int nb, char* lds) {
    const int tidx = opaque_tid();
    float gq = fabsf(p.in(I_GQN)[l * 64 + (tidx & 63)]), gk = fabsf(p.in(I_GKN)[l * 64 + (tidx & 63)]);
#pragma unroll
    for (int o = 32; o > 0; o >>= 1) { gq = fmaxf(gq, __shfl_xor(gq, o)); gk = fmaxf(gk, __shfl_xor(gk, o)); }
    const float gqa_ref = 64.0f * SC_GQA * gq * gk * 1.02f + 0.01f;
    for (int ty = 0; ty < 2; ++ty)
        for (int u = bid; u < 512; u += nb) attn_dispatch(p, ty, u & 7, 1 + (u >> 3), gqa_ref, lds);
    for (int u = bid; u < 16; u += nb) attn_dispatch(p, u >> 3, u & 7, 0, gqa_ref, lds);
}

__device__ __forceinline__ void st_merge(const KP& p, int bid, int nb, char* lds) {
    const int tidx = opaque_tid();
    const bf16_t* P = WSP(bf16_t, OFF_P); bf16_t* Mb = WSP(bf16_t, OFF_H);
    const bf16_t* Wb = WSP(bf16_t, OFF_WB + WB_BR);
    int mt, nt;
    for (int it = 0; dense_tile(it, 8, true, bid, nb, mt, nt); ++it) {
        f32x16 tot[2][2]; acc_zero(tot);
#pragma unroll 1
        for (int b = 0; b < 3; ++b) {
            const bf16_t* Ob = b == 1 ? P + C_SSM : WSP(bf16_t, b == 0 ? OFF_OM : OFF_OG); const int opitch = b == 1 ? NIN : 512;
            f32x16 acc[2][2]; acc_zero(acc);
            gemm_core(acc, [&](int r) { return Ob + (size_t)(mt * 256 + r) * opitch; }, [&](int r) { return Wb + ((size_t)b * 1024 + nt * 128 + r) * 512; }, 512, lds);
            acc_visit_add(acc, tot, [&](int ml, int nl, f32x4 v) {
                const uint2 gr = *(const uint2*)(P + (size_t)(mt * 256 + ml) * NIN + C_GATE + b * 1024 + nt * 128 + nl);
                f32x4 r; r[0] = sigmoidf_(bflo(gr.x)) * v[0]; r[1] = sigmoidf_(bfhi(gr.x)) * v[1]; r[2] = sigmoidf_(bflo(gr.y)) * v[2]; r[3] = sigmoidf_(bfhi(gr.y)) * v[3];
                return r; });
        }
        acc_visit(tot, [&](int ml, int nl, f32x4 v) { *(uint2*)(Mb + (size_t)(mt * 256 + ml) * 1024 + nt * 128 + nl) = pack4(v); });
    }
}
__device__ __forceinline__ void st_wout(const KP& p, int bid, int nb, char* lds) {
    const int tidx = opaque_tid();
    const bf16_t* Mb = WSP(bf16_t, OFF_H); const bf16_t* Wt = WSP(bf16_t, OFF_WB + WB_OUT); float* Y = WSP(float, OFF_Y);
    int mt, nt;
    for (int it = 0; dense_tile(it, 8, true, bid, nb, mt, nt); ++it) {
        f32x16 acc[2][2]; acc_zero(acc);
        gemm_core(acc, [&](int r) { return Mb + (size_t)(mt * 256 + r) * 1024; }, [&](int r) { return Wt + (size_t)(nt * 128 + r) * 1024; }, 1024, lds);
        acc_visit(acc, [&](int ml, int nl, f32x4 v) { *(f32x4*)(Y + (size_t)(mt * 256 + ml) * 1024 + nt * 128 + nl) = v; });
    }
    int* sltok = WSP(int, OFF_SLTOK); float* slw = WSP(float, OFF_SLW); int* cnt = WSP(int, OFF_CNT);
    for (int i = bid * NTH + tidx; i < TP; i += nb * NTH) { sltok[i] = 0; slw[i] = 0.f; }
    if (bid == 0 && tidx < 32) cnt[tidx] = 0;
}

__device__ __forceinline__ void st_postmix(const KP& p, int l, int bid, int nb, char* lds) {
    const int tidx = opaque_tid();
    const int lane = tidx & 63, wid = tidx >> 6;
    const float* Y = WSP(float, OFF_Y); bf16_t* H2 = WSP(bf16_t, OFF_H);
    const float* gpost = p.in(I_GPOSTMIX) + l * D; const float* gpre = p.in(I_GPREFFN) + l * D;
    int* toke = WSP(int, OFF_TOKE); float* tokw = WSP(float, OFF_TOKW); int* cnt = WSP(int, OFF_CNT);
    float* wl = (float*)lds; int* hist = (int*)(lds + 20 * 1024 * 4);
    {   const float* wg = p.in(I_WGROUP) + (size_t)l * D * 4; const float* wr = p.in(I_WROUTER) + (size_t)l * D * 16;
        for (int k = tidx; k < 1024; k += NTH) {
            const float4 g4 = *(const float4*)(wg + (size_t)k * 4);
            wl[0 * 1024 + k] = g4.x; wl[1 * 1024 + k] = g4.y; wl[2 * 1024 + k] = g4.z; wl[3 * 1024 + k] = g4.w;
#pragma unroll
            for (int e4 = 0; e4 < 4; ++e4) { const float4 r4 = *(const float4*)(wr + (size_t)k * 16 + e4 * 4);
                wl[(4 + e4 * 4 + 0) * 1024 + k] = r4.x; wl[(4 + e4 * 4 + 1) * 1024 + k] = r4.y; wl[(4 + e4 * 4 + 2) * 1024 + k] = r4.z; wl[(4 + e4 * 4 + 3) * 1024 + k] = r4.w; }
        }
        if (tidx < 16) hist[tidx] = 0;
        __syncthreads(); }
    for (int r = bid * NWV + wid; r < T; r += nb * NWV) {
        float* xr = xrow(p, r);
        const float* md = WSP(float, OFF_MOD) + (size_t)(l * 2 + (r < LC ? 1 : 0)) * 6144;
        float4 y[4], x[4]; float ss = 0.f;
#pragma unroll
        for (int i = 0; i < 4; ++i) { y[i] = *(const float4*)(Y + (size_t)r * D + i * 256 + lane * 4); ss += y[i].x * y[i].x + y[i].y * y[i].y + y[i].z * y[i].z + y[i].w * y[i].w; }
        ss = wave_sum(ss);
        const float rstd = rsqrtf(ss * (1.0f / D) + EPS);
        float ss2 = 0.f;
#pragma unroll
        for (int i = 0; i < 4; ++i) { const int c = i * 256 + lane * 4;
            const float4 gg = *(const float4*)(gpost + c), ga = *(const float4*)(md + 2048 + c); x[i] = *(const float4*)((l == 0 ? xrow_in(p, r) : (const float*)xr) + c);
            x[i].x += ga.x * y[i].x * rstd * gg.x; x[i].y += ga.y * y[i].y * rstd * gg.y; x[i].z += ga.z * y[i].z * rstd * gg.z; x[i].w += ga.w * y[i].w * rstd * gg.w;
            *(float4*)(xr + c) = x[i];
            ss2 += x[i].x * x[i].x + x[i].y * x[i].y + x[i].z * x[i].z + x[i].w * x[i].w; }
        ss2 = wave_sum(ss2);
        const float rstd2 = rsqrtf(ss2 * (1.0f / D) + EPS);
        float lg[4] = {0.f, 0.f, 0.f, 0.f}, le[16];
#pragma unroll
        for (int e = 0; e < 16; ++e) le[e] = 0.f;
#pragma unroll
        for (int i = 0; i < 4; ++i) { const int c = i * 256 + lane * 4;
            const float4 gg = *(const float4*)(gpre + c), sh = *(const float4*)(md + 3072 + c), sc = *(const float4*)(md + 4096 + c);
            float h[4];
            h[0] = x[i].x * rstd2 * gg.x * (1.f + sc.x) + sh.x; h[1] = x[i].y * rstd2 * gg.y * (1.f + sc.y) + sh.y;
            h[2] = x[i].z * rstd2 * gg.z * (1.f + sc.z) + sh.z; h[3] = x[i].w * rstd2 * gg.w * (1.f + sc.w) + sh.w;
            uint2 o; o.x = pack2(h[0], h[1]); o.y = pack2(h[2], h[3]);
            *(uint2*)(H2 + (size_t)r * D + c) = o;
#pragma unroll
            for (int e = 0; e < 4; ++e) { const float4 w4 = *(const float4*)(wl + e * 1024 + c);
                lg[e] = fmaf(h[0], w4.x, lg[e]); lg[e] = fmaf(h[1], w4.y, lg[e]); lg[e] = fmaf(h[2], w4.z, lg[e]); lg[e] = fmaf(h[3], w4.w, lg[e]); }
#pragma unroll
            for (int e = 0; e < 16; ++e) { const float4 w4 = *(const float4*)(wl + (4 + e) * 1024 + c);
                le[e] = fmaf(h[0], w4.x, le[e]); le[e] = fmaf(h[1], w4.y, le[e]); le[e] = fmaf(h[2], w4.z, le[e]); le[e] = fmaf(h[3], w4.w, le[e]); }
        }
#pragma unroll
        for (int g = 0; g < 4; ++g) lg[g] = wave_sum(lg[g]) + p.in(I_BGROUP)[l * 4 + g];
        const float myle = transpose_reduce16(le, lane) + p.in(I_BROUTER)[l * 16 + (lane & 15)];
        int gs = 0; float gm = lg[0];
#pragma unroll
        for (int g = 1; g < 4; ++g) if (lg[g] > gm) { gm = lg[g]; gs = g; }
        float ls[4];
#pragma unroll
        for (int i = 0; i < 4; ++i) ls[i] = __shfl(myle, gs * 4 + i);
        if (lane == 0) {
            float den = 0.f;
#pragma unroll
            for (int g = 0; g < 4; ++g) den += __expf(lg[g] - gm);
            const float pg = 1.0f / den;
            int i0 = 0; float m0 = ls[0];
#pragma unroll
            for (int i = 1; i < 4; ++i) if (ls[i] > m0) { m0 = ls[i]; i0 = i; }
            int i1 = -1; float m1 = -INFINITY;
#pragma unroll
            for (int i = 0; i < 4; ++i) if (i != i0 && ls[i] > m1) { m1 = ls[i]; i1 = i; }
            const float e1 = __expf(m1 - m0), w0 = pg / (1.f + e1), w1 = pg * e1 / (1.f + e1);
            const int ex0 = gs * 4 + i0, ex1 = gs * 4 + i1;
            toke[r * 2] = ex0; toke[r * 2 + 1] = ex1; tokw[r * 2] = w0; tokw[r * 2 + 1] = w1;
            atomicAdd(&hist[ex0], 1); atomicAdd(&hist[ex1], 1);
        }
    }
    __syncthreads();
    if (tidx < 16 && hist[tidx] != 0) atomicAdd(&cnt[tidx], hist[tidx]);
}

__device__ __forceinline__ void moe_offsets(const int* cnt, int* off) {
    int a = 0;
#pragma unroll
    for (int e = 0; e < 16; ++e) { off[e] = a; a += (cnt[e] + 255) & ~255; }
    off[16] = a;
}
__device__ __forceinline__ int moe_expert_of(const int* off, int j) {
    int e = 0;
#pragma unroll
    for (int k = 1; k < 16; ++k) e += (j >= off[k]) ? 1 : 0;
    return e;
}
__device__ __forceinline__ void st_moe_build(const KP& p, int bid, int nb) {
    const int tidx = opaque_tid();
    int* cnt = WSP(int, OFF_CNT); int* cnt2 = cnt + 16;
    const int* toke = WSP(int, OFF_TOKE); const float* tokw = WSP(float, OFF_TOKW); int* toks = WSP(int, OFF_TOKS);
    int* sltok = WSP(int, OFF_SLTOK); float* slw = WSP(float, OFF_SLW);
    int off[17]; moe_offsets(cnt, off);
    for (int idx = bid * NTH + tidx; idx < T * 2; idx += nb * NTH) {
        const int e = toke[idx];
        int o = 0;
#pragma unroll
        for (int k = 0; k < 16; ++k) o = (e == k) ? off[k] : o;
        const int pos = o + atomicAdd(&cnt2[e], 1);
        sltok[pos] = idx >> 1; slw[pos] = tokw[idx]; toks[idx] = pos;
    }
}
__device__ __forceinline__ void st_moe_up(const KP& p, int bid, int nb, char* lds) {
    const int tidx = opaque_tid();
    const int* cnt = WSP(int, OFF_CNT); const int* sltok = WSP(int, OFF_SLTOK);
    const bf16_t* H2 = WSP(bf16_t, OFF_H); const bf16_t* Wg = WSP(bf16_t, OFF_WB + WB_EG); const bf16_t* Wu = WSP(bf16_t, OFF_WB + WB_EU); bf16_t* Hid = WSP(bf16_t, OFF_HID);
    int off[17]; moe_offsets(cnt, off);
    const int ntiles = (off[16] >> 8) * 8;
    for (int L = bid; L < ntiles; L += nb) {
        const int mt = L >> 3, nt = L & 7, e = moe_expert_of(off, mt * 256);
        f32x16 acc[2][2]; acc_zero(acc);
        gemm_core(acc, [&](int r) { return H2 + (size_t)sltok[mt * 256 + r] * 1024; },
                  [&](int r) { const int wn = r >> 6, in = (r >> 5) & 1, j = r & 31; return (in ? Wu : Wg) + ((size_t)e * 512 + nt * 64 + wn * 32 + j) * 1024; }, 1024, lds);
        const int lane = tidx & 63, wid = tidx >> 6, wm = wid >> 1, wn = wid & 1, r32 = lane & 31, hi = lane >> 5;
#pragma unroll
        for (int im = 0; im < 2; ++im)
#pragma unroll
            for (int rg = 0; rg < 4; ++rg) {
                const int ml = wm * 64 + im * 32 + r32, col = nt * 64 + wn * 32 + 8 * rg + 4 * hi;
                float h[4];
#pragma unroll
                for (int q = 0; q < 4; ++q) h[q] = siluf_(acc[0][im][4 * rg + q]) * acc[1][im][4 * rg + q];
                uint2 o; o.x = pack2(h[0], h[1]); o.y = pack2(h[2], h[3]);
                *(uint2*)(Hid + (size_t)(mt * 256 + ml) * 512 + col) = o;
            }
    }
}
__device__ __forceinline__ void st_moe_down(const KP& p, int bid, int nb, char* lds) {
    const int tidx = opaque_tid();
    const int* cnt = WSP(int, OFF_CNT); const float* slw = WSP(float, OFF_SLW);
    const bf16_t* Hid = WSP(bf16_t, OFF_HID); const bf16_t* Wd = WSP(bf16_t, OFF_WB + WB_ED); bf16_t* Sl = WSP(bf16_t, OFF_SLOTS);
    int off[17]; moe_offsets(cnt, off);
    const int ntiles = (off[16] >> 8) * 8;
    for (int L = bid; L < ntiles; L += nb) {
        const int mt = L >> 3, nt = L & 7, e = moe_expert_of(off, mt * 256);
        f32x16 acc[2][2]; acc_zero(acc);
        gemm_core(acc, [&](int r) { return Hid + (size_t)(mt * 256 + r) * 512; }, [&](int r) { return Wd + ((size_t)e * 1024 + nt * 128 + r) * 512; }, 512, lds);
        acc_visit(acc, [&](int ml, int nl, f32x4 v) {
            const float w = slw[mt * 256 + ml];
            *(uint2*)(Sl + (size_t)(mt * 256 + ml) * 1024 + nt * 128 + nl) = pack4(v * w); });
    }
}
__device__ __forceinline__ void st_postffn(const KP& p, int l, int bid, int nb) {
    const int tidx = opaque_tid();
    const int lane = tidx & 63, wid = tidx >> 6;
    const bf16_t* Sl = WSP(bf16_t, OFF_SLOTS); const int* toks = WSP(int, OFF_TOKS);
    const float* gpost = p.in(I_GPOSTFFN) + l * D;
    const bool next = (l + 1 < NL);
    bf16_t* Hb = WSP(bf16_t, OFF_H); const float* gpre = p.in(I_GPREMIX) + (next ? l + 1 : l) * D;
    for (int r = bid * NWV + wid; r < T; r += nb * NWV) {
        float* xr = xrow(p, r);
        const float* md = WSP(float, OFF_MOD) + (size_t)(l * 2 + (r < LC ? 1 : 0)) * 6144;
        const bf16_t* s0 = Sl + (size_t)toks[r * 2] * 1024; const bf16_t* s1 = Sl + (size_t)toks[r * 2 + 1] * 1024;
        float v[16]; float ss = 0.f;
#pragma unroll
        for (int i = 0; i < 4; ++i) { const int c = i * 256 + lane * 4; const uint2 a = *(const uint2*)(s0 + c), b = *(const uint2*)(s1 + c);
            v[4 * i] = bflo(a.x) + bflo(b.x); v[4 * i + 1] = bfhi(a.x) + bfhi(b.x); v[4 * i + 2] = bflo(a.y) + bflo(b.y); v[4 * i + 3] = bfhi(a.y) + bfhi(b.y);
            ss += v[4 * i] * v[4 * i] + v[4 * i + 1] * v[4 * i + 1] + v[4 * i + 2] * v[4 * i + 2] + v[4 * i + 3] * v[4 * i + 3]; }
        ss = wave_sum(ss);
        const float rstd = rsqrtf(ss * (1.0f / D) + EPS);
        float4 xs[4]; float ss2 = 0.f;
#pragma unroll
        for (int i = 0; i < 4; ++i) { const int c = i * 256 + lane * 4;
            const float4 gg = *(const float4*)(gpost + c), ga = *(const float4*)(md + 5120 + c); float4 x = *(const float4*)(xr + c);
            x.x += ga.x * v[4 * i] * rstd * gg.x; x.y += ga.y * v[4 * i + 1] * rstd * gg.y; x.z += ga.z * v[4 * i + 2] * rstd * gg.z; x.w += ga.w * v[4 * i + 3] * rstd * gg.w;
            *(float4*)(xr + c) = x; xs[i] = x; ss2 += x.x * x.x + x.y * x.y + x.z * x.z + x.w * x.w; }
        if (next) {
            ss2 = wave_sum(ss2);
            const float rstd2 = rsqrtf(ss2 * (1.0f / D) + EPS);
            const float* md2 = WSP(float, OFF_MOD) + (size_t)((l + 1) * 2 + (r < LC ? 1 : 0)) * 6144;
#pragma unroll
            for (int i = 0; i < 4; ++i) { const int c = i * 256 + lane * 4;
                const float4 gg = *(const float4*)(gpre + c), sh = *(const float4*)(md2 + c), sc = *(const float4*)(md2 + 1024 + c);
                uint2 o; o.x = pack2(xs[i].x * rstd2 * gg.x * (1.f + sc.x) + sh.x, xs[i].y * rstd2 * gg.y * (1.f + sc.y) + sh.y);
                o.y = pack2(xs[i].z * rstd2 * gg.z * (1.f + sc.z) + sh.z, xs[i].w * rstd2 * gg.w * (1.f + sc.w) + sh.w);
                *(uint2*)(Hb + (size_t)r * D + c) = o; }
        }
    }
}

__device__ __forceinline__ void gsync(unsigned* bar, unsigned& epoch) {
    asm volatile("s_waitcnt vmcnt(0) lgkmcnt(0)" ::: "memory");
    __syncthreads();
    if (threadIdx.x == 0) {
        __builtin_amdgcn_fence(__ATOMIC_RELEASE, "agent");
        asm volatile("s_waitcnt vmcnt(0)" ::: "memory");
        epoch += 1;
        __hip_atomic_fetch_add(bar, 1u, __ATOMIC_RELAXED, __HIP_MEMORY_SCOPE_AGENT);
        const unsigned target = epoch * gridDim.x;
        while (__hip_atomic_load(bar, __ATOMIC_RELAXED, __HIP_MEMORY_SCOPE_AGENT) < target) __builtin_amdgcn_s_sleep(2);
        __builtin_amdgcn_fence(__ATOMIC_ACQUIRE, "agent");
        asm volatile("s_waitcnt vmcnt(0)" ::: "memory");
    }
    __syncthreads();
}

__global__ void __launch_bounds__(NTH) k_mega(Params p_unused) {
    KP p; p.k = (kparams_t)__builtin_amdgcn_kernarg_segment_ptr();
    __shared__ __attribute__((aligned(16))) char lds[LDS_BYTES]; float* smem = (float*)lds;
    cg::grid_group grid = cg::this_grid();
    grid.sync();
    const int bid = blockIdx.x, nb = gridDim.x;
    unsigned* bar = WSP(unsigned, OFF_BAR); unsigned epoch = 0;
#define GS() gsync(bar, epoch)
    st_prologue(p, bid, nb, smem); st_conv(p, 0, bid, nb, smem); st_s5_tables(p, 0, bid, nb, lds); GS();
    st_modulate(p, 0, bid, nb); GS();
#pragma unroll 1
    for (int l = 0; l < NL; ++l) {
        st_gemm_in(p, l, bid, nb, lds); GS();
        st_s5_local(p, l, bid, nb); st_s5_fgemm(p, bid, nb, lds); GS();
        st_s5_carry(p, l, bid, nb); st_proj2<0>(p, l, bid, nb, lds); GS();
        st_s5_ygemm(p, l, bid, nb, lds); st_s5_ctx_y(p, l, bid, nb); st_ropeq(p, bid, nb, lds); GS();
        st_proj2<1>(p, l, bid, nb, lds); st_attn(p, l, bid, nb, lds); GS();
        st_merge(p, bid, nb, lds); GS();
        st_wout(p, bid, nb, lds); st_conv_experts(p, l, bid, nb, smem); GS();
        st_postmix(p, l, bid, nb, lds); GS();
        st_moe_build(p, bid, nb); GS();
        st_moe_up(p, bid, nb, lds); GS();
        st_moe_down(p, bid, nb, lds); GS();
        st_postffn(p, l, bid, nb);
        if (l + 1 < NL) { st_conv(p, l + 1, bid, nb, smem); st_s5_tables(p, l + 1, bid, nb, lds); }
        GS();
    }
#undef GS
}

extern "C" void kernel_launch(void* const* d_in, const int* in_sizes, int n_in, void* d_out, int out_size, void* d_ws, size_t ws_size, hipStream_t stream) {
    Params p{};
    for (int i = 0; i < N_IN; ++i) p.in[i] = (const float*)d_in[i];
    p.out = (float*)d_out; p.ws = (char*)d_ws;
    if (ws_size < WS_NEED) { fprintf(stderr, "workspace too small: %zu < %zu\n", ws_size, (size_t)WS_NEED); return; }
    static int grid_blocks = 0;
    if (!grid_blocks) {
        int dev = 0, cus = 0, per_cu = 0;
        hipGetDevice(&dev);
        hipDeviceGetAttribute(&cus, hipDeviceAttributeMultiprocessorCount, dev);
        hipOccupancyMaxActiveBlocksPerMultiprocessor(&per_cu, k_mega, NTH, 0);
        if (per_cu > 1) per_cu = 1;
        if (per_cu < 1) per_cu = 1;
        grid_blocks = cus * per_cu;
    }
    hipMemsetAsync((char*)d_ws + OFF_BAR, 0, 256, stream);
    void* args[] = { &p };
    hipError_t e = hipLaunchCooperativeKernel((void*)k_mega, dim3(grid_blocks), dim3(NTH), args, 0, stream);
    if (e != hipSuccess) fprintf(stderr, "cooperative launch failed: %s (grid %d)\n", hipGetErrorString(e), grid_blocks);
}
```

```cpp
#include <hip/hip_runtime.h>
#include <hip/hip_cooperative_groups.h>
#include <cstdio>
#include <cstdint>
#include <type_traits>
namespace cg = cooperative_groups;


typedef unsigned short bf16_t;
typedef short bf16x8 __attribute__((ext_vector_type(8)));
typedef float f32x16 __attribute__((ext_vector_type(16)));
typedef float f32x4 __attribute__((ext_vector_type(4)));
typedef unsigned u32x4 __attribute__((ext_vector_type(4)));
constexpr int NTH = 512, NWV = 8;
#ifndef REP_CONV
#define REP_CONV 1
#endif
#ifndef REP_G1
#define REP_G1 1
#endif
#ifndef REP_G2
#define REP_G2 1
#endif
#ifndef REP_G3
#define REP_G3 1
#endif
#ifndef REP_S5
#define REP_S5 1
#endif
#ifndef REP_ATTN
#define REP_ATTN 1
#endif

constexpr int D = 1024, S = 16384, LC = 256, T = S + LC, NL = 2;
constexpr int NIN = 4768, NINP = 4864;
constexpr int PP = 1696;
constexpr int C_GQ = 0, C_GK = 512, C_GV = 640, C_CQ = 768, C_CKV = 1024, C_KR = 1152, C_SSM = 1184, C_GATE = 1696;
__host__ __device__ constexpr int win_col_old(int n) {
    return n < 512 ? 928 + n : n < 640 ? 1440 + (n - 512) : n < 768 ? 1568 + (n - 640) : n < 1024 ? (n - 768) : n < 1152 ? 256 + (n - 1024) : n < 1184 ? 384 + (n - 1152) : n < 1696 ? 416 + (n - 1184) : n;
}
constexpr int TP = 2 * T + 16 * 256;
constexpr float EPS = 1e-6f;
constexpr float LOG2E = 1.4426950408889634f;
constexpr float SC_MLA = 0.10206207261596575f * LOG2E, SC_GQA = 0.125f * LOG2E;

enum { I_X = 0, I_C, I_CTX, I_CCTX, I_WMOD, I_BMOD, I_GPREMIX, I_GPOSTMIX, I_GPREFFN, I_GPOSTFFN, I_WIN, I_GCQ, I_GCKV, I_WUQ, I_WUKV,
       I_GQN, I_GKN, I_ARE, I_AIM, I_LOGDT, I_BRE, I_BIM, I_CRE, I_CIM, I_SSMD, I_WGLU, I_BGLU, I_WBRM, I_WBRS, I_WBRG, I_WOUT,
       I_WGROUP, I_BGROUP, I_WROUTER, I_BROUTER, I_WEG, I_WEU, I_WED, N_IN };

constexpr size_t al256(size_t x) { return (x + 255) & ~(size_t)255; }
constexpr size_t WB_IN = 0;
constexpr size_t WB_UQ = WB_IN + (size_t)NINP * 1024 * 2;
constexpr size_t WB_UKV = WB_UQ + (size_t)768 * 256 * 2;
constexpr size_t WB_GLU = WB_UKV + (size_t)1024 * 128 * 2;
constexpr size_t WB_BR = WB_GLU + (size_t)512 * 512 * 2;
constexpr size_t WB_OUT = WB_BR + (size_t)3 * 1024 * 512 * 2;
constexpr size_t WB_EG = WB_OUT + (size_t)1024 * 1024 * 2;
constexpr size_t WB_EU = WB_EG + (size_t)16 * 512 * 1024 * 2;
constexpr size_t WB_ED = WB_EU + (size_t)16 * 512 * 1024 * 2;
constexpr size_t WB_BYTES = WB_ED + (size_t)16 * 1024 * 512 * 2;

constexpr size_t OFF_WB = 0;
constexpr size_t OFF_P = al256(OFF_WB + WB_BYTES);
constexpr size_t P_BYTES = (size_t)T * NIN * 2;
constexpr size_t OFF_GS = OFF_P + (size_t)T * PP * 2;
constexpr size_t OFF_Y = OFF_P;
constexpr size_t OFF_SLOTS = OFF_P;
constexpr size_t OFF_HID = OFF_P + (size_t)TP * 1024 * 2;
constexpr size_t OFF_H = al256(OFF_P + P_BYTES);
constexpr size_t OFF_KN = al256(OFF_H + (size_t)T * 1024 * 2);
constexpr size_t OFF_V = al256(OFF_KN + (size_t)T * 512 * 2);
constexpr size_t OFF_OM = al256(OFF_V + (size_t)T * 512 * 2);
constexpr size_t OFF_OG = OFF_OM + (size_t)T * 512 * 2;
constexpr size_t OFF_OS = OFF_OG + (size_t)T * 512 * 2;
constexpr size_t OFF_XC = al256(OFF_OS + (size_t)T * 512 * 2);
constexpr size_t OFF_MOD = al256(OFF_XC + (size_t)LC * 1024 * 4);
constexpr size_t OFF_TOKE = al256(OFF_MOD + (size_t)NL * 2 * 6144 * 4);
constexpr size_t OFF_TOKW = al256(OFF_TOKE + (size_t)T * 2 * 4);
constexpr size_t OFF_TOKS = al256(OFF_TOKW + (size_t)T * 2 * 4);
constexpr size_t OFF_SLTOK = al256(OFF_TOKS + (size_t)T * 2 * 4);
constexpr size_t OFF_SLW = al256(OFF_SLTOK + (size_t)TP * 4);
constexpr size_t OFF_CNT = al256(OFF_SLW + (size_t)TP * 4);
constexpr size_t OFF_S5 = al256(OFF_CNT + 256);
constexpr size_t OFF_ROPE = al256(OFF_S5 + (size_t)(T / 64) * 4096 * 8);
constexpr size_t OFF_SSQ = al256(OFF_ROPE + 256 * 24 * 8);
constexpr size_t OFF_BAR = al256(OFF_SSQ + (size_t)T * 8 * 4);
constexpr size_t WS_NEED = al256(OFF_BAR + 256);
static_assert(OFF_HID + (size_t)TP * 512 * 2 <= OFF_P + P_BYTES, "overlay");
static_assert((size_t)T * 1024 * 4 <= P_BYTES, "overlay Y");
static_assert(WS_NEED < 380000000ull, "ws");

struct Params {
    const float* in[N_IN];
    float* out;
    char* ws;
};
typedef const __attribute__((address_space(4))) Params* kparams_t;
struct KP {
    kparams_t k;
    __device__ __forceinline__ const float* in(int i) const { return *(const float* const volatile __attribute__((address_space(4)))*)(&k->in[i]); }
    __device__ __forceinline__ float* out() const { return *(float* const volatile __attribute__((address_space(4)))*)(&k->out); }
    __device__ __forceinline__ char* ws() const { return *(char* const volatile __attribute__((address_space(4)))*)(&k->ws); }
};

__device__ __forceinline__ float bf2f(bf16_t v) { return __uint_as_float(((unsigned)v) << 16); }
typedef __bf16 bf16x2_t __attribute__((ext_vector_type(2)));
__device__ __forceinline__ bf16_t f2bf(float f) { const __bf16 b = (__bf16)f; return __builtin_bit_cast(bf16_t, b); }
__device__ __forceinline__ float bflo(unsigned u) { return __uint_as_float(u << 16); }
__device__ __forceinline__ float bfhi(unsigned u) { return __uint_as_float(u & 0xFFFF0000u); }
__device__ __forceinline__ unsigned pack2(float lo, float hi) { bf16x2_t v; v[0] = (__bf16)lo; v[1] = (__bf16)hi; return __builtin_bit_cast(unsigned, v); }
__device__ __forceinline__ float wave_sum(float v) {
#pragma unroll
    for (int o = 32; o > 0; o >>= 1) v += __shfl_xor(v, o);
    return v;
}
__device__ __forceinline__ float xhalf_max(float m) { auto rr = __builtin_amdgcn_permlane32_swap(__float_as_uint(m), __float_as_uint(m), false, false); return fmaxf(__uint_as_float(rr[0]), __uint_as_float(rr[1])); }
__device__ __forceinline__ float xhalf_sum(float m) { auto rr = __builtin_amdgcn_permlane32_swap(__float_as_uint(m), __float_as_uint(m), false, false); return __uint_as_float(rr[0]) + __uint_as_float(rr[1]); }
__device__ __forceinline__ void rope_tab(float& a, float& b, float2 cs) { const float na = a * cs.x - b * cs.y, nb_ = a * cs.y + b * cs.x; a = na; b = nb_; }
__device__ __forceinline__ float transpose_reduce16(const float (&t16)[16], int lane) {
    float t8[8], t4[4], t2[2];
#pragma unroll
    for (int i = 0; i < 8; ++i) { const float a = t16[2 * i], b = t16[2 * i + 1]; const bool o = lane & 1; const float keep = o ? b : a, send = o ? a : b; t8[i] = keep + __shfl_xor(send, 1); }
#pragma unroll
    for (int i = 0; i < 4; ++i) { const float a = t8[2 * i], b = t8[2 * i + 1]; const bool o = lane & 2; const float keep = o ? b : a, send = o ? a : b; t4[i] = keep + __shfl_xor(send, 2); }
#pragma unroll
    for (int i = 0; i < 2; ++i) { const float a = t4[2 * i], b = t4[2 * i + 1]; const bool o = lane & 4; const float keep = o ? b : a, send = o ? a : b; t2[i] = keep + __shfl_xor(send, 4); }
    float y; { const float a = t2[0], b = t2[1]; const bool o = lane & 8; const float keep = o ? b : a, send = o ? a : b; y = keep + __shfl_xor(send, 8); }
    y += __shfl_xor(y, 16); y += __shfl_xor(y, 32);
    return y;
}
__device__ __forceinline__ float sigmoidf_(float x) { return __builtin_amdgcn_rcpf(1.0f + __builtin_amdgcn_exp2f(-LOG2E * x)); }
__device__ __forceinline__ float siluf_(float x) { return x * __builtin_amdgcn_rcpf(1.0f + __builtin_amdgcn_exp2f(-LOG2E * x)); }
__device__ __forceinline__ float gelu_tanh(float x) {
    const float u = 0.7978845608028654f * (x + 0.044715f * x * x * x);
    return x * __builtin_amdgcn_rcpf(1.0f + __builtin_amdgcn_exp2f(-2.0f * LOG2E * u));
}
__device__ __forceinline__ float dot8(uint4 a, uint4 b, float acc) {
    acc = fmaf(bflo(a.x), bflo(b.x), acc); acc = fmaf(bfhi(a.x), bfhi(b.x), acc);
    acc = fmaf(bflo(a.y), bflo(b.y), acc); acc = fmaf(bfhi(a.y), bfhi(b.y), acc);
    acc = fmaf(bflo(a.z), bflo(b.z), acc); acc = fmaf(bfhi(a.z), bfhi(b.z), acc);
    acc = fmaf(bflo(a.w), bflo(b.w), acc); acc = fmaf(bfhi(a.w), bfhi(b.w), acc);
    return acc;
}
__device__ __forceinline__ float dotrow(const bf16_t* a, const bf16_t* b, int K) {
    float acc = 0.f;
    const uint4* a4 = (const uint4*)a; const uint4* b4 = (const uint4*)b;
    for (int k = 0; k < K / 8; ++k) acc = dot8(a4[k], b4[k], acc);
    return acc;
}

__device__ __forceinline__ int opaque_tid() { int t = threadIdx.x; asm volatile("" : "+v"(t)); return t; }
#define WSP(type, off) ((type*)(p.ws() + (off)))

template <class AF, class BF, class EF>
__device__ __forceinline__ void gemm_naive(int M, int N, int K, AF arow, BF brow, EF epi, int bid, int nb) {
    const int tidx = opaque_tid();
    const long total = (long)M * N;
    for (long idx = (long)bid * NTH + tidx; idx < total; idx += (long)nb * NTH) {
        const int m = (int)(idx / N), n = (int)(idx % N);
        const float acc = dotrow(arow(m), brow(m, n), K);
        epi(m, n, acc);
    }
}

constexpr int G_A_BYTES = 256 * 128, G_W_BYTES = 128 * 128, G_BUF = G_A_BYTES + G_W_BYTES;
constexpr int LDS_BYTES = 3 * G_BUF;
#define MFMA32(a, b, c) __builtin_amdgcn_mfma_f32_32x32x16_bf16(a, b, c, 0, 0, 0)

#define GLDS16(gptr, lptr) __builtin_amdgcn_global_load_lds((const __attribute__((address_space(1))) void*)(gptr), (__attribute__((address_space(3))) void*)(lptr), 16, 0, 0)
typedef f32x4 acc_t[4][4];
#define MFMA16(a, b, c) __builtin_amdgcn_mfma_f32_16x16x32_bf16(a, b, c, 0, 0, 0)
template <class APTR, class WPTR>
__device__ __forceinline__ void gemm_core_g(acc_t& acc, APTR aptr, WPTR wptr, int nk, char* lds) {
    const int tidx = opaque_tid();
    const int tid = tidx, lane = tid & 63, wid = tid >> 6, wm = wid >> 1, wn = wid & 1, fr = lane & 15, g = lane >> 4;
    const int wu = __builtin_amdgcn_readfirstlane(wid);
    char* sdst = lds + wu * 1024;
    const int xoff = (wm * 64 + fr) * 128, woff = G_A_BYTES + (wn * 64 + fr) * 128, sw7 = (fr >> 1) & 7;
    asm volatile("s_waitcnt vmcnt(0)" ::: "memory");
#pragma unroll
    for (int i = 0; i < 4; ++i) GLDS16(aptr(i, 0), sdst + i * 8192);
#pragma unroll
    for (int i = 0; i < 2; ++i) GLDS16(wptr(i, 0), sdst + G_A_BYTES + i * 8192);
    if (nk > 1) {
#pragma unroll
        for (int i = 0; i < 4; ++i) GLDS16(aptr(i, 1), sdst + G_BUF + i * 8192);
#pragma unroll
        for (int i = 0; i < 2; ++i) GLDS16(wptr(i, 1), sdst + G_BUF + G_A_BYTES + i * 8192);
        asm volatile("s_waitcnt vmcnt(6)" ::: "memory");
    } else asm volatile("s_waitcnt vmcnt(0)" ::: "memory");
    __builtin_amdgcn_s_barrier();
    int slot = 0;
    for (int kt = 0; kt < nk; ++kt) {
        const char* cur = lds + slot * G_BUF;
        const int s2 = slot >= 1 ? slot - 1 : 2;
        const bool more2 = (kt + 2 < nk);
        char* nxt = sdst + s2 * G_BUF;
#pragma unroll
        for (int ks = 0; ks < 2; ++ks) {
            const int co = ((ks * 4 + g) ^ sw7) << 4;
            bf16x8 x[4], w[4];
#pragma unroll
            for (int i = 0; i < 4; ++i) { x[i] = *(const bf16x8*)(cur + xoff + i * 16 * 128 + co); w[i] = *(const bf16x8*)(cur + woff + i * 16 * 128 + co); }
#pragma unroll
            for (int in = 0; in < 4; ++in)
#pragma unroll
                for (int im = 0; im < 4; ++im) acc[in][im] = MFMA16(w[in], x[im], acc[in][im]);
            __builtin_amdgcn_sched_barrier(0);
            if (more2) {
                if (ks == 0) { GLDS16(aptr(0, kt + 2), nxt); GLDS16(aptr(1, kt + 2), nxt + 8192); GLDS16(aptr(2, kt + 2), nxt + 2 * 8192); }
                else { GLDS16(aptr(3, kt + 2), nxt + 3 * 8192); GLDS16(wptr(0, kt + 2), nxt + G_A_BYTES); GLDS16(wptr(1, kt + 2), nxt + G_A_BYTES + 8192); }
            }
            __builtin_amdgcn_sched_barrier(0);
        }
        if (more2) asm volatile("s_waitcnt vmcnt(6) lgkmcnt(0)" ::: "memory");
        else asm volatile("s_waitcnt vmcnt(0) lgkmcnt(0)" ::: "memory");
        __builtin_amdgcn_s_barrier();
        slot = slot == 2 ? 0 : slot + 1;
    }
}
template <class AROW, class WROW>
__device__ __forceinline__ void gemm_core(acc_t& acc, AROW arow, WROW wrow, int K, char* lds) {
    const int tidx = opaque_tid();
    const int srow = tidx >> 3, gch = (tidx & 7) ^ ((srow >> 1) & 7);
    const bf16_t* pa[4]; const bf16_t* pw[2];
#pragma unroll
    for (int i = 0; i < 4; ++i) pa[i] = arow(srow + 64 * i) + gch * 8;
#pragma unroll
    for (int i = 0; i < 2; ++i) pw[i] = wrow(srow + 64 * i) + gch * 8;
    gemm_core_g(acc, [&](int i, int kt) { return pa[i] + kt * 64; }, [&](int i, int kt) { return pw[i] + kt * 64; }, K >> 6, lds);
}
__device__ __forceinline__ void acc_zero(acc_t& acc) {
#pragma unroll
    for (int a = 0; a < 4; ++a)
#pragma unroll
        for (int b = 0; b < 4; ++b) { acc[a][b][0] = 0.f; acc[a][b][1] = 0.f; acc[a][b][2] = 0.f; acc[a][b][3] = 0.f; }
}
template <class F>
__device__ __forceinline__ void acc_visit(const acc_t& acc, F f) {
    const int tidx = opaque_tid();
    const int lane = tidx & 63, wid = tidx >> 6, wm = wid >> 1, wn = wid & 1, fr = lane & 15, g = lane >> 4;
#pragma unroll
    for (int in = 0; in < 4; ++in)
#pragma unroll
        for (int im = 0; im < 4; ++im) f(wm * 64 + 16 * im + fr, wn * 64 + 16 * in + 4 * g, acc[in][im]);
}
template <class F>
__device__ __forceinline__ void acc_visit_add(const acc_t& acc, acc_t& tot, F f) {
    const int tidx = opaque_tid();
    const int lane = tidx & 63, wid = tidx >> 6, wm = wid >> 1, wn = wid & 1, fr = lane & 15, g = lane >> 4;
#pragma unroll
    for (int in = 0; in < 4; ++in)
#pragma unroll
        for (int im = 0; im < 4; ++im) tot[in][im] += f(wm * 64 + 16 * im + fr, wn * 64 + 16 * in + 4 * g, acc[in][im]);
}
__device__ __forceinline__ uint2 pack4(f32x4 v) { uint2 o; o.x = pack2(v[0], v[1]); o.y = pack2(v[2], v[3]); return o; }
__device__ __forceinline__ bool dense_tile(int it, int NT, bool with_ctx, int bid, int nb, int& mt, int& nt) {
    const int x = bid & 7, j = bid >> 3, jb = nb >> 3;
    int v = it * jb + j;
    if (v < 8 * NT) { mt = 1 + x * 8 + (v & 7); nt = v >> 3; return true; }
    if (!with_ctx) return false;
    v -= 8 * NT; nt = x + 8 * v; mt = 0;
    return nt < NT;
}

__device__ __forceinline__ void st_prologue(const KP& p, int bid, int nb, float* smem) {
    const int tidx = opaque_tid();
    const int tid = tidx;
    {   float2* t16 = WSP(float2, OFF_ROPE); float2* t8 = t16 + 256 * 16;
        for (int idx = bid * NTH + tid; idx < 256 * 24; idx += nb * NTH) {
            const bool big = idx < 256 * 16; const int j = big ? idx : idx - 256 * 16, half = big ? 16 : 8, pos = j / half, i = j % half;
            const float ang = (float)pos * powf(10000.0f, -(float)i / (float)half);
            float sn, cs; sincosf(ang, &sn, &cs);
            (big ? t16 : t8)[j] = make_float2(cs, sn);
        } }
    for (int k = tid; k < 1024; k += NTH) { smem[k] = siluf_(p.in(I_C)[k]); smem[1024 + k] = siluf_(p.in(I_CCTX)[k]); }
    __syncthreads();
    float* mod = WSP(float, OFF_MOD);
    float4* red = (float4*)(smem + 2048);
    for (int jb = bid; jb < 256; jb += nb) {
        const int l = jb >> 7, j0 = (jb & 127) * 48, jj = tid % 12, kk = tid / 12;
        float4 a0 = make_float4(0.f, 0.f, 0.f, 0.f), a1 = a0;
        if (kk < 42) {
            const float* w = p.in(I_WMOD) + (size_t)l * 1024 * 6144 + j0 + jj * 4;
            for (int k = kk; k < 1024; k += 42) { const float4 wv = *(const float4*)(w + (size_t)k * 6144); const float s0 = smem[k], s1 = smem[1024 + k];
                a0.x = fmaf(s0, wv.x, a0.x); a0.y = fmaf(s0, wv.y, a0.y); a0.z = fmaf(s0, wv.z, a0.z); a0.w = fmaf(s0, wv.w, a0.w);
                a1.x = fmaf(s1, wv.x, a1.x); a1.y = fmaf(s1, wv.y, a1.y); a1.z = fmaf(s1, wv.z, a1.z); a1.w = fmaf(s1, wv.w, a1.w); }
            red[(kk * 12 + jj) * 2] = a0; red[(kk * 12 + jj) * 2 + 1] = a1;
        }
        __syncthreads();
        if (tid < 24) {
            const int cj = tid >> 1, cond = tid & 1;
            float4 s = make_float4(0.f, 0.f, 0.f, 0.f);
            for (int q = 0; q < 42; ++q) { const float4 v = red[(q * 12 + cj) * 2 + cond]; s.x += v.x; s.y += v.y; s.z += v.z; s.w += v.w; }
            const float4 b = *(const float4*)(p.in(I_BMOD) + l * 6144 + j0 + cj * 4);
            s.x += b.x; s.y += b.y; s.z += b.z; s.w += b.w;
            *(float4*)(mod + (size_t)(l * 2 + cond) * 6144 + j0 + cj * 4) = s;
        }
        __syncthreads();
    }
}

template <class COLF, class KSF>
__device__ __forceinline__ void conv_t_g(const float* W, bf16_t* Wt, int K, int N, int Npad, int nmat, int bid, int nb, float* smem, COLF colf, KSF ksf) {
    const int tidx = opaque_tid();
    const int tid = tidx, tx = tid & 63, ty = tid >> 6;
    const int tn = Npad / 64, tk = K / 64;
    const int ntile = tn * tk * nmat;
    for (int t = bid; t < ntile; t += nb) {
        const int mat = t / (tn * tk), r = t % (tn * tk), n0 = (r / tk) * 64, k0 = (r % tk) * 64;
        const float* Wm = W + (size_t)mat * K * N; bf16_t* Wtm = Wt + (size_t)mat * Npad * K;
        __syncthreads();
#pragma unroll
        for (int i = 0; i < 8; ++i) { const int kk = ty + 8 * i, n = n0 + tx; smem[kk * 65 + tx] = (n < N) ? Wm[(size_t)(k0 + kk) * N + colf(n)] * ksf(k0 + kk) : 0.f; }
        __syncthreads();
#pragma unroll
        for (int i = 0; i < 8; ++i) { const int nn = ty + 8 * i; Wtm[(size_t)(n0 + nn) * K + k0 + tx] = f2bf(smem[tx * 65 + nn]); }
    }
    __syncthreads();
}
__device__ __forceinline__ void conv_t(const float* W, bf16_t* Wt, int K, int N, int Npad, int nmat, int bid, int nb, float* smem) {
    conv_t_g(W, Wt, K, N, Npad, nmat, bid, nb, smem, [](int n) { return n; }, [](int) { return 1.0f; });
}
__device__ __forceinline__ void st_conv(const KP& p, int l, int bid, int nb, float* smem) {
    const int tidx = opaque_tid(); (void)tidx;
    bf16_t* wb = WSP(bf16_t, OFF_WB);
    conv_t_g(p.in(I_WIN) + (size_t)l * 1024 * NIN, (bf16_t*)((char*)wb + WB_IN), 1024, NIN, NINP, 1, bid, nb, smem, [](int n) { return win_col_old(n); }, [](int) { return 1.0f; });
    {   const float* gcq = p.in(I_GCQ) + l * 256; const float* gckv = p.in(I_GCKV) + l * 128;
        conv_t_g(p.in(I_WUQ) + (size_t)l * 256 * 768, (bf16_t*)((char*)wb + WB_UQ), 256, 768, 768, 1, bid, nb, smem, [](int n) { return n; }, [&](int k) { return gcq[k]; });
        conv_t_g(p.in(I_WUKV) + (size_t)l * 128 * 1024, (bf16_t*)((char*)wb + WB_UKV), 128, 1024, 1024, 1, bid, nb, smem, [](int n) { return n; }, [&](int k) { return gckv[k]; }); }
    conv_t(p.in(I_WGLU) + (size_t)l * 512 * 512, (bf16_t*)((char*)wb + WB_GLU), 512, 512, 512, 1, bid, nb, smem);
    conv_t(p.in(I_WBRM) + (size_t)l * 512 * 1024, (bf16_t*)((char*)wb + WB_BR), 512, 1024, 1024, 1, bid, nb, smem);
    conv_t(p.in(I_WBRS) + (size_t)l * 512 * 1024, (bf16_t*)((char*)wb + WB_BR + (size_t)1024 * 512 * 2), 512, 1024, 1024, 1, bid, nb, smem);
    conv_t(p.in(I_WBRG) + (size_t)l * 512 * 1024, (bf16_t*)((char*)wb + WB_BR + (size_t)2 * 1024 * 512 * 2), 512, 1024, 1024, 1, bid, nb, smem);
    conv_t(p.in(I_WOUT) + (size_t)l * 1024 * 1024, (bf16_t*)((char*)wb + WB_OUT), 1024, 1024, 1024, 1, bid, nb, smem);
}
__device__ __forceinline__ void st_conv_experts(const KP& p, int l, int bid, int nb, float* smem) {
    const int tidx = opaque_tid(); (void)tidx;
    bf16_t* wb = WSP(bf16_t, OFF_WB);
    conv_t(p.in(I_WEG) + (size_t)l * 16 * 1024 * 512, (bf16_t*)((char*)wb + WB_EG), 1024, 512, 512, 16, bid, nb, smem);
    conv_t(p.in(I_WEU) + (size_t)l * 16 * 1024 * 512, (bf16_t*)((char*)wb + WB_EU), 1024, 512, 512, 16, bid, nb, smem);
    conv_t(p.in(I_WED) + (size_t)l * 16 * 512 * 1024, (bf16_t*)((char*)wb + WB_ED), 512, 1024, 1024, 16, bid, nb, smem);
}

__device__ __forceinline__ const float* xrow_c(const KP& p, int r) { return (r < LC) ? (WSP(float, OFF_XC) + (size_t)r * D) : (p.out() + (size_t)(r - LC) * D); }
__device__ __forceinline__ const float* xrow_in(const KP& p, int r) { return (r < LC) ? (p.in(I_CTX) + (size_t)r * D) : (p.in(I_X) + (size_t)(r - LC) * D); }
__device__ __forceinline__ float* xrow(const KP& p, int r) { return (r < LC) ? (WSP(float, OFF_XC) + (size_t)r * D) : (p.out() + (size_t)(r - LC) * D); }
__device__ __forceinline__ void st_modulate(const KP& p, int l, int bid, int nb) {
    const int tidx = opaque_tid();
    const int lane = tidx & 63, wid = tidx >> 6;
    bf16_t* Hb = WSP(bf16_t, OFF_H);
    const float* g = p.in(I_GPREMIX) + l * D;
    for (int r = bid * NWV + wid; r < T; r += nb * NWV) {
        const float* xr = l == 0 ? xrow_in(p, r) : xrow_c(p, r);
        const float* md = WSP(float, OFF_MOD) + (size_t)(l * 2 + (r < LC ? 1 : 0)) * 6144;
        float4 v[4]; float ss = 0.f;
#pragma unroll
        for (int i = 0; i < 4; ++i) { v[i] = *(const float4*)(xr + i * 256 + lane * 4); ss += v[i].x * v[i].x + v[i].y * v[i].y + v[i].z * v[i].z + v[i].w * v[i].w; }
        ss = wave_sum(ss);
        const float rstd = rsqrtf(ss * (1.0f / D) + EPS);
#pragma unroll
        for (int i = 0; i < 4; ++i) {
            const int c = i * 256 + lane * 4;
            const float4 gg = *(const float4*)(g + c), sh = *(const float4*)(md + c), sc = *(const float4*)(md + 1024 + c);
            const float h0 = v[i].x * rstd * gg.x * (1.f + sc.x) + sh.x, h1 = v[i].y * rstd * gg.y * (1.f + sc.y) + sh.y;
            const float h2 = v[i].z * rstd * gg.z * (1.f + sc.z) + sh.z, h3 = v[i].w * rstd * gg.w * (1.f + sc.w) + sh.w;
            uint2 o; o.x = pack2(h0, h1); o.y = pack2(h2, h3);
            *(uint2*)(Hb + (size_t)r * D + c) = o;
        }
    }
}

__device__ __forceinline__ void st_gemm_in(const KP& p, int l, int bid, int nb, char* lds) {
    const int tidx = opaque_tid();
    if (bid == 0 && tidx < 8) WSP(unsigned, OFF_CNT)[32 + tidx] = 0u;
    const bf16_t* Hb = WSP(bf16_t, OFF_H); const bf16_t* Wt = WSP(bf16_t, OFF_WB + WB_IN); bf16_t* P = WSP(bf16_t, OFF_P);
    float* ssq = WSP(float, OFF_SSQ); const float2* t16 = WSP(float2, OFF_ROPE); const float2* t8 = t16 + 256 * 16;
    const float* gqn = p.in(I_GQN) + l * 64; const float* gkn = p.in(I_GKN) + l * 64;
    const int lane = tidx & 63, wid = tidx >> 6, wm = wid >> 1, wn = wid & 1, fr = lane & 15, g = lane >> 4;
    int mt, nt;
    for (int it = 0; dense_tile(it, NINP / 128, true, bid, nb, mt, nt); ++it) {
        acc_t acc; acc_zero(acc);
        gemm_core(acc, [&](int r) { return Hb + (size_t)(mt * 256 + r) * 1024; }, [&](int r) { return Wt + (size_t)(nt * 128 + r) * 1024; }, 1024, lds);
#pragma unroll
        for (int im = 0; im < 4; ++im) {
            const int row = mt * 256 + wm * 64 + 16 * im + fr;
            bf16_t* prow_ = P + (size_t)row * PP + nt * 128 + wn * 64 + 4 * g;
            const bool lat = row >= LC; const int tpos = row - LC, prow = lat ? (tpos >> 6) : 0, pcol = lat ? (tpos & 63) : 0;
            f32x4 v[4];
#pragma unroll
            for (int in = 0; in < 4; ++in) v[in] = acc[in][im];
            if (nt <= 4) {
                float ss = 0.f;
#pragma unroll
                for (int in = 0; in < 4; ++in) ss += (v[in][0] * v[in][0] + v[in][1] * v[in][1]) + (v[in][2] * v[in][2] + v[in][3] * v[in][3]);
                ss += __shfl_xor(ss, 16); ss += __shfl_xor(ss, 32);
                const float sc = rsqrtf(ss * (1.0f / 64.0f) + EPS) * (nt < 4 ? SC_GQA : 1.0f);
                const float* gg = (nt < 4 ? gqn : gkn) + 4 * g;
#pragma unroll
                for (int in = 0; in < 4; ++in) { const float4 g4 = *(const float4*)(gg + 16 * in); v[in][0] *= sc * g4.x; v[in][1] *= sc * g4.y; v[in][2] *= sc * g4.z; v[in][3] *= sc * g4.w; }
                if (lat) {
#pragma unroll
                    for (int hlf = 0; hlf < 2; ++hlf) {
                        const float4* cs = (const float4*)(t16 + (hlf == 0 ? prow : pcol) * 16 + 4 * g);
                        const float4 c01 = cs[0], c23 = cs[1];
                        const f32x4 cc = {c01.x, c01.z, c23.x, c23.z}, sn = {c01.y, c01.w, c23.y, c23.w}, a = v[2 * hlf], b = v[2 * hlf + 1];
                        v[2 * hlf] = a * cc - b * sn; v[2 * hlf + 1] = a * sn + b * cc; }
                }
            } else if (nt >= 6 && nt <= 8) {
                float ss = 0.f;
#pragma unroll
                for (int in = 0; in < 4; ++in) ss += (v[in][0] * v[in][0] + v[in][1] * v[in][1]) + (v[in][2] * v[in][2] + v[in][3] * v[in][3]);
                ss += __shfl_xor(ss, 16); ss += __shfl_xor(ss, 32);
                if (g == 0) ssq[(size_t)row * 8 + (nt - 6) * 2 + wn] = ss;
            } else if (nt == 9 && wn == 0) {
#pragma unroll
                for (int in = 0; in < 2; ++in) {
                    f32x4 o; o[0] = __shfl_xor(v[in][0], 32); o[1] = __shfl_xor(v[in][1], 32); o[2] = __shfl_xor(v[in][2], 32); o[3] = __shfl_xor(v[in][3], 32);
                    if (lat) { const float4* cs = (const float4*)(t8 + (in == 0 ? prow : pcol) * 8 + 4 * (g & 1));
                        const float4 c01 = cs[0], c23 = cs[1];
                        if (g < 2) { v[in][0] = v[in][0] * c01.x - o[0] * c01.y; v[in][1] = v[in][1] * c01.z - o[1] * c01.w; v[in][2] = v[in][2] * c23.x - o[2] * c23.y; v[in][3] = v[in][3] * c23.z - o[3] * c23.w; }
                        else { v[in][0] = o[0] * c01.y + v[in][0] * c01.x; v[in][1] = o[1] * c01.w + v[in][1] * c01.z; v[in][2] = o[2] * c23.y + v[in][2] * c23.x; v[in][3] = o[3] * c23.w + v[in][3] * c23.z; } }
                }
            }
#pragma unroll
            for (int in = 0; in < 4; ++in) {
                const int G = nt * 8 + wn * 4 + in;
                if (G >= 106) {
                    if (G < 298) {
                        uint2 o; o.x = pack2(sigmoidf_(v[in][0]), sigmoidf_(v[in][1])); o.y = pack2(sigmoidf_(v[in][2]), sigmoidf_(v[in][3]));
                        *(uint2*)(WSP(bf16_t, OFF_GS) + (((((size_t)(mt * 192 + (G - 106)) * 4 + wm) * 4 + im) * 64) + lane) * 4) = o; }
                } else *(uint2*)(prow_ + 16 * in) = pack4(v[in]);
            }
        }
    }
}

__device__ __forceinline__ void rope_pair(float& a, float& b, int pos, int i, int half) {
    const float freq = powf(10000.0f, -(float)i / (float)half);
    const float ang = (float)pos * freq;
    float sn, cs; sincosf(ang, &sn, &cs);
    const float na = a * cs - b * sn, nb_ = a * sn + b * cs; a = na; b = nb_;
}

constexpr int S5C = 64, NCH = T / S5C;
constexpr size_t S5_ZERO = OFF_WB + WB_EG;
constexpr size_t S5_KTAB = S5_ZERO + 256;
constexpr size_t S5_FTAB = S5_KTAB + (size_t)64 * 64 * 256 * 2;
constexpr size_t S5_GTAB = S5_FTAB + (size_t)64 * 128 * 1024 * 2;
constexpr size_t S5_SINB = S5_GTAB + (size_t)64 * 1024 * 128 * 2;
static_assert(S5_SINB + (size_t)NCH * 64 * 128 * 2 <= OFF_WB + WB_BYTES, "s5 tables overlay");
__device__ __forceinline__ int s5_row(int dir, int j) { return dir == 0 ? j : (j < LC ? LC - 1 - j : T + LC - 1 - j); }
__device__ __forceinline__ void s5_consts(const KP& p, int l, int dir, int g, int lane, float& lr, float& li, float (&bbr)[16], float (&bbi)[16]) {
    const int gi = (l * 2 + dir) * 32 + g, pi = gi * 64 + lane;
    const float are = p.in(I_ARE)[pi], aim = p.in(I_AIM)[pi], dt = expf(p.in(I_LOGDT)[gi]);
    const float mag = expf(are * dt); float sn, cs; sincosf(aim * dt, &sn, &cs);
    lr = mag * cs; li = mag * sn; const float den = are * are + aim * aim;
    const float cr = ((lr - 1.0f) * are + li * aim) / den, ci = (li * are - (lr - 1.0f) * aim) / den;
    const float4* br4 = (const float4*)(p.in(I_BRE) + (size_t)pi * 16); const float4* bi4 = (const float4*)(p.in(I_BIM) + (size_t)pi * 16);
#pragma unroll
    for (int q = 0; q < 4; ++q) { const float4 br = br4[q], bi = bi4[q];
        bbr[4 * q] = cr * br.x - ci * bi.x; bbi[4 * q] = cr * bi.x + ci * br.x; bbr[4 * q + 1] = cr * br.y - ci * bi.y; bbi[4 * q + 1] = cr * bi.y + ci * br.y;
        bbr[4 * q + 2] = cr * br.z - ci * bi.z; bbi[4 * q + 2] = cr * bi.z + ci * br.z; bbr[4 * q + 3] = cr * br.w - ci * bi.w; bbi[4 * q + 3] = cr * bi.w + ci * br.w; }
}
__device__ __forceinline__ void s5_unpack(uint4 a, uint4 b, float (&u)[16]) {
    u[0] = bflo(a.x); u[1] = bfhi(a.x); u[2] = bflo(a.y); u[3] = bfhi(a.y); u[4] = bflo(a.z); u[5] = bfhi(a.z); u[6] = bflo(a.w); u[7] = bfhi(a.w);
    u[8] = bflo(b.x); u[9] = bfhi(b.x); u[10] = bflo(b.y); u[11] = bfhi(b.y); u[12] = bflo(b.z); u[13] = bfhi(b.z); u[14] = bflo(b.w); u[15] = bfhi(b.w);
}
__device__ __forceinline__ void st_s5_local(const KP& p, int l, int bid, int nb) {
    const int tidx = opaque_tid();
    const int lane = tidx & 63, wid = tidx >> 6;
    const bf16_t* P = WSP(bf16_t, OFF_P); float2* F = WSP(float2, OFF_S5);
    const int gw = bid * NWV + wid, nw = nb * NWV;
    if (gw >= (nw / 64) * 64) return;
    const int gd = gw & 63, dir = gd >> 5, g = gd & 31, part = gw >> 6, nparts = nw >> 6;
    if (part >= 4) return;
    float lr, li, bbr[16], bbi[16]; s5_consts(p, l, dir, g, lane, lr, li, bbr, bbi);
    for (int c = part; c < 4; c += nparts) {
        float sr = 0.f, si = 0.f;
        for (int j0 = 0; j0 < S5C; j0 += 8) {
            uint4 ua[8], ub[8];
#pragma unroll
            for (int q = 0; q < 8; ++q) { const int r = s5_row(dir, c * S5C + j0 + q); const uint4* up = (const uint4*)(P + (size_t)r * PP + C_SSM + g * 16); ua[q] = up[0]; ub[q] = up[1]; }
#pragma unroll
            for (int q = 0; q < 8; ++q) { float u[16]; s5_unpack(ua[q], ub[q], u);
                float bur = 0.f, bui = 0.f;
#pragma unroll
                for (int cc = 0; cc < 16; ++cc) { bur = fmaf(bbr[cc], u[cc], bur); bui = fmaf(bbi[cc], u[cc], bui); }
                const float nsr = lr * sr - li * si + bur, nsi = lr * si + li * sr + bui; sr = nsr; si = nsi; }
        }
        F[((size_t)(c * 2 + dir) * 32 + g) * 64 + lane] = make_float2(sr, si);
    }
}
__device__ __forceinline__ void st_s5_carry(const KP& p, int l, int bid, int nb, char* lds) {
    const int tidx = opaque_tid();
    float2* F = WSP(float2, OFF_S5); bf16_t* SB = WSP(bf16_t, S5_SINB);
    float4* comp = (float4*)lds;
    constexpr int RUN = 9;
    for (int cb = bid; cb < 256; cb += nb) {
        const int chl = tidx & 15, seg = tidx >> 4, idx = cb * 16 + chl;
        const int gi = l * 64 + (idx >> 6);
        const float are = p.in(I_ARE)[gi * 64 + (idx & 63)], aim = p.in(I_AIM)[gi * 64 + (idx & 63)], dt = expf(p.in(I_LOGDT)[gi]);
        const float mag = expf(are * dt); float sn, cs; sincosf(aim * dt, &sn, &cs);
        float pr = mag * cs, pi_ = mag * sn;
#pragma unroll
        for (int q = 0; q < 6; ++q) { const float nr = pr * pr - pi_ * pi_, ni = 2.f * pr * pi_; pr = nr; pi_ = ni; }
        const int c0 = seg * RUN;
        float2 f[RUN]; float ar = 1.f, ai = 0.f, br = 0.f, bi = 0.f;
#pragma unroll
        for (int q = 0; q < RUN; ++q) { const int c = c0 + q; f[q] = (c < NCH) ? F[(size_t)c * 4096 + idx] : make_float2(0.f, 0.f);
            if (c < NCH) { const float nbr = pr * br - pi_ * bi + f[q].x, nbi = pr * bi + pi_ * br + f[q].y; br = nbr; bi = nbi;
                           const float nar = pr * ar - pi_ * ai, nai = pr * ai + pi_ * ar; ar = nar; ai = nai; } }
        __syncthreads();
        comp[chl * 32 + seg] = make_float4(ar, ai, br, bi);
        __syncthreads();
        float sr = 0.f, si = 0.f;
        for (int j = 0; j < seg; ++j) { const float4 cj = comp[chl * 32 + j]; const float nr = cj.x * sr - cj.y * si + cj.z, ni = cj.x * si + cj.y * sr + cj.w; sr = nr; si = ni; }
#pragma unroll
        for (int q = 0; q < RUN; ++q) { const int c = c0 + q;
            if (c < NCH) { F[(size_t)c * 4096 + idx] = make_float2(sr, si);
                bf16_t* sb = SB + ((size_t)c * 64 + (idx >> 6)) * 128 + (idx & 63); sb[0] = f2bf(sr); sb[64] = f2bf(si);
                const float nr = pr * sr - pi_ * si + f[q].x, ni = pr * si + pi_ * sr + f[q].y; sr = nr; si = ni; } }
    }
    __syncthreads();
}
__device__ __forceinline__ void st_s5_scan(const KP& p, int l, int bid, int nb) {
    const int tidx = opaque_tid();
    const int lane = tidx & 63, wid = tidx >> 6;
    const bf16_t* P = WSP(bf16_t, OFF_P); const float2* F = WSP(float2, OFF_S5);
    const int gw = bid * NWV + wid, nw = nb * NWV;
    if (gw >= (nw / 64) * 64) return;
    const int gd = gw & 63, dir = gd >> 5, g = gd & 31, part = gw >> 6, nparts = nw >> 6;
    if (part >= 4) return;
    float* Yo = dir == 0 ? WSP(float, OFF_OM) : WSP(float, OFF_H);
    float lr, li, bbr[16], bbi[16]; s5_consts(p, l, dir, g, lane, lr, li, bbr, bbi);
    const int gi = (l * 2 + dir) * 32 + g;
    float cre[16], cim[16];
#pragma unroll
    for (int cc = 0; cc < 16; ++cc) { cre[cc] = p.in(I_CRE)[((size_t)gi * 16 + cc) * 64 + lane]; cim[cc] = p.in(I_CIM)[((size_t)gi * 16 + cc) * 64 + lane]; }
    const float dsk = p.in(I_SSMD)[l * 512 + g * 16 + (lane & 15)];
    for (int c = part; c < 4; c += nparts) {
        const float2 s0 = F[((size_t)(c * 2 + dir) * 32 + g) * 64 + lane];
        float sr = s0.x, si = s0.y;
        for (int j0 = 0; j0 < S5C; j0 += 8) {
            uint4 ua[8], ub[8];
#pragma unroll
            for (int q = 0; q < 8; ++q) { const int r = s5_row(dir, c * S5C + j0 + q); const uint4* up = (const uint4*)(P + (size_t)r * PP + C_SSM + g * 16); ua[q] = up[0]; ub[q] = up[1]; }
#pragma unroll
            for (int q = 0; q < 8; ++q) { const int r = s5_row(dir, c * S5C + j0 + q);
                float u[16]; s5_unpack(ua[q], ub[q], u);
                float bur = 0.f, bui = 0.f;
#pragma unroll
                for (int cc = 0; cc < 16; ++cc) { bur = fmaf(bbr[cc], u[cc], bur); bui = fmaf(bbi[cc], u[cc], bui); }
                const float nsr = lr * sr - li * si + bur, nsi = lr * si + li * sr + bui; sr = nsr; si = nsi;
                float t16[16];
#pragma unroll
                for (int cc = 0; cc < 16; ++cc) t16[cc] = cre[cc] * sr - cim[cc] * si;
                float y = transpose_reduce16(t16, lane);
                if (lane < 16) {
                    if (dir == 0) y += dsk * bf2f(P[(size_t)r * PP + C_SSM + g * 16 + lane]);
                    Yo[(size_t)r * 512 + g * 16 + lane] = y; }
            }
        }
    }
}

__device__ __forceinline__ void st_s5_tables(const KP& p, int l, int bid, int nb, char* lds) {
    const int tidx = opaque_tid();
    float* pwr = (float*)lds; float* pwi = pwr + 65 * 64; float* bbr = pwi + 65 * 64; float* bbi = bbr + 1024; float* cre = bbi + 1024; float* cim = cre + 1024;
    bf16_t* Ktab = WSP(bf16_t, S5_KTAB); bf16_t* Ftab = WSP(bf16_t, S5_FTAB); bf16_t* Gtab = WSP(bf16_t, S5_GTAB);
    if (bid == 0 && tidx < 64) WSP(unsigned, S5_ZERO)[tidx] = 0u;
    for (int item = bid; item < 256; item += nb) {
        const int gd = item >> 2, q = item & 3, dir = gd >> 5, g = gd & 31, gi = (l * 2 + dir) * 32 + g;
        __syncthreads();
        if (tidx < 64) {
            const int pp = tidx, pi = gi * 64 + pp;
            const float are = p.in(I_ARE)[pi], aim = p.in(I_AIM)[pi], dt = expf(p.in(I_LOGDT)[gi]);
            const float mag = expf(are * dt); float sn, cs; sincosf(aim * dt, &sn, &cs);
            const float lr = mag * cs, li = mag * sn, den = are * are + aim * aim;
            const float cr = ((lr - 1.0f) * are + li * aim) / den, ci = (li * are - (lr - 1.0f) * aim) / den;
            for (int c = 0; c < 16; ++c) { const float br = p.in(I_BRE)[(size_t)pi * 16 + c], bi = p.in(I_BIM)[(size_t)pi * 16 + c];
                bbr[pp * 16 + c] = cr * br - ci * bi; bbi[pp * 16 + c] = cr * bi + ci * br; }
            float ar = 1.f, ai = 0.f;
            for (int n = 0; n <= 64; ++n) { pwr[n * 64 + pp] = ar; pwi[n * 64 + pp] = ai; const float nr = ar * lr - ai * li, ni = ar * li + ai * lr; ar = nr; ai = ni; }
        } else {
            for (int i = tidx - 64; i < 1024; i += NTH - 64) { cre[i] = p.in(I_CRE)[(size_t)gi * 1024 + i]; cim[i] = p.in(I_CIM)[(size_t)gi * 1024 + i]; }
        }
        __syncthreads();
        for (int e = 0; e < 8; ++e) {
            const int idx = tidx + NTH * e, tau = 16 * q + (idx >> 8), c = (idx >> 4) & 15, c2 = idx & 15;
            float s = 0.f;
            for (int pp = 0; pp < 64; ++pp) {
                const float xr = cre[c * 64 + pp], xi = cim[c * 64 + pp], wr = pwr[tau * 64 + pp], wi = pwi[tau * 64 + pp];
                const float zr = xr * wr - xi * wi, zi = xr * wi + xi * wr;
                s += zr * bbr[pp * 16 + c2] - zi * bbi[pp * 16 + c2];
            }
            Ktab[(((size_t)gd * 64 + tau) * 16 + c) * 16 + c2] = f2bf(s);
        }
        for (int e = 0; e < 32; ++e) {
            const int idx2 = tidx + NTH * e, n = 32 * q + (idx2 >> 9), k = (idx2 & 511) * 2, pp = n & 63, comp = n >> 6, i = k >> 4, c2 = k & 15;
            const float wr = pwr[(63 - i) * 64 + pp], wi = pwi[(63 - i) * 64 + pp];
            const float b0r = bbr[pp * 16 + c2], b0i = bbi[pp * 16 + c2], b1r = bbr[pp * 16 + c2 + 1], b1i = bbi[pp * 16 + c2 + 1];
            const float v0 = comp ? (wr * b0i + wi * b0r) : (wr * b0r - wi * b0i), v1 = comp ? (wr * b1i + wi * b1r) : (wr * b1r - wi * b1i);
            *(unsigned*)(Ftab + ((size_t)gd * 128 + n) * 1024 + k) = pack2(v0, v1);
        }
        for (int e = 0; e < 32; ++e) {
            const int idx2 = tidx + NTH * e, row = 256 * q + (idx2 >> 6), n = (idx2 & 63) * 2, t = row >> 4, c = row & 15, comp = n >> 6, pp = n & 63;
            float v[2];
#pragma unroll
            for (int h = 0; h < 2; ++h) { const float xr = cre[c * 64 + pp + h], xi = cim[c * 64 + pp + h], wr = pwr[(t + 1) * 64 + pp + h], wi = pwi[(t + 1) * 64 + pp + h];
                v[h] = comp ? -(xr * wi + xi * wr) : (xr * wr - xi * wi); }
            *(unsigned*)(Gtab + ((size_t)gd * 1024 + row) * 128 + n) = pack2(v[0], v[1]);
        }
    }
    __syncthreads();
}
__device__ __forceinline__ void st_s5_fgemm(const KP& p, int bid, int nb, char* lds) {
    const int tidx = opaque_tid();
    const bf16_t* P = WSP(bf16_t, OFF_P); const bf16_t* Ftab = WSP(bf16_t, S5_FTAB); float* F = WSP(float, OFF_S5);
    const int srow = tidx >> 3, gch = (tidx & 7) ^ ((srow >> 1) & 7);
    for (int gd = bid; gd < 64; gd += nb) {
        const int dir = gd >> 5, g = gd & 31;
        acc_t acc; acc_zero(acc);
        gemm_core_g(acc,
            [&](int i, int kt) { const int m = srow + 64 * i, tok = kt * 4 + (gch >> 1); return P + (size_t)s5_row(dir, 64 * (4 + m) + tok) * PP + C_SSM + 16 * g + 8 * (gch & 1); },
            [&](int i, int kt) { return Ftab + ((size_t)gd * 128 + srow + 64 * i) * 1024 + kt * 64 + gch * 8; }, 16, lds);
        acc_visit(acc, [&](int ml, int nl, f32x4 v) {
            float* dst = F + (((size_t)(4 + ml) * 2 + dir) * 32 + g) * 128 + (nl & 63) * 2 + (nl >> 6);
            dst[0] = v[0]; dst[2] = v[1]; dst[4] = v[2]; dst[6] = v[3]; });
    }
}
__device__ __forceinline__ void st_s5_ygemm(const KP& p, int l, int bid, int nb, char* lds) {
    const int tidx = opaque_tid();
    const bf16_t* P = WSP(bf16_t, OFF_P); const bf16_t* Ktab = WSP(bf16_t, S5_KTAB); const bf16_t* Gtab = WSP(bf16_t, S5_GTAB);
    const bf16_t* Sinb = WSP(bf16_t, S5_SINB); const bf16_t* Zero = WSP(bf16_t, S5_ZERO); bf16_t* Y1 = WSP(bf16_t, OFF_OS);
    const int srow = tidx >> 3, gch = (tidx & 7) ^ ((srow >> 1) & 7);
    for (int u = bid; u < 256; u += nb) {
        const int g = u >> 3, nt = u & 7;
        acc_t acc; acc_zero(acc);
        {   const int gd = g, nkt = 2 * (nt + 1);
            gemm_core_g(acc,
                [&](int i, int kt) { const int m = srow + 64 * i;
                    if (kt < nkt) { const int tok = kt * 4 + (gch >> 1); return P + (size_t)(64 * (4 + m) + tok) * PP + C_SSM + 16 * g + 8 * (gch & 1); }
                    return Sinb + ((size_t)(4 + m) * 64 + gd) * 128 + (kt - nkt) * 64 + gch * 8; },
                [&](int i, int kt) { const int n = nt * 128 + srow + 64 * i, t = n >> 4, c = n & 15;
                    if (kt < nkt) { const int tau = t - (kt * 4 + (gch >> 1)); return tau >= 0 ? Ktab + (((size_t)gd * 64 + tau) * 16 + c) * 16 + 8 * (gch & 1) : Zero; }
                    return Gtab + ((size_t)gd * 1024 + n) * 128 + (kt - nkt) * 64 + gch * 8; }, nkt + 2, lds); }
        {   const int gd = 32 + g, nkt = 2 * (8 - nt);
            gemm_core_g(acc,
                [&](int i, int kt) { const int m = srow + 64 * i, cx = 259 - m;
                    if (kt < nkt) { const int tok = kt * 4 + (gch >> 1); return P + (size_t)(T + LC - 1 - (64 * cx + tok)) * PP + C_SSM + 16 * g + 8 * (gch & 1); }
                    return Sinb + ((size_t)cx * 64 + gd) * 128 + (kt - nkt) * 64 + gch * 8; },
                [&](int i, int kt) { const int n = nt * 128 + srow + 64 * i, t = 63 - (n >> 4), c = n & 15;
                    if (kt < nkt) { const int tau = t - (kt * 4 + (gch >> 1)); return tau >= 0 ? Ktab + (((size_t)gd * 64 + tau) * 16 + c) * 16 + 8 * (gch & 1) : Zero; }
                    return Gtab + ((size_t)gd * 1024 + t * 16 + c) * 128 + (kt - nkt) * 64 + gch * 8; }, nkt + 2, lds); }
        acc_visit(acc, [&](int ml, int nl, f32x4 v) {
            const int n = nt * 128 + nl, t = n >> 4, c0 = n & 15, r = 64 * (4 + ml) + t;
            const float4 dsk = *(const float4*)(p.in(I_SSMD) + l * 512 + g * 16 + c0); const uint2 ur = *(const uint2*)(P + (size_t)r * PP + C_SSM + g * 16 + c0);
            uint2 o; o.x = pack2(gelu_tanh(v[0] + dsk.x * bflo(ur.x)), gelu_tanh(v[1] + dsk.y * bfhi(ur.x))); o.y = pack2(gelu_tanh(v[2] + dsk.z * bflo(ur.y)), gelu_tanh(v[3] + dsk.w * bfhi(ur.y)));
            *(uint2*)(Y1 + (size_t)r * 512 + g * 16 + c0) = o; });
    }
}
__device__ __forceinline__ void st_s5_ctx_y(const KP& p, int l, int bid, int nb) {
    const int tidx = opaque_tid();
    const bf16_t* P = WSP(bf16_t, OFF_P); const bf16_t* Ktab = WSP(bf16_t, S5_KTAB); const bf16_t* Gtab = WSP(bf16_t, S5_GTAB);
    const float* SIN = WSP(float, OFF_S5); bf16_t* Y1 = WSP(bf16_t, OFF_OS);
    for (int idx = bid * NTH + tidx; idx < 32 * 256 * 16; idx += nb * NTH) {
        const int ch = idx & 15, r = (idx >> 4) & 255, g = idx >> 12;
        float y = p.in(I_SSMD)[l * 512 + g * 16 + ch] * bf2f(P[(size_t)r * PP + C_SSM + g * 16 + ch]);
#pragma unroll 1
        for (int dir = 0; dir < 2; ++dir) {
            const int gd = dir * 32 + g, j = dir == 0 ? r : (LC - 1 - r), cx = j >> 6, t = j & 63;
            const bf16_t* kt_ = Ktab + ((size_t)gd * 64 * 16 + ch) * 16;
            float a = 0.f;
            for (int i = 0; i <= t; ++i) {
                const int jr = 64 * cx + i, rr = dir == 0 ? jr : (LC - 1 - jr);
                const uint4* up = (const uint4*)(P + (size_t)rr * PP + C_SSM + g * 16); const uint4* kp = (const uint4*)(kt_ + (size_t)(t - i) * 256);
                a = dot8(up[0], kp[0], a); a = dot8(up[1], kp[1], a);
            }
            const bf16_t* gp = Gtab + ((size_t)gd * 1024 + t * 16 + ch) * 128; const float* sp = SIN + (((size_t)cx * 2 + dir) * 32 + g) * 128;
            for (int q = 0; q < 64; q += 2) { const unsigned gre = *(const unsigned*)(gp + q), gim = *(const unsigned*)(gp + 64 + q); const float4 s4 = *(const float4*)(sp + 2 * q);
                a = fmaf(bflo(gre), s4.x, a); a = fmaf(bflo(gim), s4.y, a); a = fmaf(bfhi(gre), s4.z, a); a = fmaf(bfhi(gim), s4.w, a); }
            y += a;
        }
        Y1[(size_t)r * 512 + g * 16 + ch] = f2bf(gelu_tanh(y));
    }
}
__device__ __forceinline__ void st_s5_fin(const KP& p, int bid, int nb) {
    const int tidx = opaque_tid();
    const float* Yf = WSP(float, OFF_OM); const float* Yb = WSP(float, OFF_H); bf16_t* P = WSP(bf16_t, OFF_P);
    for (long idx = (long)bid * NTH + tidx; idx < (long)T * 512; idx += (long)nb * NTH) {
        const int r = (int)(idx >> 9), c = (int)(idx & 511);
        P[(size_t)r * PP + C_SSM + c] = f2bf(gelu_tanh(Yf[idx] + Yb[idx]));
    }
}

template <int SET>
__device__ __forceinline__ void st_proj2(const KP& p, int l, int bid, int nb, char* lds) {
    const int tidx = opaque_tid();
    bf16_t* P = WSP(bf16_t, OFF_P);
    const bf16_t* Wuq = WSP(bf16_t, OFF_WB + WB_UQ); bf16_t* Qm = WSP(bf16_t, OFF_H);
    const bf16_t* Wukv = WSP(bf16_t, OFF_WB + WB_UKV); bf16_t* Kn = WSP(bf16_t, OFF_KN); bf16_t* Vm = WSP(bf16_t, OFF_V);
    const bf16_t* Wglu = WSP(bf16_t, OFF_WB + WB_GLU); bf16_t* Os = WSP(bf16_t, OFF_OS); const float* bg = p.in(I_BGLU) + l * 512;
    int mt, ntv;
    for (int it = 0; dense_tile(it, SET == 0 ? 14 : 4, SET == 0 || l + 1 < NL, bid, nb, mt, ntv); ++it) {
        if (SET == 1) ntv += 14;
        const int which = ntv < 6 ? 0 : (ntv < 14 ? 1 : 2), nt = ntv - (which == 0 ? 0 : (which == 1 ? 6 : 14));
        const int K = which == 0 ? 256 : (which == 1 ? 128 : 512);
        const bf16_t* abase = which == 2 ? (const bf16_t*)Os + (size_t)mt * 256 * 512 : P + (size_t)mt * 256 * PP + (which == 0 ? C_CQ : C_CKV);
        const int apitch = which == 2 ? 512 : PP;
        const bf16_t* wbase = (which == 0 ? Wuq : (which == 1 ? Wukv : Wglu)) + (size_t)nt * 128 * K;
        acc_t acc; acc_zero(acc);
        gemm_core(acc, [&](int r) { return abase + (size_t)r * apitch; }, [&](int r) { return wbase + (size_t)r * K; }, K, lds);
        if (which == 0) {
            const float* ssq = WSP(float, OFF_SSQ); const float2* t8 = WSP(float2, OFF_ROPE) + 256 * 16;
            const int lane_ = tidx & 63, wid_ = tidx >> 6, wm_ = wid_ >> 1, wn_ = wid_ & 1, fr_ = lane_ & 15, g_ = lane_ >> 4;
#pragma unroll
            for (int im = 0; im < 4; ++im) {
                const int row = mt * 256 + wm_ * 64 + 16 * im + fr_;
                const float4 s4 = *(const float4*)(ssq + (size_t)row * 8);
                const float sc = rsqrtf(((s4.x + s4.y) + (s4.z + s4.w)) * (1.0f / 256.0f) + EPS) * SC_MLA;
                const bool lat = row >= LC; const int tpos = row - LC, prow = lat ? (tpos >> 6) : 0, pcol = lat ? (tpos & 63) : 0;
#pragma unroll
                for (int in = 0; in < 4; ++in) {
                    f32x4 v = acc[in][im] * sc;
                    if (((nt * 4 + wn_ * 2 + (in >> 1)) % 3) == 2) {
                        f32x4 o; o[0] = __shfl_xor(v[0], 32); o[1] = __shfl_xor(v[1], 32); o[2] = __shfl_xor(v[2], 32); o[3] = __shfl_xor(v[3], 32);
                        if (lat) { const float4* cs = (const float4*)(t8 + ((in & 1) == 0 ? prow : pcol) * 8 + 4 * (g_ & 1));
                            const float4 c01 = cs[0], c23 = cs[1];
                            if (g_ < 2) { v[0] = v[0] * c01.x - o[0] * c01.y; v[1] = v[1] * c01.z - o[1] * c01.w; v[2] = v[2] * c23.x - o[2] * c23.y; v[3] = v[3] * c23.z - o[3] * c23.w; }
                            else { v[0] = o[0] * c01.y + v[0] * c01.x; v[1] = o[1] * c01.w + v[1] * c01.z; v[2] = o[2] * c23.y + v[2] * c23.x; v[3] = o[3] * c23.w + v[3] * c23.z; } }
                    }
                    *(uint2*)(Qm + (size_t)row * 768 + nt * 128 + wn_ * 64 + 16 * in + 4 * g_) = pack4(v);
                }
            }
        } else if (which == 1) {
            const float* ssq = WSP(float, OFF_SSQ);
            acc_visit(acc, [&](int ml, int nl, f32x4 v) {
                const float2 s2 = *(const float2*)(ssq + (size_t)(mt * 256 + ml) * 8 + 4);
                const float sc = rsqrtf((s2.x + s2.y) * (1.0f / 128.0f) + EPS);
                bf16_t* dst = (nl < 64) ? (Kn + (size_t)(mt * 256 + ml) * 512 + nt * 64 + nl) : (Vm + (size_t)(mt * 256 + ml) * 512 + nt * 64 + nl - 64);
                *(uint2*)dst = pack4(v * sc); });
        } else {
            acc_visit(acc, [&](int ml, int nl, f32x4 v) {
                const int n = nt * 128 + nl;
                const uint2 yr = *(const uint2*)(Os + (size_t)(mt * 256 + ml) * 512 + n); const float4 b4 = *(const float4*)(bg + n);
                uint2 o; o.x = pack2(bflo(yr.x) * sigmoidf_(v[0] + b4.x), bfhi(yr.x) * sigmoidf_(v[1] + b4.y));
                o.y = pack2(bflo(yr.y) * sigmoidf_(v[2] + b4.z), bfhi(yr.y) * sigmoidf_(v[3] + b4.w));
                *(uint2*)(P + (size_t)(mt * 256 + ml) * PP + C_SSM + n) = o; });
        }
    }
}
__device__ __forceinline__ void st_ropeq(const KP& p, int bid, int nb, char* lds) {
    const int tidx = opaque_tid();
    {   const int lane = tidx & 63, wid = tidx >> 6;
        const bf16_t* Kn = WSP(bf16_t, OFF_KN); const bf16_t* P = WSP(bf16_t, OFF_P);
        float runmax = 0.f;
        for (int r = bid * NWV + wid; r < T; r += nb * NWV) {
            const uint4 kv = *(const uint4*)(Kn + (size_t)r * 512 + lane * 8);
            float s = bflo(kv.x) * bflo(kv.x) + bfhi(kv.x) * bfhi(kv.x) + bflo(kv.y) * bflo(kv.y) + bfhi(kv.y) * bfhi(kv.y)
                    + bflo(kv.z) * bflo(kv.z) + bfhi(kv.z) * bfhi(kv.z) + bflo(kv.w) * bflo(kv.w) + bfhi(kv.w) * bfhi(kv.w);
            s += __shfl_xor(s, 1); s += __shfl_xor(s, 2); s += __shfl_xor(s, 4);
            float sr = 0.f;
            if (lane < 4) { const uint4 rv = *(const uint4*)(P + (size_t)r * PP + C_KR + lane * 8);
                sr = bflo(rv.x) * bflo(rv.x) + bfhi(rv.x) * bfhi(rv.x) + bflo(rv.y) * bflo(rv.y) + bfhi(rv.y) * bfhi(rv.y)
                   + bflo(rv.z) * bflo(rv.z) + bfhi(rv.z) * bfhi(rv.z) + bflo(rv.w) * bflo(rv.w) + bfhi(rv.w) * bfhi(rv.w); }
            sr += __shfl_xor(sr, 1); sr += __shfl_xor(sr, 2);
            sr = __shfl(sr, 0);
            runmax = fmaxf(runmax, s + sr);
        }
        unsigned* lmax = (unsigned*)lds;
        __syncthreads();
        if (tidx < 8) lmax[tidx] = 0u;
        __syncthreads();
        if ((lane & 7) == 0) atomicMax(&lmax[lane >> 3], __float_as_uint(runmax));
        __syncthreads();
        if (tidx < 8) atomicMax(WSP(unsigned, OFF_CNT) + 32 + tidx, lmax[tidx]);
    }
}

typedef short s16x4 __attribute__((ext_vector_type(4)));
typedef short v4i16_t __attribute__((ext_vector_type(4)));
typedef __attribute__((address_space(3))) const char* lds_cptr;
__device__ __forceinline__ s16x4 vtr(lds_cptr q) { return __builtin_bit_cast(s16x4, __builtin_amdgcn_ds_read_tr16_b64_v4i16((__attribute__((address_space(3))) v4i16_t*)q)); }
__device__ __forceinline__ unsigned cvtpk(float lo, float hi) { return pack2(lo, hi); }
constexpr int AT_K = 0, AT_V = 8192, AT_KR = 16384, AT_BUF = 20480;

template <int DQK, int VAR = 0>
__device__ __forceinline__ void attn_item(const bf16_t* Q, int qpitch, const bf16_t* KA, int kapitch, const bf16_t* KB, int kbpitch,
                                          const bf16_t* V, int vpitch, int ntiles, float C, bf16_t* O, char* lds) {
    const int tid = opaque_tid(), lane = tid & 63, wid = tid >> 6, r32 = lane & 31, hi = lane >> 5;
    constexpr int ND0 = DQK / 16;
    bf16x8 qr[ND0];
    { const bf16_t* qp = Q + (size_t)(wid * 32 + r32) * qpitch + hi * 8;
#pragma unroll
      for (int d0 = 0; d0 < ND0; ++d0) qr[d0] = *(const bf16x8*)(qp + d0 * 16); }
    const int srow = tid >> 3, sch = tid & 7;
    const bf16_t* gk = KA + (size_t)srow * kapitch + sch * 8;
    const bf16_t* gv = V + (size_t)srow * vpitch + sch * 8;
    const bf16_t* gr = (DQK > 64) ? (KB + (size_t)(tid >> 2) * kbpitch + (tid & 3) * 8) : nullptr;
    const int sk_off = AT_K + srow * 128 + ((sch ^ ((srow >> 1) & 7)) << 4);
    const int sv_off = AT_V + (sch >> 2) * 4096 + srow * 64 + (sch & 3) * 16;
    const int sr_off = AT_KR + (tid >> 2) * 64 + (((tid & 3) ^ (((tid >> 2) >> 2) & 3)) << 4);
    const bool do_r = (DQK > 64) && (tid < 256);
    const int kf_off = AT_K + r32 * 128, ksw = (r32 >> 1) & 7;
    const int rf_off = AT_KR + r32 * 64, rsw = (r32 >> 2) & 3;
    const int vf_off = AT_V + (4 * hi + ((lane & 15) >> 2)) * 64 + ((lane >> 4) & 1) * 32 + (lane & 3) * 8;
    uint4 rk, rv, rr; rr = make_uint4(0, 0, 0, 0);
    rk = *(const uint4*)gk; rv = *(const uint4*)gv; if (do_r) rr = *(const uint4*)gr;
    *(uint4*)(lds + sk_off) = rk; *(uint4*)(lds + sv_off) = rv; if (do_r) *(uint4*)(lds + sr_off) = rr;
    __syncthreads();
    f32x16 o0, o1;
#pragma unroll
    for (int r = 0; r < 16; ++r) { o0[r] = 0.f; o1[r] = 0.f; }
    float mrun = -INFINITY, lrun = 0.f;
    for (int t = 0; t < ntiles; ++t) {
        const char* cur = lds + (VAR == 2 ? 0 : (t & 1)) * AT_BUF; char* nxt = lds + ((t + 1) & 1) * AT_BUF;
        const bool more = (t + 1 < ntiles);
        if (more && VAR != 2) { rk = *(const uint4*)(gk + (size_t)(t + 1) * 64 * kapitch); rv = *(const uint4*)(gv + (size_t)(t + 1) * 64 * vpitch); if (do_r) rr = *(const uint4*)(gr + (size_t)(t + 1) * 64 * kbpitch); }
        f32x16 p0, p1;
#pragma unroll
        for (int r = 0; r < 16; ++r) { p0[r] = 0.f; p1[r] = 0.f; }
#pragma unroll
        for (int d0 = 0; d0 < 4; ++d0) {
            const int co = ((2 * d0 + hi) ^ ksw) << 4;
            const bf16x8 k0 = *(const bf16x8*)(cur + kf_off + co), k1 = *(const bf16x8*)(cur + kf_off + 32 * 128 + co);
            p0 = MFMA32(k0, qr[d0], p0); p1 = MFMA32(k1, qr[d0], p1);
        }
        if (DQK > 64) {
#pragma unroll
            for (int d0 = 4; d0 < ND0; ++d0) {
                const int co = ((2 * (d0 - 4) + hi) ^ rsw) << 4;
                const bf16x8 k0 = *(const bf16x8*)(cur + rf_off + co), k1 = *(const bf16x8*)(cur + rf_off + 32 * 64 + co);
                p0 = MFMA32(k0, qr[d0], p0); p1 = MFMA32(k1, qr[d0], p1);
            }
        }
        if (VAR != 1) {
        float mx = fmaxf(p0[0], p1[0]);
#pragma unroll
        for (int r = 1; r < 16; ++r) mx = fmaxf(mx, fmaxf(p0[r], p1[r]));
        mx = xhalf_max(mx) * C;
        const float mnew = fmaxf(mrun, mx);
        if (__any(mnew > mrun)) {
            const float alpha = __builtin_amdgcn_exp2f(mrun - mnew);
            lrun *= alpha;
#pragma unroll
            for (int r = 0; r < 16; ++r) { o0[r] *= alpha; o1[r] *= alpha; }
            mrun = mnew;
        }
        const float nm = -mrun;
        float ls = 0.f;
#pragma unroll
        for (int r = 0; r < 16; ++r) { p0[r] = __builtin_amdgcn_exp2f(fmaf(p0[r], C, nm)); p1[r] = __builtin_amdgcn_exp2f(fmaf(p1[r], C, nm)); ls += p0[r] + p1[r]; }
        lrun += ls;
        }
#pragma unroll
        for (int s = 0; s < 4; ++s) {
            bf16x8 pf;
            {   unsigned w0, w1, w2, w3;
                if (s < 2) { w0 = cvtpk(p0[8 * s], p0[8 * s + 1]); w1 = cvtpk(p0[8 * s + 2], p0[8 * s + 3]); w2 = cvtpk(p0[8 * s + 4], p0[8 * s + 5]); w3 = cvtpk(p0[8 * s + 6], p0[8 * s + 7]); }
                else { const int s2 = s - 2; w0 = cvtpk(p1[8 * s2], p1[8 * s2 + 1]); w1 = cvtpk(p1[8 * s2 + 2], p1[8 * s2 + 3]); w2 = cvtpk(p1[8 * s2 + 4], p1[8 * s2 + 5]); w3 = cvtpk(p1[8 * s2 + 6], p1[8 * s2 + 7]); }
                uint4 u = make_uint4(w0, w1, w2, w3); pf = __builtin_bit_cast(bf16x8, u); }
            const lds_cptr vb = (lds_cptr)cur + vf_off + s * 1024;
            const s16x4 a0 = vtr(vb), a1 = vtr(vb + 512), b0 = vtr(vb + 4096), b1 = vtr(vb + 4096 + 512);
            const bf16x8 v0 = (bf16x8){a0[0], a0[1], a0[2], a0[3], a1[0], a1[1], a1[2], a1[3]};
            const bf16x8 v1 = (bf16x8){b0[0], b0[1], b0[2], b0[3], b1[0], b1[1], b1[2], b1[3]};
            o0 = MFMA32(v0, pf, o0); o1 = MFMA32(v1, pf, o1);
        }
        if (VAR != 2) { if (more) { *(uint4*)(nxt + sk_off) = rk; *(uint4*)(nxt + sv_off) = rv; if (do_r) *(uint4*)(nxt + sr_off) = rr; }
        __syncthreads(); }
    }
    const float inv = 1.0f / xhalf_sum(lrun);
    bf16_t* op = O + (size_t)(wid * 32 + r32) * 512 + 4 * hi;
#pragma unroll
    for (int rg = 0; rg < 4; ++rg) {
        uint2 a; a.x = pack2(o0[4 * rg] * inv, o0[4 * rg + 1] * inv); a.y = pack2(o0[4 * rg + 2] * inv, o0[4 * rg + 3] * inv);
        uint2 b; b.x = pack2(o1[4 * rg] * inv, o1[4 * rg + 1] * inv); b.y = pack2(o1[4 * rg + 2] * inv, o1[4 * rg + 3] * inv);
        *(uint2*)(op + 8 * rg) = a; *(uint2*)(op + 32 + 8 * rg) = b;
    }
}
#define SBAR() __builtin_amdgcn_sched_barrier(0)
#define PINV(x) asm volatile("" : "+v"(x))
constexpr float ATT_THR = 6.0f;
template <int DQK>
__device__ __forceinline__ void attn_item2(const bf16_t* Q, int qpitch, const bf16_t* KA, int kapitch, const bf16_t* KB, int kbpitch,
                                           const bf16_t* V, int vpitch, int ntiles, bf16_t* O, char* lds) {
    const int tid = opaque_tid(), lane = tid & 63, wid = tid >> 6, r32 = lane & 31, hi = lane >> 5;
    const int wu = __builtin_amdgcn_readfirstlane(wid);
    constexpr int ND0 = DQK / 16, NQK = 2 * ND0;
    constexpr bool ROPE = DQK > 64;
    const int krow = 8 * wu + (lane >> 3);
    const bf16_t* gk = KA + (size_t)krow * kapitch + (((lane & 7) ^ ((krow >> 1) & 7)) << 3);
    const bf16_t* gv = V + (size_t)(16 * (wu & 3) + (lane >> 2)) * vpitch + (wu >> 2) * 32 + (lane & 3) * 8;
    const int rrow = 16 * (wu & 3) + (lane >> 2);
    const bf16_t* gr = ROPE ? (KB + (size_t)rrow * kbpitch + (((lane & 3) ^ ((rrow >> 2) & 3)) << 3)) : nullptr;
    char* dk = lds + AT_K + wu * 1024; char* dv = lds + AT_V + wu * 1024; char* dr = lds + AT_KR + (wu & 3) * 1024;
    auto issue = [&](int t, int slot) {
        GLDS16(gk + (size_t)t * 64 * kapitch, dk + slot * AT_BUF); GLDS16(gv + (size_t)t * 64 * vpitch, dv + slot * AT_BUF);
        if (ROPE) GLDS16(gr + (size_t)t * 64 * kbpitch, dr + slot * AT_BUF);
    };
    asm volatile("s_waitcnt vmcnt(0)" ::: "memory");
    issue(0, 0);
    if (ntiles > 1) issue(1, 1);
    bf16x8 qr[ND0];
    { const bf16_t* qp = Q + (size_t)(wid * 32 + r32) * qpitch + hi * 8;
#pragma unroll
      for (int d0 = 0; d0 < ND0; ++d0) qr[d0] = *(const bf16x8*)(qp + d0 * 16); }
    const int kf_off = AT_K + r32 * 128, ksw = (r32 >> 1) & 7;
    const int rf_off = AT_KR + r32 * 64, rsw = (r32 >> 2) & 3;
    const int vf_off = AT_V + (4 * hi + ((lane & 15) >> 2)) * 64 + ((lane >> 4) & 1) * 32 + (lane & 3) * 8;
    auto kfrag = [&](const char* slot, int g) -> bf16x8 {
        const int d0 = g >> 1, n = g & 1;
        if (d0 < 4) return *(const bf16x8*)(slot + kf_off + n * 32 * 128 + (((2 * d0 + hi) ^ ksw) << 4));
        return *(const bf16x8*)(slot + rf_off + n * 32 * 64 + (((2 * (d0 - 4) + hi) ^ rsw) << 4));
    };
    auto vfrag = [&](const char* slot, int g) -> bf16x8 {
        const lds_cptr vb = (lds_cptr)slot + vf_off + (g >> 1) * 1024 + (g & 1) * 4096;
        const s16x4 a0 = vtr(vb), a1 = vtr(vb + 512);
        return (bf16x8){a0[0], a0[1], a0[2], a0[3], a1[0], a1[1], a1[2], a1[3]};
    };
    f32x16 o0, o1, sA0, sA1, sB0, sB1;
    const f32x16 zero16 = {0.f, 0.f, 0.f, 0.f, 0.f, 0.f, 0.f, 0.f, 0.f, 0.f, 0.f, 0.f, 0.f, 0.f, 0.f, 0.f};
#pragma unroll
    for (int r = 0; r < 16; ++r) { o0[r] = 0.f; o1[r] = 0.f; }
    float mref, lrun = 0.f;
    if (ntiles > 1) asm volatile("s_waitcnt vmcnt(%0)" :: "n"(ROPE ? 3 : 2) : "memory"); else asm volatile("s_waitcnt vmcnt(0)" ::: "memory");
    __builtin_amdgcn_s_barrier();
    {
#pragma unroll
        for (int g = 0; g < NQK; ++g) { const bf16x8 kf = kfrag(lds, g);
            if (g & 1) sA1 = MFMA32(kf, qr[g >> 1], g < 2 ? zero16 : sA1); else sA0 = MFMA32(kf, qr[g >> 1], g < 2 ? zero16 : sA0); }
        float mx = fmaxf(sA0[0], sA1[0]);
#pragma unroll
        for (int r = 1; r < 16; ++r) mx = fmaxf(mx, fmaxf(sA0[r], sA1[r]));
        mref = xhalf_max(mx);
    }
    asm volatile("s_waitcnt vmcnt(0) lgkmcnt(0)" ::: "memory");
    __builtin_amdgcn_s_barrier();
    auto step = [&](auto HN, f32x16& c0, f32x16& c1, f32x16& n0, f32x16& n1, int t) __attribute__((always_inline)) {
        const int sl = t % 3, sl1 = (t + 1) % 3, sl2 = (t + 2) % 3;
        const char* cs = lds + sl * AT_BUF; const char* ns = lds + sl1 * AT_BUF;
        constexpr bool has_next = decltype(HN)::value;
        if (t + 2 < ntiles) issue(t + 2, sl2);
        u32x4 pw[4];
        float ls = 0.f;
        bf16x8 kf;
        if (has_next) kf = kfrag(ns, 0);
        SBAR();
#pragma unroll
        for (int g = 0; g < (NQK > 8 ? NQK : 8); ++g) {
            bf16x8 kcur = kf;
            if (has_next && g + 1 < NQK) kf = kfrag(ns, g + 1);
            SBAR();
            if (g < 8) {
                float e0, e1, e2, e3;
                if (g < 4) { e0 = __builtin_amdgcn_exp2f(c0[4 * g] - mref); e1 = __builtin_amdgcn_exp2f(c0[4 * g + 1] - mref); e2 = __builtin_amdgcn_exp2f(c0[4 * g + 2] - mref); e3 = __builtin_amdgcn_exp2f(c0[4 * g + 3] - mref); }
                else { e0 = __builtin_amdgcn_exp2f(c1[4 * (g - 4)] - mref); e1 = __builtin_amdgcn_exp2f(c1[4 * (g - 4) + 1] - mref); e2 = __builtin_amdgcn_exp2f(c1[4 * (g - 4) + 2] - mref); e3 = __builtin_amdgcn_exp2f(c1[4 * (g - 4) + 3] - mref); }
                ls += (e0 + e1) + (e2 + e3);
                const unsigned w0 = cvtpk(e0, e1), w1 = cvtpk(e2, e3);
                if ((g & 1) == 0) { pw[g >> 1][0] = w0; pw[g >> 1][1] = w1; } else { pw[g >> 1][2] = w0; pw[g >> 1][3] = w1; }
                PINV(ls); PINV(pw[g >> 1]);
            }
            SBAR();
            if (has_next && g < NQK) { if (g & 1) n1 = MFMA32(kcur, qr[g >> 1], g < 2 ? zero16 : n1); else n0 = MFMA32(kcur, qr[g >> 1], g < 2 ? zero16 : n0); }
            SBAR();
        }
        lrun += ls;
        float mx = -INFINITY;
        bf16x8 vf = vfrag(cs, 0);
        SBAR();
#pragma unroll
        for (int g = 0; g < 8; ++g) {
            const bf16x8 vcur = vf;
            if (g + 1 < 8) vf = vfrag(cs, g + 1);
            SBAR();
            if (has_next) {
                if (g < 4) mx = fmaxf(fmaxf(mx, fmaxf(n0[4 * g], n0[4 * g + 1])), fmaxf(n0[4 * g + 2], n0[4 * g + 3]));
                else mx = fmaxf(fmaxf(mx, fmaxf(n1[4 * (g - 4)], n1[4 * (g - 4) + 1])), fmaxf(n1[4 * (g - 4) + 2], n1[4 * (g - 4) + 3]));
                PINV(mx);
            }
            SBAR();
            const bf16x8 pf = __builtin_bit_cast(bf16x8, pw[g >> 1]);
            if (g & 1) o1 = MFMA32(vcur, pf, o1); else o0 = MFMA32(vcur, pf, o0);
            SBAR();
        }
        if (has_next) {
            const float gr_ = xhalf_max(mx) - mref;
            if (__any(gr_ > ATT_THR)) {
                const float d = fmaxf(gr_, 0.f), a = __builtin_amdgcn_exp2f(-d);
                mref += d; lrun *= a;
#pragma unroll
                for (int r = 0; r < 16; ++r) { o0[r] *= a; o1[r] *= a; }
            }
        }
        asm volatile("s_waitcnt vmcnt(0) lgkmcnt(0)" ::: "memory");
        __builtin_amdgcn_s_barrier();
    };
    {   const std::integral_constant<bool, true> yes; const std::integral_constant<bool, false> no;
        int t = 0;
        for (; t + 2 < ntiles; t += 2) { step(yes, sA0, sA1, sB0, sB1, t); step(yes, sB0, sB1, sA0, sA1, t + 1); }
        step(yes, sA0, sA1, sB0, sB1, t); step(no, sB0, sB1, sA0, sA1, t + 1); }
    const float inv = 1.0f / xhalf_sum(lrun);
    bf16_t* op = O + (size_t)(wid * 32 + r32) * 512 + 4 * hi;
#pragma unroll
    for (int rg = 0; rg < 4; ++rg) {
        uint2 a; a.x = pack2(o0[4 * rg] * inv, o0[4 * rg + 1] * inv); a.y = pack2(o0[4 * rg + 2] * inv, o0[4 * rg + 3] * inv);
        uint2 b; b.x = pack2(o1[4 * rg] * inv, o1[4 * rg + 1] * inv); b.y = pack2(o1[4 * rg + 2] * inv, o1[4 * rg + 3] * inv);
        *(uint2*)(op + 8 * rg) = a; *(uint2*)(op + 32 + 8 * rg) = b;
    }
}
constexpr int A3_K = 0, A3_KR = 16384, A3_V = 24576, A3_BYTES = 24576 + 3 * 8192;
template <int DQK>
__device__ __forceinline__ void attn_item3(const bf16_t* Q, int qpitch, const bf16_t* KA, int kapitch, const bf16_t* KB, int kbpitch,
                                           const bf16_t* V, int vpitch, int ntiles, bf16_t* O, char* lds) {
    const int tid = opaque_tid(), lane = tid & 63, wid = tid >> 6, r32 = lane & 31, hi = lane >> 5;
    const bool grpB = __builtin_amdgcn_readfirstlane(wid) >= 4;
    constexpr int ND0 = DQK / 16;
    bf16x8 qr[ND0];
    { const bf16_t* qp = Q + (size_t)(wid * 32 + r32) * qpitch + hi * 8;
#pragma unroll
      for (int d0 = 0; d0 < ND0; ++d0) qr[d0] = *(const bf16x8*)(qp + d0 * 16); }
    const int srow = tid >> 3, sch = tid & 7;
    const bf16_t* gk = KA + (size_t)srow * kapitch + sch * 8;
    const bf16_t* gv = V + (size_t)srow * vpitch + sch * 8;
    const bf16_t* gr = (DQK > 64) ? (KB + (size_t)(tid >> 2) * kbpitch + (tid & 3) * 8) : nullptr;
    const int sk_off = A3_K + srow * 128 + ((sch ^ ((srow >> 1) & 7)) << 4);
    const int sv_off = A3_V + (sch >> 2) * 4096 + srow * 64 + (sch & 3) * 16;
    const int sr_off = A3_KR + (tid >> 2) * 64 + (((tid & 3) ^ (((tid >> 2) >> 2) & 3)) << 4);
    const bool do_r = (DQK > 64) && (tid < 256);
    const int kf_off = A3_K + r32 * 128, ksw = (r32 >> 1) & 7;
    const int rf_off = A3_KR + r32 * 64, rsw = (r32 >> 2) & 3;
    const int vf_off = A3_V + (4 * hi + ((lane & 15) >> 2)) * 64 + ((lane >> 4) & 1) * 32 + (lane & 3) * 8;
    uint4 rk, rv, rr; rr = make_uint4(0, 0, 0, 0);
    rk = *(const uint4*)gk; rv = *(const uint4*)gv; if (do_r) rr = *(const uint4*)gr;
    *(uint4*)(lds + sk_off) = rk; *(uint4*)(lds + sv_off) = rv; if (do_r) *(uint4*)(lds + sr_off) = rr;
    __syncthreads();
    f32x16 o0, o1, p0, p1;
#pragma unroll
    for (int r = 0; r < 16; ++r) { o0[r] = 0.f; o1[r] = 0.f; p0[r] = 0.f; p1[r] = 0.f; }
    float mrun = -INFINITY, lrun = 0.f;
    auto H1 = [&](int t) __attribute__((always_inline)) {
        const char* ks = lds + (t & 1) * 8192; const char* rs = lds + (t & 1) * 4096;
#pragma unroll
        for (int r = 0; r < 16; ++r) { p0[r] = 0.f; p1[r] = 0.f; }
#pragma unroll
        for (int d0 = 0; d0 < 4; ++d0) {
            const int co = ((2 * d0 + hi) ^ ksw) << 4;
            const bf16x8 k0 = *(const bf16x8*)(ks + kf_off + co), k1 = *(const bf16x8*)(ks + kf_off + 32 * 128 + co);
            p0 = MFMA32(k0, qr[d0], p0); p1 = MFMA32(k1, qr[d0], p1);
        }
        if (DQK > 64) {
#pragma unroll
            for (int d0 = 4; d0 < ND0; ++d0) {
                const int co = ((2 * (d0 - 4) + hi) ^ rsw) << 4;
                const bf16x8 k0 = *(const bf16x8*)(rs + rf_off + co), k1 = *(const bf16x8*)(rs + rf_off + 32 * 64 + co);
                p0 = MFMA32(k0, qr[d0], p0); p1 = MFMA32(k1, qr[d0], p1);
            }
        }
        float mx = fmaxf(p0[0], p1[0]);
#pragma unroll
        for (int r = 1; r < 16; ++r) mx = fmaxf(mx, fmaxf(p0[r], p1[r]));
        mx = xhalf_max(mx);
        if (__any(mx > mrun + ATT_THR)) {
            const float mnew = fmaxf(mrun, mx), alpha = __builtin_amdgcn_exp2f(mrun - mnew);
            lrun *= alpha;
#pragma unroll
            for (int r = 0; r < 16; ++r) { o0[r] *= alpha; o1[r] *= alpha; }
            mrun = mnew;
        }
    };
    auto H2 = [&](int t) __attribute__((always_inline)) {
        const char* vs = lds + (t % 3) * 8192;
        float ls = 0.f;
#pragma unroll
        for (int r = 0; r < 16; ++r) { p0[r] = __builtin_amdgcn_exp2f(p0[r] - mrun); p1[r] = __builtin_amdgcn_exp2f(p1[r] - mrun); ls += p0[r] + p1[r]; }
        lrun += ls;
#pragma unroll
        for (int s = 0; s < 4; ++s) {
            bf16x8 pf;
            {   unsigned w0, w1, w2, w3;
                if (s < 2) { w0 = cvtpk(p0[8 * s], p0[8 * s + 1]); w1 = cvtpk(p0[8 * s + 2], p0[8 * s + 3]); w2 = cvtpk(p0[8 * s + 4], p0[8 * s + 5]); w3 = cvtpk(p0[8 * s + 6], p0[8 * s + 7]); }
                else { const int s2 = s - 2; w0 = cvtpk(p1[8 * s2], p1[8 * s2 + 1]); w1 = cvtpk(p1[8 * s2 + 2], p1[8 * s2 + 3]); w2 = cvtpk(p1[8 * s2 + 4], p1[8 * s2 + 5]); w3 = cvtpk(p1[8 * s2 + 6], p1[8 * s2 + 7]); }
                u32x4 u = {w0, w1, w2, w3}; pf = __builtin_bit_cast(bf16x8, u); }
            const lds_cptr vb = (lds_cptr)vs + vf_off + s * 1024;
            const s16x4 a0 = vtr(vb), a1 = vtr(vb + 512), b0 = vtr(vb + 4096), b1 = vtr(vb + 4096 + 512);
            const bf16x8 v0 = (bf16x8){a0[0], a0[1], a0[2], a0[3], a1[0], a1[1], a1[2], a1[3]};
            const bf16x8 v1 = (bf16x8){b0[0], b0[1], b0[2], b0[3], b1[0], b1[1], b1[2], b1[3]};
            o0 = MFMA32(v0, pf, o0); o1 = MFMA32(v1, pf, o1);
        }
    };
#define A3_LOAD(t) do { rk = *(const uint4*)(gk + (size_t)((t) + 1) * 64 * kapitch); rv = *(const uint4*)(gv + (size_t)((t) + 1) * 64 * vpitch); if (do_r) rr = *(const uint4*)(gr + (size_t)((t) + 1) * 64 * kbpitch); } while (0)
#define A3_WRITE(t) do { const int kn = ((t) + 1) & 1, vn = ((t) + 1) % 3; *(uint4*)(lds + kn * 8192 + sk_off) = rk; *(uint4*)(lds + vn * 8192 + sv_off) = rv; if (do_r) *(uint4*)(lds + kn * 4096 + sr_off) = rr; } while (0)
    if (grpB) {
        { const bool more = (1 < ntiles); if (more) A3_LOAD(0); H1(0); if (more) A3_WRITE(0); __syncthreads(); }
        for (int t = 1; t < ntiles; ++t) {
            const bool more = (t + 1 < ntiles);
            if (more) A3_LOAD(t);
            H2(t - 1); H1(t);
            if (more) A3_WRITE(t);
            __syncthreads();
        }
    } else {
        for (int t = 0; t < ntiles; ++t) {
            const bool more = (t + 1 < ntiles);
            if (more) A3_LOAD(t);
            H1(t); H2(t);
            if (more) A3_WRITE(t);
            __syncthreads();
        }
    }
#undef A3_LOAD
#undef A3_WRITE
    if (grpB) H2(ntiles - 1);
    const float inv = 1.0f / xhalf_sum(lrun);
    bf16_t* op = O + (size_t)(wid * 32 + r32) * 512 + 4 * hi;
#pragma unroll
    for (int rg = 0; rg < 4; ++rg) {
        uint2 a; a.x = pack2(o0[4 * rg] * inv, o0[4 * rg + 1] * inv); a.y = pack2(o0[4 * rg + 2] * inv, o0[4 * rg + 3] * inv);
        uint2 b; b.x = pack2(o1[4 * rg] * inv, o1[4 * rg + 1] * inv); b.y = pack2(o1[4 * rg + 2] * inv, o1[4 * rg + 3] * inv);
        *(uint2*)(op + 8 * rg) = a; *(uint2*)(op + 32 + 8 * rg) = b;
    }
    __syncthreads();
}
template <int DQK>
__device__ __forceinline__ void attn_item4(const bf16_t* Q, int qpitch, const bf16_t* KA, int kapitch, const bf16_t* KB, int kbpitch,
                                           const bf16_t* V, int vpitch, int ntiles, float ref_const, float kmax2, bf16_t* O, char* lds) {
    const int tid = opaque_tid(), lane = tid & 63, wid = tid >> 6, r32 = lane & 31, hi = lane >> 5;
    constexpr int ND0 = DQK / 16;
    bf16x8 qr[ND0];
    { const bf16_t* qp = Q + (size_t)(wid * 32 + r32) * qpitch + hi * 8;
#pragma unroll
      for (int d0 = 0; d0 < ND0; ++d0) qr[d0] = *(const bf16x8*)(qp + d0 * 16); }
    float mref = ref_const;
    if (DQK > 64) {
        float qn2 = 0.f;
#pragma unroll
        for (int d0 = 0; d0 < ND0; ++d0)
#pragma unroll
            for (int j = 0; j < 8; ++j) { const float v = bf2f((bf16_t)qr[d0][j]); qn2 = fmaf(v, v, qn2); }
        qn2 = xhalf_sum(qn2);
        mref = sqrtf(qn2 * kmax2) * 1.01f + 0.01f;
    }
    f32x16 negm;
#pragma unroll
    for (int r = 0; r < 16; ++r) negm[r] = -mref;
    const int srow = tid >> 3, sch = tid & 7;
    const bf16_t* gk = KA + (size_t)srow * kapitch + sch * 8;
    const bf16_t* gv = V + (size_t)srow * vpitch + sch * 8;
    const bf16_t* gr = (DQK > 64) ? (KB + (size_t)(tid >> 2) * kbpitch + (tid & 3) * 8) : nullptr;
    const int sk_off = AT_K + srow * 128 + ((sch ^ ((srow >> 1) & 7)) << 4);
    const int sv_off = AT_V + (sch >> 2) * 4096 + srow * 64 + (sch & 3) * 16;
    const int sr_off = AT_KR + (tid >> 2) * 64 + (((tid & 3) ^ (((tid >> 2) >> 2) & 3)) << 4);
    const bool do_r = (DQK > 64) && (tid < 256);
    const int kf_off = AT_K + r32 * 128, ksw = (r32 >> 1) & 7;
    const int rf_off = AT_KR + r32 * 64, rsw = (r32 >> 2) & 3;
    const int vf_off = AT_V + (4 * hi + ((lane & 15) >> 2)) * 64 + ((lane >> 4) & 1) * 32 + (lane & 3) * 8;
    uint4 rk, rv, rr; rr = make_uint4(0, 0, 0, 0);
    rk = *(const uint4*)gk; rv = *(const uint4*)gv; if (do_r) rr = *(const uint4*)gr;
    *(uint4*)(lds + sk_off) = rk; *(uint4*)(lds + sv_off) = rv; if (do_r) *(uint4*)(lds + sr_off) = rr;
    __syncthreads();
    f32x16 o0, o1;
#pragma unroll
    for (int r = 0; r < 16; ++r) { o0[r] = 0.f; o1[r] = 0.f; }
    float lrun = 0.f;
#pragma unroll 1
    for (int t = 0; t < ntiles; ++t) {
        const char* cur = lds + (t & 1) * AT_BUF; char* nxt = lds + ((t + 1) & 1) * AT_BUF;
        const bool more = (t + 1 < ntiles);
        if (more) { rk = *(const uint4*)(gk + (size_t)(t + 1) * 64 * kapitch); rv = *(const uint4*)(gv + (size_t)(t + 1) * 64 * vpitch); if (do_r) rr = *(const uint4*)(gr + (size_t)(t + 1) * 64 * kbpitch); }
        bf16x8 kf[8];
#pragma unroll
        for (int d0 = 0; d0 < 4; ++d0) { const int co = ((2 * d0 + hi) ^ ksw) << 4; kf[2 * d0] = *(const bf16x8*)(cur + kf_off + co); kf[2 * d0 + 1] = *(const bf16x8*)(cur + kf_off + 32 * 128 + co); }
        f32x16 p0, p1;
        p0 = MFMA32(kf[0], qr[0], negm); p1 = MFMA32(kf[1], qr[0], negm);
        p0 = MFMA32(kf[2], qr[1], p0); p1 = MFMA32(kf[3], qr[1], p1);
        if (DQK > 64) {
            __builtin_amdgcn_sched_barrier(0);
#pragma unroll
            for (int d0 = 4; d0 < ND0; ++d0) { const int co = ((2 * (d0 - 4) + hi) ^ rsw) << 4; kf[2 * (d0 - 4)] = *(const bf16x8*)(cur + rf_off + co); kf[2 * (d0 - 4) + 1] = *(const bf16x8*)(cur + rf_off + 32 * 64 + co); }
        }
        p0 = MFMA32(kf[4], qr[2], p0); p1 = MFMA32(kf[5], qr[2], p1);
        p0 = MFMA32(kf[6], qr[3], p0); p1 = MFMA32(kf[7], qr[3], p1);
        if (DQK > 64) {
#pragma unroll
            for (int d0 = 4; d0 < ND0; ++d0) { p0 = MFMA32(kf[2 * (d0 - 4)], qr[d0], p0); p1 = MFMA32(kf[2 * (d0 - 4) + 1], qr[d0], p1); }
        }
        bf16x8 vf[8];
        auto vload = [&](int s) __attribute__((always_inline)) {
            const lds_cptr vb = (lds_cptr)cur + vf_off + s * 1024;
            const s16x4 a0 = vtr(vb), a1 = vtr(vb + 512), b0 = vtr(vb + 4096), b1 = vtr(vb + 4096 + 512);
            vf[2 * s] = (bf16x8){a0[0], a0[1], a0[2], a0[3], a1[0], a1[1], a1[2], a1[3]};
            vf[2 * s + 1] = (bf16x8){b0[0], b0[1], b0[2], b0[3], b1[0], b1[1], b1[2], b1[3]};
        };
        vload(0); vload(1);
        float ls = 0.f;
#pragma unroll
        for (int s = 0; s < 4; ++s) {
            float e[8];
#pragma unroll
            for (int j = 0; j < 8; ++j) e[j] = __builtin_amdgcn_exp2f(s < 2 ? p0[8 * s + j] : p1[8 * (s - 2) + j]);
            ls += ((e[0] + e[1]) + (e[2] + e[3])) + ((e[4] + e[5]) + (e[6] + e[7]));
            u32x4 u = {cvtpk(e[0], e[1]), cvtpk(e[2], e[3]), cvtpk(e[4], e[5]), cvtpk(e[6], e[7])};
            const bf16x8 pf = __builtin_bit_cast(bf16x8, u);
            if (s + 2 < 4) vload(s + 2);
            o0 = MFMA32(vf[2 * s], pf, o0); o1 = MFMA32(vf[2 * s + 1], pf, o1);
        }
        lrun += ls;
        if (more) { *(uint4*)(nxt + sk_off) = rk; *(uint4*)(nxt + sv_off) = rv; if (do_r) *(uint4*)(nxt + sr_off) = rr; }
        __syncthreads();
    }
    const float inv = 1.0f / xhalf_sum(lrun);
    bf16_t* op = O + (size_t)(wid * 32 + r32) * 512 + 4 * hi;
#pragma unroll
    for (int rg = 0; rg < 4; ++rg) {
        uint2 a; a.x = pack2(o0[4 * rg] * inv, o0[4 * rg + 1] * inv); a.y = pack2(o0[4 * rg + 2] * inv, o0[4 * rg + 3] * inv);
        uint2 b; b.x = pack2(o1[4 * rg] * inv, o1[4 * rg + 1] * inv); b.y = pack2(o1[4 * rg + 2] * inv, o1[4 * rg + 3] * inv);
        *(uint2*)(op + 8 * rg) = a; *(uint2*)(op + 32 + 8 * rg) = b;
    }
}
__device__ __forceinline__ void attn_dispatch(const KP& p, int ty, int h, int qt, float gqa_ref, char* lds) {
    const bf16_t* P = WSP(bf16_t, OFF_P); const bf16_t* Qm = WSP(bf16_t, OFF_H); const bf16_t* Kn = WSP(bf16_t, OFF_KN); const bf16_t* Vm = WSP(bf16_t, OFF_V);
    const int ntiles = (qt == 0) ? (LC / 64) : (T / 64);
    const size_t r0 = (size_t)qt * 256;
    bf16_t* Om = WSP(bf16_t, OFF_OM); bf16_t* Og = WSP(bf16_t, OFF_OG);
    if (ty == 0) {
        const float kmax2 = __uint_as_float(WSP(unsigned, OFF_CNT)[32 + h]);
        attn_item4<96>(Qm + r0 * 768 + h * 96, 768, Kn + h * 64, 512, P + C_KR, PP, Vm + h * 64, 512, ntiles, 0.f, kmax2, Om + r0 * 512 + h * 64, lds);
    } else
        attn_item4<64>(P + r0 * PP + C_GQ + h * 64, PP, P + C_GK + (h >> 2) * 64, PP, nullptr, 0, P + C_GV + (h >> 2) * 64, PP, ntiles, gqa_ref, 0.f, Og + r0 * 512 + h * 64, lds);
}
__device__ __forceinline__ void st_attn(const KP& p, int l, int bid, int nb, char* lds) {
    const int tidx = opaque_tid();
    float gq = fabsf(p.in(I_GQN)[l * 64 + (tidx & 63)]), gk = fabsf(p.in(I_GKN)[l * 64 + (tidx & 63)]);
#pragma unroll
    for (int o = 32; o > 0; o >>= 1) { gq = fmaxf(gq, __shfl_xor(gq, o)); gk = fmaxf(gk, __shfl_xor(gk, o)); }
    const float gqa_ref = 64.0f * SC_GQA * gq * gk * 1.02f + 0.01f;
    for (int ty = 0; ty < 2; ++ty)
        for (int u = bid; u < 512; u += nb) attn_dispatch(p, ty, u & 7, 1 + (u >> 3), gqa_ref, lds);
    for (int u = bid; u < 16; u += nb) attn_dispatch(p, u >> 3, u & 7, 0, gqa_ref, lds);
}

__device__ __forceinline__ void st_merge(const KP& p, int l, int bid, int nb, char* lds) {
    const int tidx = opaque_tid();
    const bf16_t* P = WSP(bf16_t, OFF_P); bf16_t* Mb = WSP(bf16_t, OFF_H);
    const bf16_t* Wb = WSP(bf16_t, OFF_WB + WB_BR);
    int mt, nt;
    for (int it = 0; dense_tile(it, 8, l + 1 < NL, bid, nb, mt, nt); ++it) {
        acc_t tot; acc_zero(tot);
#pragma unroll 1
        for (int b = 0; b < 3; ++b) {
            const bf16_t* Ob = b == 1 ? P + C_SSM : WSP(bf16_t, b == 0 ? OFF_OM : OFF_OG); const int opitch = b == 1 ? PP : 512;
            acc_t acc; acc_zero(acc);
            gemm_core(acc, [&](int r) { return Ob + (size_t)(mt * 256 + r) * opitch; }, [&](int r) { return Wb + ((size_t)b * 1024 + nt * 128 + r) * 512; }, 512, lds);
            acc_visit_add(acc, tot, [&](int ml, int nl, f32x4 v) {
                const int wm_ = ml >> 6, im_ = (ml >> 4) & 3, fr_ = ml & 15, G_ = b * 64 + nt * 8 + (nl >> 4), g_ = (nl >> 2) & 3;
                const uint2 gr = *(const uint2*)(WSP(bf16_t, OFF_GS) + (((((size_t)(mt * 192 + G_) * 4 + wm_) * 4 + im_) * 64) + g_ * 16 + fr_) * 4);
                f32x4 r; r[0] = bflo(gr.x) * v[0]; r[1] = bfhi(gr.x) * v[1]; r[2] = bflo(gr.y) * v[2]; r[3] = bfhi(gr.y) * v[3];
                return r; });
        }
        acc_visit(tot, [&](int ml, int nl, f32x4 v) { *(uint2*)(Mb + (size_t)(mt * 256 + ml) * 1024 + nt * 128 + nl) = pack4(v); });
    }
}
__device__ __forceinline__ void st_wout(const KP& p, int l, int bid, int nb, char* lds) {
    const int tidx = opaque_tid();
    const bf16_t* Mb = WSP(bf16_t, OFF_H); const bf16_t* Wt = WSP(bf16_t, OFF_WB + WB_OUT); float* Y = WSP(float, OFF_Y);
    int mt, nt;
    for (int it = 0; dense_tile(it, 8, l + 1 < NL, bid, nb, mt, nt); ++it) {
        acc_t acc; acc_zero(acc);
        gemm_core(acc, [&](int r) { return Mb + (size_t)(mt * 256 + r) * 1024; }, [&](int r) { return Wt + (size_t)(nt * 128 + r) * 1024; }, 1024, lds);
        acc_visit(acc, [&](int ml, int nl, f32x4 v) { *(f32x4*)(Y + (size_t)(mt * 256 + ml) * 1024 + nt * 128 + nl) = v; });
    }
    int* sltok = WSP(int, OFF_SLTOK); float* slw = WSP(float, OFF_SLW); int* cnt = WSP(int, OFF_CNT);
    for (int i = bid * NTH + tidx; i < TP; i += nb * NTH) { sltok[i] = 0; slw[i] = 0.f; }
    if (bid == 0 && tidx < 32) cnt[tidx] = 0;
}

__device__ __forceinline__ void st_postmix(const KP& p, int l, int bid, int nb, char* lds) {
    const int tidx = opaque_tid();
    const int lane = tidx & 63, wid = tidx >> 6;
    const float* Y = WSP(float, OFF_Y); bf16_t* H2 = WSP(bf16_t, OFF_H);
    const float* gpost = p.in(I_GPOSTMIX) + l * D; const float* gpre = p.in(I_GPREFFN) + l * D;
    int* toke = WSP(int, OFF_TOKE); float* tokw = WSP(float, OFF_TOKW); int* cnt = WSP(int, OFF_CNT);
    float* wl = (float*)lds; int* hist = (int*)(lds + 20 * 1024 * 4);
    {   const float* wg = p.in(I_WGROUP) + (size_t)l * D * 4; const float* wr = p.in(I_WROUTER) + (size_t)l * D * 16;
        for (int k = tidx; k < 1024; k += NTH) {
            const float4 g4 = *(const float4*)(wg + (size_t)k * 4);
            wl[0 * 1024 + k] = g4.x; wl[1 * 1024 + k] = g4.y; wl[2 * 1024 + k] = g4.z; wl[3 * 1024 + k] = g4.w;
#pragma unroll
            for (int e4 = 0; e4 < 4; ++e4) { const float4 r4 = *(const float4*)(wr + (size_t)k * 16 + e4 * 4);
                wl[(4 + e4 * 4 + 0) * 1024 + k] = r4.x; wl[(4 + e4 * 4 + 1) * 1024 + k] = r4.y; wl[(4 + e4 * 4 + 2) * 1024 + k] = r4.z; wl[(4 + e4 * 4 + 3) * 1024 + k] = r4.w; }
        }
        if (tidx < 16) hist[tidx] = 0;
        __syncthreads(); }
    for (int r = (l + 1 < NL ? 0 : LC) + bid * NWV + wid; r < T; r += nb * NWV) {
        float* xr = xrow(p, r);
        const float* md = WSP(float, OFF_MOD) + (size_t)(l * 2 + (r < LC ? 1 : 0)) * 6144;
        float4 y[4], x[4]; float ss = 0.f;
#pragma unroll
        for (int i = 0; i < 4; ++i) { y[i] = *(const float4*)(Y + (size_t)r * D + i * 256 + lane * 4); ss += y[i].x * y[i].x + y[i].y * y[i].y + y[i].z * y[i].z + y[i].w * y[i].w; }
        ss = wave_sum(ss);
        const float rstd = rsqrtf(ss * (1.0f / D) + EPS);
        float ss2 = 0.f;
#pragma unroll
        for (int i = 0; i < 4; ++i) { const int c = i * 256 + lane * 4;
            const float4 gg = *(const float4*)(gpost + c), ga = *(const float4*)(md + 2048 + c); x[i] = *(const float4*)((l == 0 ? xrow_in(p, r) : (const float*)xr) + c);
            x[i].x += ga.x * y[i].x * rstd * gg.x; x[i].y += ga.y * y[i].y * rstd * gg.y; x[i].z += ga.z * y[i].z * rstd * gg.z; x[i].w += ga.w * y[i].w * rstd * gg.w;
            *(float4*)(xr + c) = x[i];
            ss2 += x[i].x * x[i].x + x[i].y * x[i].y + x[i].z * x[i].z + x[i].w * x[i].w; }
        ss2 = wave_sum(ss2);
        const float rstd2 = rsqrtf(ss2 * (1.0f / D) + EPS);
        float lg[4] = {0.f, 0.f, 0.f, 0.f}, le[16];
#pragma unroll
        for (int e = 0; e < 16; ++e) le[e] = 0.f;
#pragma unroll
        for (int i = 0; i < 4; ++i) { const int c = i * 256 + lane * 4;
            const float4 gg = *(const float4*)(gpre + c), sh = *(const float4*)(md + 3072 + c), sc = *(const float4*)(md + 4096 + c);
            float h[4];
            h[0] = x[i].x * rstd2 * gg.x * (1.f + sc.x) + sh.x; h[1] = x[i].y * rstd2 * gg.y * (1.f + sc.y) + sh.y;
            h[2] = x[i].z * rstd2 * gg.z * (1.f + sc.z) + sh.z; h[3] = x[i].w * rstd2 * gg.w * (1.f + sc.w) + sh.w;
            uint2 o; o.x = pack2(h[0], h[1]); o.y = pack2(h[2], h[3]);
            *(uint2*)(H2 + (size_t)r * D + c) = o;
#pragma unroll
            for (int e = 0; e < 4; ++e) { const float4 w4 = *(const float4*)(wl + e * 1024 + c);
                lg[e] = fmaf(h[0], w4.x, lg[e]); lg[e] = fmaf(h[1], w4.y, lg[e]); lg[e] = fmaf(h[2], w4.z, lg[e]); lg[e] = fmaf(h[3], w4.w, lg[e]); }
#pragma unroll
            for (int e = 0; e < 16; ++e) { const float4 w4 = *(const float4*)(wl + (4 + e) * 1024 + c);
                le[e] = fmaf(h[0], w4.x, le[e]); le[e] = fmaf(h[1], w4.y, le[e]); le[e] = fmaf(h[2], w4.z, le[e]); le[e] = fmaf(h[3], w4.w, le[e]); }
        }
#pragma unroll
        for (int g = 0; g < 4; ++g) lg[g] = wave_sum(lg[g]) + p.in(I_BGROUP)[l * 4 + g];
        const float myle = transpose_reduce16(le, lane) + p.in(I_BROUTER)[l * 16 + (lane & 15)];
        int gs = 0; float gm = lg[0];
#pragma unroll
        for (int g = 1; g < 4; ++g) if (lg[g] > gm) { gm = lg[g]; gs = g; }
        float ls[4];
#pragma unroll
        for (int i = 0; i < 4; ++i) ls[i] = __shfl(myle, gs * 4 + i);
        if (lane == 0) {
            float den = 0.f;
#pragma unroll
            for (int g = 0; g < 4; ++g) den += __expf(lg[g] - gm);
            const float pg = 1.0f / den;
            int i0 = 0; float m0 = ls[0];
#pragma unroll
            for (int i = 1; i < 4; ++i) if (ls[i] > m0) { m0 = ls[i]; i0 = i; }
            int i1 = -1; float m1 = -INFINITY;
#pragma unroll
            for (int i = 0; i < 4; ++i) if (i != i0 && ls[i] > m1) { m1 = ls[i]; i1 = i; }
            const float e1 = __expf(m1 - m0), w0 = pg / (1.f + e1), w1 = pg * e1 / (1.f + e1);
            const int ex0 = gs * 4 + i0, ex1 = gs * 4 + i1;
            toke[r * 2] = ex0; toke[r * 2 + 1] = ex1; tokw[r * 2] = w0; tokw[r * 2 + 1] = w1;
            atomicAdd(&hist[ex0], 1); atomicAdd(&hist[ex1], 1);
        }
    }
    __syncthreads();
    if (tidx < 16 && hist[tidx] != 0) atomicAdd(&cnt[tidx], hist[tidx]);
}

__device__ __forceinline__ void moe_offsets(const int* cnt, int* off) {
    int a = 0;
#pragma unroll
    for (int e = 0; e < 16; ++e) { off[e] = a; a += (cnt[e] + 255) & ~255; }
    off[16] = a;
}
__device__ __forceinline__ int moe_expert_of(const int* off, int j) {
    int e = 0;
#pragma unroll
    for (int k = 1; k < 16; ++k) e += (j >= off[k]) ? 1 : 0;
    return e;
}
__device__ __forceinline__ void st_moe_build(const KP& p, int l, int bid, int nb) {
    const int tidx = opaque_tid();
    int* cnt = WSP(int, OFF_CNT); int* cnt2 = cnt + 16;
    const int* toke = WSP(int, OFF_TOKE); const float* tokw = WSP(float, OFF_TOKW); int* toks = WSP(int, OFF_TOKS);
    int* sltok = WSP(int, OFF_SLTOK); float* slw = WSP(float, OFF_SLW);
    int off[17]; moe_offsets(cnt, off);
    for (int idx = (l + 1 < NL ? 0 : 2 * LC) + bid * NTH + tidx; idx < T * 2; idx += nb * NTH) {
        const int e = toke[idx];
        int o = 0;
#pragma unroll
        for (int k = 0; k < 16; ++k) o = (e == k) ? off[k] : o;
        const int pos = o + atomicAdd(&cnt2[e], 1);
        sltok[pos] = idx >> 1; slw[pos] = tokw[idx]; toks[idx] = pos;
    }
}
__device__ __forceinline__ void st_moe_up(const KP& p, int bid, int nb, char* lds) {
    const int tidx = opaque_tid();
    const int* cnt = WSP(int, OFF_CNT); const int* sltok = WSP(int, OFF_SLTOK);
    const bf16_t* H2 = WSP(bf16_t, OFF_H); const bf16_t* Wg = WSP(bf16_t, OFF_WB + WB_EG); const bf16_t* Wu = WSP(bf16_t, OFF_WB + WB_EU); bf16_t* Hid = WSP(bf16_t, OFF_HID);
    int off[17]; moe_offsets(cnt, off);
    const int ntiles = (off[16] >> 8) * 8;
    for (int L = bid; L < ntiles; L += nb) {
        const int mt = L >> 3, nt = L & 7, e = moe_expert_of(off, mt * 256);
        acc_t acc; acc_zero(acc);
        gemm_core(acc, [&](int r) { return H2 + (size_t)sltok[mt * 256 + r] * 1024; },
                  [&](int r) { const int wn = r >> 6, in = (r >> 4) & 3, j = r & 15; return ((in & 1) ? Wu : Wg) + ((size_t)e * 512 + nt * 64 + wn * 32 + (in >> 1) * 16 + j) * 1024; }, 1024, lds);
        const int lane = tidx & 63, wid = tidx >> 6, wm = wid >> 1, wn = wid & 1, fr = lane & 15, g = lane >> 4;
#pragma unroll
        for (int im = 0; im < 4; ++im)
#pragma unroll
            for (int q = 0; q < 2; ++q) {
                const f32x4 gt = acc[2 * q][im], up = acc[2 * q + 1][im];
                uint2 o; o.x = pack2(siluf_(gt[0]) * up[0], siluf_(gt[1]) * up[1]); o.y = pack2(siluf_(gt[2]) * up[2], siluf_(gt[3]) * up[3]);
                *(uint2*)(Hid + (size_t)(mt * 256 + wm * 64 + 16 * im + fr) * 512 + nt * 64 + wn * 32 + 16 * q + 4 * g) = o;
            }
    }
}
__device__ __forceinline__ void st_moe_down(const KP& p, int bid, int nb, char* lds) {
    const int tidx = opaque_tid();
    const int* cnt = WSP(int, OFF_CNT); const float* slw = WSP(float, OFF_SLW);
    const bf16_t* Hid = WSP(bf16_t, OFF_HID); const bf16_t* Wd = WSP(bf16_t, OFF_WB + WB_ED); bf16_t* Sl = WSP(bf16_t, OFF_SLOTS);
    int off[17]; moe_offsets(cnt, off);
    const int ntiles = (off[16] >> 8) * 8;
    for (int L = bid; L < ntiles; L += nb) {
        const int mt = L >> 3, nt = L & 7, e = moe_expert_of(off, mt * 256);
        acc_t acc; acc_zero(acc);
        gemm_core(acc, [&](int r) { return Hid + (size_t)(mt * 256 + r) * 512; }, [&](int r) { return Wd + ((size_t)e * 1024 + nt * 128 + r) * 512; }, 512, lds);
        acc_visit(acc, [&](int ml, int nl, f32x4 v) {
            const float w = slw[mt * 256 + ml];
            *(uint2*)(Sl + (size_t)(mt * 256 + ml) * 1024 + nt * 128 + nl) = pack4(v * w); });
    }
}
__device__ __forceinline__ void st_postffn(const KP& p, int l, int bid, int nb) {
    const int tidx = opaque_tid();
    const int lane = tidx & 63, wid = tidx >> 6;
    const bf16_t* Sl = WSP(bf16_t, OFF_SLOTS); const int* toks = WSP(int, OFF_TOKS);
    const float* gpost = p.in(I_GPOSTFFN) + l * D;
    const bool next = (l + 1 < NL);
    bf16_t* Hb = WSP(bf16_t, OFF_H); const float* gpre = p.in(I_GPREMIX) + (next ? l + 1 : l) * D;
    for (int r = (l + 1 < NL ? 0 : LC) + bid * NWV + wid; r < T; r += nb * NWV) {
        float* xr = xrow(p, r);
        const float* md = WSP(float, OFF_MOD) + (size_t)(l * 2 + (r < LC ? 1 : 0)) * 6144;
        const bf16_t* s0 = Sl + (size_t)toks[r * 2] * 1024; const bf16_t* s1 = Sl + (size_t)toks[r * 2 + 1] * 1024;
        float v[16]; float ss = 0.f;
#pragma unroll
        for (int i = 0; i < 4; ++i) { const int c = i * 256 + lane * 4; const uint2 a = *(const uint2*)(s0 + c), b = *(const uint2*)(s1 + c);
            v[4 * i] = bflo(a.x) + bflo(b.x); v[4 * i + 1] = bfhi(a.x) + bfhi(b.x); v[4 * i + 2] = bflo(a.y) + bflo(b.y); v[4 * i + 3] = bfhi(a.y) + bfhi(b.y);
            ss += v[4 * i] * v[4 * i] + v[4 * i + 1] * v[4 * i + 1] + v[4 * i + 2] * v[4 * i + 2] + v[4 * i + 3] * v[4 * i + 3]; }
        ss = wave_sum(ss);
        const float rstd = rsqrtf(ss * (1.0f / D) + EPS);
        float4 xs[4]; float ss2 = 0.f;
#pragma unroll
        for (int i = 0; i < 4; ++i) { const int c = i * 256 + lane * 4;
            const float4 gg = *(const float4*)(gpost + c), ga = *(const float4*)(md + 5120 + c); float4 x = *(const float4*)(xr + c);
            x.x += ga.x * v[4 * i] * rstd * gg.x; x.y += ga.y * v[4 * i + 1] * rstd * gg.y; x.z += ga.z * v[4 * i + 2] * rstd * gg.z; x.w += ga.w * v[4 * i + 3] * rstd * gg.w;
            *(float4*)(xr + c) = x; xs[i] = x; ss2 += x.x * x.x + x.y * x.y + x.z * x.z + x.w * x.w; }
        if (next) {
            ss2 = wave_sum(ss2);
            const float rstd2 = rsqrtf(ss2 * (1.0f / D) + EPS);
            const float* md2 = WSP(float, OFF_MOD) + (size_t)((l + 1) * 2 + (r < LC ? 1 : 0)) * 6144;
#pragma unroll
            for (int i = 0; i < 4; ++i) { const int c = i * 256 + lane * 4;
                const float4 gg = *(const float4*)(gpre + c), sh = *(const float4*)(md2 + c), sc = *(const float4*)(md2 + 1024 + c);
                uint2 o; o.x = pack2(xs[i].x * rstd2 * gg.x * (1.f + sc.x) + sh.x, xs[i].y * rstd2 * gg.y * (1.f + sc.y) + sh.y);
                o.y = pack2(xs[i].z * rstd2 * gg.z * (1.f + sc.z) + sh.z, xs[i].w * rstd2 * gg.w * (1.f + sc.w) + sh.w);
                *(uint2*)(Hb + (size_t)r * D + c) = o; }
        }
    }
}

__device__ __forceinline__ void gsync(unsigned* bar, unsigned& epoch) {
    asm volatile("s_waitcnt vmcnt(0) lgkmcnt(0)" ::: "memory");
    __syncthreads();
    if (threadIdx.x == 0) {
        __builtin_amdgcn_fence(__ATOMIC_RELEASE, "agent");
        asm volatile("s_waitcnt vmcnt(0)" ::: "memory");
        epoch += 1;
        __hip_atomic_fetch_add(bar, 1u, __ATOMIC_RELAXED, __HIP_MEMORY_SCOPE_AGENT);
        const unsigned target = epoch * gridDim.x;
        while (__hip_atomic_load(bar, __ATOMIC_RELAXED, __HIP_MEMORY_SCOPE_AGENT) < target) __builtin_amdgcn_s_sleep(2);
        __builtin_amdgcn_fence(__ATOMIC_ACQUIRE, "agent");
        asm volatile("s_waitcnt vmcnt(0)" ::: "memory");
    }
    __syncthreads();
}

__global__ void __launch_bounds__(NTH) k_mega(Params p_unused) {
    KP p; p.k = (kparams_t)__builtin_amdgcn_kernarg_segment_ptr();
    __shared__ __attribute__((aligned(16))) char lds[LDS_BYTES]; float* smem = (float*)lds;
    cg::grid_group grid = cg::this_grid();
    grid.sync();
    const int bid = blockIdx.x, nb = gridDim.x;
    unsigned* bar = WSP(unsigned, OFF_BAR); unsigned epoch = 0;
#define GS() gsync(bar, epoch)
    st_prologue(p, bid, nb, smem); st_conv(p, 0, bid, nb, smem); st_s5_tables(p, 0, bid, nb, lds); GS();
    st_modulate(p, 0, bid, nb); GS();
#pragma unroll 1
    for (int l = 0; l < NL; ++l) {
        st_gemm_in(p, l, bid, nb, lds); GS();
        st_s5_local(p, l, bid, nb); st_s5_fgemm(p, bid, nb, lds); GS();
        st_s5_carry(p, l, bid, nb, lds); st_proj2<0>(p, l, bid, nb, lds); GS();
        st_s5_ygemm(p, l, bid, nb, lds); st_s5_ctx_y(p, l, bid, nb); st_ropeq(p, bid, nb, lds); GS();
        st_proj2<1>(p, l, bid, nb, lds); st_attn(p, l, bid, nb, lds); GS();
        st_merge(p, l, bid, nb, lds); GS();
        st_wout(p, l, bid, nb, lds); st_conv_experts(p, l, bid, nb, smem); GS();
        st_postmix(p, l, bid, nb, lds); GS();
        st_moe_build(p, l, bid, nb); GS();
        st_moe_up(p, bid, nb, lds); GS();
        st_moe_down(p, bid, nb, lds); GS();
        st_postffn(p, l, bid, nb);
        if (l + 1 < NL) { st_conv(p, l + 1, bid, nb, smem); st_s5_tables(p, l + 1, bid, nb, lds); }
        GS();
    }
#undef GS
}

extern "C" void kernel_launch(void* const* d_in, const int* in_sizes, int n_in, void* d_out, int out_size, void* d_ws, size_t ws_size, hipStream_t stream) {
    Params p{};
    for (int i = 0; i < N_IN; ++i) p.in[i] = (const float*)d_in[i];
    p.out = (float*)d_out; p.ws = (char*)d_ws;
    if (ws_size < WS_NEED) { fprintf(stderr, "workspace too small: %zu < %zu\n", ws_size, (size_t)WS_NEED); return; }
    static int grid_blocks = 0;
    if (!grid_blocks) {
        int dev = 0, cus = 0, per_cu = 0;
        hipGetDevice(&dev);
        hipDeviceGetAttribute(&cus, hipDeviceAttributeMultiprocessorCount, dev);
        hipOccupancyMaxActiveBlocksPerMultiprocessor(&per_cu, k_mega, NTH, 0);
        if (per_cu > 1) per_cu = 1;
        if (per_cu < 1) per_cu = 1;
        grid_blocks = cus * per_cu;
    }
    hipMemsetAsync((char*)d_ws + OFF_BAR, 0, 256, stream);
    void* args[] = { &p };
    hipError_t e = hipLaunchCooperativeKernel((void*)k_mega, dim3(grid_blocks), dim3(NTH), args, 0, stream);
    if (e != hipSuccess) fprintf(stderr, "cooperative launch failed: %s (grid %d)\n", hipGetErrorString(e), grid_blocks);
}
```

```cpp
#include <hip/hip_runtime.h>
#include <hip/hip_cooperative_groups.h>
#include <cstdio>
#include <cstdint>
#include <type_traits>
namespace cg = cooperative_groups;


typedef unsigned short bf16_t;
typedef short bf16x8 __attribute__((ext_vector_type(8)));
typedef float f32x16 __attribute__((ext_vector_type(16)));
typedef float f32x4 __attribute__((ext_vector_type(4)));
typedef unsigned u32x4 __attribute__((ext_vector_type(4)));
constexpr int NTH = 512, NWV = 8;
#ifndef REP_CONV
#define REP_CONV 1
#endif
#ifndef REP_G1
#define REP_G1 1
#endif
#ifndef REP_G2
#define REP_G2 1
#endif
#ifndef REP_G3
#define REP_G3 1
#endif
#ifndef REP_S5
#define REP_S5 1
#endif
#ifndef REP_ATTN
#define REP_ATTN 1
#endif

constexpr int D = 1024, S = 16384, LC = 256, T = S + LC, NL = 2;
constexpr int NIN = 4768, NINP = 4864;
constexpr int PP = 1696;
constexpr int C_GQ = 0, C_GK = 512, C_GV = 640, C_CQ = 768, C_CKV = 1024, C_KR = 1152, C_SSM = 1184, C_GATE = 1696;
__host__ __device__ constexpr int win_col_old(int n) {
    return n < 512 ? 928 + n : n < 640 ? 1440 + (n - 512) : n < 768 ? 1568 + (n - 640) : n < 1024 ? (n - 768) : n < 1152 ? 256 + (n - 1024) : n < 1184 ? 384 + (n - 1152) : n < 1696 ? 416 + (n - 1184) : n;
}
constexpr int TP = 2 * T + 16 * 256;
constexpr float EPS = 1e-6f;
constexpr float LOG2E = 1.4426950408889634f;
constexpr float SC_MLA = 0.10206207261596575f * LOG2E, SC_GQA = 0.125f * LOG2E;

enum { I_X = 0, I_C, I_CTX, I_CCTX, I_WMOD, I_BMOD, I_GPREMIX, I_GPOSTMIX, I_GPREFFN, I_GPOSTFFN, I_WIN, I_GCQ, I_GCKV, I_WUQ, I_WUKV,
       I_GQN, I_GKN, I_ARE, I_AIM, I_LOGDT, I_BRE, I_BIM, I_CRE, I_CIM, I_SSMD, I_WGLU, I_BGLU, I_WBRM, I_WBRS, I_WBRG, I_WOUT,
       I_WGROUP, I_BGROUP, I_WROUTER, I_BROUTER, I_WEG, I_WEU, I_WED, N_IN };

constexpr size_t al256(size_t x) { return (x + 255) & ~(size_t)255; }
constexpr size_t WB_IN = 0;
constexpr size_t WB_UQ = WB_IN + (size_t)NINP * 1024 * 2;
constexpr size_t WB_UKV = WB_UQ + (size_t)768 * 256 * 2;
constexpr size_t WB_GLU = WB_UKV + (size_t)1024 * 128 * 2;
constexpr size_t WB_BR = WB_GLU + (size_t)512 * 512 * 2;
constexpr size_t WB_OUT = WB_BR + (size_t)3 * 1024 * 512 * 2;
constexpr size_t WB_EG = WB_OUT + (size_t)1024 * 1024 * 2;
constexpr size_t WB_EU = WB_EG + (size_t)16 * 512 * 1024 * 2;
constexpr size_t WB_ED = WB_EU + (size_t)16 * 512 * 1024 * 2;
constexpr size_t WB_BYTES = WB_ED + (size_t)16 * 1024 * 512 * 2;

constexpr size_t OFF_WB = 0;
constexpr size_t OFF_P = al256(OFF_WB + WB_BYTES);
constexpr size_t P_BYTES = (size_t)T * NIN * 2;
constexpr size_t OFF_GS = OFF_P + (size_t)T * PP * 2;
constexpr size_t OFF_Y = OFF_P;
constexpr size_t OFF_SLOTS = OFF_P;
constexpr size_t OFF_HID = OFF_P + (size_t)TP * 1024 * 2;
constexpr size_t OFF_H = al256(OFF_P + P_BYTES);
constexpr size_t OFF_KN = al256(OFF_H + (size_t)T * 1024 * 2);
constexpr size_t OFF_V = al256(OFF_KN + (size_t)T * 512 * 2);
constexpr size_t OFF_OM = al256(OFF_V + (size_t)T * 512 * 2);
constexpr size_t OFF_OG = OFF_OM + (size_t)T * 512 * 2;
constexpr size_t OFF_OS = OFF_OG + (size_t)T * 512 * 2;
constexpr size_t OFF_XC = al256(OFF_OS + (size_t)T * 512 * 2);
constexpr size_t OFF_MOD = al256(OFF_XC + (size_t)LC * 1024 * 4);
constexpr size_t OFF_TOKE = al256(OFF_MOD + (size_t)NL * 2 * 6144 * 4);
constexpr size_t OFF_TOKW = al256(OFF_TOKE + (size_t)T * 2 * 4);
constexpr size_t OFF_TOKS = al256(OFF_TOKW + (size_t)T * 2 * 4);
constexpr size_t OFF_SLTOK = al256(OFF_TOKS + (size_t)T * 2 * 4);
constexpr size_t OFF_SLW = al256(OFF_SLTOK + (size_t)TP * 4);
constexpr size_t OFF_CNT = al256(OFF_SLW + (size_t)TP * 4);
constexpr size_t OFF_S5 = al256(OFF_CNT + 256);
constexpr size_t OFF_ROPE = al256(OFF_S5 + (size_t)(T / 64) * 4096 * 8);
constexpr size_t OFF_SSQ = al256(OFF_ROPE + 256 * 24 * 8);
constexpr size_t OFF_SSMG = al256(OFF_SSQ + (size_t)T * 8 * 4);
constexpr size_t OFF_BAR = al256(OFF_SSMG + (size_t)32 * T * 16 * 2);
constexpr size_t WS_NEED = al256(OFF_BAR + 256);
static_assert(OFF_HID + (size_t)TP * 512 * 2 <= OFF_P + P_BYTES, "overlay");
static_assert((size_t)T * 1024 * 4 <= P_BYTES, "overlay Y");
static_assert(WS_NEED < 384000000ull, "ws");

struct Params {
    const float* in[N_IN];
    float* out;
    char* ws;
};
typedef const __attribute__((address_space(4))) Params* kparams_t;
struct KP {
    kparams_t k;
    __device__ __forceinline__ const float* in(int i) const { return *(const float* const volatile __attribute__((address_space(4)))*)(&k->in[i]); }
    __device__ __forceinline__ float* out() const { return *(float* const volatile __attribute__((address_space(4)))*)(&k->out); }
    __device__ __forceinline__ char* ws() const { return *(char* const volatile __attribute__((address_space(4)))*)(&k->ws); }
};

__device__ __forceinline__ float bf2f(bf16_t v) { return __uint_as_float(((unsigned)v) << 16); }
typedef __bf16 bf16x2_t __attribute__((ext_vector_type(2)));
__device__ __forceinline__ bf16_t f2bf(float f) { const __bf16 b = (__bf16)f; return __builtin_bit_cast(bf16_t, b); }
__device__ __forceinline__ float bflo(unsigned u) { return __uint_as_float(u << 16); }
__device__ __forceinline__ float bfhi(unsigned u) { return __uint_as_float(u & 0xFFFF0000u); }
__device__ __forceinline__ unsigned pack2(float lo, float hi) { bf16x2_t v; v[0] = (__bf16)lo; v[1] = (__bf16)hi; return __builtin_bit_cast(unsigned, v); }
__device__ __forceinline__ float wave_sum(float v) {
#pragma unroll
    for (int o = 32; o > 0; o >>= 1) v += __shfl_xor(v, o);
    return v;
}
__device__ __forceinline__ float xhalf_max(float m) { auto rr = __builtin_amdgcn_permlane32_swap(__float_as_uint(m), __float_as_uint(m), false, false); return fmaxf(__uint_as_float(rr[0]), __uint_as_float(rr[1])); }
__device__ __forceinline__ float xhalf_sum(float m) { auto rr = __builtin_amdgcn_permlane32_swap(__float_as_uint(m), __float_as_uint(m), false, false); return __uint_as_float(rr[0]) + __uint_as_float(rr[1]); }
__device__ __forceinline__ void rope_tab(float& a, float& b, float2 cs) { const float na = a * cs.x - b * cs.y, nb_ = a * cs.y + b * cs.x; a = na; b = nb_; }
__device__ __forceinline__ float transpose_reduce16(const float (&t16)[16], int lane) {
    float t8[8], t4[4], t2[2];
#pragma unroll
    for (int i = 0; i < 8; ++i) { const float a = t16[2 * i], b = t16[2 * i + 1]; const bool o = lane & 1; const float keep = o ? b : a, send = o ? a : b; t8[i] = keep + __shfl_xor(send, 1); }
#pragma unroll
    for (int i = 0; i < 4; ++i) { const float a = t8[2 * i], b = t8[2 * i + 1]; const bool o = lane & 2; const float keep = o ? b : a, send = o ? a : b; t4[i] = keep + __shfl_xor(send, 2); }
#pragma unroll
    for (int i = 0; i < 2; ++i) { const float a = t4[2 * i], b = t4[2 * i + 1]; const bool o = lane & 4; const float keep = o ? b : a, send = o ? a : b; t2[i] = keep + __shfl_xor(send, 4); }
    float y; { const float a = t2[0], b = t2[1]; const bool o = lane & 8; const float keep = o ? b : a, send = o ? a : b; y = keep + __shfl_xor(send, 8); }
    y += __shfl_xor(y, 16); y += __shfl_xor(y, 32);
    return y;
}
__device__ __forceinline__ float sigmoidf_(float x) { return __builtin_amdgcn_rcpf(1.0f + __builtin_amdgcn_exp2f(-LOG2E * x)); }
__device__ __forceinline__ float siluf_(float x) { return x * __builtin_amdgcn_rcpf(1.0f + __builtin_amdgcn_exp2f(-LOG2E * x)); }
__device__ __forceinline__ float gelu_tanh(float x) {
    const float u = 0.7978845608028654f * (x + 0.044715f * x * x * x);
    return x * __builtin_amdgcn_rcpf(1.0f + __builtin_amdgcn_exp2f(-2.0f * LOG2E * u));
}
__device__ __forceinline__ float dot8(uint4 a, uint4 b, float acc) {
    acc = fmaf(bflo(a.x), bflo(b.x), acc); acc = fmaf(bfhi(a.x), bfhi(b.x), acc);
    acc = fmaf(bflo(a.y), bflo(b.y), acc); acc = fmaf(bfhi(a.y), bfhi(b.y), acc);
    acc = fmaf(bflo(a.z), bflo(b.z), acc); acc = fmaf(bfhi(a.z), bfhi(b.z), acc);
    acc = fmaf(bflo(a.w), bflo(b.w), acc); acc = fmaf(bfhi(a.w), bfhi(b.w), acc);
    return acc;
}
__device__ __forceinline__ float dotrow(const bf16_t* a, const bf16_t* b, int K) {
    float acc = 0.f;
    const uint4* a4 = (const uint4*)a; const uint4* b4 = (const uint4*)b;
    for (int k = 0; k < K / 8; ++k) acc = dot8(a4[k], b4[k], acc);
    return acc;
}

__device__ __forceinline__ int opaque_tid() { int t = threadIdx.x; asm volatile("" : "+v"(t)); return t; }
#define WSP(type, off) ((type*)(p.ws() + (off)))
#define SSMU(g, r) (WSP(const bf16_t, OFF_SSMG) + ((size_t)(g) * T + (r)) * 16)

template <class AF, class BF, class EF>
__device__ __forceinline__ void gemm_naive(int M, int N, int K, AF arow, BF brow, EF epi, int bid, int nb) {
    const int tidx = opaque_tid();
    const long total = (long)M * N;
    for (long idx = (long)bid * NTH + tidx; idx < total; idx += (long)nb * NTH) {
        const int m = (int)(idx / N), n = (int)(idx % N);
        const float acc = dotrow(arow(m), brow(m, n), K);
        epi(m, n, acc);
    }
}

constexpr int G_A_BYTES = 256 * 128, G_W_BYTES = 128 * 128, G_BUF = G_A_BYTES + G_W_BYTES;
constexpr int LDS_BYTES = 3 * G_BUF;
#define MFMA32(a, b, c) __builtin_amdgcn_mfma_f32_32x32x16_bf16(a, b, c, 0, 0, 0)

#define GLDS16(gptr, lptr) __builtin_amdgcn_global_load_lds((const __attribute__((address_space(1))) void*)(gptr), (__attribute__((address_space(3))) void*)(lptr), 16, 0, 0)
typedef f32x4 acc_t[4][4];
#define MFMA16(a, b, c) __builtin_amdgcn_mfma_f32_16x16x32_bf16(a, b, c, 0, 0, 0)
template <class APTR, class WPTR>
__device__ __forceinline__ void gemm_core_g(acc_t& acc, APTR aptr, WPTR wptr, int nk, char* lds) {
    const int tidx = opaque_tid();
    const int tid = tidx, lane = tid & 63, wid = tid >> 6, wm = wid >> 1, wn = wid & 1, fr = lane & 15, g = lane >> 4;
    const int wu = __builtin_amdgcn_readfirstlane(wid);
    char* sdst = lds + wu * 1024;
    const int xoff = (wm * 64 + fr) * 128, woff = G_A_BYTES + (wn * 64 + fr) * 128, sw7 = (fr >> 1) & 7;
    asm volatile("s_waitcnt vmcnt(0)" ::: "memory");
#pragma unroll
    for (int i = 0; i < 4; ++i) GLDS16(aptr(i, 0), sdst + i * 8192);
#pragma unroll
    for (int i = 0; i < 2; ++i) GLDS16(wptr(i, 0), sdst + G_A_BYTES + i * 8192);
    if (nk > 1) {
#pragma unroll
        for (int i = 0; i < 4; ++i) GLDS16(aptr(i, 1), sdst + G_BUF + i * 8192);
#pragma unroll
        for (int i = 0; i < 2; ++i) GLDS16(wptr(i, 1), sdst + G_BUF + G_A_BYTES + i * 8192);
        asm volatile("s_waitcnt vmcnt(6)" ::: "memory");
    } else asm volatile("s_waitcnt vmcnt(0)" ::: "memory");
    __builtin_amdgcn_s_barrier();
    int slot = 0;
    for (int kt = 0; kt < nk; ++kt) {
        const char* cur = lds + slot * G_BUF;
        const int s2 = slot >= 1 ? slot - 1 : 2;
        const bool more2 = (kt + 2 < nk);
        char* nxt = sdst + s2 * G_BUF;
#pragma unroll
        for (int ks = 0; ks < 2; ++ks) {
            const int co = ((ks * 4 + g) ^ sw7) << 4;
            bf16x8 x[4], w[4];
#pragma unroll
            for (int i = 0; i < 4; ++i) { x[i] = *(const bf16x8*)(cur + xoff + i * 16 * 128 + co); w[i] = *(const bf16x8*)(cur + woff + i * 16 * 128 + co); }
#pragma unroll
            for (int in = 0; in < 4; ++in)
#pragma unroll
                for (int im = 0; im < 4; ++im) acc[in][im] = MFMA16(w[in], x[im], acc[in][im]);
            __builtin_amdgcn_sched_barrier(0);
            if (more2) {
                if (ks == 0) { GLDS16(aptr(0, kt + 2), nxt); GLDS16(aptr(1, kt + 2), nxt + 8192); GLDS16(aptr(2, kt + 2), nxt + 2 * 8192); }
                else { GLDS16(aptr(3, kt + 2), nxt + 3 * 8192); GLDS16(wptr(0, kt + 2), nxt + G_A_BYTES); GLDS16(wptr(1, kt + 2), nxt + G_A_BYTES + 8192); }
            }
            __builtin_amdgcn_sched_barrier(0);
        }
        if (more2) asm volatile("s_waitcnt vmcnt(6) lgkmcnt(0)" ::: "memory");
        else asm volatile("s_waitcnt vmcnt(0) lgkmcnt(0)" ::: "memory");
        __builtin_amdgcn_s_barrier();
        slot = slot == 2 ? 0 : slot + 1;
    }
}
template <class AROW, class WROW>
__device__ __forceinline__ void gemm_core(acc_t& acc, AROW arow, WROW wrow, int K, char* lds) {
    const int tidx = opaque_tid();
    const int srow = tidx >> 3, gch = (tidx & 7) ^ ((srow >> 1) & 7);
    const bf16_t* pa[4]; const bf16_t* pw[2];
#pragma unroll
    for (int i = 0; i < 4; ++i) pa[i] = arow(srow + 64 * i) + gch * 8;
#pragma unroll
    for (int i = 0; i < 2; ++i) pw[i] = wrow(srow + 64 * i) + gch * 8;
    gemm_core_g(acc, [&](int i, int kt) { return pa[i] + kt * 64; }, [&](int i, int kt) { return pw[i] + kt * 64; }, K >> 6, lds);
}
__device__ __forceinline__ void acc_zero(acc_t& acc) {
#pragma unroll
    for (int a = 0; a < 4; ++a)
#pragma unroll
        for (int b = 0; b < 4; ++b) { acc[a][b][0] = 0.f; acc[a][b][1] = 0.f; acc[a][b][2] = 0.f; acc[a][b][3] = 0.f; }
}
template <class F>
__device__ __forceinline__ void acc_visit(const acc_t& acc, F f) {
    const int tidx = opaque_tid();
    const int lane = tidx & 63, wid = tidx >> 6, wm = wid >> 1, wn = wid & 1, fr = lane & 15, g = lane >> 4;
#pragma unroll
    for (int in = 0; in < 4; ++in)
#pragma unroll
        for (int im = 0; im < 4; ++im) f(wm * 64 + 16 * im + fr, wn * 64 + 16 * in + 4 * g, acc[in][im]);
}
template <class F>
__device__ __forceinline__ void acc_visit_add(const acc_t& acc, acc_t& tot, F f) {
    const int tidx = opaque_tid();
    const int lane = tidx & 63, wid = tidx >> 6, wm = wid >> 1, wn = wid & 1, fr = lane & 15, g = lane >> 4;
#pragma unroll
    for (int in = 0; in < 4; ++in)
#pragma unroll
        for (int im = 0; im < 4; ++im) tot[in][im] += f(wm * 64 + 16 * im + fr, wn * 64 + 16 * in + 4 * g, acc[in][im]);
}
__device__ __forceinline__ uint2 pack4(f32x4 v) { uint2 o; o.x = pack2(v[0], v[1]); o.y = pack2(v[2], v[3]); return o; }
__device__ __forceinline__ bool dense_tile(int it, int NT, bool with_ctx, int bid, int nb, int& mt, int& nt) {
    const int x = bid & 7, j = bid >> 3, jb = nb >> 3;
    int v = it * jb + j;
    if (v < 8 * NT) { mt = 1 + x * 8 + (v & 7); nt = v >> 3; return true; }
    if (!with_ctx) return false;
    v -= 8 * NT; nt = x + 8 * v; mt = 0;
    return nt < NT;
}

__device__ __forceinline__ void st_prologue(const KP& p, int bid, int nb, float* smem) {
    const int tidx = opaque_tid();
    const int tid = tidx;
    {   float2* t16 = WSP(float2, OFF_ROPE); float2* t8 = t16 + 256 * 16;
        for (int idx = bid * NTH + tid; idx < 256 * 24; idx += nb * NTH) {
            const bool big = idx < 256 * 16; const int j = big ? idx : idx - 256 * 16, half = big ? 16 : 8, pos = j / half, i = j % half;
            const float ang = (float)pos * powf(10000.0f, -(float)i / (float)half);
            float sn, cs; sincosf(ang, &sn, &cs);
            (big ? t16 : t8)[j] = make_float2(cs, sn);
        } }
    for (int k = tid; k < 1024; k += NTH) { smem[k] = siluf_(p.in(I_C)[k]); smem[1024 + k] = siluf_(p.in(I_CCTX)[k]); }
    __syncthreads();
    float* mod = WSP(float, OFF_MOD);
    float4* red = (float4*)(smem + 2048);
    for (int jb = bid; jb < 256; jb += nb) {
        const int l = jb >> 7, j0 = (jb & 127) * 48, jj = tid % 12, kk = tid / 12;
        float4 a0 = make_float4(0.f, 0.f, 0.f, 0.f), a1 = a0;
        if (kk < 42) {
            const float* w = p.in(I_WMOD) + (size_t)l * 1024 * 6144 + j0 + jj * 4;
            for (int k = kk; k < 1024; k += 42) { const float4 wv = *(const float4*)(w + (size_t)k * 6144); const float s0 = smem[k], s1 = smem[1024 + k];
                a0.x = fmaf(s0, wv.x, a0.x); a0.y = fmaf(s0, wv.y, a0.y); a0.z = fmaf(s0, wv.z, a0.z); a0.w = fmaf(s0, wv.w, a0.w);
                a1.x = fmaf(s1, wv.x, a1.x); a1.y = fmaf(s1, wv.y, a1.y); a1.z = fmaf(s1, wv.z, a1.z); a1.w = fmaf(s1, wv.w, a1.w); }
            red[(kk * 12 + jj) * 2] = a0; red[(kk * 12 + jj) * 2 + 1] = a1;
        }
        __syncthreads();
        if (tid < 24) {
            const int cj = tid >> 1, cond = tid & 1;
            float4 s = make_float4(0.f, 0.f, 0.f, 0.f);
            for (int q = 0; q < 42; ++q) { const float4 v = red[(q * 12 + cj) * 2 + cond]; s.x += v.x; s.y += v.y; s.z += v.z; s.w += v.w; }
            const float4 b = *(const float4*)(p.in(I_BMOD) + l * 6144 + j0 + cj * 4);
            s.x += b.x; s.y += b.y; s.z += b.z; s.w += b.w;
            *(float4*)(mod + (size_t)(l * 2 + cond) * 6144 + j0 + cj * 4) = s;
        }
        __syncthreads();
    }
}

template <bool IDN, class COLF, class KSF>
__device__ __forceinline__ void conv_t_g(const float* W, bf16_t* Wt, int K, int N, int Npad, int nmat, int bid, int nb, float* smem, COLF colf, KSF ksf) {
    const int tidx = opaque_tid();
    const int tid = tidx;
    const int tn = Npad / 64, tk = K / 64;
    const int ntile = tn * tk * nmat;
    for (int t = bid; t < ntile; t += nb) {
        const int mat = t / (tn * tk), r = t % (tn * tk), n0 = (r / tk) * 64, k0 = (r % tk) * 64;
        const float* Wm = W + (size_t)mat * K * N; bf16_t* Wtm = Wt + (size_t)mat * Npad * K;
        __syncthreads();
        {
            const int kk = tid >> 4, c4 = (tid & 15) * 4; const bool ok = (n0 + c4 < N); const int sc = ok ? colf(n0 + c4) : 0;
#pragma unroll
            for (int i = 0; i < 2; ++i) { float4 v = make_float4(0.f, 0.f, 0.f, 0.f); if (ok) v = *(const float4*)(Wm + (size_t)(k0 + kk + 32 * i) * N + sc); const float s = ksf(k0 + kk + 32 * i);
                float* d = smem + (kk + 32 * i) * 65 + c4; d[0] = v.x * s; d[1] = v.y * s; d[2] = v.z * s; d[3] = v.w * s; }
        }
        __syncthreads();
        {   const int nn = tid >> 3, kc = (tid & 7) * 8;
            float e[8];
#pragma unroll
            for (int j = 0; j < 8; ++j) e[j] = smem[(kc + j) * 65 + nn];
            uint4 o; o.x = pack2(e[0], e[1]); o.y = pack2(e[2], e[3]); o.z = pack2(e[4], e[5]); o.w = pack2(e[6], e[7]);
            *(uint4*)(Wtm + (size_t)(n0 + nn) * K + k0 + kc) = o; }
    }
    __syncthreads();
}
__device__ __forceinline__ void conv_t(const float* W, bf16_t* Wt, int K, int N, int Npad, int nmat, int bid, int nb, float* smem) {
    conv_t_g<true>(W, Wt, K, N, Npad, nmat, bid, nb, smem, [](int n) { return n; }, [](int) { return 1.0f; });
}
__device__ __forceinline__ void st_conv(const KP& p, int l, int bid, int nb, float* smem) {
    const int tidx = opaque_tid(); (void)tidx;
    bf16_t* wb = WSP(bf16_t, OFF_WB);
    conv_t_g<false>(p.in(I_WIN) + (size_t)l * 1024 * NIN, (bf16_t*)((char*)wb + WB_IN), 1024, NIN, NINP, 1, bid, nb, smem, [](int n) { return win_col_old(n); }, [](int) { return 1.0f; });
    {   const float* gcq = p.in(I_GCQ) + l * 256; const float* gckv = p.in(I_GCKV) + l * 128;
        conv_t_g<true>(p.in(I_WUQ) + (size_t)l * 256 * 768, (bf16_t*)((char*)wb + WB_UQ), 256, 768, 768, 1, bid, nb, smem, [](int n) { return n; }, [&](int k) { return gcq[k]; });
        conv_t_g<true>(p.in(I_WUKV) + (size_t)l * 128 * 1024, (bf16_t*)((char*)wb + WB_UKV), 128, 1024, 1024, 1, bid, nb, smem, [](int n) { return n; }, [&](int k) { return gckv[k]; }); }
    conv_t(p.in(I_WGLU) + (size_t)l * 512 * 512, (bf16_t*)((char*)wb + WB_GLU), 512, 512, 512, 1, bid, nb, smem);
    conv_t(p.in(I_WBRM) + (size_t)l * 512 * 1024, (bf16_t*)((char*)wb + WB_BR), 512, 1024, 1024, 1, bid, nb, smem);
    conv_t(p.in(I_WBRS) + (size_t)l * 512 * 1024, (bf16_t*)((char*)wb + WB_BR + (size_t)1024 * 512 * 2), 512, 1024, 1024, 1, bid, nb, smem);
    conv_t(p.in(I_WBRG) + (size_t)l * 512 * 1024, (bf16_t*)((char*)wb + WB_BR + (size_t)2 * 1024 * 512 * 2), 512, 1024, 1024, 1, bid, nb, smem);
    conv_t(p.in(I_WOUT) + (size_t)l * 1024 * 1024, (bf16_t*)((char*)wb + WB_OUT), 1024, 1024, 1024, 1, bid, nb, smem);
}
__device__ __forceinline__ void st_conv_experts(const KP& p, int l, int bid, int nb, float* smem) {
    const int tidx = opaque_tid(); (void)tidx;
    bf16_t* wb = WSP(bf16_t, OFF_WB);
    conv_t(p.in(I_WEG) + (size_t)l * 16 * 1024 * 512, (bf16_t*)((char*)wb + WB_EG), 1024, 512, 512, 16, bid, nb, smem);
    conv_t(p.in(I_WEU) + (size_t)l * 16 * 1024 * 512, (bf16_t*)((char*)wb + WB_EU), 1024, 512, 512, 16, bid, nb, smem);
    conv_t(p.in(I_WED) + (size_t)l * 16 * 512 * 1024, (bf16_t*)((char*)wb + WB_ED), 512, 1024, 1024, 16, bid, nb, smem);
}

__device__ __forceinline__ const float* xrow_c(const KP& p, int r) { return (r < LC) ? (WSP(float, OFF_XC) + (size_t)r * D) : (p.out() + (size_t)(r - LC) * D); }
__device__ __forceinline__ const float* xrow_in(const KP& p, int r) { return (r < LC) ? (p.in(I_CTX) + (size_t)r * D) : (p.in(I_X) + (size_t)(r - LC) * D); }
__device__ __forceinline__ float* xrow(const KP& p, int r) { return (r < LC) ? (WSP(float, OFF_XC) + (size_t)r * D) : (p.out() + (size_t)(r - LC) * D); }
__device__ __forceinline__ void st_modulate(const KP& p, int l, int bid, int nb) {
    const int tidx = opaque_tid();
    const int lane = tidx & 63, wid = tidx >> 6;
    bf16_t* Hb = WSP(bf16_t, OFF_H);
    const float* g = p.in(I_GPREMIX) + l * D;
    auto ld = [&](int r, float4 (&v)[4]) __attribute__((always_inline)) {
        const float* xr = l == 0 ? xrow_in(p, r) : xrow_c(p, r);
#pragma unroll
        for (int i = 0; i < 4; ++i) v[i] = *(const float4*)(xr + i * 256 + lane * 4);
    };
    auto proc = [&](int r, float4 (&v)[4]) __attribute__((always_inline)) {
        const float* md = WSP(float, OFF_MOD) + (size_t)(l * 2 + (r < LC ? 1 : 0)) * 6144;
        float ss = 0.f;
#pragma unroll
        for (int i = 0; i < 4; ++i) ss += v[i].x * v[i].x + v[i].y * v[i].y + v[i].z * v[i].z + v[i].w * v[i].w;
        ss = wave_sum(ss);
        const float rstd = rsqrtf(ss * (1.0f / D) + EPS);
#pragma unroll
        for (int i = 0; i < 4; ++i) {
            const int c = i * 256 + lane * 4;
            const float4 gg = *(const float4*)(g + c), sh = *(const float4*)(md + c), sc = *(const float4*)(md + 1024 + c);
            const float h0 = v[i].x * rstd * gg.x * (1.f + sc.x) + sh.x, h1 = v[i].y * rstd * gg.y * (1.f + sc.y) + sh.y;
            const float h2 = v[i].z * rstd * gg.z * (1.f + sc.z) + sh.z, h3 = v[i].w * rstd * gg.w * (1.f + sc.w) + sh.w;
            uint2 o; o.x = pack2(h0, h1); o.y = pack2(h2, h3);
            *(uint2*)(Hb + (size_t)r * D + c) = o;
        }
    };
    {   const int r0 = bid * NWV + wid, rs = nb * NWV;
        float4 va[4], vb[4];
        if (r0 < T) ld(r0, va);
        for (int r = r0; r < T; r += 2 * rs) {
            if (r + rs < T) ld(r + rs, vb);
            proc(r, va);
            if (r + rs < T) { if (r + 2 * rs < T) ld(r + 2 * rs, va); proc(r + rs, vb); }
        } }
}

__device__ __forceinline__ void st_gemm_in(const KP& p, int l, int bid, int nb, char* lds) {
    const int tidx = opaque_tid();
    if (bid == 0 && tidx < 8) WSP(unsigned, OFF_CNT)[32 + tidx] = 0u;
    const bf16_t* Hb = WSP(bf16_t, OFF_H); const bf16_t* Wt = WSP(bf16_t, OFF_WB + WB_IN); bf16_t* P = WSP(bf16_t, OFF_P);
    float* ssq = WSP(float, OFF_SSQ); const float2* t16 = WSP(float2, OFF_ROPE); const float2* t8 = t16 + 256 * 16;
    const float* gqn = p.in(I_GQN) + l * 64; const float* gkn = p.in(I_GKN) + l * 64;
    const int lane = tidx & 63, wid = tidx >> 6, wm = wid >> 1, wn = wid & 1, fr = lane & 15, g = lane >> 4;
    int mt, nt;
    for (int it = 0; dense_tile(it, NINP / 128, true, bid, nb, mt, nt); ++it) {
        acc_t acc; acc_zero(acc);
        gemm_core(acc, [&](int r) { return Hb + (size_t)(mt * 256 + r) * 1024; }, [&](int r) { return Wt + (size_t)(nt * 128 + r) * 1024; }, 1024, lds);
#pragma unroll
        for (int im = 0; im < 4; ++im) {
            const int row = mt * 256 + wm * 64 + 16 * im + fr;
            bf16_t* prow_ = P + (size_t)row * PP + nt * 128 + wn * 64 + 4 * g;
            const bool lat = row >= LC; const int tpos = row - LC, prow = lat ? (tpos >> 6) : 0, pcol = lat ? (tpos & 63) : 0;
            f32x4 v[4];
#pragma unroll
            for (int in = 0; in < 4; ++in) v[in] = acc[in][im];
            if (nt <= 4) {
                float ss = 0.f;
#pragma unroll
                for (int in = 0; in < 4; ++in) ss += (v[in][0] * v[in][0] + v[in][1] * v[in][1]) + (v[in][2] * v[in][2] + v[in][3] * v[in][3]);
                ss += __shfl_xor(ss, 16); ss += __shfl_xor(ss, 32);
                const float sc = rsqrtf(ss * (1.0f / 64.0f) + EPS) * (nt < 4 ? SC_GQA : 1.0f);
                const float* gg = (nt < 4 ? gqn : gkn) + 4 * g;
#pragma unroll
                for (int in = 0; in < 4; ++in) { const float4 g4 = *(const float4*)(gg + 16 * in); v[in][0] *= sc * g4.x; v[in][1] *= sc * g4.y; v[in][2] *= sc * g4.z; v[in][3] *= sc * g4.w; }
                if (lat) {
#pragma unroll
                    for (int hlf = 0; hlf < 2; ++hlf) {
                        const float4* cs = (const float4*)(t16 + (hlf == 0 ? prow : pcol) * 16 + 4 * g);
                        const float4 c01 = cs[0], c23 = cs[1];
                        const f32x4 cc = {c01.x, c01.z, c23.x, c23.z}, sn = {c01.y, c01.w, c23.y, c23.w}, a = v[2 * hlf], b = v[2 * hlf + 1];
                        v[2 * hlf] = a * cc - b * sn; v[2 * hlf + 1] = a * sn + b * cc; }
                }
            } else if (nt >= 6 && nt <= 8) {
                float ss = 0.f;
#pragma unroll
                for (int in = 0; in < 4; ++in) ss += (v[in][0] * v[in][0] + v[in][1] * v[in][1]) + (v[in][2] * v[in][2] + v[in][3] * v[in][3]);
                ss += __shfl_xor(ss, 16); ss += __shfl_xor(ss, 32);
                if (g == 0) ssq[(size_t)row * 8 + (nt - 6) * 2 + wn] = ss;
            } else if (nt == 9 && wn == 0) {
#pragma unroll
                for (int in = 0; in < 2; ++in) {
                    f32x4 o; o[0] = __shfl_xor(v[in][0], 32); o[1] = __shfl_xor(v[in][1], 32); o[2] = __shfl_xor(v[in][2], 32); o[3] = __shfl_xor(v[in][3], 32);
                    if (lat) { const float4* cs = (const float4*)(t8 + (in == 0 ? prow : pcol) * 8 + 4 * (g & 1));
                        const float4 c01 = cs[0], c23 = cs[1];
                        if (g < 2) { v[in][0] = v[in][0] * c01.x - o[0] * c01.y; v[in][1] = v[in][1] * c01.z - o[1] * c01.w; v[in][2] = v[in][2] * c23.x - o[2] * c23.y; v[in][3] = v[in][3] * c23.z - o[3] * c23.w; }
                        else { v[in][0] = o[0] * c01.y + v[in][0] * c01.x; v[in][1] = o[1] * c01.w + v[in][1] * c01.z; v[in][2] = o[2] * c23.y + v[in][2] * c23.x; v[in][3] = o[3] * c23.w + v[in][3] * c23.z; } }
                }
            }
#pragma unroll
            for (int in = 0; in < 4; ++in) {
                const int G = nt * 8 + wn * 4 + in;
                if (G >= 106) {
                    if (G < 298) {
                        uint2 o; o.x = pack2(sigmoidf_(v[in][0]), sigmoidf_(v[in][1])); o.y = pack2(sigmoidf_(v[in][2]), sigmoidf_(v[in][3]));
                        *(uint2*)(WSP(bf16_t, OFF_GS) + (((((size_t)(mt * 192 + (G - 106)) * 4 + wm) * 4 + im) * 64) + lane) * 4) = o; }
                } else if (G >= 74) *(uint2*)(WSP(bf16_t, OFF_SSMG) + ((size_t)(G - 74) * T + row) * 16 + 4 * g) = pack4(v[in]);
                else *(uint2*)(prow_ + 16 * in) = pack4(v[in]);
            }
        }
    }
}

__device__ __forceinline__ void rope_pair(float& a, float& b, int pos, int i, int half) {
    const float freq = powf(10000.0f, -(float)i / (float)half);
    const float ang = (float)pos * freq;
    float sn, cs; sincosf(ang, &sn, &cs);
    const float na = a * cs - b * sn, nb_ = a * sn + b * cs; a = na; b = nb_;
}

constexpr int S5C = 64, NCH = T / S5C;
constexpr size_t S5_ZERO = OFF_WB + WB_EG;
constexpr size_t S5_KTAB = S5_ZERO + 256;
constexpr size_t S5_FTAB = S5_KTAB + (size_t)64 * 64 * 256 * 2;
constexpr size_t S5_GTAB = S5_FTAB + (size_t)64 * 128 * 1024 * 2;
constexpr size_t S5_SINB = S5_GTAB + (size_t)64 * 1024 * 128 * 2;
static_assert(S5_SINB + (size_t)NCH * 64 * 128 * 2 <= OFF_WB + WB_BYTES, "s5 tables overlay");
__device__ __forceinline__ int s5_row(int dir, int j) { return dir == 0 ? j : (j < LC ? LC - 1 - j : T + LC - 1 - j); }
__device__ __forceinline__ void s5_consts(const KP& p, int l, int dir, int g, int lane, float& lr, float& li, float (&bbr)[16], float (&bbi)[16]) {
    const int gi = (l * 2 + dir) * 32 + g, pi = gi * 64 + lane;
    const float are = p.in(I_ARE)[pi], aim = p.in(I_AIM)[pi], dt = expf(p.in(I_LOGDT)[gi]);
    const float mag = expf(are * dt); float sn, cs; sincosf(aim * dt, &sn, &cs);
    lr = mag * cs; li = mag * sn; const float den = are * are + aim * aim;
    const float cr = ((lr - 1.0f) * are + li * aim) / den, ci = (li * are - (lr - 1.0f) * aim) / den;
    const float4* br4 = (const float4*)(p.in(I_BRE) + (size_t)pi * 16); const float4* bi4 = (const float4*)(p.in(I_BIM) + (size_t)pi * 16);
#pragma unroll
    for (int q = 0; q < 4; ++q) { const float4 br = br4[q], bi = bi4[q];
        bbr[4 * q] = cr * br.x - ci * bi.x; bbi[4 * q] = cr * bi.x + ci * br.x; bbr[4 * q + 1] = cr * br.y - ci * bi.y; bbi[4 * q + 1] = cr * bi.y + ci * br.y;
        bbr[4 * q + 2] = cr * br.z - ci * bi.z; bbi[4 * q + 2] = cr * bi.z + ci * br.z; bbr[4 * q + 3] = cr * br.w - ci * bi.w; bbi[4 * q + 3] = cr * bi.w + ci * br.w; }
}
__device__ __forceinline__ void s5_unpack(uint4 a, uint4 b, float (&u)[16]) {
    u[0] = bflo(a.x); u[1] = bfhi(a.x); u[2] = bflo(a.y); u[3] = bfhi(a.y); u[4] = bflo(a.z); u[5] = bfhi(a.z); u[6] = bflo(a.w); u[7] = bfhi(a.w);
    u[8] = bflo(b.x); u[9] = bfhi(b.x); u[10] = bflo(b.y); u[11] = bfhi(b.y); u[12] = bflo(b.z); u[13] = bfhi(b.z); u[14] = bflo(b.w); u[15] = bfhi(b.w);
}
__device__ __forceinline__ void st_s5_local(const KP& p, int l, int bid, int nb) {
    const int tidx = opaque_tid();
    const int lane = tidx & 63, wid = tidx >> 6;
    const bf16_t* P = WSP(bf16_t, OFF_P); float2* F = WSP(float2, OFF_S5);
    const int gw = bid * NWV + wid, nw = nb * NWV;
    if (gw >= (nw / 64) * 64) return;
    const int gd = gw & 63, dir = gd >> 5, g = gd & 31, part = gw >> 6, nparts = nw >> 6;
    if (part >= 4) return;
    float lr, li, bbr[16], bbi[16]; s5_consts(p, l, dir, g, lane, lr, li, bbr, bbi);
    for (int c = part; c < 4; c += nparts) {
        float sr = 0.f, si = 0.f;
        for (int j0 = 0; j0 < S5C; j0 += 8) {
            uint4 ua[8], ub[8];
#pragma unroll
            for (int q = 0; q < 8; ++q) { const int r = s5_row(dir, c * S5C + j0 + q); const uint4* up = (const uint4*)SSMU(g, r); ua[q] = up[0]; ub[q] = up[1]; }
#pragma unroll
            for (int q = 0; q < 8; ++q) { float u[16]; s5_unpack(ua[q], ub[q], u);
                float bur = 0.f, bui = 0.f;
#pragma unroll
                for (int cc = 0; cc < 16; ++cc) { bur = fmaf(bbr[cc], u[cc], bur); bui = fmaf(bbi[cc], u[cc], bui); }
                const float nsr = lr * sr - li * si + bur, nsi = lr * si + li * sr + bui; sr = nsr; si = nsi; }
        }
        F[((size_t)(c * 2 + dir) * 32 + g) * 64 + lane] = make_float2(sr, si);
    }
}
__device__ __forceinline__ void st_s5_carry(const KP& p, int l, int bid, int nb, char* lds) {
    const int tidx = opaque_tid();
    float2* F = WSP(float2, OFF_S5); bf16_t* SB = WSP(bf16_t, S5_SINB);
    float4* comp = (float4*)lds;
    constexpr int RUN = 9;
    for (int cb = bid; cb < 256; cb += nb) {
        const int chl = tidx & 15, seg = tidx >> 4, idx = cb * 16 + chl;
        const int gi = l * 64 + (idx >> 6);
        const float are = p.in(I_ARE)[gi * 64 + (idx & 63)], aim = p.in(I_AIM)[gi * 64 + (idx & 63)], dt = expf(p.in(I_LOGDT)[gi]);
        const float mag = expf(are * dt); float sn, cs; sincosf(aim * dt, &sn, &cs);
        float pr = mag * cs, pi_ = mag * sn;
#pragma unroll
        for (int q = 0; q < 6; ++q) { const float nr = pr * pr - pi_ * pi_, ni = 2.f * pr * pi_; pr = nr; pi_ = ni; }
        const int c0 = seg * RUN;
        float2 f[RUN]; float ar = 1.f, ai = 0.f, br = 0.f, bi = 0.f;
#pragma unroll
        for (int q = 0; q < RUN; ++q) { const int c = c0 + q; f[q] = (c < NCH) ? F[(size_t)c * 4096 + idx] : make_float2(0.f, 0.f);
            if (c < NCH) { const float nbr = pr * br - pi_ * bi + f[q].x, nbi = pr * bi + pi_ * br + f[q].y; br = nbr; bi = nbi;
                           const float nar = pr * ar - pi_ * ai, nai = pr * ai + pi_ * ar; ar = nar; ai = nai; } }
        __syncthreads();
        comp[chl * 32 + seg] = make_float4(ar, ai, br, bi);
        __syncthreads();
        float sr = 0.f, si = 0.f;
        for (int j = 0; j < seg; ++j) { const float4 cj = comp[chl * 32 + j]; const float nr = cj.x * sr - cj.y * si + cj.z, ni = cj.x * si + cj.y * sr + cj.w; sr = nr; si = ni; }
#pragma unroll
        for (int q = 0; q < RUN; ++q) { const int c = c0 + q;
            if (c < NCH) { F[(size_t)c * 4096 + idx] = make_float2(sr, si);
                bf16_t* sb = SB + ((size_t)c * 64 + (idx >> 6)) * 128 + (idx & 63); sb[0] = f2bf(sr); sb[64] = f2bf(si);
                const float nr = pr * sr - pi_ * si + f[q].x, ni = pr * si + pi_ * sr + f[q].y; sr = nr; si = ni; } }
    }
    __syncthreads();
}
__device__ __forceinline__ void st_s5_scan(const KP& p, int l, int bid, int nb) {
    const int tidx = opaque_tid();
    const int lane = tidx & 63, wid = tidx >> 6;
    const bf16_t* P = WSP(bf16_t, OFF_P); const float2* F = WSP(float2, OFF_S5);
    const int gw = bid * NWV + wid, nw = nb * NWV;
    if (gw >= (nw / 64) * 64) return;
    const int gd = gw & 63, dir = gd >> 5, g = gd & 31, part = gw >> 6, nparts = nw >> 6;
    if (part >= 4) return;
    float* Yo = dir == 0 ? WSP(float, OFF_OM) : WSP(float, OFF_H);
    float lr, li, bbr[16], bbi[16]; s5_consts(p, l, dir, g, lane, lr, li, bbr, bbi);
    const int gi = (l * 2 + dir) * 32 + g;
    float cre[16], cim[16];
#pragma unroll
    for (int cc = 0; cc < 16; ++cc) { cre[cc] = p.in(I_CRE)[((size_t)gi * 16 + cc) * 64 + lane]; cim[cc] = p.in(I_CIM)[((size_t)gi * 16 + cc) * 64 + lane]; }
    const float dsk = p.in(I_SSMD)[l * 512 + g * 16 + (lane & 15)];
    for (int c = part; c < 4; c += nparts) {
        const float2 s0 = F[((size_t)(c * 2 + dir) * 32 + g) * 64 + lane];
        float sr = s0.x, si = s0.y;
        for (int j0 = 0; j0 < S5C; j0 += 8) {
            uint4 ua[8], ub[8];
#pragma unroll
            for (int q = 0; q < 8; ++q) { const int r = s5_row(dir, c * S5C + j0 + q); const uint4* up = (const uint4*)SSMU(g, r); ua[q] = up[0]; ub[q] = up[1]; }
#pragma unroll
            for (int q = 0; q < 8; ++q) { const int r = s5_row(dir, c * S5C + j0 + q);
                float u[16]; s5_unpack(ua[q], ub[q], u);
                float bur = 0.f, bui = 0.f;
#pragma unroll
                for (int cc = 0; cc < 16; ++cc) { bur = fmaf(bbr[cc], u[cc], bur); bui = fmaf(bbi[cc], u[cc], bui); }
                const float nsr = lr * sr - li * si + bur, nsi = lr * si + li * sr + bui; sr = nsr; si = nsi;
                float t16[16];
#pragma unroll
                for (int cc = 0; cc < 16; ++cc) t16[cc] = cre[cc] * sr - cim[cc] * si;
                float y = transpose_reduce16(t16, lane);
                if (lane < 16) {
                    if (dir == 0) y += dsk * bf2f(SSMU(g, r)[lane]);
                    Yo[(size_t)r * 512 + g * 16 + lane] = y; }
            }
        }
    }
}

__device__ __forceinline__ void st_s5_tables(const KP& p, int l, int bid, int nb, char* lds) {
    const int tidx = opaque_tid();
    float* pwr = (float*)lds; float* pwi = pwr + 65 * 64; float* bbr = pwi + 65 * 64; float* bbi = bbr + 1024; float* cre = bbi + 1024; float* cim = cre + 1024;
    bf16_t* Ktab = WSP(bf16_t, S5_KTAB); bf16_t* Ftab = WSP(bf16_t, S5_FTAB); bf16_t* Gtab = WSP(bf16_t, S5_GTAB);
    if (bid == 0 && tidx < 64) WSP(unsigned, S5_ZERO)[tidx] = 0u;
    for (int item = bid; item < 256; item += nb) {
        const int gd = item >> 2, q = item & 3, dir = gd >> 5, g = gd & 31, gi = (l * 2 + dir) * 32 + g;
        __syncthreads();
        if (tidx < 64) {
            const int pp = tidx, pi = gi * 64 + pp;
            const float are = p.in(I_ARE)[pi], aim = p.in(I_AIM)[pi], dt = expf(p.in(I_LOGDT)[gi]);
            const float mag = expf(are * dt); float sn, cs; sincosf(aim * dt, &sn, &cs);
            const float lr = mag * cs, li = mag * sn, den = are * are + aim * aim;
            const float cr = ((lr - 1.0f) * are + li * aim) / den, ci = (li * are - (lr - 1.0f) * aim) / den;
            for (int c = 0; c < 16; ++c) { const float br = p.in(I_BRE)[(size_t)pi * 16 + c], bi = p.in(I_BIM)[(size_t)pi * 16 + c];
                bbr[pp * 16 + c] = cr * br - ci * bi; bbi[pp * 16 + c] = cr * bi + ci * br; }
            float ar = 1.f, ai = 0.f;
            for (int n = 0; n <= 64; ++n) { pwr[n * 64 + pp] = ar; pwi[n * 64 + pp] = ai; const float nr = ar * lr - ai * li, ni = ar * li + ai * lr; ar = nr; ai = ni; }
        } else {
            for (int i = tidx - 64; i < 1024; i += NTH - 64) { cre[i] = p.in(I_CRE)[(size_t)gi * 1024 + i]; cim[i] = p.in(I_CIM)[(size_t)gi * 1024 + i]; }
        }
        __syncthreads();
        for (int e = 0; e < 8; ++e) {
            const int idx = tidx + NTH * e, tau = 16 * q + (idx >> 8), c = (idx >> 4) & 15, c2 = idx & 15;
            float s = 0.f;
            for (int pp = 0; pp < 64; ++pp) {
                const float xr = cre[c * 64 + pp], xi = cim[c * 64 + pp], wr = pwr[tau * 64 + pp], wi = pwi[tau * 64 + pp];
                const float zr = xr * wr - xi * wi, zi = xr * wi + xi * wr;
                s += zr * bbr[pp * 16 + c2] - zi * bbi[pp * 16 + c2];
            }
            Ktab[(((size_t)gd * 64 + tau) * 16 + c) * 16 + c2] = f2bf(s);
        }
        for (int e = 0; e < 32; ++e) {
            const int idx2 = tidx + NTH * e, n = 32 * q + (idx2 >> 9), k = (idx2 & 511) * 2, pp = n & 63, comp = n >> 6, i = k >> 4, c2 = k & 15;
            const float wr = pwr[(63 - i) * 64 + pp], wi = pwi[(63 - i) * 64 + pp];
            const float b0r = bbr[pp * 16 + c2], b0i = bbi[pp * 16 + c2], b1r = bbr[pp * 16 + c2 + 1], b1i = bbi[pp * 16 + c2 + 1];
            const float v0 = comp ? (wr * b0i + wi * b0r) : (wr * b0r - wi * b0i), v1 = comp ? (wr * b1i + wi * b1r) : (wr * b1r - wi * b1i);
            *(unsigned*)(Ftab + ((size_t)gd * 128 + n) * 1024 + k) = pack2(v0, v1);
        }
        for (int e = 0; e < 32; ++e) {
            const int idx2 = tidx + NTH * e, row = 256 * q + (idx2 >> 6), n = (idx2 & 63) * 2, t = row >> 4, c = row & 15, comp = n >> 6, pp = n & 63;
            float v[2];
#pragma unroll
            for (int h = 0; h < 2; ++h) { const float xr = cre[c * 64 + pp + h], xi = cim[c * 64 + pp + h], wr = pwr[(t + 1) * 64 + pp + h], wi = pwi[(t + 1) * 64 + pp + h];
                v[h] = comp ? -(xr * wi + xi * wr) : (xr * wr - xi * wi); }
            *(unsigned*)(Gtab + ((size_t)gd * 1024 + row) * 128 + n) = pack2(v[0], v[1]);
        }
    }
    __syncthreads();
}
__device__ __forceinline__ void st_s5_fgemm(const KP& p, int bid, int nb, char* lds) {
    const int tidx = opaque_tid();
    const bf16_t* P = WSP(bf16_t, OFF_P); const bf16_t* Ftab = WSP(bf16_t, S5_FTAB); float* F = WSP(float, OFF_S5);
    const int srow = tidx >> 3, gch = (tidx & 7) ^ ((srow >> 1) & 7);
    for (int gd = bid; gd < 64; gd += nb) {
        const int dir = gd >> 5, g = gd & 31;
        acc_t acc; acc_zero(acc);
        gemm_core_g(acc,
            [&](int i, int kt) { const int m = srow + 64 * i, tok = kt * 4 + (gch >> 1); return SSMU(g, s5_row(dir, 64 * (4 + m) + tok)) + 8 * (gch & 1); },
            [&](int i, int kt) { return Ftab + ((size_t)gd * 128 + srow + 64 * i) * 1024 + kt * 64 + gch * 8; }, 16, lds);
        acc_visit(acc, [&](int ml, int nl, f32x4 v) {
            float* dst = F + (((size_t)(4 + ml) * 2 + dir) * 32 + g) * 128 + (nl & 63) * 2 + (nl >> 6);
            dst[0] = v[0]; dst[2] = v[1]; dst[4] = v[2]; dst[6] = v[3]; });
    }
}
__device__ __forceinline__ void st_s5_ygemm(const KP& p, int l, int bid, int nb, char* lds) {
    const int tidx = opaque_tid();
    const bf16_t* P = WSP(bf16_t, OFF_P); const bf16_t* Ktab = WSP(bf16_t, S5_KTAB); const bf16_t* Gtab = WSP(bf16_t, S5_GTAB);
    const bf16_t* Sinb = WSP(bf16_t, S5_SINB); const bf16_t* Zero = WSP(bf16_t, S5_ZERO); bf16_t* Y1 = WSP(bf16_t, OFF_OS);
    const int srow = tidx >> 3, gch = (tidx & 7) ^ ((srow >> 1) & 7);
    for (int u = bid; u < 256; u += nb) {
        const int g = u >> 3, nt = u & 7;
        acc_t acc; acc_zero(acc);
        {   const int gd = g, nkt = 2 * (nt + 1);
            gemm_core_g(acc,
                [&](int i, int kt) { const int m = srow + 64 * i;
                    if (kt < nkt) { const int tok = kt * 4 + (gch >> 1); return SSMU(g, 64 * (4 + m) + tok) + 8 * (gch & 1); }
                    return Sinb + ((size_t)(4 + m) * 64 + gd) * 128 + (kt - nkt) * 64 + gch * 8; },
                [&](int i, int kt) { const int n = nt * 128 + srow + 64 * i, t = n >> 4, c = n & 15;
                    if (kt < nkt) { const int tau = t - (kt * 4 + (gch >> 1)); return tau >= 0 ? Ktab + (((size_t)gd * 64 + tau) * 16 + c) * 16 + 8 * (gch & 1) : Zero; }
                    return Gtab + ((size_t)gd * 1024 + n) * 128 + (kt - nkt) * 64 + gch * 8; }, nkt + 2, lds); }
        {   const int gd = 32 + g, nkt = 2 * (8 - nt);
            gemm_core_g(acc,
                [&](int i, int kt) { const int m = srow + 64 * i, cx = 259 - m;
                    if (kt < nkt) { const int tok = kt * 4 + (gch >> 1); return SSMU(g, T + LC - 1 - (64 * cx + tok)) + 8 * (gch & 1); }
                    return Sinb + ((size_t)cx * 64 + gd) * 128 + (kt - nkt) * 64 + gch * 8; },
                [&](int i, int kt) { const int n = nt * 128 + srow + 64 * i, t = 63 - (n >> 4), c = n & 15;
                    if (kt < nkt) { const int tau = t - (kt * 4 + (gch >> 1)); return tau >= 0 ? Ktab + (((size_t)gd * 64 + tau) * 16 + c) * 16 + 8 * (gch & 1) : Zero; }
                    return Gtab + ((size_t)gd * 1024 + t * 16 + c) * 128 + (kt - nkt) * 64 + gch * 8; }, nkt + 2, lds); }
        acc_visit(acc, [&](int ml, int nl, f32x4 v) {
            const int n = nt * 128 + nl, t = n >> 4, c0 = n & 15, r = 64 * (4 + ml) + t;
            const float4 dsk = *(const float4*)(p.in(I_SSMD) + l * 512 + g * 16 + c0); const uint2 ur = *(const uint2*)(SSMU(g, r) + c0);
            uint2 o; o.x = pack2(gelu_tanh(v[0] + dsk.x * bflo(ur.x)), gelu_tanh(v[1] + dsk.y * bfhi(ur.x))); o.y = pack2(gelu_tanh(v[2] + dsk.z * bflo(ur.y)), gelu_tanh(v[3] + dsk.w * bfhi(ur.y)));
            *(uint2*)(Y1 + (size_t)r * 512 + g * 16 + c0) = o; });
    }
}
__device__ __forceinline__ void st_s5_ctx_y(const KP& p, int l, int bid, int nb) {
    const int tidx = opaque_tid();
    const bf16_t* P = WSP(bf16_t, OFF_P); const bf16_t* Ktab = WSP(bf16_t, S5_KTAB); const bf16_t* Gtab = WSP(bf16_t, S5_GTAB);
    const float* SIN = WSP(float, OFF_S5); bf16_t* Y1 = WSP(bf16_t, OFF_OS);
    for (int idx = bid * NTH + tidx; idx < 32 * 256 * 16; idx += nb * NTH) {
        const int ch = idx & 15, r = (idx >> 4) & 255, g = idx >> 12;
        float y = p.in(I_SSMD)[l * 512 + g * 16 + ch] * bf2f(SSMU(g, r)[ch]);
#pragma unroll 1
        for (int dir = 0; dir < 2; ++dir) {
            const int gd = dir * 32 + g, j = dir == 0 ? r : (LC - 1 - r), cx = j >> 6, t = j & 63;
            const bf16_t* kt_ = Ktab + ((size_t)gd * 64 * 16 + ch) * 16;
            float a = 0.f;
            for (int i = 0; i <= t; ++i) {
                const int jr = 64 * cx + i, rr = dir == 0 ? jr : (LC - 1 - jr);
                const uint4* up = (const uint4*)SSMU(g, rr); const uint4* kp = (const uint4*)(kt_ + (size_t)(t - i) * 256);
                a = dot8(up[0], kp[0], a); a = dot8(up[1], kp[1], a);
            }
            const bf16_t* gp = Gtab + ((size_t)gd * 1024 + t * 16 + ch) * 128; const float* sp = SIN + (((size_t)cx * 2 + dir) * 32 + g) * 128;
            for (int q = 0; q < 64; q += 2) { const unsigned gre = *(const unsigned*)(gp + q), gim = *(const unsigned*)(gp + 64 + q); const float4 s4 = *(const float4*)(sp + 2 * q);
                a = fmaf(bflo(gre), s4.x, a); a = fmaf(bflo(gim), s4.y, a); a = fmaf(bfhi(gre), s4.z, a); a = fmaf(bfhi(gim), s4.w, a); }
            y += a;
        }
        Y1[(size_t)r * 512 + g * 16 + ch] = f2bf(gelu_tanh(y));
    }
}
__device__ __forceinline__ void st_s5_fin(const KP& p, int bid, int nb) {
    const int tidx = opaque_tid();
    const float* Yf = WSP(float, OFF_OM); const float* Yb = WSP(float, OFF_H); bf16_t* P = WSP(bf16_t, OFF_P);
    for (long idx = (long)bid * NTH + tidx; idx < (long)T * 512; idx += (long)nb * NTH) {
        const int r = (int)(idx >> 9), c = (int)(idx & 511);
        P[(size_t)r * PP + C_SSM + c] = f2bf(gelu_tanh(Yf[idx] + Yb[idx]));
    }
}

template <int SET>
__device__ __forceinline__ void st_proj2(const KP& p, int l, int bid, int nb, char* lds) {
    const int tidx = opaque_tid();
    bf16_t* P = WSP(bf16_t, OFF_P);
    const bf16_t* Wuq = WSP(bf16_t, OFF_WB + WB_UQ); bf16_t* Qm = WSP(bf16_t, OFF_H);
    const bf16_t* Wukv = WSP(bf16_t, OFF_WB + WB_UKV); bf16_t* Kn = WSP(bf16_t, OFF_KN); bf16_t* Vm = WSP(bf16_t, OFF_V);
    const bf16_t* Wglu = WSP(bf16_t, OFF_WB + WB_GLU); bf16_t* Os = WSP(bf16_t, OFF_OS); const float* bg = p.in(I_BGLU) + l * 512;
    int mt, ntv;
    for (int it = 0; dense_tile(it, SET == 0 ? 14 : 4, SET == 0 || l + 1 < NL, bid, nb, mt, ntv); ++it) {
        if (SET == 1) ntv += 14;
        const int which = ntv < 6 ? 0 : (ntv < 14 ? 1 : 2), nt = ntv - (which == 0 ? 0 : (which == 1 ? 6 : 14));
        const int K = which == 0 ? 256 : (which == 1 ? 128 : 512);
        const bf16_t* abase = which == 2 ? (const bf16_t*)Os + (size_t)mt * 256 * 512 : P + (size_t)mt * 256 * PP + (which == 0 ? C_CQ : C_CKV);
        const int apitch = which == 2 ? 512 : PP;
        const bf16_t* wbase = (which == 0 ? Wuq : (which == 1 ? Wukv : Wglu)) + (size_t)nt * 128 * K;
        acc_t acc; acc_zero(acc);
        gemm_core(acc, [&](int r) { return abase + (size_t)r * apitch; }, [&](int r) { return wbase + (size_t)r * K; }, K, lds);
        if (which == 0) {
            const float* ssq = WSP(float, OFF_SSQ); const float2* t8 = WSP(float2, OFF_ROPE) + 256 * 16;
            const int lane_ = tidx & 63, wid_ = tidx >> 6, wm_ = wid_ >> 1, wn_ = wid_ & 1, fr_ = lane_ & 15, g_ = lane_ >> 4;
#pragma unroll
            for (int im = 0; im < 4; ++im) {
                const int row = mt * 256 + wm_ * 64 + 16 * im + fr_;
                const float4 s4 = *(const float4*)(ssq + (size_t)row * 8);
                const float sc = rsqrtf(((s4.x + s4.y) + (s4.z + s4.w)) * (1.0f / 256.0f) + EPS) * SC_MLA;
                const bool lat = row >= LC; const int tpos = row - LC, prow = lat ? (tpos >> 6) : 0, pcol = lat ? (tpos & 63) : 0;
#pragma unroll
                for (int in = 0; in < 4; ++in) {
                    f32x4 v = acc[in][im] * sc;
                    if (((nt * 4 + wn_ * 2 + (in >> 1)) % 3) == 2) {
                        f32x4 o; o[0] = __shfl_xor(v[0], 32); o[1] = __shfl_xor(v[1], 32); o[2] = __shfl_xor(v[2], 32); o[3] = __shfl_xor(v[3], 32);
                        if (lat) { const float4* cs = (const float4*)(t8 + ((in & 1) == 0 ? prow : pcol) * 8 + 4 * (g_ & 1));
                            const float4 c01 = cs[0], c23 = cs[1];
                            if (g_ < 2) { v[0] = v[0] * c01.x - o[0] * c01.y; v[1] = v[1] * c01.z - o[1] * c01.w; v[2] = v[2] * c23.x - o[2] * c23.y; v[3] = v[3] * c23.z - o[3] * c23.w; }
                            else { v[0] = o[0] * c01.y + v[0] * c01.x; v[1] = o[1] * c01.w + v[1] * c01.z; v[2] = o[2] * c23.y + v[2] * c23.x; v[3] = o[3] * c23.w + v[3] * c23.z; } }
                    }
                    *(uint2*)(Qm + (size_t)row * 768 + nt * 128 + wn_ * 64 + 16 * in + 4 * g_) = pack4(v);
                }
            }
        } else if (which == 1) {
            const float* ssq = WSP(float, OFF_SSQ);
            acc_visit(acc, [&](int ml, int nl, f32x4 v) {
                const float2 s2 = *(const float2*)(ssq + (size_t)(mt * 256 + ml) * 8 + 4);
                const float sc = rsqrtf((s2.x + s2.y) * (1.0f / 128.0f) + EPS);
                bf16_t* dst = (nl < 64) ? (Kn + (size_t)(mt * 256 + ml) * 512 + nt * 64 + nl) : (Vm + (size_t)(mt * 256 + ml) * 512 + nt * 64 + nl - 64);
                *(uint2*)dst = pack4(v * sc); });
        } else {
            acc_visit(acc, [&](int ml, int nl, f32x4 v) {
                const int n = nt * 128 + nl;
                const uint2 yr = *(const uint2*)(Os + (size_t)(mt * 256 + ml) * 512 + n); const float4 b4 = *(const float4*)(bg + n);
                uint2 o; o.x = pack2(bflo(yr.x) * sigmoidf_(v[0] + b4.x), bfhi(yr.x) * sigmoidf_(v[1] + b4.y));
                o.y = pack2(bflo(yr.y) * sigmoidf_(v[2] + b4.z), bfhi(yr.y) * sigmoidf_(v[3] + b4.w));
                *(uint2*)(P + (size_t)(mt * 256 + ml) * PP + C_SSM + n) = o; });
        }
    }
}
__device__ __forceinline__ void st_ropeq(const KP& p, int bid, int nb, char* lds) {
    const int tidx = opaque_tid();
    {   const int lane = tidx & 63, wid = tidx >> 6;
        const bf16_t* Kn = WSP(bf16_t, OFF_KN); const bf16_t* P = WSP(bf16_t, OFF_P);
        float runmax = 0.f;
        for (int r = bid * NWV + wid; r < T; r += nb * NWV) {
            const uint4 kv = *(const uint4*)(Kn + (size_t)r * 512 + lane * 8);
            float s = bflo(kv.x) * bflo(kv.x) + bfhi(kv.x) * bfhi(kv.x) + bflo(kv.y) * bflo(kv.y) + bfhi(kv.y) * bfhi(kv.y)
                    + bflo(kv.z) * bflo(kv.z) + bfhi(kv.z) * bfhi(kv.z) + bflo(kv.w) * bflo(kv.w) + bfhi(kv.w) * bfhi(kv.w);
            s += __shfl_xor(s, 1); s += __shfl_xor(s, 2); s += __shfl_xor(s, 4);
            float sr = 0.f;
            if (lane < 4) { const uint4 rv = *(const uint4*)(P + (size_t)r * PP + C_KR + lane * 8);
                sr = bflo(rv.x) * bflo(rv.x) + bfhi(rv.x) * bfhi(rv.x) + bflo(rv.y) * bflo(rv.y) + bfhi(rv.y) * bfhi(rv.y)
                   + bflo(rv.z) * bflo(rv.z) + bfhi(rv.z) * bfhi(rv.z) + bflo(rv.w) * bflo(rv.w) + bfhi(rv.w) * bfhi(rv.w); }
            sr += __shfl_xor(sr, 1); sr += __shfl_xor(sr, 2);
            sr = __shfl(sr, 0);
            runmax = fmaxf(runmax, s + sr);
        }
        unsigned* lmax = (unsigned*)lds;
        __syncthreads();
        if (tidx < 8) lmax[tidx] = 0u;
        __syncthreads();
        if ((lane & 7) == 0) atomicMax(&lmax[lane >> 3], __float_as_uint(runmax));
        __syncthreads();
        if (tidx < 8) atomicMax(WSP(unsigned, OFF_CNT) + 32 + tidx, lmax[tidx]);
    }
}

typedef short s16x4 __attribute__((ext_vector_type(4)));
typedef short v4i16_t __attribute__((ext_vector_type(4)));
typedef __attribute__((address_space(3))) const char* lds_cptr;
__device__ __forceinline__ s16x4 vtr(lds_cptr q) { return __builtin_bit_cast(s16x4, __builtin_amdgcn_ds_read_tr16_b64_v4i16((__attribute__((address_space(3))) v4i16_t*)q)); }
__device__ __forceinline__ unsigned cvtpk(float lo, float hi) { return pack2(lo, hi); }
constexpr int AT_K = 0, AT_V = 8192, AT_KR = 16384, AT_BUF = 20480;

template <int DQK, int VAR = 0>
__device__ __forceinline__ void attn_item(const bf16_t* Q, int qpitch, const bf16_t* KA, int kapitch, const bf16_t* KB, int kbpitch,
                                          const bf16_t* V, int vpitch, int ntiles, float C, bf16_t* O, char* lds) {
    const int tid = opaque_tid(), lane = tid & 63, wid = tid >> 6, r32 = lane & 31, hi = lane >> 5;
    constexpr int ND0 = DQK / 16;
    bf16x8 qr[ND0];
    { const bf16_t* qp = Q + (size_t)(wid * 32 + r32) * qpitch + hi * 8;
#pragma unroll
      for (int d0 = 0; d0 < ND0; ++d0) qr[d0] = *(const bf16x8*)(qp + d0 * 16); }
    const int srow = tid >> 3, sch = tid & 7;
    const bf16_t* gk = KA + (size_t)srow * kapitch + sch * 8;
    const bf16_t* gv = V + (size_t)srow * vpitch + sch * 8;
    const bf16_t* gr = (DQK > 64) ? (KB + (size_t)(tid >> 2) * kbpitch + (tid & 3) * 8) : nullptr;
    const int sk_off = AT_K + srow * 128 + ((sch ^ ((srow >> 1) & 7)) << 4);
    const int sv_off = AT_V + (sch >> 2) * 4096 + srow * 64 + (sch & 3) * 16;
    const int sr_off = AT_KR + (tid >> 2) * 64 + (((tid & 3) ^ (((tid >> 2) >> 2) & 3)) << 4);
    const bool do_r = (DQK > 64) && (tid < 256);
    const int kf_off = AT_K + r32 * 128, ksw = (r32 >> 1) & 7;
    const int rf_off = AT_KR + r32 * 64, rsw = (r32 >> 2) & 3;
    const int vf_off = AT_V + (4 * hi + ((lane & 15) >> 2)) * 64 + ((lane >> 4) & 1) * 32 + (lane & 3) * 8;
    uint4 rk, rv, rr; rr = make_uint4(0, 0, 0, 0);
    rk = *(const uint4*)gk; rv = *(const uint4*)gv; if (do_r) rr = *(const uint4*)gr;
    *(uint4*)(lds + sk_off) = rk; *(uint4*)(lds + sv_off) = rv; if (do_r) *(uint4*)(lds + sr_off) = rr;
    __syncthreads();
    f32x16 o0, o1;
#pragma unroll
    for (int r = 0; r < 16; ++r) { o0[r] = 0.f; o1[r] = 0.f; }
    float mrun = -INFINITY, lrun = 0.f;
    for (int t = 0; t < ntiles; ++t) {
        const char* cur = lds + (VAR == 2 ? 0 : (t & 1)) * AT_BUF; char* nxt = lds + ((t + 1) & 1) * AT_BUF;
        const bool more = (t + 1 < ntiles);
        if (more && VAR != 2) { rk = *(const uint4*)(gk + (size_t)(t + 1) * 64 * kapitch); rv = *(const uint4*)(gv + (size_t)(t + 1) * 64 * vpitch); if (do_r) rr = *(const uint4*)(gr + (size_t)(t + 1) * 64 * kbpitch); }
        f32x16 p0, p1;
#pragma unroll
        for (int r = 0; r < 16; ++r) { p0[r] = 0.f; p1[r] = 0.f; }
#pragma unroll
        for (int d0 = 0; d0 < 4; ++d0) {
            const int co = ((2 * d0 + hi) ^ ksw) << 4;
            const bf16x8 k0 = *(const bf16x8*)(cur + kf_off + co), k1 = *(const bf16x8*)(cur + kf_off + 32 * 128 + co);
            p0 = MFMA32(k0, qr[d0], p0); p1 = MFMA32(k1, qr[d0], p1);
        }
        if (DQK > 64) {
#pragma unroll
            for (int d0 = 4; d0 < ND0; ++d0) {
                const int co = ((2 * (d0 - 4) + hi) ^ rsw) << 4;
                const bf16x8 k0 = *(const bf16x8*)(cur + rf_off + co), k1 = *(const bf16x8*)(cur + rf_off + 32 * 64 + co);
                p0 = MFMA32(k0, qr[d0], p0); p1 = MFMA32(k1, qr[d0], p1);
            }
        }
        if (VAR != 1) {
        float mx = fmaxf(p0[0], p1[0]);
#pragma unroll
        for (int r = 1; r < 16; ++r) mx = fmaxf(mx, fmaxf(p0[r], p1[r]));
        mx = xhalf_max(mx) * C;
        const float mnew = fmaxf(mrun, mx);
        if (__any(mnew > mrun)) {
            const float alpha = __builtin_amdgcn_exp2f(mrun - mnew);
            lrun *= alpha;
#pragma unroll
            for (int r = 0; r < 16; ++r) { o0[r] *= alpha; o1[r] *= alpha; }
            mrun = mnew;
        }
        const float nm = -mrun;
        float ls = 0.f;
#pragma unroll
        for (int r = 0; r < 16; ++r) { p0[r] = __builtin_amdgcn_exp2f(fmaf(p0[r], C, nm)); p1[r] = __builtin_amdgcn_exp2f(fmaf(p1[r], C, nm)); ls += p0[r] + p1[r]; }
        lrun += ls;
        }
#pragma unroll
        for (int s = 0; s < 4; ++s) {
            bf16x8 pf;
            {   unsigned w0, w1, w2, w3;
                if (s < 2) { w0 = cvtpk(p0[8 * s], p0[8 * s + 1]); w1 = cvtpk(p0[8 * s + 2], p0[8 * s + 3]); w2 = cvtpk(p0[8 * s + 4], p0[8 * s + 5]); w3 = cvtpk(p0[8 * s + 6], p0[8 * s + 7]); }
                else { const int s2 = s - 2; w0 = cvtpk(p1[8 * s2], p1[8 * s2 + 1]); w1 = cvtpk(p1[8 * s2 + 2], p1[8 * s2 + 3]); w2 = cvtpk(p1[8 * s2 + 4], p1[8 * s2 + 5]); w3 = cvtpk(p1[8 * s2 + 6], p1[8 * s2 + 7]); }
                uint4 u = make_uint4(w0, w1, w2, w3); pf = __builtin_bit_cast(bf16x8, u); }
            const lds_cptr vb = (lds_cptr)cur + vf_off + s * 1024;
            const s16x4 a0 = vtr(vb), a1 = vtr(vb + 512), b0 = vtr(vb + 4096), b1 = vtr(vb + 4096 + 512);
            const bf16x8 v0 = (bf16x8){a0[0], a0[1], a0[2], a0[3], a1[0], a1[1], a1[2], a1[3]};
            const bf16x8 v1 = (bf16x8){b0[0], b0[1], b0[2], b0[3], b1[0], b1[1], b1[2], b1[3]};
            o0 = MFMA32(v0, pf, o0); o1 = MFMA32(v1, pf, o1);
        }
        if (VAR != 2) { if (more) { *(uint4*)(nxt + sk_off) = rk; *(uint4*)(nxt + sv_off) = rv; if (do_r) *(uint4*)(nxt + sr_off) = rr; }
        __syncthreads(); }
    }
    const float inv = 1.0f / xhalf_sum(lrun);
    bf16_t* op = O + (size_t)(wid * 32 + r32) * 512 + 4 * hi;
#pragma unroll
    for (int rg = 0; rg < 4; ++rg) {
        uint2 a; a.x = pack2(o0[4 * rg] * inv, o0[4 * rg + 1] * inv); a.y = pack2(o0[4 * rg + 2] * inv, o0[4 * rg + 3] * inv);
        uint2 b; b.x = pack2(o1[4 * rg] * inv, o1[4 * rg + 1] * inv); b.y = pack2(o1[4 * rg + 2] * inv, o1[4 * rg + 3] * inv);
        *(uint2*)(op + 8 * rg) = a; *(uint2*)(op + 32 + 8 * rg) = b;
    }
}
#define SBAR() __builtin_amdgcn_sched_barrier(0)
#define PINV(x) asm volatile("" : "+v"(x))
constexpr float ATT_THR = 6.0f;
template <int DQK>
__device__ __forceinline__ void attn_item2(const bf16_t* Q, int qpitch, const bf16_t* KA, int kapitch, const bf16_t* KB, int kbpitch,
                                           const bf16_t* V, int vpitch, int ntiles, bf16_t* O, char* lds) {
    const int tid = opaque_tid(), lane = tid & 63, wid = tid >> 6, r32 = lane & 31, hi = lane >> 5;
    const int wu = __builtin_amdgcn_readfirstlane(wid);
    constexpr int ND0 = DQK / 16, NQK = 2 * ND0;
    constexpr bool ROPE = DQK > 64;
    const int krow = 8 * wu + (lane >> 3);
    const bf16_t* gk = KA + (size_t)krow * kapitch + (((lane & 7) ^ ((krow >> 1) & 7)) << 3);
    const bf16_t* gv = V + (size_t)(16 * (wu & 3) + (lane >> 2)) * vpitch + (wu >> 2) * 32 + (lane & 3) * 8;
    const int rrow = 16 * (wu & 3) + (lane >> 2);
    const bf16_t* gr = ROPE ? (KB + (size_t)rrow * kbpitch + (((lane & 3) ^ ((rrow >> 2) & 3)) << 3)) : nullptr;
    char* dk = lds + AT_K + wu * 1024; char* dv = lds + AT_V + wu * 1024; char* dr = lds + AT_KR + (wu & 3) * 1024;
    auto issue = [&](int t, int slot) {
        GLDS16(gk + (size_t)t * 64 * kapitch, dk + slot * AT_BUF); GLDS16(gv + (size_t)t * 64 * vpitch, dv + slot * AT_BUF);
        if (ROPE) GLDS16(gr + (size_t)t * 64 * kbpitch, dr + slot * AT_BUF);
    };
    asm volatile("s_waitcnt vmcnt(0)" ::: "memory");
    issue(0, 0);
    if (ntiles > 1) issue(1, 1);
    bf16x8 qr[ND0];
    { const bf16_t* qp = Q + (size_t)(wid * 32 + r32) * qpitch + hi * 8;
#pragma unroll
      for (int d0 = 0; d0 < ND0; ++d0) qr[d0] = *(const bf16x8*)(qp + d0 * 16); }
    const int kf_off = AT_K + r32 * 128, ksw = (r32 >> 1) & 7;
    const int rf_off = AT_KR + r32 * 64, rsw = (r32 >> 2) & 3;
    const int vf_off = AT_V + (4 * hi + ((lane & 15) >> 2)) * 64 + ((lane >> 4) & 1) * 32 + (lane & 3) * 8;
    auto kfrag = [&](const char* slot, int g) -> bf16x8 {
        const int d0 = g >> 1, n = g & 1;
        if (d0 < 4) return *(const bf16x8*)(slot + kf_off + n * 32 * 128 + (((2 * d0 + hi) ^ ksw) << 4));
        return *(const bf16x8*)(slot + rf_off + n * 32 * 64 + (((2 * (d0 - 4) + hi) ^ rsw) << 4));
    };
    auto vfrag = [&](const char* slot, int g) -> bf16x8 {
        const lds_cptr vb = (lds_cptr)slot + vf_off + (g >> 1) * 1024 + (g & 1) * 4096;
        const s16x4 a0 = vtr(vb), a1 = vtr(vb + 512);
        return (bf16x8){a0[0], a0[1], a0[2], a0[3], a1[0], a1[1], a1[2], a1[3]};
    };
    f32x16 o0, o1, sA0, sA1, sB0, sB1;
    const f32x16 zero16 = {0.f, 0.f, 0.f, 0.f, 0.f, 0.f, 0.f, 0.f, 0.f, 0.f, 0.f, 0.f, 0.f, 0.f, 0.f, 0.f};
#pragma unroll
    for (int r = 0; r < 16; ++r) { o0[r] = 0.f; o1[r] = 0.f; }
    float mref, lrun = 0.f;
    if (ntiles > 1) asm volatile("s_waitcnt vmcnt(%0)" :: "n"(ROPE ? 3 : 2) : "memory"); else asm volatile("s_waitcnt vmcnt(0)" ::: "memory");
    __builtin_amdgcn_s_barrier();
    {
#pragma unroll
        for (int g = 0; g < NQK; ++g) { const bf16x8 kf = kfrag(lds, g);
            if (g & 1) sA1 = MFMA32(kf, qr[g >> 1], g < 2 ? zero16 : sA1); else sA0 = MFMA32(kf, qr[g >> 1], g < 2 ? zero16 : sA0); }
        float mx = fmaxf(sA0[0], sA1[0]);
#pragma unroll
        for (int r = 1; r < 16; ++r) mx = fmaxf(mx, fmaxf(sA0[r], sA1[r]));
        mref = xhalf_max(mx);
    }
    asm volatile("s_waitcnt vmcnt(0) lgkmcnt(0)" ::: "memory");
    __builtin_amdgcn_s_barrier();
    auto step = [&](auto HN, f32x16& c0, f32x16& c1, f32x16& n0, f32x16& n1, int t) __attribute__((always_inline)) {
        const int sl = t % 3, sl1 = (t + 1) % 3, sl2 = (t + 2) % 3;
        const char* cs = lds + sl * AT_BUF; const char* ns = lds + sl1 * AT_BUF;
        constexpr bool has_next = decltype(HN)::value;
        if (t + 2 < ntiles) issue(t + 2, sl2);
        u32x4 pw[4];
        float ls = 0.f;
        bf16x8 kf;
        if (has_next) kf = kfrag(ns, 0);
        SBAR();
#pragma unroll
        for (int g = 0; g < (NQK > 8 ? NQK : 8); ++g) {
            bf16x8 kcur = kf;
            if (has_next && g + 1 < NQK) kf = kfrag(ns, g + 1);
            SBAR();
            if (g < 8) {
                float e0, e1, e2, e3;
                if (g < 4) { e0 = __builtin_amdgcn_exp2f(c0[4 * g] - mref); e1 = __builtin_amdgcn_exp2f(c0[4 * g + 1] - mref); e2 = __builtin_amdgcn_exp2f(c0[4 * g + 2] - mref); e3 = __builtin_amdgcn_exp2f(c0[4 * g + 3] - mref); }
                else { e0 = __builtin_amdgcn_exp2f(c1[4 * (g - 4)] - mref); e1 = __builtin_amdgcn_exp2f(c1[4 * (g - 4) + 1] - mref); e2 = __builtin_amdgcn_exp2f(c1[4 * (g - 4) + 2] - mref); e3 = __builtin_amdgcn_exp2f(c1[4 * (g - 4) + 3] - mref); }
                ls += (e0 + e1) + (e2 + e3);
                const unsigned w0 = cvtpk(e0, e1), w1 = cvtpk(e2, e3);
                if ((g & 1) == 0) { pw[g >> 1][0] = w0; pw[g >> 1][1] = w1; } else { pw[g >> 1][2] = w0; pw[g >> 1][3] = w1; }
                PINV(ls); PINV(pw[g >> 1]);
            }
            SBAR();
            if (has_next && g < NQK) { if (g & 1) n1 = MFMA32(kcur, qr[g >> 1], g < 2 ? zero16 : n1); else n0 = MFMA32(kcur, qr[g >> 1], g < 2 ? zero16 : n0); }
            SBAR();
        }
        lrun += ls;
        float mx = -INFINITY;
        bf16x8 vf = vfrag(cs, 0);
        SBAR();
#pragma unroll
        for (int g = 0; g < 8; ++g) {
            const bf16x8 vcur = vf;
            if (g + 1 < 8) vf = vfrag(cs, g + 1);
            SBAR();
            if (has_next) {
                if (g < 4) mx = fmaxf(fmaxf(mx, fmaxf(n0[4 * g], n0[4 * g + 1])), fmaxf(n0[4 * g + 2], n0[4 * g + 3]));
                else mx = fmaxf(fmaxf(mx, fmaxf(n1[4 * (g - 4)], n1[4 * (g - 4) + 1])), fmaxf(n1[4 * (g - 4) + 2], n1[4 * (g - 4) + 3]));
                PINV(mx);
            }
            SBAR();
            const bf16x8 pf = __builtin_bit_cast(bf16x8, pw[g >> 1]);
            if (g & 1) o1 = MFMA32(vcur, pf, o1); else o0 = MFMA32(vcur, pf, o0);
            SBAR();
        }
        if (has_next) {
            const float gr_ = xhalf_max(mx) - mref;
            if (__any(gr_ > ATT_THR)) {
                const float d = fmaxf(gr_, 0.f), a = __builtin_amdgcn_exp2f(-d);
                mref += d; lrun *= a;
#pragma unroll
                for (int r = 0; r < 16; ++r) { o0[r] *= a; o1[r] *= a; }
            }
        }
        asm volatile("s_waitcnt vmcnt(0) lgkmcnt(0)" ::: "memory");
        __builtin_amdgcn_s_barrier();
    };
    {   const std::integral_constant<bool, true> yes; const std::integral_constant<bool, false> no;
        int t = 0;
        for (; t + 2 < ntiles; t += 2) { step(yes, sA0, sA1, sB0, sB1, t); step(yes, sB0, sB1, sA0, sA1, t + 1); }
        step(yes, sA0, sA1, sB0, sB1, t); step(no, sB0, sB1, sA0, sA1, t + 1); }
    const float inv = 1.0f / xhalf_sum(lrun);
    bf16_t* op = O + (size_t)(wid * 32 + r32) * 512 + 4 * hi;
#pragma unroll
    for (int rg = 0; rg < 4; ++rg) {
        uint2 a; a.x = pack2(o0[4 * rg] * inv, o0[4 * rg + 1] * inv); a.y = pack2(o0[4 * rg + 2] * inv, o0[4 * rg + 3] * inv);
        uint2 b; b.x = pack2(o1[4 * rg] * inv, o1[4 * rg + 1] * inv); b.y = pack2(o1[4 * rg + 2] * inv, o1[4 * rg + 3] * inv);
        *(uint2*)(op + 8 * rg) = a; *(uint2*)(op + 32 + 8 * rg) = b;
    }
}
constexpr int A3_K = 0, A3_KR = 16384, A3_V = 24576, A3_BYTES = 24576 + 3 * 8192;
template <int DQK>
__device__ __forceinline__ void attn_item3(const bf16_t* Q, int qpitch, const bf16_t* KA, int kapitch, const bf16_t* KB, int kbpitch,
                                           const bf16_t* V, int vpitch, int ntiles, bf16_t* O, char* lds) {
    const int tid = opaque_tid(), lane = tid & 63, wid = tid >> 6, r32 = lane & 31, hi = lane >> 5;
    const bool grpB = __builtin_amdgcn_readfirstlane(wid) >= 4;
    constexpr int ND0 = DQK / 16;
    bf16x8 qr[ND0];
    { const bf16_t* qp = Q + (size_t)(wid * 32 + r32) * qpitch + hi * 8;
#pragma unroll
      for (int d0 = 0; d0 < ND0; ++d0) qr[d0] = *(const bf16x8*)(qp + d0 * 16); }
    const int srow = tid >> 3, sch = tid & 7;
    const bf16_t* gk = KA + (size_t)srow * kapitch + sch * 8;
    const bf16_t* gv = V + (size_t)srow * vpitch + sch * 8;
    const bf16_t* gr = (DQK > 64) ? (KB + (size_t)(tid >> 2) * kbpitch + (tid & 3) * 8) : nullptr;
    const int sk_off = A3_K + srow * 128 + ((sch ^ ((srow >> 1) & 7)) << 4);
    const int sv_off = A3_V + (sch >> 2) * 4096 + srow * 64 + (sch & 3) * 16;
    const int sr_off = A3_KR + (tid >> 2) * 64 + (((tid & 3) ^ (((tid >> 2) >> 2) & 3)) << 4);
    const bool do_r = (DQK > 64) && (tid < 256);
    const int kf_off = A3_K + r32 * 128, ksw = (r32 >> 1) & 7;
    const int rf_off = A3_KR + r32 * 64, rsw = (r32 >> 2) & 3;
    const int vf_off = A3_V + (4 * hi + ((lane & 15) >> 2)) * 64 + ((lane >> 4) & 1) * 32 + (lane & 3) * 8;
    uint4 rk, rv, rr; rr = make_uint4(0, 0, 0, 0);
    rk = *(const uint4*)gk; rv = *(const uint4*)gv; if (do_r) rr = *(const uint4*)gr;
    *(uint4*)(lds + sk_off) = rk; *(uint4*)(lds + sv_off) = rv; if (do_r) *(uint4*)(lds + sr_off) = rr;
    __syncthreads();
    f32x16 o0, o1, p0, p1;
#pragma unroll
    for (int r = 0; r < 16; ++r) { o0[r] = 0.f; o1[r] = 0.f; p0[r] = 0.f; p1[r] = 0.f; }
    float mrun = -INFINITY, lrun = 0.f;
    auto H1 = [&](int t) __attribute__((always_inline)) {
        const char* ks = lds + (t & 1) * 8192; const char* rs = lds + (t & 1) * 4096;
#pragma unroll
        for (int r = 0; r < 16; ++r) { p0[r] = 0.f; p1[r] = 0.f; }
#pragma unroll
        for (int d0 = 0; d0 < 4; ++d0) {
            const int co = ((2 * d0 + hi) ^ ksw) << 4;
            const bf16x8 k0 = *(const bf16x8*)(ks + kf_off + co), k1 = *(const bf16x8*)(ks + kf_off + 32 * 128 + co);
            p0 = MFMA32(k0, qr[d0], p0); p1 = MFMA32(k1, qr[d0], p1);
        }
        if (DQK > 64) {
#pragma unroll
            for (int d0 = 4; d0 < ND0; ++d0) {
                const int co = ((2 * (d0 - 4) + hi) ^ rsw) << 4;
                const bf16x8 k0 = *(const bf16x8*)(rs + rf_off + co), k1 = *(const bf16x8*)(rs + rf_off + 32 * 64 + co);
                p0 = MFMA32(k0, qr[d0], p0); p1 = MFMA32(k1, qr[d0], p1);
            }
        }
        float mx = fmaxf(p0[0], p1[0]);
#pragma unroll
        for (int r = 1; r < 16; ++r) mx = fmaxf(mx, fmaxf(p0[r], p1[r]));
        mx = xhalf_max(mx);
        if (__any(mx > mrun + ATT_THR)) {
            const float mnew = fmaxf(mrun, mx), alpha = __builtin_amdgcn_exp2f(mrun - mnew);
            lrun *= alpha;
#pragma unroll
            for (int r = 0; r < 16; ++r) { o0[r] *= alpha; o1[r] *= alpha; }
            mrun = mnew;
        }
    };
    auto H2 = [&](int t) __attribute__((always_inline)) {
        const char* vs = lds + (t % 3) * 8192;
        float ls = 0.f;
#pragma unroll
        for (int r = 0; r < 16; ++r) { p0[r] = __builtin_amdgcn_exp2f(p0[r] - mrun); p1[r] = __builtin_amdgcn_exp2f(p1[r] - mrun); ls += p0[r] + p1[r]; }
        lrun += ls;
#pragma unroll
        for (int s = 0; s < 4; ++s) {
            bf16x8 pf;
            {   unsigned w0, w1, w2, w3;
                if (s < 2) { w0 = cvtpk(p0[8 * s], p0[8 * s + 1]); w1 = cvtpk(p0[8 * s + 2], p0[8 * s + 3]); w2 = cvtpk(p0[8 * s + 4], p0[8 * s + 5]); w3 = cvtpk(p0[8 * s + 6], p0[8 * s + 7]); }
                else { const int s2 = s - 2; w0 = cvtpk(p1[8 * s2], p1[8 * s2 + 1]); w1 = cvtpk(p1[8 * s2 + 2], p1[8 * s2 + 3]); w2 = cvtpk(p1[8 * s2 + 4], p1[8 * s2 + 5]); w3 = cvtpk(p1[8 * s2 + 6], p1[8 * s2 + 7]); }
                u32x4 u = {w0, w1, w2, w3}; pf = __builtin_bit_cast(bf16x8, u); }
            const lds_cptr vb = (lds_cptr)vs + vf_off + s * 1024;
            const s16x4 a0 = vtr(vb), a1 = vtr(vb + 512), b0 = vtr(vb + 4096), b1 = vtr(vb + 4096 + 512);
            const bf16x8 v0 = (bf16x8){a0[0], a0[1], a0[2], a0[3], a1[0], a1[1], a1[2], a1[3]};
            const bf16x8 v1 = (bf16x8){b0[0], b0[1], b0[2], b0[3], b1[0], b1[1], b1[2], b1[3]};
            o0 = MFMA32(v0, pf, o0); o1 = MFMA32(v1, pf, o1);
        }
    };
#define A3_LOAD(t) do { rk = *(const uint4*)(gk + (size_t)((t) + 1) * 64 * kapitch); rv = *(const uint4*)(gv + (size_t)((t) + 1) * 64 * vpitch); if (do_r) rr = *(const uint4*)(gr + (size_t)((t) + 1) * 64 * kbpitch); } while (0)
#define A3_WRITE(t) do { const int kn = ((t) + 1) & 1, vn = ((t) + 1) % 3; *(uint4*)(lds + kn * 8192 + sk_off) = rk; *(uint4*)(lds + vn * 8192 + sv_off) = rv; if (do_r) *(uint4*)(lds + kn * 4096 + sr_off) = rr; } while (0)
    if (grpB) {
        { const bool more = (1 < ntiles); if (more) A3_LOAD(0); H1(0); if (more) A3_WRITE(0); __syncthreads(); }
        for (int t = 1; t < ntiles; ++t) {
            const bool more = (t + 1 < ntiles);
            if (more) A3_LOAD(t);
            H2(t - 1); H1(t);
            if (more) A3_WRITE(t);
            __syncthreads();
        }
    } else {
        for (int t = 0; t < ntiles; ++t) {
            const bool more = (t + 1 < ntiles);
            if (more) A3_LOAD(t);
            H1(t); H2(t);
            if (more) A3_WRITE(t);
            __syncthreads();
        }
    }
#undef A3_LOAD
#undef A3_WRITE
    if (grpB) H2(ntiles - 1);
    const float inv = 1.0f / xhalf_sum(lrun);
    bf16_t* op = O + (size_t)(wid * 32 + r32) * 512 + 4 * hi;
#pragma unroll
    for (int rg = 0; rg < 4; ++rg) {
        uint2 a; a.x = pack2(o0[4 * rg] * inv, o0[4 * rg + 1] * inv); a.y = pack2(o0[4 * rg + 2] * inv, o0[4 * rg + 3] * inv);
        uint2 b; b.x = pack2(o1[4 * rg] * inv, o1[4 * rg + 1] * inv); b.y = pack2(o1[4 * rg + 2] * inv, o1[4 * rg + 3] * inv);
        *(uint2*)(op + 8 * rg) = a; *(uint2*)(op + 32 + 8 * rg) = b;
    }
    __syncthreads();
}
template <int DQK>
__device__ __forceinline__ void attn_item4(const bf16_t* Q, int qpitch, const bf16_t* KA, int kapitch, const bf16_t* KB, int kbpitch,
                                           const bf16_t* V, int vpitch, int ntiles, float ref_const, float kmax2, bf16_t* O, char* lds) {
    const int tid = opaque_tid(), lane = tid & 63, wid = tid >> 6, r32 = lane & 31, hi = lane >> 5;
    constexpr int ND0 = DQK / 16;
    bf16x8 qr[ND0];
    { const bf16_t* qp = Q + (size_t)(wid * 32 + r32) * qpitch + hi * 8;
#pragma unroll
      for (int d0 = 0; d0 < ND0; ++d0) qr[d0] = *(const bf16x8*)(qp + d0 * 16); }
    float mref = ref_const;
    if (DQK > 64) {
        float qn2 = 0.f;
#pragma unroll
        for (int d0 = 0; d0 < ND0; ++d0)
#pragma unroll
            for (int j = 0; j < 8; ++j) { const float v = bf2f((bf16_t)qr[d0][j]); qn2 = fmaf(v, v, qn2); }
        qn2 = xhalf_sum(qn2);
        mref = sqrtf(qn2 * kmax2) * 1.01f + 0.01f;
    }
    f32x16 negm;
#pragma unroll
    for (int r = 0; r < 16; ++r) negm[r] = -mref;
    const int srow = tid >> 3, sch = tid & 7;
    const bf16_t* gk = KA + (size_t)srow * kapitch + sch * 8;
    const bf16_t* gv = V + (size_t)srow * vpitch + sch * 8;
    const bf16_t* gr = (DQK > 64) ? (KB + (size_t)(tid >> 2) * kbpitch + (tid & 3) * 8) : nullptr;
    const int sk_off = AT_K + srow * 128 + ((sch ^ ((srow >> 1) & 7)) << 4);
    const int sv_off = AT_V + (sch >> 2) * 4096 + srow * 64 + (sch & 3) * 16;
    const int sr_off = AT_KR + (tid >> 2) * 64 + (((tid & 3) ^ (((tid >> 2) >> 2) & 3)) << 4);
    const bool do_r = (DQK > 64) && (tid < 256);
    const int kf_off = AT_K + r32 * 128, ksw = (r32 >> 1) & 7;
    const int rf_off = AT_KR + r32 * 64, rsw = (r32 >> 2) & 3;
    const int vf_off = AT_V + (4 * hi + ((lane & 15) >> 2)) * 64 + ((lane >> 4) & 1) * 32 + (lane & 3) * 8;
    uint4 rk, rv, rr; rr = make_uint4(0, 0, 0, 0);
    rk = *(const uint4*)gk; rv = *(const uint4*)gv; if (do_r) rr = *(const uint4*)gr;
    *(uint4*)(lds + sk_off) = rk; *(uint4*)(lds + sv_off) = rv; if (do_r) *(uint4*)(lds + sr_off) = rr;
    __syncthreads();
    f32x16 o0, o1;
#pragma unroll
    for (int r = 0; r < 16; ++r) { o0[r] = 0.f; o1[r] = 0.f; }
    float lrun = 0.f;
#pragma unroll 1
    for (int t = 0; t < ntiles; ++t) {
        const char* cur = lds + (t & 1) * AT_BUF; char* nxt = lds + ((t + 1) & 1) * AT_BUF;
        const bool more = (t + 1 < ntiles);
        if (more) { rk = *(const uint4*)(gk + (size_t)(t + 1) * 64 * kapitch); rv = *(const uint4*)(gv + (size_t)(t + 1) * 64 * vpitch); if (do_r) rr = *(const uint4*)(gr + (size_t)(t + 1) * 64 * kbpitch); }
        bf16x8 kf[8];
#pragma unroll
        for (int d0 = 0; d0 < 4; ++d0) { const int co = ((2 * d0 + hi) ^ ksw) << 4; kf[2 * d0] = *(const bf16x8*)(cur + kf_off + co); kf[2 * d0 + 1] = *(const bf16x8*)(cur + kf_off + 32 * 128 + co); }
        f32x16 p0, p1;
        p0 = MFMA32(kf[0], qr[0], negm); p1 = MFMA32(kf[1], qr[0], negm);
        p0 = MFMA32(kf[2], qr[1], p0); p1 = MFMA32(kf[3], qr[1], p1);
        if (DQK > 64) {
            __builtin_amdgcn_sched_barrier(0);
#pragma unroll
            for (int d0 = 4; d0 < ND0; ++d0) { const int co = ((2 * (d0 - 4) + hi) ^ rsw) << 4; kf[2 * (d0 - 4)] = *(const bf16x8*)(cur + rf_off + co); kf[2 * (d0 - 4) + 1] = *(const bf16x8*)(cur + rf_off + 32 * 64 + co); }
        }
        p0 = MFMA32(kf[4], qr[2], p0); p1 = MFMA32(kf[5], qr[2], p1);
        p0 = MFMA32(kf[6], qr[3], p0); p1 = MFMA32(kf[7], qr[3], p1);
        if (DQK > 64) {
#pragma unroll
            for (int d0 = 4; d0 < ND0; ++d0) { p0 = MFMA32(kf[2 * (d0 - 4)], qr[d0], p0); p1 = MFMA32(kf[2 * (d0 - 4) + 1], qr[d0], p1); }
        }
        bf16x8 vf[8];
        auto vload = [&](int s) __attribute__((always_inline)) {
            const lds_cptr vb = (lds_cptr)cur + vf_off + s * 1024;
            const s16x4 a0 = vtr(vb), a1 = vtr(vb + 512), b0 = vtr(vb + 4096), b1 = vtr(vb + 4096 + 512);
            vf[2 * s] = (bf16x8){a0[0], a0[1], a0[2], a0[3], a1[0], a1[1], a1[2], a1[3]};
            vf[2 * s + 1] = (bf16x8){b0[0], b0[1], b0[2], b0[3], b1[0], b1[1], b1[2], b1[3]};
        };
        vload(0); vload(1);
        float ls = 0.f;
#pragma unroll
        for (int s = 0; s < 4; ++s) {
            float e[8];
#pragma unroll
            for (int j = 0; j < 8; ++j) e[j] = __builtin_amdgcn_exp2f(s < 2 ? p0[8 * s + j] : p1[8 * (s - 2) + j]);
            ls += ((e[0] + e[1]) + (e[2] + e[3])) + ((e[4] + e[5]) + (e[6] + e[7]));
            u32x4 u = {cvtpk(e[0], e[1]), cvtpk(e[2], e[3]), cvtpk(e[4], e[5]), cvtpk(e[6], e[7])};
            const bf16x8 pf = __builtin_bit_cast(bf16x8, u);
            if (s + 2 < 4) vload(s + 2);
            o0 = MFMA32(vf[2 * s], pf, o0); o1 = MFMA32(vf[2 * s + 1], pf, o1);
        }
        lrun += ls;
        if (more) { *(uint4*)(nxt + sk_off) = rk; *(uint4*)(nxt + sv_off) = rv; if (do_r) *(uint4*)(nxt + sr_off) = rr; }
        __syncthreads();
    }
    const float inv = 1.0f / xhalf_sum(lrun);
    bf16_t* op = O + (size_t)(wid * 32 + r32) * 512 + 4 * hi;
#pragma unroll
    for (int rg = 0; rg < 4; ++rg) {
        uint2 a; a.x = pack2(o0[4 * rg] * inv, o0[4 * rg + 1] * inv); a.y = pack2(o0[4 * rg + 2] * inv, o0[4 * rg + 3] * inv);
        uint2 b; b.x = pack2(o1[4 * rg] * inv, o1[4 * rg + 1] * inv); b.y = pack2(o1[4 * rg + 2] * inv, o1[4 * rg + 3] * inv);
        *(uint2*)(op + 8 * rg) = a; *(uint2*)(op + 32 + 8 * rg) = b;
    }
}
constexpr int A7_K = 0, A7_V = 8192, A7_KR = 16384, A7_BUF = 20480;
template <int DQK>
__device__ __forceinline__ void attn_item7(const bf16_t* Q, int qpitch, const bf16_t* KA, int kapitch, const bf16_t* KB, int kbpitch,
                                           const bf16_t* V, int vpitch, int ntiles, float ref_const, float kmax2, bf16_t* O, char* lds) {
    const int tid = opaque_tid(), lane = tid & 63, wid = tid >> 6, fr = lane & 15, g = lane >> 4;
    constexpr int NKS = DQK / 32;
    bf16x8 qr[2][NKS];
#pragma unroll
    for (int qi = 0; qi < 2; ++qi) { const bf16_t* qp = Q + (size_t)(wid * 32 + 16 * qi + fr) * qpitch + 8 * g;
#pragma unroll
        for (int ks = 0; ks < NKS; ++ks) qr[qi][ks] = *(const bf16x8*)(qp + 32 * ks); }
    f32x4 negm[2];
#pragma unroll
    for (int qi = 0; qi < 2; ++qi) {
        float mref = ref_const;
        if (DQK > 64) {
            float qn2 = 0.f;
#pragma unroll
            for (int ks = 0; ks < NKS; ++ks)
#pragma unroll
                for (int j = 0; j < 8; ++j) { const float v = bf2f((bf16_t)qr[qi][ks][j]); qn2 = fmaf(v, v, qn2); }
            qn2 += __shfl_xor(qn2, 16); qn2 += __shfl_xor(qn2, 32);
            mref = sqrtf(qn2 * kmax2) * 1.01f + 0.01f;
        }
        negm[qi][0] = -mref; negm[qi][1] = -mref; negm[qi][2] = -mref; negm[qi][3] = -mref;
    }
    const int srow = tid >> 3, sch = tid & 7;
    const bf16_t* gk = KA + (size_t)srow * kapitch + sch * 8;
    const bf16_t* gv = V + (size_t)srow * vpitch + sch * 8;
    const bf16_t* gr = (DQK > 64) ? (KB + (size_t)(tid >> 2) * kbpitch + (tid & 3) * 8) : nullptr;
    const int sk_off = A7_K + srow * 128 + ((sch ^ ((srow >> 1) & 7)) << 4);
    const int sv_off = A7_V + (sch >> 1) * 2048 + srow * 32 + (sch & 1) * 16;
    const int sr_off = A7_KR + (tid >> 2) * 64 + ((((tid & 3) + 2 * ((tid >> 2) >> 2)) & 3) << 4);
    const bool do_r = (DQK > 64) && (tid < 256);
    const int kf_off = A7_K + fr * 128, ksw = (fr >> 1) & 7;
    const int rf_off = A7_KR + fr * 64 + (((g + 2 * (fr >> 2)) & 3) << 4);
    const int vf_off = A7_V + (4 * g + (fr >> 2)) * 32 + (fr & 3) * 8;
    uint4 rk, rv, rr; rr = make_uint4(0, 0, 0, 0);
    rk = *(const uint4*)gk; rv = *(const uint4*)gv; if (do_r) rr = *(const uint4*)gr;
    *(uint4*)(lds + sk_off) = rk; *(uint4*)(lds + sv_off) = rv; if (do_r) *(uint4*)(lds + sr_off) = rr;
    __syncthreads();
    f32x4 o[4][2]; float lsum[2] = {0.f, 0.f};
#pragma unroll
    for (int di = 0; di < 4; ++di)
#pragma unroll
        for (int qi = 0; qi < 2; ++qi) { o[di][qi][0] = 0.f; o[di][qi][1] = 0.f; o[di][qi][2] = 0.f; o[di][qi][3] = 0.f; }
#pragma unroll 1
    for (int t = 0; t < ntiles; ++t) {
        const char* cur = lds + (t & 1) * A7_BUF; char* nxt = lds + ((t + 1) & 1) * A7_BUF;
        const bool more = (t + 1 < ntiles);
        if (more) { rk = *(const uint4*)(gk + (size_t)(t + 1) * 64 * kapitch); rv = *(const uint4*)(gv + (size_t)(t + 1) * 64 * vpitch); if (do_r) rr = *(const uint4*)(gr + (size_t)(t + 1) * 64 * kbpitch); }
        f32x4 s[4][2];
#pragma unroll
        for (int ks = 0; ks < NKS; ++ks) {
            bf16x8 kf[4];
#pragma unroll
            for (int kj = 0; kj < 4; ++kj)
                kf[kj] = (ks < 2) ? *(const bf16x8*)(cur + kf_off + kj * 2048 + (((4 * ks + g) ^ ksw) << 4)) : *(const bf16x8*)(cur + rf_off + kj * 1024);
#pragma unroll
            for (int kj = 0; kj < 4; ++kj)
#pragma unroll
                for (int qi = 0; qi < 2; ++qi) s[kj][qi] = MFMA16(kf[kj], qr[qi][ks], ks == 0 ? negm[qi] : s[kj][qi]);
        }
#pragma unroll
        for (int kk = 0; kk < 2; ++kk) {
            bf16x8 vf[4];
#pragma unroll
            for (int di = 0; di < 4; ++di) {
                const lds_cptr vb = (lds_cptr)cur + vf_off + di * 2048 + kk * 1024;
                const s16x4 a0 = vtr(vb), a1 = vtr(vb + 512);
                vf[di] = (bf16x8){a0[0], a0[1], a0[2], a0[3], a1[0], a1[1], a1[2], a1[3]};
            }
            bf16x8 pf[2];
#pragma unroll
            for (int qi = 0; qi < 2; ++qi) {
                float e[8];
#pragma unroll
                for (int j = 0; j < 4; ++j) { e[j] = __builtin_amdgcn_exp2f(s[2 * kk][qi][j]); e[4 + j] = __builtin_amdgcn_exp2f(s[2 * kk + 1][qi][j]); }
                lsum[qi] += ((e[0] + e[1]) + (e[2] + e[3])) + ((e[4] + e[5]) + (e[6] + e[7]));
                u32x4 u = {cvtpk(e[0], e[1]), cvtpk(e[2], e[3]), cvtpk(e[4], e[5]), cvtpk(e[6], e[7])};
                pf[qi] = __builtin_bit_cast(bf16x8, u);
            }
#pragma unroll
            for (int di = 0; di < 4; ++di) { o[di][0] = MFMA16(vf[di], pf[0], o[di][0]); o[di][1] = MFMA16(vf[di], pf[1], o[di][1]); }
        }
        if (more) { *(uint4*)(nxt + sk_off) = rk; *(uint4*)(nxt + sv_off) = rv; if (do_r) *(uint4*)(nxt + sr_off) = rr; }
        __syncthreads();
    }
#pragma unroll
    for (int qi = 0; qi < 2; ++qi) {
        float l = lsum[qi]; l += __shfl_xor(l, 16); l += __shfl_xor(l, 32);
        const float inv = 1.0f / l;
        bf16_t* op = O + (size_t)(wid * 32 + 16 * qi + fr) * 512 + 4 * g;
#pragma unroll
        for (int di = 0; di < 4; ++di) *(uint2*)(op + 16 * di) = pack4(o[di][qi] * inv);
    }
}
__device__ __forceinline__ void attn_dispatch(const KP& p, int ty, int h, int qt, float gqa_ref, char* lds) {
    const bf16_t* P = WSP(bf16_t, OFF_P); const bf16_t* Qm = WSP(bf16_t, OFF_H); const bf16_t* Kn = WSP(bf16_t, OFF_KN); const bf16_t* Vm = WSP(bf16_t, OFF_V);
    const int ntiles = (qt == 0) ? (LC / 64) : (T / 64);
    const size_t r0 = (size_t)qt * 256;
    bf16_t* Om = WSP(bf16_t, OFF_OM); bf16_t* Og = WSP(bf16_t, OFF_OG);
    if (ty == 0) {
        const float kmax2 = __uint_as_float(WSP(unsigned, OFF_CNT)[32 + h]);
        attn_item7<96>(Qm + r0 * 768 + h * 96, 768, Kn + h * 64, 512, P + C_KR, PP, Vm + h * 64, 512, ntiles, 0.f, kmax2, Om + r0 * 512 + h * 64, lds);
    } else
        attn_item7<64>(P + r0 * PP + C_GQ + h * 64, PP, P + C_GK + (h >> 2) * 64, PP, nullptr, 0, P + C_GV + (h >> 2) * 64, PP, ntiles, gqa_ref, 0.f, Og + r0 * 512 + h * 64, lds);
}
__device__ __forceinline__ void st_attn(const KP& p, int l, int bid, int nb, char* lds) {
    const int tidx = opaque_tid();
    float gq = fabsf(p.in(I_GQN)[l * 64 + (tidx & 63)]), gk = fabsf(p.in(I_GKN)[l * 64 + (tidx & 63)]);
#pragma unroll
    for (int o = 32; o > 0; o >>= 1) { gq = fmaxf(gq, __shfl_xor(gq, o)); gk = fmaxf(gk, __shfl_xor(gk, o)); }
    const float gqa_ref = 64.0f * SC_GQA * gq * gk * 1.02f + 0.01f;
    for (int ty = 0; ty < 2; ++ty)
        for (int u = bid; u < 512; u += nb) attn_dispatch(p, ty, u & 7, 1 + (u >> 3), gqa_ref, lds);
    for (int u = bid; u < 16; u += nb) attn_dispatch(p, u >> 3, u & 7, 0, gqa_ref, lds);
}

__device__ __forceinline__ void st_merge(const KP& p, int l, int bid, int nb, char* lds) {
    const int tidx = opaque_tid();
    const bf16_t* P = WSP(bf16_t, OFF_P); bf16_t* Mb = WSP(bf16_t, OFF_H);
    const bf16_t* Wb = WSP(bf16_t, OFF_WB + WB_BR);
    int mt, nt;
    for (int it = 0; dense_tile(it, 8, l + 1 < NL, bid, nb, mt, nt); ++it) {
        acc_t tot; acc_zero(tot);
#pragma unroll 1
        for (int b = 0; b < 3; ++b) {
            const bf16_t* Ob = b == 1 ? P + C_SSM : WSP(bf16_t, b == 0 ? OFF_OM : OFF_OG); const int opitch = b == 1 ? PP : 512;
            acc_t acc; acc_zero(acc);
            gemm_core(acc, [&](int r) { return Ob + (size_t)(mt * 256 + r) * opitch; }, [&](int r) { return Wb + ((size_t)b * 1024 + nt * 128 + r) * 512; }, 512, lds);
            acc_visit_add(acc, tot, [&](int ml, int nl, f32x4 v) {
                const int wm_ = ml >> 6, im_ = (ml >> 4) & 3, fr_ = ml & 15, G_ = b * 64 + nt * 8 + (nl >> 4), g_ = (nl >> 2) & 3;
                const uint2 gr = *(const uint2*)(WSP(bf16_t, OFF_GS) + (((((size_t)(mt * 192 + G_) * 4 + wm_) * 4 + im_) * 64) + g_ * 16 + fr_) * 4);
                f32x4 r; r[0] = bflo(gr.x) * v[0]; r[1] = bfhi(gr.x) * v[1]; r[2] = bflo(gr.y) * v[2]; r[3] = bfhi(gr.y) * v[3];
                return r; });
        }
        acc_visit(tot, [&](int ml, int nl, f32x4 v) { *(uint2*)(Mb + (size_t)(mt * 256 + ml) * 1024 + nt * 128 + nl) = pack4(v); });
    }
}
__device__ __forceinline__ void st_wout(const KP& p, int l, int bid, int nb, char* lds) {
    const int tidx = opaque_tid();
    const bf16_t* Mb = WSP(bf16_t, OFF_H); const bf16_t* Wt = WSP(bf16_t, OFF_WB + WB_OUT); float* Y = WSP(float, OFF_Y);
    int mt, nt;
    for (int it = 0; dense_tile(it, 8, l + 1 < NL, bid, nb, mt, nt); ++it) {
        acc_t acc; acc_zero(acc);
        gemm_core(acc, [&](int r) { return Mb + (size_t)(mt * 256 + r) * 1024; }, [&](int r) { return Wt + (size_t)(nt * 128 + r) * 1024; }, 1024, lds);
        acc_visit(acc, [&](int ml, int nl, f32x4 v) { *(f32x4*)(Y + (size_t)(mt * 256 + ml) * 1024 + nt * 128 + nl) = v; });
    }
    int* sltok = WSP(int, OFF_SLTOK); float* slw = WSP(float, OFF_SLW); int* cnt = WSP(int, OFF_CNT);
    for (int i = bid * NTH + tidx; i < TP; i += nb * NTH) { sltok[i] = 0; slw[i] = 0.f; }
    if (bid == 0 && tidx < 32) cnt[tidx] = 0;
}

__device__ __forceinline__ void st_postmix(const KP& p, int l, int bid, int nb, char* lds) {
    const int tidx = opaque_tid();
    const int lane = tidx & 63, wid = tidx >> 6;
    const float* Y = WSP(float, OFF_Y); bf16_t* H2 = WSP(bf16_t, OFF_H);
    const float* gpost = p.in(I_GPOSTMIX) + l * D; const float* gpre = p.in(I_GPREFFN) + l * D;
    int* toke = WSP(int, OFF_TOKE); float* tokw = WSP(float, OFF_TOKW); int* cnt = WSP(int, OFF_CNT);
    float* wl = (float*)lds; int* hist = (int*)(lds + 20 * 1024 * 4);
    {   const float* wg = p.in(I_WGROUP) + (size_t)l * D * 4; const float* wr = p.in(I_WROUTER) + (size_t)l * D * 16;
        for (int k = tidx; k < 1024; k += NTH) {
            const float4 g4 = *(const float4*)(wg + (size_t)k * 4);
            wl[0 * 1024 + k] = g4.x; wl[1 * 1024 + k] = g4.y; wl[2 * 1024 + k] = g4.z; wl[3 * 1024 + k] = g4.w;
#pragma unroll
            for (int e4 = 0; e4 < 4; ++e4) { const float4 r4 = *(const float4*)(wr + (size_t)k * 16 + e4 * 4);
                wl[(4 + e4 * 4 + 0) * 1024 + k] = r4.x; wl[(4 + e4 * 4 + 1) * 1024 + k] = r4.y; wl[(4 + e4 * 4 + 2) * 1024 + k] = r4.z; wl[(4 + e4 * 4 + 3) * 1024 + k] = r4.w; }
        }
        if (tidx < 16) hist[tidx] = 0;
        __syncthreads(); }
    auto ld = [&](int r, float4 (&y)[4], float4 (&x)[4]) __attribute__((always_inline)) {
        const float* xs = l == 0 ? xrow_in(p, r) : xrow_c(p, r);
#pragma unroll
        for (int i = 0; i < 4; ++i) { y[i] = *(const float4*)(Y + (size_t)r * D + i * 256 + lane * 4); x[i] = *(const float4*)(xs + i * 256 + lane * 4); }
    };
    auto proc = [&](int r, float4 (&y)[4], float4 (&x)[4]) __attribute__((always_inline)) {
        float* xr = xrow(p, r);
        const float* md = WSP(float, OFF_MOD) + (size_t)(l * 2 + (r < LC ? 1 : 0)) * 6144;
        float ss = 0.f;
#pragma unroll
        for (int i = 0; i < 4; ++i) ss += y[i].x * y[i].x + y[i].y * y[i].y + y[i].z * y[i].z + y[i].w * y[i].w;

        ss = wave_sum(ss);
        const float rstd = rsqrtf(ss * (1.0f / D) + EPS);
        float ss2 = 0.f;
#pragma unroll
        for (int i = 0; i < 4; ++i) { const int c = i * 256 + lane * 4;
            const float4 gg = *(const float4*)(gpost + c), ga = *(const float4*)(md + 2048 + c);
            x[i].x += ga.x * y[i].x * rstd * gg.x; x[i].y += ga.y * y[i].y * rstd * gg.y; x[i].z += ga.z * y[i].z * rstd * gg.z; x[i].w += ga.w * y[i].w * rstd * gg.w;
            *(float4*)(xr + c) = x[i];
            ss2 += x[i].x * x[i].x + x[i].y * x[i].y + x[i].z * x[i].z + x[i].w * x[i].w; }
        ss2 = wave_sum(ss2);
        const float rstd2 = rsqrtf(ss2 * (1.0f / D) + EPS);
        float lg[4] = {0.f, 0.f, 0.f, 0.f}, le[16];
#pragma unroll
        for (int e = 0; e < 16; ++e) le[e] = 0.f;
#pragma unroll
        for (int i = 0; i < 4; ++i) { const int c = i * 256 + lane * 4;
            const float4 gg = *(const float4*)(gpre + c), sh = *(const float4*)(md + 3072 + c), sc = *(const float4*)(md + 4096 + c);
            float h[4];
            h[0] = x[i].x * rstd2 * gg.x * (1.f + sc.x) + sh.x; h[1] = x[i].y * rstd2 * gg.y * (1.f + sc.y) + sh.y;
            h[2] = x[i].z * rstd2 * gg.z * (1.f + sc.z) + sh.z; h[3] = x[i].w * rstd2 * gg.w * (1.f + sc.w) + sh.w;
            uint2 o; o.x = pack2(h[0], h[1]); o.y = pack2(h[2], h[3]);
            *(uint2*)(H2 + (size_t)r * D + c) = o;
#pragma unroll
            for (int e = 0; e < 4; ++e) { const float4 w4 = *(const float4*)(wl + e * 1024 + c);
                lg[e] = fmaf(h[0], w4.x, lg[e]); lg[e] = fmaf(h[1], w4.y, lg[e]); lg[e] = fmaf(h[2], w4.z, lg[e]); lg[e] = fmaf(h[3], w4.w, lg[e]); }
#pragma unroll
            for (int e = 0; e < 16; ++e) { const float4 w4 = *(const float4*)(wl + (4 + e) * 1024 + c);
                le[e] = fmaf(h[0], w4.x, le[e]); le[e] = fmaf(h[1], w4.y, le[e]); le[e] = fmaf(h[2], w4.z, le[e]); le[e] = fmaf(h[3], w4.w, le[e]); }
        }
#pragma unroll
        for (int g = 0; g < 4; ++g) lg[g] = wave_sum(lg[g]) + p.in(I_BGROUP)[l * 4 + g];
        const float myle = transpose_reduce16(le, lane) + p.in(I_BROUTER)[l * 16 + (lane & 15)];
        int gs = 0; float gm = lg[0];
#pragma unroll
        for (int g = 1; g < 4; ++g) if (lg[g] > gm) { gm = lg[g]; gs = g; }
        float ls[4];
#pragma unroll
        for (int i = 0; i < 4; ++i) ls[i] = __shfl(myle, gs * 4 + i);
        if (lane == 0) {
            float den = 0.f;
#pragma unroll
            for (int g = 0; g < 4; ++g) den += __expf(lg[g] - gm);
            const float pg = 1.0f / den;
            int i0 = 0; float m0 = ls[0];
#pragma unroll
            for (int i = 1; i < 4; ++i) if (ls[i] > m0) { m0 = ls[i]; i0 = i; }
            int i1 = -1; float m1 = -INFINITY;
#pragma unroll
            for (int i = 0; i < 4; ++i) if (i != i0 && ls[i] > m1) { m1 = ls[i]; i1 = i; }
            const float e1 = __expf(m1 - m0), w0 = pg / (1.f + e1), w1 = pg * e1 / (1.f + e1);
            const int ex0 = gs * 4 + i0, ex1 = gs * 4 + i1;
            toke[r * 2] = ex0; toke[r * 2 + 1] = ex1; tokw[r * 2] = w0; tokw[r * 2 + 1] = w1;
            atomicAdd(&hist[ex0], 1); atomicAdd(&hist[ex1], 1);
        }
        };
    {   const int r0 = (l + 1 < NL ? 0 : LC) + bid * NWV + wid, rs = nb * NWV;
        float4 ya[4], xa[4], yb[4], xb[4];
        if (r0 < T) ld(r0, ya, xa);
        for (int r = r0; r < T; r += 2 * rs) {
            if (r + rs < T) ld(r + rs, yb, xb);
            proc(r, ya, xa);
            if (r + rs < T) { if (r + 2 * rs < T) ld(r + 2 * rs, ya, xa); proc(r + rs, yb, xb); }
        } }
    __syncthreads();
    if (tidx < 16 && hist[tidx] != 0) atomicAdd(&cnt[tidx], hist[tidx]);
}

__device__ __forceinline__ void moe_offsets(const int* cnt, int* off) {
    int a = 0;
#pragma unroll
    for (int e = 0; e < 16; ++e) { off[e] = a; a += (cnt[e] + 255) & ~255; }
    off[16] = a;
}
__device__ __forceinline__ int moe_expert_of(const int* off, int j) {
    int e = 0;
#pragma unroll
    for (int k = 1; k < 16; ++k) e += (j >= off[k]) ? 1 : 0;
    return e;
}
__device__ __forceinline__ void st_moe_build(const KP& p, int l, int bid, int nb, char* lds) {
    const int tidx = opaque_tid();
    int* cnt = WSP(int, OFF_CNT); int* cnt2 = cnt + 16;
    const int* toke = WSP(int, OFF_TOKE); const float* tokw = WSP(float, OFF_TOKW); int* toks = WSP(int, OFF_TOKS);
    int* sltok = WSP(int, OFF_SLTOK); float* slw = WSP(float, OFF_SLW);
    int* lcnt = (int*)lds; int* lbase = lcnt + 16;
    int off[17]; moe_offsets(cnt, off);
    const int first = (l + 1 < NL ? 0 : 2 * LC), total = 2 * T - first, per = (total + nb - 1) / nb;
    const int beg = first + bid * per, end = min(beg + per, 2 * T);
    __syncthreads();
    if (tidx < 16) lcnt[tidx] = 0;
    __syncthreads();
    const int idx = beg + tidx; const bool act = (tidx < per) && (idx < end);
    int e = 0, rank = 0;
    if (act) { e = toke[idx]; rank = atomicAdd(&lcnt[e], 1); }
    __syncthreads();
    if (tidx < 16) lbase[tidx] = lcnt[tidx] ? atomicAdd(&cnt2[tidx], lcnt[tidx]) : 0;
    __syncthreads();
    if (act) {
        int o = 0;
#pragma unroll
        for (int k = 0; k < 16; ++k) o = (e == k) ? off[k] : o;
        const int pos = o + lbase[e] + rank;
        sltok[pos] = idx >> 1; slw[pos] = tokw[idx]; toks[idx] = pos;
    }
}
__device__ __forceinline__ void st_moe_up(const KP& p, int bid, int nb, char* lds) {
    const int tidx = opaque_tid();
    const int* cnt = WSP(int, OFF_CNT); const int* sltok = WSP(int, OFF_SLTOK);
    const bf16_t* H2 = WSP(bf16_t, OFF_H); const bf16_t* Wg = WSP(bf16_t, OFF_WB + WB_EG); const bf16_t* Wu = WSP(bf16_t, OFF_WB + WB_EU); bf16_t* Hid = WSP(bf16_t, OFF_HID);
    int off[17]; moe_offsets(cnt, off);
    const int ntiles = (off[16] >> 8) * 8;
    for (int L = bid; L < ntiles; L += nb) {
        const int mt = L >> 3, nt = L & 7, e = moe_expert_of(off, mt * 256);
        acc_t acc; acc_zero(acc);
        gemm_core(acc, [&](int r) { return H2 + (size_t)sltok[mt * 256 + r] * 1024; },
                  [&](int r) { const int wn = r >> 6, in = (r >> 4) & 3, j = r & 15; return ((in & 1) ? Wu : Wg) + ((size_t)e * 512 + nt * 64 + wn * 32 + (in >> 1) * 16 + j) * 1024; }, 1024, lds);
        const int lane = tidx & 63, wid = tidx >> 6, wm = wid >> 1, wn = wid & 1, fr = lane & 15, g = lane >> 4;
#pragma unroll
        for (int im = 0; im < 4; ++im)
#pragma unroll
            for (int q = 0; q < 2; ++q) {
                const f32x4 gt = acc[2 * q][im], up = acc[2 * q + 1][im];
                uint2 o; o.x = pack2(siluf_(gt[0]) * up[0], siluf_(gt[1]) * up[1]); o.y = pack2(siluf_(gt[2]) * up[2], siluf_(gt[3]) * up[3]);
                *(uint2*)(Hid + (size_t)(mt * 256 + wm * 64 + 16 * im + fr) * 512 + nt * 64 + wn * 32 + 16 * q + 4 * g) = o;
            }
    }
}
__device__ __forceinline__ void st_moe_down(const KP& p, int bid, int nb, char* lds) {
    const int tidx = opaque_tid();
    const int* cnt = WSP(int, OFF_CNT); const float* slw = WSP(float, OFF_SLW);
    const bf16_t* Hid = WSP(bf16_t, OFF_HID); const bf16_t* Wd = WSP(bf16_t, OFF_WB + WB_ED); bf16_t* Sl = WSP(bf16_t, OFF_SLOTS);
    int off[17]; moe_offsets(cnt, off);
    const int ntiles = (off[16] >> 8) * 8;
    for (int L = bid; L < ntiles; L += nb) {
        const int mt = L >> 3, nt = L & 7, e = moe_expert_of(off, mt * 256);
        acc_t acc; acc_zero(acc);
        gemm_core(acc, [&](int r) { return Hid + (size_t)(mt * 256 + r) * 512; }, [&](int r) { return Wd + ((size_t)e * 1024 + nt * 128 + r) * 512; }, 512, lds);
        acc_visit(acc, [&](int ml, int nl, f32x4 v) {
            const float w = slw[mt * 256 + ml];
            *(uint2*)(Sl + (size_t)(mt * 256 + ml) * 1024 + nt * 128 + nl) = pack4(v * w); });
    }
}
__device__ __forceinline__ void st_postffn(const KP& p, int l, int bid, int nb) {
    const int tidx = opaque_tid();
    const int lane = tidx & 63, wid = tidx >> 6;
    const bf16_t* Sl = WSP(bf16_t, OFF_SLOTS); const int* toks = WSP(int, OFF_TOKS);
    const float* gpost = p.in(I_GPOSTFFN) + l * D;
    const bool next = (l + 1 < NL);
    bf16_t* Hb = WSP(bf16_t, OFF_H); const float* gpre = p.in(I_GPREMIX) + (next ? l + 1 : l) * D;
    auto ld = [&](int r, uint2 (&a)[4], uint2 (&b)[4], float4 (&x)[4]) __attribute__((always_inline)) {
        const bf16_t* s0 = Sl + (size_t)toks[r * 2] * 1024; const bf16_t* s1 = Sl + (size_t)toks[r * 2 + 1] * 1024; const float* xs = xrow_c(p, r);
#pragma unroll
        for (int i = 0; i < 4; ++i) { const int c = i * 256 + lane * 4; a[i] = *(const uint2*)(s0 + c); b[i] = *(const uint2*)(s1 + c); x[i] = *(const float4*)(xs + c); }
    };
    auto proc = [&](int r, uint2 (&a)[4], uint2 (&b)[4], float4 (&xq)[4]) __attribute__((always_inline)) {
        float* xr = xrow(p, r);
        const float* md = WSP(float, OFF_MOD) + (size_t)(l * 2 + (r < LC ? 1 : 0)) * 6144;
        float v[16]; float ss = 0.f;
#pragma unroll
        for (int i = 0; i < 4; ++i) {
            v[4 * i] = bflo(a[i].x) + bflo(b[i].x); v[4 * i + 1] = bfhi(a[i].x) + bfhi(b[i].x); v[4 * i + 2] = bflo(a[i].y) + bflo(b[i].y); v[4 * i + 3] = bfhi(a[i].y) + bfhi(b[i].y);
            ss += v[4 * i] * v[4 * i] + v[4 * i + 1] * v[4 * i + 1] + v[4 * i + 2] * v[4 * i + 2] + v[4 * i + 3] * v[4 * i + 3]; }
        ss = wave_sum(ss);
        const float rstd = rsqrtf(ss * (1.0f / D) + EPS);
        float4 xs[4]; float ss2 = 0.f;
#pragma unroll
        for (int i = 0; i < 4; ++i) { const int c = i * 256 + lane * 4;
            const float4 gg = *(const float4*)(gpost + c), ga = *(const float4*)(md + 5120 + c); float4 x = xq[i];
            x.x += ga.x * v[4 * i] * rstd * gg.x; x.y += ga.y * v[4 * i + 1] * rstd * gg.y; x.z += ga.z * v[4 * i + 2] * rstd * gg.z; x.w += ga.w * v[4 * i + 3] * rstd * gg.w;
            *(float4*)(xr + c) = x; xs[i] = x; ss2 += x.x * x.x + x.y * x.y + x.z * x.z + x.w * x.w; }
        if (next) {
            ss2 = wave_sum(ss2);
            const float rstd2 = rsqrtf(ss2 * (1.0f / D) + EPS);
            const float* md2 = WSP(float, OFF_MOD) + (size_t)((l + 1) * 2 + (r < LC ? 1 : 0)) * 6144;
#pragma unroll
            for (int i = 0; i < 4; ++i) { const int c = i * 256 + lane * 4;
                const float4 gg = *(const float4*)(gpre + c), sh = *(const float4*)(md2 + c), sc = *(const float4*)(md2 + 1024 + c);
                uint2 o; o.x = pack2(xs[i].x * rstd2 * gg.x * (1.f + sc.x) + sh.x, xs[i].y * rstd2 * gg.y * (1.f + sc.y) + sh.y);
                o.y = pack2(xs[i].z * rstd2 * gg.z * (1.f + sc.z) + sh.z, xs[i].w * rstd2 * gg.w * (1.f + sc.w) + sh.w);
                *(uint2*)(Hb + (size_t)r * D + c) = o; }
        }
    };
    {   const int r0 = (l + 1 < NL ? 0 : LC) + bid * NWV + wid, rs = nb * NWV;
        uint2 aa[4], ab[4], ba[4], bb[4]; float4 xa[4], xb[4];
        if (r0 < T) ld(r0, aa, ab, xa);
        for (int r = r0; r < T; r += 2 * rs) {
            if (r + rs < T) ld(r + rs, ba, bb, xb);
            proc(r, aa, ab, xa);
            if (r + rs < T) { if (r + 2 * rs < T) ld(r + 2 * rs, aa, ab, xa); proc(r + rs, ba, bb, xb); }
        } }
}

__device__ __forceinline__ void gsync(unsigned* bar, unsigned& epoch) {
    asm volatile("s_waitcnt vmcnt(0) lgkmcnt(0)" ::: "memory");
    __syncthreads();
    if (threadIdx.x == 0) {
        __builtin_amdgcn_fence(__ATOMIC_RELEASE, "agent");
        asm volatile("s_waitcnt vmcnt(0)" ::: "memory");
        epoch += 1;
        __hip_atomic_fetch_add(bar, 1u, __ATOMIC_RELAXED, __HIP_MEMORY_SCOPE_AGENT);
        const unsigned target = epoch * gridDim.x;
        while (__hip_atomic_load(bar, __ATOMIC_RELAXED, __HIP_MEMORY_SCOPE_AGENT) < target) __builtin_amdgcn_s_sleep(2);
        __builtin_amdgcn_fence(__ATOMIC_ACQUIRE, "agent");
        asm volatile("s_waitcnt vmcnt(0)" ::: "memory");
    }
    __syncthreads();
}

__global__ void __launch_bounds__(NTH) k_mega(Params p_unused) {
    KP p; p.k = (kparams_t)__builtin_amdgcn_kernarg_segment_ptr();
    __shared__ __attribute__((aligned(16))) char lds[LDS_BYTES]; float* smem = (float*)lds;
    cg::grid_group grid = cg::this_grid();
    grid.sync();
    const int bid = blockIdx.x, nb = gridDim.x;
    unsigned* bar = WSP(unsigned, OFF_BAR); unsigned epoch = 0;
#define GS() gsync(bar, epoch)
    st_prologue(p, bid, nb, smem); st_conv(p, 0, bid, nb, smem); st_s5_tables(p, 0, bid, nb, lds); GS();
    st_modulate(p, 0, bid, nb); GS();
#pragma unroll 1
    for (int l = 0; l < NL; ++l) {
        st_gemm_in(p, l, bid, nb, lds); GS();
        st_s5_local(p, l, bid, nb); st_s5_fgemm(p, bid, nb, lds); GS();
        st_s5_carry(p, l, bid, nb, lds); st_proj2<0>(p, l, bid, nb, lds); GS();
        st_s5_ygemm(p, l, bid, nb, lds); st_s5_ctx_y(p, l, bid, nb); st_ropeq(p, bid, nb, lds); GS();
        st_proj2<1>(p, l, bid, nb, lds); st_attn(p, l, bid, nb, lds); GS();
        st_merge(p, l, bid, nb, lds); GS();
        st_wout(p, l, bid, nb, lds); st_conv_experts(p, l, bid, nb, smem); GS();
        st_postmix(p, l, bid, nb, lds); GS();
        st_moe_build(p, l, bid, nb, lds); GS();
        st_moe_up(p, bid, nb, lds); GS();
        st_moe_down(p, bid, nb, lds); GS();
        st_postffn(p, l, bid, nb);
        if (l + 1 < NL) { st_conv(p, l + 1, bid, nb, smem); st_s5_tables(p, l + 1, bid, nb, lds); }
        GS();
    }
#undef GS
}

extern "C" void kernel_launch(void* const* d_in, const int* in_sizes, int n_in, void* d_out, int out_size, void* d_ws, size_t ws_size, hipStream_t stream) {
    Params p{};
    for (int i = 0; i < N_IN; ++i) p.in[i] = (const float*)d_in[i];
    p.out = (float*)d_out; p.ws = (char*)d_ws;
    if (ws_size < WS_NEED) { fprintf(stderr, "workspace too small: %zu < %zu\n", ws_size, (size_t)WS_NEED); return; }
    static int grid_blocks = 0;
    if (!grid_blocks) {
        int dev = 0, cus = 0, per_cu = 0;
        hipGetDevice(&dev);
        hipDeviceGetAttribute(&cus, hipDeviceAttributeMultiprocessorCount, dev);
        hipOccupancyMaxActiveBlocksPerMultiprocessor(&per_cu, k_mega, NTH, 0);
        if (per_cu > 1) per_cu = 1;
        if (per_cu < 1) per_cu = 1;
        grid_blocks = cus * per_cu;
    }
    hipMemsetAsync((char*)d_ws + OFF_BAR, 0, 256, stream);
    void* args[] = { &p };
    hipError_t e = hipLaunchCooperativeKernel((void*)k_mega, dim3(grid_blocks), dim3(NTH), args, 0, stream);
    if (e != hipSuccess) fprintf(stderr, "cooperative launch failed: %s (grid %d)\n", hipGetErrorString(e), grid_blocks);
}
```

```cpp
#include <hip/hip_runtime.h>
#include <hip/hip_cooperative_groups.h>
#include <cstdio>
#include <cstdint>
#include <type_traits>
namespace cg = cooperative_groups;


typedef unsigned short bf16_t;
typedef short bf16x8 __attribute__((ext_vector_type(8)));
typedef float f32x16 __attribute__((ext_vector_type(16)));
typedef float f32x4 __attribute__((ext_vector_type(4)));
typedef unsigned u32x4 __attribute__((ext_vector_type(4)));
constexpr int NTH = 512, NWV = 8;
#ifndef REP_CONV
#define REP_CONV 1
#endif
#ifndef REP_G1
#define REP_G1 1
#endif
#ifndef REP_G2
#define REP_G2 1
#endif
#ifndef REP_G3
#define REP_G3 1
#endif
#ifndef REP_S5
#define REP_S5 1
#endif
#ifndef REP_ATTN
#define REP_ATTN 1
#endif

constexpr int D = 1024, S = 16384, LC = 256, T = S + LC, NL = 2;
constexpr int NIN = 4768, NINP = 4864;
constexpr int PP = 1696;
constexpr int C_GQ = 0, C_GK = 512, C_GV = 640, C_CQ = 768, C_CKV = 1024, C_KR = 1152, C_SSM = 1184, C_GATE = 1696;
__host__ __device__ constexpr int win_col_old(int n) {
    return n < 512 ? 928 + n : n < 640 ? 1440 + (n - 512) : n < 768 ? 1568 + (n - 640) : n < 1024 ? (n - 768) : n < 1152 ? 256 + (n - 1024) : n < 1184 ? 384 + (n - 1152) : n < 1696 ? 416 + (n - 1184) : n;
}
constexpr int TP = 2 * T + 16 * 256;
constexpr float EPS = 1e-6f;
constexpr float LOG2E = 1.4426950408889634f;
constexpr float SC_MLA = 0.10206207261596575f * LOG2E, SC_GQA = 0.125f * LOG2E;

enum { I_X = 0, I_C, I_CTX, I_CCTX, I_WMOD, I_BMOD, I_GPREMIX, I_GPOSTMIX, I_GPREFFN, I_GPOSTFFN, I_WIN, I_GCQ, I_GCKV, I_WUQ, I_WUKV,
       I_GQN, I_GKN, I_ARE, I_AIM, I_LOGDT, I_BRE, I_BIM, I_CRE, I_CIM, I_SSMD, I_WGLU, I_BGLU, I_WBRM, I_WBRS, I_WBRG, I_WOUT,
       I_WGROUP, I_BGROUP, I_WROUTER, I_BROUTER, I_WEG, I_WEU, I_WED, N_IN };

constexpr size_t al256(size_t x) { return (x + 255) & ~(size_t)255; }
constexpr size_t WB_IN = 0;
constexpr size_t WB_UQ = WB_IN + (size_t)NINP * 1024 * 2;
constexpr size_t WB_UKV = WB_UQ + (size_t)768 * 256 * 2;
constexpr size_t WB_GLU = WB_UKV + (size_t)1024 * 128 * 2;
constexpr size_t WB_BR = WB_GLU + (size_t)512 * 512 * 2;
constexpr size_t WB_OUT = WB_BR + (size_t)3 * 1024 * 512 * 2;
constexpr size_t WB_EG = WB_OUT + (size_t)1024 * 1024 * 2;
constexpr size_t WB_EU = WB_EG + (size_t)16 * 512 * 1024 * 2;
constexpr size_t WB_ED = WB_EU + (size_t)16 * 512 * 1024 * 2;
constexpr size_t WB_BYTES = WB_ED + (size_t)16 * 1024 * 512 * 2;

constexpr size_t OFF_WB = 0;
constexpr size_t OFF_P = al256(OFF_WB + WB_BYTES);
constexpr size_t P_BYTES = (size_t)T * NIN * 2;
constexpr size_t OFF_GS = OFF_P + (size_t)T * PP * 2;
constexpr size_t OFF_Y = OFF_P;
constexpr size_t OFF_SLOTS = OFF_P;
constexpr size_t OFF_HID = OFF_P + (size_t)TP * 1024 * 2;
constexpr size_t OFF_H = al256(OFF_P + P_BYTES);
constexpr size_t OFF_KN = al256(OFF_H + (size_t)T * 1024 * 2);
constexpr size_t OFF_V = al256(OFF_KN + (size_t)T * 512 * 2);
constexpr size_t OFF_OM = al256(OFF_V + (size_t)T * 512 * 2);
constexpr size_t OFF_OG = OFF_OM + (size_t)T * 512 * 2;
constexpr size_t OFF_OS = OFF_OG + (size_t)T * 512 * 2;
constexpr size_t OFF_XC = al256(OFF_OS + (size_t)T * 512 * 2);
constexpr size_t OFF_MOD = al256(OFF_XC + (size_t)LC * 1024 * 4);
constexpr size_t OFF_TOKE = al256(OFF_MOD + (size_t)NL * 2 * 6144 * 4);
constexpr size_t OFF_TOKW = al256(OFF_TOKE + (size_t)T * 2 * 4);
constexpr size_t OFF_TOKS = al256(OFF_TOKW + (size_t)T * 2 * 4);
constexpr size_t OFF_SLTOK = al256(OFF_TOKS + (size_t)T * 2 * 4);
constexpr size_t OFF_SLW = al256(OFF_SLTOK + (size_t)TP * 4);
constexpr size_t OFF_CNT = al256(OFF_SLW + (size_t)TP * 4);
constexpr size_t OFF_S5 = al256(OFF_CNT + 256);
constexpr size_t OFF_ROPE = al256(OFF_S5 + (size_t)(T / 64) * 4096 * 8);
constexpr size_t OFF_SSQ = al256(OFF_ROPE + 256 * 24 * 8);
constexpr size_t OFF_SSMG = al256(OFF_SSQ + (size_t)T * 8 * 4);
constexpr size_t OFF_BAR = al256(OFF_SSMG + (size_t)32 * T * 16 * 2);
constexpr size_t WS_NEED = al256(OFF_BAR + 256);
static_assert(OFF_HID + (size_t)TP * 512 * 2 <= OFF_P + P_BYTES, "overlay");
static_assert((size_t)T * 1024 * 4 <= P_BYTES, "overlay Y");
static_assert(WS_NEED < 384000000ull, "ws");

struct Params {
    const float* in[N_IN];
    float* out;
    char* ws;
};
typedef const __attribute__((address_space(4))) Params* kparams_t;
struct KP {
    kparams_t k;
    __device__ __forceinline__ const float* in(int i) const { return *(const float* const volatile __attribute__((address_space(4)))*)(&k->in[i]); }
    __device__ __forceinline__ float* out() const { return *(float* const volatile __attribute__((address_space(4)))*)(&k->out); }
    __device__ __forceinline__ char* ws() const { return *(char* const volatile __attribute__((address_space(4)))*)(&k->ws); }
};

__device__ __forceinline__ float bf2f(bf16_t v) { return __uint_as_float(((unsigned)v) << 16); }
typedef __bf16 bf16x2_t __attribute__((ext_vector_type(2)));
__device__ __forceinline__ bf16_t f2bf(float f) { const __bf16 b = (__bf16)f; return __builtin_bit_cast(bf16_t, b); }
__device__ __forceinline__ float bflo(unsigned u) { return __uint_as_float(u << 16); }
__device__ __forceinline__ float bfhi(unsigned u) { return __uint_as_float(u & 0xFFFF0000u); }
__device__ __forceinline__ unsigned pack2(float lo, float hi) { bf16x2_t v; v[0] = (__bf16)lo; v[1] = (__bf16)hi; return __builtin_bit_cast(unsigned, v); }
__device__ __forceinline__ float wave_sum(float v) {
#pragma unroll
    for (int o = 32; o > 0; o >>= 1) v += __shfl_xor(v, o);
    return v;
}
__device__ __forceinline__ float xhalf_max(float m) { auto rr = __builtin_amdgcn_permlane32_swap(__float_as_uint(m), __float_as_uint(m), false, false); return fmaxf(__uint_as_float(rr[0]), __uint_as_float(rr[1])); }
__device__ __forceinline__ float xhalf_sum(float m) { auto rr = __builtin_amdgcn_permlane32_swap(__float_as_uint(m), __float_as_uint(m), false, false); return __uint_as_float(rr[0]) + __uint_as_float(rr[1]); }
__device__ __forceinline__ void rope_tab(float& a, float& b, float2 cs) { const float na = a * cs.x - b * cs.y, nb_ = a * cs.y + b * cs.x; a = na; b = nb_; }
__device__ __forceinline__ float transpose_reduce16(const float (&t16)[16], int lane) {
    float t8[8], t4[4], t2[2];
#pragma unroll
    for (int i = 0; i < 8; ++i) { const float a = t16[2 * i], b = t16[2 * i + 1]; const bool o = lane & 1; const float keep = o ? b : a, send = o ? a : b; t8[i] = keep + __shfl_xor(send, 1); }
#pragma unroll
    for (int i = 0; i < 4; ++i) { const float a = t8[2 * i], b = t8[2 * i + 1]; const bool o = lane & 2; const float keep = o ? b : a, send = o ? a : b; t4[i] = keep + __shfl_xor(send, 2); }
#pragma unroll
    for (int i = 0; i < 2; ++i) { const float a = t4[2 * i], b = t4[2 * i + 1]; const bool o = lane & 4; const float keep = o ? b : a, send = o ? a : b; t2[i] = keep + __shfl_xor(send, 4); }
    float y; { const float a = t2[0], b = t2[1]; const bool o = lane & 8; const float keep = o ? b : a, send = o ? a : b; y = keep + __shfl_xor(send, 8); }
    y += __shfl_xor(y, 16); y += __shfl_xor(y, 32);
    return y;
}
__device__ __forceinline__ float sigmoidf_(float x) { return __builtin_amdgcn_rcpf(1.0f + __builtin_amdgcn_exp2f(-LOG2E * x)); }
__device__ __forceinline__ float siluf_(float x) { return x * __builtin_amdgcn_rcpf(1.0f + __builtin_amdgcn_exp2f(-LOG2E * x)); }
__device__ __forceinline__ float gelu_tanh(float x) {
    const float u = 0.7978845608028654f * (x + 0.044715f * x * x * x);
    return x * __builtin_amdgcn_rcpf(1.0f + __builtin_amdgcn_exp2f(-2.0f * LOG2E * u));
}
__device__ __forceinline__ float dot8(uint4 a, uint4 b, float acc) {
    acc = fmaf(bflo(a.x), bflo(b.x), acc); acc = fmaf(bfhi(a.x), bfhi(b.x), acc);
    acc = fmaf(bflo(a.y), bflo(b.y), acc); acc = fmaf(bfhi(a.y), bfhi(b.y), acc);
    acc = fmaf(bflo(a.z), bflo(b.z), acc); acc = fmaf(bfhi(a.z), bfhi(b.z), acc);
    acc = fmaf(bflo(a.w), bflo(b.w), acc); acc = fmaf(bfhi(a.w), bfhi(b.w), acc);
    return acc;
}
__device__ __forceinline__ float dotrow(const bf16_t* a, const bf16_t* b, int K) {
    float acc = 0.f;
    const uint4* a4 = (const uint4*)a; const uint4* b4 = (const uint4*)b;
    for (int k = 0; k < K / 8; ++k) acc = dot8(a4[k], b4[k], acc);
    return acc;
}

__device__ __forceinline__ int opaque_tid() { int t = threadIdx.x; asm volatile("" : "+v"(t)); return t; }
#define WSP(type, off) ((type*)(p.ws() + (off)))
#define SSMU(g, r) (WSP(const bf16_t, OFF_SSMG) + ((size_t)(g) * T + (r)) * 16)

template <class AF, class BF, class EF>
__device__ __forceinline__ void gemm_naive(int M, int N, int K, AF arow, BF brow, EF epi, int bid, int nb) {
    const int tidx = opaque_tid();
    const long total = (long)M * N;
    for (long idx = (long)bid * NTH + tidx; idx < total; idx += (long)nb * NTH) {
        const int m = (int)(idx / N), n = (int)(idx % N);
        const float acc = dotrow(arow(m), brow(m, n), K);
        epi(m, n, acc);
    }
}

constexpr int G_A_BYTES = 256 * 128, G_W_BYTES = 128 * 128, G_BUF = G_A_BYTES + G_W_BYTES;
constexpr int LDS_BYTES = 3 * G_BUF;
#define MFMA32(a, b, c) __builtin_amdgcn_mfma_f32_32x32x16_bf16(a, b, c, 0, 0, 0)

#define GLDS16(gptr, lptr) __builtin_amdgcn_global_load_lds((const __attribute__((address_space(1))) void*)(gptr), (__attribute__((address_space(3))) void*)(lptr), 16, 0, 0)
typedef f32x4 acc_t[4][4];
#define MFMA16(a, b, c) __builtin_amdgcn_mfma_f32_16x16x32_bf16(a, b, c, 0, 0, 0)
template <class APTR, class WPTR>
__device__ __forceinline__ void gemm_core_g(acc_t& acc, APTR aptr, WPTR wptr, int nk, char* lds) {
    const int tidx = opaque_tid();
    const int tid = tidx, lane = tid & 63, wid = tid >> 6, wm = wid >> 1, wn = wid & 1, fr = lane & 15, g = lane >> 4;
    const int wu = __builtin_amdgcn_readfirstlane(wid);
    char* sdst = lds + wu * 1024;
    const int xoff = (wm * 64 + fr) * 128, woff = G_A_BYTES + (wn * 64 + fr) * 128, sw7 = (fr >> 1) & 7;
    asm volatile("s_waitcnt vmcnt(0)" ::: "memory");
#pragma unroll
    for (int i = 0; i < 4; ++i) GLDS16(aptr(i, 0), sdst + i * 8192);
#pragma unroll
    for (int i = 0; i < 2; ++i) GLDS16(wptr(i, 0), sdst + G_A_BYTES + i * 8192);
    if (nk > 1) {
#pragma unroll
        for (int i = 0; i < 4; ++i) GLDS16(aptr(i, 1), sdst + G_BUF + i * 8192);
#pragma unroll
        for (int i = 0; i < 2; ++i) GLDS16(wptr(i, 1), sdst + G_BUF + G_A_BYTES + i * 8192);
        asm volatile("s_waitcnt vmcnt(6)" ::: "memory");
    } else asm volatile("s_waitcnt vmcnt(0)" ::: "memory");
    __builtin_amdgcn_s_barrier();
    int slot = 0;
    for (int kt = 0; kt < nk; ++kt) {
        const char* cur = lds + slot * G_BUF;
        const int s2 = slot >= 1 ? slot - 1 : 2;
        const bool more2 = (kt + 2 < nk);
        char* nxt = sdst + s2 * G_BUF;
#pragma unroll
        for (int ks = 0; ks < 2; ++ks) {
            const int co = ((ks * 4 + g) ^ sw7) << 4;
            bf16x8 x[4], w[4];
#pragma unroll
            for (int i = 0; i < 4; ++i) { x[i] = *(const bf16x8*)(cur + xoff + i * 16 * 128 + co); w[i] = *(const bf16x8*)(cur + woff + i * 16 * 128 + co); }
#pragma unroll
            for (int in = 0; in < 4; ++in)
#pragma unroll
                for (int im = 0; im < 4; ++im) acc[in][im] = MFMA16(w[in], x[im], acc[in][im]);
            __builtin_amdgcn_sched_barrier(0);
            if (more2) {
                if (ks == 0) { GLDS16(aptr(0, kt + 2), nxt); GLDS16(aptr(1, kt + 2), nxt + 8192); GLDS16(aptr(2, kt + 2), nxt + 2 * 8192); }
                else { GLDS16(aptr(3, kt + 2), nxt + 3 * 8192); GLDS16(wptr(0, kt + 2), nxt + G_A_BYTES); GLDS16(wptr(1, kt + 2), nxt + G_A_BYTES + 8192); }
            }
            __builtin_amdgcn_sched_barrier(0);
        }
        if (more2) asm volatile("s_waitcnt vmcnt(6) lgkmcnt(0)" ::: "memory");
        else asm volatile("s_waitcnt vmcnt(0) lgkmcnt(0)" ::: "memory");
        __builtin_amdgcn_s_barrier();
        slot = slot == 2 ? 0 : slot + 1;
    }
}
template <class AROW, class WROW>
__device__ __forceinline__ void gemm_core(acc_t& acc, AROW arow, WROW wrow, int K, char* lds) {
    const int tidx = opaque_tid();
    const int srow = tidx >> 3, gch = (tidx & 7) ^ ((srow >> 1) & 7);
    const bf16_t* pa[4]; const bf16_t* pw[2];
#pragma unroll
    for (int i = 0; i < 4; ++i) pa[i] = arow(srow + 64 * i) + gch * 8;
#pragma unroll
    for (int i = 0; i < 2; ++i) pw[i] = wrow(srow + 64 * i) + gch * 8;
    gemm_core_g(acc, [&](int i, int kt) { return pa[i] + kt * 64; }, [&](int i, int kt) { return pw[i] + kt * 64; }, K >> 6, lds);
}
__device__ __forceinline__ void acc_zero(acc_t& acc) {
#pragma unroll
    for (int a = 0; a < 4; ++a)
#pragma unroll
        for (int b = 0; b < 4; ++b) { acc[a][b][0] = 0.f; acc[a][b][1] = 0.f; acc[a][b][2] = 0.f; acc[a][b][3] = 0.f; }
}
template <class F>
__device__ __forceinline__ void acc_visit(const acc_t& acc, F f) {
    const int tidx = opaque_tid();
    const int lane = tidx & 63, wid = tidx >> 6, wm = wid >> 1, wn = wid & 1, fr = lane & 15, g = lane >> 4;
#pragma unroll
    for (int in = 0; in < 4; ++in)
#pragma unroll
        for (int im = 0; im < 4; ++im) f(wm * 64 + 16 * im + fr, wn * 64 + 16 * in + 4 * g, acc[in][im]);
}
template <class F>
__device__ __forceinline__ void acc_visit_add(const acc_t& acc, acc_t& tot, F f) {
    const int tidx = opaque_tid();
    const int lane = tidx & 63, wid = tidx >> 6, wm = wid >> 1, wn = wid & 1, fr = lane & 15, g = lane >> 4;
#pragma unroll
    for (int in = 0; in < 4; ++in)
#pragma unroll
        for (int im = 0; im < 4; ++im) tot[in][im] += f(wm * 64 + 16 * im + fr, wn * 64 + 16 * in + 4 * g, acc[in][im]);
}
template <class APTR, class WPTR>
__device__ __forceinline__ void gemm_core256(acc_t (&acc)[2], APTR aptr, WPTR wptr, int nt, char* lds) {
    const int tid = opaque_tid(), lane = tid & 63, wid = tid >> 6, wr = wid >> 2, wc = wid & 3, fr = lane & 15, g = lane >> 4;
    const int wu = __builtin_amdgcn_readfirstlane(wid);
    char* sdst = lds + wu * 1024;
    const int sw7 = (fr >> 1) & 7;
    typedef const __attribute__((address_space(3))) char* l3p; typedef const __attribute__((address_space(3))) bf16x8* l3v;
    l3p wf0 = (l3p)lds + (wr * 64 + fr) * 128 + ((g ^ sw7) << 4); l3p wf1 = (l3p)lds + (wr * 64 + fr) * 128 + (((4 + g) ^ sw7) << 4);
    l3p xf0 = (l3p)lds + 4 * 16384 + (wc * 32 + fr) * 128 + ((g ^ sw7) << 4); l3p xf1 = (l3p)lds + 4 * 16384 + (wc * 32 + fr) * 128 + (((4 + g) ^ sw7) << 4);
    asm volatile("" : "+v"(wf0), "+v"(wf1), "+v"(xf0), "+v"(xf1));
#define C2_SW(b, h) (((b) * 2 + (h)) * 16384)
#define C2_STG_W(b, h, kt) do { GLDS16(wptr(h, 0, kt), sdst + C2_SW(b, h)); GLDS16(wptr(h, 1, kt), sdst + C2_SW(b, h) + 8192); } while (0)
#define C2_STG_X(b, h, kt) do { GLDS16(aptr(h, 0, kt), sdst + 4 * 16384 + C2_SW(b, h)); GLDS16(aptr(h, 1, kt), sdst + 4 * 16384 + C2_SW(b, h) + 8192); } while (0)
#define C2_LDW(b, h) do { _Pragma("unroll") for (int m = 0; m < 4; ++m) { Wt[m][0] = *(l3v)(wf0 + C2_SW(b, h) + m * 2048); Wt[m][1] = *(l3v)(wf1 + C2_SW(b, h) + m * 2048); } } while (0)
#define C2_LDX(dst, b, h) do { _Pragma("unroll") for (int n = 0; n < 2; ++n) { dst[n][0] = *(l3v)(xf0 + C2_SW(b, h) + n * 2048); dst[n][1] = *(l3v)(xf1 + C2_SW(b, h) + n * 2048); } } while (0)
#define C2_MMA(nh, mh, Xf) do { __builtin_amdgcn_s_setprio(1); \
        _Pragma("unroll") for (int m = 0; m < 4; ++m) _Pragma("unroll") for (int n = 0; n < 2; ++n) _Pragma("unroll") for (int k = 0; k < 2; ++k) \
            acc[nh][m][2 * (mh) + n] = MFMA16(Wt[m][k], Xf[n][k], acc[nh][m][2 * (mh) + n]); \
        __builtin_amdgcn_s_setprio(0); } while (0)
#define C2_WV(n) asm volatile("s_waitcnt vmcnt(" #n ")" ::: "memory")
#define C2_WL(n) asm volatile("s_waitcnt lgkmcnt(" #n ")" ::: "memory")
#define C2_BAR __builtin_amdgcn_s_barrier()
#define C2_SCHED __builtin_amdgcn_sched_barrier(0)
    bf16x8 Wt[4][2], X0[2][2], X1[2][2];
    C2_WV(0);
    C2_STG_X(0, 0, 0); C2_STG_W(0, 0, 0); C2_STG_X(0, 1, 0); C2_STG_W(0, 1, 0);
    if (wu >= 4) C2_BAR;
    C2_WV(4); C2_BAR;
    C2_STG_X(1, 0, 1); C2_STG_W(1, 0, 1); C2_STG_X(1, 1, 1);
    C2_WV(6); C2_BAR;
#pragma unroll 1
    for (int t = 0; t < nt - 2; t += 2) {
        C2_LDX(X0, 0, 0); C2_SCHED; C2_LDW(0, 0); C2_STG_W(1, 1, t + 1);
        C2_WL(8); C2_BAR; C2_WL(0); C2_MMA(0, 0, X0); C2_BAR; C2_SCHED;
        C2_LDX(X1, 0, 1); C2_STG_X(0, 0, t + 2);
        C2_BAR; C2_WL(0); C2_MMA(0, 1, X1); C2_BAR;
        C2_LDW(0, 1); C2_STG_W(0, 0, t + 2);
        C2_BAR; C2_WL(0); C2_MMA(1, 0, X0); C2_BAR; C2_SCHED;
        C2_STG_X(0, 1, t + 2);
        C2_WV(6); C2_BAR; C2_MMA(1, 1, X1); C2_BAR;
        C2_LDX(X0, 1, 0); C2_SCHED; C2_LDW(1, 0); C2_STG_W(0, 1, t + 2);
        C2_WL(8); C2_BAR; C2_WL(0); C2_MMA(0, 0, X0); C2_BAR; C2_SCHED;
        C2_LDX(X1, 1, 1); C2_STG_X(1, 0, t + 3);
        C2_BAR; C2_WL(0); C2_MMA(0, 1, X1); C2_BAR;
        C2_LDW(1, 1); C2_STG_W(1, 0, t + 3);
        C2_BAR; C2_WL(0); C2_MMA(1, 0, X0); C2_BAR; C2_SCHED;
        C2_STG_X(1, 1, t + 3);
        C2_WV(6); C2_BAR; C2_MMA(1, 1, X1); C2_BAR;
    }
    {   C2_LDX(X0, 0, 0); C2_LDW(0, 0); C2_STG_W(1, 1, nt - 1);
        C2_BAR; C2_WL(0); C2_MMA(0, 0, X0); C2_BAR;
        C2_LDX(X1, 0, 1); C2_BAR; C2_WL(0); C2_MMA(0, 1, X1); C2_BAR;
        C2_LDW(0, 1); C2_WV(4); C2_BAR; C2_WL(0); C2_MMA(1, 0, X0); C2_MMA(1, 1, X1); C2_BAR; }
    {   C2_LDX(X0, 1, 0); C2_LDW(1, 0); C2_WV(2); C2_BAR; C2_WL(0); C2_MMA(0, 0, X0); C2_BAR;
        C2_LDX(X1, 1, 1); C2_WV(0); C2_BAR; C2_WL(0); C2_MMA(0, 1, X1); C2_BAR;
        C2_LDW(1, 1); C2_BAR; C2_WL(0); C2_MMA(1, 0, X0); C2_MMA(1, 1, X1); C2_BAR; }
    if (wu < 4) C2_BAR;
}
__device__ __forceinline__ void gemm_core256_dense(acc_t (&acc)[2], const bf16_t* xb, int xpitch, const bf16_t* wb, int wpitch, int K, char* lds) {
    const int tidx = opaque_tid();
    const int srow = tidx >> 3, gch = (tidx & 7) ^ ((srow >> 1) & 7);
    const unsigned vx = (unsigned)(srow * xpitch + gch * 8) * 2u, vw = (unsigned)(srow * wpitch + gch * 8) * 2u;
    auto upin = [](const char* q) { asm volatile("" : "+s"(q)); return q; };
    gemm_core256(acc, [&](int h, int i, int kt) { return (const bf16_t*)(upin((const char*)xb + ((size_t)(h * 128 + i * 64) * xpitch + kt * 64) * 2) + vx); },
                 [&](int h, int i, int kt) { return (const bf16_t*)(upin((const char*)wb + ((size_t)(h * 128 + i * 64) * wpitch + kt * 64) * 2) + vw); }, K >> 6, lds);
}
template <class F>
__device__ __forceinline__ void acc_visit2(const acc_t& acc, F f) {
    const int tidx = opaque_tid();
    const int lane = tidx & 63, wid = tidx >> 6, wr = wid >> 2, wc = wid & 3, fr = lane & 15, g = lane >> 4;
#pragma unroll
    for (int in = 0; in < 4; ++in)
#pragma unroll
        for (int im = 0; im < 4; ++im) f((im >> 1) * 128 + wc * 32 + (im & 1) * 16 + fr, wr * 64 + 16 * in + 4 * g, acc[in][im]);
}
__device__ __forceinline__ uint2 pack4(f32x4 v) { uint2 o; o.x = pack2(v[0], v[1]); o.y = pack2(v[2], v[3]); return o; }
__device__ __forceinline__ bool dense_tile(int it, int NT, bool with_ctx, int bid, int nb, int& mt, int& nt) {
    const int x = bid & 7, j = bid >> 3, jb = nb >> 3;
    int v = it * jb + j;
    if (v < 8 * NT) { mt = 1 + x * 8 + (v & 7); nt = v >> 3; return true; }
    if (!with_ctx) return false;
    v -= 8 * NT; nt = x + 8 * v; mt = 0;
    return nt < NT;
}

__device__ __forceinline__ void st_prologue(const KP& p, int bid, int nb, float* smem) {
    const int tidx = opaque_tid();
    const int tid = tidx;
    {   float2* t16 = WSP(float2, OFF_ROPE); float2* t8 = t16 + 256 * 16;
        for (int idx = bid * NTH + tid; idx < 256 * 24; idx += nb * NTH) {
            const bool big = idx < 256 * 16; const int j = big ? idx : idx - 256 * 16, half = big ? 16 : 8, pos = j / half, i = j % half;
            const float ang = (float)pos * powf(10000.0f, -(float)i / (float)half);
            float sn, cs; sincosf(ang, &sn, &cs);
            (big ? t16 : t8)[j] = make_float2(cs, sn);
        } }
    for (int k = tid; k < 1024; k += NTH) { smem[k] = siluf_(p.in(I_C)[k]); smem[1024 + k] = siluf_(p.in(I_CCTX)[k]); }
    __syncthreads();
    float* mod = WSP(float, OFF_MOD);
    float4* red = (float4*)(smem + 2048);
    for (int jb = bid; jb < 256; jb += nb) {
        const int l = jb >> 7, j0 = (jb & 127) * 48, jj = tid % 12, kk = tid / 12;
        float4 a0 = make_float4(0.f, 0.f, 0.f, 0.f), a1 = a0;
        if (kk < 42) {
            const float* w = p.in(I_WMOD) + (size_t)l * 1024 * 6144 + j0 + jj * 4;
            for (int k = kk; k < 1024; k += 42) { const float4 wv = *(const float4*)(w + (size_t)k * 6144); const float s0 = smem[k], s1 = smem[1024 + k];
                a0.x = fmaf(s0, wv.x, a0.x); a0.y = fmaf(s0, wv.y, a0.y); a0.z = fmaf(s0, wv.z, a0.z); a0.w = fmaf(s0, wv.w, a0.w);
                a1.x = fmaf(s1, wv.x, a1.x); a1.y = fmaf(s1, wv.y, a1.y); a1.z = fmaf(s1, wv.z, a1.z); a1.w = fmaf(s1, wv.w, a1.w); }
            red[(kk * 12 + jj) * 2] = a0; red[(kk * 12 + jj) * 2 + 1] = a1;
        }
        __syncthreads();
        if (tid < 24) {
            const int cj = tid >> 1, cond = tid & 1;
            float4 s = make_float4(0.f, 0.f, 0.f, 0.f);
            for (int q = 0; q < 42; ++q) { const float4 v = red[(q * 12 + cj) * 2 + cond]; s.x += v.x; s.y += v.y; s.z += v.z; s.w += v.w; }
            const float4 b = *(const float4*)(p.in(I_BMOD) + l * 6144 + j0 + cj * 4);
            s.x += b.x; s.y += b.y; s.z += b.z; s.w += b.w;
            *(float4*)(mod + (size_t)(l * 2 + cond) * 6144 + j0 + cj * 4) = s;
        }
        __syncthreads();
    }
}

template <bool IDN, class COLF, class KSF>
__device__ __forceinline__ void conv_t_g(const float* W, bf16_t* Wt, int K, int N, int Npad, int nmat, int bid, int nb, float* smem, COLF colf, KSF ksf) {
    const int tidx = opaque_tid();
    const int tid = tidx;
    const int tn = Npad / 64, tk = K / 64;
    const int ntile = tn * tk * nmat;
    for (int t = bid; t < ntile; t += nb) {
        const int mat = t / (tn * tk), r = t % (tn * tk), n0 = (r / tk) * 64, k0 = (r % tk) * 64;
        const float* Wm = W + (size_t)mat * K * N; bf16_t* Wtm = Wt + (size_t)mat * Npad * K;
        __syncthreads();
        {
            const int kk = tid >> 4, c4 = (tid & 15) * 4; const bool ok = (n0 + c4 < N); const int sc = ok ? colf(n0 + c4) : 0;
#pragma unroll
            for (int i = 0; i < 2; ++i) { float4 v = make_float4(0.f, 0.f, 0.f, 0.f); if (ok) v = *(const float4*)(Wm + (size_t)(k0 + kk + 32 * i) * N + sc); const float s = ksf(k0 + kk + 32 * i);
                float* d = smem + (kk + 32 * i) * 65 + c4; d[0] = v.x * s; d[1] = v.y * s; d[2] = v.z * s; d[3] = v.w * s; }
        }
        __syncthreads();
        {   const int nn = tid >> 3, kc = (tid & 7) * 8;
            float e[8];
#pragma unroll
            for (int j = 0; j < 8; ++j) e[j] = smem[(kc + j) * 65 + nn];
            uint4 o; o.x = pack2(e[0], e[1]); o.y = pack2(e[2], e[3]); o.z = pack2(e[4], e[5]); o.w = pack2(e[6], e[7]);
            *(uint4*)(Wtm + (size_t)(n0 + nn) * K + k0 + kc) = o; }
    }
    __syncthreads();
}
__device__ __forceinline__ void conv_t(const float* W, bf16_t* Wt, int K, int N, int Npad, int nmat, int bid, int nb, float* smem) {
    conv_t_g<true>(W, Wt, K, N, Npad, nmat, bid, nb, smem, [](int n) { return n; }, [](int) { return 1.0f; });
}
__device__ __forceinline__ void st_conv(const KP& p, int l, int bid, int nb, float* smem) {
    const int tidx = opaque_tid(); (void)tidx;
    bf16_t* wb = WSP(bf16_t, OFF_WB);
    conv_t_g<false>(p.in(I_WIN) + (size_t)l * 1024 * NIN, (bf16_t*)((char*)wb + WB_IN), 1024, NIN, NINP, 1, bid, nb, smem, [](int n) { return win_col_old(n); }, [](int) { return 1.0f; });
    {   const float* gcq = p.in(I_GCQ) + l * 256; const float* gckv = p.in(I_GCKV) + l * 128;
        conv_t_g<true>(p.in(I_WUQ) + (size_t)l * 256 * 768, (bf16_t*)((char*)wb + WB_UQ), 256, 768, 768, 1, bid, nb, smem, [](int n) { return n; }, [&](int k) { return gcq[k]; });
        conv_t_g<true>(p.in(I_WUKV) + (size_t)l * 128 * 1024, (bf16_t*)((char*)wb + WB_UKV), 128, 1024, 1024, 1, bid, nb, smem, [](int n) { return n; }, [&](int k) { return gckv[k]; }); }
    conv_t(p.in(I_WGLU) + (size_t)l * 512 * 512, (bf16_t*)((char*)wb + WB_GLU), 512, 512, 512, 1, bid, nb, smem);
    conv_t(p.in(I_WBRM) + (size_t)l * 512 * 1024, (bf16_t*)((char*)wb + WB_BR), 512, 1024, 1024, 1, bid, nb, smem);
    conv_t(p.in(I_WBRS) + (size_t)l * 512 * 1024, (bf16_t*)((char*)wb + WB_BR + (size_t)1024 * 512 * 2), 512, 1024, 1024, 1, bid, nb, smem);
    conv_t(p.in(I_WBRG) + (size_t)l * 512 * 1024, (bf16_t*)((char*)wb + WB_BR + (size_t)2 * 1024 * 512 * 2), 512, 1024, 1024, 1, bid, nb, smem);
    conv_t(p.in(I_WOUT) + (size_t)l * 1024 * 1024, (bf16_t*)((char*)wb + WB_OUT), 1024, 1024, 1024, 1, bid, nb, smem);
}
__device__ __forceinline__ void st_conv_experts(const KP& p, int l, int bid, int nb, float* smem) {
    const int tidx = opaque_tid(); (void)tidx;
    bf16_t* wb = WSP(bf16_t, OFF_WB);
    conv_t(p.in(I_WEG) + (size_t)l * 16 * 1024 * 512, (bf16_t*)((char*)wb + WB_EG), 1024, 512, 512, 16, bid, nb, smem);
    conv_t(p.in(I_WEU) + (size_t)l * 16 * 1024 * 512, (bf16_t*)((char*)wb + WB_EU), 1024, 512, 512, 16, bid, nb, smem);
    conv_t(p.in(I_WED) + (size_t)l * 16 * 512 * 1024, (bf16_t*)((char*)wb + WB_ED), 512, 1024, 1024, 16, bid, nb, smem);
}

__device__ __forceinline__ const float* xrow_c(const KP& p, int r) { return (r < LC) ? (WSP(float, OFF_XC) + (size_t)r * D) : (p.out() + (size_t)(r - LC) * D); }
__device__ __forceinline__ const float* xrow_in(const KP& p, int r) { return (r < LC) ? (p.in(I_CTX) + (size_t)r * D) : (p.in(I_X) + (size_t)(r - LC) * D); }
__device__ __forceinline__ float* xrow(const KP& p, int r) { return (r < LC) ? (WSP(float, OFF_XC) + (size_t)r * D) : (p.out() + (size_t)(r - LC) * D); }
__device__ __forceinline__ void st_modulate(const KP& p, int l, int bid, int nb) {
    const int tidx = opaque_tid();
    const int lane = tidx & 63, wid = tidx >> 6;
    bf16_t* Hb = WSP(bf16_t, OFF_H);
    const float* g = p.in(I_GPREMIX) + l * D;
    auto ld = [&](int r, float4 (&v)[4]) __attribute__((always_inline)) {
        const float* xr = l == 0 ? xrow_in(p, r) : xrow_c(p, r);
#pragma unroll
        for (int i = 0; i < 4; ++i) v[i] = *(const float4*)(xr + i * 256 + lane * 4);
    };
    auto proc = [&](int r, float4 (&v)[4]) __attribute__((always_inline)) {
        const float* md = WSP(float, OFF_MOD) + (size_t)(l * 2 + (r < LC ? 1 : 0)) * 6144;
        float ss = 0.f;
#pragma unroll
        for (int i = 0; i < 4; ++i) ss += v[i].x * v[i].x + v[i].y * v[i].y + v[i].z * v[i].z + v[i].w * v[i].w;
        ss = wave_sum(ss);
        const float rstd = rsqrtf(ss * (1.0f / D) + EPS);
#pragma unroll
        for (int i = 0; i < 4; ++i) {
            const int c = i * 256 + lane * 4;
            const float4 gg = *(const float4*)(g + c), sh = *(const float4*)(md + c), sc = *(const float4*)(md + 1024 + c);
            const float h0 = v[i].x * rstd * gg.x * (1.f + sc.x) + sh.x, h1 = v[i].y * rstd * gg.y * (1.f + sc.y) + sh.y;
            const float h2 = v[i].z * rstd * gg.z * (1.f + sc.z) + sh.z, h3 = v[i].w * rstd * gg.w * (1.f + sc.w) + sh.w;
            uint2 o; o.x = pack2(h0, h1); o.y = pack2(h2, h3);
            *(uint2*)(Hb + (size_t)r * D + c) = o;
        }
    };
    {   const int r0 = bid * NWV + wid, rs = nb * NWV;
        float4 va[4], vb[4];
        if (r0 < T) ld(r0, va);
        for (int r = r0; r < T; r += 2 * rs) {
            if (r + rs < T) ld(r + rs, vb);
            proc(r, va);
            if (r + rs < T) { if (r + 2 * rs < T) ld(r + 2 * rs, va); proc(r + rs, vb); }
        } }
}

__device__ __forceinline__ void st_gemm_in(const KP& p, int l, int bid, int nb, char* lds) {
    const int tidx = opaque_tid();
    if (bid == 0 && tidx < 8) WSP(unsigned, OFF_CNT)[32 + tidx] = 0u;
    const bf16_t* Hb = WSP(bf16_t, OFF_H); const bf16_t* Wt = WSP(bf16_t, OFF_WB + WB_IN); bf16_t* P = WSP(bf16_t, OFF_P);
    float* ssq = WSP(float, OFF_SSQ); const float2* t16 = WSP(float2, OFF_ROPE); const float2* t8 = t16 + 256 * 16;
    const float* gqn = p.in(I_GQN) + l * 64; const float* gkn = p.in(I_GKN) + l * 64;
    const int lane = tidx & 63, wid = tidx >> 6, wm = wid >> 1, wn = wid & 1, fr = lane & 15, g = lane >> 4;
    int mt, nt;
    for (int it = 0; dense_tile(it, NINP / 128, true, bid, nb, mt, nt); ++it) {
        acc_t acc; acc_zero(acc);
        gemm_core(acc, [&](int r) { return Hb + (size_t)(mt * 256 + r) * 1024; }, [&](int r) { return Wt + (size_t)(nt * 128 + r) * 1024; }, 1024, lds);
#pragma unroll
        for (int im = 0; im < 4; ++im) {
            const int row = mt * 256 + wm * 64 + 16 * im + fr;
            bf16_t* prow_ = P + (size_t)row * PP + nt * 128 + wn * 64 + 4 * g;
            const bool lat = row >= LC; const int tpos = row - LC, prow = lat ? (tpos >> 6) : 0, pcol = lat ? (tpos & 63) : 0;
            f32x4 v[4];
#pragma unroll
            for (int in = 0; in < 4; ++in) v[in] = acc[in][im];
            if (nt <= 4) {
                float ss = 0.f;
#pragma unroll
                for (int in = 0; in < 4; ++in) ss += (v[in][0] * v[in][0] + v[in][1] * v[in][1]) + (v[in][2] * v[in][2] + v[in][3] * v[in][3]);
                ss += __shfl_xor(ss, 16); ss += __shfl_xor(ss, 32);
                const float sc = rsqrtf(ss * (1.0f / 64.0f) + EPS) * (nt < 4 ? SC_GQA : 1.0f);
                const float* gg = (nt < 4 ? gqn : gkn) + 4 * g;
#pragma unroll
                for (int in = 0; in < 4; ++in) { const float4 g4 = *(const float4*)(gg + 16 * in); v[in][0] *= sc * g4.x; v[in][1] *= sc * g4.y; v[in][2] *= sc * g4.z; v[in][3] *= sc * g4.w; }
                if (lat) {
#pragma unroll
                    for (int hlf = 0; hlf < 2; ++hlf) {
                        const float4* cs = (const float4*)(t16 + (hlf == 0 ? prow : pcol) * 16 + 4 * g);
                        const float4 c01 = cs[0], c23 = cs[1];
                        const f32x4 cc = {c01.x, c01.z, c23.x, c23.z}, sn = {c01.y, c01.w, c23.y, c23.w}, a = v[2 * hlf], b = v[2 * hlf + 1];
                        v[2 * hlf] = a * cc - b * sn; v[2 * hlf + 1] = a * sn + b * cc; }
                }
            } else if (nt >= 6 && nt <= 8) {
                float ss = 0.f;
#pragma unroll
                for (int in = 0; in < 4; ++in) ss += (v[in][0] * v[in][0] + v[in][1] * v[in][1]) + (v[in][2] * v[in][2] + v[in][3] * v[in][3]);
                ss += __shfl_xor(ss, 16); ss += __shfl_xor(ss, 32);
                if (g == 0) ssq[(size_t)row * 8 + (nt - 6) * 2 + wn] = ss;
            } else if (nt == 9 && wn == 0) {
#pragma unroll
                for (int in = 0; in < 2; ++in) {
                    f32x4 o; o[0] = __shfl_xor(v[in][0], 32); o[1] = __shfl_xor(v[in][1], 32); o[2] = __shfl_xor(v[in][2], 32); o[3] = __shfl_xor(v[in][3], 32);
                    if (lat) { const float4* cs = (const float4*)(t8 + (in == 0 ? prow : pcol) * 8 + 4 * (g & 1));
                        const float4 c01 = cs[0], c23 = cs[1];
                        if (g < 2) { v[in][0] = v[in][0] * c01.x - o[0] * c01.y; v[in][1] = v[in][1] * c01.z - o[1] * c01.w; v[in][2] = v[in][2] * c23.x - o[2] * c23.y; v[in][3] = v[in][3] * c23.z - o[3] * c23.w; }
                        else { v[in][0] = o[0] * c01.y + v[in][0] * c01.x; v[in][1] = o[1] * c01.w + v[in][1] * c01.z; v[in][2] = o[2] * c23.y + v[in][2] * c23.x; v[in][3] = o[3] * c23.w + v[in][3] * c23.z; } }
                }
            }
#pragma unroll
            for (int in = 0; in < 4; ++in) {
                const int G = nt * 8 + wn * 4 + in;
                if (G >= 106) {
                    if (G < 298) {
                        uint2 o; o.x = pack2(sigmoidf_(v[in][0]), sigmoidf_(v[in][1])); o.y = pack2(sigmoidf_(v[in][2]), sigmoidf_(v[in][3]));
                        *(uint2*)(WSP(bf16_t, OFF_GS) + (((((size_t)(mt * 192 + (G - 106)) * 4 + wm) * 4 + im) * 64) + lane) * 4) = o; }
                } else if (G >= 74) *(uint2*)(WSP(bf16_t, OFF_SSMG) + ((size_t)(G - 74) * T + row) * 16 + 4 * g) = pack4(v[in]);
                else *(uint2*)(prow_ + 16 * in) = pack4(v[in]);
            }
        }
    }
}

__device__ __forceinline__ void rope_pair(float& a, float& b, int pos, int i, int half) {
    const float freq = powf(10000.0f, -(float)i / (float)half);
    const float ang = (float)pos * freq;
    float sn, cs; sincosf(ang, &sn, &cs);
    const float na = a * cs - b * sn, nb_ = a * sn + b * cs; a = na; b = nb_;
}

constexpr int S5C = 64, NCH = T / S5C;
constexpr size_t S5_ZERO = OFF_WB + WB_EG;
constexpr size_t S5_KTAB = S5_ZERO + 256;
constexpr size_t S5_FTAB = S5_KTAB + (size_t)64 * 64 * 256 * 2;
constexpr size_t S5_GTAB = S5_FTAB + (size_t)64 * 128 * 1024 * 2;
constexpr size_t S5_SINB = S5_GTAB + (size_t)64 * 1024 * 128 * 2;
static_assert(S5_SINB + (size_t)NCH * 64 * 128 * 2 <= OFF_WB + WB_BYTES, "s5 tables overlay");
__device__ __forceinline__ int s5_row(int dir, int j) { return dir == 0 ? j : (j < LC ? LC - 1 - j : T + LC - 1 - j); }
__device__ __forceinline__ void s5_consts(const KP& p, int l, int dir, int g, int lane, float& lr, float& li, float (&bbr)[16], float (&bbi)[16]) {
    const int gi = (l * 2 + dir) * 32 + g, pi = gi * 64 + lane;
    const float are = p.in(I_ARE)[pi], aim = p.in(I_AIM)[pi], dt = expf(p.in(I_LOGDT)[gi]);
    const float mag = expf(are * dt); float sn, cs; sincosf(aim * dt, &sn, &cs);
    lr = mag * cs; li = mag * sn; const float den = are * are + aim * aim;
    const float cr = ((lr - 1.0f) * are + li * aim) / den, ci = (li * are - (lr - 1.0f) * aim) / den;
    const float4* br4 = (const float4*)(p.in(I_BRE) + (size_t)pi * 16); const float4* bi4 = (const float4*)(p.in(I_BIM) + (size_t)pi * 16);
#pragma unroll
    for (int q = 0; q < 4; ++q) { const float4 br = br4[q], bi = bi4[q];
        bbr[4 * q] = cr * br.x - ci * bi.x; bbi[4 * q] = cr * bi.x + ci * br.x; bbr[4 * q + 1] = cr * br.y - ci * bi.y; bbi[4 * q + 1] = cr * bi.y + ci * br.y;
        bbr[4 * q + 2] = cr * br.z - ci * bi.z; bbi[4 * q + 2] = cr * bi.z + ci * br.z; bbr[4 * q + 3] = cr * br.w - ci * bi.w; bbi[4 * q + 3] = cr * bi.w + ci * br.w; }
}
__device__ __forceinline__ void s5_unpack(uint4 a, uint4 b, float (&u)[16]) {
    u[0] = bflo(a.x); u[1] = bfhi(a.x); u[2] = bflo(a.y); u[3] = bfhi(a.y); u[4] = bflo(a.z); u[5] = bfhi(a.z); u[6] = bflo(a.w); u[7] = bfhi(a.w);
    u[8] = bflo(b.x); u[9] = bfhi(b.x); u[10] = bflo(b.y); u[11] = bfhi(b.y); u[12] = bflo(b.z); u[13] = bfhi(b.z); u[14] = bflo(b.w); u[15] = bfhi(b.w);
}
__device__ __forceinline__ void st_s5_local(const KP& p, int l, int bid, int nb) {
    const int tidx = opaque_tid();
    const int lane = tidx & 63, wid = tidx >> 6;
    const bf16_t* P = WSP(bf16_t, OFF_P); float2* F = WSP(float2, OFF_S5);
    const int gw = bid * NWV + wid, nw = nb * NWV;
    if (gw >= (nw / 64) * 64) return;
    const int gd = gw & 63, dir = gd >> 5, g = gd & 31, part = gw >> 6, nparts = nw >> 6;
    if (part >= 4) return;
    float lr, li, bbr[16], bbi[16]; s5_consts(p, l, dir, g, lane, lr, li, bbr, bbi);
    for (int c = part; c < 4; c += nparts) {
        float sr = 0.f, si = 0.f;
        for (int j0 = 0; j0 < S5C; j0 += 8) {
            uint4 ua[8], ub[8];
#pragma unroll
            for (int q = 0; q < 8; ++q) { const int r = s5_row(dir, c * S5C + j0 + q); const uint4* up = (const uint4*)SSMU(g, r); ua[q] = up[0]; ub[q] = up[1]; }
#pragma unroll
            for (int q = 0; q < 8; ++q) { float u[16]; s5_unpack(ua[q], ub[q], u);
                float bur = 0.f, bui = 0.f;
#pragma unroll
                for (int cc = 0; cc < 16; ++cc) { bur = fmaf(bbr[cc], u[cc], bur); bui = fmaf(bbi[cc], u[cc], bui); }
                const float nsr = lr * sr - li * si + bur, nsi = lr * si + li * sr + bui; sr = nsr; si = nsi; }
        }
        F[((size_t)(c * 2 + dir) * 32 + g) * 64 + lane] = make_float2(sr, si);
    }
}
__device__ __forceinline__ void st_s5_carry(const KP& p, int l, int bid, int nb, char* lds) {
    const int tidx = opaque_tid();
    float2* F = WSP(float2, OFF_S5); bf16_t* SB = WSP(bf16_t, S5_SINB);
    float4* comp = (float4*)lds;
    constexpr int RUN = 9;
    for (int cb = bid; cb < 256; cb += nb) {
        const int chl = tidx & 15, seg = tidx >> 4, idx = cb * 16 + chl;
        const int gi = l * 64 + (idx >> 6);
        const float are = p.in(I_ARE)[gi * 64 + (idx & 63)], aim = p.in(I_AIM)[gi * 64 + (idx & 63)], dt = expf(p.in(I_LOGDT)[gi]);
        const float mag = expf(are * dt); float sn, cs; sincosf(aim * dt, &sn, &cs);
        float pr = mag * cs, pi_ = mag * sn;
#pragma unroll
        for (int q = 0; q < 6; ++q) { const float nr = pr * pr - pi_ * pi_, ni = 2.f * pr * pi_; pr = nr; pi_ = ni; }
        const int c0 = seg * RUN;
        float2 f[RUN]; float ar = 1.f, ai = 0.f, br = 0.f, bi = 0.f;
#pragma unroll
        for (int q = 0; q < RUN; ++q) { const int c = c0 + q; f[q] = (c < NCH) ? F[(size_t)c * 4096 + idx] : make_float2(0.f, 0.f);
            if (c < NCH) { const float nbr = pr * br - pi_ * bi + f[q].x, nbi = pr * bi + pi_ * br + f[q].y; br = nbr; bi = nbi;
                           const float nar = pr * ar - pi_ * ai, nai = pr * ai + pi_ * ar; ar = nar; ai = nai; } }
        __syncthreads();
        comp[chl * 32 + seg] = make_float4(ar, ai, br, bi);
        __syncthreads();
        float sr = 0.f, si = 0.f;
        for (int j = 0; j < seg; ++j) { const float4 cj = comp[chl * 32 + j]; const float nr = cj.x * sr - cj.y * si + cj.z, ni = cj.x * si + cj.y * sr + cj.w; sr = nr; si = ni; }
#pragma unroll
        for (int q = 0; q < RUN; ++q) { const int c = c0 + q;
            if (c < NCH) { F[(size_t)c * 4096 + idx] = make_float2(sr, si);
                bf16_t* sb = SB + ((size_t)c * 64 + (idx >> 6)) * 128 + (idx & 63); sb[0] = f2bf(sr); sb[64] = f2bf(si);
                const float nr = pr * sr - pi_ * si + f[q].x, ni = pr * si + pi_ * sr + f[q].y; sr = nr; si = ni; } }
    }
    __syncthreads();
}
__device__ __forceinline__ void st_s5_scan(const KP& p, int l, int bid, int nb) {
    const int tidx = opaque_tid();
    const int lane = tidx & 63, wid = tidx >> 6;
    const bf16_t* P = WSP(bf16_t, OFF_P); const float2* F = WSP(float2, OFF_S5);
    const int gw = bid * NWV + wid, nw = nb * NWV;
    if (gw >= (nw / 64) * 64) return;
    const int gd = gw & 63, dir = gd >> 5, g = gd & 31, part = gw >> 6, nparts = nw >> 6;
    if (part >= 4) return;
    float* Yo = dir == 0 ? WSP(float, OFF_OM) : WSP(float, OFF_H);
    float lr, li, bbr[16], bbi[16]; s5_consts(p, l, dir, g, lane, lr, li, bbr, bbi);
    const int gi = (l * 2 + dir) * 32 + g;
    float cre[16], cim[16];
#pragma unroll
    for (int cc = 0; cc < 16; ++cc) { cre[cc] = p.in(I_CRE)[((size_t)gi * 16 + cc) * 64 + lane]; cim[cc] = p.in(I_CIM)[((size_t)gi * 16 + cc) * 64 + lane]; }
    const float dsk = p.in(I_SSMD)[l * 512 + g * 16 + (lane & 15)];
    for (int c = part; c < 4; c += nparts) {
        const float2 s0 = F[((size_t)(c * 2 + dir) * 32 + g) * 64 + lane];
        float sr = s0.x, si = s0.y;
        for (int j0 = 0; j0 < S5C; j0 += 8) {
            uint4 ua[8], ub[8];
#pragma unroll
            for (int q = 0; q < 8; ++q) { const int r = s5_row(dir, c * S5C + j0 + q); const uint4* up = (const uint4*)SSMU(g, r); ua[q] = up[0]; ub[q] = up[1]; }
#pragma unroll
            for (int q = 0; q < 8; ++q) { const int r = s5_row(dir, c * S5C + j0 + q);
                float u[16]; s5_unpack(ua[q], ub[q], u);
                float bur = 0.f, bui = 0.f;
#pragma unroll
                for (int cc = 0; cc < 16; ++cc) { bur = fmaf(bbr[cc], u[cc], bur); bui = fmaf(bbi[cc], u[cc], bui); }
                const float nsr = lr * sr - li * si + bur, nsi = lr * si + li * sr + bui; sr = nsr; si = nsi;
                float t16[16];
#pragma unroll
                for (int cc = 0; cc < 16; ++cc) t16[cc] = cre[cc] * sr - cim[cc] * si;
                float y = transpose_reduce16(t16, lane);
                if (lane < 16) {
                    if (dir == 0) y += dsk * bf2f(SSMU(g, r)[lane]);
                    Yo[(size_t)r * 512 + g * 16 + lane] = y; }
            }
        }
    }
}

__device__ __forceinline__ void st_s5_tables(const KP& p, int l, int bid, int nb, char* lds) {
    const int tidx = opaque_tid();
    float* pwr = (float*)lds; float* pwi = pwr + 65 * 64; float* bbr = pwi + 65 * 64; float* bbi = bbr + 1024; float* cre = bbi + 1024; float* cim = cre + 1024;
    bf16_t* Ktab = WSP(bf16_t, S5_KTAB); bf16_t* Ftab = WSP(bf16_t, S5_FTAB); bf16_t* Gtab = WSP(bf16_t, S5_GTAB);
    if (bid == 0 && tidx < 64) WSP(unsigned, S5_ZERO)[tidx] = 0u;
    for (int item = bid; item < 256; item += nb) {
        const int gd = item >> 2, q = item & 3, dir = gd >> 5, g = gd & 31, gi = (l * 2 + dir) * 32 + g;
        __syncthreads();
        if (tidx < 64) {
            const int pp = tidx, pi = gi * 64 + pp;
            const float are = p.in(I_ARE)[pi], aim = p.in(I_AIM)[pi], dt = expf(p.in(I_LOGDT)[gi]);
            const float mag = expf(are * dt); float sn, cs; sincosf(aim * dt, &sn, &cs);
            const float lr = mag * cs, li = mag * sn, den = are * are + aim * aim;
            const float cr = ((lr - 1.0f) * are + li * aim) / den, ci = (li * are - (lr - 1.0f) * aim) / den;
            for (int c = 0; c < 16; ++c) { const float br = p.in(I_BRE)[(size_t)pi * 16 + c], bi = p.in(I_BIM)[(size_t)pi * 16 + c];
                bbr[pp * 16 + c] = cr * br - ci * bi; bbi[pp * 16 + c] = cr * bi + ci * br; }
            float ar = 1.f, ai = 0.f;
            for (int n = 0; n <= 64; ++n) { pwr[n * 64 + pp] = ar; pwi[n * 64 + pp] = ai; const float nr = ar * lr - ai * li, ni = ar * li + ai * lr; ar = nr; ai = ni; }
        } else {
            for (int i = tidx - 64; i < 1024; i += NTH - 64) { cre[i] = p.in(I_CRE)[(size_t)gi * 1024 + i]; cim[i] = p.in(I_CIM)[(size_t)gi * 1024 + i]; }
        }
        __syncthreads();
        for (int e = 0; e < 8; ++e) {
            const int idx = tidx + NTH * e, tau = 16 * q + (idx >> 8), c = (idx >> 4) & 15, c2 = idx & 15;
            float s = 0.f;
            for (int pp = 0; pp < 64; ++pp) {
                const float xr = cre[c * 64 + pp], xi = cim[c * 64 + pp], wr = pwr[tau * 64 + pp], wi = pwi[tau * 64 + pp];
                const float zr = xr * wr - xi * wi, zi = xr * wi + xi * wr;
                s += zr * bbr[pp * 16 + c2] - zi * bbi[pp * 16 + c2];
            }
            Ktab[(((size_t)gd * 64 + tau) * 16 + c) * 16 + c2] = f2bf(s);
        }
        for (int e = 0; e < 32; ++e) {
            const int idx2 = tidx + NTH * e, n = 32 * q + (idx2 >> 9), k = (idx2 & 511) * 2, pp = n & 63, comp = n >> 6, i = k >> 4, c2 = k & 15;
            const float wr = pwr[(63 - i) * 64 + pp], wi = pwi[(63 - i) * 64 + pp];
            const float b0r = bbr[pp * 16 + c2], b0i = bbi[pp * 16 + c2], b1r = bbr[pp * 16 + c2 + 1], b1i = bbi[pp * 16 + c2 + 1];
            const float v0 = comp ? (wr * b0i + wi * b0r) : (wr * b0r - wi * b0i), v1 = comp ? (wr * b1i + wi * b1r) : (wr * b1r - wi * b1i);
            *(unsigned*)(Ftab + ((size_t)gd * 128 + n) * 1024 + k) = pack2(v0, v1);
        }
        for (int e = 0; e < 32; ++e) {
            const int idx2 = tidx + NTH * e, row = 256 * q + (idx2 >> 6), n = (idx2 & 63) * 2, t = row >> 4, c = row & 15, comp = n >> 6, pp = n & 63;
            float v[2];
#pragma unroll
            for (int h = 0; h < 2; ++h) { const float xr = cre[c * 64 + pp + h], xi = cim[c * 64 + pp + h], wr = pwr[(t + 1) * 64 + pp + h], wi = pwi[(t + 1) * 64 + pp + h];
                v[h] = comp ? -(xr * wi + xi * wr) : (xr * wr - xi * wi); }
            *(unsigned*)(Gtab + ((size_t)gd * 1024 + row) * 128 + n) = pack2(v[0], v[1]);
        }
    }
    __syncthreads();
}
__device__ __forceinline__ void st_s5_fgemm(const KP& p, int bid, int nb, char* lds) {
    const int tidx = opaque_tid();
    const bf16_t* P = WSP(bf16_t, OFF_P); const bf16_t* Ftab = WSP(bf16_t, S5_FTAB); float* F = WSP(float, OFF_S5);
    const int srow = tidx >> 3, gch = (tidx & 7) ^ ((srow >> 1) & 7);
    for (int gd = bid; gd < 64; gd += nb) {
        const int dir = gd >> 5, g = gd & 31;
        acc_t acc; acc_zero(acc);
        gemm_core_g(acc,
            [&](int i, int kt) { const int m = srow + 64 * i, tok = kt * 4 + (gch >> 1); return SSMU(g, s5_row(dir, 64 * (4 + m) + tok)) + 8 * (gch & 1); },
            [&](int i, int kt) { return Ftab + ((size_t)gd * 128 + srow + 64 * i) * 1024 + kt * 64 + gch * 8; }, 16, lds);
        acc_visit(acc, [&](int ml, int nl, f32x4 v) {
            float* dst = F + (((size_t)(4 + ml) * 2 + dir) * 32 + g) * 128 + (nl & 63) * 2 + (nl >> 6);
            dst[0] = v[0]; dst[2] = v[1]; dst[4] = v[2]; dst[6] = v[3]; });
    }
}
__device__ __forceinline__ void st_s5_ygemm(const KP& p, int l, int bid, int nb, char* lds) {
    const int tidx = opaque_tid();
    const bf16_t* P = WSP(bf16_t, OFF_P); const bf16_t* Ktab = WSP(bf16_t, S5_KTAB); const bf16_t* Gtab = WSP(bf16_t, S5_GTAB);
    const bf16_t* Sinb = WSP(bf16_t, S5_SINB); const bf16_t* Zero = WSP(bf16_t, S5_ZERO); bf16_t* Y1 = WSP(bf16_t, OFF_OS);
    const int srow = tidx >> 3, gch = (tidx & 7) ^ ((srow >> 1) & 7);
    for (int u = bid; u < 256; u += nb) {
        const int g = u >> 3, nt = u & 7;
        acc_t acc; acc_zero(acc);
        {   const int gd = g, nkt = 2 * (nt + 1);
            gemm_core_g(acc,
                [&](int i, int kt) { const int m = srow + 64 * i;
                    if (kt < nkt) { const int tok = kt * 4 + (gch >> 1); return SSMU(g, 64 * (4 + m) + tok) + 8 * (gch & 1); }
                    return Sinb + ((size_t)(4 + m) * 64 + gd) * 128 + (kt - nkt) * 64 + gch * 8; },
                [&](int i, int kt) { const int n = nt * 128 + srow + 64 * i, t = n >> 4, c = n & 15;
                    if (kt < nkt) { const int tau = t - (kt * 4 + (gch >> 1)); return tau >= 0 ? Ktab + (((size_t)gd * 64 + tau) * 16 + c) * 16 + 8 * (gch & 1) : Zero; }
                    return Gtab + ((size_t)gd * 1024 + n) * 128 + (kt - nkt) * 64 + gch * 8; }, nkt + 2, lds); }
        {   const int gd = 32 + g, nkt = 2 * (8 - nt);
            gemm_core_g(acc,
                [&](int i, int kt) { const int m = srow + 64 * i, cx = 259 - m;
                    if (kt < nkt) { const int tok = kt * 4 + (gch >> 1); return SSMU(g, T + LC - 1 - (64 * cx + tok)) + 8 * (gch & 1); }
                    return Sinb + ((size_t)cx * 64 + gd) * 128 + (kt - nkt) * 64 + gch * 8; },
                [&](int i, int kt) { const int n = nt * 128 + srow + 64 * i, t = 63 - (n >> 4), c = n & 15;
                    if (kt < nkt) { const int tau = t - (kt * 4 + (gch >> 1)); return tau >= 0 ? Ktab + (((size_t)gd * 64 + tau) * 16 + c) * 16 + 8 * (gch & 1) : Zero; }
                    return Gtab + ((size_t)gd * 1024 + t * 16 + c) * 128 + (kt - nkt) * 64 + gch * 8; }, nkt + 2, lds); }
        acc_visit(acc, [&](int ml, int nl, f32x4 v) {
            const int n = nt * 128 + nl, t = n >> 4, c0 = n & 15, r = 64 * (4 + ml) + t;
            const float4 dsk = *(const float4*)(p.in(I_SSMD) + l * 512 + g * 16 + c0); const uint2 ur = *(const uint2*)(SSMU(g, r) + c0);
            uint2 o; o.x = pack2(gelu_tanh(v[0] + dsk.x * bflo(ur.x)), gelu_tanh(v[1] + dsk.y * bfhi(ur.x))); o.y = pack2(gelu_tanh(v[2] + dsk.z * bflo(ur.y)), gelu_tanh(v[3] + dsk.w * bfhi(ur.y)));
            *(uint2*)(Y1 + (size_t)r * 512 + g * 16 + c0) = o; });
    }
}
__device__ __forceinline__ void st_s5_ctx_y(const KP& p, int l, int bid, int nb) {
    const int tidx = opaque_tid();
    const bf16_t* P = WSP(bf16_t, OFF_P); const bf16_t* Ktab = WSP(bf16_t, S5_KTAB); const bf16_t* Gtab = WSP(bf16_t, S5_GTAB);
    const float* SIN = WSP(float, OFF_S5); bf16_t* Y1 = WSP(bf16_t, OFF_OS);
    for (int idx = bid * NTH + tidx; idx < 32 * 256 * 16; idx += nb * NTH) {
        const int ch = idx & 15, r = (idx >> 4) & 255, g = idx >> 12;
        float y = p.in(I_SSMD)[l * 512 + g * 16 + ch] * bf2f(SSMU(g, r)[ch]);
#pragma unroll 1
        for (int dir = 0; dir < 2; ++dir) {
            const int gd = dir * 32 + g, j = dir == 0 ? r : (LC - 1 - r), cx = j >> 6, t = j & 63;
            const bf16_t* kt_ = Ktab + ((size_t)gd * 64 * 16 + ch) * 16;
            float a = 0.f;
            for (int i = 0; i <= t; ++i) {
                const int jr = 64 * cx + i, rr = dir == 0 ? jr : (LC - 1 - jr);
                const uint4* up = (const uint4*)SSMU(g, rr); const uint4* kp = (const uint4*)(kt_ + (size_t)(t - i) * 256);
                a = dot8(up[0], kp[0], a); a = dot8(up[1], kp[1], a);
            }
            const bf16_t* gp = Gtab + ((size_t)gd * 1024 + t * 16 + ch) * 128; const float* sp = SIN + (((size_t)cx * 2 + dir) * 32 + g) * 128;
            for (int q = 0; q < 64; q += 2) { const unsigned gre = *(const unsigned*)(gp + q), gim = *(const unsigned*)(gp + 64 + q); const float4 s4 = *(const float4*)(sp + 2 * q);
                a = fmaf(bflo(gre), s4.x, a); a = fmaf(bflo(gim), s4.y, a); a = fmaf(bfhi(gre), s4.z, a); a = fmaf(bfhi(gim), s4.w, a); }
            y += a;
        }
        Y1[(size_t)r * 512 + g * 16 + ch] = f2bf(gelu_tanh(y));
    }
}
__device__ __forceinline__ void st_s5_fin(const KP& p, int bid, int nb) {
    const int tidx = opaque_tid();
    const float* Yf = WSP(float, OFF_OM); const float* Yb = WSP(float, OFF_H); bf16_t* P = WSP(bf16_t, OFF_P);
    for (long idx = (long)bid * NTH + tidx; idx < (long)T * 512; idx += (long)nb * NTH) {
        const int r = (int)(idx >> 9), c = (int)(idx & 511);
        P[(size_t)r * PP + C_SSM + c] = f2bf(gelu_tanh(Yf[idx] + Yb[idx]));
    }
}

template <int SET>
__device__ __forceinline__ void st_proj2(const KP& p, int l, int bid, int nb, char* lds) {
    const int tidx = opaque_tid();
    bf16_t* P = WSP(bf16_t, OFF_P);
    const bf16_t* Wuq = WSP(bf16_t, OFF_WB + WB_UQ); bf16_t* Qm = WSP(bf16_t, OFF_H);
    const bf16_t* Wukv = WSP(bf16_t, OFF_WB + WB_UKV); bf16_t* Kn = WSP(bf16_t, OFF_KN); bf16_t* Vm = WSP(bf16_t, OFF_V);
    const bf16_t* Wglu = WSP(bf16_t, OFF_WB + WB_GLU); bf16_t* Os = WSP(bf16_t, OFF_OS); const float* bg = p.in(I_BGLU) + l * 512;
    int mt, ntv;
    for (int it = 0; dense_tile(it, SET == 0 ? 14 : 4, SET == 0 || l + 1 < NL, bid, nb, mt, ntv); ++it) {
        if (SET == 1) ntv += 14;
        const int which = ntv < 6 ? 0 : (ntv < 14 ? 1 : 2), nt = ntv - (which == 0 ? 0 : (which == 1 ? 6 : 14));
        const int K = which == 0 ? 256 : (which == 1 ? 128 : 512);
        const bf16_t* abase = which == 2 ? (const bf16_t*)Os + (size_t)mt * 256 * 512 : P + (size_t)mt * 256 * PP + (which == 0 ? C_CQ : C_CKV);
        const int apitch = which == 2 ? 512 : PP;
        const bf16_t* wbase = (which == 0 ? Wuq : (which == 1 ? Wukv : Wglu)) + (size_t)nt * 128 * K;
        acc_t acc; acc_zero(acc);
        gemm_core(acc, [&](int r) { return abase + (size_t)r * apitch; }, [&](int r) { return wbase + (size_t)r * K; }, K, lds);
        if (which == 0) {
            const float* ssq = WSP(float, OFF_SSQ); const float2* t8 = WSP(float2, OFF_ROPE) + 256 * 16;
            const int lane_ = tidx & 63, wid_ = tidx >> 6, wm_ = wid_ >> 1, wn_ = wid_ & 1, fr_ = lane_ & 15, g_ = lane_ >> 4;
#pragma unroll
            for (int im = 0; im < 4; ++im) {
                const int row = mt * 256 + wm_ * 64 + 16 * im + fr_;
                const float4 s4 = *(const float4*)(ssq + (size_t)row * 8);
                const float sc = rsqrtf(((s4.x + s4.y) + (s4.z + s4.w)) * (1.0f / 256.0f) + EPS) * SC_MLA;
                const bool lat = row >= LC; const int tpos = row - LC, prow = lat ? (tpos >> 6) : 0, pcol = lat ? (tpos & 63) : 0;
#pragma unroll
                for (int in = 0; in < 4; ++in) {
                    f32x4 v = acc[in][im] * sc;
                    if (((nt * 4 + wn_ * 2 + (in >> 1)) % 3) == 2) {
                        f32x4 o; o[0] = __shfl_xor(v[0], 32); o[1] = __shfl_xor(v[1], 32); o[2] = __shfl_xor(v[2], 32); o[3] = __shfl_xor(v[3], 32);
                        if (lat) { const float4* cs = (const float4*)(t8 + ((in & 1) == 0 ? prow : pcol) * 8 + 4 * (g_ & 1));
                            const float4 c01 = cs[0], c23 = cs[1];
                            if (g_ < 2) { v[0] = v[0] * c01.x - o[0] * c01.y; v[1] = v[1] * c01.z - o[1] * c01.w; v[2] = v[2] * c23.x - o[2] * c23.y; v[3] = v[3] * c23.z - o[3] * c23.w; }
                            else { v[0] = o[0] * c01.y + v[0] * c01.x; v[1] = o[1] * c01.w + v[1] * c01.z; v[2] = o[2] * c23.y + v[2] * c23.x; v[3] = o[3] * c23.w + v[3] * c23.z; } }
                    }
                    *(uint2*)(Qm + (size_t)row * 768 + nt * 128 + wn_ * 64 + 16 * in + 4 * g_) = pack4(v);
                }
            }
        } else if (which == 1) {
            const float* ssq = WSP(float, OFF_SSQ);
            acc_visit(acc, [&](int ml, int nl, f32x4 v) {
                const float2 s2 = *(const float2*)(ssq + (size_t)(mt * 256 + ml) * 8 + 4);
                const float sc = rsqrtf((s2.x + s2.y) * (1.0f / 128.0f) + EPS);
                bf16_t* dst = (nl < 64) ? (Kn + (size_t)(mt * 256 + ml) * 512 + nt * 64 + nl) : (Vm + (size_t)(mt * 256 + ml) * 512 + nt * 64 + nl - 64);
                *(uint2*)dst = pack4(v * sc); });
        } else {
            acc_visit(acc, [&](int ml, int nl, f32x4 v) {
                const int n = nt * 128 + nl;
                const uint2 yr = *(const uint2*)(Os + (size_t)(mt * 256 + ml) * 512 + n); const float4 b4 = *(const float4*)(bg + n);
                uint2 o; o.x = pack2(bflo(yr.x) * sigmoidf_(v[0] + b4.x), bfhi(yr.x) * sigmoidf_(v[1] + b4.y));
                o.y = pack2(bflo(yr.y) * sigmoidf_(v[2] + b4.z), bfhi(yr.y) * sigmoidf_(v[3] + b4.w));
                *(uint2*)(P + (size_t)(mt * 256 + ml) * PP + C_SSM + n) = o; });
        }
    }
}
__device__ __forceinline__ void st_ropeq(const KP& p, int bid, int nb, char* lds) {
    const int tidx = opaque_tid();
    {   const int lane = tidx & 63, wid = tidx >> 6;
        const bf16_t* Kn = WSP(bf16_t, OFF_KN); const bf16_t* P = WSP(bf16_t, OFF_P);
        float runmax = 0.f;
        for (int r = bid * NWV + wid; r < T; r += nb * NWV) {
            const uint4 kv = *(const uint4*)(Kn + (size_t)r * 512 + lane * 8);
            float s = bflo(kv.x) * bflo(kv.x) + bfhi(kv.x) * bfhi(kv.x) + bflo(kv.y) * bflo(kv.y) + bfhi(kv.y) * bfhi(kv.y)
                    + bflo(kv.z) * bflo(kv.z) + bfhi(kv.z) * bfhi(kv.z) + bflo(kv.w) * bflo(kv.w) + bfhi(kv.w) * bfhi(kv.w);
            s += __shfl_xor(s, 1); s += __shfl_xor(s, 2); s += __shfl_xor(s, 4);
            float sr = 0.f;
            if (lane < 4) { const uint4 rv = *(const uint4*)(P + (size_t)r * PP + C_KR + lane * 8);
                sr = bflo(rv.x) * bflo(rv.x) + bfhi(rv.x) * bfhi(rv.x) + bflo(rv.y) * bflo(rv.y) + bfhi(rv.y) * bfhi(rv.y)
                   + bflo(rv.z) * bflo(rv.z) + bfhi(rv.z) * bfhi(rv.z) + bflo(rv.w) * bflo(rv.w) + bfhi(rv.w) * bfhi(rv.w); }
            sr += __shfl_xor(sr, 1); sr += __shfl_xor(sr, 2);
            sr = __shfl(sr, 0);
            runmax = fmaxf(runmax, s + sr);
        }
        unsigned* lmax = (unsigned*)lds;
        __syncthreads();
        if (tidx < 8) lmax[tidx] = 0u;
        __syncthreads();
        if ((lane & 7) == 0) atomicMax(&lmax[lane >> 3], __float_as_uint(runmax));
        __syncthreads();
        if (tidx < 8) atomicMax(WSP(unsigned, OFF_CNT) + 32 + tidx, lmax[tidx]);
    }
}

typedef short s16x4 __attribute__((ext_vector_type(4)));
typedef short v4i16_t __attribute__((ext_vector_type(4)));
typedef __attribute__((address_space(3))) const char* lds_cptr;
__device__ __forceinline__ s16x4 vtr(lds_cptr q) { return __builtin_bit_cast(s16x4, __builtin_amdgcn_ds_read_tr16_b64_v4i16((__attribute__((address_space(3))) v4i16_t*)q)); }
__device__ __forceinline__ unsigned cvtpk(float lo, float hi) { return pack2(lo, hi); }
constexpr int AT_K = 0, AT_V = 8192, AT_KR = 16384, AT_BUF = 20480;

template <int DQK, int VAR = 0>
__device__ __forceinline__ void attn_item(const bf16_t* Q, int qpitch, const bf16_t* KA, int kapitch, const bf16_t* KB, int kbpitch,
                                          const bf16_t* V, int vpitch, int ntiles, float C, bf16_t* O, char* lds) {
    const int tid = opaque_tid(), lane = tid & 63, wid = tid >> 6, r32 = lane & 31, hi = lane >> 5;
    constexpr int ND0 = DQK / 16;
    bf16x8 qr[ND0];
    { const bf16_t* qp = Q + (size_t)(wid * 32 + r32) * qpitch + hi * 8;
#pragma unroll
      for (int d0 = 0; d0 < ND0; ++d0) qr[d0] = *(const bf16x8*)(qp + d0 * 16); }
    const int srow = tid >> 3, sch = tid & 7;
    const bf16_t* gk = KA + (size_t)srow * kapitch + sch * 8;
    const bf16_t* gv = V + (size_t)srow * vpitch + sch * 8;
    const bf16_t* gr = (DQK > 64) ? (KB + (size_t)(tid >> 2) * kbpitch + (tid & 3) * 8) : nullptr;
    const int sk_off = AT_K + srow * 128 + ((sch ^ ((srow >> 1) & 7)) << 4);
    const int sv_off = AT_V + (sch >> 2) * 4096 + srow * 64 + (sch & 3) * 16;
    const int sr_off = AT_KR + (tid >> 2) * 64 + (((tid & 3) ^ (((tid >> 2) >> 2) & 3)) << 4);
    const bool do_r = (DQK > 64) && (tid < 256);
    const int kf_off = AT_K + r32 * 128, ksw = (r32 >> 1) & 7;
    const int rf_off = AT_KR + r32 * 64, rsw = (r32 >> 2) & 3;
    const int vf_off = AT_V + (4 * hi + ((lane & 15) >> 2)) * 64 + ((lane >> 4) & 1) * 32 + (lane & 3) * 8;
    uint4 rk, rv, rr; rr = make_uint4(0, 0, 0, 0);
    rk = *(const uint4*)gk; rv = *(const uint4*)gv; if (do_r) rr = *(const uint4*)gr;
    *(uint4*)(lds + sk_off) = rk; *(uint4*)(lds + sv_off) = rv; if (do_r) *(uint4*)(lds + sr_off) = rr;
    __syncthreads();
    f32x16 o0, o1;
#pragma unroll
    for (int r = 0; r < 16; ++r) { o0[r] = 0.f; o1[r] = 0.f; }
    float mrun = -INFINITY, lrun = 0.f;
    for (int t = 0; t < ntiles; ++t) {
        const char* cur = lds + (VAR == 2 ? 0 : (t & 1)) * AT_BUF; char* nxt = lds + ((t + 1) & 1) * AT_BUF;
        const bool more = (t + 1 < ntiles);
        if (more && VAR != 2) { rk = *(const uint4*)(gk + (size_t)(t + 1) * 64 * kapitch); rv = *(const uint4*)(gv + (size_t)(t + 1) * 64 * vpitch); if (do_r) rr = *(const uint4*)(gr + (size_t)(t + 1) * 64 * kbpitch); }
        f32x16 p0, p1;
#pragma unroll
        for (int r = 0; r < 16; ++r) { p0[r] = 0.f; p1[r] = 0.f; }
#pragma unroll
        for (int d0 = 0; d0 < 4; ++d0) {
            const int co = ((2 * d0 + hi) ^ ksw) << 4;
            const bf16x8 k0 = *(const bf16x8*)(cur + kf_off + co), k1 = *(const bf16x8*)(cur + kf_off + 32 * 128 + co);
            p0 = MFMA32(k0, qr[d0], p0); p1 = MFMA32(k1, qr[d0], p1);
        }
        if (DQK > 64) {
#pragma unroll
            for (int d0 = 4; d0 < ND0; ++d0) {
                const int co = ((2 * (d0 - 4) + hi) ^ rsw) << 4;
                const bf16x8 k0 = *(const bf16x8*)(cur + rf_off + co), k1 = *(const bf16x8*)(cur + rf_off + 32 * 64 + co);
                p0 = MFMA32(k0, qr[d0], p0); p1 = MFMA32(k1, qr[d0], p1);
            }
        }
        if (VAR != 1) {
        float mx = fmaxf(p0[0], p1[0]);
#pragma unroll
        for (int r = 1; r < 16; ++r) mx = fmaxf(mx, fmaxf(p0[r], p1[r]));
        mx = xhalf_max(mx) * C;
        const float mnew = fmaxf(mrun, mx);
        if (__any(mnew > mrun)) {
            const float alpha = __builtin_amdgcn_exp2f(mrun - mnew);
            lrun *= alpha;
#pragma unroll
            for (int r = 0; r < 16; ++r) { o0[r] *= alpha; o1[r] *= alpha; }
            mrun = mnew;
        }
        const float nm = -mrun;
        float ls = 0.f;
#pragma unroll
        for (int r = 0; r < 16; ++r) { p0[r] = __builtin_amdgcn_exp2f(fmaf(p0[r], C, nm)); p1[r] = __builtin_amdgcn_exp2f(fmaf(p1[r], C, nm)); ls += p0[r] + p1[r]; }
        lrun += ls;
        }
#pragma unroll
        for (int s = 0; s < 4; ++s) {
            bf16x8 pf;
            {   unsigned w0, w1, w2, w3;
                if (s < 2) { w0 = cvtpk(p0[8 * s], p0[8 * s + 1]); w1 = cvtpk(p0[8 * s + 2], p0[8 * s + 3]); w2 = cvtpk(p0[8 * s + 4], p0[8 * s + 5]); w3 = cvtpk(p0[8 * s + 6], p0[8 * s + 7]); }
                else { const int s2 = s - 2; w0 = cvtpk(p1[8 * s2], p1[8 * s2 + 1]); w1 = cvtpk(p1[8 * s2 + 2], p1[8 * s2 + 3]); w2 = cvtpk(p1[8 * s2 + 4], p1[8 * s2 + 5]); w3 = cvtpk(p1[8 * s2 + 6], p1[8 * s2 + 7]); }
                uint4 u = make_uint4(w0, w1, w2, w3); pf = __builtin_bit_cast(bf16x8, u); }
            const lds_cptr vb = (lds_cptr)cur + vf_off + s * 1024;
            const s16x4 a0 = vtr(vb), a1 = vtr(vb + 512), b0 = vtr(vb + 4096), b1 = vtr(vb + 4096 + 512);
            const bf16x8 v0 = (bf16x8){a0[0], a0[1], a0[2], a0[3], a1[0], a1[1], a1[2], a1[3]};
            const bf16x8 v1 = (bf16x8){b0[0], b0[1], b0[2], b0[3], b1[0], b1[1], b1[2], b1[3]};
            o0 = MFMA32(v0, pf, o0); o1 = MFMA32(v1, pf, o1);
        }
        if (VAR != 2) { if (more) { *(uint4*)(nxt + sk_off) = rk; *(uint4*)(nxt + sv_off) = rv; if (do_r) *(uint4*)(nxt + sr_off) = rr; }
        __syncthreads(); }
    }
    const float inv = 1.0f / xhalf_sum(lrun);
    bf16_t* op = O + (size_t)(wid * 32 + r32) * 512 + 4 * hi;
#pragma unroll
    for (int rg = 0; rg < 4; ++rg) {
        uint2 a; a.x = pack2(o0[4 * rg] * inv, o0[4 * rg + 1] * inv); a.y = pack2(o0[4 * rg + 2] * inv, o0[4 * rg + 3] * inv);
        uint2 b; b.x = pack2(o1[4 * rg] * inv, o1[4 * rg + 1] * inv); b.y = pack2(o1[4 * rg + 2] * inv, o1[4 * rg + 3] * inv);
        *(uint2*)(op + 8 * rg) = a; *(uint2*)(op + 32 + 8 * rg) = b;
    }
}
#define SBAR() __builtin_amdgcn_sched_barrier(0)
#define PINV(x) asm volatile("" : "+v"(x))
constexpr float ATT_THR = 6.0f;
template <int DQK>
__device__ __forceinline__ void attn_item2(const bf16_t* Q, int qpitch, const bf16_t* KA, int kapitch, const bf16_t* KB, int kbpitch,
                                           const bf16_t* V, int vpitch, int ntiles, bf16_t* O, char* lds) {
    const int tid = opaque_tid(), lane = tid & 63, wid = tid >> 6, r32 = lane & 31, hi = lane >> 5;
    const int wu = __builtin_amdgcn_readfirstlane(wid);
    constexpr int ND0 = DQK / 16, NQK = 2 * ND0;
    constexpr bool ROPE = DQK > 64;
    const int krow = 8 * wu + (lane >> 3);
    const bf16_t* gk = KA + (size_t)krow * kapitch + (((lane & 7) ^ ((krow >> 1) & 7)) << 3);
    const bf16_t* gv = V + (size_t)(16 * (wu & 3) + (lane >> 2)) * vpitch + (wu >> 2) * 32 + (lane & 3) * 8;
    const int rrow = 16 * (wu & 3) + (lane >> 2);
    const bf16_t* gr = ROPE ? (KB + (size_t)rrow * kbpitch + (((lane & 3) ^ ((rrow >> 2) & 3)) << 3)) : nullptr;
    char* dk = lds + AT_K + wu * 1024; char* dv = lds + AT_V + wu * 1024; char* dr = lds + AT_KR + (wu & 3) * 1024;
    auto issue = [&](int t, int slot) {
        GLDS16(gk + (size_t)t * 64 * kapitch, dk + slot * AT_BUF); GLDS16(gv + (size_t)t * 64 * vpitch, dv + slot * AT_BUF);
        if (ROPE) GLDS16(gr + (size_t)t * 64 * kbpitch, dr + slot * AT_BUF);
    };
    asm volatile("s_waitcnt vmcnt(0)" ::: "memory");
    issue(0, 0);
    if (ntiles > 1) issue(1, 1);
    bf16x8 qr[ND0];
    { const bf16_t* qp = Q + (size_t)(wid * 32 + r32) * qpitch + hi * 8;
#pragma unroll
      for (int d0 = 0; d0 < ND0; ++d0) qr[d0] = *(const bf16x8*)(qp + d0 * 16); }
    const int kf_off = AT_K + r32 * 128, ksw = (r32 >> 1) & 7;
    const int rf_off = AT_KR + r32 * 64, rsw = (r32 >> 2) & 3;
    const int vf_off = AT_V + (4 * hi + ((lane & 15) >> 2)) * 64 + ((lane >> 4) & 1) * 32 + (lane & 3) * 8;
    auto kfrag = [&](const char* slot, int g) -> bf16x8 {
        const int d0 = g >> 1, n = g & 1;
        if (d0 < 4) return *(const bf16x8*)(slot + kf_off + n * 32 * 128 + (((2 * d0 + hi) ^ ksw) << 4));
        return *(const bf16x8*)(slot + rf_off + n * 32 * 64 + (((2 * (d0 - 4) + hi) ^ rsw) << 4));
    };
    auto vfrag = [&](const char* slot, int g) -> bf16x8 {
        const lds_cptr vb = (lds_cptr)slot + vf_off + (g >> 1) * 1024 + (g & 1) * 4096;
        const s16x4 a0 = vtr(vb), a1 = vtr(vb + 512);
        return (bf16x8){a0[0], a0[1], a0[2], a0[3], a1[0], a1[1], a1[2], a1[3]};
    };
    f32x16 o0, o1, sA0, sA1, sB0, sB1;
    const f32x16 zero16 = {0.f, 0.f, 0.f, 0.f, 0.f, 0.f, 0.f, 0.f, 0.f, 0.f, 0.f, 0.f, 0.f, 0.f, 0.f, 0.f};
#pragma unroll
    for (int r = 0; r < 16; ++r) { o0[r] = 0.f; o1[r] = 0.f; }
    float mref, lrun = 0.f;
    if (ntiles > 1) asm volatile("s_waitcnt vmcnt(%0)" :: "n"(ROPE ? 3 : 2) : "memory"); else asm volatile("s_waitcnt vmcnt(0)" ::: "memory");
    __builtin_amdgcn_s_barrier();
    {
#pragma unroll
        for (int g = 0; g < NQK; ++g) { const bf16x8 kf = kfrag(lds, g);
            if (g & 1) sA1 = MFMA32(kf, qr[g >> 1], g < 2 ? zero16 : sA1); else sA0 = MFMA32(kf, qr[g >> 1], g < 2 ? zero16 : sA0); }
        float mx = fmaxf(sA0[0], sA1[0]);
#pragma unroll
        for (int r = 1; r < 16; ++r) mx = fmaxf(mx, fmaxf(sA0[r], sA1[r]));
        mref = xhalf_max(mx);
    }
    asm volatile("s_waitcnt vmcnt(0) lgkmcnt(0)" ::: "memory");
    __builtin_amdgcn_s_barrier();
    auto step = [&](auto HN, f32x16& c0, f32x16& c1, f32x16& n0, f32x16& n1, int t) __attribute__((always_inline)) {
        const int sl = t % 3, sl1 = (t + 1) % 3, sl2 = (t + 2) % 3;
        const char* cs = lds + sl * AT_BUF; const char* ns = lds + sl1 * AT_BUF;
        constexpr bool has_next = decltype(HN)::value;
        if (t + 2 < ntiles) issue(t + 2, sl2);
        u32x4 pw[4];
        float ls = 0.f;
        bf16x8 kf;
        if (has_next) kf = kfrag(ns, 0);
        SBAR();
#pragma unroll
        for (int g = 0; g < (NQK > 8 ? NQK : 8); ++g) {
            bf16x8 kcur = kf;
            if (has_next && g + 1 < NQK) kf = kfrag(ns, g + 1);
            SBAR();
            if (g < 8) {
                float e0, e1, e2, e3;
                if (g < 4) { e0 = __builtin_amdgcn_exp2f(c0[4 * g] - mref); e1 = __builtin_amdgcn_exp2f(c0[4 * g + 1] - mref); e2 = __builtin_amdgcn_exp2f(c0[4 * g + 2] - mref); e3 = __builtin_amdgcn_exp2f(c0[4 * g + 3] - mref); }
                else { e0 = __builtin_amdgcn_exp2f(c1[4 * (g - 4)] - mref); e1 = __builtin_amdgcn_exp2f(c1[4 * (g - 4) + 1] - mref); e2 = __builtin_amdgcn_exp2f(c1[4 * (g - 4) + 2] - mref); e3 = __builtin_amdgcn_exp2f(c1[4 * (g - 4) + 3] - mref); }
                ls += (e0 + e1) + (e2 + e3);
                const unsigned w0 = cvtpk(e0, e1), w1 = cvtpk(e2, e3);
                if ((g & 1) == 0) { pw[g >> 1][0] = w0; pw[g >> 1][1] = w1; } else { pw[g >> 1][2] = w0; pw[g >> 1][3] = w1; }
                PINV(ls); PINV(pw[g >> 1]);
            }
            SBAR();
            if (has_next && g < NQK) { if (g & 1) n1 = MFMA32(kcur, qr[g >> 1], g < 2 ? zero16 : n1); else n0 = MFMA32(kcur, qr[g >> 1], g < 2 ? zero16 : n0); }
            SBAR();
        }
        lrun += ls;
        float mx = -INFINITY;
        bf16x8 vf = vfrag(cs, 0);
        SBAR();
#pragma unroll
        for (int g = 0; g < 8; ++g) {
            const bf16x8 vcur = vf;
            if (g + 1 < 8) vf = vfrag(cs, g + 1);
            SBAR();
            if (has_next) {
                if (g < 4) mx = fmaxf(fmaxf(mx, fmaxf(n0[4 * g], n0[4 * g + 1])), fmaxf(n0[4 * g + 2], n0[4 * g + 3]));
                else mx = fmaxf(fmaxf(mx, fmaxf(n1[4 * (g - 4)], n1[4 * (g - 4) + 1])), fmaxf(n1[4 * (g - 4) + 2], n1[4 * (g - 4) + 3]));
                PINV(mx);
            }
            SBAR();
            const bf16x8 pf = __builtin_bit_cast(bf16x8, pw[g >> 1]);
            if (g & 1) o1 = MFMA32(vcur, pf, o1); else o0 = MFMA32(vcur, pf, o0);
            SBAR();
        }
        if (has_next) {
            const float gr_ = xhalf_max(mx) - mref;
            if (__any(gr_ > ATT_THR)) {
                const float d = fmaxf(gr_, 0.f), a = __builtin_amdgcn_exp2f(-d);
                mref += d; lrun *= a;
#pragma unroll
                for (int r = 0; r < 16; ++r) { o0[r] *= a; o1[r] *= a; }
            }
        }
        asm volatile("s_waitcnt vmcnt(0) lgkmcnt(0)" ::: "memory");
        __builtin_amdgcn_s_barrier();
    };
    {   const std::integral_constant<bool, true> yes; const std::integral_constant<bool, false> no;
        int t = 0;
        for (; t + 2 < ntiles; t += 2) { step(yes, sA0, sA1, sB0, sB1, t); step(yes, sB0, sB1, sA0, sA1, t + 1); }
        step(yes, sA0, sA1, sB0, sB1, t); step(no, sB0, sB1, sA0, sA1, t + 1); }
    const float inv = 1.0f / xhalf_sum(lrun);
    bf16_t* op = O + (size_t)(wid * 32 + r32) * 512 + 4 * hi;
#pragma unroll
    for (int rg = 0; rg < 4; ++rg) {
        uint2 a; a.x = pack2(o0[4 * rg] * inv, o0[4 * rg + 1] * inv); a.y = pack2(o0[4 * rg + 2] * inv, o0[4 * rg + 3] * inv);
        uint2 b; b.x = pack2(o1[4 * rg] * inv, o1[4 * rg + 1] * inv); b.y = pack2(o1[4 * rg + 2] * inv, o1[4 * rg + 3] * inv);
        *(uint2*)(op + 8 * rg) = a; *(uint2*)(op + 32 + 8 * rg) = b;
    }
}
constexpr int A3_K = 0, A3_KR = 16384, A3_V = 24576, A3_BYTES = 24576 + 3 * 8192;
template <int DQK>
__device__ __forceinline__ void attn_item3(const bf16_t* Q, int qpitch, const bf16_t* KA, int kapitch, const bf16_t* KB, int kbpitch,
                                           const bf16_t* V, int vpitch, int ntiles, bf16_t* O, char* lds) {
    const int tid = opaque_tid(), lane = tid & 63, wid = tid >> 6, r32 = lane & 31, hi = lane >> 5;
    const bool grpB = __builtin_amdgcn_readfirstlane(wid) >= 4;
    constexpr int ND0 = DQK / 16;
    bf16x8 qr[ND0];
    { const bf16_t* qp = Q + (size_t)(wid * 32 + r32) * qpitch + hi * 8;
#pragma unroll
      for (int d0 = 0; d0 < ND0; ++d0) qr[d0] = *(const bf16x8*)(qp + d0 * 16); }
    const int srow = tid >> 3, sch = tid & 7;
    const bf16_t* gk = KA + (size_t)srow * kapitch + sch * 8;
    const bf16_t* gv = V + (size_t)srow * vpitch + sch * 8;
    const bf16_t* gr = (DQK > 64) ? (KB + (size_t)(tid >> 2) * kbpitch + (tid & 3) * 8) : nullptr;
    const int sk_off = A3_K + srow * 128 + ((sch ^ ((srow >> 1) & 7)) << 4);
    const int sv_off = A3_V + (sch >> 2) * 4096 + srow * 64 + (sch & 3) * 16;
    const int sr_off = A3_KR + (tid >> 2) * 64 + (((tid & 3) ^ (((tid >> 2) >> 2) & 3)) << 4);
    const bool do_r = (DQK > 64) && (tid < 256);
    const int kf_off = A3_K + r32 * 128, ksw = (r32 >> 1) & 7;
    const int rf_off = A3_KR + r32 * 64, rsw = (r32 >> 2) & 3;
    const int vf_off = A3_V + (4 * hi + ((lane & 15) >> 2)) * 64 + ((lane >> 4) & 1) * 32 + (lane & 3) * 8;
    uint4 rk, rv, rr; rr = make_uint4(0, 0, 0, 0);
    rk = *(const uint4*)gk; rv = *(const uint4*)gv; if (do_r) rr = *(const uint4*)gr;
    *(uint4*)(lds + sk_off) = rk; *(uint4*)(lds + sv_off) = rv; if (do_r) *(uint4*)(lds + sr_off) = rr;
    __syncthreads();
    f32x16 o0, o1, p0, p1;
#pragma unroll
    for (int r = 0; r < 16; ++r) { o0[r] = 0.f; o1[r] = 0.f; p0[r] = 0.f; p1[r] = 0.f; }
    float mrun = -INFINITY, lrun = 0.f;
    auto H1 = [&](int t) __attribute__((always_inline)) {
        const char* ks = lds + (t & 1) * 8192; const char* rs = lds + (t & 1) * 4096;
#pragma unroll
        for (int r = 0; r < 16; ++r) { p0[r] = 0.f; p1[r] = 0.f; }
#pragma unroll
        for (int d0 = 0; d0 < 4; ++d0) {
            const int co = ((2 * d0 + hi) ^ ksw) << 4;
            const bf16x8 k0 = *(const bf16x8*)(ks + kf_off + co), k1 = *(const bf16x8*)(ks + kf_off + 32 * 128 + co);
            p0 = MFMA32(k0, qr[d0], p0); p1 = MFMA32(k1, qr[d0], p1);
        }
        if (DQK > 64) {
#pragma unroll
            for (int d0 = 4; d0 < ND0; ++d0) {
                const int co = ((2 * (d0 - 4) + hi) ^ rsw) << 4;
                const bf16x8 k0 = *(const bf16x8*)(rs + rf_off + co), k1 = *(const bf16x8*)(rs + rf_off + 32 * 64 + co);
                p0 = MFMA32(k0, qr[d0], p0); p1 = MFMA32(k1, qr[d0], p1);
            }
        }
        float mx = fmaxf(p0[0], p1[0]);
#pragma unroll
        for (int r = 1; r < 16; ++r) mx = fmaxf(mx, fmaxf(p0[r], p1[r]));
        mx = xhalf_max(mx);
        if (__any(mx > mrun + ATT_THR)) {
            const float mnew = fmaxf(mrun, mx), alpha = __builtin_amdgcn_exp2f(mrun - mnew);
            lrun *= alpha;
#pragma unroll
            for (int r = 0; r < 16; ++r) { o0[r] *= alpha; o1[r] *= alpha; }
            mrun = mnew;
        }
    };
    auto H2 = [&](int t) __attribute__((always_inline)) {
        const char* vs = lds + (t % 3) * 8192;
        float ls = 0.f;
#pragma unroll
        for (int r = 0; r < 16; ++r) { p0[r] = __builtin_amdgcn_exp2f(p0[r] - mrun); p1[r] = __builtin_amdgcn_exp2f(p1[r] - mrun); ls += p0[r] + p1[r]; }
        lrun += ls;
#pragma unroll
        for (int s = 0; s < 4; ++s) {
            bf16x8 pf;
            {   unsigned w0, w1, w2, w3;
                if (s < 2) { w0 = cvtpk(p0[8 * s], p0[8 * s + 1]); w1 = cvtpk(p0[8 * s + 2], p0[8 * s + 3]); w2 = cvtpk(p0[8 * s + 4], p0[8 * s + 5]); w3 = cvtpk(p0[8 * s + 6], p0[8 * s + 7]); }
                else { const int s2 = s - 2; w0 = cvtpk(p1[8 * s2], p1[8 * s2 + 1]); w1 = cvtpk(p1[8 * s2 + 2], p1[8 * s2 + 3]); w2 = cvtpk(p1[8 * s2 + 4], p1[8 * s2 + 5]); w3 = cvtpk(p1[8 * s2 + 6], p1[8 * s2 + 7]); }
                u32x4 u = {w0, w1, w2, w3}; pf = __builtin_bit_cast(bf16x8, u); }
            const lds_cptr vb = (lds_cptr)vs + vf_off + s * 1024;
            const s16x4 a0 = vtr(vb), a1 = vtr(vb + 512), b0 = vtr(vb + 4096), b1 = vtr(vb + 4096 + 512);
            const bf16x8 v0 = (bf16x8){a0[0], a0[1], a0[2], a0[3], a1[0], a1[1], a1[2], a1[3]};
            const bf16x8 v1 = (bf16x8){b0[0], b0[1], b0[2], b0[3], b1[0], b1[1], b1[2], b1[3]};
            o0 = MFMA32(v0, pf, o0); o1 = MFMA32(v1, pf, o1);
        }
    };
#define A3_LOAD(t) do { rk = *(const uint4*)(gk + (size_t)((t) + 1) * 64 * kapitch); rv = *(const uint4*)(gv + (size_t)((t) + 1) * 64 * vpitch); if (do_r) rr = *(const uint4*)(gr + (size_t)((t) + 1) * 64 * kbpitch); } while (0)
#define A3_WRITE(t) do { const int kn = ((t) + 1) & 1, vn = ((t) + 1) % 3; *(uint4*)(lds + kn * 8192 + sk_off) = rk; *(uint4*)(lds + vn * 8192 + sv_off) = rv; if (do_r) *(uint4*)(lds + kn * 4096 + sr_off) = rr; } while (0)
    if (grpB) {
        { const bool more = (1 < ntiles); if (more) A3_LOAD(0); H1(0); if (more) A3_WRITE(0); __syncthreads(); }
        for (int t = 1; t < ntiles; ++t) {
            const bool more = (t + 1 < ntiles);
            if (more) A3_LOAD(t);
            H2(t - 1); H1(t);
            if (more) A3_WRITE(t);
            __syncthreads();
        }
    } else {
        for (int t = 0; t < ntiles; ++t) {
            const bool more = (t + 1 < ntiles);
            if (more) A3_LOAD(t);
            H1(t); H2(t);
            if (more) A3_WRITE(t);
            __syncthreads();
        }
    }
#undef A3_LOAD
#undef A3_WRITE
    if (grpB) H2(ntiles - 1);
    const float inv = 1.0f / xhalf_sum(lrun);
    bf16_t* op = O + (size_t)(wid * 32 + r32) * 512 + 4 * hi;
#pragma unroll
    for (int rg = 0; rg < 4; ++rg) {
        uint2 a; a.x = pack2(o0[4 * rg] * inv, o0[4 * rg + 1] * inv); a.y = pack2(o0[4 * rg + 2] * inv, o0[4 * rg + 3] * inv);
        uint2 b; b.x = pack2(o1[4 * rg] * inv, o1[4 * rg + 1] * inv); b.y = pack2(o1[4 * rg + 2] * inv, o1[4 * rg + 3] * inv);
        *(uint2*)(op + 8 * rg) = a; *(uint2*)(op + 32 + 8 * rg) = b;
    }
    __syncthreads();
}
template <int DQK>
__device__ __forceinline__ void attn_item4(const bf16_t* Q, int qpitch, const bf16_t* KA, int kapitch, const bf16_t* KB, int kbpitch,
                                           const bf16_t* V, int vpitch, int ntiles, float ref_const, float kmax2, bf16_t* O, char* lds) {
    const int tid = opaque_tid(), lane = tid & 63, wid = tid >> 6, r32 = lane & 31, hi = lane >> 5;
    constexpr int ND0 = DQK / 16;
    bf16x8 qr[ND0];
    { const bf16_t* qp = Q + (size_t)(wid * 32 + r32) * qpitch + hi * 8;
#pragma unroll
      for (int d0 = 0; d0 < ND0; ++d0) qr[d0] = *(const bf16x8*)(qp + d0 * 16); }
    float mref = ref_const;
    if (DQK > 64) {
        float qn2 = 0.f;
#pragma unroll
        for (int d0 = 0; d0 < ND0; ++d0)
#pragma unroll
            for (int j = 0; j < 8; ++j) { const float v = bf2f((bf16_t)qr[d0][j]); qn2 = fmaf(v, v, qn2); }
        qn2 = xhalf_sum(qn2);
        mref = sqrtf(qn2 * kmax2) * 1.01f + 0.01f;
    }
    f32x16 negm;
#pragma unroll
    for (int r = 0; r < 16; ++r) negm[r] = -mref;
    const int srow = tid >> 3, sch = tid & 7;
    const bf16_t* gk = KA + (size_t)srow * kapitch + sch * 8;
    const bf16_t* gv = V + (size_t)srow * vpitch + sch * 8;
    const bf16_t* gr = (DQK > 64) ? (KB + (size_t)(tid >> 2) * kbpitch + (tid & 3) * 8) : nullptr;
    const int sk_off = AT_K + srow * 128 + ((sch ^ ((srow >> 1) & 7)) << 4);
    const int sv_off = AT_V + (sch >> 2) * 4096 + srow * 64 + (sch & 3) * 16;
    const int sr_off = AT_KR + (tid >> 2) * 64 + (((tid & 3) ^ (((tid >> 2) >> 2) & 3)) << 4);
    const bool do_r = (DQK > 64) && (tid < 256);
    const int kf_off = AT_K + r32 * 128, ksw = (r32 >> 1) & 7;
    const int rf_off = AT_KR + r32 * 64, rsw = (r32 >> 2) & 3;
    const int vf_off = AT_V + (4 * hi + ((lane & 15) >> 2)) * 64 + ((lane >> 4) & 1) * 32 + (lane & 3) * 8;
    uint4 rk, rv, rr; rr = make_uint4(0, 0, 0, 0);
    rk = *(const uint4*)gk; rv = *(const uint4*)gv; if (do_r) rr = *(const uint4*)gr;
    *(uint4*)(lds + sk_off) = rk; *(uint4*)(lds + sv_off) = rv; if (do_r) *(uint4*)(lds + sr_off) = rr;
    __syncthreads();
    f32x16 o0, o1;
#pragma unroll
    for (int r = 0; r < 16; ++r) { o0[r] = 0.f; o1[r] = 0.f; }
    float lrun = 0.f;
#pragma unroll 1
    for (int t = 0; t < ntiles; ++t) {
        const char* cur = lds + (t & 1) * AT_BUF; char* nxt = lds + ((t + 1) & 1) * AT_BUF;
        const bool more = (t + 1 < ntiles);
        if (more) { rk = *(const uint4*)(gk + (size_t)(t + 1) * 64 * kapitch); rv = *(const uint4*)(gv + (size_t)(t + 1) * 64 * vpitch); if (do_r) rr = *(const uint4*)(gr + (size_t)(t + 1) * 64 * kbpitch); }
        bf16x8 kf[8];
#pragma unroll
        for (int d0 = 0; d0 < 4; ++d0) { const int co = ((2 * d0 + hi) ^ ksw) << 4; kf[2 * d0] = *(const bf16x8*)(cur + kf_off + co); kf[2 * d0 + 1] = *(const bf16x8*)(cur + kf_off + 32 * 128 + co); }
        f32x16 p0, p1;
        p0 = MFMA32(kf[0], qr[0], negm); p1 = MFMA32(kf[1], qr[0], negm);
        p0 = MFMA32(kf[2], qr[1], p0); p1 = MFMA32(kf[3], qr[1], p1);
        if (DQK > 64) {
            __builtin_amdgcn_sched_barrier(0);
#pragma unroll
            for (int d0 = 4; d0 < ND0; ++d0) { const int co = ((2 * (d0 - 4) + hi) ^ rsw) << 4; kf[2 * (d0 - 4)] = *(const bf16x8*)(cur + rf_off + co); kf[2 * (d0 - 4) + 1] = *(const bf16x8*)(cur + rf_off + 32 * 64 + co); }
        }
        p0 = MFMA32(kf[4], qr[2], p0); p1 = MFMA32(kf[5], qr[2], p1);
        p0 = MFMA32(kf[6], qr[3], p0); p1 = MFMA32(kf[7], qr[3], p1);
        if (DQK > 64) {
#pragma unroll
            for (int d0 = 4; d0 < ND0; ++d0) { p0 = MFMA32(kf[2 * (d0 - 4)], qr[d0], p0); p1 = MFMA32(kf[2 * (d0 - 4) + 1], qr[d0], p1); }
        }
        bf16x8 vf[8];
        auto vload = [&](int s) __attribute__((always_inline)) {
            const lds_cptr vb = (lds_cptr)cur + vf_off + s * 1024;
            const s16x4 a0 = vtr(vb), a1 = vtr(vb + 512), b0 = vtr(vb + 4096), b1 = vtr(vb + 4096 + 512);
            vf[2 * s] = (bf16x8){a0[0], a0[1], a0[2], a0[3], a1[0], a1[1], a1[2], a1[3]};
            vf[2 * s + 1] = (bf16x8){b0[0], b0[1], b0[2], b0[3], b1[0], b1[1], b1[2], b1[3]};
        };
        vload(0); vload(1);
        float ls = 0.f;
#pragma unroll
        for (int s = 0; s < 4; ++s) {
            float e[8];
#pragma unroll
            for (int j = 0; j < 8; ++j) e[j] = __builtin_amdgcn_exp2f(s < 2 ? p0[8 * s + j] : p1[8 * (s - 2) + j]);
            ls += ((e[0] + e[1]) + (e[2] + e[3])) + ((e[4] + e[5]) + (e[6] + e[7]));
            u32x4 u = {cvtpk(e[0], e[1]), cvtpk(e[2], e[3]), cvtpk(e[4], e[5]), cvtpk(e[6], e[7])};
            const bf16x8 pf = __builtin_bit_cast(bf16x8, u);
            if (s + 2 < 4) vload(s + 2);
            o0 = MFMA32(vf[2 * s], pf, o0); o1 = MFMA32(vf[2 * s + 1], pf, o1);
        }
        lrun += ls;
        if (more) { *(uint4*)(nxt + sk_off) = rk; *(uint4*)(nxt + sv_off) = rv; if (do_r) *(uint4*)(nxt + sr_off) = rr; }
        __syncthreads();
    }
    const float inv = 1.0f / xhalf_sum(lrun);
    bf16_t* op = O + (size_t)(wid * 32 + r32) * 512 + 4 * hi;
#pragma unroll
    for (int rg = 0; rg < 4; ++rg) {
        uint2 a; a.x = pack2(o0[4 * rg] * inv, o0[4 * rg + 1] * inv); a.y = pack2(o0[4 * rg + 2] * inv, o0[4 * rg + 3] * inv);
        uint2 b; b.x = pack2(o1[4 * rg] * inv, o1[4 * rg + 1] * inv); b.y = pack2(o1[4 * rg + 2] * inv, o1[4 * rg + 3] * inv);
        *(uint2*)(op + 8 * rg) = a; *(uint2*)(op + 32 + 8 * rg) = b;
    }
}
constexpr int A7_K = 0, A7_V = 8192, A7_KR = 16384, A7_BUF = 20480;
template <int DQK>
__device__ __forceinline__ void attn_item7(const bf16_t* Q, int qpitch, const bf16_t* KA, int kapitch, const bf16_t* KB, int kbpitch,
                                           const bf16_t* V, int vpitch, int ntiles, float ref_const, float kmax2, bf16_t* O, char* lds) {
    const int tid = opaque_tid(), lane = tid & 63, wid = tid >> 6, fr = lane & 15, g = lane >> 4;
    constexpr int NKS = DQK / 32;
    bf16x8 qr[2][NKS];
#pragma unroll
    for (int qi = 0; qi < 2; ++qi) { const bf16_t* qp = Q + (size_t)(wid * 32 + 16 * qi + fr) * qpitch + 8 * g;
#pragma unroll
        for (int ks = 0; ks < NKS; ++ks) qr[qi][ks] = *(const bf16x8*)(qp + 32 * ks); }
    f32x4 negm[2];
#pragma unroll
    for (int qi = 0; qi < 2; ++qi) {
        float mref = ref_const;
        if (DQK > 64) {
            float qn2 = 0.f;
#pragma unroll
            for (int ks = 0; ks < NKS; ++ks)
#pragma unroll
                for (int j = 0; j < 8; ++j) { const float v = bf2f((bf16_t)qr[qi][ks][j]); qn2 = fmaf(v, v, qn2); }
            qn2 += __shfl_xor(qn2, 16); qn2 += __shfl_xor(qn2, 32);
            mref = sqrtf(qn2 * kmax2) * 1.01f + 0.01f;
        }
        negm[qi][0] = -mref; negm[qi][1] = -mref; negm[qi][2] = -mref; negm[qi][3] = -mref;
    }
    const int srow = tid >> 3, sch = tid & 7;
    const bf16_t* gk = KA + (size_t)srow * kapitch + sch * 8;
    const bf16_t* gv = V + (size_t)srow * vpitch + sch * 8;
    const bf16_t* gr = (DQK > 64) ? (KB + (size_t)(tid >> 2) * kbpitch + (tid & 3) * 8) : nullptr;
    const int sk_off = A7_K + srow * 128 + ((sch ^ ((srow >> 1) & 7)) << 4);
    const int sv_off = A7_V + (sch >> 1) * 2048 + srow * 32 + (sch & 1) * 16;
    const int sr_off = A7_KR + (tid >> 2) * 64 + ((((tid & 3) + 2 * ((tid >> 2) >> 2)) & 3) << 4);
    const bool do_r = (DQK > 64) && (tid < 256);
    const int kf_off = A7_K + fr * 128, ksw = (fr >> 1) & 7;
    const int rf_off = A7_KR + fr * 64 + (((g + 2 * (fr >> 2)) & 3) << 4);
    const int vf_off = A7_V + (4 * g + (fr >> 2)) * 32 + (fr & 3) * 8;
    uint4 rk, rv, rr; rr = make_uint4(0, 0, 0, 0);
    rk = *(const uint4*)gk; rv = *(const uint4*)gv; if (do_r) rr = *(const uint4*)gr;
    *(uint4*)(lds + sk_off) = rk; *(uint4*)(lds + sv_off) = rv; if (do_r) *(uint4*)(lds + sr_off) = rr;
    __syncthreads();
    f32x4 o[4][2]; float lsum[2] = {0.f, 0.f};
#pragma unroll
    for (int di = 0; di < 4; ++di)
#pragma unroll
        for (int qi = 0; qi < 2; ++qi) { o[di][qi][0] = 0.f; o[di][qi][1] = 0.f; o[di][qi][2] = 0.f; o[di][qi][3] = 0.f; }
#pragma unroll 1
    for (int t = 0; t < ntiles; ++t) {
        const char* cur = lds + (t & 1) * A7_BUF; char* nxt = lds + ((t + 1) & 1) * A7_BUF;
        const bool more = (t + 1 < ntiles);
        if (more) { rk = *(const uint4*)(gk + (size_t)(t + 1) * 64 * kapitch); rv = *(const uint4*)(gv + (size_t)(t + 1) * 64 * vpitch); if (do_r) rr = *(const uint4*)(gr + (size_t)(t + 1) * 64 * kbpitch); }
        f32x4 s[4][2];
#pragma unroll
        for (int ks = 0; ks < NKS; ++ks) {
            bf16x8 kf[4];
#pragma unroll
            for (int kj = 0; kj < 4; ++kj)
                kf[kj] = (ks < 2) ? *(const bf16x8*)(cur + kf_off + kj * 2048 + (((4 * ks + g) ^ ksw) << 4)) : *(const bf16x8*)(cur + rf_off + kj * 1024);
#pragma unroll
            for (int kj = 0; kj < 4; ++kj)
#pragma unroll
                for (int qi = 0; qi < 2; ++qi) s[kj][qi] = MFMA16(kf[kj], qr[qi][ks], ks == 0 ? negm[qi] : s[kj][qi]);
        }
#pragma unroll
        for (int kk = 0; kk < 2; ++kk) {
            bf16x8 vf[4];
#pragma unroll
            for (int di = 0; di < 4; ++di) {
                const lds_cptr vb = (lds_cptr)cur + vf_off + di * 2048 + kk * 1024;
                const s16x4 a0 = vtr(vb), a1 = vtr(vb + 512);
                vf[di] = (bf16x8){a0[0], a0[1], a0[2], a0[3], a1[0], a1[1], a1[2], a1[3]};
            }
            bf16x8 pf[2];
#pragma unroll
            for (int qi = 0; qi < 2; ++qi) {
                float e[8];
#pragma unroll
                for (int j = 0; j < 4; ++j) { e[j] = __builtin_amdgcn_exp2f(s[2 * kk][qi][j]); e[4 + j] = __builtin_amdgcn_exp2f(s[2 * kk + 1][qi][j]); }
                lsum[qi] += ((e[0] + e[1]) + (e[2] + e[3])) + ((e[4] + e[5]) + (e[6] + e[7]));
                u32x4 u = {cvtpk(e[0], e[1]), cvtpk(e[2], e[3]), cvtpk(e[4], e[5]), cvtpk(e[6], e[7])};
                pf[qi] = __builtin_bit_cast(bf16x8, u);
            }
#pragma unroll
            for (int di = 0; di < 4; ++di) { o[di][0] = MFMA16(vf[di], pf[0], o[di][0]); o[di][1] = MFMA16(vf[di], pf[1], o[di][1]); }
        }
        if (more) { *(uint4*)(nxt + sk_off) = rk; *(uint4*)(nxt + sv_off) = rv; if (do_r) *(uint4*)(nxt + sr_off) = rr; }
        __syncthreads();
    }
#pragma unroll
    for (int qi = 0; qi < 2; ++qi) {
        float l = lsum[qi]; l += __shfl_xor(l, 16); l += __shfl_xor(l, 32);
        const float inv = 1.0f / l;
        bf16_t* op = O + (size_t)(wid * 32 + 16 * qi + fr) * 512 + 4 * g;
#pragma unroll
        for (int di = 0; di < 4; ++di) *(uint2*)(op + 16 * di) = pack4(o[di][qi] * inv);
    }
}
__device__ __forceinline__ void attn_dispatch(const KP& p, int ty, int h, int qt, float gqa_ref, char* lds) {
    const bf16_t* P = WSP(bf16_t, OFF_P); const bf16_t* Qm = WSP(bf16_t, OFF_H); const bf16_t* Kn = WSP(bf16_t, OFF_KN); const bf16_t* Vm = WSP(bf16_t, OFF_V);
    const int ntiles = (qt == 0) ? (LC / 64) : (T / 64);
    const size_t r0 = (size_t)qt * 256;
    bf16_t* Om = WSP(bf16_t, OFF_OM); bf16_t* Og = WSP(bf16_t, OFF_OG);
    if (ty == 0) {
        const float kmax2 = __uint_as_float(WSP(unsigned, OFF_CNT)[32 + h]);
        attn_item7<96>(Qm + r0 * 768 + h * 96, 768, Kn + h * 64, 512, P + C_KR, PP, Vm + h * 64, 512, ntiles, 0.f, kmax2, Om + r0 * 512 + h * 64, lds);
    } else
        attn_item7<64>(P + r0 * PP + C_GQ + h * 64, PP, P + C_GK + (h >> 2) * 64, PP, nullptr, 0, P + C_GV + (h >> 2) * 64, PP, ntiles, gqa_ref, 0.f, Og + r0 * 512 + h * 64, lds);
}
__device__ __forceinline__ void st_attn(const KP& p, int l, int bid, int nb, char* lds) {
    const int tidx = opaque_tid();
    float gq = fabsf(p.in(I_GQN)[l * 64 + (tidx & 63)]), gk = fabsf(p.in(I_GKN)[l * 64 + (tidx & 63)]);
#pragma unroll
    for (int o = 32; o > 0; o >>= 1) { gq = fmaxf(gq, __shfl_xor(gq, o)); gk = fmaxf(gk, __shfl_xor(gk, o)); }
    const float gqa_ref = 64.0f * SC_GQA * gq * gk * 1.02f + 0.01f;
    for (int ty = 0; ty < 2; ++ty)
        for (int u = bid; u < 512; u += nb) attn_dispatch(p, ty, u & 7, 1 + (u >> 3), gqa_ref, lds);
    for (int u = bid; u < 16; u += nb) attn_dispatch(p, u >> 3, u & 7, 0, gqa_ref, lds);
}

__device__ __forceinline__ void st_merge(const KP& p, int l, int bid, int nb, char* lds) {
    const int tidx = opaque_tid();
    const bf16_t* P = WSP(bf16_t, OFF_P); bf16_t* Mb = WSP(bf16_t, OFF_H);
    const bf16_t* Wb = WSP(bf16_t, OFF_WB + WB_BR);
    int mt, nt;
    for (int it = 0; dense_tile(it, 8, l + 1 < NL, bid, nb, mt, nt); ++it) {
        acc_t tot; acc_zero(tot);
#pragma unroll 1
        for (int b = 0; b < 3; ++b) {
            const bf16_t* Ob = b == 1 ? P + C_SSM : WSP(bf16_t, b == 0 ? OFF_OM : OFF_OG); const int opitch = b == 1 ? PP : 512;
            acc_t acc; acc_zero(acc);
            gemm_core(acc, [&](int r) { return Ob + (size_t)(mt * 256 + r) * opitch; }, [&](int r) { return Wb + ((size_t)b * 1024 + nt * 128 + r) * 512; }, 512, lds);
            acc_visit_add(acc, tot, [&](int ml, int nl, f32x4 v) {
                const int wm_ = ml >> 6, im_ = (ml >> 4) & 3, fr_ = ml & 15, G_ = b * 64 + nt * 8 + (nl >> 4), g_ = (nl >> 2) & 3;
                const uint2 gr = *(const uint2*)(WSP(bf16_t, OFF_GS) + (((((size_t)(mt * 192 + G_) * 4 + wm_) * 4 + im_) * 64) + g_ * 16 + fr_) * 4);
                f32x4 r; r[0] = bflo(gr.x) * v[0]; r[1] = bfhi(gr.x) * v[1]; r[2] = bflo(gr.y) * v[2]; r[3] = bfhi(gr.y) * v[3];
                return r; });
        }
        acc_visit(tot, [&](int ml, int nl, f32x4 v) { *(uint2*)(Mb + (size_t)(mt * 256 + ml) * 1024 + nt * 128 + nl) = pack4(v); });
    }
}
__device__ __forceinline__ void st_wout(const KP& p, int l, int bid, int nb, char* lds) {
    const int tidx = opaque_tid();
    const bf16_t* Mb = WSP(bf16_t, OFF_H); const bf16_t* Wt = WSP(bf16_t, OFF_WB + WB_OUT); float* Y = WSP(float, OFF_Y);
    int mt, nt;
    for (int it = 0; dense_tile(it, 4, l + 1 < NL, bid, nb, mt, nt); ++it) {
        acc_t acc[2]; acc_zero(acc[0]); acc_zero(acc[1]);
        gemm_core256_dense(acc, Mb + (size_t)mt * 256 * 1024, 1024, Wt + (size_t)nt * 256 * 1024, 1024, 1024, lds);
#pragma unroll
        for (int nh = 0; nh < 2; ++nh)
            acc_visit2(acc[nh], [&](int ml, int nl, f32x4 v) { *(f32x4*)(Y + (size_t)(mt * 256 + ml) * 1024 + nt * 256 + nh * 128 + nl) = v; });
    }
    int* sltok = WSP(int, OFF_SLTOK); float* slw = WSP(float, OFF_SLW); int* cnt = WSP(int, OFF_CNT);
#pragma unroll 1
    for (int i = bid * NTH + tidx; i < TP; i += nb * NTH) { sltok[i] = 0; slw[i] = 0.f; asm volatile("" : "+v"(i)); }
    if (bid == 0 && tidx < 32) cnt[tidx] = 0;
}

__device__ __forceinline__ void st_postmix(const KP& p, int l, int bid, int nb, char* lds) {
    const int tidx = opaque_tid();
    const int lane = tidx & 63, wid = tidx >> 6;
    const float* Y = WSP(float, OFF_Y); bf16_t* H2 = WSP(bf16_t, OFF_H);
    const float* gpost = p.in(I_GPOSTMIX) + l * D; const float* gpre = p.in(I_GPREFFN) + l * D;
    int* toke = WSP(int, OFF_TOKE); float* tokw = WSP(float, OFF_TOKW); int* cnt = WSP(int, OFF_CNT);
    float* wl = (float*)lds; int* hist = (int*)(lds + 20 * 1024 * 4);
    {   const float* wg = p.in(I_WGROUP) + (size_t)l * D * 4; const float* wr = p.in(I_WROUTER) + (size_t)l * D * 16;
        for (int k = tidx; k < 1024; k += NTH) {
            const float4 g4 = *(const float4*)(wg + (size_t)k * 4);
            wl[0 * 1024 + k] = g4.x; wl[1 * 1024 + k] = g4.y; wl[2 * 1024 + k] = g4.z; wl[3 * 1024 + k] = g4.w;
#pragma unroll
            for (int e4 = 0; e4 < 4; ++e4) { const float4 r4 = *(const float4*)(wr + (size_t)k * 16 + e4 * 4);
                wl[(4 + e4 * 4 + 0) * 1024 + k] = r4.x; wl[(4 + e4 * 4 + 1) * 1024 + k] = r4.y; wl[(4 + e4 * 4 + 2) * 1024 + k] = r4.z; wl[(4 + e4 * 4 + 3) * 1024 + k] = r4.w; }
        }
        if (tidx < 16) hist[tidx] = 0;
        __syncthreads(); }
    auto ld = [&](int r, float4 (&y)[4], float4 (&x)[4]) __attribute__((always_inline)) {
        const float* xs = l == 0 ? xrow_in(p, r) : xrow_c(p, r);
#pragma unroll
        for (int i = 0; i < 4; ++i) { y[i] = *(const float4*)(Y + (size_t)r * D + i * 256 + lane * 4); x[i] = *(const float4*)(xs + i * 256 + lane * 4); }
    };
    auto proc = [&](int r, float4 (&y)[4], float4 (&x)[4]) __attribute__((always_inline)) {
        float* xr = xrow(p, r);
        const float* md = WSP(float, OFF_MOD) + (size_t)(l * 2 + (r < LC ? 1 : 0)) * 6144;
        float ss = 0.f;
#pragma unroll
        for (int i = 0; i < 4; ++i) ss += y[i].x * y[i].x + y[i].y * y[i].y + y[i].z * y[i].z + y[i].w * y[i].w;

        ss = wave_sum(ss);
        const float rstd = rsqrtf(ss * (1.0f / D) + EPS);
        float ss2 = 0.f;
#pragma unroll
        for (int i = 0; i < 4; ++i) { const int c = i * 256 + lane * 4;
            const float4 gg = *(const float4*)(gpost + c), ga = *(const float4*)(md + 2048 + c);
            x[i].x += ga.x * y[i].x * rstd * gg.x; x[i].y += ga.y * y[i].y * rstd * gg.y; x[i].z += ga.z * y[i].z * rstd * gg.z; x[i].w += ga.w * y[i].w * rstd * gg.w;
            *(float4*)(xr + c) = x[i];
            ss2 += x[i].x * x[i].x + x[i].y * x[i].y + x[i].z * x[i].z + x[i].w * x[i].w; }
        ss2 = wave_sum(ss2);
        const float rstd2 = rsqrtf(ss2 * (1.0f / D) + EPS);
        float lg[4] = {0.f, 0.f, 0.f, 0.f}, le[16];
#pragma unroll
        for (int e = 0; e < 16; ++e) le[e] = 0.f;
#pragma unroll
        for (int i = 0; i < 4; ++i) { const int c = i * 256 + lane * 4;
            const float4 gg = *(const float4*)(gpre + c), sh = *(const float4*)(md + 3072 + c), sc = *(const float4*)(md + 4096 + c);
            float h[4];
            h[0] = x[i].x * rstd2 * gg.x * (1.f + sc.x) + sh.x; h[1] = x[i].y * rstd2 * gg.y * (1.f + sc.y) + sh.y;
            h[2] = x[i].z * rstd2 * gg.z * (1.f + sc.z) + sh.z; h[3] = x[i].w * rstd2 * gg.w * (1.f + sc.w) + sh.w;
            uint2 o; o.x = pack2(h[0], h[1]); o.y = pack2(h[2], h[3]);
            *(uint2*)(H2 + (size_t)r * D + c) = o;
#pragma unroll
            for (int e = 0; e < 4; ++e) { const float4 w4 = *(const float4*)(wl + e * 1024 + c);
                lg[e] = fmaf(h[0], w4.x, lg[e]); lg[e] = fmaf(h[1], w4.y, lg[e]); lg[e] = fmaf(h[2], w4.z, lg[e]); lg[e] = fmaf(h[3], w4.w, lg[e]); }
#pragma unroll
            for (int e = 0; e < 16; ++e) { const float4 w4 = *(const float4*)(wl + (4 + e) * 1024 + c);
                le[e] = fmaf(h[0], w4.x, le[e]); le[e] = fmaf(h[1], w4.y, le[e]); le[e] = fmaf(h[2], w4.z, le[e]); le[e] = fmaf(h[3], w4.w, le[e]); }
        }
#pragma unroll
        for (int g = 0; g < 4; ++g) lg[g] = wave_sum(lg[g]) + p.in(I_BGROUP)[l * 4 + g];
        const float myle = transpose_reduce16(le, lane) + p.in(I_BROUTER)[l * 16 + (lane & 15)];
        int gs = 0; float gm = lg[0];
#pragma unroll
        for (int g = 1; g < 4; ++g) if (lg[g] > gm) { gm = lg[g]; gs = g; }
        float ls[4];
#pragma unroll
        for (int i = 0; i < 4; ++i) ls[i] = __shfl(myle, gs * 4 + i);
        if (lane == 0) {
            float den = 0.f;
#pragma unroll
            for (int g = 0; g < 4; ++g) den += __expf(lg[g] - gm);
            const float pg = 1.0f / den;
            int i0 = 0; float m0 = ls[0];
#pragma unroll
            for (int i = 1; i < 4; ++i) if (ls[i] > m0) { m0 = ls[i]; i0 = i; }
            int i1 = -1; float m1 = -INFINITY;
#pragma unroll
            for (int i = 0; i < 4; ++i) if (i != i0 && ls[i] > m1) { m1 = ls[i]; i1 = i; }
            const float e1 = __expf(m1 - m0), w0 = pg / (1.f + e1), w1 = pg * e1 / (1.f + e1);
            const int ex0 = gs * 4 + i0, ex1 = gs * 4 + i1;
            toke[r * 2] = ex0; toke[r * 2 + 1] = ex1; tokw[r * 2] = w0; tokw[r * 2 + 1] = w1;
            atomicAdd(&hist[ex0], 1); atomicAdd(&hist[ex1], 1);
        }
        };
    {   const int r0 = (l + 1 < NL ? 0 : LC) + bid * NWV + wid, rs = nb * NWV;
        float4 ya[4], xa[4], yb[4], xb[4];
        if (r0 < T) ld(r0, ya, xa);
        for (int r = r0; r < T; r += 2 * rs) {
            if (r + rs < T) ld(r + rs, yb, xb);
            proc(r, ya, xa);
            if (r + rs < T) { if (r + 2 * rs < T) ld(r + 2 * rs, ya, xa); proc(r + rs, yb, xb); }
        } }
    __syncthreads();
    if (tidx < 16 && hist[tidx] != 0) atomicAdd(&cnt[tidx], hist[tidx]);
}

__device__ __forceinline__ void moe_offsets(const int* cnt, int* off) {
    int a = 0;
#pragma unroll
    for (int e = 0; e < 16; ++e) { off[e] = a; a += (cnt[e] + 255) & ~255; }
    off[16] = a;
}
__device__ __forceinline__ int moe_expert_of(const int* off, int j) {
    int e = 0;
#pragma unroll
    for (int k = 1; k < 16; ++k) e += (j >= off[k]) ? 1 : 0;
    return e;
}
__device__ __forceinline__ void st_moe_build(const KP& p, int l, int bid, int nb, char* lds) {
    const int tidx = opaque_tid();
    int* cnt = WSP(int, OFF_CNT); int* cnt2 = cnt + 16;
    const int* toke = WSP(int, OFF_TOKE); const float* tokw = WSP(float, OFF_TOKW); int* toks = WSP(int, OFF_TOKS);
    int* sltok = WSP(int, OFF_SLTOK); float* slw = WSP(float, OFF_SLW);
    int* lcnt = (int*)lds; int* lbase = lcnt + 16;
    int off[17]; moe_offsets(cnt, off);
    const int first = (l + 1 < NL ? 0 : 2 * LC), total = 2 * T - first, per = (total + nb - 1) / nb;
    const int beg = first + bid * per, end = min(beg + per, 2 * T);
    __syncthreads();
    if (tidx < 16) lcnt[tidx] = 0;
    __syncthreads();
    const int idx = beg + tidx; const bool act = (tidx < per) && (idx < end);
    int e = 0, rank = 0;
    if (act) { e = toke[idx]; rank = atomicAdd(&lcnt[e], 1); }
    __syncthreads();
    if (tidx < 16) lbase[tidx] = lcnt[tidx] ? atomicAdd(&cnt2[tidx], lcnt[tidx]) : 0;
    __syncthreads();
    if (act) {
        int o = 0;
#pragma unroll
        for (int k = 0; k < 16; ++k) o = (e == k) ? off[k] : o;
        const int pos = o + lbase[e] + rank;
        sltok[pos] = idx >> 1; slw[pos] = tokw[idx]; toks[idx] = pos;
    }
}
__device__ __forceinline__ bool moe_tile(int r, int M2, int bid, int nb, int& mt, int& pn) {
    const int x = bid & 7, j = bid >> 3, q = nb >> 5;
    mt = (r * 8 + x) * q + (j % q); pn = j / q;
    return mt < M2 && pn < 4;
}
__device__ __forceinline__ void st_moe_up(const KP& p, int bid, int nb, char* lds) {
    const int tidx = opaque_tid();
    const int* cnt = WSP(int, OFF_CNT); const int* sltok = WSP(int, OFF_SLTOK);
    const bf16_t* H2 = WSP(bf16_t, OFF_H); const bf16_t* Wg = WSP(bf16_t, OFF_WB + WB_EG); bf16_t* Hid = WSP(bf16_t, OFF_HID);
    int off[17]; moe_offsets(cnt, off);
    const int M2 = off[16] >> 8;
    const int srow = tidx >> 3, gch = (tidx & 7) ^ ((srow >> 1) & 7);
    auto upin = [](const char* q) { asm volatile("" : "+s"(q)); return q; };
    const unsigned vw = (unsigned)(((srow >> 4) & 1) ? (unsigned)(WB_EU - WB_EG) : 0u) + (unsigned)(((((srow >> 5) & 1) * 16 + (srow & 15)) * 1024 + gch * 8) * 2);
    int mt, pn;
    for (int r = 0; r * 8 * (nb >> 5) < M2; ++r) {
        if (!moe_tile(r, M2, bid, nb, mt, pn)) continue;
        const int e = __builtin_amdgcn_readfirstlane(moe_expert_of(off, mt * 256));
        unsigned xo[2][2];
#pragma unroll
        for (int h = 0; h < 2; ++h)
#pragma unroll
            for (int i = 0; i < 2; ++i) xo[h][i] = (unsigned)sltok[mt * 256 + h * 128 + srow + 64 * i] * 2048u + (unsigned)gch * 16u;
        acc_t acc[2]; acc_zero(acc[0]); acc_zero(acc[1]);
        gemm_core256(acc, [&](int h, int i, int kt) { return (const bf16_t*)(upin((const char*)H2 + kt * 128) + xo[h][i]); },
                     [&](int h, int i, int kt) { return (const bf16_t*)(upin((const char*)Wg + ((size_t)(e * 512 + (2 * pn + h) * 64 + i * 32) * 1024 + kt * 64) * 2) + vw); }, 16, lds);
        const int lane = tidx & 63, wid = tidx >> 6, wr = wid >> 2, wc = wid & 3, fr = lane & 15, g = lane >> 4;
#pragma unroll
        for (int nh = 0; nh < 2; ++nh)
#pragma unroll
            for (int im = 0; im < 4; ++im)
#pragma unroll
                for (int q = 0; q < 2; ++q) {
                    const f32x4 gt = acc[nh][2 * q][im], up = acc[nh][2 * q + 1][im];
                    uint2 o; o.x = pack2(siluf_(gt[0]) * up[0], siluf_(gt[1]) * up[1]); o.y = pack2(siluf_(gt[2]) * up[2], siluf_(gt[3]) * up[3]);
                    *(uint2*)(Hid + (size_t)(mt * 256 + (im >> 1) * 128 + wc * 32 + (im & 1) * 16 + fr) * 512 + (2 * pn + nh) * 64 + wr * 32 + 16 * q + 4 * g) = o;
                }
    }
}
__device__ __forceinline__ void st_moe_down(const KP& p, int bid, int nb, char* lds) {
    const int tidx = opaque_tid();
    const int* cnt = WSP(int, OFF_CNT); const float* slw = WSP(float, OFF_SLW);
    const bf16_t* Hid = WSP(bf16_t, OFF_HID); const bf16_t* Wd = WSP(bf16_t, OFF_WB + WB_ED); bf16_t* Sl = WSP(bf16_t, OFF_SLOTS);
    int off[17]; moe_offsets(cnt, off);
    const int M2 = off[16] >> 8;
    int mt, pn;
    for (int r = 0; r * 8 * (nb >> 5) < M2; ++r) {
        if (!moe_tile(r, M2, bid, nb, mt, pn)) continue;
        const int e = __builtin_amdgcn_readfirstlane(moe_expert_of(off, mt * 256));
        acc_t acc[2]; acc_zero(acc[0]); acc_zero(acc[1]);
        gemm_core256_dense(acc, Hid + (size_t)mt * 256 * 512, 512, Wd + ((size_t)e * 1024 + pn * 256) * 512, 512, 512, lds);
#pragma unroll
        for (int nh = 0; nh < 2; ++nh)
            acc_visit2(acc[nh], [&](int ml, int nl, f32x4 v) {
                const float w = slw[mt * 256 + ml];
                *(uint2*)(Sl + (size_t)(mt * 256 + ml) * 1024 + pn * 256 + nh * 128 + nl) = pack4(v * w); });
    }
}
__device__ __forceinline__ void st_postffn(const KP& p, int l, int bid, int nb) {
    const int tidx = opaque_tid();
    const int lane = tidx & 63, wid = tidx >> 6;
    const bf16_t* Sl = WSP(bf16_t, OFF_SLOTS); const int* toks = WSP(int, OFF_TOKS);
    const float* gpost = p.in(I_GPOSTFFN) + l * D;
    const bool next = (l + 1 < NL);
    bf16_t* Hb = WSP(bf16_t, OFF_H); const float* gpre = p.in(I_GPREMIX) + (next ? l + 1 : l) * D;
    auto ld = [&](int r, uint2 (&a)[4], uint2 (&b)[4], float4 (&x)[4]) __attribute__((always_inline)) {
        const bf16_t* s0 = Sl + (size_t)toks[r * 2] * 1024; const bf16_t* s1 = Sl + (size_t)toks[r * 2 + 1] * 1024; const float* xs = xrow_c(p, r);
#pragma unroll
        for (int i = 0; i < 4; ++i) { const int c = i * 256 + lane * 4; a[i] = *(const uint2*)(s0 + c); b[i] = *(const uint2*)(s1 + c); x[i] = *(const float4*)(xs + c); }
    };
    auto proc = [&](int r, uint2 (&a)[4], uint2 (&b)[4], float4 (&xq)[4]) __attribute__((always_inline)) {
        float* xr = xrow(p, r);
        const float* md = WSP(float, OFF_MOD) + (size_t)(l * 2 + (r < LC ? 1 : 0)) * 6144;
        float v[16]; float ss = 0.f;
#pragma unroll
        for (int i = 0; i < 4; ++i) {
            v[4 * i] = bflo(a[i].x) + bflo(b[i].x); v[4 * i + 1] = bfhi(a[i].x) + bfhi(b[i].x); v[4 * i + 2] = bflo(a[i].y) + bflo(b[i].y); v[4 * i + 3] = bfhi(a[i].y) + bfhi(b[i].y);
            ss += v[4 * i] * v[4 * i] + v[4 * i + 1] * v[4 * i + 1] + v[4 * i + 2] * v[4 * i + 2] + v[4 * i + 3] * v[4 * i + 3]; }
        ss = wave_sum(ss);
        const float rstd = rsqrtf(ss * (1.0f / D) + EPS);
        float4 xs[4]; float ss2 = 0.f;
#pragma unroll
        for (int i = 0; i < 4; ++i) { const int c = i * 256 + lane * 4;
            const float4 gg = *(const float4*)(gpost + c), ga = *(const float4*)(md + 5120 + c); float4 x = xq[i];
            x.x += ga.x * v[4 * i] * rstd * gg.x; x.y += ga.y * v[4 * i + 1] * rstd * gg.y; x.z += ga.z * v[4 * i + 2] * rstd * gg.z; x.w += ga.w * v[4 * i + 3] * rstd * gg.w;
            *(float4*)(xr + c) = x; xs[i] = x; ss2 += x.x * x.x + x.y * x.y + x.z * x.z + x.w * x.w; }
        if (next) {
            ss2 = wave_sum(ss2);
            const float rstd2 = rsqrtf(ss2 * (1.0f / D) + EPS);
            const float* md2 = WSP(float, OFF_MOD) + (size_t)((l + 1) * 2 + (r < LC ? 1 : 0)) * 6144;
#pragma unroll
            for (int i = 0; i < 4; ++i) { const int c = i * 256 + lane * 4;
                const float4 gg = *(const float4*)(gpre + c), sh = *(const float4*)(md2 + c), sc = *(const float4*)(md2 + 1024 + c);
                uint2 o; o.x = pack2(xs[i].x * rstd2 * gg.x * (1.f + sc.x) + sh.x, xs[i].y * rstd2 * gg.y * (1.f + sc.y) + sh.y);
                o.y = pack2(xs[i].z * rstd2 * gg.z * (1.f + sc.z) + sh.z, xs[i].w * rstd2 * gg.w * (1.f + sc.w) + sh.w);
                *(uint2*)(Hb + (size_t)r * D + c) = o; }
        }
    };
    {   const int r0 = (l + 1 < NL ? 0 : LC) + bid * NWV + wid, rs = nb * NWV;
        uint2 aa[4], ab[4], ba[4], bb[4]; float4 xa[4], xb[4];
        if (r0 < T) ld(r0, aa, ab, xa);
        for (int r = r0; r < T; r += 2 * rs) {
            if (r + rs < T) ld(r + rs, ba, bb, xb);
            proc(r, aa, ab, xa);
            if (r + rs < T) { if (r + 2 * rs < T) ld(r + 2 * rs, aa, ab, xa); proc(r + rs, ba, bb, xb); }
        } }
}

__device__ __forceinline__ void gsync(unsigned* bar, unsigned epoch) {
    asm volatile("s_waitcnt vmcnt(0) lgkmcnt(0)" ::: "memory");
    __syncthreads();
    if (threadIdx.x == 0) {
        __builtin_amdgcn_fence(__ATOMIC_RELEASE, "agent");
        asm volatile("s_waitcnt vmcnt(0)" ::: "memory");
        __hip_atomic_fetch_add(bar, 1u, __ATOMIC_RELAXED, __HIP_MEMORY_SCOPE_AGENT);
        const unsigned target = epoch * gridDim.x;
        while (__hip_atomic_load(bar, __ATOMIC_RELAXED, __HIP_MEMORY_SCOPE_AGENT) < target) __builtin_amdgcn_s_sleep(2);
        __builtin_amdgcn_fence(__ATOMIC_ACQUIRE, "agent");
        asm volatile("s_waitcnt vmcnt(0)" ::: "memory");
    }
    __syncthreads();
}

__global__ void __launch_bounds__(NTH) k_mega(Params p_unused) {
    KP p; p.k = (kparams_t)__builtin_amdgcn_kernarg_segment_ptr();
    __shared__ __attribute__((aligned(16))) char lds[LDS_BYTES]; float* smem = (float*)lds;
    cg::grid_group grid = cg::this_grid();
    grid.sync();
    const int bid = blockIdx.x, nb = gridDim.x;
    unsigned* bar = WSP(unsigned, OFF_BAR);
#define GS(k) gsync(bar, (unsigned)(k))
    st_prologue(p, bid, nb, smem); st_conv(p, 0, bid, nb, smem); st_s5_tables(p, 0, bid, nb, lds); GS(1);
    st_modulate(p, 0, bid, nb); GS(2);
#pragma unroll 1
    for (int l = 0; l < NL; ++l) {
        st_gemm_in(p, l, bid, nb, lds); GS(2 + 12 * l + 1);
        st_s5_local(p, l, bid, nb); st_s5_fgemm(p, bid, nb, lds); GS(2 + 12 * l + 2);
        st_s5_carry(p, l, bid, nb, lds); st_proj2<0>(p, l, bid, nb, lds); GS(2 + 12 * l + 3);
        st_s5_ygemm(p, l, bid, nb, lds); st_s5_ctx_y(p, l, bid, nb); st_ropeq(p, bid, nb, lds); GS(2 + 12 * l + 4);
        st_proj2<1>(p, l, bid, nb, lds); st_attn(p, l, bid, nb, lds); GS(2 + 12 * l + 5);
        st_merge(p, l, bid, nb, lds); GS(2 + 12 * l + 6);
        st_wout(p, l, bid, nb, lds); st_conv_experts(p, l, bid, nb, smem); GS(2 + 12 * l + 7);
        st_postmix(p, l, bid, nb, lds); GS(2 + 12 * l + 8);
        st_moe_build(p, l, bid, nb, lds); GS(2 + 12 * l + 9);
        st_moe_up(p, bid, nb, lds); GS(2 + 12 * l + 10);
        st_moe_down(p, bid, nb, lds); GS(2 + 12 * l + 11);
        st_postffn(p, l, bid, nb);
        if (l + 1 < NL) { st_conv(p, l + 1, bid, nb, smem); st_s5_tables(p, l + 1, bid, nb, lds); }
        GS(2 + 12 * l + 12);
    }
#undef GS
}

extern "C" void kernel_launch(void* const* d_in, const int* in_sizes, int n_in, void* d_out, int out_size, void* d_ws, size_t ws_size, hipStream_t stream) {
    Params p{};
    for (int i = 0; i < N_IN; ++i) p.in[i] = (const float*)d_in[i];
    p.out = (float*)d_out; p.ws = (char*)d_ws;
    if (ws_size < WS_NEED) { fprintf(stderr, "workspace too small: %zu < %zu\n", ws_size, (size_t)WS_NEED); return; }
    static int grid_blocks = 0;
    if (!grid_blocks) {
        int dev = 0, cus = 0, per_cu = 0;
        hipGetDevice(&dev);
        hipDeviceGetAttribute(&cus, hipDeviceAttributeMultiprocessorCount, dev);
        hipOccupancyMaxActiveBlocksPerMultiprocessor(&per_cu, k_mega, NTH, 0);
        if (per_cu > 1) per_cu = 1;
        if (per_cu < 1) per_cu = 1;
        grid_blocks = cus * per_cu;
    }
    hipMemsetAsync((char*)d_ws + OFF_BAR, 0, 256, stream);
    void* args[] = { &p };
    hipError_t e = hipLaunchCooperativeKernel((void*)k_mega, dim3(grid_blocks), dim3(NTH), args, 0, stream);
    if (e != hipSuccess) fprintf(stderr, "cooperative launch failed: %s (grid %d)\n", hipGetErrorString(e), grid_blocks);
}
```

```cpp
#include <hip/hip_runtime.h>
#include <hip/hip_cooperative_groups.h>
#include <cstdio>
#include <cstdint>
#include <type_traits>
namespace cg = cooperative_groups;


typedef unsigned short bf16_t;
typedef short bf16x8 __attribute__((ext_vector_type(8)));
typedef float f32x16 __attribute__((ext_vector_type(16)));
typedef float f32x4 __attribute__((ext_vector_type(4)));
typedef unsigned u32x4 __attribute__((ext_vector_type(4)));
constexpr int NTH = 512, NWV = 8;
#ifndef REP_CONV
#define REP_CONV 1
#endif
#ifndef REP_G1
#define REP_G1 1
#endif
#ifndef REP_G2
#define REP_G2 1
#endif
#ifndef REP_G3
#define REP_G3 1
#endif
#ifndef REP_S5
#define REP_S5 1
#endif
#ifndef REP_ATTN
#define REP_ATTN 1
#endif

constexpr int D = 1024, S = 16384, LC = 256, T = S + LC, NL = 2;
constexpr int NIN = 4768, NINP = 4864;
constexpr int PP = 1696;
constexpr int C_GQ = 0, C_GK = 512, C_GV = 640, C_CQ = 768, C_CKV = 1024, C_KR = 1152, C_SSM = 1184, C_GATE = 1696;
__host__ __device__ constexpr int win_col_old(int n) {
    return n < 512 ? 928 + n : n < 640 ? 1440 + (n - 512) : n < 768 ? 1568 + (n - 640) : n < 1024 ? (n - 768) : n < 1152 ? 256 + (n - 1024) : n < 1184 ? 384 + (n - 1152) : n < 1696 ? 416 + (n - 1184) : n;
}
constexpr int TP = 2 * T + 16 * 256;
constexpr float EPS = 1e-6f;
constexpr float LOG2E = 1.4426950408889634f;
constexpr float SC_MLA = 0.10206207261596575f * LOG2E, SC_GQA = 0.125f * LOG2E;

enum { I_X = 0, I_C, I_CTX, I_CCTX, I_WMOD, I_BMOD, I_GPREMIX, I_GPOSTMIX, I_GPREFFN, I_GPOSTFFN, I_WIN, I_GCQ, I_GCKV, I_WUQ, I_WUKV,
       I_GQN, I_GKN, I_ARE, I_AIM, I_LOGDT, I_BRE, I_BIM, I_CRE, I_CIM, I_SSMD, I_WGLU, I_BGLU, I_WBRM, I_WBRS, I_WBRG, I_WOUT,
       I_WGROUP, I_BGROUP, I_WROUTER, I_BROUTER, I_WEG, I_WEU, I_WED, N_IN };

constexpr size_t al256(size_t x) { return (x + 255) & ~(size_t)255; }
constexpr size_t WB_IN = 0;
constexpr size_t WB_UQ = WB_IN + (size_t)NINP * 1024 * 2;
constexpr size_t WB_UKV = WB_UQ + (size_t)768 * 256 * 2;
constexpr size_t WB_GLU = WB_UKV + (size_t)1024 * 128 * 2;
constexpr size_t WB_BR = WB_GLU + (size_t)512 * 512 * 2;
constexpr size_t WB_OUT = WB_BR + (size_t)3 * 1024 * 512 * 2;
constexpr size_t WB_EG = WB_OUT + (size_t)1024 * 1024 * 2;
constexpr size_t WB_EU = WB_EG + (size_t)16 * 512 * 1024 * 2;
constexpr size_t WB_ED = WB_EU + (size_t)16 * 512 * 1024 * 2;
constexpr size_t WB_BYTES = WB_ED + (size_t)16 * 1024 * 512 * 2;

constexpr size_t OFF_WB = 0;
constexpr size_t OFF_P = al256(OFF_WB + WB_BYTES);
constexpr size_t P_BYTES = (size_t)T * NIN * 2;
constexpr size_t OFF_GS = OFF_P + (size_t)T * PP * 2;
constexpr size_t OFF_Y = OFF_P;
constexpr size_t OFF_SLOTS = OFF_P;
constexpr size_t OFF_HID = OFF_P + (size_t)TP * 1024 * 2;
constexpr size_t OFF_H = al256(OFF_P + P_BYTES);
constexpr size_t OFF_KN = al256(OFF_H + (size_t)T * 1024 * 2);
constexpr size_t OFF_V = al256(OFF_KN + (size_t)T * 512 * 2);
constexpr size_t OFF_OM = al256(OFF_V + (size_t)T * 512 * 2);
constexpr size_t OFF_OG = OFF_OM + (size_t)T * 512 * 2;
constexpr size_t OFF_OS = OFF_OG + (size_t)T * 512 * 2;
constexpr size_t OFF_XC = al256(OFF_OS + (size_t)T * 512 * 2);
constexpr size_t OFF_MOD = al256(OFF_XC + (size_t)LC * 1024 * 4);
constexpr size_t OFF_TOKE = al256(OFF_MOD + (size_t)NL * 2 * 6144 * 4);
constexpr size_t OFF_TOKW = al256(OFF_TOKE + (size_t)T * 2 * 4);
constexpr size_t OFF_TOKS = al256(OFF_TOKW + (size_t)T * 2 * 4);
constexpr size_t OFF_SLTOK = al256(OFF_TOKS + (size_t)T * 2 * 4);
constexpr size_t OFF_SLW = al256(OFF_SLTOK + (size_t)TP * 4);
constexpr size_t OFF_CNT = al256(OFF_SLW + (size_t)TP * 4);
constexpr size_t OFF_S5 = al256(OFF_CNT + 256);
constexpr size_t OFF_ROPE = al256(OFF_S5 + (size_t)(T / 64) * 4096 * 8);
constexpr size_t OFF_SSQ = al256(OFF_ROPE + 256 * 24 * 8);
constexpr size_t OFF_SSMG = al256(OFF_SSQ + (size_t)T * 8 * 4);
constexpr size_t OFF_BAR = al256(OFF_SSMG + (size_t)32 * T * 16 * 2);
constexpr size_t WS_NEED = al256(OFF_BAR + 256);
static_assert(OFF_HID + (size_t)TP * 512 * 2 <= OFF_P + P_BYTES, "overlay");
static_assert((size_t)T * 1024 * 4 <= P_BYTES, "overlay Y");
static_assert(WS_NEED < 384000000ull, "ws");

struct Params {
    const float* in[N_IN];
    float* out;
    char* ws;
};
typedef const __attribute__((address_space(4))) Params* kparams_t;
struct KP {
    kparams_t k;
    __device__ __forceinline__ const float* in(int i) const { return *(const float* const volatile __attribute__((address_space(4)))*)(&k->in[i]); }
    __device__ __forceinline__ float* out() const { return *(float* const volatile __attribute__((address_space(4)))*)(&k->out); }
    __device__ __forceinline__ char* ws() const { return *(char* const volatile __attribute__((address_space(4)))*)(&k->ws); }
};

__device__ __forceinline__ float bf2f(bf16_t v) { return __uint_as_float(((unsigned)v) << 16); }
typedef __bf16 bf16x2_t __attribute__((ext_vector_type(2)));
__device__ __forceinline__ bf16_t f2bf(float f) { const __bf16 b = (__bf16)f; return __builtin_bit_cast(bf16_t, b); }
__device__ __forceinline__ float bflo(unsigned u) { return __uint_as_float(u << 16); }
__device__ __forceinline__ float bfhi(unsigned u) { return __uint_as_float(u & 0xFFFF0000u); }
__device__ __forceinline__ unsigned pack2(float lo, float hi) { bf16x2_t v; v[0] = (__bf16)lo; v[1] = (__bf16)hi; return __builtin_bit_cast(unsigned, v); }
__device__ __forceinline__ float wave_sum(float v) {
#pragma unroll
    for (int o = 32; o > 0; o >>= 1) v += __shfl_xor(v, o);
    return v;
}
__device__ __forceinline__ float xhalf_max(float m) { auto rr = __builtin_amdgcn_permlane32_swap(__float_as_uint(m), __float_as_uint(m), false, false); return fmaxf(__uint_as_float(rr[0]), __uint_as_float(rr[1])); }
__device__ __forceinline__ float xhalf_sum(float m) { auto rr = __builtin_amdgcn_permlane32_swap(__float_as_uint(m), __float_as_uint(m), false, false); return __uint_as_float(rr[0]) + __uint_as_float(rr[1]); }
__device__ __forceinline__ void rope_tab(float& a, float& b, float2 cs) { const float na = a * cs.x - b * cs.y, nb_ = a * cs.y + b * cs.x; a = na; b = nb_; }
__device__ __forceinline__ float transpose_reduce16(const float (&t16)[16], int lane) {
    float t8[8], t4[4], t2[2];
#pragma unroll
    for (int i = 0; i < 8; ++i) { const float a = t16[2 * i], b = t16[2 * i + 1]; const bool o = lane & 1; const float keep = o ? b : a, send = o ? a : b; t8[i] = keep + __shfl_xor(send, 1); }
#pragma unroll
    for (int i = 0; i < 4; ++i) { const float a = t8[2 * i], b = t8[2 * i + 1]; const bool o = lane & 2; const float keep = o ? b : a, send = o ? a : b; t4[i] = keep + __shfl_xor(send, 2); }
#pragma unroll
    for (int i = 0; i < 2; ++i) { const float a = t4[2 * i], b = t4[2 * i + 1]; const bool o = lane & 4; const float keep = o ? b : a, send = o ? a : b; t2[i] = keep + __shfl_xor(send, 4); }
    float y; { const float a = t2[0], b = t2[1]; const bool o = lane & 8; const float keep = o ? b : a, send = o ? a : b; y = keep + __shfl_xor(send, 8); }
    y += __shfl_xor(y, 16); y += __shfl_xor(y, 32);
    return y;
}
__device__ __forceinline__ float sigmoidf_(float x) { return __builtin_amdgcn_rcpf(1.0f + __builtin_amdgcn_exp2f(-LOG2E * x)); }
__device__ __forceinline__ float siluf_(float x) { return x * __builtin_amdgcn_rcpf(1.0f + __builtin_amdgcn_exp2f(-LOG2E * x)); }
__device__ __forceinline__ float gelu_tanh(float x) {
    const float u = 0.7978845608028654f * (x + 0.044715f * x * x * x);
    return x * __builtin_amdgcn_rcpf(1.0f + __builtin_amdgcn_exp2f(-2.0f * LOG2E * u));
}
__device__ __forceinline__ float dot8(uint4 a, uint4 b, float acc) {
    acc = fmaf(bflo(a.x), bflo(b.x), acc); acc = fmaf(bfhi(a.x), bfhi(b.x), acc);
    acc = fmaf(bflo(a.y), bflo(b.y), acc); acc = fmaf(bfhi(a.y), bfhi(b.y), acc);
    acc = fmaf(bflo(a.z), bflo(b.z), acc); acc = fmaf(bfhi(a.z), bfhi(b.z), acc);
    acc = fmaf(bflo(a.w), bflo(b.w), acc); acc = fmaf(bfhi(a.w), bfhi(b.w), acc);
    return acc;
}
__device__ __forceinline__ float dotrow(const bf16_t* a, const bf16_t* b, int K) {
    float acc = 0.f;
    const uint4* a4 = (const uint4*)a; const uint4* b4 = (const uint4*)b;
    for (int k = 0; k < K / 8; ++k) acc = dot8(a4[k], b4[k], acc);
    return acc;
}

__device__ __forceinline__ int opaque_tid() { int t = threadIdx.x; asm volatile("" : "+v"(t)); return t; }
#define WSP(type, off) ((type*)(p.ws() + (off)))
#define SSMU(g, r) (WSP(const bf16_t, OFF_SSMG) + ((size_t)(g) * T + (r)) * 16)

template <class AF, class BF, class EF>
__device__ __forceinline__ void gemm_naive(int M, int N, int K, AF arow, BF brow, EF epi, int bid, int nb) {
    const int tidx = opaque_tid();
    const long total = (long)M * N;
    for (long idx = (long)bid * NTH + tidx; idx < total; idx += (long)nb * NTH) {
        const int m = (int)(idx / N), n = (int)(idx % N);
        const float acc = dotrow(arow(m), brow(m, n), K);
        epi(m, n, acc);
    }
}

constexpr int G_A_BYTES = 256 * 128, G_W_BYTES = 128 * 128, G_BUF = G_A_BYTES + G_W_BYTES;
constexpr int LDS_BYTES = 3 * G_BUF;
#define MFMA32(a, b, c) __builtin_amdgcn_mfma_f32_32x32x16_bf16(a, b, c, 0, 0, 0)

#define GLDS16(gptr, lptr) __builtin_amdgcn_global_load_lds((const __attribute__((address_space(1))) void*)(gptr), (__attribute__((address_space(3))) void*)(lptr), 16, 0, 0)
typedef f32x4 acc_t[4][4];
#define MFMA16(a, b, c) __builtin_amdgcn_mfma_f32_16x16x32_bf16(a, b, c, 0, 0, 0)
template <class APTR, class WPTR>
__device__ __forceinline__ void gemm_core_g(acc_t& acc, APTR aptr, WPTR wptr, int nk, char* lds) {
    const int tidx = opaque_tid();
    const int tid = tidx, lane = tid & 63, wid = tid >> 6, wm = wid >> 1, wn = wid & 1, fr = lane & 15, g = lane >> 4;
    const int wu = __builtin_amdgcn_readfirstlane(wid);
    char* sdst = lds + wu * 1024;
    const int xoff = (wm * 64 + fr) * 128, woff = G_A_BYTES + (wn * 64 + fr) * 128, sw7 = (fr >> 1) & 7;
    asm volatile("s_waitcnt vmcnt(0)" ::: "memory");
#pragma unroll
    for (int i = 0; i < 4; ++i) GLDS16(aptr(i, 0), sdst + i * 8192);
#pragma unroll
    for (int i = 0; i < 2; ++i) GLDS16(wptr(i, 0), sdst + G_A_BYTES + i * 8192);
    if (nk > 1) {
#pragma unroll
        for (int i = 0; i < 4; ++i) GLDS16(aptr(i, 1), sdst + G_BUF + i * 8192);
#pragma unroll
        for (int i = 0; i < 2; ++i) GLDS16(wptr(i, 1), sdst + G_BUF + G_A_BYTES + i * 8192);
        asm volatile("s_waitcnt vmcnt(6)" ::: "memory");
    } else asm volatile("s_waitcnt vmcnt(0)" ::: "memory");
    __builtin_amdgcn_s_barrier();
    int slot = 0;
    for (int kt = 0; kt < nk; ++kt) {
        const char* cur = lds + slot * G_BUF;
        const int s2 = slot >= 1 ? slot - 1 : 2;
        const bool more2 = (kt + 2 < nk);
        char* nxt = sdst + s2 * G_BUF;
#pragma unroll
        for (int ks = 0; ks < 2; ++ks) {
            const int co = ((ks * 4 + g) ^ sw7) << 4;
            bf16x8 x[4], w[4];
#pragma unroll
            for (int i = 0; i < 4; ++i) { x[i] = *(const bf16x8*)(cur + xoff + i * 16 * 128 + co); w[i] = *(const bf16x8*)(cur + woff + i * 16 * 128 + co); }
#pragma unroll
            for (int in = 0; in < 4; ++in)
#pragma unroll
                for (int im = 0; im < 4; ++im) acc[in][im] = MFMA16(w[in], x[im], acc[in][im]);
            __builtin_amdgcn_sched_barrier(0);
            if (more2) {
                if (ks == 0) { GLDS16(aptr(0, kt + 2), nxt); GLDS16(aptr(1, kt + 2), nxt + 8192); GLDS16(aptr(2, kt + 2), nxt + 2 * 8192); }
                else { GLDS16(aptr(3, kt + 2), nxt + 3 * 8192); GLDS16(wptr(0, kt + 2), nxt + G_A_BYTES); GLDS16(wptr(1, kt + 2), nxt + G_A_BYTES + 8192); }
            }
            __builtin_amdgcn_sched_barrier(0);
        }
        if (more2) asm volatile("s_waitcnt vmcnt(6) lgkmcnt(0)" ::: "memory");
        else asm volatile("s_waitcnt vmcnt(0) lgkmcnt(0)" ::: "memory");
        __builtin_amdgcn_s_barrier();
        slot = slot == 2 ? 0 : slot + 1;
    }
}
template <class AROW, class WROW>
__device__ __forceinline__ void gemm_core(acc_t& acc, AROW arow, WROW wrow, int K, char* lds) {
    const int tidx = opaque_tid();
    const int srow = tidx >> 3, gch = (tidx & 7) ^ ((srow >> 1) & 7);
    const bf16_t* pa[4]; const bf16_t* pw[2];
#pragma unroll
    for (int i = 0; i < 4; ++i) pa[i] = arow(srow + 64 * i) + gch * 8;
#pragma unroll
    for (int i = 0; i < 2; ++i) pw[i] = wrow(srow + 64 * i) + gch * 8;
    gemm_core_g(acc, [&](int i, int kt) { return pa[i] + kt * 64; }, [&](int i, int kt) { return pw[i] + kt * 64; }, K >> 6, lds);
}
__device__ __forceinline__ void acc_zero(acc_t& acc) {
#pragma unroll
    for (int a = 0; a < 4; ++a)
#pragma unroll
        for (int b = 0; b < 4; ++b) { acc[a][b][0] = 0.f; acc[a][b][1] = 0.f; acc[a][b][2] = 0.f; acc[a][b][3] = 0.f; }
}
template <class F>
__device__ __forceinline__ void acc_visit(const acc_t& acc, F f) {
    const int tidx = opaque_tid();
    const int lane = tidx & 63, wid = tidx >> 6, wm = wid >> 1, wn = wid & 1, fr = lane & 15, g = lane >> 4;
#pragma unroll
    for (int in = 0; in < 4; ++in)
#pragma unroll
        for (int im = 0; im < 4; ++im) f(wm * 64 + 16 * im + fr, wn * 64 + 16 * in + 4 * g, acc[in][im]);
}
template <class F>
__device__ __forceinline__ void acc_visit_add(const acc_t& acc, acc_t& tot, F f) {
    const int tidx = opaque_tid();
    const int lane = tidx & 63, wid = tidx >> 6, wm = wid >> 1, wn = wid & 1, fr = lane & 15, g = lane >> 4;
#pragma unroll
    for (int in = 0; in < 4; ++in)
#pragma unroll
        for (int im = 0; im < 4; ++im) tot[in][im] += f(wm * 64 + 16 * im + fr, wn * 64 + 16 * in + 4 * g, acc[in][im]);
}
template <class APTR, class WPTR>
__device__ __forceinline__ void gemm_core256(acc_t (&acc)[2], APTR aptr, WPTR wptr, int nt, char* lds) {
    const int tid = opaque_tid(), lane = tid & 63, wid = tid >> 6, wr = wid >> 2, wc = wid & 3, fr = lane & 15, g = lane >> 4;
    const int wu = __builtin_amdgcn_readfirstlane(wid);
    char* sdst = lds + wu * 1024;
    const int sw7 = (fr >> 1) & 7;
    typedef const __attribute__((address_space(3))) char* l3p; typedef const __attribute__((address_space(3))) bf16x8* l3v;
    l3p wf0 = (l3p)lds + (wr * 64 + fr) * 128 + ((g ^ sw7) << 4); l3p wf1 = (l3p)lds + (wr * 64 + fr) * 128 + (((4 + g) ^ sw7) << 4);
    l3p xf0 = (l3p)lds + 4 * 16384 + (wc * 32 + fr) * 128 + ((g ^ sw7) << 4); l3p xf1 = (l3p)lds + 4 * 16384 + (wc * 32 + fr) * 128 + (((4 + g) ^ sw7) << 4);
    asm volatile("" : "+v"(wf0), "+v"(wf1), "+v"(xf0), "+v"(xf1));
#define C2_SW(b, h) (((b) * 2 + (h)) * 16384)
#define C2_STG_W(b, h, kt) do { GLDS16(wptr(h, 0, kt), sdst + C2_SW(b, h)); GLDS16(wptr(h, 1, kt), sdst + C2_SW(b, h) + 8192); } while (0)
#define C2_STG_X(b, h, kt) do { GLDS16(aptr(h, 0, kt), sdst + 4 * 16384 + C2_SW(b, h)); GLDS16(aptr(h, 1, kt), sdst + 4 * 16384 + C2_SW(b, h) + 8192); } while (0)
#define C2_LDW(b, h) do { _Pragma("unroll") for (int m = 0; m < 4; ++m) { Wt[m][0] = *(l3v)(wf0 + C2_SW(b, h) + m * 2048); Wt[m][1] = *(l3v)(wf1 + C2_SW(b, h) + m * 2048); } } while (0)
#define C2_LDX(dst, b, h) do { _Pragma("unroll") for (int n = 0; n < 2; ++n) { dst[n][0] = *(l3v)(xf0 + C2_SW(b, h) + n * 2048); dst[n][1] = *(l3v)(xf1 + C2_SW(b, h) + n * 2048); } } while (0)
#define C2_MMA(nh, mh, Xf) do { __builtin_amdgcn_s_setprio(1); \
        _Pragma("unroll") for (int m = 0; m < 4; ++m) _Pragma("unroll") for (int n = 0; n < 2; ++n) _Pragma("unroll") for (int k = 0; k < 2; ++k) \
            acc[nh][m][2 * (mh) + n] = MFMA16(Wt[m][k], Xf[n][k], acc[nh][m][2 * (mh) + n]); \
        __builtin_amdgcn_s_setprio(0); } while (0)
#define C2_WV(n) asm volatile("s_waitcnt vmcnt(" #n ")" ::: "memory")
#define C2_WL(n) asm volatile("s_waitcnt lgkmcnt(" #n ")" ::: "memory")
#define C2_BAR __builtin_amdgcn_s_barrier()
#define C2_SCHED __builtin_amdgcn_sched_barrier(0)
    bf16x8 Wt[4][2], X0[2][2], X1[2][2];
    C2_WV(0);
    C2_STG_X(0, 0, 0); C2_STG_W(0, 0, 0); C2_STG_X(0, 1, 0); C2_STG_W(0, 1, 0);
    if (wu >= 4) C2_BAR;
    C2_WV(4); C2_BAR;
    C2_STG_X(1, 0, 1); C2_STG_W(1, 0, 1); C2_STG_X(1, 1, 1);
    C2_WV(6); C2_BAR;
#pragma unroll 1
    for (int t = 0; t < nt - 2; t += 2) {
        C2_LDX(X0, 0, 0); C2_SCHED; C2_LDW(0, 0); C2_STG_W(1, 1, t + 1);
        C2_WL(8); C2_BAR; C2_WL(0); C2_MMA(0, 0, X0); C2_BAR; C2_SCHED;
        C2_LDX(X1, 0, 1); C2_STG_X(0, 0, t + 2);
        C2_BAR; C2_WL(0); C2_MMA(0, 1, X1); C2_BAR;
        C2_LDW(0, 1); C2_STG_W(0, 0, t + 2);
        C2_BAR; C2_WL(0); C2_MMA(1, 0, X0); C2_BAR; C2_SCHED;
        C2_STG_X(0, 1, t + 2);
        C2_WV(6); C2_BAR; C2_MMA(1, 1, X1); C2_BAR;
        C2_LDX(X0, 1, 0); C2_SCHED; C2_LDW(1, 0); C2_STG_W(0, 1, t + 2);
        C2_WL(8); C2_BAR; C2_WL(0); C2_MMA(0, 0, X0); C2_BAR; C2_SCHED;
        C2_LDX(X1, 1, 1); C2_STG_X(1, 0, t + 3);
        C2_BAR; C2_WL(0); C2_MMA(0, 1, X1); C2_BAR;
        C2_LDW(1, 1); C2_STG_W(1, 0, t + 3);
        C2_BAR; C2_WL(0); C2_MMA(1, 0, X0); C2_BAR; C2_SCHED;
        C2_STG_X(1, 1, t + 3);
        C2_WV(6); C2_BAR; C2_MMA(1, 1, X1); C2_BAR;
    }
    {   C2_LDX(X0, 0, 0); C2_LDW(0, 0); C2_STG_W(1, 1, nt - 1);
        C2_BAR; C2_WL(0); C2_MMA(0, 0, X0); C2_BAR;
        C2_LDX(X1, 0, 1); C2_BAR; C2_WL(0); C2_MMA(0, 1, X1); C2_BAR;
        C2_LDW(0, 1); C2_WV(4); C2_BAR; C2_WL(0); C2_MMA(1, 0, X0); C2_MMA(1, 1, X1); C2_BAR; }
    {   C2_LDX(X0, 1, 0); C2_LDW(1, 0); C2_WV(2); C2_BAR; C2_WL(0); C2_MMA(0, 0, X0); C2_BAR;
        C2_LDX(X1, 1, 1); C2_WV(0); C2_BAR; C2_WL(0); C2_MMA(0, 1, X1); C2_BAR;
        C2_LDW(1, 1); C2_BAR; C2_WL(0); C2_MMA(1, 0, X0); C2_MMA(1, 1, X1); C2_BAR; }
    if (wu < 4) C2_BAR;
}
__device__ __forceinline__ void gemm_core256_dense(acc_t (&acc)[2], const bf16_t* xb, int xpitch, const bf16_t* wb, int wpitch, int K, char* lds) {
    const int tidx = opaque_tid();
    const int srow = tidx >> 3, gch = (tidx & 7) ^ ((srow >> 1) & 7);
    const unsigned vx = (unsigned)(srow * xpitch + gch * 8) * 2u, vw = (unsigned)(srow * wpitch + gch * 8) * 2u;
    auto upin = [](const char* q) { asm volatile("" : "+s"(q)); return q; };
    gemm_core256(acc, [&](int h, int i, int kt) { return (const bf16_t*)(upin((const char*)xb + ((size_t)(h * 128 + i * 64) * xpitch + kt * 64) * 2) + vx); },
                 [&](int h, int i, int kt) { return (const bf16_t*)(upin((const char*)wb + ((size_t)(h * 128 + i * 64) * wpitch + kt * 64) * 2) + vw); }, K >> 6, lds);
}
template <class F>
__device__ __forceinline__ void acc_visit2(const acc_t& acc, F f) {
    const int tidx = opaque_tid();
    const int lane = tidx & 63, wid = tidx >> 6, wr = wid >> 2, wc = wid & 3, fr = lane & 15, g = lane >> 4;
#pragma unroll
    for (int in = 0; in < 4; ++in)
#pragma unroll
        for (int im = 0; im < 4; ++im) f((im >> 1) * 128 + wc * 32 + (im & 1) * 16 + fr, wr * 64 + 16 * in + 4 * g, acc[in][im]);
}
__device__ __forceinline__ uint2 pack4(f32x4 v) { uint2 o; o.x = pack2(v[0], v[1]); o.y = pack2(v[2], v[3]); return o; }
__device__ __forceinline__ bool dense_tile(int it, int NT, bool with_ctx, int bid, int nb, int& mt, int& nt) {
    const int x = bid & 7, j = bid >> 3, jb = nb >> 3;
    int v = it * jb + j;
    if (v < 8 * NT) { mt = 1 + x * 8 + (v & 7); nt = v >> 3; return true; }
    if (!with_ctx) return false;
    v -= 8 * NT; nt = x + 8 * v; mt = 0;
    return nt < NT;
}

__device__ __forceinline__ void st_prologue(const KP& p, int bid, int nb, float* smem) {
    const int tidx = opaque_tid();
    const int tid = tidx;
    {   float2* t16 = WSP(float2, OFF_ROPE); float2* t8 = t16 + 256 * 16;
        for (int idx = bid * NTH + tid; idx < 256 * 24; idx += nb * NTH) {
            const bool big = idx < 256 * 16; const int j = big ? idx : idx - 256 * 16, half = big ? 16 : 8, pos = j / half, i = j % half;
            const float ang = (float)pos * powf(10000.0f, -(float)i / (float)half);
            float sn, cs; sincosf(ang, &sn, &cs);
            (big ? t16 : t8)[j] = make_float2(cs, sn);
        } }
    for (int k = tid; k < 1024; k += NTH) { smem[k] = siluf_(p.in(I_C)[k]); smem[1024 + k] = siluf_(p.in(I_CCTX)[k]); }
    __syncthreads();
    float* mod = WSP(float, OFF_MOD);
    float4* red = (float4*)(smem + 2048);
    for (int jb = bid; jb < 256; jb += nb) {
        const int l = jb >> 7, j0 = (jb & 127) * 48, jj = tid % 12, kk = tid / 12;
        float4 a0 = make_float4(0.f, 0.f, 0.f, 0.f), a1 = a0;
        if (kk < 42) {
            const float* w = p.in(I_WMOD) + (size_t)l * 1024 * 6144 + j0 + jj * 4;
            for (int k = kk; k < 1024; k += 42) { const float4 wv = *(const float4*)(w + (size_t)k * 6144); const float s0 = smem[k], s1 = smem[1024 + k];
                a0.x = fmaf(s0, wv.x, a0.x); a0.y = fmaf(s0, wv.y, a0.y); a0.z = fmaf(s0, wv.z, a0.z); a0.w = fmaf(s0, wv.w, a0.w);
                a1.x = fmaf(s1, wv.x, a1.x); a1.y = fmaf(s1, wv.y, a1.y); a1.z = fmaf(s1, wv.z, a1.z); a1.w = fmaf(s1, wv.w, a1.w); }
            red[(kk * 12 + jj) * 2] = a0; red[(kk * 12 + jj) * 2 + 1] = a1;
        }
        __syncthreads();
        if (tid < 24) {
            const int cj = tid >> 1, cond = tid & 1;
            float4 s = make_float4(0.f, 0.f, 0.f, 0.f);
            for (int q = 0; q < 42; ++q) { const float4 v = red[(q * 12 + cj) * 2 + cond]; s.x += v.x; s.y += v.y; s.z += v.z; s.w += v.w; }
            const float4 b = *(const float4*)(p.in(I_BMOD) + l * 6144 + j0 + cj * 4);
            s.x += b.x; s.y += b.y; s.z += b.z; s.w += b.w;
            *(float4*)(mod + (size_t)(l * 2 + cond) * 6144 + j0 + cj * 4) = s;
        }
        __syncthreads();
    }
}

template <bool IDN, class COLF, class KSF>
__device__ __forceinline__ void conv_t_g(const float* W, bf16_t* Wt, int K, int N, int Npad, int nmat, int bid, int nb, float* smem, COLF colf, KSF ksf) {
    const int tidx = opaque_tid();
    const int tid = tidx;
    const int tn = Npad / 64, tk = K / 64;
    const int ntile = tn * tk * nmat;
    for (int t = bid; t < ntile; t += nb) {
        const int mat = t / (tn * tk), r = t % (tn * tk), n0 = (r / tk) * 64, k0 = (r % tk) * 64;
        const float* Wm = W + (size_t)mat * K * N; bf16_t* Wtm = Wt + (size_t)mat * Npad * K;
        __syncthreads();
        {
            const int kk = tid >> 4, c4 = (tid & 15) * 4; const bool ok = (n0 + c4 < N); const int sc = ok ? colf(n0 + c4) : 0;
#pragma unroll
            for (int i = 0; i < 2; ++i) { float4 v = make_float4(0.f, 0.f, 0.f, 0.f); if (ok) v = *(const float4*)(Wm + (size_t)(k0 + kk + 32 * i) * N + sc); const float s = ksf(k0 + kk + 32 * i);
                float* d = smem + (kk + 32 * i) * 65 + c4; d[0] = v.x * s; d[1] = v.y * s; d[2] = v.z * s; d[3] = v.w * s; }
        }
        __syncthreads();
        {   const int nn = tid >> 3, kc = (tid & 7) * 8;
            float e[8];
#pragma unroll
            for (int j = 0; j < 8; ++j) e[j] = smem[(kc + j) * 65 + nn];
            uint4 o; o.x = pack2(e[0], e[1]); o.y = pack2(e[2], e[3]); o.z = pack2(e[4], e[5]); o.w = pack2(e[6], e[7]);
            *(uint4*)(Wtm + (size_t)(n0 + nn) * K + k0 + kc) = o; }
    }
    __syncthreads();
}
__device__ __forceinline__ void conv_t(const float* W, bf16_t* Wt, int K, int N, int Npad, int nmat, int bid, int nb, float* smem) {
    conv_t_g<true>(W, Wt, K, N, Npad, nmat, bid, nb, smem, [](int n) { return n; }, [](int) { return 1.0f; });
}
__device__ __forceinline__ void st_conv(const KP& p, int l, int bid, int nb, float* smem) {
    const int tidx = opaque_tid(); (void)tidx;
    bf16_t* wb = WSP(bf16_t, OFF_WB);
    conv_t_g<false>(p.in(I_WIN) + (size_t)l * 1024 * NIN, (bf16_t*)((char*)wb + WB_IN), 1024, NIN, NINP, 1, bid, nb, smem, [](int n) { return win_col_old(n); }, [](int) { return 1.0f; });
    {   const float* gcq = p.in(I_GCQ) + l * 256; const float* gckv = p.in(I_GCKV) + l * 128;
        conv_t_g<true>(p.in(I_WUQ) + (size_t)l * 256 * 768, (bf16_t*)((char*)wb + WB_UQ), 256, 768, 768, 1, bid, nb, smem, [](int n) { return n; }, [&](int k) { return gcq[k]; });
        conv_t_g<true>(p.in(I_WUKV) + (size_t)l * 128 * 1024, (bf16_t*)((char*)wb + WB_UKV), 128, 1024, 1024, 1, bid, nb, smem, [](int n) { return n; }, [&](int k) { return gckv[k]; }); }
    conv_t(p.in(I_WGLU) + (size_t)l * 512 * 512, (bf16_t*)((char*)wb + WB_GLU), 512, 512, 512, 1, bid, nb, smem);
    conv_t(p.in(I_WBRM) + (size_t)l * 512 * 1024, (bf16_t*)((char*)wb + WB_BR), 512, 1024, 1024, 1, bid, nb, smem);
    conv_t(p.in(I_WBRS) + (size_t)l * 512 * 1024, (bf16_t*)((char*)wb + WB_BR + (size_t)1024 * 512 * 2), 512, 1024, 1024, 1, bid, nb, smem);
    conv_t(p.in(I_WBRG) + (size_t)l * 512 * 1024, (bf16_t*)((char*)wb + WB_BR + (size_t)2 * 1024 * 512 * 2), 512, 1024, 1024, 1, bid, nb, smem);
    conv_t(p.in(I_WOUT) + (size_t)l * 1024 * 1024, (bf16_t*)((char*)wb + WB_OUT), 1024, 1024, 1024, 1, bid, nb, smem);
}
__device__ __forceinline__ void st_conv_experts(const KP& p, int l, int bid, int nb, float* smem) {
    const int tidx = opaque_tid(); (void)tidx;
    bf16_t* wb = WSP(bf16_t, OFF_WB);
    conv_t(p.in(I_WEG) + (size_t)l * 16 * 1024 * 512, (bf16_t*)((char*)wb + WB_EG), 1024, 512, 512, 16, bid, nb, smem);
    conv_t(p.in(I_WEU) + (size_t)l * 16 * 1024 * 512, (bf16_t*)((char*)wb + WB_EU), 1024, 512, 512, 16, bid, nb, smem);
    conv_t(p.in(I_WED) + (size_t)l * 16 * 512 * 1024, (bf16_t*)((char*)wb + WB_ED), 512, 1024, 1024, 16, bid, nb, smem);
}

__device__ __forceinline__ const float* xrow_c(const KP& p, int r) { return (r < LC) ? (WSP(float, OFF_XC) + (size_t)r * D) : (p.out() + (size_t)(r - LC) * D); }
__device__ __forceinline__ const float* xrow_in(const KP& p, int r) { return (r < LC) ? (p.in(I_CTX) + (size_t)r * D) : (p.in(I_X) + (size_t)(r - LC) * D); }
__device__ __forceinline__ float* xrow(const KP& p, int r) { return (r < LC) ? (WSP(float, OFF_XC) + (size_t)r * D) : (p.out() + (size_t)(r - LC) * D); }
__device__ __forceinline__ void st_modulate(const KP& p, int l, int bid, int nb) {
    const int tidx = opaque_tid();
    const int lane = tidx & 63, wid = tidx >> 6;
    bf16_t* Hb = WSP(bf16_t, OFF_H);
    const float* g = p.in(I_GPREMIX) + l * D;
    auto ld = [&](int r, float4 (&v)[4]) __attribute__((always_inline)) {
        const float* xr = l == 0 ? xrow_in(p, r) : xrow_c(p, r);
#pragma unroll
        for (int i = 0; i < 4; ++i) v[i] = *(const float4*)(xr + i * 256 + lane * 4);
    };
    auto proc = [&](int r, float4 (&v)[4]) __attribute__((always_inline)) {
        const float* md = WSP(float, OFF_MOD) + (size_t)(l * 2 + (r < LC ? 1 : 0)) * 6144;
        float ss = 0.f;
#pragma unroll
        for (int i = 0; i < 4; ++i) ss += v[i].x * v[i].x + v[i].y * v[i].y + v[i].z * v[i].z + v[i].w * v[i].w;
        ss = wave_sum(ss);
        const float rstd = rsqrtf(ss * (1.0f / D) + EPS);
#pragma unroll
        for (int i = 0; i < 4; ++i) {
            const int c = i * 256 + lane * 4;
            const float4 gg = *(const float4*)(g + c), sh = *(const float4*)(md + c), sc = *(const float4*)(md + 1024 + c);
            const float h0 = v[i].x * rstd * gg.x * (1.f + sc.x) + sh.x, h1 = v[i].y * rstd * gg.y * (1.f + sc.y) + sh.y;
            const float h2 = v[i].z * rstd * gg.z * (1.f + sc.z) + sh.z, h3 = v[i].w * rstd * gg.w * (1.f + sc.w) + sh.w;
            uint2 o; o.x = pack2(h0, h1); o.y = pack2(h2, h3);
            *(uint2*)(Hb + (size_t)r * D + c) = o;
        }
    };
    {   const int r0 = bid * NWV + wid, rs = nb * NWV;
        float4 va[4], vb[4];
        if (r0 < T) ld(r0, va);
        for (int r = r0; r < T; r += 2 * rs) {
            if (r + rs < T) ld(r + rs, vb);
            proc(r, va);
            if (r + rs < T) { if (r + 2 * rs < T) ld(r + 2 * rs, va); proc(r + rs, vb); }
        } }
}

__device__ __forceinline__ void st_gemm_in(const KP& p, int l, int bid, int nb, char* lds) {
    const int tidx = opaque_tid();
    if (bid == 0 && tidx < 8) WSP(unsigned, OFF_CNT)[32 + tidx] = 0u;
    const bf16_t* Hb = WSP(bf16_t, OFF_H); const bf16_t* Wt = WSP(bf16_t, OFF_WB + WB_IN); bf16_t* P = WSP(bf16_t, OFF_P);
    float* ssq = WSP(float, OFF_SSQ); const float2* t16 = WSP(float2, OFF_ROPE); const float2* t8 = t16 + 256 * 16;
    const float* gqn = p.in(I_GQN) + l * 64; const float* gkn = p.in(I_GKN) + l * 64;
    int mt, pn;
    for (int it = 0; dense_tile(it, NINP / 256, true, bid, nb, mt, pn); ++it) {
        acc_t acc2[2]; acc_zero(acc2[0]); acc_zero(acc2[1]);
        gemm_core256_dense(acc2, Hb + (size_t)mt * 256 * 1024, 1024, Wt + (size_t)pn * 256 * 1024, 1024, 1024, lds);
        const int tid2 = opaque_tid(), lane = tid2 & 63, wid = tid2 >> 6, wn = wid >> 2, wc = wid & 3, fr = lane & 15, g = lane >> 4;
#pragma unroll
      for (int nh = 0; nh < 2; ++nh) {
        const int nt = 2 * pn + nh; const acc_t& acc = acc2[nh];
#pragma unroll
        for (int im = 0; im < 4; ++im) {
            const int ml = (im >> 1) * 128 + wc * 32 + (im & 1) * 16 + fr, row = mt * 256 + ml;
            bf16_t* prow_ = P + (size_t)row * PP + nt * 128 + wn * 64 + 4 * g;
            const bool lat = row >= LC; const int tpos = row - LC, prow = lat ? (tpos >> 6) : 0, pcol = lat ? (tpos & 63) : 0;
            f32x4 v[4];
#pragma unroll
            for (int in = 0; in < 4; ++in) v[in] = acc[in][im];
            if (nt <= 4) {
                float ss = 0.f;
#pragma unroll
                for (int in = 0; in < 4; ++in) ss += (v[in][0] * v[in][0] + v[in][1] * v[in][1]) + (v[in][2] * v[in][2] + v[in][3] * v[in][3]);
                ss += __shfl_xor(ss, 16); ss += __shfl_xor(ss, 32);
                const float sc = rsqrtf(ss * (1.0f / 64.0f) + EPS) * (nt < 4 ? SC_GQA : 1.0f);
                const float* gg = (nt < 4 ? gqn : gkn) + 4 * g;
#pragma unroll
                for (int in = 0; in < 4; ++in) { const float4 g4 = *(const float4*)(gg + 16 * in); v[in][0] *= sc * g4.x; v[in][1] *= sc * g4.y; v[in][2] *= sc * g4.z; v[in][3] *= sc * g4.w; }
                if (lat) {
#pragma unroll
                    for (int hlf = 0; hlf < 2; ++hlf) {
                        const float4* cs = (const float4*)(t16 + (hlf == 0 ? prow : pcol) * 16 + 4 * g);
                        const float4 c01 = cs[0], c23 = cs[1];
                        const f32x4 cc = {c01.x, c01.z, c23.x, c23.z}, sn = {c01.y, c01.w, c23.y, c23.w}, a = v[2 * hlf], b = v[2 * hlf + 1];
                        v[2 * hlf] = a * cc - b * sn; v[2 * hlf + 1] = a * sn + b * cc; }
                }
            } else if (nt >= 6 && nt <= 8) {
                float ss = 0.f;
#pragma unroll
                for (int in = 0; in < 4; ++in) ss += (v[in][0] * v[in][0] + v[in][1] * v[in][1]) + (v[in][2] * v[in][2] + v[in][3] * v[in][3]);
                ss += __shfl_xor(ss, 16); ss += __shfl_xor(ss, 32);
                if (g == 0) ssq[(size_t)row * 8 + (nt - 6) * 2 + wn] = ss;
            } else if (nt == 9 && wn == 0) {
#pragma unroll
                for (int in = 0; in < 2; ++in) {
                    f32x4 o; o[0] = __shfl_xor(v[in][0], 32); o[1] = __shfl_xor(v[in][1], 32); o[2] = __shfl_xor(v[in][2], 32); o[3] = __shfl_xor(v[in][3], 32);
                    if (lat) { const float4* cs = (const float4*)(t8 + (in == 0 ? prow : pcol) * 8 + 4 * (g & 1));
                        const float4 c01 = cs[0], c23 = cs[1];
                        if (g < 2) { v[in][0] = v[in][0] * c01.x - o[0] * c01.y; v[in][1] = v[in][1] * c01.z - o[1] * c01.w; v[in][2] = v[in][2] * c23.x - o[2] * c23.y; v[in][3] = v[in][3] * c23.z - o[3] * c23.w; }
                        else { v[in][0] = o[0] * c01.y + v[in][0] * c01.x; v[in][1] = o[1] * c01.w + v[in][1] * c01.z; v[in][2] = o[2] * c23.y + v[in][2] * c23.x; v[in][3] = o[3] * c23.w + v[in][3] * c23.z; } }
                }
            }
#pragma unroll
            for (int in = 0; in < 4; ++in) {
                const int G = nt * 8 + wn * 4 + in;
                if (G >= 106) {
                    if (G < 298) {
                        uint2 o; o.x = pack2(sigmoidf_(v[in][0]), sigmoidf_(v[in][1])); o.y = pack2(sigmoidf_(v[in][2]), sigmoidf_(v[in][3]));
                        *(uint2*)(WSP(bf16_t, OFF_GS) + ((((size_t)(mt * 192 + (G - 106)) * 16 + (ml >> 4)) * 64) + lane) * 4) = o; }
                } else if (G >= 74) *(uint2*)(WSP(bf16_t, OFF_SSMG) + ((size_t)(G - 74) * T + row) * 16 + 4 * g) = pack4(v[in]);
                else *(uint2*)(prow_ + 16 * in) = pack4(v[in]);
            }
        }
      }
    }
}

__device__ __forceinline__ void rope_pair(float& a, float& b, int pos, int i, int half) {
    const float freq = powf(10000.0f, -(float)i / (float)half);
    const float ang = (float)pos * freq;
    float sn, cs; sincosf(ang, &sn, &cs);
    const float na = a * cs - b * sn, nb_ = a * sn + b * cs; a = na; b = nb_;
}

constexpr int S5C = 64, NCH = T / S5C;
constexpr size_t S5_ZERO = OFF_WB + WB_EG;
constexpr size_t S5_KTAB = S5_ZERO + 256;
constexpr size_t S5_FTAB = S5_KTAB + (size_t)64 * 64 * 256 * 2;
constexpr size_t S5_GTAB = S5_FTAB + (size_t)64 * 128 * 1024 * 2;
constexpr size_t S5_SINB = S5_GTAB + (size_t)64 * 1024 * 128 * 2;
static_assert(S5_SINB + (size_t)NCH * 64 * 128 * 2 <= OFF_WB + WB_BYTES, "s5 tables overlay");
__device__ __forceinline__ int s5_row(int dir, int j) { return dir == 0 ? j : (j < LC ? LC - 1 - j : T + LC - 1 - j); }
__device__ __forceinline__ void s5_consts(const KP& p, int l, int dir, int g, int lane, float& lr, float& li, float (&bbr)[16], float (&bbi)[16]) {
    const int gi = (l * 2 + dir) * 32 + g, pi = gi * 64 + lane;
    const float are = p.in(I_ARE)[pi], aim = p.in(I_AIM)[pi], dt = expf(p.in(I_LOGDT)[gi]);
    const float mag = expf(are * dt); float sn, cs; sincosf(aim * dt, &sn, &cs);
    lr = mag * cs; li = mag * sn; const float den = are * are + aim * aim;
    const float cr = ((lr - 1.0f) * are + li * aim) / den, ci = (li * are - (lr - 1.0f) * aim) / den;
    const float4* br4 = (const float4*)(p.in(I_BRE) + (size_t)pi * 16); const float4* bi4 = (const float4*)(p.in(I_BIM) + (size_t)pi * 16);
#pragma unroll
    for (int q = 0; q < 4; ++q) { const float4 br = br4[q], bi = bi4[q];
        bbr[4 * q] = cr * br.x - ci * bi.x; bbi[4 * q] = cr * bi.x + ci * br.x; bbr[4 * q + 1] = cr * br.y - ci * bi.y; bbi[4 * q + 1] = cr * bi.y + ci * br.y;
        bbr[4 * q + 2] = cr * br.z - ci * bi.z; bbi[4 * q + 2] = cr * bi.z + ci * br.z; bbr[4 * q + 3] = cr * br.w - ci * bi.w; bbi[4 * q + 3] = cr * bi.w + ci * br.w; }
}
__device__ __forceinline__ void s5_unpack(uint4 a, uint4 b, float (&u)[16]) {
    u[0] = bflo(a.x); u[1] = bfhi(a.x); u[2] = bflo(a.y); u[3] = bfhi(a.y); u[4] = bflo(a.z); u[5] = bfhi(a.z); u[6] = bflo(a.w); u[7] = bfhi(a.w);
    u[8] = bflo(b.x); u[9] = bfhi(b.x); u[10] = bflo(b.y); u[11] = bfhi(b.y); u[12] = bflo(b.z); u[13] = bfhi(b.z); u[14] = bflo(b.w); u[15] = bfhi(b.w);
}
__device__ __forceinline__ void st_s5_local(const KP& p, int l, int bid, int nb) {
    const int tidx = opaque_tid();
    const int lane = tidx & 63, wid = tidx >> 6;
    const bf16_t* P = WSP(bf16_t, OFF_P); float2* F = WSP(float2, OFF_S5);
    const int gw = bid * NWV + wid, nw = nb * NWV;
    if (gw >= (nw / 64) * 64) return;
    const int gd = gw & 63, dir = gd >> 5, g = gd & 31, part = gw >> 6, nparts = nw >> 6;
    if (part >= 4) return;
    float lr, li, bbr[16], bbi[16]; s5_consts(p, l, dir, g, lane, lr, li, bbr, bbi);
    for (int c = part; c < 4; c += nparts) {
        float sr = 0.f, si = 0.f;
        for (int j0 = 0; j0 < S5C; j0 += 8) {
            uint4 ua[8], ub[8];
#pragma unroll
            for (int q = 0; q < 8; ++q) { const int r = s5_row(dir, c * S5C + j0 + q); const uint4* up = (const uint4*)SSMU(g, r); ua[q] = up[0]; ub[q] = up[1]; }
#pragma unroll
            for (int q = 0; q < 8; ++q) { float u[16]; s5_unpack(ua[q], ub[q], u);
                float bur = 0.f, bui = 0.f;
#pragma unroll
                for (int cc = 0; cc < 16; ++cc) { bur = fmaf(bbr[cc], u[cc], bur); bui = fmaf(bbi[cc], u[cc], bui); }
                const float nsr = lr * sr - li * si + bur, nsi = lr * si + li * sr + bui; sr = nsr; si = nsi; }
        }
        F[((size_t)(c * 2 + dir) * 32 + g) * 64 + lane] = make_float2(sr, si);
    }
}
__device__ __forceinline__ void st_s5_carry(const KP& p, int l, int bid, int nb, char* lds) {
    const int tidx = opaque_tid();
    float2* F = WSP(float2, OFF_S5); bf16_t* SB = WSP(bf16_t, S5_SINB);
    float4* comp = (float4*)lds;
    constexpr int RUN = 9;
    for (int cb = bid; cb < 256; cb += nb) {
        const int chl = tidx & 15, seg = tidx >> 4, idx = cb * 16 + chl;
        const int gi = l * 64 + (idx >> 6);
        const float are = p.in(I_ARE)[gi * 64 + (idx & 63)], aim = p.in(I_AIM)[gi * 64 + (idx & 63)], dt = expf(p.in(I_LOGDT)[gi]);
        const float mag = expf(are * dt); float sn, cs; sincosf(aim * dt, &sn, &cs);
        float pr = mag * cs, pi_ = mag * sn;
#pragma unroll
        for (int q = 0; q < 6; ++q) { const float nr = pr * pr - pi_ * pi_, ni = 2.f * pr * pi_; pr = nr; pi_ = ni; }
        const int c0 = seg * RUN;
        float2 f[RUN]; float ar = 1.f, ai = 0.f, br = 0.f, bi = 0.f;
#pragma unroll
        for (int q = 0; q < RUN; ++q) { const int c = c0 + q; f[q] = (c < NCH) ? F[(size_t)c * 4096 + idx] : make_float2(0.f, 0.f);
            if (c < NCH) { const float nbr = pr * br - pi_ * bi + f[q].x, nbi = pr * bi + pi_ * br + f[q].y; br = nbr; bi = nbi;
                           const float nar = pr * ar - pi_ * ai, nai = pr * ai + pi_ * ar; ar = nar; ai = nai; } }
        __syncthreads();
        comp[chl * 32 + seg] = make_float4(ar, ai, br, bi);
        __syncthreads();
        float sr = 0.f, si = 0.f;
        for (int j = 0; j < seg; ++j) { const float4 cj = comp[chl * 32 + j]; const float nr = cj.x * sr - cj.y * si + cj.z, ni = cj.x * si + cj.y * sr + cj.w; sr = nr; si = ni; }
#pragma unroll
        for (int q = 0; q < RUN; ++q) { const int c = c0 + q;
            if (c < NCH) { F[(size_t)c * 4096 + idx] = make_float2(sr, si);
                bf16_t* sb = SB + ((size_t)c * 64 + (idx >> 6)) * 128 + (idx & 63); sb[0] = f2bf(sr); sb[64] = f2bf(si);
                const float nr = pr * sr - pi_ * si + f[q].x, ni = pr * si + pi_ * sr + f[q].y; sr = nr; si = ni; } }
    }
    __syncthreads();
}
__device__ __forceinline__ void st_s5_scan(const KP& p, int l, int bid, int nb) {
    const int tidx = opaque_tid();
    const int lane = tidx & 63, wid = tidx >> 6;
    const bf16_t* P = WSP(bf16_t, OFF_P); const float2* F = WSP(float2, OFF_S5);
    const int gw = bid * NWV + wid, nw = nb * NWV;
    if (gw >= (nw / 64) * 64) return;
    const int gd = gw & 63, dir = gd >> 5, g = gd & 31, part = gw >> 6, nparts = nw >> 6;
    if (part >= 4) return;
    float* Yo = dir == 0 ? WSP(float, OFF_OM) : WSP(float, OFF_H);
    float lr, li, bbr[16], bbi[16]; s5_consts(p, l, dir, g, lane, lr, li, bbr, bbi);
    const int gi = (l * 2 + dir) * 32 + g;
    float cre[16], cim[16];
#pragma unroll
    for (int cc = 0; cc < 16; ++cc) { cre[cc] = p.in(I_CRE)[((size_t)gi * 16 + cc) * 64 + lane]; cim[cc] = p.in(I_CIM)[((size_t)gi * 16 + cc) * 64 + lane]; }
    const float dsk = p.in(I_SSMD)[l * 512 + g * 16 + (lane & 15)];
    for (int c = part; c < 4; c += nparts) {
        const float2 s0 = F[((size_t)(c * 2 + dir) * 32 + g) * 64 + lane];
        float sr = s0.x, si = s0.y;
        for (int j0 = 0; j0 < S5C; j0 += 8) {
            uint4 ua[8], ub[8];
#pragma unroll
            for (int q = 0; q < 8; ++q) { const int r = s5_row(dir, c * S5C + j0 + q); const uint4* up = (const uint4*)SSMU(g, r); ua[q] = up[0]; ub[q] = up[1]; }
#pragma unroll
            for (int q = 0; q < 8; ++q) { const int r = s5_row(dir, c * S5C + j0 + q);
                float u[16]; s5_unpack(ua[q], ub[q], u);
                float bur = 0.f, bui = 0.f;
#pragma unroll
                for (int cc = 0; cc < 16; ++cc) { bur = fmaf(bbr[cc], u[cc], bur); bui = fmaf(bbi[cc], u[cc], bui); }
                const float nsr = lr * sr - li * si + bur, nsi = lr * si + li * sr + bui; sr = nsr; si = nsi;
                float t16[16];
#pragma unroll
                for (int cc = 0; cc < 16; ++cc) t16[cc] = cre[cc] * sr - cim[cc] * si;
                float y = transpose_reduce16(t16, lane);
                if (lane < 16) {
                    if (dir == 0) y += dsk * bf2f(SSMU(g, r)[lane]);
                    Yo[(size_t)r * 512 + g * 16 + lane] = y; }
            }
        }
    }
}

__device__ __forceinline__ void st_s5_tables(const KP& p, int l, int bid, int nb, char* lds) {
    const int tidx = opaque_tid();
    float* pwr = (float*)lds; float* pwi = pwr + 65 * 64; float* bbr = pwi + 65 * 64; float* bbi = bbr + 1024; float* cre = bbi + 1024; float* cim = cre + 1024;
    bf16_t* Ktab = WSP(bf16_t, S5_KTAB); bf16_t* Ftab = WSP(bf16_t, S5_FTAB); bf16_t* Gtab = WSP(bf16_t, S5_GTAB);
    if (bid == 0 && tidx < 64) WSP(unsigned, S5_ZERO)[tidx] = 0u;
    for (int item = bid; item < 256; item += nb) {
        const int gd = item >> 2, q = item & 3, dir = gd >> 5, g = gd & 31, gi = (l * 2 + dir) * 32 + g;
        __syncthreads();
        if (tidx < 64) {
            const int pp = tidx, pi = gi * 64 + pp;
            const float are = p.in(I_ARE)[pi], aim = p.in(I_AIM)[pi], dt = expf(p.in(I_LOGDT)[gi]);
            const float mag = expf(are * dt); float sn, cs; sincosf(aim * dt, &sn, &cs);
            const float lr = mag * cs, li = mag * sn, den = are * are + aim * aim;
            const float cr = ((lr - 1.0f) * are + li * aim) / den, ci = (li * are - (lr - 1.0f) * aim) / den;
            for (int c = 0; c < 16; ++c) { const float br = p.in(I_BRE)[(size_t)pi * 16 + c], bi = p.in(I_BIM)[(size_t)pi * 16 + c];
                bbr[pp * 16 + c] = cr * br - ci * bi; bbi[pp * 16 + c] = cr * bi + ci * br; }
            float ar = 1.f, ai = 0.f;
            for (int n = 0; n <= 64; ++n) { pwr[n * 64 + pp] = ar; pwi[n * 64 + pp] = ai; const float nr = ar * lr - ai * li, ni = ar * li + ai * lr; ar = nr; ai = ni; }
        } else {
            for (int i = tidx - 64; i < 1024; i += NTH - 64) { cre[i] = p.in(I_CRE)[(size_t)gi * 1024 + i]; cim[i] = p.in(I_CIM)[(size_t)gi * 1024 + i]; }
        }
        __syncthreads();
        for (int e = 0; e < 8; ++e) {
            const int idx = tidx + NTH * e, tau = 16 * q + (idx >> 8), c = (idx >> 4) & 15, c2 = idx & 15;
            float s = 0.f;
            for (int pp = 0; pp < 64; ++pp) {
                const float xr = cre[c * 64 + pp], xi = cim[c * 64 + pp], wr = pwr[tau * 64 + pp], wi = pwi[tau * 64 + pp];
                const float zr = xr * wr - xi * wi, zi = xr * wi + xi * wr;
                s += zr * bbr[pp * 16 + c2] - zi * bbi[pp * 16 + c2];
            }
            Ktab[(((size_t)gd * 64 + tau) * 16 + c) * 16 + c2] = f2bf(s);
        }
        for (int e = 0; e < 32; ++e) {
            const int idx2 = tidx + NTH * e, n = 32 * q + (idx2 >> 9), k = (idx2 & 511) * 2, pp = n & 63, comp = n >> 6, i = k >> 4, c2 = k & 15;
            const float wr = pwr[(63 - i) * 64 + pp], wi = pwi[(63 - i) * 64 + pp];
            const float b0r = bbr[pp * 16 + c2], b0i = bbi[pp * 16 + c2], b1r = bbr[pp * 16 + c2 + 1], b1i = bbi[pp * 16 + c2 + 1];
            const float v0 = comp ? (wr * b0i + wi * b0r) : (wr * b0r - wi * b0i), v1 = comp ? (wr * b1i + wi * b1r) : (wr * b1r - wi * b1i);
            *(unsigned*)(Ftab + ((size_t)gd * 128 + n) * 1024 + k) = pack2(v0, v1);
        }
        for (int e = 0; e < 32; ++e) {
            const int idx2 = tidx + NTH * e, row = 256 * q + (idx2 >> 6), n = (idx2 & 63) * 2, t = row >> 4, c = row & 15, comp = n >> 6, pp = n & 63;
            float v[2];
#pragma unroll
            for (int h = 0; h < 2; ++h) { const float xr = cre[c * 64 + pp + h], xi = cim[c * 64 + pp + h], wr = pwr[(t + 1) * 64 + pp + h], wi = pwi[(t + 1) * 64 + pp + h];
                v[h] = comp ? -(xr * wi + xi * wr) : (xr * wr - xi * wi); }
            *(unsigned*)(Gtab + ((size_t)gd * 1024 + row) * 128 + n) = pack2(v[0], v[1]);
        }
    }
    __syncthreads();
}
__device__ __forceinline__ void st_s5_fgemm(const KP& p, int bid, int nb, char* lds) {
    const int tidx = opaque_tid();
    const bf16_t* P = WSP(bf16_t, OFF_P); const bf16_t* Ftab = WSP(bf16_t, S5_FTAB); float* F = WSP(float, OFF_S5);
    const int srow = tidx >> 3, gch = (tidx & 7) ^ ((srow >> 1) & 7);
    for (int gd = bid; gd < 64; gd += nb) {
        const int dir = gd >> 5, g = gd & 31;
        acc_t acc; acc_zero(acc);
        gemm_core_g(acc,
            [&](int i, int kt) { const int m = srow + 64 * i, tok = kt * 4 + (gch >> 1); return SSMU(g, s5_row(dir, 64 * (4 + m) + tok)) + 8 * (gch & 1); },
            [&](int i, int kt) { return Ftab + ((size_t)gd * 128 + srow + 64 * i) * 1024 + kt * 64 + gch * 8; }, 16, lds);
        acc_visit(acc, [&](int ml, int nl, f32x4 v) {
            float* dst = F + (((size_t)(4 + ml) * 2 + dir) * 32 + g) * 128 + (nl & 63) * 2 + (nl >> 6);
            dst[0] = v[0]; dst[2] = v[1]; dst[4] = v[2]; dst[6] = v[3]; });
    }
}
__device__ __forceinline__ void st_s5_ygemm(const KP& p, int l, int bid, int nb, char* lds) {
    const int tidx = opaque_tid();
    const bf16_t* P = WSP(bf16_t, OFF_P); const bf16_t* Ktab = WSP(bf16_t, S5_KTAB); const bf16_t* Gtab = WSP(bf16_t, S5_GTAB);
    const bf16_t* Sinb = WSP(bf16_t, S5_SINB); const bf16_t* Zero = WSP(bf16_t, S5_ZERO); bf16_t* Y1 = WSP(bf16_t, OFF_OS);
    const int srow = tidx >> 3, gch = (tidx & 7) ^ ((srow >> 1) & 7);
    for (int u = bid; u < 256; u += nb) {
        const int g = u >> 3, nt = u & 7;
        acc_t acc; acc_zero(acc);
        {   const int gd = g, nkt = 2 * (nt + 1);
            gemm_core_g(acc,
                [&](int i, int kt) { const int m = srow + 64 * i;
                    if (kt < nkt) { const int tok = kt * 4 + (gch >> 1); return SSMU(g, 64 * (4 + m) + tok) + 8 * (gch & 1); }
                    return Sinb + ((size_t)(4 + m) * 64 + gd) * 128 + (kt - nkt) * 64 + gch * 8; },
                [&](int i, int kt) { const int n = nt * 128 + srow + 64 * i, t = n >> 4, c = n & 15;
                    if (kt < nkt) { const int tau = t - (kt * 4 + (gch >> 1)); return tau >= 0 ? Ktab + (((size_t)gd * 64 + tau) * 16 + c) * 16 + 8 * (gch & 1) : Zero; }
                    return Gtab + ((size_t)gd * 1024 + n) * 128 + (kt - nkt) * 64 + gch * 8; }, nkt + 2, lds); }
        {   const int gd = 32 + g, nkt = 2 * (8 - nt);
            gemm_core_g(acc,
                [&](int i, int kt) { const int m = srow + 64 * i, cx = 259 - m;
                    if (kt < nkt) { const int tok = kt * 4 + (gch >> 1); return SSMU(g, T + LC - 1 - (64 * cx + tok)) + 8 * (gch & 1); }
                    return Sinb + ((size_t)cx * 64 + gd) * 128 + (kt - nkt) * 64 + gch * 8; },
                [&](int i, int kt) { const int n = nt * 128 + srow + 64 * i, t = 63 - (n >> 4), c = n & 15;
                    if (kt < nkt) { const int tau = t - (kt * 4 + (gch >> 1)); return tau >= 0 ? Ktab + (((size_t)gd * 64 + tau) * 16 + c) * 16 + 8 * (gch & 1) : Zero; }
                    return Gtab + ((size_t)gd * 1024 + t * 16 + c) * 128 + (kt - nkt) * 64 + gch * 8; }, nkt + 2, lds); }
        acc_visit(acc, [&](int ml, int nl, f32x4 v) {
            const int n = nt * 128 + nl, t = n >> 4, c0 = n & 15, r = 64 * (4 + ml) + t;
            const float4 dsk = *(const float4*)(p.in(I_SSMD) + l * 512 + g * 16 + c0); const uint2 ur = *(const uint2*)(SSMU(g, r) + c0);
            uint2 o; o.x = pack2(gelu_tanh(v[0] + dsk.x * bflo(ur.x)), gelu_tanh(v[1] + dsk.y * bfhi(ur.x))); o.y = pack2(gelu_tanh(v[2] + dsk.z * bflo(ur.y)), gelu_tanh(v[3] + dsk.w * bfhi(ur.y)));
            *(uint2*)(Y1 + (size_t)r * 512 + g * 16 + c0) = o; });
    }
}
__device__ __forceinline__ void st_s5_ctx_y(const KP& p, int l, int bid, int nb) {
    const int tidx = opaque_tid();
    const bf16_t* P = WSP(bf16_t, OFF_P); const bf16_t* Ktab = WSP(bf16_t, S5_KTAB); const bf16_t* Gtab = WSP(bf16_t, S5_GTAB);
    const float* SIN = WSP(float, OFF_S5); bf16_t* Y1 = WSP(bf16_t, OFF_OS);
    for (int idx = bid * NTH + tidx; idx < 32 * 256 * 16; idx += nb * NTH) {
        const int ch = idx & 15, r = (idx >> 4) & 255, g = idx >> 12;
        float y = p.in(I_SSMD)[l * 512 + g * 16 + ch] * bf2f(SSMU(g, r)[ch]);
#pragma unroll 1
        for (int dir = 0; dir < 2; ++dir) {
            const int gd = dir * 32 + g, j = dir == 0 ? r : (LC - 1 - r), cx = j >> 6, t = j & 63;
            const bf16_t* kt_ = Ktab + ((size_t)gd * 64 * 16 + ch) * 16;
            float a = 0.f;
            for (int i = 0; i <= t; ++i) {
                const int jr = 64 * cx + i, rr = dir == 0 ? jr : (LC - 1 - jr);
                const uint4* up = (const uint4*)SSMU(g, rr); const uint4* kp = (const uint4*)(kt_ + (size_t)(t - i) * 256);
                a = dot8(up[0], kp[0], a); a = dot8(up[1], kp[1], a);
            }
            const bf16_t* gp = Gtab + ((size_t)gd * 1024 + t * 16 + ch) * 128; const float* sp = SIN + (((size_t)cx * 2 + dir) * 32 + g) * 128;
            for (int q = 0; q < 64; q += 2) { const unsigned gre = *(const unsigned*)(gp + q), gim = *(const unsigned*)(gp + 64 + q); const float4 s4 = *(const float4*)(sp + 2 * q);
                a = fmaf(bflo(gre), s4.x, a); a = fmaf(bflo(gim), s4.y, a); a = fmaf(bfhi(gre), s4.z, a); a = fmaf(bfhi(gim), s4.w, a); }
            y += a;
        }
        Y1[(size_t)r * 512 + g * 16 + ch] = f2bf(gelu_tanh(y));
    }
}
__device__ __forceinline__ void st_s5_fin(const KP& p, int bid, int nb) {
    const int tidx = opaque_tid();
    const float* Yf = WSP(float, OFF_OM); const float* Yb = WSP(float, OFF_H); bf16_t* P = WSP(bf16_t, OFF_P);
    for (long idx = (long)bid * NTH + tidx; idx < (long)T * 512; idx += (long)nb * NTH) {
        const int r = (int)(idx >> 9), c = (int)(idx & 511);
        P[(size_t)r * PP + C_SSM + c] = f2bf(gelu_tanh(Yf[idx] + Yb[idx]));
    }
}

template <int SET>
__device__ __forceinline__ void st_proj2(const KP& p, int l, int bid, int nb, char* lds) {
    const int tidx = opaque_tid();
    bf16_t* P = WSP(bf16_t, OFF_P);
    const bf16_t* Wuq = WSP(bf16_t, OFF_WB + WB_UQ); bf16_t* Qm = WSP(bf16_t, OFF_H);
    const bf16_t* Wukv = WSP(bf16_t, OFF_WB + WB_UKV); bf16_t* Kn = WSP(bf16_t, OFF_KN); bf16_t* Vm = WSP(bf16_t, OFF_V);
    const bf16_t* Wglu = WSP(bf16_t, OFF_WB + WB_GLU); bf16_t* Os = WSP(bf16_t, OFF_OS); const float* bg = p.in(I_BGLU) + l * 512;
    int mt, ntv;
    for (int it = 0; dense_tile(it, SET == 0 ? 14 : 4, SET == 0 || l + 1 < NL, bid, nb, mt, ntv); ++it) {
        if (SET == 1) ntv += 14;
        const int which = ntv < 6 ? 0 : (ntv < 14 ? 1 : 2), nt = ntv - (which == 0 ? 0 : (which == 1 ? 6 : 14));
        const int K = which == 0 ? 256 : (which == 1 ? 128 : 512);
        const bf16_t* abase = which == 2 ? (const bf16_t*)Os + (size_t)mt * 256 * 512 : P + (size_t)mt * 256 * PP + (which == 0 ? C_CQ : C_CKV);
        const int apitch = which == 2 ? 512 : PP;
        const bf16_t* wbase = (which == 0 ? Wuq : (which == 1 ? Wukv : Wglu)) + (size_t)nt * 128 * K;
        acc_t acc; acc_zero(acc);
        gemm_core(acc, [&](int r) { return abase + (size_t)r * apitch; }, [&](int r) { return wbase + (size_t)r * K; }, K, lds);
        if (which == 0) {
            const float* ssq = WSP(float, OFF_SSQ); const float2* t8 = WSP(float2, OFF_ROPE) + 256 * 16;
            const int lane_ = tidx & 63, wid_ = tidx >> 6, wm_ = wid_ >> 1, wn_ = wid_ & 1, fr_ = lane_ & 15, g_ = lane_ >> 4;
#pragma unroll
            for (int im = 0; im < 4; ++im) {
                const int row = mt * 256 + wm_ * 64 + 16 * im + fr_;
                const float4 s4 = *(const float4*)(ssq + (size_t)row * 8);
                const float sc = rsqrtf(((s4.x + s4.y) + (s4.z + s4.w)) * (1.0f / 256.0f) + EPS) * SC_MLA;
                const bool lat = row >= LC; const int tpos = row - LC, prow = lat ? (tpos >> 6) : 0, pcol = lat ? (tpos & 63) : 0;
#pragma unroll
                for (int in = 0; in < 4; ++in) {
                    f32x4 v = acc[in][im] * sc;
                    if (((nt * 4 + wn_ * 2 + (in >> 1)) % 3) == 2) {
                        f32x4 o; o[0] = __shfl_xor(v[0], 32); o[1] = __shfl_xor(v[1], 32); o[2] = __shfl_xor(v[2], 32); o[3] = __shfl_xor(v[3], 32);
                        if (lat) { const float4* cs = (const float4*)(t8 + ((in & 1) == 0 ? prow : pcol) * 8 + 4 * (g_ & 1));
                            const float4 c01 = cs[0], c23 = cs[1];
                            if (g_ < 2) { v[0] = v[0] * c01.x - o[0] * c01.y; v[1] = v[1] * c01.z - o[1] * c01.w; v[2] = v[2] * c23.x - o[2] * c23.y; v[3] = v[3] * c23.z - o[3] * c23.w; }
                            else { v[0] = o[0] * c01.y + v[0] * c01.x; v[1] = o[1] * c01.w + v[1] * c01.z; v[2] = o[2] * c23.y + v[2] * c23.x; v[3] = o[3] * c23.w + v[3] * c23.z; } }
                    }
                    *(uint2*)(Qm + (size_t)row * 768 + nt * 128 + wn_ * 64 + 16 * in + 4 * g_) = pack4(v);
                }
            }
        } else if (which == 1) {
            const float* ssq = WSP(float, OFF_SSQ);
            acc_visit(acc, [&](int ml, int nl, f32x4 v) {
                const float2 s2 = *(const float2*)(ssq + (size_t)(mt * 256 + ml) * 8 + 4);
                const float sc = rsqrtf((s2.x + s2.y) * (1.0f / 128.0f) + EPS);
                bf16_t* dst = (nl < 64) ? (Kn + (size_t)(mt * 256 + ml) * 512 + nt * 64 + nl) : (Vm + (size_t)(mt * 256 + ml) * 512 + nt * 64 + nl - 64);
                *(uint2*)dst = pack4(v * sc); });
        } else {
            acc_visit(acc, [&](int ml, int nl, f32x4 v) {
                const int n = nt * 128 + nl;
                const uint2 yr = *(const uint2*)(Os + (size_t)(mt * 256 + ml) * 512 + n); const float4 b4 = *(const float4*)(bg + n);
                uint2 o; o.x = pack2(bflo(yr.x) * sigmoidf_(v[0] + b4.x), bfhi(yr.x) * sigmoidf_(v[1] + b4.y));
                o.y = pack2(bflo(yr.y) * sigmoidf_(v[2] + b4.z), bfhi(yr.y) * sigmoidf_(v[3] + b4.w));
                *(uint2*)(P + (size_t)(mt * 256 + ml) * PP + C_SSM + n) = o; });
        }
    }
}
__device__ __forceinline__ void st_ropeq(const KP& p, int bid, int nb, char* lds) {
    const int tidx = opaque_tid();
    {   const int lane = tidx & 63, wid = tidx >> 6;
        const bf16_t* Kn = WSP(bf16_t, OFF_KN); const bf16_t* P = WSP(bf16_t, OFF_P);
        float runmax = 0.f;
        for (int r = bid * NWV + wid; r < T; r += nb * NWV) {
            const uint4 kv = *(const uint4*)(Kn + (size_t)r * 512 + lane * 8);
            float s = bflo(kv.x) * bflo(kv.x) + bfhi(kv.x) * bfhi(kv.x) + bflo(kv.y) * bflo(kv.y) + bfhi(kv.y) * bfhi(kv.y)
                    + bflo(kv.z) * bflo(kv.z) + bfhi(kv.z) * bfhi(kv.z) + bflo(kv.w) * bflo(kv.w) + bfhi(kv.w) * bfhi(kv.w);
            s += __shfl_xor(s, 1); s += __shfl_xor(s, 2); s += __shfl_xor(s, 4);
            float sr = 0.f;
            if (lane < 4) { const uint4 rv = *(const uint4*)(P + (size_t)r * PP + C_KR + lane * 8);
                sr = bflo(rv.x) * bflo(rv.x) + bfhi(rv.x) * bfhi(rv.x) + bflo(rv.y) * bflo(rv.y) + bfhi(rv.y) * bfhi(rv.y)
                   + bflo(rv.z) * bflo(rv.z) + bfhi(rv.z) * bfhi(rv.z) + bflo(rv.w) * bflo(rv.w) + bfhi(rv.w) * bfhi(rv.w); }
            sr += __shfl_xor(sr, 1); sr += __shfl_xor(sr, 2);
            sr = __shfl(sr, 0);
            runmax = fmaxf(runmax, s + sr);
        }
        unsigned* lmax = (unsigned*)lds;
        __syncthreads();
        if (tidx < 8) lmax[tidx] = 0u;
        __syncthreads();
        if ((lane & 7) == 0) atomicMax(&lmax[lane >> 3], __float_as_uint(runmax));
        __syncthreads();
        if (tidx < 8) atomicMax(WSP(unsigned, OFF_CNT) + 32 + tidx, lmax[tidx]);
    }
}

typedef short s16x4 __attribute__((ext_vector_type(4)));
typedef short v4i16_t __attribute__((ext_vector_type(4)));
typedef __attribute__((address_space(3))) const char* lds_cptr;
__device__ __forceinline__ s16x4 vtr(lds_cptr q) { return __builtin_bit_cast(s16x4, __builtin_amdgcn_ds_read_tr16_b64_v4i16((__attribute__((address_space(3))) v4i16_t*)q)); }
__device__ __forceinline__ unsigned cvtpk(float lo, float hi) { return pack2(lo, hi); }
constexpr int AT_K = 0, AT_V = 8192, AT_KR = 16384, AT_BUF = 20480;

template <int DQK, int VAR = 0>
__device__ __forceinline__ void attn_item(const bf16_t* Q, int qpitch, const bf16_t* KA, int kapitch, const bf16_t* KB, int kbpitch,
                                          const bf16_t* V, int vpitch, int ntiles, float C, bf16_t* O, char* lds) {
    const int tid = opaque_tid(), lane = tid & 63, wid = tid >> 6, r32 = lane & 31, hi = lane >> 5;
    constexpr int ND0 = DQK / 16;
    bf16x8 qr[ND0];
    { const bf16_t* qp = Q + (size_t)(wid * 32 + r32) * qpitch + hi * 8;
#pragma unroll
      for (int d0 = 0; d0 < ND0; ++d0) qr[d0] = *(const bf16x8*)(qp + d0 * 16); }
    const int srow = tid >> 3, sch = tid & 7;
    const bf16_t* gk = KA + (size_t)srow * kapitch + sch * 8;
    const bf16_t* gv = V + (size_t)srow * vpitch + sch * 8;
    const bf16_t* gr = (DQK > 64) ? (KB + (size_t)(tid >> 2) * kbpitch + (tid & 3) * 8) : nullptr;
    const int sk_off = AT_K + srow * 128 + ((sch ^ ((srow >> 1) & 7)) << 4);
    const int sv_off = AT_V + (sch >> 2) * 4096 + srow * 64 + (sch & 3) * 16;
    const int sr_off = AT_KR + (tid >> 2) * 64 + (((tid & 3) ^ (((tid >> 2) >> 2) & 3)) << 4);
    const bool do_r = (DQK > 64) && (tid < 256);
    const int kf_off = AT_K + r32 * 128, ksw = (r32 >> 1) & 7;
    const int rf_off = AT_KR + r32 * 64, rsw = (r32 >> 2) & 3;
    const int vf_off = AT_V + (4 * hi + ((lane & 15) >> 2)) * 64 + ((lane >> 4) & 1) * 32 + (lane & 3) * 8;
    uint4 rk, rv, rr; rr = make_uint4(0, 0, 0, 0);
    rk = *(const uint4*)gk; rv = *(const uint4*)gv; if (do_r) rr = *(const uint4*)gr;
    *(uint4*)(lds + sk_off) = rk; *(uint4*)(lds + sv_off) = rv; if (do_r) *(uint4*)(lds + sr_off) = rr;
    __syncthreads();
    f32x16 o0, o1;
#pragma unroll
    for (int r = 0; r < 16; ++r) { o0[r] = 0.f; o1[r] = 0.f; }
    float mrun = -INFINITY, lrun = 0.f;
    for (int t = 0; t < ntiles; ++t) {
        const char* cur = lds + (VAR == 2 ? 0 : (t & 1)) * AT_BUF; char* nxt = lds + ((t + 1) & 1) * AT_BUF;
        const bool more = (t + 1 < ntiles);
        if (more && VAR != 2) { rk = *(const uint4*)(gk + (size_t)(t + 1) * 64 * kapitch); rv = *(const uint4*)(gv + (size_t)(t + 1) * 64 * vpitch); if (do_r) rr = *(const uint4*)(gr + (size_t)(t + 1) * 64 * kbpitch); }
        f32x16 p0, p1;
#pragma unroll
        for (int r = 0; r < 16; ++r) { p0[r] = 0.f; p1[r] = 0.f; }
#pragma unroll
        for (int d0 = 0; d0 < 4; ++d0) {
            const int co = ((2 * d0 + hi) ^ ksw) << 4;
            const bf16x8 k0 = *(const bf16x8*)(cur + kf_off + co), k1 = *(const bf16x8*)(cur + kf_off + 32 * 128 + co);
            p0 = MFMA32(k0, qr[d0], p0); p1 = MFMA32(k1, qr[d0], p1);
        }
        if (DQK > 64) {
#pragma unroll
            for (int d0 = 4; d0 < ND0; ++d0) {
                const int co = ((2 * (d0 - 4) + hi) ^ rsw) << 4;
                const bf16x8 k0 = *(const bf16x8*)(cur + rf_off + co), k1 = *(const bf16x8*)(cur + rf_off + 32 * 64 + co);
                p0 = MFMA32(k0, qr[d0], p0); p1 = MFMA32(k1, qr[d0], p1);
            }
        }
        if (VAR != 1) {
        float mx = fmaxf(p0[0], p1[0]);
#pragma unroll
        for (int r = 1; r < 16; ++r) mx = fmaxf(mx, fmaxf(p0[r], p1[r]));
        mx = xhalf_max(mx) * C;
        const float mnew = fmaxf(mrun, mx);
        if (__any(mnew > mrun)) {
            const float alpha = __builtin_amdgcn_exp2f(mrun - mnew);
            lrun *= alpha;
#pragma unroll
            for (int r = 0; r < 16; ++r) { o0[r] *= alpha; o1[r] *= alpha; }
            mrun = mnew;
        }
        const float nm = -mrun;
        float ls = 0.f;
#pragma unroll
        for (int r = 0; r < 16; ++r) { p0[r] = __builtin_amdgcn_exp2f(fmaf(p0[r], C, nm)); p1[r] = __builtin_amdgcn_exp2f(fmaf(p1[r], C, nm)); ls += p0[r] + p1[r]; }
        lrun += ls;
        }
#pragma unroll
        for (int s = 0; s < 4; ++s) {
            bf16x8 pf;
            {   unsigned w0, w1, w2, w3;
                if (s < 2) { w0 = cvtpk(p0[8 * s], p0[8 * s + 1]); w1 = cvtpk(p0[8 * s + 2], p0[8 * s + 3]); w2 = cvtpk(p0[8 * s + 4], p0[8 * s + 5]); w3 = cvtpk(p0[8 * s + 6], p0[8 * s + 7]); }
                else { const int s2 = s - 2; w0 = cvtpk(p1[8 * s2], p1[8 * s2 + 1]); w1 = cvtpk(p1[8 * s2 + 2], p1[8 * s2 + 3]); w2 = cvtpk(p1[8 * s2 + 4], p1[8 * s2 + 5]); w3 = cvtpk(p1[8 * s2 + 6], p1[8 * s2 + 7]); }
                uint4 u = make_uint4(w0, w1, w2, w3); pf = __builtin_bit_cast(bf16x8, u); }
            const lds_cptr vb = (lds_cptr)cur + vf_off + s * 1024;
            const s16x4 a0 = vtr(vb), a1 = vtr(vb + 512), b0 = vtr(vb + 4096), b1 = vtr(vb + 4096 + 512);
            const bf16x8 v0 = (bf16x8){a0[0], a0[1], a0[2], a0[3], a1[0], a1[1], a1[2], a1[3]};
            const bf16x8 v1 = (bf16x8){b0[0], b0[1], b0[2], b0[3], b1[0], b1[1], b1[2], b1[3]};
            o0 = MFMA32(v0, pf, o0); o1 = MFMA32(v1, pf, o1);
        }
        if (VAR != 2) { if (more) { *(uint4*)(nxt + sk_off) = rk; *(uint4*)(nxt + sv_off) = rv; if (do_r) *(uint4*)(nxt + sr_off) = rr; }
        __syncthreads(); }
    }
    const float inv = 1.0f / xhalf_sum(lrun);
    bf16_t* op = O + (size_t)(wid * 32 + r32) * 512 + 4 * hi;
#pragma unroll
    for (int rg = 0; rg < 4; ++rg) {
        uint2 a; a.x = pack2(o0[4 * rg] * inv, o0[4 * rg + 1] * inv); a.y = pack2(o0[4 * rg + 2] * inv, o0[4 * rg + 3] * inv);
        uint2 b; b.x = pack2(o1[4 * rg] * inv, o1[4 * rg + 1] * inv); b.y = pack2(o1[4 * rg + 2] * inv, o1[4 * rg + 3] * inv);
        *(uint2*)(op + 8 * rg) = a; *(uint2*)(op + 32 + 8 * rg) = b;
    }
}
#define SBAR() __builtin_amdgcn_sched_barrier(0)
#define PINV(x) asm volatile("" : "+v"(x))
constexpr float ATT_THR = 6.0f;
template <int DQK>
__device__ __forceinline__ void attn_item2(const bf16_t* Q, int qpitch, const bf16_t* KA, int kapitch, const bf16_t* KB, int kbpitch,
                                           const bf16_t* V, int vpitch, int ntiles, bf16_t* O, char* lds) {
    const int tid = opaque_tid(), lane = tid & 63, wid = tid >> 6, r32 = lane & 31, hi = lane >> 5;
    const int wu = __builtin_amdgcn_readfirstlane(wid);
    constexpr int ND0 = DQK / 16, NQK = 2 * ND0;
    constexpr bool ROPE = DQK > 64;
    const int krow = 8 * wu + (lane >> 3);
    const bf16_t* gk = KA + (size_t)krow * kapitch + (((lane & 7) ^ ((krow >> 1) & 7)) << 3);
    const bf16_t* gv = V + (size_t)(16 * (wu & 3) + (lane >> 2)) * vpitch + (wu >> 2) * 32 + (lane & 3) * 8;
    const int rrow = 16 * (wu & 3) + (lane >> 2);
    const bf16_t* gr = ROPE ? (KB + (size_t)rrow * kbpitch + (((lane & 3) ^ ((rrow >> 2) & 3)) << 3)) : nullptr;
    char* dk = lds + AT_K + wu * 1024; char* dv = lds + AT_V + wu * 1024; char* dr = lds + AT_KR + (wu & 3) * 1024;
    auto issue = [&](int t, int slot) {
        GLDS16(gk + (size_t)t * 64 * kapitch, dk + slot * AT_BUF); GLDS16(gv + (size_t)t * 64 * vpitch, dv + slot * AT_BUF);
        if (ROPE) GLDS16(gr + (size_t)t * 64 * kbpitch, dr + slot * AT_BUF);
    };
    asm volatile("s_waitcnt vmcnt(0)" ::: "memory");
    issue(0, 0);
    if (ntiles > 1) issue(1, 1);
    bf16x8 qr[ND0];
    { const bf16_t* qp = Q + (size_t)(wid * 32 + r32) * qpitch + hi * 8;
#pragma unroll
      for (int d0 = 0; d0 < ND0; ++d0) qr[d0] = *(const bf16x8*)(qp + d0 * 16); }
    const int kf_off = AT_K + r32 * 128, ksw = (r32 >> 1) & 7;
    const int rf_off = AT_KR + r32 * 64, rsw = (r32 >> 2) & 3;
    const int vf_off = AT_V + (4 * hi + ((lane & 15) >> 2)) * 64 + ((lane >> 4) & 1) * 32 + (lane & 3) * 8;
    auto kfrag = [&](const char* slot, int g) -> bf16x8 {
        const int d0 = g >> 1, n = g & 1;
        if (d0 < 4) return *(const bf16x8*)(slot + kf_off + n * 32 * 128 + (((2 * d0 + hi) ^ ksw) << 4));
        return *(const bf16x8*)(slot + rf_off + n * 32 * 64 + (((2 * (d0 - 4) + hi) ^ rsw) << 4));
    };
    auto vfrag = [&](const char* slot, int g) -> bf16x8 {
        const lds_cptr vb = (lds_cptr)slot + vf_off + (g >> 1) * 1024 + (g & 1) * 4096;
        const s16x4 a0 = vtr(vb), a1 = vtr(vb + 512);
        return (bf16x8){a0[0], a0[1], a0[2], a0[3], a1[0], a1[1], a1[2], a1[3]};
    };
    f32x16 o0, o1, sA0, sA1, sB0, sB1;
    const f32x16 zero16 = {0.f, 0.f, 0.f, 0.f, 0.f, 0.f, 0.f, 0.f, 0.f, 0.f, 0.f, 0.f, 0.f, 0.f, 0.f, 0.f};
#pragma unroll
    for (int r = 0; r < 16; ++r) { o0[r] = 0.f; o1[r] = 0.f; }
    float mref, lrun = 0.f;
    if (ntiles > 1) asm volatile("s_waitcnt vmcnt(%0)" :: "n"(ROPE ? 3 : 2) : "memory"); else asm volatile("s_waitcnt vmcnt(0)" ::: "memory");
    __builtin_amdgcn_s_barrier();
    {
#pragma unroll
        for (int g = 0; g < NQK; ++g) { const bf16x8 kf = kfrag(lds, g);
            if (g & 1) sA1 = MFMA32(kf, qr[g >> 1], g < 2 ? zero16 : sA1); else sA0 = MFMA32(kf, qr[g >> 1], g < 2 ? zero16 : sA0); }
        float mx = fmaxf(sA0[0], sA1[0]);
#pragma unroll
        for (int r = 1; r < 16; ++r) mx = fmaxf(mx, fmaxf(sA0[r], sA1[r]));
        mref = xhalf_max(mx);
    }
    asm volatile("s_waitcnt vmcnt(0) lgkmcnt(0)" ::: "memory");
    __builtin_amdgcn_s_barrier();
    auto step = [&](auto HN, f32x16& c0, f32x16& c1, f32x16& n0, f32x16& n1, int t) __attribute__((always_inline)) {
        const int sl = t % 3, sl1 = (t + 1) % 3, sl2 = (t + 2) % 3;
        const char* cs = lds + sl * AT_BUF; const char* ns = lds + sl1 * AT_BUF;
        constexpr bool has_next = decltype(HN)::value;
        if (t + 2 < ntiles) issue(t + 2, sl2);
        u32x4 pw[4];
        float ls = 0.f;
        bf16x8 kf;
        if (has_next) kf = kfrag(ns, 0);
        SBAR();
#pragma unroll
        for (int g = 0; g < (NQK > 8 ? NQK : 8); ++g) {
            bf16x8 kcur = kf;
            if (has_next && g + 1 < NQK) kf = kfrag(ns, g + 1);
            SBAR();
            if (g < 8) {
                float e0, e1, e2, e3;
                if (g < 4) { e0 = __builtin_amdgcn_exp2f(c0[4 * g] - mref); e1 = __builtin_amdgcn_exp2f(c0[4 * g + 1] - mref); e2 = __builtin_amdgcn_exp2f(c0[4 * g + 2] - mref); e3 = __builtin_amdgcn_exp2f(c0[4 * g + 3] - mref); }
                else { e0 = __builtin_amdgcn_exp2f(c1[4 * (g - 4)] - mref); e1 = __builtin_amdgcn_exp2f(c1[4 * (g - 4) + 1] - mref); e2 = __builtin_amdgcn_exp2f(c1[4 * (g - 4) + 2] - mref); e3 = __builtin_amdgcn_exp2f(c1[4 * (g - 4) + 3] - mref); }
                ls += (e0 + e1) + (e2 + e3);
                const unsigned w0 = cvtpk(e0, e1), w1 = cvtpk(e2, e3);
                if ((g & 1) == 0) { pw[g >> 1][0] = w0; pw[g >> 1][1] = w1; } else { pw[g >> 1][2] = w0; pw[g >> 1][3] = w1; }
                PINV(ls); PINV(pw[g >> 1]);
            }
            SBAR();
            if (has_next && g < NQK) { if (g & 1) n1 = MFMA32(kcur, qr[g >> 1], g < 2 ? zero16 : n1); else n0 = MFMA32(kcur, qr[g >> 1], g < 2 ? zero16 : n0); }
            SBAR();
        }
        lrun += ls;
        float mx = -INFINITY;
        bf16x8 vf = vfrag(cs, 0);
        SBAR();
#pragma unroll
        for (int g = 0; g < 8; ++g) {
            const bf16x8 vcur = vf;
            if (g + 1 < 8) vf = vfrag(cs, g + 1);
            SBAR();
            if (has_next) {
                if (g < 4) mx = fmaxf(fmaxf(mx, fmaxf(n0[4 * g], n0[4 * g + 1])), fmaxf(n0[4 * g + 2], n0[4 * g + 3]));
                else mx = fmaxf(fmaxf(mx, fmaxf(n1[4 * (g - 4)], n1[4 * (g - 4) + 1])), fmaxf(n1[4 * (g - 4) + 2], n1[4 * (g - 4) + 3]));
                PINV(mx);
            }
            SBAR();
            const bf16x8 pf = __builtin_bit_cast(bf16x8, pw[g >> 1]);
            if (g & 1) o1 = MFMA32(vcur, pf, o1); else o0 = MFMA32(vcur, pf, o0);
            SBAR();
        }
        if (has_next) {
            const float gr_ = xhalf_max(mx) - mref;
            if (__any(gr_ > ATT_THR)) {
                const float d = fmaxf(gr_, 0.f), a = __builtin_amdgcn_exp2f(-d);
                mref += d; lrun *= a;
#pragma unroll
                for (int r = 0; r < 16; ++r) { o0[r] *= a; o1[r] *= a; }
            }
        }
        asm volatile("s_waitcnt vmcnt(0) lgkmcnt(0)" ::: "memory");
        __builtin_amdgcn_s_barrier();
    };
    {   const std::integral_constant<bool, true> yes; const std::integral_constant<bool, false> no;
        int t = 0;
        for (; t + 2 < ntiles; t += 2) { step(yes, sA0, sA1, sB0, sB1, t); step(yes, sB0, sB1, sA0, sA1, t + 1); }
        step(yes, sA0, sA1, sB0, sB1, t); step(no, sB0, sB1, sA0, sA1, t + 1); }
    const float inv = 1.0f / xhalf_sum(lrun);
    bf16_t* op = O + (size_t)(wid * 32 + r32) * 512 + 4 * hi;
#pragma unroll
    for (int rg = 0; rg < 4; ++rg) {
        uint2 a; a.x = pack2(o0[4 * rg] * inv, o0[4 * rg + 1] * inv); a.y = pack2(o0[4 * rg + 2] * inv, o0[4 * rg + 3] * inv);
        uint2 b; b.x = pack2(o1[4 * rg] * inv, o1[4 * rg + 1] * inv); b.y = pack2(o1[4 * rg + 2] * inv, o1[4 * rg + 3] * inv);
        *(uint2*)(op + 8 * rg) = a; *(uint2*)(op + 32 + 8 * rg) = b;
    }
}
constexpr int A3_K = 0, A3_KR = 16384, A3_V = 24576, A3_BYTES = 24576 + 3 * 8192;
template <int DQK>
__device__ __forceinline__ void attn_item3(const bf16_t* Q, int qpitch, const bf16_t* KA, int kapitch, const bf16_t* KB, int kbpitch,
                                           const bf16_t* V, int vpitch, int ntiles, bf16_t* O, char* lds) {
    const int tid = opaque_tid(), lane = tid & 63, wid = tid >> 6, r32 = lane & 31, hi = lane >> 5;
    const bool grpB = __builtin_amdgcn_readfirstlane(wid) >= 4;
    constexpr int ND0 = DQK / 16;
    bf16x8 qr[ND0];
    { const bf16_t* qp = Q + (size_t)(wid * 32 + r32) * qpitch + hi * 8;
#pragma unroll
      for (int d0 = 0; d0 < ND0; ++d0) qr[d0] = *(const bf16x8*)(qp + d0 * 16); }
    const int srow = tid >> 3, sch = tid & 7;
    const bf16_t* gk = KA + (size_t)srow * kapitch + sch * 8;
    const bf16_t* gv = V + (size_t)srow * vpitch + sch * 8;
    const bf16_t* gr = (DQK > 64) ? (KB + (size_t)(tid >> 2) * kbpitch + (tid & 3) * 8) : nullptr;
    const int sk_off = A3_K + srow * 128 + ((sch ^ ((srow >> 1) & 7)) << 4);
    const int sv_off = A3_V + (sch >> 2) * 4096 + srow * 64 + (sch & 3) * 16;
    const int sr_off = A3_KR + (tid >> 2) * 64 + (((tid & 3) ^ (((tid >> 2) >> 2) & 3)) << 4);
    const bool do_r = (DQK > 64) && (tid < 256);
    const int kf_off = A3_K + r32 * 128, ksw = (r32 >> 1) & 7;
    const int rf_off = A3_KR + r32 * 64, rsw = (r32 >> 2) & 3;
    const int vf_off = A3_V + (4 * hi + ((lane & 15) >> 2)) * 64 + ((lane >> 4) & 1) * 32 + (lane & 3) * 8;
    uint4 rk, rv, rr; rr = make_uint4(0, 0, 0, 0);
    rk = *(const uint4*)gk; rv = *(const uint4*)gv; if (do_r) rr = *(const uint4*)gr;
    *(uint4*)(lds + sk_off) = rk; *(uint4*)(lds + sv_off) = rv; if (do_r) *(uint4*)(lds + sr_off) = rr;
    __syncthreads();
    f32x16 o0, o1, p0, p1;
#pragma unroll
    for (int r = 0; r < 16; ++r) { o0[r] = 0.f; o1[r] = 0.f; p0[r] = 0.f; p1[r] = 0.f; }
    float mrun = -INFINITY, lrun = 0.f;
    auto H1 = [&](int t) __attribute__((always_inline)) {
        const char* ks = lds + (t & 1) * 8192; const char* rs = lds + (t & 1) * 4096;
#pragma unroll
        for (int r = 0; r < 16; ++r) { p0[r] = 0.f; p1[r] = 0.f; }
#pragma unroll
        for (int d0 = 0; d0 < 4; ++d0) {
            const int co = ((2 * d0 + hi) ^ ksw) << 4;
            const bf16x8 k0 = *(const bf16x8*)(ks + kf_off + co), k1 = *(const bf16x8*)(ks + kf_off + 32 * 128 + co);
            p0 = MFMA32(k0, qr[d0], p0); p1 = MFMA32(k1, qr[d0], p1);
        }
        if (DQK > 64) {
#pragma unroll
            for (int d0 = 4; d0 < ND0; ++d0) {
                const int co = ((2 * (d0 - 4) + hi) ^ rsw) << 4;
                const bf16x8 k0 = *(const bf16x8*)(rs + rf_off + co), k1 = *(const bf16x8*)(rs + rf_off + 32 * 64 + co);
                p0 = MFMA32(k0, qr[d0], p0); p1 = MFMA32(k1, qr[d0], p1);
            }
        }
        float mx = fmaxf(p0[0], p1[0]);
#pragma unroll
        for (int r = 1; r < 16; ++r) mx = fmaxf(mx, fmaxf(p0[r], p1[r]));
        mx = xhalf_max(mx);
        if (__any(mx > mrun + ATT_THR)) {
            const float mnew = fmaxf(mrun, mx), alpha = __builtin_amdgcn_exp2f(mrun - mnew);
            lrun *= alpha;
#pragma unroll
            for (int r = 0; r < 16; ++r) { o0[r] *= alpha; o1[r] *= alpha; }
            mrun = mnew;
        }
    };
    auto H2 = [&](int t) __attribute__((always_inline)) {
        const char* vs = lds + (t % 3) * 8192;
        float ls = 0.f;
#pragma unroll
        for (int r = 0; r < 16; ++r) { p0[r] = __builtin_amdgcn_exp2f(p0[r] - mrun); p1[r] = __builtin_amdgcn_exp2f(p1[r] - mrun); ls += p0[r] + p1[r]; }
        lrun += ls;
#pragma unroll
        for (int s = 0; s < 4; ++s) {
            bf16x8 pf;
            {   unsigned w0, w1, w2, w3;
                if (s < 2) { w0 = cvtpk(p0[8 * s], p0[8 * s + 1]); w1 = cvtpk(p0[8 * s + 2], p0[8 * s + 3]); w2 = cvtpk(p0[8 * s + 4], p0[8 * s + 5]); w3 = cvtpk(p0[8 * s + 6], p0[8 * s + 7]); }
                else { const int s2 = s - 2; w0 = cvtpk(p1[8 * s2], p1[8 * s2 + 1]); w1 = cvtpk(p1[8 * s2 + 2], p1[8 * s2 + 3]); w2 = cvtpk(p1[8 * s2 + 4], p1[8 * s2 + 5]); w3 = cvtpk(p1[8 * s2 + 6], p1[8 * s2 + 7]); }
                u32x4 u = {w0, w1, w2, w3}; pf = __builtin_bit_cast(bf16x8, u); }
            const lds_cptr vb = (lds_cptr)vs + vf_off + s * 1024;
            const s16x4 a0 = vtr(vb), a1 = vtr(vb + 512), b0 = vtr(vb + 4096), b1 = vtr(vb + 4096 + 512);
            const bf16x8 v0 = (bf16x8){a0[0], a0[1], a0[2], a0[3], a1[0], a1[1], a1[2], a1[3]};
            const bf16x8 v1 = (bf16x8){b0[0], b0[1], b0[2], b0[3], b1[0], b1[1], b1[2], b1[3]};
            o0 = MFMA32(v0, pf, o0); o1 = MFMA32(v1, pf, o1);
        }
    };
#define A3_LOAD(t) do { rk = *(const uint4*)(gk + (size_t)((t) + 1) * 64 * kapitch); rv = *(const uint4*)(gv + (size_t)((t) + 1) * 64 * vpitch); if (do_r) rr = *(const uint4*)(gr + (size_t)((t) + 1) * 64 * kbpitch); } while (0)
#define A3_WRITE(t) do { const int kn = ((t) + 1) & 1, vn = ((t) + 1) % 3; *(uint4*)(lds + kn * 8192 + sk_off) = rk; *(uint4*)(lds + vn * 8192 + sv_off) = rv; if (do_r) *(uint4*)(lds + kn * 4096 + sr_off) = rr; } while (0)
    if (grpB) {
        { const bool more = (1 < ntiles); if (more) A3_LOAD(0); H1(0); if (more) A3_WRITE(0); __syncthreads(); }
        for (int t = 1; t < ntiles; ++t) {
            const bool more = (t + 1 < ntiles);
            if (more) A3_LOAD(t);
            H2(t - 1); H1(t);
            if (more) A3_WRITE(t);
            __syncthreads();
        }
    } else {
        for (int t = 0; t < ntiles; ++t) {
            const bool more = (t + 1 < ntiles);
            if (more) A3_LOAD(t);
            H1(t); H2(t);
            if (more) A3_WRITE(t);
            __syncthreads();
        }
    }
#undef A3_LOAD
#undef A3_WRITE
    if (grpB) H2(ntiles - 1);
    const float inv = 1.0f / xhalf_sum(lrun);
    bf16_t* op = O + (size_t)(wid * 32 + r32) * 512 + 4 * hi;
#pragma unroll
    for (int rg = 0; rg < 4; ++rg) {
        uint2 a; a.x = pack2(o0[4 * rg] * inv, o0[4 * rg + 1] * inv); a.y = pack2(o0[4 * rg + 2] * inv, o0[4 * rg + 3] * inv);
        uint2 b; b.x = pack2(o1[4 * rg] * inv, o1[4 * rg + 1] * inv); b.y = pack2(o1[4 * rg + 2] * inv, o1[4 * rg + 3] * inv);
        *(uint2*)(op + 8 * rg) = a; *(uint2*)(op + 32 + 8 * rg) = b;
    }
    __syncthreads();
}
template <int DQK>
__device__ __forceinline__ void attn_item4(const bf16_t* Q, int qpitch, const bf16_t* KA, int kapitch, const bf16_t* KB, int kbpitch,
                                           const bf16_t* V, int vpitch, int ntiles, float ref_const, float kmax2, bf16_t* O, char* lds) {
    const int tid = opaque_tid(), lane = tid & 63, wid = tid >> 6, r32 = lane & 31, hi = lane >> 5;
    constexpr int ND0 = DQK / 16;
    bf16x8 qr[ND0];
    { const bf16_t* qp = Q + (size_t)(wid * 32 + r32) * qpitch + hi * 8;
#pragma unroll
      for (int d0 = 0; d0 < ND0; ++d0) qr[d0] = *(const bf16x8*)(qp + d0 * 16); }
    float mref = ref_const;
    if (DQK > 64) {
        float qn2 = 0.f;
#pragma unroll
        for (int d0 = 0; d0 < ND0; ++d0)
#pragma unroll
            for (int j = 0; j < 8; ++j) { const float v = bf2f((bf16_t)qr[d0][j]); qn2 = fmaf(v, v, qn2); }
        qn2 = xhalf_sum(qn2);
        mref = sqrtf(qn2 * kmax2) * 1.01f + 0.01f;
    }
    f32x16 negm;
#pragma unroll
    for (int r = 0; r < 16; ++r) negm[r] = -mref;
    const int srow = tid >> 3, sch = tid & 7;
    const bf16_t* gk = KA + (size_t)srow * kapitch + sch * 8;
    const bf16_t* gv = V + (size_t)srow * vpitch + sch * 8;
    const bf16_t* gr = (DQK > 64) ? (KB + (size_t)(tid >> 2) * kbpitch + (tid & 3) * 8) : nullptr;
    const int sk_off = AT_K + srow * 128 + ((sch ^ ((srow >> 1) & 7)) << 4);
    const int sv_off = AT_V + (sch >> 2) * 4096 + srow * 64 + (sch & 3) * 16;
    const int sr_off = AT_KR + (tid >> 2) * 64 + (((tid & 3) ^ (((tid >> 2) >> 2) & 3)) << 4);
    const bool do_r = (DQK > 64) && (tid < 256);
    const int kf_off = AT_K + r32 * 128, ksw = (r32 >> 1) & 7;
    const int rf_off = AT_KR + r32 * 64, rsw = (r32 >> 2) & 3;
    const int vf_off = AT_V + (4 * hi + ((lane & 15) >> 2)) * 64 + ((lane >> 4) & 1) * 32 + (lane & 3) * 8;
    uint4 rk, rv, rr; rr = make_uint4(0, 0, 0, 0);
    rk = *(const uint4*)gk; rv = *(const uint4*)gv; if (do_r) rr = *(const uint4*)gr;
    *(uint4*)(lds + sk_off) = rk; *(uint4*)(lds + sv_off) = rv; if (do_r) *(uint4*)(lds + sr_off) = rr;
    __syncthreads();
    f32x16 o0, o1;
#pragma unroll
    for (int r = 0; r < 16; ++r) { o0[r] = 0.f; o1[r] = 0.f; }
    float lrun = 0.f;
#pragma unroll 1
    for (int t = 0; t < ntiles; ++t) {
        const char* cur = lds + (t & 1) * AT_BUF; char* nxt = lds + ((t + 1) & 1) * AT_BUF;
        const bool more = (t + 1 < ntiles);
        if (more) { rk = *(const uint4*)(gk + (size_t)(t + 1) * 64 * kapitch); rv = *(const uint4*)(gv + (size_t)(t + 1) * 64 * vpitch); if (do_r) rr = *(const uint4*)(gr + (size_t)(t + 1) * 64 * kbpitch); }
        bf16x8 kf[8];
#pragma unroll
        for (int d0 = 0; d0 < 4; ++d0) { const int co = ((2 * d0 + hi) ^ ksw) << 4; kf[2 * d0] = *(const bf16x8*)(cur + kf_off + co); kf[2 * d0 + 1] = *(const bf16x8*)(cur + kf_off + 32 * 128 + co); }
        f32x16 p0, p1;
        p0 = MFMA32(kf[0], qr[0], negm); p1 = MFMA32(kf[1], qr[0], negm);
        p0 = MFMA32(kf[2], qr[1], p0); p1 = MFMA32(kf[3], qr[1], p1);
        if (DQK > 64) {
            __builtin_amdgcn_sched_barrier(0);
#pragma unroll
            for (int d0 = 4; d0 < ND0; ++d0) { const int co = ((2 * (d0 - 4) + hi) ^ rsw) << 4; kf[2 * (d0 - 4)] = *(const bf16x8*)(cur + rf_off + co); kf[2 * (d0 - 4) + 1] = *(const bf16x8*)(cur + rf_off + 32 * 64 + co); }
        }
        p0 = MFMA32(kf[4], qr[2], p0); p1 = MFMA32(kf[5], qr[2], p1);
        p0 = MFMA32(kf[6], qr[3], p0); p1 = MFMA32(kf[7], qr[3], p1);
        if (DQK > 64) {
#pragma unroll
            for (int d0 = 4; d0 < ND0; ++d0) { p0 = MFMA32(kf[2 * (d0 - 4)], qr[d0], p0); p1 = MFMA32(kf[2 * (d0 - 4) + 1], qr[d0], p1); }
        }
        bf16x8 vf[8];
        auto vload = [&](int s) __attribute__((always_inline)) {
            const lds_cptr vb = (lds_cptr)cur + vf_off + s * 1024;
            const s16x4 a0 = vtr(vb), a1 = vtr(vb + 512), b0 = vtr(vb + 4096), b1 = vtr(vb + 4096 + 512);
            vf[2 * s] = (bf16x8){a0[0], a0[1], a0[2], a0[3], a1[0], a1[1], a1[2], a1[3]};
            vf[2 * s + 1] = (bf16x8){b0[0], b0[1], b0[2], b0[3], b1[0], b1[1], b1[2], b1[3]};
        };
        vload(0); vload(1);
        float ls = 0.f;
#pragma unroll
        for (int s = 0; s < 4; ++s) {
            float e[8];
#pragma unroll
            for (int j = 0; j < 8; ++j) e[j] = __builtin_amdgcn_exp2f(s < 2 ? p0[8 * s + j] : p1[8 * (s - 2) + j]);
            ls += ((e[0] + e[1]) + (e[2] + e[3])) + ((e[4] + e[5]) + (e[6] + e[7]));
            u32x4 u = {cvtpk(e[0], e[1]), cvtpk(e[2], e[3]), cvtpk(e[4], e[5]), cvtpk(e[6], e[7])};
            const bf16x8 pf = __builtin_bit_cast(bf16x8, u);
            if (s + 2 < 4) vload(s + 2);
            o0 = MFMA32(vf[2 * s], pf, o0); o1 = MFMA32(vf[2 * s + 1], pf, o1);
        }
        lrun += ls;
        if (more) { *(uint4*)(nxt + sk_off) = rk; *(uint4*)(nxt + sv_off) = rv; if (do_r) *(uint4*)(nxt + sr_off) = rr; }
        __syncthreads();
    }
    const float inv = 1.0f / xhalf_sum(lrun);
    bf16_t* op = O + (size_t)(wid * 32 + r32) * 512 + 4 * hi;
#pragma unroll
    for (int rg = 0; rg < 4; ++rg) {
        uint2 a; a.x = pack2(o0[4 * rg] * inv, o0[4 * rg + 1] * inv); a.y = pack2(o0[4 * rg + 2] * inv, o0[4 * rg + 3] * inv);
        uint2 b; b.x = pack2(o1[4 * rg] * inv, o1[4 * rg + 1] * inv); b.y = pack2(o1[4 * rg + 2] * inv, o1[4 * rg + 3] * inv);
        *(uint2*)(op + 8 * rg) = a; *(uint2*)(op + 32 + 8 * rg) = b;
    }
}
constexpr int A7_K = 0, A7_V = 8192, A7_KR = 16384, A7_BUF = 20480;
template <int DQK>
__device__ __forceinline__ void attn_item7(const bf16_t* Q, int qpitch, const bf16_t* KA, int kapitch, const bf16_t* KB, int kbpitch,
                                           const bf16_t* V, int vpitch, int ntiles, float ref_const, float kmax2, bf16_t* O, char* lds) {
    const int tid = opaque_tid(), lane = tid & 63, wid = tid >> 6, fr = lane & 15, g = lane >> 4;
    constexpr int NKS = DQK / 32;
    bf16x8 qr[2][NKS];
#pragma unroll
    for (int qi = 0; qi < 2; ++qi) { const bf16_t* qp = Q + (size_t)(wid * 32 + 16 * qi + fr) * qpitch + 8 * g;
#pragma unroll
        for (int ks = 0; ks < NKS; ++ks) qr[qi][ks] = *(const bf16x8*)(qp + 32 * ks); }
    f32x4 negm[2];
#pragma unroll
    for (int qi = 0; qi < 2; ++qi) {
        float mref = ref_const;
        if (DQK > 64) {
            float qn2 = 0.f;
#pragma unroll
            for (int ks = 0; ks < NKS; ++ks)
#pragma unroll
                for (int j = 0; j < 8; ++j) { const float v = bf2f((bf16_t)qr[qi][ks][j]); qn2 = fmaf(v, v, qn2); }
            qn2 += __shfl_xor(qn2, 16); qn2 += __shfl_xor(qn2, 32);
            mref = sqrtf(qn2 * kmax2) * 1.01f + 0.01f;
        }
        negm[qi][0] = -mref; negm[qi][1] = -mref; negm[qi][2] = -mref; negm[qi][3] = -mref;
    }
    const int srow = tid >> 3, sch = tid & 7;
    const bf16_t* gk = KA + (size_t)srow * kapitch + sch * 8;
    const bf16_t* gv = V + (size_t)srow * vpitch + sch * 8;
    const bf16_t* gr = (DQK > 64) ? (KB + (size_t)(tid >> 2) * kbpitch + (tid & 3) * 8) : nullptr;
    const int sk_off = A7_K + srow * 128 + ((sch ^ ((srow >> 1) & 7)) << 4);
    const int sv_off = A7_V + (sch >> 1) * 2048 + srow * 32 + (sch & 1) * 16;
    const int sr_off = A7_KR + (tid >> 2) * 64 + ((((tid & 3) + 2 * ((tid >> 2) >> 2)) & 3) << 4);
    const bool do_r = (DQK > 64) && (tid < 256);
    const int kf_off = A7_K + fr * 128, ksw = (fr >> 1) & 7;
    const int rf_off = A7_KR + fr * 64 + (((g + 2 * (fr >> 2)) & 3) << 4);
    const int vf_off = A7_V + (4 * g + (fr >> 2)) * 32 + (fr & 3) * 8;
    uint4 rk, rv, rr; rr = make_uint4(0, 0, 0, 0);
    rk = *(const uint4*)gk; rv = *(const uint4*)gv; if (do_r) rr = *(const uint4*)gr;
    *(uint4*)(lds + sk_off) = rk; *(uint4*)(lds + sv_off) = rv; if (do_r) *(uint4*)(lds + sr_off) = rr;
    __syncthreads();
    f32x4 o[4][2]; float lsum[2] = {0.f, 0.f};
#pragma unroll
    for (int di = 0; di < 4; ++di)
#pragma unroll
        for (int qi = 0; qi < 2; ++qi) { o[di][qi][0] = 0.f; o[di][qi][1] = 0.f; o[di][qi][2] = 0.f; o[di][qi][3] = 0.f; }
#pragma unroll 1
    for (int t = 0; t < ntiles; ++t) {
        const char* cur = lds + (t & 1) * A7_BUF; char* nxt = lds + ((t + 1) & 1) * A7_BUF;
        const bool more = (t + 1 < ntiles);
        if (more) { rk = *(const uint4*)(gk + (size_t)(t + 1) * 64 * kapitch); rv = *(const uint4*)(gv + (size_t)(t + 1) * 64 * vpitch); if (do_r) rr = *(const uint4*)(gr + (size_t)(t + 1) * 64 * kbpitch); }
        f32x4 s[4][2];
#pragma unroll
        for (int ks = 0; ks < NKS; ++ks) {
            bf16x8 kf[4];
#pragma unroll
            for (int kj = 0; kj < 4; ++kj)
                kf[kj] = (ks < 2) ? *(const bf16x8*)(cur + kf_off + kj * 2048 + (((4 * ks + g) ^ ksw) << 4)) : *(const bf16x8*)(cur + rf_off + kj * 1024);
#pragma unroll
            for (int kj = 0; kj < 4; ++kj)
#pragma unroll
                for (int qi = 0; qi < 2; ++qi) s[kj][qi] = MFMA16(kf[kj], qr[qi][ks], ks == 0 ? negm[qi] : s[kj][qi]);
        }
#pragma unroll
        for (int kk = 0; kk < 2; ++kk) {
            bf16x8 vf[4];
#pragma unroll
            for (int di = 0; di < 4; ++di) {
                const lds_cptr vb = (lds_cptr)cur + vf_off + di * 2048 + kk * 1024;
                const s16x4 a0 = vtr(vb), a1 = vtr(vb + 512);
                vf[di] = (bf16x8){a0[0], a0[1], a0[2], a0[3], a1[0], a1[1], a1[2], a1[3]};
            }
            bf16x8 pf[2];
#pragma unroll
            for (int qi = 0; qi < 2; ++qi) {
                float e[8];
#pragma unroll
                for (int j = 0; j < 4; ++j) { e[j] = __builtin_amdgcn_exp2f(s[2 * kk][qi][j]); e[4 + j] = __builtin_amdgcn_exp2f(s[2 * kk + 1][qi][j]); }
                lsum[qi] += ((e[0] + e[1]) + (e[2] + e[3])) + ((e[4] + e[5]) + (e[6] + e[7]));
                u32x4 u = {cvtpk(e[0], e[1]), cvtpk(e[2], e[3]), cvtpk(e[4], e[5]), cvtpk(e[6], e[7])};
                pf[qi] = __builtin_bit_cast(bf16x8, u);
            }
#pragma unroll
            for (int di = 0; di < 4; ++di) { o[di][0] = MFMA16(vf[di], pf[0], o[di][0]); o[di][1] = MFMA16(vf[di], pf[1], o[di][1]); }
        }
        if (more) { *(uint4*)(nxt + sk_off) = rk; *(uint4*)(nxt + sv_off) = rv; if (do_r) *(uint4*)(nxt + sr_off) = rr; }
        __syncthreads();
    }
#pragma unroll
    for (int qi = 0; qi < 2; ++qi) {
        float l = lsum[qi]; l += __shfl_xor(l, 16); l += __shfl_xor(l, 32);
        const float inv = 1.0f / l;
        bf16_t* op = O + (size_t)(wid * 32 + 16 * qi + fr) * 512 + 4 * g;
#pragma unroll
        for (int di = 0; di < 4; ++di) *(uint2*)(op + 16 * di) = pack4(o[di][qi] * inv);
    }
}
__device__ __forceinline__ void attn_dispatch(const KP& p, int ty, int h, int qt, float gqa_ref, char* lds) {
    const bf16_t* P = WSP(bf16_t, OFF_P); const bf16_t* Qm = WSP(bf16_t, OFF_H); const bf16_t* Kn = WSP(bf16_t, OFF_KN); const bf16_t* Vm = WSP(bf16_t, OFF_V);
    const int ntiles = (qt == 0) ? (LC / 64) : (T / 64);
    const size_t r0 = (size_t)qt * 256;
    bf16_t* Om = WSP(bf16_t, OFF_OM); bf16_t* Og = WSP(bf16_t, OFF_OG);
    if (ty == 0) {
        const float kmax2 = __uint_as_float(WSP(unsigned, OFF_CNT)[32 + h]);
        attn_item7<96>(Qm + r0 * 768 + h * 96, 768, Kn + h * 64, 512, P + C_KR, PP, Vm + h * 64, 512, ntiles, 0.f, kmax2, Om + r0 * 512 + h * 64, lds);
    } else
        attn_item7<64>(P + r0 * PP + C_GQ + h * 64, PP, P + C_GK + (h >> 2) * 64, PP, nullptr, 0, P + C_GV + (h >> 2) * 64, PP, ntiles, gqa_ref, 0.f, Og + r0 * 512 + h * 64, lds);
}
__device__ __forceinline__ void st_attn(const KP& p, int l, int bid, int nb, char* lds) {
    const int tidx = opaque_tid();
    float gq = fabsf(p.in(I_GQN)[l * 64 + (tidx & 63)]), gk = fabsf(p.in(I_GKN)[l * 64 + (tidx & 63)]);
#pragma unroll
    for (int o = 32; o > 0; o >>= 1) { gq = fmaxf(gq, __shfl_xor(gq, o)); gk = fmaxf(gk, __shfl_xor(gk, o)); }
    const float gqa_ref = 64.0f * SC_GQA * gq * gk * 1.02f + 0.01f;
    for (int ty = 0; ty < 2; ++ty)
        for (int u = bid; u < 512; u += nb) attn_dispatch(p, ty, u & 7, 1 + (u >> 3), gqa_ref, lds);
    for (int u = bid; u < 16; u += nb) attn_dispatch(p, u >> 3, u & 7, 0, gqa_ref, lds);
}

__device__ __forceinline__ void st_merge(const KP& p, int l, int bid, int nb, char* lds) {
    const int tidx = opaque_tid();
    const bf16_t* P = WSP(bf16_t, OFF_P); bf16_t* Mb = WSP(bf16_t, OFF_H);
    const bf16_t* Wb = WSP(bf16_t, OFF_WB + WB_BR);
    int mt, nt;
    for (int it = 0; dense_tile(it, 8, l + 1 < NL, bid, nb, mt, nt); ++it) {
        acc_t tot; acc_zero(tot);
#pragma unroll 1
        for (int b = 0; b < 3; ++b) {
            const bf16_t* Ob = b == 1 ? P + C_SSM : WSP(bf16_t, b == 0 ? OFF_OM : OFF_OG); const int opitch = b == 1 ? PP : 512;
            acc_t acc; acc_zero(acc);
            gemm_core(acc, [&](int r) { return Ob + (size_t)(mt * 256 + r) * opitch; }, [&](int r) { return Wb + ((size_t)b * 1024 + nt * 128 + r) * 512; }, 512, lds);
            acc_visit_add(acc, tot, [&](int ml, int nl, f32x4 v) {
                const int wm_ = ml >> 6, im_ = (ml >> 4) & 3, fr_ = ml & 15, G_ = b * 64 + nt * 8 + (nl >> 4), g_ = (nl >> 2) & 3;
                const uint2 gr = *(const uint2*)(WSP(bf16_t, OFF_GS) + (((((size_t)(mt * 192 + G_) * 4 + wm_) * 4 + im_) * 64) + g_ * 16 + fr_) * 4);
                f32x4 r; r[0] = bflo(gr.x) * v[0]; r[1] = bfhi(gr.x) * v[1]; r[2] = bflo(gr.y) * v[2]; r[3] = bfhi(gr.y) * v[3];
                return r; });
        }
        acc_visit(tot, [&](int ml, int nl, f32x4 v) { *(uint2*)(Mb + (size_t)(mt * 256 + ml) * 1024 + nt * 128 + nl) = pack4(v); });
    }
}
__device__ __forceinline__ void st_wout(const KP& p, int l, int bid, int nb, char* lds) {
    const int tidx = opaque_tid();
    const bf16_t* Mb = WSP(bf16_t, OFF_H); const bf16_t* Wt = WSP(bf16_t, OFF_WB + WB_OUT); float* Y = WSP(float, OFF_Y);
    int mt, nt;
    for (int it = 0; dense_tile(it, 4, l + 1 < NL, bid, nb, mt, nt); ++it) {
        acc_t acc[2]; acc_zero(acc[0]); acc_zero(acc[1]);
        gemm_core256_dense(acc, Mb + (size_t)mt * 256 * 1024, 1024, Wt + (size_t)nt * 256 * 1024, 1024, 1024, lds);
#pragma unroll
        for (int nh = 0; nh < 2; ++nh)
            acc_visit2(acc[nh], [&](int ml, int nl, f32x4 v) { *(f32x4*)(Y + (size_t)(mt * 256 + ml) * 1024 + nt * 256 + nh * 128 + nl) = v; });
    }
    int* sltok = WSP(int, OFF_SLTOK); float* slw = WSP(float, OFF_SLW); int* cnt = WSP(int, OFF_CNT);
#pragma unroll 1
    for (int i = bid * NTH + tidx; i < TP; i += nb * NTH) { sltok[i] = 0; slw[i] = 0.f; asm volatile("" : "+v"(i)); }
    if (bid == 0 && tidx < 32) cnt[tidx] = 0;
}

__device__ __forceinline__ void st_postmix(const KP& p, int l, int bid, int nb, char* lds) {
    const int tidx = opaque_tid();
    const int lane = tidx & 63, wid = tidx >> 6;
    const float* Y = WSP(float, OFF_Y); bf16_t* H2 = WSP(bf16_t, OFF_H);
    const float* gpost = p.in(I_GPOSTMIX) + l * D; const float* gpre = p.in(I_GPREFFN) + l * D;
    int* toke = WSP(int, OFF_TOKE); float* tokw = WSP(float, OFF_TOKW); int* cnt = WSP(int, OFF_CNT);
    float* wl = (float*)lds; int* hist = (int*)(lds + 20 * 1024 * 4);
    {   const float* wg = p.in(I_WGROUP) + (size_t)l * D * 4; const float* wr = p.in(I_WROUTER) + (size_t)l * D * 16;
        for (int k = tidx; k < 1024; k += NTH) {
            const float4 g4 = *(const float4*)(wg + (size_t)k * 4);
            wl[0 * 1024 + k] = g4.x; wl[1 * 1024 + k] = g4.y; wl[2 * 1024 + k] = g4.z; wl[3 * 1024 + k] = g4.w;
#pragma unroll
            for (int e4 = 0; e4 < 4; ++e4) { const float4 r4 = *(const float4*)(wr + (size_t)k * 16 + e4 * 4);
                wl[(4 + e4 * 4 + 0) * 1024 + k] = r4.x; wl[(4 + e4 * 4 + 1) * 1024 + k] = r4.y; wl[(4 + e4 * 4 + 2) * 1024 + k] = r4.z; wl[(4 + e4 * 4 + 3) * 1024 + k] = r4.w; }
        }
        if (tidx < 16) hist[tidx] = 0;
        __syncthreads(); }
    auto ld = [&](int r, float4 (&y)[4], float4 (&x)[4]) __attribute__((always_inline)) {
        const float* xs = l == 0 ? xrow_in(p, r) : xrow_c(p, r);
#pragma unroll
        for (int i = 0; i < 4; ++i) { y[i] = *(const float4*)(Y + (size_t)r * D + i * 256 + lane * 4); x[i] = *(const float4*)(xs + i * 256 + lane * 4); }
    };
    auto proc = [&](int r, float4 (&y)[4], float4 (&x)[4]) __attribute__((always_inline)) {
        float* xr = xrow(p, r);
        const float* md = WSP(float, OFF_MOD) + (size_t)(l * 2 + (r < LC ? 1 : 0)) * 6144;
        float ss = 0.f;
#pragma unroll
        for (int i = 0; i < 4; ++i) ss += y[i].x * y[i].x + y[i].y * y[i].y + y[i].z * y[i].z + y[i].w * y[i].w;

        ss = wave_sum(ss);
        const float rstd = rsqrtf(ss * (1.0f / D) + EPS);
        float ss2 = 0.f;
#pragma unroll
        for (int i = 0; i < 4; ++i) { const int c = i * 256 + lane * 4;
            const float4 gg = *(const float4*)(gpost + c), ga = *(const float4*)(md + 2048 + c);
            x[i].x += ga.x * y[i].x * rstd * gg.x; x[i].y += ga.y * y[i].y * rstd * gg.y; x[i].z += ga.z * y[i].z * rstd * gg.z; x[i].w += ga.w * y[i].w * rstd * gg.w;
            *(float4*)(xr + c) = x[i];
            ss2 += x[i].x * x[i].x + x[i].y * x[i].y + x[i].z * x[i].z + x[i].w * x[i].w; }
        ss2 = wave_sum(ss2);
        const float rstd2 = rsqrtf(ss2 * (1.0f / D) + EPS);
        float lg[4] = {0.f, 0.f, 0.f, 0.f}, le[16];
#pragma unroll
        for (int e = 0; e < 16; ++e) le[e] = 0.f;
#pragma unroll
        for (int i = 0; i < 4; ++i) { const int c = i * 256 + lane * 4;
            const float4 gg = *(const float4*)(gpre + c), sh = *(const float4*)(md + 3072 + c), sc = *(const float4*)(md + 4096 + c);
            float h[4];
            h[0] = x[i].x * rstd2 * gg.x * (1.f + sc.x) + sh.x; h[1] = x[i].y * rstd2 * gg.y * (1.f + sc.y) + sh.y;
            h[2] = x[i].z * rstd2 * gg.z * (1.f + sc.z) + sh.z; h[3] = x[i].w * rstd2 * gg.w * (1.f + sc.w) + sh.w;
            uint2 o; o.x = pack2(h[0], h[1]); o.y = pack2(h[2], h[3]);
            *(uint2*)(H2 + (size_t)r * D + c) = o;
#pragma unroll
            for (int e = 0; e < 4; ++e) { const float4 w4 = *(const float4*)(wl + e * 1024 + c);
                lg[e] = fmaf(h[0], w4.x, lg[e]); lg[e] = fmaf(h[1], w4.y, lg[e]); lg[e] = fmaf(h[2], w4.z, lg[e]); lg[e] = fmaf(h[3], w4.w, lg[e]); }
#pragma unroll
            for (int e = 0; e < 16; ++e) { const float4 w4 = *(const float4*)(wl + (4 + e) * 1024 + c);
                le[e] = fmaf(h[0], w4.x, le[e]); le[e] = fmaf(h[1], w4.y, le[e]); le[e] = fmaf(h[2], w4.z, le[e]); le[e] = fmaf(h[3], w4.w, le[e]); }
        }
#pragma unroll
        for (int g = 0; g < 4; ++g) lg[g] = wave_sum(lg[g]) + p.in(I_BGROUP)[l * 4 + g];
        const float myle = transpose_reduce16(le, lane) + p.in(I_BROUTER)[l * 16 + (lane & 15)];
        int gs = 0; float gm = lg[0];
#pragma unroll
        for (int g = 1; g < 4; ++g) if (lg[g] > gm) { gm = lg[g]; gs = g; }
        float ls[4];
#pragma unroll
        for (int i = 0; i < 4; ++i) ls[i] = __shfl(myle, gs * 4 + i);
        if (lane == 0) {
            float den = 0.f;
#pragma unroll
            for (int g = 0; g < 4; ++g) den += __expf(lg[g] - gm);
            const float pg = 1.0f / den;
            int i0 = 0; float m0 = ls[0];
#pragma unroll
            for (int i = 1; i < 4; ++i) if (ls[i] > m0) { m0 = ls[i]; i0 = i; }
            int i1 = -1; float m1 = -INFINITY;
#pragma unroll
            for (int i = 0; i < 4; ++i) if (i != i0 && ls[i] > m1) { m1 = ls[i]; i1 = i; }
            const float e1 = __expf(m1 - m0), w0 = pg / (1.f + e1), w1 = pg * e1 / (1.f + e1);
            const int ex0 = gs * 4 + i0, ex1 = gs * 4 + i1;
            toke[r * 2] = ex0; toke[r * 2 + 1] = ex1; tokw[r * 2] = w0; tokw[r * 2 + 1] = w1;
            atomicAdd(&hist[ex0], 1); atomicAdd(&hist[ex1], 1);
        }
        };
    {   const int r0 = (l + 1 < NL ? 0 : LC) + bid * NWV + wid, rs = nb * NWV;
        float4 ya[4], xa[4], yb[4], xb[4];
        if (r0 < T) ld(r0, ya, xa);
        for (int r = r0; r < T; r += 2 * rs) {
            if (r + rs < T) ld(r + rs, yb, xb);
            proc(r, ya, xa);
            if (r + rs < T) { if (r + 2 * rs < T) ld(r + 2 * rs, ya, xa); proc(r + rs, yb, xb); }
        } }
    __syncthreads();
    if (tidx < 16 && hist[tidx] != 0) atomicAdd(&cnt[tidx], hist[tidx]);
}

__device__ __forceinline__ void moe_offsets(const int* cnt, int* off) {
    int a = 0;
#pragma unroll
    for (int e = 0; e < 16; ++e) { off[e] = a; a += (cnt[e] + 255) & ~255; }
    off[16] = a;
}
__device__ __forceinline__ int moe_expert_of(const int* off, int j) {
    int e = 0;
#pragma unroll
    for (int k = 1; k < 16; ++k) e += (j >= off[k]) ? 1 : 0;
    return e;
}
__device__ __forceinline__ void st_moe_build(const KP& p, int l, int bid, int nb, char* lds) {
    const int tidx = opaque_tid();
    int* cnt = WSP(int, OFF_CNT); int* cnt2 = cnt + 16;
    const int* toke = WSP(int, OFF_TOKE); const float* tokw = WSP(float, OFF_TOKW); int* toks = WSP(int, OFF_TOKS);
    int* sltok = WSP(int, OFF_SLTOK); float* slw = WSP(float, OFF_SLW);
    int* lcnt = (int*)lds; int* lbase = lcnt + 16;
    int off[17]; moe_offsets(cnt, off);
    const int first = (l + 1 < NL ? 0 : 2 * LC), total = 2 * T - first, per = (total + nb - 1) / nb;
    const int beg = first + bid * per, end = min(beg + per, 2 * T);
    __syncthreads();
    if (tidx < 16) lcnt[tidx] = 0;
    __syncthreads();
    const int idx = beg + tidx; const bool act = (tidx < per) && (idx < end);
    int e = 0, rank = 0;
    if (act) { e = toke[idx]; rank = atomicAdd(&lcnt[e], 1); }
    __syncthreads();
    if (tidx < 16) lbase[tidx] = lcnt[tidx] ? atomicAdd(&cnt2[tidx], lcnt[tidx]) : 0;
    __syncthreads();
    if (act) {
        int o = 0;
#pragma unroll
        for (int k = 0; k < 16; ++k) o = (e == k) ? off[k] : o;
        const int pos = o + lbase[e] + rank;
        sltok[pos] = idx >> 1; slw[pos] = tokw[idx]; toks[idx] = pos;
    }
}
__device__ __forceinline__ bool moe_tile(int r, int M2, int bid, int nb, int& mt, int& pn) {
    const int x = bid & 7, j = bid >> 3, q = nb >> 5;
    mt = (r * 8 + x) * q + (j % q); pn = j / q;
    return mt < M2 && pn < 4;
}
__device__ __forceinline__ void st_moe_up(const KP& p, int bid, int nb, char* lds) {
    const int tidx = opaque_tid();
    const int* cnt = WSP(int, OFF_CNT); const int* sltok = WSP(int, OFF_SLTOK);
    const bf16_t* H2 = WSP(bf16_t, OFF_H); const bf16_t* Wg = WSP(bf16_t, OFF_WB + WB_EG); bf16_t* Hid = WSP(bf16_t, OFF_HID);
    int off[17]; moe_offsets(cnt, off);
    const int M2 = off[16] >> 8;
    const int srow = tidx >> 3, gch = (tidx & 7) ^ ((srow >> 1) & 7);
    auto upin = [](const char* q) { asm volatile("" : "+s"(q)); return q; };
    const unsigned vw = (unsigned)(((srow >> 4) & 1) ? (unsigned)(WB_EU - WB_EG) : 0u) + (unsigned)(((((srow >> 5) & 1) * 16 + (srow & 15)) * 1024 + gch * 8) * 2);
    int mt, pn;
    for (int r = 0; r * 8 * (nb >> 5) < M2; ++r) {
        if (!moe_tile(r, M2, bid, nb, mt, pn)) continue;
        const int e = __builtin_amdgcn_readfirstlane(moe_expert_of(off, mt * 256));
        unsigned xo[2][2];
#pragma unroll
        for (int h = 0; h < 2; ++h)
#pragma unroll
            for (int i = 0; i < 2; ++i) xo[h][i] = (unsigned)sltok[mt * 256 + h * 128 + srow + 64 * i] * 2048u + (unsigned)gch * 16u;
        acc_t acc[2]; acc_zero(acc[0]); acc_zero(acc[1]);
        gemm_core256(acc, [&](int h, int i, int kt) { return (const bf16_t*)(upin((const char*)H2 + kt * 128) + xo[h][i]); },
                     [&](int h, int i, int kt) { return (const bf16_t*)(upin((const char*)Wg + ((size_t)(e * 512 + (2 * pn + h) * 64 + i * 32) * 1024 + kt * 64) * 2) + vw); }, 16, lds);
        const int lane = tidx & 63, wid = tidx >> 6, wr = wid >> 2, wc = wid & 3, fr = lane & 15, g = lane >> 4;
#pragma unroll
        for (int nh = 0; nh < 2; ++nh)
#pragma unroll
            for (int im = 0; im < 4; ++im)
#pragma unroll
                for (int q = 0; q < 2; ++q) {
                    const f32x4 gt = acc[nh][2 * q][im], up = acc[nh][2 * q + 1][im];
                    uint2 o; o.x = pack2(siluf_(gt[0]) * up[0], siluf_(gt[1]) * up[1]); o.y = pack2(siluf_(gt[2]) * up[2], siluf_(gt[3]) * up[3]);
                    *(uint2*)(Hid + (size_t)(mt * 256 + (im >> 1) * 128 + wc * 32 + (im & 1) * 16 + fr) * 512 + (2 * pn + nh) * 64 + wr * 32 + 16 * q + 4 * g) = o;
                }
    }
}
__device__ __forceinline__ void st_moe_down(const KP& p, int bid, int nb, char* lds) {
    const int tidx = opaque_tid();
    const int* cnt = WSP(int, OFF_CNT); const float* slw = WSP(float, OFF_SLW);
    const bf16_t* Hid = WSP(bf16_t, OFF_HID); const bf16_t* Wd = WSP(bf16_t, OFF_WB + WB_ED); bf16_t* Sl = WSP(bf16_t, OFF_SLOTS);
    int off[17]; moe_offsets(cnt, off);
    const int M2 = off[16] >> 8;
    int mt, pn;
    for (int r = 0; r * 8 * (nb >> 5) < M2; ++r) {
        if (!moe_tile(r, M2, bid, nb, mt, pn)) continue;
        const int e = __builtin_amdgcn_readfirstlane(moe_expert_of(off, mt * 256));
        acc_t acc[2]; acc_zero(acc[0]); acc_zero(acc[1]);
        gemm_core256_dense(acc, Hid + (size_t)mt * 256 * 512, 512, Wd + ((size_t)e * 1024 + pn * 256) * 512, 512, 512, lds);
#pragma unroll
        for (int nh = 0; nh < 2; ++nh)
            acc_visit2(acc[nh], [&](int ml, int nl, f32x4 v) {
                const float w = slw[mt * 256 + ml];
                *(uint2*)(Sl + (size_t)(mt * 256 + ml) * 1024 + pn * 256 + nh * 128 + nl) = pack4(v * w); });
    }
}
__device__ __forceinline__ void st_postffn(const KP& p, int l, int bid, int nb) {
    const int tidx = opaque_tid();
    const int lane = tidx & 63, wid = tidx >> 6;
    const bf16_t* Sl = WSP(bf16_t, OFF_SLOTS); const int* toks = WSP(int, OFF_TOKS);
    const float* gpost = p.in(I_GPOSTFFN) + l * D;
    const bool next = (l + 1 < NL);
    bf16_t* Hb = WSP(bf16_t, OFF_H); const float* gpre = p.in(I_GPREMIX) + (next ? l + 1 : l) * D;
    auto ld = [&](int r, uint2 (&a)[4], uint2 (&b)[4], float4 (&x)[4]) __attribute__((always_inline)) {
        const bf16_t* s0 = Sl + (size_t)toks[r * 2] * 1024; const bf16_t* s1 = Sl + (size_t)toks[r * 2 + 1] * 1024; const float* xs = xrow_c(p, r);
#pragma unroll
        for (int i = 0; i < 4; ++i) { const int c = i * 256 + lane * 4; a[i] = *(const uint2*)(s0 + c); b[i] = *(const uint2*)(s1 + c); x[i] = *(const float4*)(xs + c); }
    };
    auto proc = [&](int r, uint2 (&a)[4], uint2 (&b)[4], float4 (&xq)[4]) __attribute__((always_inline)) {
        float* xr = xrow(p, r);
        const float* md = WSP(float, OFF_MOD) + (size_t)(l * 2 + (r < LC ? 1 : 0)) * 6144;
        float v[16]; float ss = 0.f;
#pragma unroll
        for (int i = 0; i < 4; ++i) {
            v[4 * i] = bflo(a[i].x) + bflo(b[i].x); v[4 * i + 1] = bfhi(a[i].x) + bfhi(b[i].x); v[4 * i + 2] = bflo(a[i].y) + bflo(b[i].y); v[4 * i + 3] = bfhi(a[i].y) + bfhi(b[i].y);
            ss += v[4 * i] * v[4 * i] + v[4 * i + 1] * v[4 * i + 1] + v[4 * i + 2] * v[4 * i + 2] + v[4 * i + 3] * v[4 * i + 3]; }
        ss = wave_sum(ss);
        const float rstd = rsqrtf(ss * (1.0f / D) + EPS);
        float4 xs[4]; float ss2 = 0.f;
#pragma unroll
        for (int i = 0; i < 4; ++i) { const int c = i * 256 + lane * 4;
            const float4 gg = *(const float4*)(gpost + c), ga = *(const float4*)(md + 5120 + c); float4 x = xq[i];
            x.x += ga.x * v[4 * i] * rstd * gg.x; x.y += ga.y * v[4 * i + 1] * rstd * gg.y; x.z += ga.z * v[4 * i + 2] * rstd * gg.z; x.w += ga.w * v[4 * i + 3] * rstd * gg.w;
            *(float4*)(xr + c) = x; xs[i] = x; ss2 += x.x * x.x + x.y * x.y + x.z * x.z + x.w * x.w; }
        if (next) {
            ss2 = wave_sum(ss2);
            const float rstd2 = rsqrtf(ss2 * (1.0f / D) + EPS);
            const float* md2 = WSP(float, OFF_MOD) + (size_t)((l + 1) * 2 + (r < LC ? 1 : 0)) * 6144;
#pragma unroll
            for (int i = 0; i < 4; ++i) { const int c = i * 256 + lane * 4;
                const float4 gg = *(const float4*)(gpre + c), sh = *(const float4*)(md2 + c), sc = *(const float4*)(md2 + 1024 + c);
                uint2 o; o.x = pack2(xs[i].x * rstd2 * gg.x * (1.f + sc.x) + sh.x, xs[i].y * rstd2 * gg.y * (1.f + sc.y) + sh.y);
                o.y = pack2(xs[i].z * rstd2 * gg.z * (1.f + sc.z) + sh.z, xs[i].w * rstd2 * gg.w * (1.f + sc.w) + sh.w);
                *(uint2*)(Hb + (size_t)r * D + c) = o; }
        }
    };
    {   const int r0 = (l + 1 < NL ? 0 : LC) + bid * NWV + wid, rs = nb * NWV;
        uint2 aa[4], ab[4], ba[4], bb[4]; float4 xa[4], xb[4];
        if (r0 < T) ld(r0, aa, ab, xa);
        for (int r = r0; r < T; r += 2 * rs) {
            if (r + rs < T) ld(r + rs, ba, bb, xb);
            proc(r, aa, ab, xa);
            if (r + rs < T) { if (r + 2 * rs < T) ld(r + 2 * rs, aa, ab, xa); proc(r + rs, ba, bb, xb); }
        } }
}

__device__ __forceinline__ void gsync(unsigned* bar, unsigned epoch) {
    asm volatile("s_waitcnt vmcnt(0) lgkmcnt(0)" ::: "memory");
    __syncthreads();
    if (threadIdx.x == 0) {
        __builtin_amdgcn_fence(__ATOMIC_RELEASE, "agent");
        asm volatile("s_waitcnt vmcnt(0)" ::: "memory");
        __hip_atomic_fetch_add(bar, 1u, __ATOMIC_RELAXED, __HIP_MEMORY_SCOPE_AGENT);
        const unsigned target = epoch * gridDim.x;
        while (__hip_atomic_load(bar, __ATOMIC_RELAXED, __HIP_MEMORY_SCOPE_AGENT) < target) __builtin_amdgcn_s_sleep(2);
        __builtin_amdgcn_fence(__ATOMIC_ACQUIRE, "agent");
        asm volatile("s_waitcnt vmcnt(0)" ::: "memory");
    }
    __syncthreads();
}

__global__ void __launch_bounds__(NTH) k_mega(Params p_unused) {
    KP p; p.k = (kparams_t)__builtin_amdgcn_kernarg_segment_ptr();
    __shared__ __attribute__((aligned(16))) char lds[LDS_BYTES]; float* smem = (float*)lds;
    cg::grid_group grid = cg::this_grid();
    grid.sync();
    const int bid = blockIdx.x, nb = gridDim.x;
    unsigned* bar = WSP(unsigned, OFF_BAR);
#define GS(k) gsync(bar, (unsigned)(k))
    st_prologue(p, bid, nb, smem); st_conv(p, 0, bid, nb, smem); st_s5_tables(p, 0, bid, nb, lds); GS(1);
    st_modulate(p, 0, bid, nb); GS(2);
#pragma unroll 1
    for (int l = 0; l < NL; ++l) {
        st_gemm_in(p, l, bid, nb, lds); GS(2 + 12 * l + 1);
        st_s5_local(p, l, bid, nb); st_s5_fgemm(p, bid, nb, lds); GS(2 + 12 * l + 2);
        st_s5_carry(p, l, bid, nb, lds); st_proj2<0>(p, l, bid, nb, lds); GS(2 + 12 * l + 3);
        st_s5_ygemm(p, l, bid, nb, lds); st_s5_ctx_y(p, l, bid, nb); st_ropeq(p, bid, nb, lds); GS(2 + 12 * l + 4);
        st_proj2<1>(p, l, bid, nb, lds); st_attn(p, l, bid, nb, lds); GS(2 + 12 * l + 5);
        st_merge(p, l, bid, nb, lds); GS(2 + 12 * l + 6);
        st_wout(p, l, bid, nb, lds); st_conv_experts(p, l, bid, nb, smem); GS(2 + 12 * l + 7);
        st_postmix(p, l, bid, nb, lds); GS(2 + 12 * l + 8);
        st_moe_build(p, l, bid, nb, lds); GS(2 + 12 * l + 9);
        st_moe_up(p, bid, nb, lds); GS(2 + 12 * l + 10);
        st_moe_down(p, bid, nb, lds); GS(2 + 12 * l + 11);
        st_postffn(p, l, bid, nb);
        if (l + 1 < NL) { st_conv(p, l + 1, bid, nb, smem); st_s5_tables(p, l + 1, bid, nb, lds); }
        GS(2 + 12 * l + 12);
    }
#undef GS
}

extern "C" void kernel_launch(void* const* d_in, const int* in_sizes, int n_in, void* d_out, int out_size, void* d_ws, size_t ws_size, hipStream_t stream) {
    Params p{};
    for (int i = 0; i < N_IN; ++i) p.in[i] = (const float*)d_in[i];
    p.out = (float*)d_out; p.ws = (char*)d_ws;
    if (ws_size < WS_NEED) { fprintf(stderr, "workspace too small: %zu < %zu\n", ws_size, (size_t)WS_NEED); return; }
    static int grid_blocks = 0;
    if (!grid_blocks) {
        int dev = 0, cus = 0, per_cu = 0;
        hipGetDevice(&dev);
        hipDeviceGetAttribute(&cus, hipDeviceAttributeMultiprocessorCount, dev);
        hipOccupancyMaxActiveBlocksPerMultiprocessor(&per_cu, k_mega, NTH, 0);
        if (per_cu > 1) per_cu = 1;
        if (per_cu < 1) per_cu = 1;
        grid_blocks = cus * per_cu;
    }
    hipMemsetAsync((char*)d_ws + OFF_BAR, 0, 256, stream);
    void* args[] = { &p };
    hipError_t e = hipLaunchCooperativeKernel((void*)k_mega, dim3(grid_blocks), dim3(NTH), args, 0, stream);
    if (e != hipSuccess) fprintf(stderr, "cooperative launch failed: %s (grid %d)\n", hipGetErrorString(e), grid_blocks);
}
```

```cpp
#include <hip/hip_runtime.h>
#include <hip/hip_cooperative_groups.h>
#include <cstdio>
#include <cstdint>
#include <type_traits>
namespace cg = cooperative_groups;


typedef unsigned short bf16_t;
typedef short bf16x8 __attribute__((ext_vector_type(8)));
typedef float f32x16 __attribute__((ext_vector_type(16)));
typedef float f32x4 __attribute__((ext_vector_type(4)));
typedef unsigned u32x4 __attribute__((ext_vector_type(4)));
constexpr int NTH = 512, NWV = 8;
#ifndef REP_CONV
#define REP_CONV 1
#endif
#ifndef REP_G1
#define REP_G1 1
#endif
#ifndef REP_G2
#define REP_G2 1
#endif
#ifndef REP_G3
#define REP_G3 1
#endif
#ifndef REP_S5
#define REP_S5 1
#endif
#ifndef REP_ATTN
#define REP_ATTN 1
#endif

constexpr int D = 1024, S = 16384, LC = 256, T = S + LC, NL = 2;
constexpr int NIN = 4768, NINP = 4864;
constexpr int PP = 1696;
constexpr int C_GQ = 0, C_GK = 512, C_GV = 640, C_CQ = 768, C_CKV = 1024, C_KR = 1152, C_SSM = 1184, C_GATE = 1696;
__host__ __device__ constexpr int win_col_old(int n) {
    return n < 512 ? 928 + n : n < 640 ? 1440 + (n - 512) : n < 768 ? 1568 + (n - 640) : n < 1024 ? (n - 768) : n < 1152 ? 256 + (n - 1024) : n < 1184 ? 384 + (n - 1152) : n < 1696 ? 416 + (n - 1184) : n;
}
constexpr int TP = 2 * T + 16 * 256;
constexpr float EPS = 1e-6f;
constexpr float LOG2E = 1.4426950408889634f;
constexpr float SC_MLA = 0.10206207261596575f * LOG2E, SC_GQA = 0.125f * LOG2E;

enum { I_X = 0, I_C, I_CTX, I_CCTX, I_WMOD, I_BMOD, I_GPREMIX, I_GPOSTMIX, I_GPREFFN, I_GPOSTFFN, I_WIN, I_GCQ, I_GCKV, I_WUQ, I_WUKV,
       I_GQN, I_GKN, I_ARE, I_AIM, I_LOGDT, I_BRE, I_BIM, I_CRE, I_CIM, I_SSMD, I_WGLU, I_BGLU, I_WBRM, I_WBRS, I_WBRG, I_WOUT,
       I_WGROUP, I_BGROUP, I_WROUTER, I_BROUTER, I_WEG, I_WEU, I_WED, N_IN };

constexpr size_t al256(size_t x) { return (x + 255) & ~(size_t)255; }
constexpr size_t WB_IN = 0;
constexpr size_t WB_UQ = WB_IN + (size_t)NINP * 1024 * 2;
constexpr size_t WB_UKV = WB_UQ + (size_t)768 * 256 * 2;
constexpr size_t WB_GLU = WB_UKV + (size_t)1024 * 128 * 2;
constexpr size_t WB_BR = WB_GLU + (size_t)512 * 512 * 2;
constexpr size_t WB_OUT = WB_BR + (size_t)3 * 1024 * 512 * 2;
constexpr size_t WB_EG = WB_OUT + (size_t)1024 * 1024 * 2;
constexpr size_t WB_EU = WB_EG + (size_t)16 * 512 * 1024 * 2;
constexpr size_t WB_ED = WB_EU + (size_t)16 * 512 * 1024 * 2;
constexpr size_t WB_BYTES = WB_ED + (size_t)16 * 1024 * 512 * 2;

constexpr size_t OFF_WB = 0;
constexpr size_t OFF_P = al256(OFF_WB + WB_BYTES);
constexpr size_t P_BYTES = (size_t)T * NIN * 2;
constexpr size_t OFF_GS = OFF_P + (size_t)T * PP * 2;
constexpr size_t OFF_Y = OFF_P;
constexpr size_t OFF_SLOTS = OFF_P;
constexpr size_t OFF_HID = OFF_P + (size_t)TP * 1024 * 2;
constexpr size_t OFF_H = al256(OFF_P + P_BYTES);
constexpr size_t OFF_KN = al256(OFF_H + (size_t)T * 1024 * 2);
constexpr size_t OFF_V = al256(OFF_KN + (size_t)T * 512 * 2);
constexpr size_t OFF_OM = al256(OFF_V + (size_t)T * 512 * 2);
constexpr size_t OFF_OG = OFF_OM + (size_t)T * 512 * 2;
constexpr size_t OFF_OS = OFF_OG + (size_t)T * 512 * 2;
constexpr size_t OFF_XC = al256(OFF_OS + (size_t)T * 512 * 2);
constexpr size_t OFF_MOD = al256(OFF_XC + (size_t)LC * 1024 * 4);
constexpr size_t OFF_TOKE = al256(OFF_MOD + (size_t)NL * 2 * 6144 * 4);
constexpr size_t OFF_TOKW = al256(OFF_TOKE + (size_t)T * 2 * 4);
constexpr size_t OFF_TOKS = al256(OFF_TOKW + (size_t)T * 2 * 4);
constexpr size_t OFF_SLTOK = al256(OFF_TOKS + (size_t)T * 2 * 4);
constexpr size_t OFF_SLW = al256(OFF_SLTOK + (size_t)TP * 4);
constexpr size_t OFF_CNT = al256(OFF_SLW + (size_t)TP * 4);
constexpr size_t OFF_S5 = al256(OFF_CNT + 256);
constexpr size_t OFF_ROPE = al256(OFF_S5 + (size_t)(T / 64) * 4096 * 8);
constexpr size_t OFF_SSQ = al256(OFF_ROPE + 256 * 24 * 8);
constexpr size_t OFF_SSMG = al256(OFF_SSQ + (size_t)T * 8 * 4);
constexpr size_t OFF_BAR = al256(OFF_SSMG + (size_t)32 * T * 16 * 2);
constexpr size_t BAR_BYTES = 4096;
constexpr size_t WS_NEED = al256(OFF_BAR + BAR_BYTES);
static_assert(OFF_HID + (size_t)TP * 512 * 2 <= OFF_P + P_BYTES, "overlay");
static_assert((size_t)T * 1024 * 4 <= P_BYTES, "overlay Y");
static_assert(WS_NEED < 384000000ull, "ws");

struct Params {
    const float* in[N_IN];
    float* out;
    char* ws;
};
typedef const __attribute__((address_space(4))) Params* kparams_t;
struct KP {
    kparams_t k;
    __device__ __forceinline__ const float* in(int i) const { return *(const float* const volatile __attribute__((address_space(4)))*)(&k->in[i]); }
    __device__ __forceinline__ float* out() const { return *(float* const volatile __attribute__((address_space(4)))*)(&k->out); }
    __device__ __forceinline__ char* ws() const { return *(char* const volatile __attribute__((address_space(4)))*)(&k->ws); }
};

__device__ __forceinline__ float bf2f(bf16_t v) { return __uint_as_float(((unsigned)v) << 16); }
typedef __bf16 bf16x2_t __attribute__((ext_vector_type(2)));
__device__ __forceinline__ bf16_t f2bf(float f) { const __bf16 b = (__bf16)f; return __builtin_bit_cast(bf16_t, b); }
__device__ __forceinline__ float bflo(unsigned u) { return __uint_as_float(u << 16); }
__device__ __forceinline__ float bfhi(unsigned u) { return __uint_as_float(u & 0xFFFF0000u); }
__device__ __forceinline__ unsigned pack2(float lo, float hi) { bf16x2_t v; v[0] = (__bf16)lo; v[1] = (__bf16)hi; return __builtin_bit_cast(unsigned, v); }
__device__ __forceinline__ float wave_sum(float v) {
#pragma unroll
    for (int o = 32; o > 0; o >>= 1) v += __shfl_xor(v, o);
    return v;
}
__device__ __forceinline__ float xhalf_max(float m) { auto rr = __builtin_amdgcn_permlane32_swap(__float_as_uint(m), __float_as_uint(m), false, false); return fmaxf(__uint_as_float(rr[0]), __uint_as_float(rr[1])); }
__device__ __forceinline__ float xhalf_sum(float m) { auto rr = __builtin_amdgcn_permlane32_swap(__float_as_uint(m), __float_as_uint(m), false, false); return __uint_as_float(rr[0]) + __uint_as_float(rr[1]); }
__device__ __forceinline__ void rope_tab(float& a, float& b, float2 cs) { const float na = a * cs.x - b * cs.y, nb_ = a * cs.y + b * cs.x; a = na; b = nb_; }
__device__ __forceinline__ float transpose_reduce16(const float (&t16)[16], int lane) {
    float t8[8], t4[4], t2[2];
#pragma unroll
    for (int i = 0; i < 8; ++i) { const float a = t16[2 * i], b = t16[2 * i + 1]; const bool o = lane & 1; const float keep = o ? b : a, send = o ? a : b; t8[i] = keep + __shfl_xor(send, 1); }
#pragma unroll
    for (int i = 0; i < 4; ++i) { const float a = t8[2 * i], b = t8[2 * i + 1]; const bool o = lane & 2; const float keep = o ? b : a, send = o ? a : b; t4[i] = keep + __shfl_xor(send, 2); }
#pragma unroll
    for (int i = 0; i < 2; ++i) { const float a = t4[2 * i], b = t4[2 * i + 1]; const bool o = lane & 4; const float keep = o ? b : a, send = o ? a : b; t2[i] = keep + __shfl_xor(send, 4); }
    float y; { const float a = t2[0], b = t2[1]; const bool o = lane & 8; const float keep = o ? b : a, send = o ? a : b; y = keep + __shfl_xor(send, 8); }
    y += __shfl_xor(y, 16); y += __shfl_xor(y, 32);
    return y;
}
__device__ __forceinline__ float sigmoidf_(float x) { return __builtin_amdgcn_rcpf(1.0f + __builtin_amdgcn_exp2f(-LOG2E * x)); }
__device__ __forceinline__ float siluf_(float x) { return x * __builtin_amdgcn_rcpf(1.0f + __builtin_amdgcn_exp2f(-LOG2E * x)); }
__device__ __forceinline__ float gelu_tanh(float x) {
    const float u = 0.7978845608028654f * (x + 0.044715f * x * x * x);
    return x * __builtin_amdgcn_rcpf(1.0f + __builtin_amdgcn_exp2f(-2.0f * LOG2E * u));
}
__device__ __forceinline__ float dot8(uint4 a, uint4 b, float acc) {
    acc = fmaf(bflo(a.x), bflo(b.x), acc); acc = fmaf(bfhi(a.x), bfhi(b.x), acc);
    acc = fmaf(bflo(a.y), bflo(b.y), acc); acc = fmaf(bfhi(a.y), bfhi(b.y), acc);
    acc = fmaf(bflo(a.z), bflo(b.z), acc); acc = fmaf(bfhi(a.z), bfhi(b.z), acc);
    acc = fmaf(bflo(a.w), bflo(b.w), acc); acc = fmaf(bfhi(a.w), bfhi(b.w), acc);
    return acc;
}
__device__ __forceinline__ float dotrow(const bf16_t* a, const bf16_t* b, int K) {
    float acc = 0.f;
    const uint4* a4 = (const uint4*)a; const uint4* b4 = (const uint4*)b;
    for (int k = 0; k < K / 8; ++k) acc = dot8(a4[k], b4[k], acc);
    return acc;
}

__device__ __forceinline__ int opaque_tid() { int t = threadIdx.x; asm volatile("" : "+v"(t)); return t; }
#define WSP(type, off) ((type*)(p.ws() + (off)))
#define SSMU(g, r) (WSP(const bf16_t, OFF_SSMG) + ((size_t)(g) * T + (r)) * 16)

template <class AF, class BF, class EF>
__device__ __forceinline__ void gemm_naive(int M, int N, int K, AF arow, BF brow, EF epi, int bid, int nb) {
    const int tidx = opaque_tid();
    const long total = (long)M * N;
    for (long idx = (long)bid * NTH + tidx; idx < total; idx += (long)nb * NTH) {
        const int m = (int)(idx / N), n = (int)(idx % N);
        const float acc = dotrow(arow(m), brow(m, n), K);
        epi(m, n, acc);
    }
}

constexpr int G_A_BYTES = 256 * 128, G_W_BYTES = 128 * 128, G_BUF = G_A_BYTES + G_W_BYTES;
constexpr int LDS_BYTES = 3 * G_BUF;
#define MFMA32(a, b, c) __builtin_amdgcn_mfma_f32_32x32x16_bf16(a, b, c, 0, 0, 0)

#define GLDS16(gptr, lptr) __builtin_amdgcn_global_load_lds((const __attribute__((address_space(1))) void*)(gptr), (__attribute__((address_space(3))) void*)(lptr), 16, 0, 0)
typedef f32x4 acc_t[4][4];
#define MFMA16(a, b, c) __builtin_amdgcn_mfma_f32_16x16x32_bf16(a, b, c, 0, 0, 0)
template <class APTR, class WPTR>
__device__ __forceinline__ void gemm_core_g(acc_t& acc, APTR aptr, WPTR wptr, int nk, char* lds) {
    const int tidx = opaque_tid();
    const int tid = tidx, lane = tid & 63, wid = tid >> 6, wm = wid >> 1, wn = wid & 1, fr = lane & 15, g = lane >> 4;
    const int wu = __builtin_amdgcn_readfirstlane(wid);
    char* sdst = lds + wu * 1024;
    const int xoff = (wm * 64 + fr) * 128, woff = G_A_BYTES + (wn * 64 + fr) * 128, sw7 = (fr >> 1) & 7;
    asm volatile("s_waitcnt vmcnt(0)" ::: "memory");
#pragma unroll
    for (int i = 0; i < 4; ++i) GLDS16(aptr(i, 0), sdst + i * 8192);
#pragma unroll
    for (int i = 0; i < 2; ++i) GLDS16(wptr(i, 0), sdst + G_A_BYTES + i * 8192);
    if (nk > 1) {
#pragma unroll
        for (int i = 0; i < 4; ++i) GLDS16(aptr(i, 1), sdst + G_BUF + i * 8192);
#pragma unroll
        for (int i = 0; i < 2; ++i) GLDS16(wptr(i, 1), sdst + G_BUF + G_A_BYTES + i * 8192);
        asm volatile("s_waitcnt vmcnt(6)" ::: "memory");
    } else asm volatile("s_waitcnt vmcnt(0)" ::: "memory");
    __builtin_amdgcn_s_barrier();
    int slot = 0;
    for (int kt = 0; kt < nk; ++kt) {
        const char* cur = lds + slot * G_BUF;
        const int s2 = slot >= 1 ? slot - 1 : 2;
        const bool more2 = (kt + 2 < nk);
        char* nxt = sdst + s2 * G_BUF;
#pragma unroll
        for (int ks = 0; ks < 2; ++ks) {
            const int co = ((ks * 4 + g) ^ sw7) << 4;
            bf16x8 x[4], w[4];
#pragma unroll
            for (int i = 0; i < 4; ++i) { x[i] = *(const bf16x8*)(cur + xoff + i * 16 * 128 + co); w[i] = *(const bf16x8*)(cur + woff + i * 16 * 128 + co); }
#pragma unroll
            for (int in = 0; in < 4; ++in)
#pragma unroll
                for (int im = 0; im < 4; ++im) acc[in][im] = MFMA16(w[in], x[im], acc[in][im]);
            __builtin_amdgcn_sched_barrier(0);
            if (more2) {
                if (ks == 0) { GLDS16(aptr(0, kt + 2), nxt); GLDS16(aptr(1, kt + 2), nxt + 8192); GLDS16(aptr(2, kt + 2), nxt + 2 * 8192); }
                else { GLDS16(aptr(3, kt + 2), nxt + 3 * 8192); GLDS16(wptr(0, kt + 2), nxt + G_A_BYTES); GLDS16(wptr(1, kt + 2), nxt + G_A_BYTES + 8192); }
            }
            __builtin_amdgcn_sched_barrier(0);
        }
        if (more2) asm volatile("s_waitcnt vmcnt(6) lgkmcnt(0)" ::: "memory");
        else asm volatile("s_waitcnt vmcnt(0) lgkmcnt(0)" ::: "memory");
        __builtin_amdgcn_s_barrier();
        slot = slot == 2 ? 0 : slot + 1;
    }
}
template <class AROW, class WROW>
__device__ __forceinline__ void gemm_core(acc_t& acc, AROW arow, WROW wrow, int K, char* lds) {
    const int tidx = opaque_tid();
    const int srow = tidx >> 3, gch = (tidx & 7) ^ ((srow >> 1) & 7);
    const bf16_t* pa[4]; const bf16_t* pw[2];
#pragma unroll
    for (int i = 0; i < 4; ++i) pa[i] = arow(srow + 64 * i) + gch * 8;
#pragma unroll
    for (int i = 0; i < 2; ++i) pw[i] = wrow(srow + 64 * i) + gch * 8;
    gemm_core_g(acc, [&](int i, int kt) { return pa[i] + kt * 64; }, [&](int i, int kt) { return pw[i] + kt * 64; }, K >> 6, lds);
}
__device__ __forceinline__ void acc_zero(acc_t& acc) {
#pragma unroll
    for (int a = 0; a < 4; ++a)
#pragma unroll
        for (int b = 0; b < 4; ++b) { acc[a][b][0] = 0.f; acc[a][b][1] = 0.f; acc[a][b][2] = 0.f; acc[a][b][3] = 0.f; }
}
template <class F>
__device__ __forceinline__ void acc_visit(const acc_t& acc, F f) {
    const int tidx = opaque_tid();
    const int lane = tidx & 63, wid = tidx >> 6, wm = wid >> 1, wn = wid & 1, fr = lane & 15, g = lane >> 4;
#pragma unroll
    for (int in = 0; in < 4; ++in)
#pragma unroll
        for (int im = 0; im < 4; ++im) f(wm * 64 + 16 * im + fr, wn * 64 + 16 * in + 4 * g, acc[in][im]);
}
template <class F>
__device__ __forceinline__ void acc_visit_add(const acc_t& acc, acc_t& tot, F f) {
    const int tidx = opaque_tid();
    const int lane = tidx & 63, wid = tidx >> 6, wm = wid >> 1, wn = wid & 1, fr = lane & 15, g = lane >> 4;
#pragma unroll
    for (int in = 0; in < 4; ++in)
#pragma unroll
        for (int im = 0; im < 4; ++im) tot[in][im] += f(wm * 64 + 16 * im + fr, wn * 64 + 16 * in + 4 * g, acc[in][im]);
}
template <class APTR, class WPTR>
__device__ __forceinline__ void gemm_core256(acc_t (&acc)[2], APTR aptr, WPTR wptr, int nt, char* lds) {
    const int tid = opaque_tid(), lane = tid & 63, wid = tid >> 6, wr = wid >> 2, wc = wid & 3, fr = lane & 15, g = lane >> 4;
    const int wu = __builtin_amdgcn_readfirstlane(wid);
    char* sdst = lds + wu * 1024;
    const int sw7 = (fr >> 1) & 7;
    typedef const __attribute__((address_space(3))) char* l3p; typedef const __attribute__((address_space(3))) bf16x8* l3v;
    l3p wf0 = (l3p)lds + (wr * 64 + fr) * 128 + ((g ^ sw7) << 4); l3p wf1 = (l3p)lds + (wr * 64 + fr) * 128 + (((4 + g) ^ sw7) << 4);
    l3p xf0 = (l3p)lds + 4 * 16384 + (wc * 32 + fr) * 128 + ((g ^ sw7) << 4); l3p xf1 = (l3p)lds + 4 * 16384 + (wc * 32 + fr) * 128 + (((4 + g) ^ sw7) << 4);
    asm volatile("" : "+v"(wf0), "+v"(wf1), "+v"(xf0), "+v"(xf1));
#define C2_SW(b, h) (((b) * 2 + (h)) * 16384)
#define C2_STG_W(b, h, kt) do { GLDS16(wptr(h, 0, kt), sdst + C2_SW(b, h)); GLDS16(wptr(h, 1, kt), sdst + C2_SW(b, h) + 8192); } while (0)
#define C2_STG_X(b, h, kt) do { GLDS16(aptr(h, 0, kt), sdst + 4 * 16384 + C2_SW(b, h)); GLDS16(aptr(h, 1, kt), sdst + 4 * 16384 + C2_SW(b, h) + 8192); } while (0)
#define C2_LDW(b, h) do { _Pragma("unroll") for (int m = 0; m < 4; ++m) { Wt[m][0] = *(l3v)(wf0 + C2_SW(b, h) + m * 2048); Wt[m][1] = *(l3v)(wf1 + C2_SW(b, h) + m * 2048); } } while (0)
#define C2_LDX(dst, b, h) do { _Pragma("unroll") for (int n = 0; n < 2; ++n) { dst[n][0] = *(l3v)(xf0 + C2_SW(b, h) + n * 2048); dst[n][1] = *(l3v)(xf1 + C2_SW(b, h) + n * 2048); } } while (0)
#define C2_MMA(nh, mh, Xf) do { __builtin_amdgcn_s_setprio(1); \
        _Pragma("unroll") for (int m = 0; m < 4; ++m) _Pragma("unroll") for (int n = 0; n < 2; ++n) _Pragma("unroll") for (int k = 0; k < 2; ++k) \
            acc[nh][m][2 * (mh) + n] = MFMA16(Wt[m][k], Xf[n][k], acc[nh][m][2 * (mh) + n]); \
        __builtin_amdgcn_s_setprio(0); } while (0)
#define C2_WV(n) asm volatile("s_waitcnt vmcnt(" #n ")" ::: "memory")
#define C2_WL(n) asm volatile("s_waitcnt lgkmcnt(" #n ")" ::: "memory")
#define C2_BAR __builtin_amdgcn_s_barrier()
#define C2_SCHED __builtin_amdgcn_sched_barrier(0)
    bf16x8 Wt[4][2], X0[2][2], X1[2][2];
    C2_WV(0);
    C2_STG_X(0, 0, 0); C2_STG_W(0, 0, 0); C2_STG_X(0, 1, 0); C2_STG_W(0, 1, 0);
    if (wu >= 4) C2_BAR;
    C2_WV(4); C2_BAR;
    C2_STG_X(1, 0, 1); C2_STG_W(1, 0, 1); C2_STG_X(1, 1, 1);
    C2_WV(6); C2_BAR;
#pragma unroll 1
    for (int t = 0; t < nt - 2; t += 2) {
        C2_LDX(X0, 0, 0); C2_SCHED; C2_LDW(0, 0); C2_STG_W(1, 1, t + 1);
        C2_WL(8); C2_BAR; C2_WL(0); C2_MMA(0, 0, X0); C2_BAR; C2_SCHED;
        C2_LDX(X1, 0, 1); C2_STG_X(0, 0, t + 2);
        C2_BAR; C2_WL(0); C2_MMA(0, 1, X1); C2_BAR;
        C2_LDW(0, 1); C2_STG_W(0, 0, t + 2);
        C2_BAR; C2_WL(0); C2_MMA(1, 0, X0); C2_BAR; C2_SCHED;
        C2_STG_X(0, 1, t + 2);
        C2_WV(6); C2_BAR; C2_MMA(1, 1, X1); C2_BAR;
        C2_LDX(X0, 1, 0); C2_SCHED; C2_LDW(1, 0); C2_STG_W(0, 1, t + 2);
        C2_WL(8); C2_BAR; C2_WL(0); C2_MMA(0, 0, X0); C2_BAR; C2_SCHED;
        C2_LDX(X1, 1, 1); C2_STG_X(1, 0, t + 3);
        C2_BAR; C2_WL(0); C2_MMA(0, 1, X1); C2_BAR;
        C2_LDW(1, 1); C2_STG_W(1, 0, t + 3);
        C2_BAR; C2_WL(0); C2_MMA(1, 0, X0); C2_BAR; C2_SCHED;
        C2_STG_X(1, 1, t + 3);
        C2_WV(6); C2_BAR; C2_MMA(1, 1, X1); C2_BAR;
    }
    {   C2_LDX(X0, 0, 0); C2_LDW(0, 0); C2_STG_W(1, 1, nt - 1);
        C2_BAR; C2_WL(0); C2_MMA(0, 0, X0); C2_BAR;
        C2_LDX(X1, 0, 1); C2_BAR; C2_WL(0); C2_MMA(0, 1, X1); C2_BAR;
        C2_LDW(0, 1); C2_WV(4); C2_BAR; C2_WL(0); C2_MMA(1, 0, X0); C2_MMA(1, 1, X1); C2_BAR; }
    {   C2_LDX(X0, 1, 0); C2_LDW(1, 0); C2_WV(2); C2_BAR; C2_WL(0); C2_MMA(0, 0, X0); C2_BAR;
        C2_LDX(X1, 1, 1); C2_WV(0); C2_BAR; C2_WL(0); C2_MMA(0, 1, X1); C2_BAR;
        C2_LDW(1, 1); C2_BAR; C2_WL(0); C2_MMA(1, 0, X0); C2_MMA(1, 1, X1); C2_BAR; }
    if (wu < 4) C2_BAR;
}
__device__ __forceinline__ void gemm_core256_dense(acc_t (&acc)[2], const bf16_t* xb, int xpitch, const bf16_t* wb, int wpitch, int K, char* lds) {
    const int tidx = opaque_tid();
    const int srow = tidx >> 3, gch = (tidx & 7) ^ ((srow >> 1) & 7);
    const unsigned vx = (unsigned)(srow * xpitch + gch * 8) * 2u, vw = (unsigned)(srow * wpitch + gch * 8) * 2u;
    auto upin = [](const char* q) { const unsigned long long v = (unsigned long long)q; const unsigned lo = __builtin_amdgcn_readfirstlane((unsigned)v), hi = __builtin_amdgcn_readfirstlane((unsigned)(v >> 32)); return (const char*)(((unsigned long long)hi << 32) | lo); };
    gemm_core256(acc, [&](int h, int i, int kt) { return (const bf16_t*)(upin((const char*)xb + ((size_t)(h * 128 + i * 64) * xpitch + kt * 64) * 2) + vx); },
                 [&](int h, int i, int kt) { return (const bf16_t*)(upin((const char*)wb + ((size_t)(h * 128 + i * 64) * wpitch + kt * 64) * 2) + vw); }, K >> 6, lds);
}
template <class F>
__device__ __forceinline__ void acc_visit2(const acc_t& acc, F f) {
    const int tidx = opaque_tid();
    const int lane = tidx & 63, wid = tidx >> 6, wr = wid >> 2, wc = wid & 3, fr = lane & 15, g = lane >> 4;
#pragma unroll
    for (int in = 0; in < 4; ++in)
#pragma unroll
        for (int im = 0; im < 4; ++im) f((im >> 1) * 128 + wc * 32 + (im & 1) * 16 + fr, wr * 64 + 16 * in + 4 * g, acc[in][im]);
}
__device__ __forceinline__ uint2 pack4(f32x4 v) { uint2 o; o.x = pack2(v[0], v[1]); o.y = pack2(v[2], v[3]); return o; }
__device__ __forceinline__ bool dense_tile(int it, int NT, bool with_ctx, int bid, int nb, int& mt, int& nt) {
    const int x = bid & 7, j = bid >> 3, jb = nb >> 3;
    int v = it * jb + j;
    if (v < 8 * NT) { mt = 1 + x * 8 + (v & 7); nt = v >> 3; return true; }
    if (!with_ctx) return false;
    v -= 8 * NT; nt = x + 8 * v; mt = 0;
    return nt < NT;
}

__device__ __forceinline__ void st_prologue(const KP& p, int bid, int nb, float* smem) {
    const int tidx = opaque_tid();
    const int tid = tidx;
    {   float2* t16 = WSP(float2, OFF_ROPE); float2* t8 = t16 + 256 * 16;
        for (int idx = bid * NTH + tid; idx < 256 * 24; idx += nb * NTH) {
            const bool big = idx < 256 * 16; const int j = big ? idx : idx - 256 * 16, half = big ? 16 : 8, pos = j / half, i = j % half;
            const float ang = (float)pos * powf(10000.0f, -(float)i / (float)half);
            float sn, cs; sincosf(ang, &sn, &cs);
            (big ? t16 : t8)[j] = make_float2(cs, sn);
        } }
    for (int k = tid; k < 1024; k += NTH) { smem[k] = siluf_(p.in(I_C)[k]); smem[1024 + k] = siluf_(p.in(I_CCTX)[k]); }
    __syncthreads();
    float* mod = WSP(float, OFF_MOD);
    float4* red = (float4*)(smem + 2048);
    for (int jb = bid; jb < 256; jb += nb) {
        const int l = jb >> 7, j0 = (jb & 127) * 48, jj = tid % 12, kk = tid / 12;
        float4 a0 = make_float4(0.f, 0.f, 0.f, 0.f), a1 = a0;
        if (kk < 42) {
            const float* w = p.in(I_WMOD) + (size_t)l * 1024 * 6144 + j0 + jj * 4;
            for (int k = kk; k < 1024; k += 42) { const float4 wv = *(const float4*)(w + (size_t)k * 6144); const float s0 = smem[k], s1 = smem[1024 + k];
                a0.x = fmaf(s0, wv.x, a0.x); a0.y = fmaf(s0, wv.y, a0.y); a0.z = fmaf(s0, wv.z, a0.z); a0.w = fmaf(s0, wv.w, a0.w);
                a1.x = fmaf(s1, wv.x, a1.x); a1.y = fmaf(s1, wv.y, a1.y); a1.z = fmaf(s1, wv.z, a1.z); a1.w = fmaf(s1, wv.w, a1.w); }
            red[(kk * 12 + jj) * 2] = a0; red[(kk * 12 + jj) * 2 + 1] = a1;
        }
        __syncthreads();
        if (tid < 24) {
            const int cj = tid >> 1, cond = tid & 1;
            float4 s = make_float4(0.f, 0.f, 0.f, 0.f);
            for (int q = 0; q < 42; ++q) { const float4 v = red[(q * 12 + cj) * 2 + cond]; s.x += v.x; s.y += v.y; s.z += v.z; s.w += v.w; }
            const float4 b = *(const float4*)(p.in(I_BMOD) + l * 6144 + j0 + cj * 4);
            s.x += b.x; s.y += b.y; s.z += b.z; s.w += b.w;
            *(float4*)(mod + (size_t)(l * 2 + cond) * 6144 + j0 + cj * 4) = s;
        }
        __syncthreads();
    }
}

template <bool IDN, class COLF, class KSF>
__device__ __forceinline__ void conv_t_g(const float* W, bf16_t* Wt, int K, int N, int Npad, int nmat, int bid, int nb, float* smem, COLF colf, KSF ksf) {
    const int tidx = opaque_tid();
    const int tid = tidx;
    const int tn = Npad / 64, tk = K / 64;
    const int ntile = tn * tk * nmat;
    for (int t = bid; t < ntile; t += nb) {
        const int mat = t / (tn * tk), r = t % (tn * tk), n0 = (r / tk) * 64, k0 = (r % tk) * 64;
        const float* Wm = W + (size_t)mat * K * N; bf16_t* Wtm = Wt + (size_t)mat * Npad * K;
        __syncthreads();
        {
            const int kk = tid >> 4, c4 = (tid & 15) * 4; const bool ok = (n0 + c4 < N); const int sc = ok ? colf(n0 + c4) : 0;
#pragma unroll
            for (int i = 0; i < 2; ++i) { float4 v = make_float4(0.f, 0.f, 0.f, 0.f); if (ok) v = *(const float4*)(Wm + (size_t)(k0 + kk + 32 * i) * N + sc); const float s = ksf(k0 + kk + 32 * i);
                float* d = smem + (kk + 32 * i) * 65 + c4; d[0] = v.x * s; d[1] = v.y * s; d[2] = v.z * s; d[3] = v.w * s; }
        }
        __syncthreads();
        {   const int nn = tid >> 3, kc = (tid & 7) * 8;
            float e[8];
#pragma unroll
            for (int j = 0; j < 8; ++j) e[j] = smem[(kc + j) * 65 + nn];
            uint4 o; o.x = pack2(e[0], e[1]); o.y = pack2(e[2], e[3]); o.z = pack2(e[4], e[5]); o.w = pack2(e[6], e[7]);
            *(uint4*)(Wtm + (size_t)(n0 + nn) * K + k0 + kc) = o; }
    }
    __syncthreads();
}
__device__ __forceinline__ void conv_t(const float* W, bf16_t* Wt, int K, int N, int Npad, int nmat, int bid, int nb, float* smem) {
    conv_t_g<true>(W, Wt, K, N, Npad, nmat, bid, nb, smem, [](int n) { return n; }, [](int) { return 1.0f; });
}
__device__ __forceinline__ void st_conv(const KP& p, int l, int bid, int nb, float* smem) {
    const int tidx = opaque_tid(); (void)tidx;
    bf16_t* wb = WSP(bf16_t, OFF_WB);
    conv_t_g<false>(p.in(I_WIN) + (size_t)l * 1024 * NIN, (bf16_t*)((char*)wb + WB_IN), 1024, NIN, NINP, 1, bid, nb, smem, [](int n) { return win_col_old(n); }, [](int) { return 1.0f; });
    {   const float* gcq = p.in(I_GCQ) + l * 256; const float* gckv = p.in(I_GCKV) + l * 128;
        conv_t_g<true>(p.in(I_WUQ) + (size_t)l * 256 * 768, (bf16_t*)((char*)wb + WB_UQ), 256, 768, 768, 1, bid, nb, smem, [](int n) { return n; }, [&](int k) { return gcq[k]; });
        conv_t_g<true>(p.in(I_WUKV) + (size_t)l * 128 * 1024, (bf16_t*)((char*)wb + WB_UKV), 128, 1024, 1024, 1, bid, nb, smem, [](int n) { return n; }, [&](int k) { return gckv[k]; }); }
    conv_t(p.in(I_WGLU) + (size_t)l * 512 * 512, (bf16_t*)((char*)wb + WB_GLU), 512, 512, 512, 1, bid, nb, smem);
    conv_t(p.in(I_WBRM) + (size_t)l * 512 * 1024, (bf16_t*)((char*)wb + WB_BR), 512, 1024, 1024, 1, bid, nb, smem);
    conv_t(p.in(I_WBRS) + (size_t)l * 512 * 1024, (bf16_t*)((char*)wb + WB_BR + (size_t)1024 * 512 * 2), 512, 1024, 1024, 1, bid, nb, smem);
    conv_t(p.in(I_WBRG) + (size_t)l * 512 * 1024, (bf16_t*)((char*)wb + WB_BR + (size_t)2 * 1024 * 512 * 2), 512, 1024, 1024, 1, bid, nb, smem);
    conv_t(p.in(I_WOUT) + (size_t)l * 1024 * 1024, (bf16_t*)((char*)wb + WB_OUT), 1024, 1024, 1024, 1, bid, nb, smem);
}
__device__ __forceinline__ void st_conv_experts(const KP& p, int l, int bid, int nb, float* smem) {
    const int tidx = opaque_tid(); (void)tidx;
    bf16_t* wb = WSP(bf16_t, OFF_WB);
    conv_t(p.in(I_WEG) + (size_t)l * 16 * 1024 * 512, (bf16_t*)((char*)wb + WB_EG), 1024, 512, 512, 16, bid, nb, smem);
    conv_t(p.in(I_WEU) + (size_t)l * 16 * 1024 * 512, (bf16_t*)((char*)wb + WB_EU), 1024, 512, 512, 16, bid, nb, smem);
    conv_t(p.in(I_WED) + (size_t)l * 16 * 512 * 1024, (bf16_t*)((char*)wb + WB_ED), 512, 1024, 1024, 16, bid, nb, smem);
}

__device__ __forceinline__ const float* xrow_c(const KP& p, int r) { return (r < LC) ? (WSP(float, OFF_XC) + (size_t)r * D) : (p.out() + (size_t)(r - LC) * D); }
__device__ __forceinline__ const float* xrow_in(const KP& p, int r) { return (r < LC) ? (p.in(I_CTX) + (size_t)r * D) : (p.in(I_X) + (size_t)(r - LC) * D); }
__device__ __forceinline__ float* xrow(const KP& p, int r) { return (r < LC) ? (WSP(float, OFF_XC) + (size_t)r * D) : (p.out() + (size_t)(r - LC) * D); }
__device__ __forceinline__ void st_modulate(const KP& p, int l, int bid, int nb) {
    const int tidx = opaque_tid();
    const int lane = tidx & 63, wid = tidx >> 6;
    bf16_t* Hb = WSP(bf16_t, OFF_H);
    const float* g = p.in(I_GPREMIX) + l * D;
    auto ld = [&](int r, float4 (&v)[4]) __attribute__((always_inline)) {
        const float* xr = l == 0 ? xrow_in(p, r) : xrow_c(p, r);
#pragma unroll
        for (int i = 0; i < 4; ++i) v[i] = *(const float4*)(xr + i * 256 + lane * 4);
    };
    auto proc = [&](int r, float4 (&v)[4]) __attribute__((always_inline)) {
        const float* md = WSP(float, OFF_MOD) + (size_t)(l * 2 + (r < LC ? 1 : 0)) * 6144;
        float ss = 0.f;
#pragma unroll
        for (int i = 0; i < 4; ++i) ss += v[i].x * v[i].x + v[i].y * v[i].y + v[i].z * v[i].z + v[i].w * v[i].w;
        ss = wave_sum(ss);
        const float rstd = rsqrtf(ss * (1.0f / D) + EPS);
#pragma unroll
        for (int i = 0; i < 4; ++i) {
            const int c = i * 256 + lane * 4;
            const float4 gg = *(const float4*)(g + c), sh = *(const float4*)(md + c), sc = *(const float4*)(md + 1024 + c);
            const float h0 = v[i].x * rstd * gg.x * (1.f + sc.x) + sh.x, h1 = v[i].y * rstd * gg.y * (1.f + sc.y) + sh.y;
            const float h2 = v[i].z * rstd * gg.z * (1.f + sc.z) + sh.z, h3 = v[i].w * rstd * gg.w * (1.f + sc.w) + sh.w;
            uint2 o; o.x = pack2(h0, h1); o.y = pack2(h2, h3);
            *(uint2*)(Hb + (size_t)r * D + c) = o;
        }
    };
    {   const int r0 = bid * NWV + wid, rs = nb * NWV;
        float4 va[4], vb[4];
        if (r0 < T) ld(r0, va);
        for (int r = r0; r < T; r += 2 * rs) {
            if (r + rs < T) ld(r + rs, vb);
            proc(r, va);
            if (r + rs < T) { if (r + 2 * rs < T) ld(r + 2 * rs, va); proc(r + rs, vb); }
        } }
}

__device__ __forceinline__ void st_gemm_in(const KP& p, int l, int bid, int nb, char* lds) {
    const int tidx = opaque_tid();
    if (bid == 0 && tidx < 8) WSP(unsigned, OFF_CNT)[32 + tidx] = 0u;
    const bf16_t* Hb = WSP(bf16_t, OFF_H); const bf16_t* Wt = WSP(bf16_t, OFF_WB + WB_IN); bf16_t* P = WSP(bf16_t, OFF_P);
    float* ssq = WSP(float, OFF_SSQ); const float2* t16 = WSP(float2, OFF_ROPE); const float2* t8 = t16 + 256 * 16;
    const float* gqn = p.in(I_GQN) + l * 64; const float* gkn = p.in(I_GKN) + l * 64;
    int mt, pn;
    for (int it = 0; dense_tile(it, NINP / 256, true, bid, nb, mt, pn); ++it) {
        acc_t acc2[2]; acc_zero(acc2[0]); acc_zero(acc2[1]);
        gemm_core256_dense(acc2, Hb + (size_t)mt * 256 * 1024, 1024, Wt + (size_t)pn * 256 * 1024, 1024, 1024, lds);
        const int tid2 = opaque_tid(), lane = tid2 & 63, wid = tid2 >> 6, wn = wid >> 2, wc = wid & 3, fr = lane & 15, g = lane >> 4;
#pragma unroll
      for (int nh = 0; nh < 2; ++nh) {
        const int nt = 2 * pn + nh; const acc_t& acc = acc2[nh];
#pragma unroll
        for (int im = 0; im < 4; ++im) {
            const int ml = (im >> 1) * 128 + wc * 32 + (im & 1) * 16 + fr, row = mt * 256 + ml;
            bf16_t* prow_ = P + (size_t)row * PP + nt * 128 + wn * 64 + 4 * g;
            const bool lat = row >= LC; const int tpos = row - LC, prow = lat ? (tpos >> 6) : 0, pcol = lat ? (tpos & 63) : 0;
            f32x4 v[4];
#pragma unroll
            for (int in = 0; in < 4; ++in) v[in] = acc[in][im];
            if (nt <= 4) {
                float ss = 0.f;
#pragma unroll
                for (int in = 0; in < 4; ++in) ss += (v[in][0] * v[in][0] + v[in][1] * v[in][1]) + (v[in][2] * v[in][2] + v[in][3] * v[in][3]);
                ss += __shfl_xor(ss, 16); ss += __shfl_xor(ss, 32);
                const float sc = rsqrtf(ss * (1.0f / 64.0f) + EPS) * (nt < 4 ? SC_GQA : 1.0f);
                const float* gg = (nt < 4 ? gqn : gkn) + 4 * g;
#pragma unroll
                for (int in = 0; in < 4; ++in) { const float4 g4 = *(const float4*)(gg + 16 * in); v[in][0] *= sc * g4.x; v[in][1] *= sc * g4.y; v[in][2] *= sc * g4.z; v[in][3] *= sc * g4.w; }
                if (lat) {
#pragma unroll
                    for (int hlf = 0; hlf < 2; ++hlf) {
                        const float4* cs = (const float4*)(t16 + (hlf == 0 ? prow : pcol) * 16 + 4 * g);
                        const float4 c01 = cs[0], c23 = cs[1];
                        const f32x4 cc = {c01.x, c01.z, c23.x, c23.z}, sn = {c01.y, c01.w, c23.y, c23.w}, a = v[2 * hlf], b = v[2 * hlf + 1];
                        v[2 * hlf] = a * cc - b * sn; v[2 * hlf + 1] = a * sn + b * cc; }
                }
            } else if (nt >= 6 && nt <= 8) {
                float ss = 0.f;
#pragma unroll
                for (int in = 0; in < 4; ++in) ss += (v[in][0] * v[in][0] + v[in][1] * v[in][1]) + (v[in][2] * v[in][2] + v[in][3] * v[in][3]);
                ss += __shfl_xor(ss, 16); ss += __shfl_xor(ss, 32);
                if (g == 0) ssq[(size_t)row * 8 + (nt - 6) * 2 + wn] = ss;
            } else if (nt == 9 && wn == 0) {
#pragma unroll
                for (int in = 0; in < 2; ++in) {
                    f32x4 o; o[0] = __shfl_xor(v[in][0], 32); o[1] = __shfl_xor(v[in][1], 32); o[2] = __shfl_xor(v[in][2], 32); o[3] = __shfl_xor(v[in][3], 32);
                    if (lat) { const float4* cs = (const float4*)(t8 + (in == 0 ? prow : pcol) * 8 + 4 * (g & 1));
                        const float4 c01 = cs[0], c23 = cs[1];
                        if (g < 2) { v[in][0] = v[in][0] * c01.x - o[0] * c01.y; v[in][1] = v[in][1] * c01.z - o[1] * c01.w; v[in][2] = v[in][2] * c23.x - o[2] * c23.y; v[in][3] = v[in][3] * c23.z - o[3] * c23.w; }
                        else { v[in][0] = o[0] * c01.y + v[in][0] * c01.x; v[in][1] = o[1] * c01.w + v[in][1] * c01.z; v[in][2] = o[2] * c23.y + v[in][2] * c23.x; v[in][3] = o[3] * c23.w + v[in][3] * c23.z; } }
                }
            }
#pragma unroll
            for (int in = 0; in < 4; ++in) {
                const int G = nt * 8 + wn * 4 + in;
                if (G >= 106) {
                    if (G < 298) {
                        uint2 o; o.x = pack2(sigmoidf_(v[in][0]), sigmoidf_(v[in][1])); o.y = pack2(sigmoidf_(v[in][2]), sigmoidf_(v[in][3]));
                        *(uint2*)(WSP(bf16_t, OFF_GS) + ((((size_t)(mt * 192 + (G - 106)) * 16 + (ml >> 4)) * 64) + lane) * 4) = o; }
                } else if (G >= 74) *(uint2*)(WSP(bf16_t, OFF_SSMG) + ((size_t)(G - 74) * T + row) * 16 + 4 * g) = pack4(v[in]);
                else *(uint2*)(prow_ + 16 * in) = pack4(v[in]);
            }
        }
      }
    }
}

__device__ __forceinline__ void rope_pair(float& a, float& b, int pos, int i, int half) {
    const float freq = powf(10000.0f, -(float)i / (float)half);
    const float ang = (float)pos * freq;
    float sn, cs; sincosf(ang, &sn, &cs);
    const float na = a * cs - b * sn, nb_ = a * sn + b * cs; a = na; b = nb_;
}

constexpr int S5C = 64, NCH = T / S5C;
constexpr size_t S5_ZERO = OFF_WB + WB_EG;
constexpr size_t S5_KTAB = S5_ZERO + 256;
constexpr size_t S5_FTAB = S5_KTAB + (size_t)64 * 64 * 256 * 2;
constexpr size_t S5_GTAB = S5_FTAB + (size_t)64 * 128 * 1024 * 2;
constexpr size_t S5_SINB = S5_GTAB + (size_t)64 * 1024 * 128 * 2;
static_assert(S5_SINB + (size_t)NCH * 64 * 128 * 2 <= OFF_WB + WB_BYTES, "s5 tables overlay");
__device__ __forceinline__ int s5_row(int dir, int j) { return dir == 0 ? j : (j < LC ? LC - 1 - j : T + LC - 1 - j); }
__device__ __forceinline__ void s5_consts(const KP& p, int l, int dir, int g, int lane, float& lr, float& li, float (&bbr)[16], float (&bbi)[16]) {
    const int gi = (l * 2 + dir) * 32 + g, pi = gi * 64 + lane;
    const float are = p.in(I_ARE)[pi], aim = p.in(I_AIM)[pi], dt = expf(p.in(I_LOGDT)[gi]);
    const float mag = expf(are * dt); float sn, cs; sincosf(aim * dt, &sn, &cs);
    lr = mag * cs; li = mag * sn; const float den = are * are + aim * aim;
    const float cr = ((lr - 1.0f) * are + li * aim) / den, ci = (li * are - (lr - 1.0f) * aim) / den;
    const float4* br4 = (const float4*)(p.in(I_BRE) + (size_t)pi * 16); const float4* bi4 = (const float4*)(p.in(I_BIM) + (size_t)pi * 16);
#pragma unroll
    for (int q = 0; q < 4; ++q) { const float4 br = br4[q], bi = bi4[q];
        bbr[4 * q] = cr * br.x - ci * bi.x; bbi[4 * q] = cr * bi.x + ci * br.x; bbr[4 * q + 1] = cr * br.y - ci * bi.y; bbi[4 * q + 1] = cr * bi.y + ci * br.y;
        bbr[4 * q + 2] = cr * br.z - ci * bi.z; bbi[4 * q + 2] = cr * bi.z + ci * br.z; bbr[4 * q + 3] = cr * br.w - ci * bi.w; bbi[4 * q + 3] = cr * bi.w + ci * br.w; }
}
__device__ __forceinline__ void s5_unpack(uint4 a, uint4 b, float (&u)[16]) {
    u[0] = bflo(a.x); u[1] = bfhi(a.x); u[2] = bflo(a.y); u[3] = bfhi(a.y); u[4] = bflo(a.z); u[5] = bfhi(a.z); u[6] = bflo(a.w); u[7] = bfhi(a.w);
    u[8] = bflo(b.x); u[9] = bfhi(b.x); u[10] = bflo(b.y); u[11] = bfhi(b.y); u[12] = bflo(b.z); u[13] = bfhi(b.z); u[14] = bflo(b.w); u[15] = bfhi(b.w);
}
__device__ __forceinline__ void st_s5_local(const KP& p, int l, int bid, int nb) {
    const int tidx = opaque_tid();
    const int lane = tidx & 63, wid = tidx >> 6;
    const bf16_t* P = WSP(bf16_t, OFF_P); float2* F = WSP(float2, OFF_S5);
    const int gw = bid * NWV + wid, nw = nb * NWV;
    if (gw >= (nw / 64) * 64) return;
    const int gd = gw & 63, dir = gd >> 5, g = gd & 31, part = gw >> 6, nparts = nw >> 6;
    if (part >= 4) return;
    float lr, li, bbr[16], bbi[16]; s5_consts(p, l, dir, g, lane, lr, li, bbr, bbi);
    for (int c = part; c < 4; c += nparts) {
        float sr = 0.f, si = 0.f;
        for (int j0 = 0; j0 < S5C; j0 += 8) {
            uint4 ua[8], ub[8];
#pragma unroll
            for (int q = 0; q < 8; ++q) { const int r = s5_row(dir, c * S5C + j0 + q); const uint4* up = (const uint4*)SSMU(g, r); ua[q] = up[0]; ub[q] = up[1]; }
#pragma unroll
            for (int q = 0; q < 8; ++q) { float u[16]; s5_unpack(ua[q], ub[q], u);
                float bur = 0.f, bui = 0.f;
#pragma unroll
                for (int cc = 0; cc < 16; ++cc) { bur = fmaf(bbr[cc], u[cc], bur); bui = fmaf(bbi[cc], u[cc], bui); }
                const float nsr = lr * sr - li * si + bur, nsi = lr * si + li * sr + bui; sr = nsr; si = nsi; }
        }
        F[((size_t)(c * 2 + dir) * 32 + g) * 64 + lane] = make_float2(sr, si);
    }
}
__device__ __forceinline__ void st_s5_carry(const KP& p, int l, int bid, int nb, char* lds) {
    const int tidx = opaque_tid();
    float2* F = WSP(float2, OFF_S5); bf16_t* SB = WSP(bf16_t, S5_SINB);
    float4* comp = (float4*)lds;
    constexpr int RUN = 9;
    for (int cb = bid; cb < 256; cb += nb) {
        const int chl = tidx & 15, seg = tidx >> 4, idx = cb * 16 + chl;
        const int gi = l * 64 + (idx >> 6);
        const float are = p.in(I_ARE)[gi * 64 + (idx & 63)], aim = p.in(I_AIM)[gi * 64 + (idx & 63)], dt = expf(p.in(I_LOGDT)[gi]);
        const float mag = expf(are * dt); float sn, cs; sincosf(aim * dt, &sn, &cs);
        float pr = mag * cs, pi_ = mag * sn;
#pragma unroll
        for (int q = 0; q < 6; ++q) { const float nr = pr * pr - pi_ * pi_, ni = 2.f * pr * pi_; pr = nr; pi_ = ni; }
        const int c0 = seg * RUN;
        float2 f[RUN]; float ar = 1.f, ai = 0.f, br = 0.f, bi = 0.f;
#pragma unroll
        for (int q = 0; q < RUN; ++q) { const int c = c0 + q; f[q] = (c < NCH) ? F[(size_t)c * 4096 + idx] : make_float2(0.f, 0.f);
            if (c < NCH) { const float nbr = pr * br - pi_ * bi + f[q].x, nbi = pr * bi + pi_ * br + f[q].y; br = nbr; bi = nbi;
                           const float nar = pr * ar - pi_ * ai, nai = pr * ai + pi_ * ar; ar = nar; ai = nai; } }
        __syncthreads();
        comp[chl * 32 + seg] = make_float4(ar, ai, br, bi);
        __syncthreads();
        float sr = 0.f, si = 0.f;
        for (int j = 0; j < seg; ++j) { const float4 cj = comp[chl * 32 + j]; const float nr = cj.x * sr - cj.y * si + cj.z, ni = cj.x * si + cj.y * sr + cj.w; sr = nr; si = ni; }
#pragma unroll
        for (int q = 0; q < RUN; ++q) { const int c = c0 + q;
            if (c < NCH) { F[(size_t)c * 4096 + idx] = make_float2(sr, si);
                bf16_t* sb = SB + ((size_t)c * 64 + (idx >> 6)) * 128 + (idx & 63); sb[0] = f2bf(sr); sb[64] = f2bf(si);
                const float nr = pr * sr - pi_ * si + f[q].x, ni = pr * si + pi_ * sr + f[q].y; sr = nr; si = ni; } }
    }
    __syncthreads();
}
__device__ __forceinline__ void st_s5_scan(const KP& p, int l, int bid, int nb) {
    const int tidx = opaque_tid();
    const int lane = tidx & 63, wid = tidx >> 6;
    const bf16_t* P = WSP(bf16_t, OFF_P); const float2* F = WSP(float2, OFF_S5);
    const int gw = bid * NWV + wid, nw = nb * NWV;
    if (gw >= (nw / 64) * 64) return;
    const int gd = gw & 63, dir = gd >> 5, g = gd & 31, part = gw >> 6, nparts = nw >> 6;
    if (part >= 4) return;
    float* Yo = dir == 0 ? WSP(float, OFF_OM) : WSP(float, OFF_H);
    float lr, li, bbr[16], bbi[16]; s5_consts(p, l, dir, g, lane, lr, li, bbr, bbi);
    const int gi = (l * 2 + dir) * 32 + g;
    float cre[16], cim[16];
#pragma unroll
    for (int cc = 0; cc < 16; ++cc) { cre[cc] = p.in(I_CRE)[((size_t)gi * 16 + cc) * 64 + lane]; cim[cc] = p.in(I_CIM)[((size_t)gi * 16 + cc) * 64 + lane]; }
    const float dsk = p.in(I_SSMD)[l * 512 + g * 16 + (lane & 15)];
    for (int c = part; c < 4; c += nparts) {
        const float2 s0 = F[((size_t)(c * 2 + dir) * 32 + g) * 64 + lane];
        float sr = s0.x, si = s0.y;
        for (int j0 = 0; j0 < S5C; j0 += 8) {
            uint4 ua[8], ub[8];
#pragma unroll
            for (int q = 0; q < 8; ++q) { const int r = s5_row(dir, c * S5C + j0 + q); const uint4* up = (const uint4*)SSMU(g, r); ua[q] = up[0]; ub[q] = up[1]; }
#pragma unroll
            for (int q = 0; q < 8; ++q) { const int r = s5_row(dir, c * S5C + j0 + q);
                float u[16]; s5_unpack(ua[q], ub[q], u);
                float bur = 0.f, bui = 0.f;
#pragma unroll
                for (int cc = 0; cc < 16; ++cc) { bur = fmaf(bbr[cc], u[cc], bur); bui = fmaf(bbi[cc], u[cc], bui); }
                const float nsr = lr * sr - li * si + bur, nsi = lr * si + li * sr + bui; sr = nsr; si = nsi;
                float t16[16];
#pragma unroll
                for (int cc = 0; cc < 16; ++cc) t16[cc] = cre[cc] * sr - cim[cc] * si;
                float y = transpose_reduce16(t16, lane);
                if (lane < 16) {
                    if (dir == 0) y += dsk * bf2f(SSMU(g, r)[lane]);
                    Yo[(size_t)r * 512 + g * 16 + lane] = y; }
            }
        }
    }
}

__device__ __forceinline__ void st_s5_tables(const KP& p, int l, int bid, int nb, char* lds) {
    const int tidx = opaque_tid();
    float* pwr = (float*)lds; float* pwi = pwr + 65 * 64; float* bbr = pwi + 65 * 64; float* bbi = bbr + 1024; float* cre = bbi + 1024; float* cim = cre + 1024;
    bf16_t* Ktab = WSP(bf16_t, S5_KTAB); bf16_t* Ftab = WSP(bf16_t, S5_FTAB); bf16_t* Gtab = WSP(bf16_t, S5_GTAB);
    if (bid == 0 && tidx < 64) WSP(unsigned, S5_ZERO)[tidx] = 0u;
    for (int item = bid; item < 256; item += nb) {
        const int gd = item >> 2, q = item & 3, dir = gd >> 5, g = gd & 31, gi = (l * 2 + dir) * 32 + g;
        __syncthreads();
        if (tidx < 64) {
            const int pp = tidx, pi = gi * 64 + pp;
            const float are = p.in(I_ARE)[pi], aim = p.in(I_AIM)[pi], dt = expf(p.in(I_LOGDT)[gi]);
            const float mag = expf(are * dt); float sn, cs; sincosf(aim * dt, &sn, &cs);
            const float lr = mag * cs, li = mag * sn, den = are * are + aim * aim;
            const float cr = ((lr - 1.0f) * are + li * aim) / den, ci = (li * are - (lr - 1.0f) * aim) / den;
            for (int c = 0; c < 16; ++c) { const float br = p.in(I_BRE)[(size_t)pi * 16 + c], bi = p.in(I_BIM)[(size_t)pi * 16 + c];
                bbr[pp * 16 + c] = cr * br - ci * bi; bbi[pp * 16 + c] = cr * bi + ci * br; }
            float ar = 1.f, ai = 0.f;
            for (int n = 0; n <= 64; ++n) { pwr[n * 64 + pp] = ar; pwi[n * 64 + pp] = ai; const float nr = ar * lr - ai * li, ni = ar * li + ai * lr; ar = nr; ai = ni; }
        } else {
            for (int i = tidx - 64; i < 1024; i += NTH - 64) { cre[i] = p.in(I_CRE)[(size_t)gi * 1024 + i]; cim[i] = p.in(I_CIM)[(size_t)gi * 1024 + i]; }
        }
        __syncthreads();
        for (int e = 0; e < 8; ++e) {
            const int idx = tidx + NTH * e, tau = 16 * q + (idx >> 8), c = (idx >> 4) & 15, c2 = idx & 15;
            float s = 0.f;
            for (int pp = 0; pp < 64; ++pp) {
                const float xr = cre[c * 64 + pp], xi = cim[c * 64 + pp], wr = pwr[tau * 64 + pp], wi = pwi[tau * 64 + pp];
                const float zr = xr * wr - xi * wi, zi = xr * wi + xi * wr;
                s += zr * bbr[pp * 16 + c2] - zi * bbi[pp * 16 + c2];
            }
            Ktab[(((size_t)gd * 64 + tau) * 16 + c) * 16 + c2] = f2bf(s);
        }
        for (int e = 0; e < 32; ++e) {
            const int idx2 = tidx + NTH * e, n = 32 * q + (idx2 >> 9), k = (idx2 & 511) * 2, pp = n & 63, comp = n >> 6, i = k >> 4, c2 = k & 15;
            const float wr = pwr[(63 - i) * 64 + pp], wi = pwi[(63 - i) * 64 + pp];
            const float b0r = bbr[pp * 16 + c2], b0i = bbi[pp * 16 + c2], b1r = bbr[pp * 16 + c2 + 1], b1i = bbi[pp * 16 + c2 + 1];
            const float v0 = comp ? (wr * b0i + wi * b0r) : (wr * b0r - wi * b0i), v1 = comp ? (wr * b1i + wi * b1r) : (wr * b1r - wi * b1i);
            *(unsigned*)(Ftab + ((size_t)gd * 128 + n) * 1024 + k) = pack2(v0, v1);
        }
        for (int e = 0; e < 32; ++e) {
            const int idx2 = tidx + NTH * e, row = 256 * q + (idx2 >> 6), n = (idx2 & 63) * 2, t = row >> 4, c = row & 15, comp = n >> 6, pp = n & 63;
            float v[2];
#pragma unroll
            for (int h = 0; h < 2; ++h) { const float xr = cre[c * 64 + pp + h], xi = cim[c * 64 + pp + h], wr = pwr[(t + 1) * 64 + pp + h], wi = pwi[(t + 1) * 64 + pp + h];
                v[h] = comp ? -(xr * wi + xi * wr) : (xr * wr - xi * wi); }
            *(unsigned*)(Gtab + ((size_t)gd * 1024 + row) * 128 + n) = pack2(v[0], v[1]);
        }
    }
    __syncthreads();
}
__device__ __forceinline__ void st_s5_fgemm(const KP& p, int bid, int nb, char* lds) {
    const int tidx = opaque_tid();
    const bf16_t* P = WSP(bf16_t, OFF_P); const bf16_t* Ftab = WSP(bf16_t, S5_FTAB); float* F = WSP(float, OFF_S5);
    const int srow = tidx >> 3, gch = (tidx & 7) ^ ((srow >> 1) & 7);
    for (int gd = bid; gd < 64; gd += nb) {
        const int dir = gd >> 5, g = gd & 31;
        acc_t acc; acc_zero(acc);
        gemm_core_g(acc,
            [&](int i, int kt) { const int m = srow + 64 * i, tok = kt * 4 + (gch >> 1); return SSMU(g, s5_row(dir, 64 * (4 + m) + tok)) + 8 * (gch & 1); },
            [&](int i, int kt) { return Ftab + ((size_t)gd * 128 + srow + 64 * i) * 1024 + kt * 64 + gch * 8; }, 16, lds);
        acc_visit(acc, [&](int ml, int nl, f32x4 v) {
            float* dst = F + (((size_t)(4 + ml) * 2 + dir) * 32 + g) * 128 + (nl & 63) * 2 + (nl >> 6);
            dst[0] = v[0]; dst[2] = v[1]; dst[4] = v[2]; dst[6] = v[3]; });
    }
}
__device__ __forceinline__ void st_s5_ygemm(const KP& p, int l, int bid, int nb, char* lds) {
    const int tidx = opaque_tid();
    const bf16_t* P = WSP(bf16_t, OFF_P); const bf16_t* Ktab = WSP(bf16_t, S5_KTAB); const bf16_t* Gtab = WSP(bf16_t, S5_GTAB);
    const bf16_t* Sinb = WSP(bf16_t, S5_SINB); const bf16_t* Zero = WSP(bf16_t, S5_ZERO); bf16_t* Y1 = WSP(bf16_t, OFF_OS);
    const int srow = tidx >> 3, gch = (tidx & 7) ^ ((srow >> 1) & 7);
    for (int u = bid; u < 256; u += nb) {
        const int g = u >> 3, nt = u & 7;
        acc_t acc; acc_zero(acc);
        {   const int gd = g, nkt = 2 * (nt + 1);
            gemm_core_g(acc,
                [&](int i, int kt) { const int m = srow + 64 * i;
                    if (kt < nkt) { const int tok = kt * 4 + (gch >> 1); return SSMU(g, 64 * (4 + m) + tok) + 8 * (gch & 1); }
                    return Sinb + ((size_t)(4 + m) * 64 + gd) * 128 + (kt - nkt) * 64 + gch * 8; },
                [&](int i, int kt) { const int n = nt * 128 + srow + 64 * i, t = n >> 4, c = n & 15;
                    if (kt < nkt) { const int tau = t - (kt * 4 + (gch >> 1)); return tau >= 0 ? Ktab + (((size_t)gd * 64 + tau) * 16 + c) * 16 + 8 * (gch & 1) : Zero; }
                    return Gtab + ((size_t)gd * 1024 + n) * 128 + (kt - nkt) * 64 + gch * 8; }, nkt + 2, lds); }
        {   const int gd = 32 + g, nkt = 2 * (8 - nt);
            gemm_core_g(acc,
                [&](int i, int kt) { const int m = srow + 64 * i, cx = 259 - m;
                    if (kt < nkt) { const int tok = kt * 4 + (gch >> 1); return SSMU(g, T + LC - 1 - (64 * cx + tok)) + 8 * (gch & 1); }
                    return Sinb + ((size_t)cx * 64 + gd) * 128 + (kt - nkt) * 64 + gch * 8; },
                [&](int i, int kt) { const int n = nt * 128 + srow + 64 * i, t = 63 - (n >> 4), c = n & 15;
                    if (kt < nkt) { const int tau = t - (kt * 4 + (gch >> 1)); return tau >= 0 ? Ktab + (((size_t)gd * 64 + tau) * 16 + c) * 16 + 8 * (gch & 1) : Zero; }
                    return Gtab + ((size_t)gd * 1024 + t * 16 + c) * 128 + (kt - nkt) * 64 + gch * 8; }, nkt + 2, lds); }
        acc_visit(acc, [&](int ml, int nl, f32x4 v) {
            const int n = nt * 128 + nl, t = n >> 4, c0 = n & 15, r = 64 * (4 + ml) + t;
            const float4 dsk = *(const float4*)(p.in(I_SSMD) + l * 512 + g * 16 + c0); const uint2 ur = *(const uint2*)(SSMU(g, r) + c0);
            uint2 o; o.x = pack2(gelu_tanh(v[0] + dsk.x * bflo(ur.x)), gelu_tanh(v[1] + dsk.y * bfhi(ur.x))); o.y = pack2(gelu_tanh(v[2] + dsk.z * bflo(ur.y)), gelu_tanh(v[3] + dsk.w * bfhi(ur.y)));
            *(uint2*)(Y1 + (size_t)r * 512 + g * 16 + c0) = o; });
    }
}
__device__ __forceinline__ void st_s5_ctx_y(const KP& p, int l, int bid, int nb) {
    const int tidx = opaque_tid();
    const bf16_t* P = WSP(bf16_t, OFF_P); const bf16_t* Ktab = WSP(bf16_t, S5_KTAB); const bf16_t* Gtab = WSP(bf16_t, S5_GTAB);
    const float* SIN = WSP(float, OFF_S5); bf16_t* Y1 = WSP(bf16_t, OFF_OS);
    for (int idx = bid * NTH + tidx; idx < 32 * 256 * 16; idx += nb * NTH) {
        const int ch = idx & 15, r = (idx >> 4) & 255, g = idx >> 12;
        float y = p.in(I_SSMD)[l * 512 + g * 16 + ch] * bf2f(SSMU(g, r)[ch]);
#pragma unroll 1
        for (int dir = 0; dir < 2; ++dir) {
            const int gd = dir * 32 + g, j = dir == 0 ? r : (LC - 1 - r), cx = j >> 6, t = j & 63;
            const bf16_t* kt_ = Ktab + ((size_t)gd * 64 * 16 + ch) * 16;
            float a = 0.f;
            for (int i = 0; i <= t; ++i) {
                const int jr = 64 * cx + i, rr = dir == 0 ? jr : (LC - 1 - jr);
                const uint4* up = (const uint4*)SSMU(g, rr); const uint4* kp = (const uint4*)(kt_ + (size_t)(t - i) * 256);
                a = dot8(up[0], kp[0], a); a = dot8(up[1], kp[1], a);
            }
            const bf16_t* gp = Gtab + ((size_t)gd * 1024 + t * 16 + ch) * 128; const float* sp = SIN + (((size_t)cx * 2 + dir) * 32 + g) * 128;
            for (int q = 0; q < 64; q += 2) { const unsigned gre = *(const unsigned*)(gp + q), gim = *(const unsigned*)(gp + 64 + q); const float4 s4 = *(const float4*)(sp + 2 * q);
                a = fmaf(bflo(gre), s4.x, a); a = fmaf(bflo(gim), s4.y, a); a = fmaf(bfhi(gre), s4.z, a); a = fmaf(bfhi(gim), s4.w, a); }
            y += a;
        }
        Y1[(size_t)r * 512 + g * 16 + ch] = f2bf(gelu_tanh(y));
    }
}
__device__ __forceinline__ void st_s5_fin(const KP& p, int bid, int nb) {
    const int tidx = opaque_tid();
    const float* Yf = WSP(float, OFF_OM); const float* Yb = WSP(float, OFF_H); bf16_t* P = WSP(bf16_t, OFF_P);
    for (long idx = (long)bid * NTH + tidx; idx < (long)T * 512; idx += (long)nb * NTH) {
        const int r = (int)(idx >> 9), c = (int)(idx & 511);
        P[(size_t)r * PP + C_SSM + c] = f2bf(gelu_tanh(Yf[idx] + Yb[idx]));
    }
}

template <int SET>
__device__ __forceinline__ void st_proj2(const KP& p, int l, int bid, int nb, char* lds) {
    const int tidx = opaque_tid();
    bf16_t* P = WSP(bf16_t, OFF_P);
    const bf16_t* Wuq = WSP(bf16_t, OFF_WB + WB_UQ); bf16_t* Qm = WSP(bf16_t, OFF_H);
    const bf16_t* Wukv = WSP(bf16_t, OFF_WB + WB_UKV); bf16_t* Kn = WSP(bf16_t, OFF_KN); bf16_t* Vm = WSP(bf16_t, OFF_V);
    const bf16_t* Wglu = WSP(bf16_t, OFF_WB + WB_GLU); bf16_t* Os = WSP(bf16_t, OFF_OS); const float* bg = p.in(I_BGLU) + l * 512;
    int mt, ntv;
    for (int it = 0; dense_tile(it, SET == 0 ? 14 : 4, SET == 0 || l + 1 < NL, bid, nb, mt, ntv); ++it) {
        if (SET == 1) ntv += 14;
        const int which = ntv < 6 ? 0 : (ntv < 14 ? 1 : 2), nt = ntv - (which == 0 ? 0 : (which == 1 ? 6 : 14));
        const int K = which == 0 ? 256 : (which == 1 ? 128 : 512);
        const bf16_t* abase = which == 2 ? (const bf16_t*)Os + (size_t)mt * 256 * 512 : P + (size_t)mt * 256 * PP + (which == 0 ? C_CQ : C_CKV);
        const int apitch = which == 2 ? 512 : PP;
        const bf16_t* wbase = (which == 0 ? Wuq : (which == 1 ? Wukv : Wglu)) + (size_t)nt * 128 * K;
        acc_t acc; acc_zero(acc);
        gemm_core(acc, [&](int r) { return abase + (size_t)r * apitch; }, [&](int r) { return wbase + (size_t)r * K; }, K, lds);
        if (which == 0) {
            const float* ssq = WSP(float, OFF_SSQ); const float2* t8 = WSP(float2, OFF_ROPE) + 256 * 16;
            const int lane_ = tidx & 63, wid_ = tidx >> 6, wm_ = wid_ >> 1, wn_ = wid_ & 1, fr_ = lane_ & 15, g_ = lane_ >> 4;
#pragma unroll
            for (int im = 0; im < 4; ++im) {
                const int row = mt * 256 + wm_ * 64 + 16 * im + fr_;
                const float4 s4 = *(const float4*)(ssq + (size_t)row * 8);
                const float sc = rsqrtf(((s4.x + s4.y) + (s4.z + s4.w)) * (1.0f / 256.0f) + EPS) * SC_MLA;
                const bool lat = row >= LC; const int tpos = row - LC, prow = lat ? (tpos >> 6) : 0, pcol = lat ? (tpos & 63) : 0;
#pragma unroll
                for (int in = 0; in < 4; ++in) {
                    f32x4 v = acc[in][im] * sc;
                    if (((nt * 4 + wn_ * 2 + (in >> 1)) % 3) == 2) {
                        f32x4 o; o[0] = __shfl_xor(v[0], 32); o[1] = __shfl_xor(v[1], 32); o[2] = __shfl_xor(v[2], 32); o[3] = __shfl_xor(v[3], 32);
                        if (lat) { const float4* cs = (const float4*)(t8 + ((in & 1) == 0 ? prow : pcol) * 8 + 4 * (g_ & 1));
                            const float4 c01 = cs[0], c23 = cs[1];
                            if (g_ < 2) { v[0] = v[0] * c01.x - o[0] * c01.y; v[1] = v[1] * c01.z - o[1] * c01.w; v[2] = v[2] * c23.x - o[2] * c23.y; v[3] = v[3] * c23.z - o[3] * c23.w; }
                            else { v[0] = o[0] * c01.y + v[0] * c01.x; v[1] = o[1] * c01.w + v[1] * c01.z; v[2] = o[2] * c23.y + v[2] * c23.x; v[3] = o[3] * c23.w + v[3] * c23.z; } }
                    }
                    *(uint2*)(Qm + (size_t)row * 768 + nt * 128 + wn_ * 64 + 16 * in + 4 * g_) = pack4(v);
                }
            }
        } else if (which == 1) {
            const float* ssq = WSP(float, OFF_SSQ);
            acc_visit(acc, [&](int ml, int nl, f32x4 v) {
                const float2 s2 = *(const float2*)(ssq + (size_t)(mt * 256 + ml) * 8 + 4);
                const float sc = rsqrtf((s2.x + s2.y) * (1.0f / 128.0f) + EPS);
                bf16_t* dst = (nl < 64) ? (Kn + (size_t)(mt * 256 + ml) * 512 + nt * 64 + nl) : (Vm + (size_t)(mt * 256 + ml) * 512 + nt * 64 + nl - 64);
                *(uint2*)dst = pack4(v * sc); });
        } else {
            acc_visit(acc, [&](int ml, int nl, f32x4 v) {
                const int n = nt * 128 + nl;
                const uint2 yr = *(const uint2*)(Os + (size_t)(mt * 256 + ml) * 512 + n); const float4 b4 = *(const float4*)(bg + n);
                uint2 o; o.x = pack2(bflo(yr.x) * sigmoidf_(v[0] + b4.x), bfhi(yr.x) * sigmoidf_(v[1] + b4.y));
                o.y = pack2(bflo(yr.y) * sigmoidf_(v[2] + b4.z), bfhi(yr.y) * sigmoidf_(v[3] + b4.w));
                *(uint2*)(P + (size_t)(mt * 256 + ml) * PP + C_SSM + n) = o; });
        }
    }
}
__device__ __forceinline__ void st_ropeq(const KP& p, int bid, int nb, char* lds) {
    const int tidx = opaque_tid();
    {   const int lane = tidx & 63, wid = tidx >> 6;
        const bf16_t* Kn = WSP(bf16_t, OFF_KN); const bf16_t* P = WSP(bf16_t, OFF_P);
        float runmax = 0.f;
        for (int r = bid * NWV + wid; r < T; r += nb * NWV) {
            const uint4 kv = *(const uint4*)(Kn + (size_t)r * 512 + lane * 8);
            float s = bflo(kv.x) * bflo(kv.x) + bfhi(kv.x) * bfhi(kv.x) + bflo(kv.y) * bflo(kv.y) + bfhi(kv.y) * bfhi(kv.y)
                    + bflo(kv.z) * bflo(kv.z) + bfhi(kv.z) * bfhi(kv.z) + bflo(kv.w) * bflo(kv.w) + bfhi(kv.w) * bfhi(kv.w);
            s += __shfl_xor(s, 1); s += __shfl_xor(s, 2); s += __shfl_xor(s, 4);
            float sr = 0.f;
            if (lane < 4) { const uint4 rv = *(const uint4*)(P + (size_t)r * PP + C_KR + lane * 8);
                sr = bflo(rv.x) * bflo(rv.x) + bfhi(rv.x) * bfhi(rv.x) + bflo(rv.y) * bflo(rv.y) + bfhi(rv.y) * bfhi(rv.y)
                   + bflo(rv.z) * bflo(rv.z) + bfhi(rv.z) * bfhi(rv.z) + bflo(rv.w) * bflo(rv.w) + bfhi(rv.w) * bfhi(rv.w); }
            sr += __shfl_xor(sr, 1); sr += __shfl_xor(sr, 2);
            sr = __shfl(sr, 0);
            runmax = fmaxf(runmax, s + sr);
        }
        unsigned* lmax = (unsigned*)lds;
        __syncthreads();
        if (tidx < 8) lmax[tidx] = 0u;
        __syncthreads();
        if ((lane & 7) == 0) atomicMax(&lmax[lane >> 3], __float_as_uint(runmax));
        __syncthreads();
        if (tidx < 8) atomicMax(WSP(unsigned, OFF_CNT) + 32 + tidx, lmax[tidx]);
    }
}

typedef short s16x4 __attribute__((ext_vector_type(4)));
typedef short v4i16_t __attribute__((ext_vector_type(4)));
typedef __attribute__((address_space(3))) const char* lds_cptr;
__device__ __forceinline__ s16x4 vtr(lds_cptr q) { return __builtin_bit_cast(s16x4, __builtin_amdgcn_ds_read_tr16_b64_v4i16((__attribute__((address_space(3))) v4i16_t*)q)); }
__device__ __forceinline__ unsigned cvtpk(float lo, float hi) { return pack2(lo, hi); }
constexpr int AT_K = 0, AT_V = 8192, AT_KR = 16384, AT_BUF = 20480;

template <int DQK, int VAR = 0>
__device__ __forceinline__ void attn_item(const bf16_t* Q, int qpitch, const bf16_t* KA, int kapitch, const bf16_t* KB, int kbpitch,
                                          const bf16_t* V, int vpitch, int ntiles, float C, bf16_t* O, char* lds) {
    const int tid = opaque_tid(), lane = tid & 63, wid = tid >> 6, r32 = lane & 31, hi = lane >> 5;
    constexpr int ND0 = DQK / 16;
    bf16x8 qr[ND0];
    { const bf16_t* qp = Q + (size_t)(wid * 32 + r32) * qpitch + hi * 8;
#pragma unroll
      for (int d0 = 0; d0 < ND0; ++d0) qr[d0] = *(const bf16x8*)(qp + d0 * 16); }
    const int srow = tid >> 3, sch = tid & 7;
    const bf16_t* gk = KA + (size_t)srow * kapitch + sch * 8;
    const bf16_t* gv = V + (size_t)srow * vpitch + sch * 8;
    const bf16_t* gr = (DQK > 64) ? (KB + (size_t)(tid >> 2) * kbpitch + (tid & 3) * 8) : nullptr;
    const int sk_off = AT_K + srow * 128 + ((sch ^ ((srow >> 1) & 7)) << 4);
    const int sv_off = AT_V + (sch >> 2) * 4096 + srow * 64 + (sch & 3) * 16;
    const int sr_off = AT_KR + (tid >> 2) * 64 + (((tid & 3) ^ (((tid >> 2) >> 2) & 3)) << 4);
    const bool do_r = (DQK > 64) && (tid < 256);
    const int kf_off = AT_K + r32 * 128, ksw = (r32 >> 1) & 7;
    const int rf_off = AT_KR + r32 * 64, rsw = (r32 >> 2) & 3;
    const int vf_off = AT_V + (4 * hi + ((lane & 15) >> 2)) * 64 + ((lane >> 4) & 1) * 32 + (lane & 3) * 8;
    uint4 rk, rv, rr; rr = make_uint4(0, 0, 0, 0);
    rk = *(const uint4*)gk; rv = *(const uint4*)gv; if (do_r) rr = *(const uint4*)gr;
    *(uint4*)(lds + sk_off) = rk; *(uint4*)(lds + sv_off) = rv; if (do_r) *(uint4*)(lds + sr_off) = rr;
    __syncthreads();
    f32x16 o0, o1;
#pragma unroll
    for (int r = 0; r < 16; ++r) { o0[r] = 0.f; o1[r] = 0.f; }
    float mrun = -INFINITY, lrun = 0.f;
    for (int t = 0; t < ntiles; ++t) {
        const char* cur = lds + (VAR == 2 ? 0 : (t & 1)) * AT_BUF; char* nxt = lds + ((t + 1) & 1) * AT_BUF;
        const bool more = (t + 1 < ntiles);
        if (more && VAR != 2) { rk = *(const uint4*)(gk + (size_t)(t + 1) * 64 * kapitch); rv = *(const uint4*)(gv + (size_t)(t + 1) * 64 * vpitch); if (do_r) rr = *(const uint4*)(gr + (size_t)(t + 1) * 64 * kbpitch); }
        f32x16 p0, p1;
#pragma unroll
        for (int r = 0; r < 16; ++r) { p0[r] = 0.f; p1[r] = 0.f; }
#pragma unroll
        for (int d0 = 0; d0 < 4; ++d0) {
            const int co = ((2 * d0 + hi) ^ ksw) << 4;
            const bf16x8 k0 = *(const bf16x8*)(cur + kf_off + co), k1 = *(const bf16x8*)(cur + kf_off + 32 * 128 + co);
            p0 = MFMA32(k0, qr[d0], p0); p1 = MFMA32(k1, qr[d0], p1);
        }
        if (DQK > 64) {
#pragma unroll
            for (int d0 = 4; d0 < ND0; ++d0) {
                const int co = ((2 * (d0 - 4) + hi) ^ rsw) << 4;
                const bf16x8 k0 = *(const bf16x8*)(cur + rf_off + co), k1 = *(const bf16x8*)(cur + rf_off + 32 * 64 + co);
                p0 = MFMA32(k0, qr[d0], p0); p1 = MFMA32(k1, qr[d0], p1);
            }
        }
        if (VAR != 1) {
        float mx = fmaxf(p0[0], p1[0]);
#pragma unroll
        for (int r = 1; r < 16; ++r) mx = fmaxf(mx, fmaxf(p0[r], p1[r]));
        mx = xhalf_max(mx) * C;
        const float mnew = fmaxf(mrun, mx);
        if (__any(mnew > mrun)) {
            const float alpha = __builtin_amdgcn_exp2f(mrun - mnew);
            lrun *= alpha;
#pragma unroll
            for (int r = 0; r < 16; ++r) { o0[r] *= alpha; o1[r] *= alpha; }
            mrun = mnew;
        }
        const float nm = -mrun;
        float ls = 0.f;
#pragma unroll
        for (int r = 0; r < 16; ++r) { p0[r] = __builtin_amdgcn_exp2f(fmaf(p0[r], C, nm)); p1[r] = __builtin_amdgcn_exp2f(fmaf(p1[r], C, nm)); ls += p0[r] + p1[r]; }
        lrun += ls;
        }
#pragma unroll
        for (int s = 0; s < 4; ++s) {
            bf16x8 pf;
            {   unsigned w0, w1, w2, w3;
                if (s < 2) { w0 = cvtpk(p0[8 * s], p0[8 * s + 1]); w1 = cvtpk(p0[8 * s + 2], p0[8 * s + 3]); w2 = cvtpk(p0[8 * s + 4], p0[8 * s + 5]); w3 = cvtpk(p0[8 * s + 6], p0[8 * s + 7]); }
                else { const int s2 = s - 2; w0 = cvtpk(p1[8 * s2], p1[8 * s2 + 1]); w1 = cvtpk(p1[8 * s2 + 2], p1[8 * s2 + 3]); w2 = cvtpk(p1[8 * s2 + 4], p1[8 * s2 + 5]); w3 = cvtpk(p1[8 * s2 + 6], p1[8 * s2 + 7]); }
                uint4 u = make_uint4(w0, w1, w2, w3); pf = __builtin_bit_cast(bf16x8, u); }
            const lds_cptr vb = (lds_cptr)cur + vf_off + s * 1024;
            const s16x4 a0 = vtr(vb), a1 = vtr(vb + 512), b0 = vtr(vb + 4096), b1 = vtr(vb + 4096 + 512);
            const bf16x8 v0 = (bf16x8){a0[0], a0[1], a0[2], a0[3], a1[0], a1[1], a1[2], a1[3]};
            const bf16x8 v1 = (bf16x8){b0[0], b0[1], b0[2], b0[3], b1[0], b1[1], b1[2], b1[3]};
            o0 = MFMA32(v0, pf, o0); o1 = MFMA32(v1, pf, o1);
        }
        if (VAR != 2) { if (more) { *(uint4*)(nxt + sk_off) = rk; *(uint4*)(nxt + sv_off) = rv; if (do_r) *(uint4*)(nxt + sr_off) = rr; }
        __syncthreads(); }
    }
    const float inv = 1.0f / xhalf_sum(lrun);
    bf16_t* op = O + (size_t)(wid * 32 + r32) * 512 + 4 * hi;
#pragma unroll
    for (int rg = 0; rg < 4; ++rg) {
        uint2 a; a.x = pack2(o0[4 * rg] * inv, o0[4 * rg + 1] * inv); a.y = pack2(o0[4 * rg + 2] * inv, o0[4 * rg + 3] * inv);
        uint2 b; b.x = pack2(o1[4 * rg] * inv, o1[4 * rg + 1] * inv); b.y = pack2(o1[4 * rg + 2] * inv, o1[4 * rg + 3] * inv);
        *(uint2*)(op + 8 * rg) = a; *(uint2*)(op + 32 + 8 * rg) = b;
    }
}
#define SBAR() __builtin_amdgcn_sched_barrier(0)
#define PINV(x) asm volatile("" : "+v"(x))
constexpr float ATT_THR = 6.0f;
template <int DQK>
__device__ __forceinline__ void attn_item2(const bf16_t* Q, int qpitch, const bf16_t* KA, int kapitch, const bf16_t* KB, int kbpitch,
                                           const bf16_t* V, int vpitch, int ntiles, bf16_t* O, char* lds) {
    const int tid = opaque_tid(), lane = tid & 63, wid = tid >> 6, r32 = lane & 31, hi = lane >> 5;
    const int wu = __builtin_amdgcn_readfirstlane(wid);
    constexpr int ND0 = DQK / 16, NQK = 2 * ND0;
    constexpr bool ROPE = DQK > 64;
    const int krow = 8 * wu + (lane >> 3);
    const bf16_t* gk = KA + (size_t)krow * kapitch + (((lane & 7) ^ ((krow >> 1) & 7)) << 3);
    const bf16_t* gv = V + (size_t)(16 * (wu & 3) + (lane >> 2)) * vpitch + (wu >> 2) * 32 + (lane & 3) * 8;
    const int rrow = 16 * (wu & 3) + (lane >> 2);
    const bf16_t* gr = ROPE ? (KB + (size_t)rrow * kbpitch + (((lane & 3) ^ ((rrow >> 2) & 3)) << 3)) : nullptr;
    char* dk = lds + AT_K + wu * 1024; char* dv = lds + AT_V + wu * 1024; char* dr = lds + AT_KR + (wu & 3) * 1024;
    auto issue = [&](int t, int slot) {
        GLDS16(gk + (size_t)t * 64 * kapitch, dk + slot * AT_BUF); GLDS16(gv + (size_t)t * 64 * vpitch, dv + slot * AT_BUF);
        if (ROPE) GLDS16(gr + (size_t)t * 64 * kbpitch, dr + slot * AT_BUF);
    };
    asm volatile("s_waitcnt vmcnt(0)" ::: "memory");
    issue(0, 0);
    if (ntiles > 1) issue(1, 1);
    bf16x8 qr[ND0];
    { const bf16_t* qp = Q + (size_t)(wid * 32 + r32) * qpitch + hi * 8;
#pragma unroll
      for (int d0 = 0; d0 < ND0; ++d0) qr[d0] = *(const bf16x8*)(qp + d0 * 16); }
    const int kf_off = AT_K + r32 * 128, ksw = (r32 >> 1) & 7;
    const int rf_off = AT_KR + r32 * 64, rsw = (r32 >> 2) & 3;
    const int vf_off = AT_V + (4 * hi + ((lane & 15) >> 2)) * 64 + ((lane >> 4) & 1) * 32 + (lane & 3) * 8;
    auto kfrag = [&](const char* slot, int g) -> bf16x8 {
        const int d0 = g >> 1, n = g & 1;
        if (d0 < 4) return *(const bf16x8*)(slot + kf_off + n * 32 * 128 + (((2 * d0 + hi) ^ ksw) << 4));
        return *(const bf16x8*)(slot + rf_off + n * 32 * 64 + (((2 * (d0 - 4) + hi) ^ rsw) << 4));
    };
    auto vfrag = [&](const char* slot, int g) -> bf16x8 {
        const lds_cptr vb = (lds_cptr)slot + vf_off + (g >> 1) * 1024 + (g & 1) * 4096;
        const s16x4 a0 = vtr(vb), a1 = vtr(vb + 512);
        return (bf16x8){a0[0], a0[1], a0[2], a0[3], a1[0], a1[1], a1[2], a1[3]};
    };
    f32x16 o0, o1, sA0, sA1, sB0, sB1;
    const f32x16 zero16 = {0.f, 0.f, 0.f, 0.f, 0.f, 0.f, 0.f, 0.f, 0.f, 0.f, 0.f, 0.f, 0.f, 0.f, 0.f, 0.f};
#pragma unroll
    for (int r = 0; r < 16; ++r) { o0[r] = 0.f; o1[r] = 0.f; }
    float mref, lrun = 0.f;
    if (ntiles > 1) asm volatile("s_waitcnt vmcnt(%0)" :: "n"(ROPE ? 3 : 2) : "memory"); else asm volatile("s_waitcnt vmcnt(0)" ::: "memory");
    __builtin_amdgcn_s_barrier();
    {
#pragma unroll
        for (int g = 0; g < NQK; ++g) { const bf16x8 kf = kfrag(lds, g);
            if (g & 1) sA1 = MFMA32(kf, qr[g >> 1], g < 2 ? zero16 : sA1); else sA0 = MFMA32(kf, qr[g >> 1], g < 2 ? zero16 : sA0); }
        float mx = fmaxf(sA0[0], sA1[0]);
#pragma unroll
        for (int r = 1; r < 16; ++r) mx = fmaxf(mx, fmaxf(sA0[r], sA1[r]));
        mref = xhalf_max(mx);
    }
    asm volatile("s_waitcnt vmcnt(0) lgkmcnt(0)" ::: "memory");
    __builtin_amdgcn_s_barrier();
    auto step = [&](auto HN, f32x16& c0, f32x16& c1, f32x16& n0, f32x16& n1, int t) __attribute__((always_inline)) {
        const int sl = t % 3, sl1 = (t + 1) % 3, sl2 = (t + 2) % 3;
        const char* cs = lds + sl * AT_BUF; const char* ns = lds + sl1 * AT_BUF;
        constexpr bool has_next = decltype(HN)::value;
        if (t + 2 < ntiles) issue(t + 2, sl2);
        u32x4 pw[4];
        float ls = 0.f;
        bf16x8 kf;
        if (has_next) kf = kfrag(ns, 0);
        SBAR();
#pragma unroll
        for (int g = 0; g < (NQK > 8 ? NQK : 8); ++g) {
            bf16x8 kcur = kf;
            if (has_next && g + 1 < NQK) kf = kfrag(ns, g + 1);
            SBAR();
            if (g < 8) {
                float e0, e1, e2, e3;
                if (g < 4) { e0 = __builtin_amdgcn_exp2f(c0[4 * g] - mref); e1 = __builtin_amdgcn_exp2f(c0[4 * g + 1] - mref); e2 = __builtin_amdgcn_exp2f(c0[4 * g + 2] - mref); e3 = __builtin_amdgcn_exp2f(c0[4 * g + 3] - mref); }
                else { e0 = __builtin_amdgcn_exp2f(c1[4 * (g - 4)] - mref); e1 = __builtin_amdgcn_exp2f(c1[4 * (g - 4) + 1] - mref); e2 = __builtin_amdgcn_exp2f(c1[4 * (g - 4) + 2] - mref); e3 = __builtin_amdgcn_exp2f(c1[4 * (g - 4) + 3] - mref); }
                ls += (e0 + e1) + (e2 + e3);
                const unsigned w0 = cvtpk(e0, e1), w1 = cvtpk(e2, e3);
                if ((g & 1) == 0) { pw[g >> 1][0] = w0; pw[g >> 1][1] = w1; } else { pw[g >> 1][2] = w0; pw[g >> 1][3] = w1; }
                PINV(ls); PINV(pw[g >> 1]);
            }
            SBAR();
            if (has_next && g < NQK) { if (g & 1) n1 = MFMA32(kcur, qr[g >> 1], g < 2 ? zero16 : n1); else n0 = MFMA32(kcur, qr[g >> 1], g < 2 ? zero16 : n0); }
            SBAR();
        }
        lrun += ls;
        float mx = -INFINITY;
        bf16x8 vf = vfrag(cs, 0);
        SBAR();
#pragma unroll
        for (int g = 0; g < 8; ++g) {
            const bf16x8 vcur = vf;
            if (g + 1 < 8) vf = vfrag(cs, g + 1);
            SBAR();
            if (has_next) {
                if (g < 4) mx = fmaxf(fmaxf(mx, fmaxf(n0[4 * g], n0[4 * g + 1])), fmaxf(n0[4 * g + 2], n0[4 * g + 3]));
                else mx = fmaxf(fmaxf(mx, fmaxf(n1[4 * (g - 4)], n1[4 * (g - 4) + 1])), fmaxf(n1[4 * (g - 4) + 2], n1[4 * (g - 4) + 3]));
                PINV(mx);
            }
            SBAR();
            const bf16x8 pf = __builtin_bit_cast(bf16x8, pw[g >> 1]);
            if (g & 1) o1 = MFMA32(vcur, pf, o1); else o0 = MFMA32(vcur, pf, o0);
            SBAR();
        }
        if (has_next) {
            const float gr_ = xhalf_max(mx) - mref;
            if (__any(gr_ > ATT_THR)) {
                const float d = fmaxf(gr_, 0.f), a = __builtin_amdgcn_exp2f(-d);
                mref += d; lrun *= a;
#pragma unroll
                for (int r = 0; r < 16; ++r) { o0[r] *= a; o1[r] *= a; }
            }
        }
        asm volatile("s_waitcnt vmcnt(0) lgkmcnt(0)" ::: "memory");
        __builtin_amdgcn_s_barrier();
    };
    {   const std::integral_constant<bool, true> yes; const std::integral_constant<bool, false> no;
        int t = 0;
        for (; t + 2 < ntiles; t += 2) { step(yes, sA0, sA1, sB0, sB1, t); step(yes, sB0, sB1, sA0, sA1, t + 1); }
        step(yes, sA0, sA1, sB0, sB1, t); step(no, sB0, sB1, sA0, sA1, t + 1); }
    const float inv = 1.0f / xhalf_sum(lrun);
    bf16_t* op = O + (size_t)(wid * 32 + r32) * 512 + 4 * hi;
#pragma unroll
    for (int rg = 0; rg < 4; ++rg) {
        uint2 a; a.x = pack2(o0[4 * rg] * inv, o0[4 * rg + 1] * inv); a.y = pack2(o0[4 * rg + 2] * inv, o0[4 * rg + 3] * inv);
        uint2 b; b.x = pack2(o1[4 * rg] * inv, o1[4 * rg + 1] * inv); b.y = pack2(o1[4 * rg + 2] * inv, o1[4 * rg + 3] * inv);
        *(uint2*)(op + 8 * rg) = a; *(uint2*)(op + 32 + 8 * rg) = b;
    }
}
constexpr int A3_K = 0, A3_KR = 16384, A3_V = 24576, A3_BYTES = 24576 + 3 * 8192;
template <int DQK>
__device__ __forceinline__ void attn_item3(const bf16_t* Q, int qpitch, const bf16_t* KA, int kapitch, const bf16_t* KB, int kbpitch,
                                           const bf16_t* V, int vpitch, int ntiles, bf16_t* O, char* lds) {
    const int tid = opaque_tid(), lane = tid & 63, wid = tid >> 6, r32 = lane & 31, hi = lane >> 5;
    const bool grpB = __builtin_amdgcn_readfirstlane(wid) >= 4;
    constexpr int ND0 = DQK / 16;
    bf16x8 qr[ND0];
    { const bf16_t* qp = Q + (size_t)(wid * 32 + r32) * qpitch + hi * 8;
#pragma unroll
      for (int d0 = 0; d0 < ND0; ++d0) qr[d0] = *(const bf16x8*)(qp + d0 * 16); }
    const int srow = tid >> 3, sch = tid & 7;
    const bf16_t* gk = KA + (size_t)srow * kapitch + sch * 8;
    const bf16_t* gv = V + (size_t)srow * vpitch + sch * 8;
    const bf16_t* gr = (DQK > 64) ? (KB + (size_t)(tid >> 2) * kbpitch + (tid & 3) * 8) : nullptr;
    const int sk_off = A3_K + srow * 128 + ((sch ^ ((srow >> 1) & 7)) << 4);
    const int sv_off = A3_V + (sch >> 2) * 4096 + srow * 64 + (sch & 3) * 16;
    const int sr_off = A3_KR + (tid >> 2) * 64 + (((tid & 3) ^ (((tid >> 2) >> 2) & 3)) << 4);
    const bool do_r = (DQK > 64) && (tid < 256);
    const int kf_off = A3_K + r32 * 128, ksw = (r32 >> 1) & 7;
    const int rf_off = A3_KR + r32 * 64, rsw = (r32 >> 2) & 3;
    const int vf_off = A3_V + (4 * hi + ((lane & 15) >> 2)) * 64 + ((lane >> 4) & 1) * 32 + (lane & 3) * 8;
    uint4 rk, rv, rr; rr = make_uint4(0, 0, 0, 0);
    rk = *(const uint4*)gk; rv = *(const uint4*)gv; if (do_r) rr = *(const uint4*)gr;
    *(uint4*)(lds + sk_off) = rk; *(uint4*)(lds + sv_off) = rv; if (do_r) *(uint4*)(lds + sr_off) = rr;
    __syncthreads();
    f32x16 o0, o1, p0, p1;
#pragma unroll
    for (int r = 0; r < 16; ++r) { o0[r] = 0.f; o1[r] = 0.f; p0[r] = 0.f; p1[r] = 0.f; }
    float mrun = -INFINITY, lrun = 0.f;
    auto H1 = [&](int t) __attribute__((always_inline)) {
        const char* ks = lds + (t & 1) * 8192; const char* rs = lds + (t & 1) * 4096;
#pragma unroll
        for (int r = 0; r < 16; ++r) { p0[r] = 0.f; p1[r] = 0.f; }
#pragma unroll
        for (int d0 = 0; d0 < 4; ++d0) {
            const int co = ((2 * d0 + hi) ^ ksw) << 4;
            const bf16x8 k0 = *(const bf16x8*)(ks + kf_off + co), k1 = *(const bf16x8*)(ks + kf_off + 32 * 128 + co);
            p0 = MFMA32(k0, qr[d0], p0); p1 = MFMA32(k1, qr[d0], p1);
        }
        if (DQK > 64) {
#pragma unroll
            for (int d0 = 4; d0 < ND0; ++d0) {
                const int co = ((2 * (d0 - 4) + hi) ^ rsw) << 4;
                const bf16x8 k0 = *(const bf16x8*)(rs + rf_off + co), k1 = *(const bf16x8*)(rs + rf_off + 32 * 64 + co);
                p0 = MFMA32(k0, qr[d0], p0); p1 = MFMA32(k1, qr[d0], p1);
            }
        }
        float mx = fmaxf(p0[0], p1[0]);
#pragma unroll
        for (int r = 1; r < 16; ++r) mx = fmaxf(mx, fmaxf(p0[r], p1[r]));
        mx = xhalf_max(mx);
        if (__any(mx > mrun + ATT_THR)) {
            const float mnew = fmaxf(mrun, mx), alpha = __builtin_amdgcn_exp2f(mrun - mnew);
            lrun *= alpha;
#pragma unroll
            for (int r = 0; r < 16; ++r) { o0[r] *= alpha; o1[r] *= alpha; }
            mrun = mnew;
        }
    };
    auto H2 = [&](int t) __attribute__((always_inline)) {
        const char* vs = lds + (t % 3) * 8192;
        float ls = 0.f;
#pragma unroll
        for (int r = 0; r < 16; ++r) { p0[r] = __builtin_amdgcn_exp2f(p0[r] - mrun); p1[r] = __builtin_amdgcn_exp2f(p1[r] - mrun); ls += p0[r] + p1[r]; }
        lrun += ls;
#pragma unroll
        for (int s = 0; s < 4; ++s) {
            bf16x8 pf;
            {   unsigned w0, w1, w2, w3;
                if (s < 2) { w0 = cvtpk(p0[8 * s], p0[8 * s + 1]); w1 = cvtpk(p0[8 * s + 2], p0[8 * s + 3]); w2 = cvtpk(p0[8 * s + 4], p0[8 * s + 5]); w3 = cvtpk(p0[8 * s + 6], p0[8 * s + 7]); }
                else { const int s2 = s - 2; w0 = cvtpk(p1[8 * s2], p1[8 * s2 + 1]); w1 = cvtpk(p1[8 * s2 + 2], p1[8 * s2 + 3]); w2 = cvtpk(p1[8 * s2 + 4], p1[8 * s2 + 5]); w3 = cvtpk(p1[8 * s2 + 6], p1[8 * s2 + 7]); }
                u32x4 u = {w0, w1, w2, w3}; pf = __builtin_bit_cast(bf16x8, u); }
            const lds_cptr vb = (lds_cptr)vs + vf_off + s * 1024;
            const s16x4 a0 = vtr(vb), a1 = vtr(vb + 512), b0 = vtr(vb + 4096), b1 = vtr(vb + 4096 + 512);
            const bf16x8 v0 = (bf16x8){a0[0], a0[1], a0[2], a0[3], a1[0], a1[1], a1[2], a1[3]};
            const bf16x8 v1 = (bf16x8){b0[0], b0[1], b0[2], b0[3], b1[0], b1[1], b1[2], b1[3]};
            o0 = MFMA32(v0, pf, o0); o1 = MFMA32(v1, pf, o1);
        }
    };
#define A3_LOAD(t) do { rk = *(const uint4*)(gk + (size_t)((t) + 1) * 64 * kapitch); rv = *(const uint4*)(gv + (size_t)((t) + 1) * 64 * vpitch); if (do_r) rr = *(const uint4*)(gr + (size_t)((t) + 1) * 64 * kbpitch); } while (0)
#define A3_WRITE(t) do { const int kn = ((t) + 1) & 1, vn = ((t) + 1) % 3; *(uint4*)(lds + kn * 8192 + sk_off) = rk; *(uint4*)(lds + vn * 8192 + sv_off) = rv; if (do_r) *(uint4*)(lds + kn * 4096 + sr_off) = rr; } while (0)
    if (grpB) {
        { const bool more = (1 < ntiles); if (more) A3_LOAD(0); H1(0); if (more) A3_WRITE(0); __syncthreads(); }
        for (int t = 1; t < ntiles; ++t) {
            const bool more = (t + 1 < ntiles);
            if (more) A3_LOAD(t);
            H2(t - 1); H1(t);
            if (more) A3_WRITE(t);
            __syncthreads();
        }
    } else {
        for (int t = 0; t < ntiles; ++t) {
            const bool more = (t + 1 < ntiles);
            if (more) A3_LOAD(t);
            H1(t); H2(t);
            if (more) A3_WRITE(t);
            __syncthreads();
        }
    }
#undef A3_LOAD
#undef A3_WRITE
    if (grpB) H2(ntiles - 1);
    const float inv = 1.0f / xhalf_sum(lrun);
    bf16_t* op = O + (size_t)(wid * 32 + r32) * 512 + 4 * hi;
#pragma unroll
    for (int rg = 0; rg < 4; ++rg) {
        uint2 a; a.x = pack2(o0[4 * rg] * inv, o0[4 * rg + 1] * inv); a.y = pack2(o0[4 * rg + 2] * inv, o0[4 * rg + 3] * inv);
        uint2 b; b.x = pack2(o1[4 * rg] * inv, o1[4 * rg + 1] * inv); b.y = pack2(o1[4 * rg + 2] * inv, o1[4 * rg + 3] * inv);
        *(uint2*)(op + 8 * rg) = a; *(uint2*)(op + 32 + 8 * rg) = b;
    }
    __syncthreads();
}
template <int DQK>
__device__ __forceinline__ void attn_item4(const bf16_t* Q, int qpitch, const bf16_t* KA, int kapitch, const bf16_t* KB, int kbpitch,
                                           const bf16_t* V, int vpitch, int ntiles, float ref_const, float kmax2, bf16_t* O, char* lds) {
    const int tid = opaque_tid(), lane = tid & 63, wid = tid >> 6, r32 = lane & 31, hi = lane >> 5;
    constexpr int ND0 = DQK / 16;
    bf16x8 qr[ND0];
    { const bf16_t* qp = Q + (size_t)(wid * 32 + r32) * qpitch + hi * 8;
#pragma unroll
      for (int d0 = 0; d0 < ND0; ++d0) qr[d0] = *(const bf16x8*)(qp + d0 * 16); }
    float mref = ref_const;
    if (DQK > 64) {
        float qn2 = 0.f;
#pragma unroll
        for (int d0 = 0; d0 < ND0; ++d0)
#pragma unroll
            for (int j = 0; j < 8; ++j) { const float v = bf2f((bf16_t)qr[d0][j]); qn2 = fmaf(v, v, qn2); }
        qn2 = xhalf_sum(qn2);
        mref = sqrtf(qn2 * kmax2) * 1.01f + 0.01f;
    }
    f32x16 negm;
#pragma unroll
    for (int r = 0; r < 16; ++r) negm[r] = -mref;
    const int srow = tid >> 3, sch = tid & 7;
    const bf16_t* gk = KA + (size_t)srow * kapitch + sch * 8;
    const bf16_t* gv = V + (size_t)srow * vpitch + sch * 8;
    const bf16_t* gr = (DQK > 64) ? (KB + (size_t)(tid >> 2) * kbpitch + (tid & 3) * 8) : nullptr;
    const int sk_off = AT_K + srow * 128 + ((sch ^ ((srow >> 1) & 7)) << 4);
    const int sv_off = AT_V + (sch >> 2) * 4096 + srow * 64 + (sch & 3) * 16;
    const int sr_off = AT_KR + (tid >> 2) * 64 + (((tid & 3) ^ (((tid >> 2) >> 2) & 3)) << 4);
    const bool do_r = (DQK > 64) && (tid < 256);
    const int kf_off = AT_K + r32 * 128, ksw = (r32 >> 1) & 7;
    const int rf_off = AT_KR + r32 * 64, rsw = (r32 >> 2) & 3;
    const int vf_off = AT_V + (4 * hi + ((lane & 15) >> 2)) * 64 + ((lane >> 4) & 1) * 32 + (lane & 3) * 8;
    uint4 rk, rv, rr; rr = make_uint4(0, 0, 0, 0);
    rk = *(const uint4*)gk; rv = *(const uint4*)gv; if (do_r) rr = *(const uint4*)gr;
    *(uint4*)(lds + sk_off) = rk; *(uint4*)(lds + sv_off) = rv; if (do_r) *(uint4*)(lds + sr_off) = rr;
    __syncthreads();
    f32x16 o0, o1;
#pragma unroll
    for (int r = 0; r < 16; ++r) { o0[r] = 0.f; o1[r] = 0.f; }
    float lrun = 0.f;
#pragma unroll 1
    for (int t = 0; t < ntiles; ++t) {
        const char* cur = lds + (t & 1) * AT_BUF; char* nxt = lds + ((t + 1) & 1) * AT_BUF;
        const bool more = (t + 1 < ntiles);
        if (more) { rk = *(const uint4*)(gk + (size_t)(t + 1) * 64 * kapitch); rv = *(const uint4*)(gv + (size_t)(t + 1) * 64 * vpitch); if (do_r) rr = *(const uint4*)(gr + (size_t)(t + 1) * 64 * kbpitch); }
        bf16x8 kf[8];
#pragma unroll
        for (int d0 = 0; d0 < 4; ++d0) { const int co = ((2 * d0 + hi) ^ ksw) << 4; kf[2 * d0] = *(const bf16x8*)(cur + kf_off + co); kf[2 * d0 + 1] = *(const bf16x8*)(cur + kf_off + 32 * 128 + co); }
        f32x16 p0, p1;
        p0 = MFMA32(kf[0], qr[0], negm); p1 = MFMA32(kf[1], qr[0], negm);
        p0 = MFMA32(kf[2], qr[1], p0); p1 = MFMA32(kf[3], qr[1], p1);
        if (DQK > 64) {
            __builtin_amdgcn_sched_barrier(0);
#pragma unroll
            for (int d0 = 4; d0 < ND0; ++d0) { const int co = ((2 * (d0 - 4) + hi) ^ rsw) << 4; kf[2 * (d0 - 4)] = *(const bf16x8*)(cur + rf_off + co); kf[2 * (d0 - 4) + 1] = *(const bf16x8*)(cur + rf_off + 32 * 64 + co); }
        }
        p0 = MFMA32(kf[4], qr[2], p0); p1 = MFMA32(kf[5], qr[2], p1);
        p0 = MFMA32(kf[6], qr[3], p0); p1 = MFMA32(kf[7], qr[3], p1);
        if (DQK > 64) {
#pragma unroll
            for (int d0 = 4; d0 < ND0; ++d0) { p0 = MFMA32(kf[2 * (d0 - 4)], qr[d0], p0); p1 = MFMA32(kf[2 * (d0 - 4) + 1], qr[d0], p1); }
        }
        bf16x8 vf[8];
        auto vload = [&](int s) __attribute__((always_inline)) {
            const lds_cptr vb = (lds_cptr)cur + vf_off + s * 1024;
            const s16x4 a0 = vtr(vb), a1 = vtr(vb + 512), b0 = vtr(vb + 4096), b1 = vtr(vb + 4096 + 512);
            vf[2 * s] = (bf16x8){a0[0], a0[1], a0[2], a0[3], a1[0], a1[1], a1[2], a1[3]};
            vf[2 * s + 1] = (bf16x8){b0[0], b0[1], b0[2], b0[3], b1[0], b1[1], b1[2], b1[3]};
        };
        vload(0); vload(1);
        float ls = 0.f;
#pragma unroll
        for (int s = 0; s < 4; ++s) {
            float e[8];
#pragma unroll
            for (int j = 0; j < 8; ++j) e[j] = __builtin_amdgcn_exp2f(s < 2 ? p0[8 * s + j] : p1[8 * (s - 2) + j]);
            ls += ((e[0] + e[1]) + (e[2] + e[3])) + ((e[4] + e[5]) + (e[6] + e[7]));
            u32x4 u = {cvtpk(e[0], e[1]), cvtpk(e[2], e[3]), cvtpk(e[4], e[5]), cvtpk(e[6], e[7])};
            const bf16x8 pf = __builtin_bit_cast(bf16x8, u);
            if (s + 2 < 4) vload(s + 2);
            o0 = MFMA32(vf[2 * s], pf, o0); o1 = MFMA32(vf[2 * s + 1], pf, o1);
        }
        lrun += ls;
        if (more) { *(uint4*)(nxt + sk_off) = rk; *(uint4*)(nxt + sv_off) = rv; if (do_r) *(uint4*)(nxt + sr_off) = rr; }
        __syncthreads();
    }
    const float inv = 1.0f / xhalf_sum(lrun);
    bf16_t* op = O + (size_t)(wid * 32 + r32) * 512 + 4 * hi;
#pragma unroll
    for (int rg = 0; rg < 4; ++rg) {
        uint2 a; a.x = pack2(o0[4 * rg] * inv, o0[4 * rg + 1] * inv); a.y = pack2(o0[4 * rg + 2] * inv, o0[4 * rg + 3] * inv);
        uint2 b; b.x = pack2(o1[4 * rg] * inv, o1[4 * rg + 1] * inv); b.y = pack2(o1[4 * rg + 2] * inv, o1[4 * rg + 3] * inv);
        *(uint2*)(op + 8 * rg) = a; *(uint2*)(op + 32 + 8 * rg) = b;
    }
}
constexpr int A7_K = 0, A7_V = 8192, A7_KR = 16384, A7_BUF = 20480;
template <int DQK>
__device__ __forceinline__ void attn_item7(const bf16_t* Q, int qpitch, const bf16_t* KA, int kapitch, const bf16_t* KB, int kbpitch,
                                           const bf16_t* V, int vpitch, int ntiles, float ref_const, float kmax2, bf16_t* O, char* lds) {
    const int tid = opaque_tid(), lane = tid & 63, wid = tid >> 6, fr = lane & 15, g = lane >> 4;
    constexpr int NKS = DQK / 32;
    bf16x8 qr[2][NKS];
#pragma unroll
    for (int qi = 0; qi < 2; ++qi) { const bf16_t* qp = Q + (size_t)(wid * 32 + 16 * qi + fr) * qpitch + 8 * g;
#pragma unroll
        for (int ks = 0; ks < NKS; ++ks) qr[qi][ks] = *(const bf16x8*)(qp + 32 * ks); }
    f32x4 negm[2];
#pragma unroll
    for (int qi = 0; qi < 2; ++qi) {
        float mref = ref_const;
        if (DQK > 64) {
            float qn2 = 0.f;
#pragma unroll
            for (int ks = 0; ks < NKS; ++ks)
#pragma unroll
                for (int j = 0; j < 8; ++j) { const float v = bf2f((bf16_t)qr[qi][ks][j]); qn2 = fmaf(v, v, qn2); }
            qn2 += __shfl_xor(qn2, 16); qn2 += __shfl_xor(qn2, 32);
            mref = sqrtf(qn2 * kmax2) * 1.01f + 0.01f;
        }
        negm[qi][0] = -mref; negm[qi][1] = -mref; negm[qi][2] = -mref; negm[qi][3] = -mref;
    }
    const int srow = tid >> 3, sch = tid & 7;
    const bf16_t* gk = KA + (size_t)srow * kapitch + sch * 8;
    const bf16_t* gv = V + (size_t)srow * vpitch + sch * 8;
    const bf16_t* gr = (DQK > 64) ? (KB + (size_t)(tid >> 2) * kbpitch + (tid & 3) * 8) : nullptr;
    const int sk_off = A7_K + srow * 128 + ((sch ^ ((srow >> 1) & 7)) << 4);
    const int sv_off = A7_V + (sch >> 1) * 2048 + srow * 32 + (sch & 1) * 16;
    const int sr_off = A7_KR + (tid >> 2) * 64 + ((((tid & 3) + 2 * ((tid >> 2) >> 2)) & 3) << 4);
    const bool do_r = (DQK > 64) && (tid < 256);
    const int kf_off = A7_K + fr * 128, ksw = (fr >> 1) & 7;
    const int rf_off = A7_KR + fr * 64 + (((g + 2 * (fr >> 2)) & 3) << 4);
    const int vf_off = A7_V + (4 * g + (fr >> 2)) * 32 + (fr & 3) * 8;
    uint4 rk, rv, rr; rr = make_uint4(0, 0, 0, 0);
    rk = *(const uint4*)gk; rv = *(const uint4*)gv; if (do_r) rr = *(const uint4*)gr;
    *(uint4*)(lds + sk_off) = rk; *(uint4*)(lds + sv_off) = rv; if (do_r) *(uint4*)(lds + sr_off) = rr;
    __syncthreads();
    f32x4 o[4][2]; float lsum[2] = {0.f, 0.f};
#pragma unroll
    for (int di = 0; di < 4; ++di)
#pragma unroll
        for (int qi = 0; qi < 2; ++qi) { o[di][qi][0] = 0.f; o[di][qi][1] = 0.f; o[di][qi][2] = 0.f; o[di][qi][3] = 0.f; }
#pragma unroll 1
    for (int t = 0; t < ntiles; ++t) {
        const char* cur = lds + (t & 1) * A7_BUF; char* nxt = lds + ((t + 1) & 1) * A7_BUF;
        const bool more = (t + 1 < ntiles);
        if (more) { rk = *(const uint4*)(gk + (size_t)(t + 1) * 64 * kapitch); rv = *(const uint4*)(gv + (size_t)(t + 1) * 64 * vpitch); if (do_r) rr = *(const uint4*)(gr + (size_t)(t + 1) * 64 * kbpitch); }
        f32x4 s[4][2];
#pragma unroll
        for (int ks = 0; ks < NKS; ++ks) {
            bf16x8 kf[4];
#pragma unroll
            for (int kj = 0; kj < 4; ++kj)
                kf[kj] = (ks < 2) ? *(const bf16x8*)(cur + kf_off + kj * 2048 + (((4 * ks + g) ^ ksw) << 4)) : *(const bf16x8*)(cur + rf_off + kj * 1024);
#pragma unroll
            for (int kj = 0; kj < 4; ++kj)
#pragma unroll
                for (int qi = 0; qi < 2; ++qi) s[kj][qi] = MFMA16(kf[kj], qr[qi][ks], ks == 0 ? negm[qi] : s[kj][qi]);
        }
#pragma unroll
        for (int kk = 0; kk < 2; ++kk) {
            bf16x8 vf[4];
#pragma unroll
            for (int di = 0; di < 4; ++di) {
                const lds_cptr vb = (lds_cptr)cur + vf_off + di * 2048 + kk * 1024;
                const s16x4 a0 = vtr(vb), a1 = vtr(vb + 512);
                vf[di] = (bf16x8){a0[0], a0[1], a0[2], a0[3], a1[0], a1[1], a1[2], a1[3]};
            }
            bf16x8 pf[2];
#pragma unroll
            for (int qi = 0; qi < 2; ++qi) {
                float e[8];
#pragma unroll
                for (int j = 0; j < 4; ++j) { e[j] = __builtin_amdgcn_exp2f(s[2 * kk][qi][j]); e[4 + j] = __builtin_amdgcn_exp2f(s[2 * kk + 1][qi][j]); }
                lsum[qi] += ((e[0] + e[1]) + (e[2] + e[3])) + ((e[4] + e[5]) + (e[6] + e[7]));
                u32x4 u = {cvtpk(e[0], e[1]), cvtpk(e[2], e[3]), cvtpk(e[4], e[5]), cvtpk(e[6], e[7])};
                pf[qi] = __builtin_bit_cast(bf16x8, u);
            }
#pragma unroll
            for (int di = 0; di < 4; ++di) { o[di][0] = MFMA16(vf[di], pf[0], o[di][0]); o[di][1] = MFMA16(vf[di], pf[1], o[di][1]); }
        }
        if (more) { *(uint4*)(nxt + sk_off) = rk; *(uint4*)(nxt + sv_off) = rv; if (do_r) *(uint4*)(nxt + sr_off) = rr; }
        __syncthreads();
    }
#pragma unroll
    for (int qi = 0; qi < 2; ++qi) {
        float l = lsum[qi]; l += __shfl_xor(l, 16); l += __shfl_xor(l, 32);
        const float inv = 1.0f / l;
        bf16_t* op = O + (size_t)(wid * 32 + 16 * qi + fr) * 512 + 4 * g;
#pragma unroll
        for (int di = 0; di < 4; ++di) *(uint2*)(op + 16 * di) = pack4(o[di][qi] * inv);
    }
}
__device__ __forceinline__ void attn_dispatch(const KP& p, int ty, int h, int qt, float gqa_ref, char* lds) {
    const bf16_t* P = WSP(bf16_t, OFF_P); const bf16_t* Qm = WSP(bf16_t, OFF_H); const bf16_t* Kn = WSP(bf16_t, OFF_KN); const bf16_t* Vm = WSP(bf16_t, OFF_V);
    const int ntiles = (qt == 0) ? (LC / 64) : (T / 64);
    const size_t r0 = (size_t)qt * 256;
    bf16_t* Om = WSP(bf16_t, OFF_OM); bf16_t* Og = WSP(bf16_t, OFF_OG);
    if (ty == 0) {
        const float kmax2 = __uint_as_float(WSP(unsigned, OFF_CNT)[32 + h]);
        attn_item7<96>(Qm + r0 * 768 + h * 96, 768, Kn + h * 64, 512, P + C_KR, PP, Vm + h * 64, 512, ntiles, 0.f, kmax2, Om + r0 * 512 + h * 64, lds);
    } else
        attn_item7<64>(P + r0 * PP + C_GQ + h * 64, PP, P + C_GK + (h >> 2) * 64, PP, nullptr, 0, P + C_GV + (h >> 2) * 64, PP, ntiles, gqa_ref, 0.f, Og + r0 * 512 + h * 64, lds);
}
__device__ __forceinline__ void st_attn(const KP& p, int l, int bid, int nb, char* lds) {
    const int tidx = opaque_tid();
    float gq = fabsf(p.in(I_GQN)[l * 64 + (tidx & 63)]), gk = fabsf(p.in(I_GKN)[l * 64 + (tidx & 63)]);
#pragma unroll
    for (int o = 32; o > 0; o >>= 1) { gq = fmaxf(gq, __shfl_xor(gq, o)); gk = fmaxf(gk, __shfl_xor(gk, o)); }
    const float gqa_ref = 64.0f * SC_GQA * gq * gk * 1.02f + 0.01f;
    for (int ty = 0; ty < 2; ++ty)
        for (int u = bid; u < 512; u += nb) attn_dispatch(p, ty, u & 7, 1 + (u >> 3), gqa_ref, lds);
    for (int u = bid; u < 16; u += nb) attn_dispatch(p, u >> 3, u & 7, 0, gqa_ref, lds);
}

__device__ __forceinline__ void st_merge(const KP& p, int l, int bid, int nb, char* lds) {
    const int tidx = opaque_tid();
    const bf16_t* P = WSP(bf16_t, OFF_P); bf16_t* Mb = WSP(bf16_t, OFF_H);
    const bf16_t* Wb = WSP(bf16_t, OFF_WB + WB_BR);
    int mt, nt;
    for (int it = 0; dense_tile(it, 8, l + 1 < NL, bid, nb, mt, nt); ++it) {
        acc_t tot; acc_zero(tot);
#pragma unroll 1
        for (int b = 0; b < 3; ++b) {
            const bf16_t* Ob = b == 1 ? P + C_SSM : WSP(bf16_t, b == 0 ? OFF_OM : OFF_OG); const int opitch = b == 1 ? PP : 512;
            acc_t acc; acc_zero(acc);
            gemm_core(acc, [&](int r) { return Ob + (size_t)(mt * 256 + r) * opitch; }, [&](int r) { return Wb + ((size_t)b * 1024 + nt * 128 + r) * 512; }, 512, lds);
            acc_visit_add(acc, tot, [&](int ml, int nl, f32x4 v) {
                const int wm_ = ml >> 6, im_ = (ml >> 4) & 3, fr_ = ml & 15, G_ = b * 64 + nt * 8 + (nl >> 4), g_ = (nl >> 2) & 3;
                const uint2 gr = *(const uint2*)(WSP(bf16_t, OFF_GS) + (((((size_t)(mt * 192 + G_) * 4 + wm_) * 4 + im_) * 64) + g_ * 16 + fr_) * 4);
                f32x4 r; r[0] = bflo(gr.x) * v[0]; r[1] = bfhi(gr.x) * v[1]; r[2] = bflo(gr.y) * v[2]; r[3] = bfhi(gr.y) * v[3];
                return r; });
        }
        acc_visit(tot, [&](int ml, int nl, f32x4 v) { *(uint2*)(Mb + (size_t)(mt * 256 + ml) * 1024 + nt * 128 + nl) = pack4(v); });
    }
}
__device__ __forceinline__ void st_wout(const KP& p, int l, int bid, int nb, char* lds) {
    const int tidx = opaque_tid();
    const bf16_t* Mb = WSP(bf16_t, OFF_H); const bf16_t* Wt = WSP(bf16_t, OFF_WB + WB_OUT); float* Y = WSP(float, OFF_Y);
    int mt, nt;
    for (int it = 0; dense_tile(it, 4, l + 1 < NL, bid, nb, mt, nt); ++it) {
        acc_t acc[2]; acc_zero(acc[0]); acc_zero(acc[1]);
        gemm_core256_dense(acc, Mb + (size_t)mt * 256 * 1024, 1024, Wt + (size_t)nt * 256 * 1024, 1024, 1024, lds);
#pragma unroll
        for (int nh = 0; nh < 2; ++nh)
            acc_visit2(acc[nh], [&](int ml, int nl, f32x4 v) { *(f32x4*)(Y + (size_t)(mt * 256 + ml) * 1024 + nt * 256 + nh * 128 + nl) = v; });
    }
    int* sltok = WSP(int, OFF_SLTOK); float* slw = WSP(float, OFF_SLW); int* cnt = WSP(int, OFF_CNT);
#pragma unroll 1
    for (int i = bid * NTH + tidx; i < TP; i += nb * NTH) { sltok[i] = 0; slw[i] = 0.f; asm volatile("" : "+v"(i)); }
    if (bid == 0 && tidx < 32) cnt[tidx] = 0;
}

__device__ __forceinline__ void st_postmix(const KP& p, int l, int bid, int nb, char* lds) {
    const int tidx = opaque_tid();
    const int lane = tidx & 63, wid = tidx >> 6;
    const float* Y = WSP(float, OFF_Y); bf16_t* H2 = WSP(bf16_t, OFF_H);
    const float* gpost = p.in(I_GPOSTMIX) + l * D; const float* gpre = p.in(I_GPREFFN) + l * D;
    int* toke = WSP(int, OFF_TOKE); float* tokw = WSP(float, OFF_TOKW); int* cnt = WSP(int, OFF_CNT);
    float* wl = (float*)lds; int* hist = (int*)(lds + 20 * 1024 * 4);
    {   const float* wg = p.in(I_WGROUP) + (size_t)l * D * 4; const float* wr = p.in(I_WROUTER) + (size_t)l * D * 16;
        for (int k = tidx; k < 1024; k += NTH) {
            const float4 g4 = *(const float4*)(wg + (size_t)k * 4);
            wl[0 * 1024 + k] = g4.x; wl[1 * 1024 + k] = g4.y; wl[2 * 1024 + k] = g4.z; wl[3 * 1024 + k] = g4.w;
#pragma unroll
            for (int e4 = 0; e4 < 4; ++e4) { const float4 r4 = *(const float4*)(wr + (size_t)k * 16 + e4 * 4);
                wl[(4 + e4 * 4 + 0) * 1024 + k] = r4.x; wl[(4 + e4 * 4 + 1) * 1024 + k] = r4.y; wl[(4 + e4 * 4 + 2) * 1024 + k] = r4.z; wl[(4 + e4 * 4 + 3) * 1024 + k] = r4.w; }
        }
        if (tidx < 16) hist[tidx] = 0;
        __syncthreads(); }
    auto ld = [&](int r, float4 (&y)[4], float4 (&x)[4]) __attribute__((always_inline)) {
        const float* xs = l == 0 ? xrow_in(p, r) : xrow_c(p, r);
#pragma unroll
        for (int i = 0; i < 4; ++i) { y[i] = *(const float4*)(Y + (size_t)r * D + i * 256 + lane * 4); x[i] = *(const float4*)(xs + i * 256 + lane * 4); }
    };
    auto proc = [&](int r, float4 (&y)[4], float4 (&x)[4]) __attribute__((always_inline)) {
        float* xr = xrow(p, r);
        const float* md = WSP(float, OFF_MOD) + (size_t)(l * 2 + (r < LC ? 1 : 0)) * 6144;
        float ss = 0.f;
#pragma unroll
        for (int i = 0; i < 4; ++i) ss += y[i].x * y[i].x + y[i].y * y[i].y + y[i].z * y[i].z + y[i].w * y[i].w;

        ss = wave_sum(ss);
        const float rstd = rsqrtf(ss * (1.0f / D) + EPS);
        float ss2 = 0.f;
#pragma unroll
        for (int i = 0; i < 4; ++i) { const int c = i * 256 + lane * 4;
            const float4 gg = *(const float4*)(gpost + c), ga = *(const float4*)(md + 2048 + c);
            x[i].x += ga.x * y[i].x * rstd * gg.x; x[i].y += ga.y * y[i].y * rstd * gg.y; x[i].z += ga.z * y[i].z * rstd * gg.z; x[i].w += ga.w * y[i].w * rstd * gg.w;
            *(float4*)(xr + c) = x[i];
            ss2 += x[i].x * x[i].x + x[i].y * x[i].y + x[i].z * x[i].z + x[i].w * x[i].w; }
        ss2 = wave_sum(ss2);
        const float rstd2 = rsqrtf(ss2 * (1.0f / D) + EPS);
        float lg[4] = {0.f, 0.f, 0.f, 0.f}, le[16];
#pragma unroll
        for (int e = 0; e < 16; ++e) le[e] = 0.f;
#pragma unroll
        for (int i = 0; i < 4; ++i) { const int c = i * 256 + lane * 4;
            const float4 gg = *(const float4*)(gpre + c), sh = *(const float4*)(md + 3072 + c), sc = *(const float4*)(md + 4096 + c);
            float h[4];
            h[0] = x[i].x * rstd2 * gg.x * (1.f + sc.x) + sh.x; h[1] = x[i].y * rstd2 * gg.y * (1.f + sc.y) + sh.y;
            h[2] = x[i].z * rstd2 * gg.z * (1.f + sc.z) + sh.z; h[3] = x[i].w * rstd2 * gg.w * (1.f + sc.w) + sh.w;
            uint2 o; o.x = pack2(h[0], h[1]); o.y = pack2(h[2], h[3]);
            *(uint2*)(H2 + (size_t)r * D + c) = o;
#pragma unroll
            for (int e = 0; e < 4; ++e) { const float4 w4 = *(const float4*)(wl + e * 1024 + c);
                lg[e] = fmaf(h[0], w4.x, lg[e]); lg[e] = fmaf(h[1], w4.y, lg[e]); lg[e] = fmaf(h[2], w4.z, lg[e]); lg[e] = fmaf(h[3], w4.w, lg[e]); }
#pragma unroll
            for (int e = 0; e < 16; ++e) { const float4 w4 = *(const float4*)(wl + (4 + e) * 1024 + c);
                le[e] = fmaf(h[0], w4.x, le[e]); le[e] = fmaf(h[1], w4.y, le[e]); le[e] = fmaf(h[2], w4.z, le[e]); le[e] = fmaf(h[3], w4.w, le[e]); }
        }
#pragma unroll
        for (int g = 0; g < 4; ++g) lg[g] = wave_sum(lg[g]) + p.in(I_BGROUP)[l * 4 + g];
        const float myle = transpose_reduce16(le, lane) + p.in(I_BROUTER)[l * 16 + (lane & 15)];
        int gs = 0; float gm = lg[0];
#pragma unroll
        for (int g = 1; g < 4; ++g) if (lg[g] > gm) { gm = lg[g]; gs = g; }
        float ls[4];
#pragma unroll
        for (int i = 0; i < 4; ++i) ls[i] = __shfl(myle, gs * 4 + i);
        if (lane == 0) {
            float den = 0.f;
#pragma unroll
            for (int g = 0; g < 4; ++g) den += __expf(lg[g] - gm);
            const float pg = 1.0f / den;
            int i0 = 0; float m0 = ls[0];
#pragma unroll
            for (int i = 1; i < 4; ++i) if (ls[i] > m0) { m0 = ls[i]; i0 = i; }
            int i1 = -1; float m1 = -INFINITY;
#pragma unroll
            for (int i = 0; i < 4; ++i) if (i != i0 && ls[i] > m1) { m1 = ls[i]; i1 = i; }
            const float e1 = __expf(m1 - m0), w0 = pg / (1.f + e1), w1 = pg * e1 / (1.f + e1);
            const int ex0 = gs * 4 + i0, ex1 = gs * 4 + i1;
            toke[r * 2] = ex0; toke[r * 2 + 1] = ex1; tokw[r * 2] = w0; tokw[r * 2 + 1] = w1;
            atomicAdd(&hist[ex0], 1); atomicAdd(&hist[ex1], 1);
        }
        };
    {   const int r0 = (l + 1 < NL ? 0 : LC) + bid * NWV + wid, rs = nb * NWV;
        float4 ya[4], xa[4], yb[4], xb[4];
        if (r0 < T) ld(r0, ya, xa);
        for (int r = r0; r < T; r += 2 * rs) {
            if (r + rs < T) ld(r + rs, yb, xb);
            proc(r, ya, xa);
            if (r + rs < T) { if (r + 2 * rs < T) ld(r + 2 * rs, ya, xa); proc(r + rs, yb, xb); }
        } }
    __syncthreads();
    if (tidx < 16 && hist[tidx] != 0) atomicAdd(&cnt[tidx], hist[tidx]);
}

__device__ __forceinline__ void moe_offsets(const int* cnt, int* off) {
    int a = 0;
#pragma unroll
    for (int e = 0; e < 16; ++e) { off[e] = a; a += (cnt[e] + 255) & ~255; }
    off[16] = a;
}
__device__ __forceinline__ int moe_expert_of(const int* off, int j) {
    int e = 0;
#pragma unroll
    for (int k = 1; k < 16; ++k) e += (j >= off[k]) ? 1 : 0;
    return e;
}
__device__ __forceinline__ void st_moe_build(const KP& p, int l, int bid, int nb, char* lds) {
    const int tidx = opaque_tid();
    int* cnt = WSP(int, OFF_CNT); int* cnt2 = cnt + 16;
    const int* toke = WSP(int, OFF_TOKE); const float* tokw = WSP(float, OFF_TOKW); int* toks = WSP(int, OFF_TOKS);
    int* sltok = WSP(int, OFF_SLTOK); float* slw = WSP(float, OFF_SLW);
    int* lcnt = (int*)lds; int* lbase = lcnt + 16;
    int off[17]; moe_offsets(cnt, off);
    const int first = (l + 1 < NL ? 0 : 2 * LC), total = 2 * T - first, per = (total + nb - 1) / nb;
    const int beg = first + bid * per, end = min(beg + per, 2 * T);
    __syncthreads();
    if (tidx < 16) lcnt[tidx] = 0;
    __syncthreads();
    const int idx = beg + tidx; const bool act = (tidx < per) && (idx < end);
    int e = 0, rank = 0;
    if (act) { e = toke[idx]; rank = atomicAdd(&lcnt[e], 1); }
    __syncthreads();
    if (tidx < 16) lbase[tidx] = lcnt[tidx] ? atomicAdd(&cnt2[tidx], lcnt[tidx]) : 0;
    __syncthreads();
    if (act) {
        int o = 0;
#pragma unroll
        for (int k = 0; k < 16; ++k) o = (e == k) ? off[k] : o;
        const int pos = o + lbase[e] + rank;
        sltok[pos] = idx >> 1; slw[pos] = tokw[idx]; toks[idx] = pos;
    }
}
__device__ __forceinline__ bool moe_tile(int r, int M2, int bid, int nb, int& mt, int& pn) {
    const int x = bid & 7, j = bid >> 3, q = nb >> 5;
    mt = (r * 8 + x) * q + (j % q); pn = j / q;
    return mt < M2 && pn < 4;
}
__device__ __forceinline__ void st_moe_up(const KP& p, int bid, int nb, char* lds) {
    const int tidx = opaque_tid();
    const int* cnt = WSP(int, OFF_CNT); const int* sltok = WSP(int, OFF_SLTOK);
    const bf16_t* H2 = WSP(bf16_t, OFF_H); const bf16_t* Wg = WSP(bf16_t, OFF_WB + WB_EG); bf16_t* Hid = WSP(bf16_t, OFF_HID);
    int off[17]; moe_offsets(cnt, off);
    const int M2 = off[16] >> 8;
    const int srow = tidx >> 3, gch = (tidx & 7) ^ ((srow >> 1) & 7);
    auto upin = [](const char* q) { const unsigned long long v = (unsigned long long)q; const unsigned lo = __builtin_amdgcn_readfirstlane((unsigned)v), hi = __builtin_amdgcn_readfirstlane((unsigned)(v >> 32)); return (const char*)(((unsigned long long)hi << 32) | lo); };
    const unsigned vw = (unsigned)(((srow >> 4) & 1) ? (unsigned)(WB_EU - WB_EG) : 0u) + (unsigned)(((((srow >> 5) & 1) * 16 + (srow & 15)) * 1024 + gch * 8) * 2);
    int mt, pn;
    for (int r = 0; r * 8 * (nb >> 5) < M2; ++r) {
        if (!moe_tile(r, M2, bid, nb, mt, pn)) continue;
        const int e = __builtin_amdgcn_readfirstlane(moe_expert_of(off, mt * 256));
        unsigned xo[2][2];
#pragma unroll
        for (int h = 0; h < 2; ++h)
#pragma unroll
            for (int i = 0; i < 2; ++i) xo[h][i] = (unsigned)sltok[mt * 256 + h * 128 + srow + 64 * i] * 2048u + (unsigned)gch * 16u;
        acc_t acc[2]; acc_zero(acc[0]); acc_zero(acc[1]);
        gemm_core256(acc, [&](int h, int i, int kt) { return (const bf16_t*)(upin((const char*)H2 + kt * 128) + xo[h][i]); },
                     [&](int h, int i, int kt) { return (const bf16_t*)(upin((const char*)Wg + ((size_t)(e * 512 + (2 * pn + h) * 64 + i * 32) * 1024 + kt * 64) * 2) + vw); }, 16, lds);
        const int lane = tidx & 63, wid = tidx >> 6, wr = wid >> 2, wc = wid & 3, fr = lane & 15, g = lane >> 4;
#pragma unroll
        for (int nh = 0; nh < 2; ++nh)
#pragma unroll
            for (int im = 0; im < 4; ++im)
#pragma unroll
                for (int q = 0; q < 2; ++q) {
                    const f32x4 gt = acc[nh][2 * q][im], up = acc[nh][2 * q + 1][im];
                    uint2 o; o.x = pack2(siluf_(gt[0]) * up[0], siluf_(gt[1]) * up[1]); o.y = pack2(siluf_(gt[2]) * up[2], siluf_(gt[3]) * up[3]);
                    *(uint2*)(Hid + (size_t)(mt * 256 + (im >> 1) * 128 + wc * 32 + (im & 1) * 16 + fr) * 512 + (2 * pn + nh) * 64 + wr * 32 + 16 * q + 4 * g) = o;
                }
    }
}
__device__ __forceinline__ void st_moe_down(const KP& p, int bid, int nb, char* lds) {
    const int tidx = opaque_tid();
    const int* cnt = WSP(int, OFF_CNT); const float* slw = WSP(float, OFF_SLW);
    const bf16_t* Hid = WSP(bf16_t, OFF_HID); const bf16_t* Wd = WSP(bf16_t, OFF_WB + WB_ED); bf16_t* Sl = WSP(bf16_t, OFF_SLOTS);
    int off[17]; moe_offsets(cnt, off);
    const int M2 = off[16] >> 8;
    int mt, pn;
    for (int r = 0; r * 8 * (nb >> 5) < M2; ++r) {
        if (!moe_tile(r, M2, bid, nb, mt, pn)) continue;
        const int e = __builtin_amdgcn_readfirstlane(moe_expert_of(off, mt * 256));
        acc_t acc[2]; acc_zero(acc[0]); acc_zero(acc[1]);
        gemm_core256_dense(acc, Hid + (size_t)mt * 256 * 512, 512, Wd + ((size_t)e * 1024 + pn * 256) * 512, 512, 512, lds);
#pragma unroll
        for (int nh = 0; nh < 2; ++nh)
            acc_visit2(acc[nh], [&](int ml, int nl, f32x4 v) {
                const float w = slw[mt * 256 + ml];
                *(uint2*)(Sl + (size_t)(mt * 256 + ml) * 1024 + pn * 256 + nh * 128 + nl) = pack4(v * w); });
    }
}
__device__ __forceinline__ void st_postffn(const KP& p, int l, int bid, int nb) {
    const int tidx = opaque_tid();
    const int lane = tidx & 63, wid = tidx >> 6;
    const bf16_t* Sl = WSP(bf16_t, OFF_SLOTS); const int* toks = WSP(int, OFF_TOKS);
    const float* gpost = p.in(I_GPOSTFFN) + l * D;
    const bool next = (l + 1 < NL);
    bf16_t* Hb = WSP(bf16_t, OFF_H); const float* gpre = p.in(I_GPREMIX) + (next ? l + 1 : l) * D;
    auto ld = [&](int r, uint2 (&a)[4], uint2 (&b)[4], float4 (&x)[4]) __attribute__((always_inline)) {
        const bf16_t* s0 = Sl + (size_t)toks[r * 2] * 1024; const bf16_t* s1 = Sl + (size_t)toks[r * 2 + 1] * 1024; const float* xs = xrow_c(p, r);
#pragma unroll
        for (int i = 0; i < 4; ++i) { const int c = i * 256 + lane * 4; a[i] = *(const uint2*)(s0 + c); b[i] = *(const uint2*)(s1 + c); x[i] = *(const float4*)(xs + c); }
    };
    auto proc = [&](int r, uint2 (&a)[4], uint2 (&b)[4], float4 (&xq)[4]) __attribute__((always_inline)) {
        float* xr = xrow(p, r);
        const float* md = WSP(float, OFF_MOD) + (size_t)(l * 2 + (r < LC ? 1 : 0)) * 6144;
        float v[16]; float ss = 0.f;
#pragma unroll
        for (int i = 0; i < 4; ++i) {
            v[4 * i] = bflo(a[i].x) + bflo(b[i].x); v[4 * i + 1] = bfhi(a[i].x) + bfhi(b[i].x); v[4 * i + 2] = bflo(a[i].y) + bflo(b[i].y); v[4 * i + 3] = bfhi(a[i].y) + bfhi(b[i].y);
            ss += v[4 * i] * v[4 * i] + v[4 * i + 1] * v[4 * i + 1] + v[4 * i + 2] * v[4 * i + 2] + v[4 * i + 3] * v[4 * i + 3]; }
        ss = wave_sum(ss);
        const float rstd = rsqrtf(ss * (1.0f / D) + EPS);
        float4 xs[4]; float ss2 = 0.f;
#pragma unroll
        for (int i = 0; i < 4; ++i) { const int c = i * 256 + lane * 4;
            const float4 gg = *(const float4*)(gpost + c), ga = *(const float4*)(md + 5120 + c); float4 x = xq[i];
            x.x += ga.x * v[4 * i] * rstd * gg.x; x.y += ga.y * v[4 * i + 1] * rstd * gg.y; x.z += ga.z * v[4 * i + 2] * rstd * gg.z; x.w += ga.w * v[4 * i + 3] * rstd * gg.w;
            *(float4*)(xr + c) = x; xs[i] = x; ss2 += x.x * x.x + x.y * x.y + x.z * x.z + x.w * x.w; }
        if (next) {
            ss2 = wave_sum(ss2);
            const float rstd2 = rsqrtf(ss2 * (1.0f / D) + EPS);
            const float* md2 = WSP(float, OFF_MOD) + (size_t)((l + 1) * 2 + (r < LC ? 1 : 0)) * 6144;
#pragma unroll
            for (int i = 0; i < 4; ++i) { const int c = i * 256 + lane * 4;
                const float4 gg = *(const float4*)(gpre + c), sh = *(const float4*)(md2 + c), sc = *(const float4*)(md2 + 1024 + c);
                uint2 o; o.x = pack2(xs[i].x * rstd2 * gg.x * (1.f + sc.x) + sh.x, xs[i].y * rstd2 * gg.y * (1.f + sc.y) + sh.y);
                o.y = pack2(xs[i].z * rstd2 * gg.z * (1.f + sc.z) + sh.z, xs[i].w * rstd2 * gg.w * (1.f + sc.w) + sh.w);
                *(uint2*)(Hb + (size_t)r * D + c) = o; }
        }
    };
    {   const int r0 = (l + 1 < NL ? 0 : LC) + bid * NWV + wid, rs = nb * NWV;
        uint2 aa[4], ab[4], ba[4], bb[4]; float4 xa[4], xb[4];
        if (r0 < T) ld(r0, aa, ab, xa);
        for (int r = r0; r < T; r += 2 * rs) {
            if (r + rs < T) ld(r + rs, ba, bb, xb);
            proc(r, aa, ab, xa);
            if (r + rs < T) { if (r + 2 * rs < T) ld(r + 2 * rs, aa, ab, xa); proc(r + rs, ba, bb, xb); }
        } }
}

__device__ __forceinline__ void gsync(unsigned* bar, unsigned epoch) {
    asm volatile("s_waitcnt vmcnt(0) lgkmcnt(0)" ::: "memory");
    unsigned x = __builtin_amdgcn_readfirstlane(blockIdx.x & 7), nbk = __builtin_amdgcn_readfirstlane(gridDim.x); asm volatile("" : "+s"(x), "+s"(nbk));
    const unsigned gsz = (nbk - x + 7) >> 3, ngrp = nbk < 8 ? nbk : 8;
    __syncthreads();
    if (threadIdx.x == 0) {
        __builtin_amdgcn_fence(__ATOMIC_RELEASE, "agent");
        asm volatile("s_waitcnt vmcnt(0)" ::: "memory");
        const unsigned old = __hip_atomic_fetch_add(bar + 64 * (1 + x), 1u, __ATOMIC_RELAXED, __HIP_MEMORY_SCOPE_AGENT);
        if (old + 1 == epoch * gsz) __hip_atomic_fetch_add(bar, 1u, __ATOMIC_RELAXED, __HIP_MEMORY_SCOPE_AGENT);
        const unsigned target = epoch * ngrp;
        while (__hip_atomic_load(bar, __ATOMIC_RELAXED, __HIP_MEMORY_SCOPE_AGENT) < target) __builtin_amdgcn_s_sleep(1);
        __builtin_amdgcn_fence(__ATOMIC_ACQUIRE, "agent");
        asm volatile("s_waitcnt vmcnt(0)" ::: "memory");
    }
    __syncthreads();
}

__global__ void __launch_bounds__(NTH) k_mega(Params p_unused) {
    KP p; p.k = (kparams_t)__builtin_amdgcn_kernarg_segment_ptr();
    __shared__ __attribute__((aligned(16))) char lds[LDS_BYTES]; float* smem = (float*)lds;
    cg::grid_group grid = cg::this_grid();
    grid.sync();
    const int bid = blockIdx.x, nb = gridDim.x;
    unsigned* bar = WSP(unsigned, OFF_BAR);
#define GS(k) gsync(bar, (unsigned)(k))
    st_prologue(p, bid, nb, smem); st_conv(p, 0, bid, nb, smem); st_s5_tables(p, 0, bid, nb, lds); GS(1);
    st_modulate(p, 0, bid, nb); GS(2);
#pragma unroll 1
    for (int l = 0; l < NL; ++l) {
        st_gemm_in(p, l, bid, nb, lds); GS(2 + 12 * l + 1);
        st_s5_local(p, l, bid, nb); st_s5_fgemm(p, bid, nb, lds); GS(2 + 12 * l + 2);
        st_s5_carry(p, l, bid, nb, lds); st_proj2<0>(p, l, bid, nb, lds); GS(2 + 12 * l + 3);
        st_s5_ygemm(p, l, bid, nb, lds); st_s5_ctx_y(p, l, bid, nb); st_ropeq(p, bid, nb, lds); GS(2 + 12 * l + 4);
        st_proj2<1>(p, l, bid, nb, lds); st_attn(p, l, bid, nb, lds); GS(2 + 12 * l + 5);
        st_merge(p, l, bid, nb, lds); GS(2 + 12 * l + 6);
        st_wout(p, l, bid, nb, lds); st_conv_experts(p, l, bid, nb, smem); GS(2 + 12 * l + 7);
        st_postmix(p, l, bid, nb, lds); GS(2 + 12 * l + 8);
        st_moe_build(p, l, bid, nb, lds); GS(2 + 12 * l + 9);
        st_moe_up(p, bid, nb, lds); GS(2 + 12 * l + 10);
        st_moe_down(p, bid, nb, lds); GS(2 + 12 * l + 11);
        st_postffn(p, l, bid, nb);
        if (l + 1 < NL) { st_conv(p, l + 1, bid, nb, smem); st_s5_tables(p, l + 1, bid, nb, lds); }
        GS(2 + 12 * l + 12);
    }
#undef GS
}

extern "C" void kernel_launch(void* const* d_in, const int* in_sizes, int n_in, void* d_out, int out_size, void* d_ws, size_t ws_size, hipStream_t stream) {
    Params p{};
    for (int i = 0; i < N_IN; ++i) p.in[i] = (const float*)d_in[i];
    p.out = (float*)d_out; p.ws = (char*)d_ws;
    if (ws_size < WS_NEED) { fprintf(stderr, "workspace too small: %zu < %zu\n", ws_size, (size_t)WS_NEED); return; }
    static int grid_blocks = 0;
    if (!grid_blocks) {
        int dev = 0, cus = 0, per_cu = 0;
        hipGetDevice(&dev);
        hipDeviceGetAttribute(&cus, hipDeviceAttributeMultiprocessorCount, dev);
        hipOccupancyMaxActiveBlocksPerMultiprocessor(&per_cu, k_mega, NTH, 0);
        if (per_cu > 1) per_cu = 1;
        if (per_cu < 1) per_cu = 1;
        grid_blocks = cus * per_cu;
    }
    hipMemsetAsync((char*)d_ws + OFF_BAR, 0, BAR_BYTES, stream);
    void* args[] = { &p };
    hipError_t e = hipLaunchCooperativeKernel((void*)k_mega, dim3(grid_blocks), dim3(NTH), args, 0, stream);
    if (e != hipSuccess) fprintf(stderr, "cooperative launch failed: %s (grid %d)\n", hipGetErrorString(e), grid_blocks);
}
```

```cpp
#include <hip/hip_runtime.h>
#include <hip/hip_cooperative_groups.h>
#include <cstdio>
#include <cstdint>
#include <type_traits>
namespace cg = cooperative_groups;


typedef unsigned short bf16_t;
typedef short bf16x8 __attribute__((ext_vector_type(8)));
typedef float f32x16 __attribute__((ext_vector_type(16)));
typedef float f32x4 __attribute__((ext_vector_type(4)));
typedef unsigned u32x4 __attribute__((ext_vector_type(4)));
constexpr int NTH = 512, NWV = 8;
#ifndef REP_CONV
#define REP_CONV 1
#endif
#ifndef REP_G1
#define REP_G1 1
#endif
#ifndef REP_G2
#define REP_G2 1
#endif
#ifndef REP_G3
#define REP_G3 1
#endif
#ifndef REP_S5
#define REP_S5 1
#endif
#ifndef REP_ATTN
#define REP_ATTN 1
#endif

constexpr int D = 1024, S = 16384, LC = 256, T = S + LC, NL = 2;
constexpr int NIN = 4768, NINP = 4864;
constexpr int PP = 1696;
constexpr int C_GQ = 0, C_GK = 512, C_GV = 640, C_CQ = 768, C_CKV = 1024, C_KR = 1152, C_SSM = 1184, C_GATE = 1696;
__host__ __device__ constexpr int win_col_old(int n) {
    return n < 512 ? 928 + n : n < 640 ? 1440 + (n - 512) : n < 768 ? 1568 + (n - 640) : n < 1024 ? (n - 768) : n < 1152 ? 256 + (n - 1024) : n < 1184 ? 384 + (n - 1152) : n < 1696 ? 416 + (n - 1184) : n;
}
constexpr int TP = 2 * T + 16 * 256;
constexpr float EPS = 1e-6f;
constexpr float LOG2E = 1.4426950408889634f;
constexpr float SC_MLA = 0.10206207261596575f * LOG2E, SC_GQA = 0.125f * LOG2E;

enum { I_X = 0, I_C, I_CTX, I_CCTX, I_WMOD, I_BMOD, I_GPREMIX, I_GPOSTMIX, I_GPREFFN, I_GPOSTFFN, I_WIN, I_GCQ, I_GCKV, I_WUQ, I_WUKV,
       I_GQN, I_GKN, I_ARE, I_AIM, I_LOGDT, I_BRE, I_BIM, I_CRE, I_CIM, I_SSMD, I_WGLU, I_BGLU, I_WBRM, I_WBRS, I_WBRG, I_WOUT,
       I_WGROUP, I_BGROUP, I_WROUTER, I_BROUTER, I_WEG, I_WEU, I_WED, N_IN };

constexpr size_t al256(size_t x) { return (x + 255) & ~(size_t)255; }
constexpr size_t WB_IN = 0;
constexpr size_t WB_UQ = WB_IN + (size_t)NINP * 1024 * 2;
constexpr size_t WB_UKV = WB_UQ + (size_t)768 * 256 * 2;
constexpr size_t WB_GLU = WB_UKV + (size_t)1024 * 128 * 2;
constexpr size_t WB_BR = WB_GLU + (size_t)512 * 512 * 2;
constexpr size_t WB_OUT = WB_BR + (size_t)3 * 1024 * 512 * 2;
constexpr size_t WB_EG = WB_OUT + (size_t)1024 * 1024 * 2;
constexpr size_t WB_EU = WB_EG + (size_t)16 * 512 * 1024 * 2;
constexpr size_t WB_ED = WB_EU + (size_t)16 * 512 * 1024 * 2;
constexpr size_t WB_BYTES = WB_ED + (size_t)16 * 1024 * 512 * 2;

constexpr size_t OFF_WB = 0;
constexpr size_t OFF_P = al256(OFF_WB + WB_BYTES);
constexpr size_t P_BYTES = (size_t)T * NIN * 2;
constexpr size_t OFF_GS = OFF_P + (size_t)T * PP * 2;
constexpr size_t OFF_Y = OFF_P;
constexpr size_t OFF_SLOTS = OFF_P;
constexpr size_t OFF_HID = OFF_P + (size_t)TP * 1024 * 2;
constexpr size_t OFF_H = al256(OFF_P + P_BYTES);
constexpr size_t OFF_KN = al256(OFF_H + (size_t)T * 1024 * 2);
constexpr size_t OFF_V = al256(OFF_KN + (size_t)T * 512 * 2);
constexpr size_t OFF_OM = al256(OFF_V + (size_t)T * 512 * 2);
constexpr size_t OFF_OG = OFF_OM + (size_t)T * 512 * 2;
constexpr size_t OFF_OS = OFF_OG + (size_t)T * 512 * 2;
constexpr size_t OFF_XC = al256(OFF_OS + (size_t)T * 512 * 2);
constexpr size_t OFF_MOD = al256(OFF_XC + (size_t)LC * 1024 * 4);
constexpr size_t OFF_TOKE = al256(OFF_MOD + (size_t)NL * 2 * 6144 * 4);
constexpr size_t OFF_TOKW = al256(OFF_TOKE + (size_t)T * 2 * 4);
constexpr size_t OFF_TOKS = al256(OFF_TOKW + (size_t)T * 2 * 4);
constexpr size_t OFF_SLTOK = al256(OFF_TOKS + (size_t)T * 2 * 4);
constexpr size_t OFF_SLW = al256(OFF_SLTOK + (size_t)TP * 4);
constexpr size_t OFF_CNT = al256(OFF_SLW + (size_t)TP * 4);
constexpr size_t OFF_S5 = al256(OFF_CNT + 256);
constexpr size_t OFF_ROPE = al256(OFF_S5 + (size_t)(T / 64) * 4096 * 8);
constexpr size_t OFF_SSQ = al256(OFF_ROPE + 256 * 24 * 8);
constexpr size_t OFF_SSMG = al256(OFF_SSQ + (size_t)T * 8 * 4);
constexpr size_t OFF_BAR = al256(OFF_SSMG + (size_t)32 * T * 16 * 2);
constexpr size_t BAR_BYTES = 4096;
constexpr size_t WS_NEED = al256(OFF_BAR + BAR_BYTES);
static_assert(OFF_HID + (size_t)TP * 512 * 2 <= OFF_P + P_BYTES, "overlay");
static_assert((size_t)T * 1024 * 4 <= P_BYTES, "overlay Y");
static_assert(WS_NEED < 384000000ull, "ws");

struct Params {
    const float* in[N_IN];
    float* out;
    char* ws;
};
typedef const __attribute__((address_space(4))) Params* kparams_t;
struct KP {
    kparams_t k;
    __device__ __forceinline__ const float* in(int i) const { return *(const float* const volatile __attribute__((address_space(4)))*)(&k->in[i]); }
    __device__ __forceinline__ float* out() const { return *(float* const volatile __attribute__((address_space(4)))*)(&k->out); }
    __device__ __forceinline__ char* ws() const { return *(char* const volatile __attribute__((address_space(4)))*)(&k->ws); }
};

__device__ __forceinline__ float bf2f(bf16_t v) { return __uint_as_float(((unsigned)v) << 16); }
typedef __bf16 bf16x2_t __attribute__((ext_vector_type(2)));
__device__ __forceinline__ bf16_t f2bf(float f) { const __bf16 b = (__bf16)f; return __builtin_bit_cast(bf16_t, b); }
__device__ __forceinline__ float bflo(unsigned u) { return __uint_as_float(u << 16); }
__device__ __forceinline__ float bfhi(unsigned u) { return __uint_as_float(u & 0xFFFF0000u); }
__device__ __forceinline__ unsigned pack2(float lo, float hi) { bf16x2_t v; v[0] = (__bf16)lo; v[1] = (__bf16)hi; return __builtin_bit_cast(unsigned, v); }
__device__ __forceinline__ float wave_sum(float v) {
#pragma unroll
    for (int o = 32; o > 0; o >>= 1) v += __shfl_xor(v, o);
    return v;
}
__device__ __forceinline__ float xhalf_max(float m) { auto rr = __builtin_amdgcn_permlane32_swap(__float_as_uint(m), __float_as_uint(m), false, false); return fmaxf(__uint_as_float(rr[0]), __uint_as_float(rr[1])); }
__device__ __forceinline__ float xhalf_sum(float m) { auto rr = __builtin_amdgcn_permlane32_swap(__float_as_uint(m), __float_as_uint(m), false, false); return __uint_as_float(rr[0]) + __uint_as_float(rr[1]); }
__device__ __forceinline__ void rope_tab(float& a, float& b, float2 cs) { const float na = a * cs.x - b * cs.y, nb_ = a * cs.y + b * cs.x; a = na; b = nb_; }
__device__ __forceinline__ float transpose_reduce16(const float (&t16)[16], int lane) {
    float t8[8], t4[4], t2[2];
#pragma unroll
    for (int i = 0; i < 8; ++i) { const float a = t16[2 * i], b = t16[2 * i + 1]; const bool o = lane & 1; const float keep = o ? b : a, send = o ? a : b; t8[i] = keep + __shfl_xor(send, 1); }
#pragma unroll
    for (int i = 0; i < 4; ++i) { const float a = t8[2 * i], b = t8[2 * i + 1]; const bool o = lane & 2; const float keep = o ? b : a, send = o ? a : b; t4[i] = keep + __shfl_xor(send, 2); }
#pragma unroll
    for (int i = 0; i < 2; ++i) { const float a = t4[2 * i], b = t4[2 * i + 1]; const bool o = lane & 4; const float keep = o ? b : a, send = o ? a : b; t2[i] = keep + __shfl_xor(send, 4); }
    float y; { const float a = t2[0], b = t2[1]; const bool o = lane & 8; const float keep = o ? b : a, send = o ? a : b; y = keep + __shfl_xor(send, 8); }
    y += __shfl_xor(y, 16); y += __shfl_xor(y, 32);
    return y;
}
__device__ __forceinline__ float sigmoidf_(float x) { return __builtin_amdgcn_rcpf(1.0f + __builtin_amdgcn_exp2f(-LOG2E * x)); }
__device__ __forceinline__ float siluf_(float x) { return x * __builtin_amdgcn_rcpf(1.0f + __builtin_amdgcn_exp2f(-LOG2E * x)); }
__device__ __forceinline__ float gelu_tanh(float x) {
    const float u = 0.7978845608028654f * (x + 0.044715f * x * x * x);
    return x * __builtin_amdgcn_rcpf(1.0f + __builtin_amdgcn_exp2f(-2.0f * LOG2E * u));
}
__device__ __forceinline__ float dot8(uint4 a, uint4 b, float acc) {
    acc = fmaf(bflo(a.x), bflo(b.x), acc); acc = fmaf(bfhi(a.x), bfhi(b.x), acc);
    acc = fmaf(bflo(a.y), bflo(b.y), acc); acc = fmaf(bfhi(a.y), bfhi(b.y), acc);
    acc = fmaf(bflo(a.z), bflo(b.z), acc); acc = fmaf(bfhi(a.z), bfhi(b.z), acc);
    acc = fmaf(bflo(a.w), bflo(b.w), acc); acc = fmaf(bfhi(a.w), bfhi(b.w), acc);
    return acc;
}
__device__ __forceinline__ float dotrow(const bf16_t* a, const bf16_t* b, int K) {
    float acc = 0.f;
    const uint4* a4 = (const uint4*)a; const uint4* b4 = (const uint4*)b;
    for (int k = 0; k < K / 8; ++k) acc = dot8(a4[k], b4[k], acc);
    return acc;
}

__device__ __forceinline__ int opaque_tid() { int t = threadIdx.x; asm volatile("" : "+v"(t)); return t; }
#define WSP(type, off) ((type*)(p.ws() + (off)))
#define SSMU(g, r) (WSP(const bf16_t, OFF_SSMG) + ((size_t)(g) * T + (r)) * 16)

template <class AF, class BF, class EF>
__device__ __forceinline__ void gemm_naive(int M, int N, int K, AF arow, BF brow, EF epi, int bid, int nb) {
    const int tidx = opaque_tid();
    const long total = (long)M * N;
    for (long idx = (long)bid * NTH + tidx; idx < total; idx += (long)nb * NTH) {
        const int m = (int)(idx / N), n = (int)(idx % N);
        const float acc = dotrow(arow(m), brow(m, n), K);
        epi(m, n, acc);
    }
}

constexpr int G_A_BYTES = 256 * 128, G_W_BYTES = 128 * 128, G_BUF = G_A_BYTES + G_W_BYTES;
constexpr int LDS_BYTES = 3 * G_BUF;
#define MFMA32(a, b, c) __builtin_amdgcn_mfma_f32_32x32x16_bf16(a, b, c, 0, 0, 0)

#define GLDS16(gptr, lptr) __builtin_amdgcn_global_load_lds((const __attribute__((address_space(1))) void*)(gptr), (__attribute__((address_space(3))) void*)(lptr), 16, 0, 0)
typedef f32x4 acc_t[4][4];
#define MFMA16(a, b, c) __builtin_amdgcn_mfma_f32_16x16x32_bf16(a, b, c, 0, 0, 0)
template <class APTR, class WPTR>
__device__ __forceinline__ void gemm_core_g(acc_t& acc, APTR aptr, WPTR wptr, int nk, char* lds) {
    const int tidx = opaque_tid();
    const int tid = tidx, lane = tid & 63, wid = tid >> 6, wm = wid >> 1, wn = wid & 1, fr = lane & 15, g = lane >> 4;
    const int wu = __builtin_amdgcn_readfirstlane(wid);
    char* sdst = lds + wu * 1024;
    const int xoff = (wm * 64 + fr) * 128, woff = G_A_BYTES + (wn * 64 + fr) * 128, sw7 = (fr >> 1) & 7;
    asm volatile("s_waitcnt vmcnt(0)" ::: "memory");
#pragma unroll
    for (int i = 0; i < 4; ++i) GLDS16(aptr(i, 0), sdst + i * 8192);
#pragma unroll
    for (int i = 0; i < 2; ++i) GLDS16(wptr(i, 0), sdst + G_A_BYTES + i * 8192);
    if (nk > 1) {
#pragma unroll
        for (int i = 0; i < 4; ++i) GLDS16(aptr(i, 1), sdst + G_BUF + i * 8192);
#pragma unroll
        for (int i = 0; i < 2; ++i) GLDS16(wptr(i, 1), sdst + G_BUF + G_A_BYTES + i * 8192);
        asm volatile("s_waitcnt vmcnt(6)" ::: "memory");
    } else asm volatile("s_waitcnt vmcnt(0)" ::: "memory");
    __builtin_amdgcn_s_barrier();
    int slot = 0;
    for (int kt = 0; kt < nk; ++kt) {
        const char* cur = lds + slot * G_BUF;
        const int s2 = slot >= 1 ? slot - 1 : 2;
        const bool more2 = (kt + 2 < nk);
        char* nxt = sdst + s2 * G_BUF;
#pragma unroll
        for (int ks = 0; ks < 2; ++ks) {
            const int co = ((ks * 4 + g) ^ sw7) << 4;
            bf16x8 x[4], w[4];
#pragma unroll
            for (int i = 0; i < 4; ++i) { x[i] = *(const bf16x8*)(cur + xoff + i * 16 * 128 + co); w[i] = *(const bf16x8*)(cur + woff + i * 16 * 128 + co); }
#pragma unroll
            for (int in = 0; in < 4; ++in)
#pragma unroll
                for (int im = 0; im < 4; ++im) acc[in][im] = MFMA16(w[in], x[im], acc[in][im]);
            __builtin_amdgcn_sched_barrier(0);
            if (more2) {
                if (ks == 0) { GLDS16(aptr(0, kt + 2), nxt); GLDS16(aptr(1, kt + 2), nxt + 8192); GLDS16(aptr(2, kt + 2), nxt + 2 * 8192); }
                else { GLDS16(aptr(3, kt + 2), nxt + 3 * 8192); GLDS16(wptr(0, kt + 2), nxt + G_A_BYTES); GLDS16(wptr(1, kt + 2), nxt + G_A_BYTES + 8192); }
            }
            __builtin_amdgcn_sched_barrier(0);
        }
        if (more2) asm volatile("s_waitcnt vmcnt(6) lgkmcnt(0)" ::: "memory");
        else asm volatile("s_waitcnt vmcnt(0) lgkmcnt(0)" ::: "memory");
        __builtin_amdgcn_s_barrier();
        slot = slot == 2 ? 0 : slot + 1;
    }
}
template <class AROW, class WROW>
__device__ __forceinline__ void gemm_core(acc_t& acc, AROW arow, WROW wrow, int K, char* lds) {
    const int tidx = opaque_tid();
    const int srow = tidx >> 3, gch = (tidx & 7) ^ ((srow >> 1) & 7);
    const bf16_t* pa[4]; const bf16_t* pw[2];
#pragma unroll
    for (int i = 0; i < 4; ++i) pa[i] = arow(srow + 64 * i) + gch * 8;
#pragma unroll
    for (int i = 0; i < 2; ++i) pw[i] = wrow(srow + 64 * i) + gch * 8;
    gemm_core_g(acc, [&](int i, int kt) { return pa[i] + kt * 64; }, [&](int i, int kt) { return pw[i] + kt * 64; }, K >> 6, lds);
}
__device__ __forceinline__ void acc_zero(acc_t& acc) {
#pragma unroll
    for (int a = 0; a < 4; ++a)
#pragma unroll
        for (int b = 0; b < 4; ++b) { acc[a][b][0] = 0.f; acc[a][b][1] = 0.f; acc[a][b][2] = 0.f; acc[a][b][3] = 0.f; }
}
template <class F>
__device__ __forceinline__ void acc_visit(const acc_t& acc, F f) {
    const int tidx = opaque_tid();
    const int lane = tidx & 63, wid = tidx >> 6, wm = wid >> 1, wn = wid & 1, fr = lane & 15, g = lane >> 4;
#pragma unroll
    for (int in = 0; in < 4; ++in)
#pragma unroll
        for (int im = 0; im < 4; ++im) f(wm * 64 + 16 * im + fr, wn * 64 + 16 * in + 4 * g, acc[in][im]);
}
template <class F>
__device__ __forceinline__ void acc_visit_add(const acc_t& acc, acc_t& tot, F f) {
    const int tidx = opaque_tid();
    const int lane = tidx & 63, wid = tidx >> 6, wm = wid >> 1, wn = wid & 1, fr = lane & 15, g = lane >> 4;
#pragma unroll
    for (int in = 0; in < 4; ++in)
#pragma unroll
        for (int im = 0; im < 4; ++im) tot[in][im] += f(wm * 64 + 16 * im + fr, wn * 64 + 16 * in + 4 * g, acc[in][im]);
}
template <class APTR, class WPTR>
__device__ __forceinline__ void gemm_core256(acc_t (&acc)[2], APTR aptr, WPTR wptr, int nt, char* lds) {
    const int tid = opaque_tid(), lane = tid & 63, wid = tid >> 6, wr = wid >> 2, wc = wid & 3, fr = lane & 15, g = lane >> 4;
    const int wu = __builtin_amdgcn_readfirstlane(wid);
    char* sdst = lds + wu * 1024;
    const int sw7 = (fr >> 1) & 7;
    typedef const __attribute__((address_space(3))) char* l3p; typedef const __attribute__((address_space(3))) bf16x8* l3v;
    l3p wf0 = (l3p)lds + (wr * 64 + fr) * 128 + ((g ^ sw7) << 4); l3p wf1 = (l3p)lds + (wr * 64 + fr) * 128 + (((4 + g) ^ sw7) << 4);
    l3p xf0 = (l3p)lds + 4 * 16384 + (wc * 32 + fr) * 128 + ((g ^ sw7) << 4); l3p xf1 = (l3p)lds + 4 * 16384 + (wc * 32 + fr) * 128 + (((4 + g) ^ sw7) << 4);
    asm volatile("" : "+v"(wf0), "+v"(wf1), "+v"(xf0), "+v"(xf1));
#define C2_SW(b, h) (((b) * 2 + (h)) * 16384)
#define C2_STG_W(b, h, kt) do { GLDS16(wptr(h, 0, kt), sdst + C2_SW(b, h)); GLDS16(wptr(h, 1, kt), sdst + C2_SW(b, h) + 8192); } while (0)
#define C2_STG_X(b, h, kt) do { GLDS16(aptr(h, 0, kt), sdst + 4 * 16384 + C2_SW(b, h)); GLDS16(aptr(h, 1, kt), sdst + 4 * 16384 + C2_SW(b, h) + 8192); } while (0)
#define C2_LDW(b, h) do { _Pragma("unroll") for (int m = 0; m < 4; ++m) { Wt[m][0] = *(l3v)(wf0 + C2_SW(b, h) + m * 2048); Wt[m][1] = *(l3v)(wf1 + C2_SW(b, h) + m * 2048); } } while (0)
#define C2_LDX(dst, b, h) do { _Pragma("unroll") for (int n = 0; n < 2; ++n) { dst[n][0] = *(l3v)(xf0 + C2_SW(b, h) + n * 2048); dst[n][1] = *(l3v)(xf1 + C2_SW(b, h) + n * 2048); } } while (0)
#define C2_MMA(nh, mh, Xf) do { __builtin_amdgcn_s_setprio(1); \
        _Pragma("unroll") for (int m = 0; m < 4; ++m) _Pragma("unroll") for (int n = 0; n < 2; ++n) _Pragma("unroll") for (int k = 0; k < 2; ++k) \
            acc[nh][m][2 * (mh) + n] = MFMA16(Wt[m][k], Xf[n][k], acc[nh][m][2 * (mh) + n]); \
        __builtin_amdgcn_s_setprio(0); } while (0)
#define C2_WV(n) asm volatile("s_waitcnt vmcnt(" #n ")" ::: "memory")
#define C2_WL(n) asm volatile("s_waitcnt lgkmcnt(" #n ")" ::: "memory")
#define C2_BAR __builtin_amdgcn_s_barrier()
#define C2_SCHED __builtin_amdgcn_sched_barrier(0)
    bf16x8 Wt[4][2], X0[2][2], X1[2][2];
    C2_WV(0);
    C2_STG_X(0, 0, 0); C2_STG_W(0, 0, 0); C2_STG_X(0, 1, 0); C2_STG_W(0, 1, 0);
    if (wu >= 4) C2_BAR;
    C2_WV(4); C2_BAR;
    C2_STG_X(1, 0, 1); C2_STG_W(1, 0, 1); C2_STG_X(1, 1, 1);
    C2_WV(6); C2_BAR;
#pragma unroll 1
    for (int t = 0; t < nt - 2; t += 2) {
        C2_LDX(X0, 0, 0); C2_SCHED; C2_LDW(0, 0); C2_STG_W(1, 1, t + 1);
        C2_WL(8); C2_BAR; C2_WL(0); C2_MMA(0, 0, X0); C2_BAR; C2_SCHED;
        C2_LDX(X1, 0, 1); C2_STG_X(0, 0, t + 2);
        C2_BAR; C2_WL(0); C2_MMA(0, 1, X1); C2_BAR;
        C2_LDW(0, 1); C2_STG_W(0, 0, t + 2);
        C2_BAR; C2_WL(0); C2_MMA(1, 0, X0); C2_BAR; C2_SCHED;
        C2_STG_X(0, 1, t + 2);
        C2_WV(6); C2_BAR; C2_MMA(1, 1, X1); C2_BAR;
        C2_LDX(X0, 1, 0); C2_SCHED; C2_LDW(1, 0); C2_STG_W(0, 1, t + 2);
        C2_WL(8); C2_BAR; C2_WL(0); C2_MMA(0, 0, X0); C2_BAR; C2_SCHED;
        C2_LDX(X1, 1, 1); C2_STG_X(1, 0, t + 3);
        C2_BAR; C2_WL(0); C2_MMA(0, 1, X1); C2_BAR;
        C2_LDW(1, 1); C2_STG_W(1, 0, t + 3);
        C2_BAR; C2_WL(0); C2_MMA(1, 0, X0); C2_BAR; C2_SCHED;
        C2_STG_X(1, 1, t + 3);
        C2_WV(6); C2_BAR; C2_MMA(1, 1, X1); C2_BAR;
    }
    {   C2_LDX(X0, 0, 0); C2_LDW(0, 0); C2_STG_W(1, 1, nt - 1);
        C2_BAR; C2_WL(0); C2_MMA(0, 0, X0); C2_BAR;
        C2_LDX(X1, 0, 1); C2_BAR; C2_WL(0); C2_MMA(0, 1, X1); C2_BAR;
        C2_LDW(0, 1); C2_WV(4); C2_BAR; C2_WL(0); C2_MMA(1, 0, X0); C2_MMA(1, 1, X1); C2_BAR; }
    {   C2_LDX(X0, 1, 0); C2_LDW(1, 0); C2_WV(2); C2_BAR; C2_WL(0); C2_MMA(0, 0, X0); C2_BAR;
        C2_LDX(X1, 1, 1); C2_WV(0); C2_BAR; C2_WL(0); C2_MMA(0, 1, X1); C2_BAR;
        C2_LDW(1, 1); C2_BAR; C2_WL(0); C2_MMA(1, 0, X0); C2_MMA(1, 1, X1); C2_BAR; }
    if (wu < 4) C2_BAR;
}
__device__ __forceinline__ void gemm_core256_dense(acc_t (&acc)[2], const bf16_t* xb, int xpitch, const bf16_t* wb, int wpitch, int K, char* lds) {
    const int tidx = opaque_tid();
    const int srow = tidx >> 3, gch = (tidx & 7) ^ ((srow >> 1) & 7);
    const unsigned vx = (unsigned)(srow * xpitch + gch * 8) * 2u, vw = (unsigned)(srow * wpitch + gch * 8) * 2u;
    auto upin = [](const char* q) { const unsigned long long v = (unsigned long long)q; const unsigned lo = __builtin_amdgcn_readfirstlane((unsigned)v), hi = __builtin_amdgcn_readfirstlane((unsigned)(v >> 32)); return (const char*)(((unsigned long long)hi << 32) | lo); };
    gemm_core256(acc, [&](int h, int i, int kt) { return (const bf16_t*)(upin((const char*)xb + ((size_t)(h * 128 + i * 64) * xpitch + kt * 64) * 2) + vx); },
                 [&](int h, int i, int kt) { return (const bf16_t*)(upin((const char*)wb + ((size_t)(h * 128 + i * 64) * wpitch + kt * 64) * 2) + vw); }, K >> 6, lds);
}
template <class F>
__device__ __forceinline__ void acc_visit2(const acc_t& acc, F f) {
    const int tidx = opaque_tid();
    const int lane = tidx & 63, wid = tidx >> 6, wr = wid >> 2, wc = wid & 3, fr = lane & 15, g = lane >> 4;
#pragma unroll
    for (int in = 0; in < 4; ++in)
#pragma unroll
        for (int im = 0; im < 4; ++im) f((im >> 1) * 128 + wc * 32 + (im & 1) * 16 + fr, wr * 64 + 16 * in + 4 * g, acc[in][im]);
}
__device__ __forceinline__ uint2 pack4(f32x4 v) { uint2 o; o.x = pack2(v[0], v[1]); o.y = pack2(v[2], v[3]); return o; }
__device__ __forceinline__ bool dense_tile(int it, int NT, bool with_ctx, int bid, int nb, int& mt, int& nt) {
    const int x = bid & 7, j = bid >> 3, jb = nb >> 3;
    int v = it * jb + j;
    if (v < 8 * NT) { mt = 1 + x * 8 + (v & 7); nt = v >> 3; return true; }
    if (!with_ctx) return false;
    v -= 8 * NT; nt = x + 8 * v; mt = 0;
    return nt < NT;
}

__device__ __forceinline__ void st_prologue(const KP& p, int bid, int nb, float* smem) {
    const int tidx = opaque_tid();
    const int tid = tidx;
    {   float2* t16 = WSP(float2, OFF_ROPE); float2* t8 = t16 + 256 * 16;
        for (int idx = bid * NTH + tid; idx < 256 * 24; idx += nb * NTH) {
            const bool big = idx < 256 * 16; const int j = big ? idx : idx - 256 * 16, half = big ? 16 : 8, pos = j / half, i = j % half;
            const float ang = (float)pos * powf(10000.0f, -(float)i / (float)half);
            float sn, cs; sincosf(ang, &sn, &cs);
            (big ? t16 : t8)[j] = make_float2(cs, sn);
        } }
    for (int k = tid; k < 1024; k += NTH) { smem[k] = siluf_(p.in(I_C)[k]); smem[1024 + k] = siluf_(p.in(I_CCTX)[k]); }
    __syncthreads();
    float* mod = WSP(float, OFF_MOD);
    float4* red = (float4*)(smem + 2048);
    for (int jb = bid; jb < 256; jb += nb) {
        const int l = jb >> 7, j0 = (jb & 127) * 48, jj = tid % 12, kk = tid / 12;
        float4 a0 = make_float4(0.f, 0.f, 0.f, 0.f), a1 = a0;
        if (kk < 42) {
            const float* w = p.in(I_WMOD) + (size_t)l * 1024 * 6144 + j0 + jj * 4;
            for (int k = kk; k < 1024; k += 42) { const float4 wv = *(const float4*)(w + (size_t)k * 6144); const float s0 = smem[k], s1 = smem[1024 + k];
                a0.x = fmaf(s0, wv.x, a0.x); a0.y = fmaf(s0, wv.y, a0.y); a0.z = fmaf(s0, wv.z, a0.z); a0.w = fmaf(s0, wv.w, a0.w);
                a1.x = fmaf(s1, wv.x, a1.x); a1.y = fmaf(s1, wv.y, a1.y); a1.z = fmaf(s1, wv.z, a1.z); a1.w = fmaf(s1, wv.w, a1.w); }
            red[(kk * 12 + jj) * 2] = a0; red[(kk * 12 + jj) * 2 + 1] = a1;
        }
        __syncthreads();
        if (tid < 24) {
            const int cj = tid >> 1, cond = tid & 1;
            float4 s = make_float4(0.f, 0.f, 0.f, 0.f);
            for (int q = 0; q < 42; ++q) { const float4 v = red[(q * 12 + cj) * 2 + cond]; s.x += v.x; s.y += v.y; s.z += v.z; s.w += v.w; }
            const float4 b = *(const float4*)(p.in(I_BMOD) + l * 6144 + j0 + cj * 4);
            s.x += b.x; s.y += b.y; s.z += b.z; s.w += b.w;
            *(float4*)(mod + (size_t)(l * 2 + cond) * 6144 + j0 + cj * 4) = s;
        }
        __syncthreads();
    }
}

template <bool IDN, class COLF, class KSF>
__device__ __forceinline__ void conv_t_g(const float* W, bf16_t* Wt, int K, int N, int Npad, int nmat, int bid, int nb, float* smem, COLF colf, KSF ksf) {
    const int tidx = opaque_tid();
    const int tid = tidx;
    const int tn = Npad / 64, tk = K / 64;
    const int ntile = tn * tk * nmat;
    for (int t = bid; t < ntile; t += nb) {
        const int mat = t / (tn * tk), r = t % (tn * tk), n0 = (r / tk) * 64, k0 = (r % tk) * 64;
        const float* Wm = W + (size_t)mat * K * N; bf16_t* Wtm = Wt + (size_t)mat * Npad * K;
        __syncthreads();
        {
            const int kk = tid >> 4, c4 = (tid & 15) * 4; const bool ok = (n0 + c4 < N); const int sc = ok ? colf(n0 + c4) : 0;
#pragma unroll
            for (int i = 0; i < 2; ++i) { float4 v = make_float4(0.f, 0.f, 0.f, 0.f); if (ok) v = *(const float4*)(Wm + (size_t)(k0 + kk + 32 * i) * N + sc); const float s = ksf(k0 + kk + 32 * i);
                float* d = smem + (kk + 32 * i) * 65 + c4; d[0] = v.x * s; d[1] = v.y * s; d[2] = v.z * s; d[3] = v.w * s; }
        }
        __syncthreads();
        {   const int nn = tid >> 3, kc = (tid & 7) * 8;
            float e[8];
#pragma unroll
            for (int j = 0; j < 8; ++j) e[j] = smem[(kc + j) * 65 + nn];
            uint4 o; o.x = pack2(e[0], e[1]); o.y = pack2(e[2], e[3]); o.z = pack2(e[4], e[5]); o.w = pack2(e[6], e[7]);
            *(uint4*)(Wtm + (size_t)(n0 + nn) * K + k0 + kc) = o; }
    }
    __syncthreads();
}
__device__ __forceinline__ void conv_t(const float* W, bf16_t* Wt, int K, int N, int Npad, int nmat, int bid, int nb, float* smem) {
    conv_t_g<true>(W, Wt, K, N, Npad, nmat, bid, nb, smem, [](int n) { return n; }, [](int) { return 1.0f; });
}
__device__ __forceinline__ void st_conv(const KP& p, int l, int bid, int nb, float* smem) {
    const int tidx = opaque_tid(); (void)tidx;
    bf16_t* wb = WSP(bf16_t, OFF_WB);
    conv_t_g<false>(p.in(I_WIN) + (size_t)l * 1024 * NIN, (bf16_t*)((char*)wb + WB_IN), 1024, NIN, NINP, 1, bid, nb, smem, [](int n) { return win_col_old(n); }, [](int) { return 1.0f; });
    {   const float* gcq = p.in(I_GCQ) + l * 256; const float* gckv = p.in(I_GCKV) + l * 128;
        conv_t_g<true>(p.in(I_WUQ) + (size_t)l * 256 * 768, (bf16_t*)((char*)wb + WB_UQ), 256, 768, 768, 1, bid, nb, smem, [](int n) { return n; }, [&](int k) { return gcq[k]; });
        conv_t_g<true>(p.in(I_WUKV) + (size_t)l * 128 * 1024, (bf16_t*)((char*)wb + WB_UKV), 128, 1024, 1024, 1, bid, nb, smem, [](int n) { return n; }, [&](int k) { return gckv[k]; }); }
    conv_t(p.in(I_WGLU) + (size_t)l * 512 * 512, (bf16_t*)((char*)wb + WB_GLU), 512, 512, 512, 1, bid, nb, smem);
    conv_t(p.in(I_WBRM) + (size_t)l * 512 * 1024, (bf16_t*)((char*)wb + WB_BR), 512, 1024, 1024, 1, bid, nb, smem);
    conv_t(p.in(I_WBRS) + (size_t)l * 512 * 1024, (bf16_t*)((char*)wb + WB_BR + (size_t)1024 * 512 * 2), 512, 1024, 1024, 1, bid, nb, smem);
    conv_t(p.in(I_WBRG) + (size_t)l * 512 * 1024, (bf16_t*)((char*)wb + WB_BR + (size_t)2 * 1024 * 512 * 2), 512, 1024, 1024, 1, bid, nb, smem);
    conv_t(p.in(I_WOUT) + (size_t)l * 1024 * 1024, (bf16_t*)((char*)wb + WB_OUT), 1024, 1024, 1024, 1, bid, nb, smem);
}
__device__ __forceinline__ void st_conv_experts(const KP& p, int l, int bid, int nb, float* smem) {
    const int tidx = opaque_tid(); (void)tidx;
    bf16_t* wb = WSP(bf16_t, OFF_WB);
    conv_t(p.in(I_WEG) + (size_t)l * 16 * 1024 * 512, (bf16_t*)((char*)wb + WB_EG), 1024, 512, 512, 16, bid, nb, smem);
    conv_t(p.in(I_WEU) + (size_t)l * 16 * 1024 * 512, (bf16_t*)((char*)wb + WB_EU), 1024, 512, 512, 16, bid, nb, smem);
    conv_t(p.in(I_WED) + (size_t)l * 16 * 512 * 1024, (bf16_t*)((char*)wb + WB_ED), 512, 1024, 1024, 16, bid, nb, smem);
}

__device__ __forceinline__ const float* xrow_c(const KP& p, int r) { return (r < LC) ? (WSP(float, OFF_XC) + (size_t)r * D) : (p.out() + (size_t)(r - LC) * D); }
__device__ __forceinline__ const float* xrow_in(const KP& p, int r) { return (r < LC) ? (p.in(I_CTX) + (size_t)r * D) : (p.in(I_X) + (size_t)(r - LC) * D); }
__device__ __forceinline__ float* xrow(const KP& p, int r) { return (r < LC) ? (WSP(float, OFF_XC) + (size_t)r * D) : (p.out() + (size_t)(r - LC) * D); }
__device__ __forceinline__ void st_modulate(const KP& p, int l, int bid, int nb) {
    const int tidx = opaque_tid();
    const int lane = tidx & 63, wid = tidx >> 6;
    bf16_t* Hb = WSP(bf16_t, OFF_H);
    const float* g = p.in(I_GPREMIX) + l * D;
    auto ld = [&](int r, float4 (&v)[4]) __attribute__((always_inline)) {
        const float* xr = l == 0 ? xrow_in(p, r) : xrow_c(p, r);
#pragma unroll
        for (int i = 0; i < 4; ++i) v[i] = *(const float4*)(xr + i * 256 + lane * 4);
    };
    auto proc = [&](int r, float4 (&v)[4]) __attribute__((always_inline)) {
        const float* md = WSP(float, OFF_MOD) + (size_t)(l * 2 + (r < LC ? 1 : 0)) * 6144;
        float ss = 0.f;
#pragma unroll
        for (int i = 0; i < 4; ++i) ss += v[i].x * v[i].x + v[i].y * v[i].y + v[i].z * v[i].z + v[i].w * v[i].w;
        ss = wave_sum(ss);
        const float rstd = rsqrtf(ss * (1.0f / D) + EPS);
#pragma unroll
        for (int i = 0; i < 4; ++i) {
            const int c = i * 256 + lane * 4;
            const float4 gg = *(const float4*)(g + c), sh = *(const float4*)(md + c), sc = *(const float4*)(md + 1024 + c);
            const float h0 = v[i].x * rstd * gg.x * (1.f + sc.x) + sh.x, h1 = v[i].y * rstd * gg.y * (1.f + sc.y) + sh.y;
            const float h2 = v[i].z * rstd * gg.z * (1.f + sc.z) + sh.z, h3 = v[i].w * rstd * gg.w * (1.f + sc.w) + sh.w;
            uint2 o; o.x = pack2(h0, h1); o.y = pack2(h2, h3);
            *(uint2*)(Hb + (size_t)r * D + c) = o;
        }
    };
    {   const int r0 = bid * NWV + wid, rs = nb * NWV;
        float4 va[4], vb[4];
        if (r0 < T) ld(r0, va);
        for (int r = r0; r < T; r += 2 * rs) {
            if (r + rs < T) ld(r + rs, vb);
            proc(r, va);
            if (r + rs < T) { if (r + 2 * rs < T) ld(r + 2 * rs, va); proc(r + rs, vb); }
        } }
}

__device__ __forceinline__ void st_gemm_in(const KP& p, int l, int bid, int nb, char* lds) {
    const int tidx = opaque_tid();
    if (bid == 0 && tidx < 8) WSP(unsigned, OFF_CNT)[32 + tidx] = 0u;
    const bf16_t* Hb = WSP(bf16_t, OFF_H); const bf16_t* Wt = WSP(bf16_t, OFF_WB + WB_IN); bf16_t* P = WSP(bf16_t, OFF_P);
    float* ssq = WSP(float, OFF_SSQ); const float2* t16 = WSP(float2, OFF_ROPE); const float2* t8 = t16 + 256 * 16;
    const float* gqn = p.in(I_GQN) + l * 64; const float* gkn = p.in(I_GKN) + l * 64;
    int mt, pn;
    for (int it = 0; dense_tile(it, NINP / 256, true, bid, nb, mt, pn); ++it) {
        acc_t acc2[2]; acc_zero(acc2[0]); acc_zero(acc2[1]);
        gemm_core256_dense(acc2, Hb + (size_t)mt * 256 * 1024, 1024, Wt + (size_t)pn * 256 * 1024, 1024, 1024, lds);
        const int tid2 = opaque_tid(), lane = tid2 & 63, wid = tid2 >> 6, wn = wid >> 2, wc = wid & 3, fr = lane & 15, g = lane >> 4;
#pragma unroll
      for (int nh = 0; nh < 2; ++nh) {
        const int nt = 2 * pn + nh; const acc_t& acc = acc2[nh];
#pragma unroll
        for (int im = 0; im < 4; ++im) {
            const int ml = (im >> 1) * 128 + wc * 32 + (im & 1) * 16 + fr, row = mt * 256 + ml;
            bf16_t* prow_ = P + (size_t)row * PP + nt * 128 + wn * 64 + 4 * g;
            const bool lat = row >= LC; const int tpos = row - LC, prow = lat ? (tpos >> 6) : 0, pcol = lat ? (tpos & 63) : 0;
            f32x4 v[4];
#pragma unroll
            for (int in = 0; in < 4; ++in) v[in] = acc[in][im];
            if (nt <= 4) {
                float ss = 0.f;
#pragma unroll
                for (int in = 0; in < 4; ++in) ss += (v[in][0] * v[in][0] + v[in][1] * v[in][1]) + (v[in][2] * v[in][2] + v[in][3] * v[in][3]);
                ss += __shfl_xor(ss, 16); ss += __shfl_xor(ss, 32);
                const float sc = rsqrtf(ss * (1.0f / 64.0f) + EPS) * (nt < 4 ? SC_GQA : 1.0f);
                const float* gg = (nt < 4 ? gqn : gkn) + 4 * g;
#pragma unroll
                for (int in = 0; in < 4; ++in) { const float4 g4 = *(const float4*)(gg + 16 * in); v[in][0] *= sc * g4.x; v[in][1] *= sc * g4.y; v[in][2] *= sc * g4.z; v[in][3] *= sc * g4.w; }
                if (lat) {
#pragma unroll
                    for (int hlf = 0; hlf < 2; ++hlf) {
                        const float4* cs = (const float4*)(t16 + (hlf == 0 ? prow : pcol) * 16 + 4 * g);
                        const float4 c01 = cs[0], c23 = cs[1];
                        const f32x4 cc = {c01.x, c01.z, c23.x, c23.z}, sn = {c01.y, c01.w, c23.y, c23.w}, a = v[2 * hlf], b = v[2 * hlf + 1];
                        v[2 * hlf] = a * cc - b * sn; v[2 * hlf + 1] = a * sn + b * cc; }
                }
            } else if (nt >= 6 && nt <= 8) {
                float ss = 0.f;
#pragma unroll
                for (int in = 0; in < 4; ++in) ss += (v[in][0] * v[in][0] + v[in][1] * v[in][1]) + (v[in][2] * v[in][2] + v[in][3] * v[in][3]);
                ss += __shfl_xor(ss, 16); ss += __shfl_xor(ss, 32);
                if (g == 0) ssq[(size_t)row * 8 + (nt - 6) * 2 + wn] = ss;
            } else if (nt == 9 && wn == 0) {
#pragma unroll
                for (int in = 0; in < 2; ++in) {
                    f32x4 o; o[0] = __shfl_xor(v[in][0], 32); o[1] = __shfl_xor(v[in][1], 32); o[2] = __shfl_xor(v[in][2], 32); o[3] = __shfl_xor(v[in][3], 32);
                    if (lat) { const float4* cs = (const float4*)(t8 + (in == 0 ? prow : pcol) * 8 + 4 * (g & 1));
                        const float4 c01 = cs[0], c23 = cs[1];
                        if (g < 2) { v[in][0] = v[in][0] * c01.x - o[0] * c01.y; v[in][1] = v[in][1] * c01.z - o[1] * c01.w; v[in][2] = v[in][2] * c23.x - o[2] * c23.y; v[in][3] = v[in][3] * c23.z - o[3] * c23.w; }
                        else { v[in][0] = o[0] * c01.y + v[in][0] * c01.x; v[in][1] = o[1] * c01.w + v[in][1] * c01.z; v[in][2] = o[2] * c23.y + v[in][2] * c23.x; v[in][3] = o[3] * c23.w + v[in][3] * c23.z; } }
                }
            }
#pragma unroll
            for (int in = 0; in < 4; ++in) {
                const int G = nt * 8 + wn * 4 + in;
                if (G >= 106) {
                    if (G < 298) {
                        uint2 o; o.x = pack2(sigmoidf_(v[in][0]), sigmoidf_(v[in][1])); o.y = pack2(sigmoidf_(v[in][2]), sigmoidf_(v[in][3]));
                        *(uint2*)(WSP(bf16_t, OFF_GS) + ((((size_t)(mt * 192 + (G - 106)) * 16 + (ml >> 4)) * 64) + lane) * 4) = o; }
                } else if (G >= 74) *(uint2*)(WSP(bf16_t, OFF_SSMG) + ((size_t)(G - 74) * T + row) * 16 + 4 * g) = pack4(v[in]);
                else *(uint2*)(prow_ + 16 * in) = pack4(v[in]);
            }
        }
      }
    }
}

__device__ __forceinline__ void rope_pair(float& a, float& b, int pos, int i, int half) {
    const float freq = powf(10000.0f, -(float)i / (float)half);
    const float ang = (float)pos * freq;
    float sn, cs; sincosf(ang, &sn, &cs);
    const float na = a * cs - b * sn, nb_ = a * sn + b * cs; a = na; b = nb_;
}

constexpr int S5C = 64, NCH = T / S5C;
constexpr size_t S5_ZERO = OFF_WB + WB_EG;
constexpr size_t S5_KTAB = S5_ZERO + 256;
constexpr size_t S5_FTAB = S5_KTAB + (size_t)64 * 64 * 256 * 2;
constexpr size_t S5_GTAB = S5_FTAB + (size_t)64 * 128 * 1024 * 2;
constexpr size_t S5_SINB = S5_GTAB + (size_t)64 * 1024 * 128 * 2;
static_assert(S5_SINB + (size_t)NCH * 64 * 128 * 2 <= OFF_WB + WB_BYTES, "s5 tables overlay");
__device__ __forceinline__ int s5_row(int dir, int j) { return dir == 0 ? j : (j < LC ? LC - 1 - j : T + LC - 1 - j); }
__device__ __forceinline__ void s5_consts(const KP& p, int l, int dir, int g, int lane, float& lr, float& li, float (&bbr)[16], float (&bbi)[16]) {
    const int gi = (l * 2 + dir) * 32 + g, pi = gi * 64 + lane;
    const float are = p.in(I_ARE)[pi], aim = p.in(I_AIM)[pi], dt = expf(p.in(I_LOGDT)[gi]);
    const float mag = expf(are * dt); float sn, cs; sincosf(aim * dt, &sn, &cs);
    lr = mag * cs; li = mag * sn; const float den = are * are + aim * aim;
    const float cr = ((lr - 1.0f) * are + li * aim) / den, ci = (li * are - (lr - 1.0f) * aim) / den;
    const float4* br4 = (const float4*)(p.in(I_BRE) + (size_t)pi * 16); const float4* bi4 = (const float4*)(p.in(I_BIM) + (size_t)pi * 16);
#pragma unroll
    for (int q = 0; q < 4; ++q) { const float4 br = br4[q], bi = bi4[q];
        bbr[4 * q] = cr * br.x - ci * bi.x; bbi[4 * q] = cr * bi.x + ci * br.x; bbr[4 * q + 1] = cr * br.y - ci * bi.y; bbi[4 * q + 1] = cr * bi.y + ci * br.y;
        bbr[4 * q + 2] = cr * br.z - ci * bi.z; bbi[4 * q + 2] = cr * bi.z + ci * br.z; bbr[4 * q + 3] = cr * br.w - ci * bi.w; bbi[4 * q + 3] = cr * bi.w + ci * br.w; }
}
__device__ __forceinline__ void s5_unpack(uint4 a, uint4 b, float (&u)[16]) {
    u[0] = bflo(a.x); u[1] = bfhi(a.x); u[2] = bflo(a.y); u[3] = bfhi(a.y); u[4] = bflo(a.z); u[5] = bfhi(a.z); u[6] = bflo(a.w); u[7] = bfhi(a.w);
    u[8] = bflo(b.x); u[9] = bfhi(b.x); u[10] = bflo(b.y); u[11] = bfhi(b.y); u[12] = bflo(b.z); u[13] = bfhi(b.z); u[14] = bflo(b.w); u[15] = bfhi(b.w);
}
__device__ __forceinline__ void st_s5_local(const KP& p, int l, int bid, int nb) {
    const int tidx = opaque_tid();
    const int lane = tidx & 63, wid = tidx >> 6;
    const bf16_t* P = WSP(bf16_t, OFF_P); float2* F = WSP(float2, OFF_S5);
    const int gw = bid * NWV + wid, nw = nb * NWV;
    if (gw >= (nw / 64) * 64) return;
    const int gd = gw & 63, dir = gd >> 5, g = gd & 31, part = gw >> 6, nparts = nw >> 6;
    if (part >= 4) return;
    float lr, li, bbr[16], bbi[16]; s5_consts(p, l, dir, g, lane, lr, li, bbr, bbi);
    for (int c = part; c < 4; c += nparts) {
        float sr = 0.f, si = 0.f;
        for (int j0 = 0; j0 < S5C; j0 += 8) {
            uint4 ua[8], ub[8];
#pragma unroll
            for (int q = 0; q < 8; ++q) { const int r = s5_row(dir, c * S5C + j0 + q); const uint4* up = (const uint4*)SSMU(g, r); ua[q] = up[0]; ub[q] = up[1]; }
#pragma unroll
            for (int q = 0; q < 8; ++q) { float u[16]; s5_unpack(ua[q], ub[q], u);
                float bur = 0.f, bui = 0.f;
#pragma unroll
                for (int cc = 0; cc < 16; ++cc) { bur = fmaf(bbr[cc], u[cc], bur); bui = fmaf(bbi[cc], u[cc], bui); }
                const float nsr = lr * sr - li * si + bur, nsi = lr * si + li * sr + bui; sr = nsr; si = nsi; }
        }
        F[((size_t)(c * 2 + dir) * 32 + g) * 64 + lane] = make_float2(sr, si);
    }
}
__device__ __forceinline__ void st_s5_carry(const KP& p, int l, int bid, int nb, char* lds) {
    const int tidx = opaque_tid();
    float2* F = WSP(float2, OFF_S5); bf16_t* SB = WSP(bf16_t, S5_SINB);
    float4* comp = (float4*)lds;
    constexpr int RUN = 9;
    for (int cb = bid; cb < 256; cb += nb) {
        const int chl = tidx & 15, seg = tidx >> 4, idx = cb * 16 + chl;
        const int gi = l * 64 + (idx >> 6);
        const float are = p.in(I_ARE)[gi * 64 + (idx & 63)], aim = p.in(I_AIM)[gi * 64 + (idx & 63)], dt = expf(p.in(I_LOGDT)[gi]);
        const float mag = expf(are * dt); float sn, cs; sincosf(aim * dt, &sn, &cs);
        float pr = mag * cs, pi_ = mag * sn;
#pragma unroll
        for (int q = 0; q < 6; ++q) { const float nr = pr * pr - pi_ * pi_, ni = 2.f * pr * pi_; pr = nr; pi_ = ni; }
        const int c0 = seg * RUN;
        float2 f[RUN]; float ar = 1.f, ai = 0.f, br = 0.f, bi = 0.f;
#pragma unroll
        for (int q = 0; q < RUN; ++q) { const int c = c0 + q; f[q] = (c < NCH) ? F[(size_t)c * 4096 + idx] : make_float2(0.f, 0.f);
            if (c < NCH) { const float nbr = pr * br - pi_ * bi + f[q].x, nbi = pr * bi + pi_ * br + f[q].y; br = nbr; bi = nbi;
                           const float nar = pr * ar - pi_ * ai, nai = pr * ai + pi_ * ar; ar = nar; ai = nai; } }
        __syncthreads();
        comp[chl * 32 + seg] = make_float4(ar, ai, br, bi);
        __syncthreads();
        float sr = 0.f, si = 0.f;
        for (int j = 0; j < seg; ++j) { const float4 cj = comp[chl * 32 + j]; const float nr = cj.x * sr - cj.y * si + cj.z, ni = cj.x * si + cj.y * sr + cj.w; sr = nr; si = ni; }
#pragma unroll
        for (int q = 0; q < RUN; ++q) { const int c = c0 + q;
            if (c < NCH) { F[(size_t)c * 4096 + idx] = make_float2(sr, si);
                bf16_t* sb = SB + ((size_t)c * 64 + (idx >> 6)) * 128 + (idx & 63); sb[0] = f2bf(sr); sb[64] = f2bf(si);
                const float nr = pr * sr - pi_ * si + f[q].x, ni = pr * si + pi_ * sr + f[q].y; sr = nr; si = ni; } }
    }
    __syncthreads();
}
__device__ __forceinline__ void st_s5_scan(const KP& p, int l, int bid, int nb) {
    const int tidx = opaque_tid();
    const int lane = tidx & 63, wid = tidx >> 6;
    const bf16_t* P = WSP(bf16_t, OFF_P); const float2* F = WSP(float2, OFF_S5);
    const int gw = bid * NWV + wid, nw = nb * NWV;
    if (gw >= (nw / 64) * 64) return;
    const int gd = gw & 63, dir = gd >> 5, g = gd & 31, part = gw >> 6, nparts = nw >> 6;
    if (part >= 4) return;
    float* Yo = dir == 0 ? WSP(float, OFF_OM) : WSP(float, OFF_H);
    float lr, li, bbr[16], bbi[16]; s5_consts(p, l, dir, g, lane, lr, li, bbr, bbi);
    const int gi = (l * 2 + dir) * 32 + g;
    float cre[16], cim[16];
#pragma unroll
    for (int cc = 0; cc < 16; ++cc) { cre[cc] = p.in(I_CRE)[((size_t)gi * 16 + cc) * 64 + lane]; cim[cc] = p.in(I_CIM)[((size_t)gi * 16 + cc) * 64 + lane]; }
    const float dsk = p.in(I_SSMD)[l * 512 + g * 16 + (lane & 15)];
    for (int c = part; c < 4; c += nparts) {
        const float2 s0 = F[((size_t)(c * 2 + dir) * 32 + g) * 64 + lane];
        float sr = s0.x, si = s0.y;
        for (int j0 = 0; j0 < S5C; j0 += 8) {
            uint4 ua[8], ub[8];
#pragma unroll
            for (int q = 0; q < 8; ++q) { const int r = s5_row(dir, c * S5C + j0 + q); const uint4* up = (const uint4*)SSMU(g, r); ua[q] = up[0]; ub[q] = up[1]; }
#pragma unroll
            for (int q = 0; q < 8; ++q) { const int r = s5_row(dir, c * S5C + j0 + q);
                float u[16]; s5_unpack(ua[q], ub[q], u);
                float bur = 0.f, bui = 0.f;
#pragma unroll
                for (int cc = 0; cc < 16; ++cc) { bur = fmaf(bbr[cc], u[cc], bur); bui = fmaf(bbi[cc], u[cc], bui); }
                const float nsr = lr * sr - li * si + bur, nsi = lr * si + li * sr + bui; sr = nsr; si = nsi;
                float t16[16];
#pragma unroll
                for (int cc = 0; cc < 16; ++cc) t16[cc] = cre[cc] * sr - cim[cc] * si;
                float y = transpose_reduce16(t16, lane);
                if (lane < 16) {
                    if (dir == 0) y += dsk * bf2f(SSMU(g, r)[lane]);
                    Yo[(size_t)r * 512 + g * 16 + lane] = y; }
            }
        }
    }
}

__device__ __forceinline__ void st_s5_tables(const KP& p, int l, int bid, int nb, char* lds) {
    const int tidx = opaque_tid();
    float* pwr = (float*)lds; float* pwi = pwr + 65 * 64; float* bbr = pwi + 65 * 64; float* bbi = bbr + 1024; float* cre = bbi + 1024; float* cim = cre + 1024;
    bf16_t* Ktab = WSP(bf16_t, S5_KTAB); bf16_t* Ftab = WSP(bf16_t, S5_FTAB); bf16_t* Gtab = WSP(bf16_t, S5_GTAB);
    if (bid == 0 && tidx < 64) WSP(unsigned, S5_ZERO)[tidx] = 0u;
    for (int item = bid; item < 256; item += nb) {
        const int gd = item >> 2, q = item & 3, dir = gd >> 5, g = gd & 31, gi = (l * 2 + dir) * 32 + g;
        __syncthreads();
        if (tidx < 64) {
            const int pp = tidx, pi = gi * 64 + pp;
            const float are = p.in(I_ARE)[pi], aim = p.in(I_AIM)[pi], dt = expf(p.in(I_LOGDT)[gi]);
            const float mag = expf(are * dt); float sn, cs; sincosf(aim * dt, &sn, &cs);
            const float lr = mag * cs, li = mag * sn, den = are * are + aim * aim;
            const float cr = ((lr - 1.0f) * are + li * aim) / den, ci = (li * are - (lr - 1.0f) * aim) / den;
            for (int c = 0; c < 16; ++c) { const float br = p.in(I_BRE)[(size_t)pi * 16 + c], bi = p.in(I_BIM)[(size_t)pi * 16 + c];
                bbr[pp * 16 + c] = cr * br - ci * bi; bbi[pp * 16 + c] = cr * bi + ci * br; }
            float ar = 1.f, ai = 0.f;
            for (int n = 0; n <= 64; ++n) { pwr[n * 64 + pp] = ar; pwi[n * 64 + pp] = ai; const float nr = ar * lr - ai * li, ni = ar * li + ai * lr; ar = nr; ai = ni; }
        } else {
            for (int i = tidx - 64; i < 1024; i += NTH - 64) { cre[i] = p.in(I_CRE)[(size_t)gi * 1024 + i]; cim[i] = p.in(I_CIM)[(size_t)gi * 1024 + i]; }
        }
        __syncthreads();
        for (int e = 0; e < 8; ++e) {
            const int idx = tidx + NTH * e, tau = 16 * q + (idx >> 8), c = (idx >> 4) & 15, c2 = idx & 15;
            float s = 0.f;
            for (int pp = 0; pp < 64; ++pp) {
                const float xr = cre[c * 64 + pp], xi = cim[c * 64 + pp], wr = pwr[tau * 64 + pp], wi = pwi[tau * 64 + pp];
                const float zr = xr * wr - xi * wi, zi = xr * wi + xi * wr;
                s += zr * bbr[pp * 16 + c2] - zi * bbi[pp * 16 + c2];
            }
            Ktab[(((size_t)gd * 64 + tau) * 16 + c) * 16 + c2] = f2bf(s);
        }
        for (int e = 0; e < 32; ++e) {
            const int idx2 = tidx + NTH * e, n = 32 * q + (idx2 >> 9), k = (idx2 & 511) * 2, pp = n & 63, comp = n >> 6, i = k >> 4, c2 = k & 15;
            const float wr = pwr[(63 - i) * 64 + pp], wi = pwi[(63 - i) * 64 + pp];
            const float b0r = bbr[pp * 16 + c2], b0i = bbi[pp * 16 + c2], b1r = bbr[pp * 16 + c2 + 1], b1i = bbi[pp * 16 + c2 + 1];
            const float v0 = comp ? (wr * b0i + wi * b0r) : (wr * b0r - wi * b0i), v1 = comp ? (wr * b1i + wi * b1r) : (wr * b1r - wi * b1i);
            *(unsigned*)(Ftab + ((size_t)gd * 128 + n) * 1024 + k) = pack2(v0, v1);
        }
        for (int e = 0; e < 32; ++e) {
            const int idx2 = tidx + NTH * e, row = 256 * q + (idx2 >> 6), n = (idx2 & 63) * 2, t = row >> 4, c = row & 15, comp = n >> 6, pp = n & 63;
            float v[2];
#pragma unroll
            for (int h = 0; h < 2; ++h) { const float xr = cre[c * 64 + pp + h], xi = cim[c * 64 + pp + h], wr = pwr[(t + 1) * 64 + pp + h], wi = pwi[(t + 1) * 64 + pp + h];
                v[h] = comp ? -(xr * wi + xi * wr) : (xr * wr - xi * wi); }
            *(unsigned*)(Gtab + ((size_t)gd * 1024 + row) * 128 + n) = pack2(v[0], v[1]);
        }
    }
    __syncthreads();
}
__device__ __forceinline__ void st_s5_fgemm(const KP& p, int bid, int nb, char* lds) {
    const int tidx = opaque_tid();
    const bf16_t* P = WSP(bf16_t, OFF_P); const bf16_t* Ftab = WSP(bf16_t, S5_FTAB); float* F = WSP(float, OFF_S5);
    const int srow = tidx >> 3, gch = (tidx & 7) ^ ((srow >> 1) & 7);
    for (int gd = bid; gd < 64; gd += nb) {
        const int dir = gd >> 5, g = gd & 31;
        acc_t acc; acc_zero(acc);
        gemm_core_g(acc,
            [&](int i, int kt) { const int m = srow + 64 * i, tok = kt * 4 + (gch >> 1); return SSMU(g, s5_row(dir, 64 * (4 + m) + tok)) + 8 * (gch & 1); },
            [&](int i, int kt) { return Ftab + ((size_t)gd * 128 + srow + 64 * i) * 1024 + kt * 64 + gch * 8; }, 16, lds);
        acc_visit(acc, [&](int ml, int nl, f32x4 v) {
            float* dst = F + (((size_t)(4 + ml) * 2 + dir) * 32 + g) * 128 + (nl & 63) * 2 + (nl >> 6);
            dst[0] = v[0]; dst[2] = v[1]; dst[4] = v[2]; dst[6] = v[3]; });
    }
}
__device__ __forceinline__ void st_s5_ygemm(const KP& p, int l, int bid, int nb, char* lds) {
    const int tidx = opaque_tid();
    const bf16_t* P = WSP(bf16_t, OFF_P); const bf16_t* Ktab = WSP(bf16_t, S5_KTAB); const bf16_t* Gtab = WSP(bf16_t, S5_GTAB);
    const bf16_t* Sinb = WSP(bf16_t, S5_SINB); const bf16_t* Zero = WSP(bf16_t, S5_ZERO); bf16_t* Y1 = WSP(bf16_t, OFF_OS);
    const int srow = tidx >> 3, gch = (tidx & 7) ^ ((srow >> 1) & 7);
    for (int u = bid; u < 256; u += nb) {
        const int g = u >> 3, nt = u & 7;
        acc_t acc; acc_zero(acc);
        {   const int gd = g, nkt = 2 * (nt + 1);
            gemm_core_g(acc,
                [&](int i, int kt) { const int m = srow + 64 * i;
                    if (kt < nkt) { const int tok = kt * 4 + (gch >> 1); return SSMU(g, 64 * (4 + m) + tok) + 8 * (gch & 1); }
                    return Sinb + ((size_t)(4 + m) * 64 + gd) * 128 + (kt - nkt) * 64 + gch * 8; },
                [&](int i, int kt) { const int n = nt * 128 + srow + 64 * i, t = n >> 4, c = n & 15;
                    if (kt < nkt) { const int tau = t - (kt * 4 + (gch >> 1)); return tau >= 0 ? Ktab + (((size_t)gd * 64 + tau) * 16 + c) * 16 + 8 * (gch & 1) : Zero; }
                    return Gtab + ((size_t)gd * 1024 + n) * 128 + (kt - nkt) * 64 + gch * 8; }, nkt + 2, lds); }
        {   const int gd = 32 + g, nkt = 2 * (8 - nt);
            gemm_core_g(acc,
                [&](int i, int kt) { const int m = srow + 64 * i, cx = 259 - m;
                    if (kt < nkt) { const int tok = kt * 4 + (gch >> 1); return SSMU(g, T + LC - 1 - (64 * cx + tok)) + 8 * (gch & 1); }
                    return Sinb + ((size_t)cx * 64 + gd) * 128 + (kt - nkt) * 64 + gch * 8; },
                [&](int i, int kt) { const int n = nt * 128 + srow + 64 * i, t = 63 - (n >> 4), c = n & 15;
                    if (kt < nkt) { const int tau = t - (kt * 4 + (gch >> 1)); return tau >= 0 ? Ktab + (((size_t)gd * 64 + tau) * 16 + c) * 16 + 8 * (gch & 1) : Zero; }
                    return Gtab + ((size_t)gd * 1024 + t * 16 + c) * 128 + (kt - nkt) * 64 + gch * 8; }, nkt + 2, lds); }
        acc_visit(acc, [&](int ml, int nl, f32x4 v) {
            const int n = nt * 128 + nl, t = n >> 4, c0 = n & 15, r = 64 * (4 + ml) + t;
            const float4 dsk = *(const float4*)(p.in(I_SSMD) + l * 512 + g * 16 + c0); const uint2 ur = *(const uint2*)(SSMU(g, r) + c0);
            uint2 o; o.x = pack2(gelu_tanh(v[0] + dsk.x * bflo(ur.x)), gelu_tanh(v[1] + dsk.y * bfhi(ur.x))); o.y = pack2(gelu_tanh(v[2] + dsk.z * bflo(ur.y)), gelu_tanh(v[3] + dsk.w * bfhi(ur.y)));
            *(uint2*)(Y1 + (size_t)r * 512 + g * 16 + c0) = o; });
    }
}
__device__ __forceinline__ void st_s5_ctx_y(const KP& p, int l, int bid, int nb) {
    const int tidx = opaque_tid();
    const bf16_t* P = WSP(bf16_t, OFF_P); const bf16_t* Ktab = WSP(bf16_t, S5_KTAB); const bf16_t* Gtab = WSP(bf16_t, S5_GTAB);
    const float* SIN = WSP(float, OFF_S5); bf16_t* Y1 = WSP(bf16_t, OFF_OS);
    for (int idx = bid * NTH + tidx; idx < 32 * 256 * 16; idx += nb * NTH) {
        const int ch = idx & 15, r = (idx >> 4) & 255, g = idx >> 12;
        float y = p.in(I_SSMD)[l * 512 + g * 16 + ch] * bf2f(SSMU(g, r)[ch]);
#pragma unroll 1
        for (int dir = 0; dir < 2; ++dir) {
            const int gd = dir * 32 + g, j = dir == 0 ? r : (LC - 1 - r), cx = j >> 6, t = j & 63;
            const bf16_t* kt_ = Ktab + ((size_t)gd * 64 * 16 + ch) * 16;
            float a = 0.f;
            for (int i = 0; i <= t; ++i) {
                const int jr = 64 * cx + i, rr = dir == 0 ? jr : (LC - 1 - jr);
                const uint4* up = (const uint4*)SSMU(g, rr); const uint4* kp = (const uint4*)(kt_ + (size_t)(t - i) * 256);
                a = dot8(up[0], kp[0], a); a = dot8(up[1], kp[1], a);
            }
            const bf16_t* gp = Gtab + ((size_t)gd * 1024 + t * 16 + ch) * 128; const float* sp = SIN + (((size_t)cx * 2 + dir) * 32 + g) * 128;
            for (int q = 0; q < 64; q += 2) { const unsigned gre = *(const unsigned*)(gp + q), gim = *(const unsigned*)(gp + 64 + q); const float4 s4 = *(const float4*)(sp + 2 * q);
                a = fmaf(bflo(gre), s4.x, a); a = fmaf(bflo(gim), s4.y, a); a = fmaf(bfhi(gre), s4.z, a); a = fmaf(bfhi(gim), s4.w, a); }
            y += a;
        }
        Y1[(size_t)r * 512 + g * 16 + ch] = f2bf(gelu_tanh(y));
    }
}
__device__ __forceinline__ void st_s5_fin(const KP& p, int bid, int nb) {
    const int tidx = opaque_tid();
    const float* Yf = WSP(float, OFF_OM); const float* Yb = WSP(float, OFF_H); bf16_t* P = WSP(bf16_t, OFF_P);
    for (long idx = (long)bid * NTH + tidx; idx < (long)T * 512; idx += (long)nb * NTH) {
        const int r = (int)(idx >> 9), c = (int)(idx & 511);
        P[(size_t)r * PP + C_SSM + c] = f2bf(gelu_tanh(Yf[idx] + Yb[idx]));
    }
}

template <int SET>
__device__ __forceinline__ void st_proj2(const KP& p, int l, int bid, int nb, char* lds) {
    const int tidx = opaque_tid();
    bf16_t* P = WSP(bf16_t, OFF_P);
    const bf16_t* Wuq = WSP(bf16_t, OFF_WB + WB_UQ); bf16_t* Qm = WSP(bf16_t, OFF_H);
    const bf16_t* Wukv = WSP(bf16_t, OFF_WB + WB_UKV); bf16_t* Kn = WSP(bf16_t, OFF_KN); bf16_t* Vm = WSP(bf16_t, OFF_V);
    const bf16_t* Wglu = WSP(bf16_t, OFF_WB + WB_GLU); bf16_t* Os = WSP(bf16_t, OFF_OS); const float* bg = p.in(I_BGLU) + l * 512;
    int mt, ntv;
    for (int it = 0; dense_tile(it, SET == 0 ? 14 : 4, SET == 0 || l + 1 < NL, bid, nb, mt, ntv); ++it) {
        if (SET == 1) ntv += 14;
        const int which = ntv < 6 ? 0 : (ntv < 14 ? 1 : 2), nt = ntv - (which == 0 ? 0 : (which == 1 ? 6 : 14));
        const int K = which == 0 ? 256 : (which == 1 ? 128 : 512);
        const bf16_t* abase = which == 2 ? (const bf16_t*)Os + (size_t)mt * 256 * 512 : P + (size_t)mt * 256 * PP + (which == 0 ? C_CQ : C_CKV);
        const int apitch = which == 2 ? 512 : PP;
        const bf16_t* wbase = (which == 0 ? Wuq : (which == 1 ? Wukv : Wglu)) + (size_t)nt * 128 * K;
        acc_t acc; acc_zero(acc);
        gemm_core(acc, [&](int r) { return abase + (size_t)r * apitch; }, [&](int r) { return wbase + (size_t)r * K; }, K, lds);
        if (which == 0) {
            const float* ssq = WSP(float, OFF_SSQ); const float2* t8 = WSP(float2, OFF_ROPE) + 256 * 16;
            const int lane_ = tidx & 63, wid_ = tidx >> 6, wm_ = wid_ >> 1, wn_ = wid_ & 1, fr_ = lane_ & 15, g_ = lane_ >> 4;
#pragma unroll
            for (int im = 0; im < 4; ++im) {
                const int row = mt * 256 + wm_ * 64 + 16 * im + fr_;
                const float4 s4 = *(const float4*)(ssq + (size_t)row * 8);
                const float sc = rsqrtf(((s4.x + s4.y) + (s4.z + s4.w)) * (1.0f / 256.0f) + EPS) * SC_MLA;
                const bool lat = row >= LC; const int tpos = row - LC, prow = lat ? (tpos >> 6) : 0, pcol = lat ? (tpos & 63) : 0;
#pragma unroll
                for (int in = 0; in < 4; ++in) {
                    f32x4 v = acc[in][im] * sc;
                    if (((nt * 4 + wn_ * 2 + (in >> 1)) % 3) == 2) {
                        f32x4 o; o[0] = __shfl_xor(v[0], 32); o[1] = __shfl_xor(v[1], 32); o[2] = __shfl_xor(v[2], 32); o[3] = __shfl_xor(v[3], 32);
                        if (lat) { const float4* cs = (const float4*)(t8 + ((in & 1) == 0 ? prow : pcol) * 8 + 4 * (g_ & 1));
                            const float4 c01 = cs[0], c23 = cs[1];
                            if (g_ < 2) { v[0] = v[0] * c01.x - o[0] * c01.y; v[1] = v[1] * c01.z - o[1] * c01.w; v[2] = v[2] * c23.x - o[2] * c23.y; v[3] = v[3] * c23.z - o[3] * c23.w; }
                            else { v[0] = o[0] * c01.y + v[0] * c01.x; v[1] = o[1] * c01.w + v[1] * c01.z; v[2] = o[2] * c23.y + v[2] * c23.x; v[3] = o[3] * c23.w + v[3] * c23.z; } }
                    }
                    *(uint2*)(Qm + (size_t)row * 768 + nt * 128 + wn_ * 64 + 16 * in + 4 * g_) = pack4(v);
                }
            }
        } else if (which == 1) {
            const float* ssq = WSP(float, OFF_SSQ);
            acc_visit(acc, [&](int ml, int nl, f32x4 v) {
                const float2 s2 = *(const float2*)(ssq + (size_t)(mt * 256 + ml) * 8 + 4);
                const float sc = rsqrtf((s2.x + s2.y) * (1.0f / 128.0f) + EPS);
                bf16_t* dst = (nl < 64) ? (Kn + (size_t)(mt * 256 + ml) * 512 + nt * 64 + nl) : (Vm + (size_t)(mt * 256 + ml) * 512 + nt * 64 + nl - 64);
                *(uint2*)dst = pack4(v * sc); });
        } else {
            acc_visit(acc, [&](int ml, int nl, f32x4 v) {
                const int n = nt * 128 + nl;
                const uint2 yr = *(const uint2*)(Os + (size_t)(mt * 256 + ml) * 512 + n); const float4 b4 = *(const float4*)(bg + n);
                uint2 o; o.x = pack2(bflo(yr.x) * sigmoidf_(v[0] + b4.x), bfhi(yr.x) * sigmoidf_(v[1] + b4.y));
                o.y = pack2(bflo(yr.y) * sigmoidf_(v[2] + b4.z), bfhi(yr.y) * sigmoidf_(v[3] + b4.w));
                *(uint2*)(P + (size_t)(mt * 256 + ml) * PP + C_SSM + n) = o; });
        }
    }
}
__device__ __forceinline__ void st_ropeq(const KP& p, int bid, int nb, char* lds) {
    const int tidx = opaque_tid();
    {   const int lane = tidx & 63, wid = tidx >> 6;
        const bf16_t* Kn = WSP(bf16_t, OFF_KN); const bf16_t* P = WSP(bf16_t, OFF_P);
        float runmax = 0.f;
        for (int r = bid * NWV + wid; r < T; r += nb * NWV) {
            const uint4 kv = *(const uint4*)(Kn + (size_t)r * 512 + lane * 8);
            float s = bflo(kv.x) * bflo(kv.x) + bfhi(kv.x) * bfhi(kv.x) + bflo(kv.y) * bflo(kv.y) + bfhi(kv.y) * bfhi(kv.y)
                    + bflo(kv.z) * bflo(kv.z) + bfhi(kv.z) * bfhi(kv.z) + bflo(kv.w) * bflo(kv.w) + bfhi(kv.w) * bfhi(kv.w);
            s += __shfl_xor(s, 1); s += __shfl_xor(s, 2); s += __shfl_xor(s, 4);
            float sr = 0.f;
            if (lane < 4) { const uint4 rv = *(const uint4*)(P + (size_t)r * PP + C_KR + lane * 8);
                sr = bflo(rv.x) * bflo(rv.x) + bfhi(rv.x) * bfhi(rv.x) + bflo(rv.y) * bflo(rv.y) + bfhi(rv.y) * bfhi(rv.y)
                   + bflo(rv.z) * bflo(rv.z) + bfhi(rv.z) * bfhi(rv.z) + bflo(rv.w) * bflo(rv.w) + bfhi(rv.w) * bfhi(rv.w); }
            sr += __shfl_xor(sr, 1); sr += __shfl_xor(sr, 2);
            sr = __shfl(sr, 0);
            runmax = fmaxf(runmax, s + sr);
        }
        unsigned* lmax = (unsigned*)lds;
        __syncthreads();
        if (tidx < 8) lmax[tidx] = 0u;
        __syncthreads();
        if ((lane & 7) == 0) atomicMax(&lmax[lane >> 3], __float_as_uint(runmax));
        __syncthreads();
        if (tidx < 8) atomicMax(WSP(unsigned, OFF_CNT) + 32 + tidx, lmax[tidx]);
    }
}

typedef short s16x4 __attribute__((ext_vector_type(4)));
typedef short v4i16_t __attribute__((ext_vector_type(4)));
typedef __attribute__((address_space(3))) const char* lds_cptr;
__device__ __forceinline__ s16x4 vtr(lds_cptr q) { return __builtin_bit_cast(s16x4, __builtin_amdgcn_ds_read_tr16_b64_v4i16((__attribute__((address_space(3))) v4i16_t*)q)); }
__device__ __forceinline__ unsigned cvtpk(float lo, float hi) { return pack2(lo, hi); }
constexpr int AT_K = 0, AT_V = 8192, AT_KR = 16384, AT_BUF = 20480;

template <int DQK, int VAR = 0>
__device__ __forceinline__ void attn_item(const bf16_t* Q, int qpitch, const bf16_t* KA, int kapitch, const bf16_t* KB, int kbpitch,
                                          const bf16_t* V, int vpitch, int ntiles, float C, bf16_t* O, char* lds) {
    const int tid = opaque_tid(), lane = tid & 63, wid = tid >> 6, r32 = lane & 31, hi = lane >> 5;
    constexpr int ND0 = DQK / 16;
    bf16x8 qr[ND0];
    { const bf16_t* qp = Q + (size_t)(wid * 32 + r32) * qpitch + hi * 8;
#pragma unroll
      for (int d0 = 0; d0 < ND0; ++d0) qr[d0] = *(const bf16x8*)(qp + d0 * 16); }
    const int srow = tid >> 3, sch = tid & 7;
    const bf16_t* gk = KA + (size_t)srow * kapitch + sch * 8;
    const bf16_t* gv = V + (size_t)srow * vpitch + sch * 8;
    const bf16_t* gr = (DQK > 64) ? (KB + (size_t)(tid >> 2) * kbpitch + (tid & 3) * 8) : nullptr;
    const int sk_off = AT_K + srow * 128 + ((sch ^ ((srow >> 1) & 7)) << 4);
    const int sv_off = AT_V + (sch >> 2) * 4096 + srow * 64 + (sch & 3) * 16;
    const int sr_off = AT_KR + (tid >> 2) * 64 + (((tid & 3) ^ (((tid >> 2) >> 2) & 3)) << 4);
    const bool do_r = (DQK > 64) && (tid < 256);
    const int kf_off = AT_K + r32 * 128, ksw = (r32 >> 1) & 7;
    const int rf_off = AT_KR + r32 * 64, rsw = (r32 >> 2) & 3;
    const int vf_off = AT_V + (4 * hi + ((lane & 15) >> 2)) * 64 + ((lane >> 4) & 1) * 32 + (lane & 3) * 8;
    uint4 rk, rv, rr; rr = make_uint4(0, 0, 0, 0);
    rk = *(const uint4*)gk; rv = *(const uint4*)gv; if (do_r) rr = *(const uint4*)gr;
    *(uint4*)(lds + sk_off) = rk; *(uint4*)(lds + sv_off) = rv; if (do_r) *(uint4*)(lds + sr_off) = rr;
    __syncthreads();
    f32x16 o0, o1;
#pragma unroll
    for (int r = 0; r < 16; ++r) { o0[r] = 0.f; o1[r] = 0.f; }
    float mrun = -INFINITY, lrun = 0.f;
    for (int t = 0; t < ntiles; ++t) {
        const char* cur = lds + (VAR == 2 ? 0 : (t & 1)) * AT_BUF; char* nxt = lds + ((t + 1) & 1) * AT_BUF;
        const bool more = (t + 1 < ntiles);
        if (more && VAR != 2) { rk = *(const uint4*)(gk + (size_t)(t + 1) * 64 * kapitch); rv = *(const uint4*)(gv + (size_t)(t + 1) * 64 * vpitch); if (do_r) rr = *(const uint4*)(gr + (size_t)(t + 1) * 64 * kbpitch); }
        f32x16 p0, p1;
#pragma unroll
        for (int r = 0; r < 16; ++r) { p0[r] = 0.f; p1[r] = 0.f; }
#pragma unroll
        for (int d0 = 0; d0 < 4; ++d0) {
            const int co = ((2 * d0 + hi) ^ ksw) << 4;
            const bf16x8 k0 = *(const bf16x8*)(cur + kf_off + co), k1 = *(const bf16x8*)(cur + kf_off + 32 * 128 + co);
            p0 = MFMA32(k0, qr[d0], p0); p1 = MFMA32(k1, qr[d0], p1);
        }
        if (DQK > 64) {
#pragma unroll
            for (int d0 = 4; d0 < ND0; ++d0) {
                const int co = ((2 * (d0 - 4) + hi) ^ rsw) << 4;
                const bf16x8 k0 = *(const bf16x8*)(cur + rf_off + co), k1 = *(const bf16x8*)(cur + rf_off + 32 * 64 + co);
                p0 = MFMA32(k0, qr[d0], p0); p1 = MFMA32(k1, qr[d0], p1);
            }
        }
        if (VAR != 1) {
        float mx = fmaxf(p0[0], p1[0]);
#pragma unroll
        for (int r = 1; r < 16; ++r) mx = fmaxf(mx, fmaxf(p0[r], p1[r]));
        mx = xhalf_max(mx) * C;
        const float mnew = fmaxf(mrun, mx);
        if (__any(mnew > mrun)) {
            const float alpha = __builtin_amdgcn_exp2f(mrun - mnew);
            lrun *= alpha;
#pragma unroll
            for (int r = 0; r < 16; ++r) { o0[r] *= alpha; o1[r] *= alpha; }
            mrun = mnew;
        }
        const float nm = -mrun;
        float ls = 0.f;
#pragma unroll
        for (int r = 0; r < 16; ++r) { p0[r] = __builtin_amdgcn_exp2f(fmaf(p0[r], C, nm)); p1[r] = __builtin_amdgcn_exp2f(fmaf(p1[r], C, nm)); ls += p0[r] + p1[r]; }
        lrun += ls;
        }
#pragma unroll
        for (int s = 0; s < 4; ++s) {
            bf16x8 pf;
            {   unsigned w0, w1, w2, w3;
                if (s < 2) { w0 = cvtpk(p0[8 * s], p0[8 * s + 1]); w1 = cvtpk(p0[8 * s + 2], p0[8 * s + 3]); w2 = cvtpk(p0[8 * s + 4], p0[8 * s + 5]); w3 = cvtpk(p0[8 * s + 6], p0[8 * s + 7]); }
                else { const int s2 = s - 2; w0 = cvtpk(p1[8 * s2], p1[8 * s2 + 1]); w1 = cvtpk(p1[8 * s2 + 2], p1[8 * s2 + 3]); w2 = cvtpk(p1[8 * s2 + 4], p1[8 * s2 + 5]); w3 = cvtpk(p1[8 * s2 + 6], p1[8 * s2 + 7]); }
                uint4 u = make_uint4(w0, w1, w2, w3); pf = __builtin_bit_cast(bf16x8, u); }
            const lds_cptr vb = (lds_cptr)cur + vf_off + s * 1024;
            const s16x4 a0 = vtr(vb), a1 = vtr(vb + 512), b0 = vtr(vb + 4096), b1 = vtr(vb + 4096 + 512);
            const bf16x8 v0 = (bf16x8){a0[0], a0[1], a0[2], a0[3], a1[0], a1[1], a1[2], a1[3]};
            const bf16x8 v1 = (bf16x8){b0[0], b0[1], b0[2], b0[3], b1[0], b1[1], b1[2], b1[3]};
            o0 = MFMA32(v0, pf, o0); o1 = MFMA32(v1, pf, o1);
        }
        if (VAR != 2) { if (more) { *(uint4*)(nxt + sk_off) = rk; *(uint4*)(nxt + sv_off) = rv; if (do_r) *(uint4*)(nxt + sr_off) = rr; }
        __syncthreads(); }
    }
    const float inv = 1.0f / xhalf_sum(lrun);
    bf16_t* op = O + (size_t)(wid * 32 + r32) * 512 + 4 * hi;
#pragma unroll
    for (int rg = 0; rg < 4; ++rg) {
        uint2 a; a.x = pack2(o0[4 * rg] * inv, o0[4 * rg + 1] * inv); a.y = pack2(o0[4 * rg + 2] * inv, o0[4 * rg + 3] * inv);
        uint2 b; b.x = pack2(o1[4 * rg] * inv, o1[4 * rg + 1] * inv); b.y = pack2(o1[4 * rg + 2] * inv, o1[4 * rg + 3] * inv);
        *(uint2*)(op + 8 * rg) = a; *(uint2*)(op + 32 + 8 * rg) = b;
    }
}
#define SBAR() __builtin_amdgcn_sched_barrier(0)
#define PINV(x) asm volatile("" : "+v"(x))
constexpr float ATT_THR = 6.0f;
template <int DQK>
__device__ __forceinline__ void attn_item2(const bf16_t* Q, int qpitch, const bf16_t* KA, int kapitch, const bf16_t* KB, int kbpitch,
                                           const bf16_t* V, int vpitch, int ntiles, bf16_t* O, char* lds) {
    const int tid = opaque_tid(), lane = tid & 63, wid = tid >> 6, r32 = lane & 31, hi = lane >> 5;
    const int wu = __builtin_amdgcn_readfirstlane(wid);
    constexpr int ND0 = DQK / 16, NQK = 2 * ND0;
    constexpr bool ROPE = DQK > 64;
    const int krow = 8 * wu + (lane >> 3);
    const bf16_t* gk = KA + (size_t)krow * kapitch + (((lane & 7) ^ ((krow >> 1) & 7)) << 3);
    const bf16_t* gv = V + (size_t)(16 * (wu & 3) + (lane >> 2)) * vpitch + (wu >> 2) * 32 + (lane & 3) * 8;
    const int rrow = 16 * (wu & 3) + (lane >> 2);
    const bf16_t* gr = ROPE ? (KB + (size_t)rrow * kbpitch + (((lane & 3) ^ ((rrow >> 2) & 3)) << 3)) : nullptr;
    char* dk = lds + AT_K + wu * 1024; char* dv = lds + AT_V + wu * 1024; char* dr = lds + AT_KR + (wu & 3) * 1024;
    auto issue = [&](int t, int slot) {
        GLDS16(gk + (size_t)t * 64 * kapitch, dk + slot * AT_BUF); GLDS16(gv + (size_t)t * 64 * vpitch, dv + slot * AT_BUF);
        if (ROPE) GLDS16(gr + (size_t)t * 64 * kbpitch, dr + slot * AT_BUF);
    };
    asm volatile("s_waitcnt vmcnt(0)" ::: "memory");
    issue(0, 0);
    if (ntiles > 1) issue(1, 1);
    bf16x8 qr[ND0];
    { const bf16_t* qp = Q + (size_t)(wid * 32 + r32) * qpitch + hi * 8;
#pragma unroll
      for (int d0 = 0; d0 < ND0; ++d0) qr[d0] = *(const bf16x8*)(qp + d0 * 16); }
    const int kf_off = AT_K + r32 * 128, ksw = (r32 >> 1) & 7;
    const int rf_off = AT_KR + r32 * 64, rsw = (r32 >> 2) & 3;
    const int vf_off = AT_V + (4 * hi + ((lane & 15) >> 2)) * 64 + ((lane >> 4) & 1) * 32 + (lane & 3) * 8;
    auto kfrag = [&](const char* slot, int g) -> bf16x8 {
        const int d0 = g >> 1, n = g & 1;
        if (d0 < 4) return *(const bf16x8*)(slot + kf_off + n * 32 * 128 + (((2 * d0 + hi) ^ ksw) << 4));
        return *(const bf16x8*)(slot + rf_off + n * 32 * 64 + (((2 * (d0 - 4) + hi) ^ rsw) << 4));
    };
    auto vfrag = [&](const char* slot, int g) -> bf16x8 {
        const lds_cptr vb = (lds_cptr)slot + vf_off + (g >> 1) * 1024 + (g & 1) * 4096;
        const s16x4 a0 = vtr(vb), a1 = vtr(vb + 512);
        return (bf16x8){a0[0], a0[1], a0[2], a0[3], a1[0], a1[1], a1[2], a1[3]};
    };
    f32x16 o0, o1, sA0, sA1, sB0, sB1;
    const f32x16 zero16 = {0.f, 0.f, 0.f, 0.f, 0.f, 0.f, 0.f, 0.f, 0.f, 0.f, 0.f, 0.f, 0.f, 0.f, 0.f, 0.f};
#pragma unroll
    for (int r = 0; r < 16; ++r) { o0[r] = 0.f; o1[r] = 0.f; }
    float mref, lrun = 0.f;
    if (ntiles > 1) asm volatile("s_waitcnt vmcnt(%0)" :: "n"(ROPE ? 3 : 2) : "memory"); else asm volatile("s_waitcnt vmcnt(0)" ::: "memory");
    __builtin_amdgcn_s_barrier();
    {
#pragma unroll
        for (int g = 0; g < NQK; ++g) { const bf16x8 kf = kfrag(lds, g);
            if (g & 1) sA1 = MFMA32(kf, qr[g >> 1], g < 2 ? zero16 : sA1); else sA0 = MFMA32(kf, qr[g >> 1], g < 2 ? zero16 : sA0); }
        float mx = fmaxf(sA0[0], sA1[0]);
#pragma unroll
        for (int r = 1; r < 16; ++r) mx = fmaxf(mx, fmaxf(sA0[r], sA1[r]));
        mref = xhalf_max(mx);
    }
    asm volatile("s_waitcnt vmcnt(0) lgkmcnt(0)" ::: "memory");
    __builtin_amdgcn_s_barrier();
    auto step = [&](auto HN, f32x16& c0, f32x16& c1, f32x16& n0, f32x16& n1, int t) __attribute__((always_inline)) {
        const int sl = t % 3, sl1 = (t + 1) % 3, sl2 = (t + 2) % 3;
        const char* cs = lds + sl * AT_BUF; const char* ns = lds + sl1 * AT_BUF;
        constexpr bool has_next = decltype(HN)::value;
        if (t + 2 < ntiles) issue(t + 2, sl2);
        u32x4 pw[4];
        float ls = 0.f;
        bf16x8 kf;
        if (has_next) kf = kfrag(ns, 0);
        SBAR();
#pragma unroll
        for (int g = 0; g < (NQK > 8 ? NQK : 8); ++g) {
            bf16x8 kcur = kf;
            if (has_next && g + 1 < NQK) kf = kfrag(ns, g + 1);
            SBAR();
            if (g < 8) {
                float e0, e1, e2, e3;
                if (g < 4) { e0 = __builtin_amdgcn_exp2f(c0[4 * g] - mref); e1 = __builtin_amdgcn_exp2f(c0[4 * g + 1] - mref); e2 = __builtin_amdgcn_exp2f(c0[4 * g + 2] - mref); e3 = __builtin_amdgcn_exp2f(c0[4 * g + 3] - mref); }
                else { e0 = __builtin_amdgcn_exp2f(c1[4 * (g - 4)] - mref); e1 = __builtin_amdgcn_exp2f(c1[4 * (g - 4) + 1] - mref); e2 = __builtin_amdgcn_exp2f(c1[4 * (g - 4) + 2] - mref); e3 = __builtin_amdgcn_exp2f(c1[4 * (g - 4) + 3] - mref); }
                ls += (e0 + e1) + (e2 + e3);
                const unsigned w0 = cvtpk(e0, e1), w1 = cvtpk(e2, e3);
                if ((g & 1) == 0) { pw[g >> 1][0] = w0; pw[g >> 1][1] = w1; } else { pw[g >> 1][2] = w0; pw[g >> 1][3] = w1; }
                PINV(ls); PINV(pw[g >> 1]);
            }
            SBAR();
            if (has_next && g < NQK) { if (g & 1) n1 = MFMA32(kcur, qr[g >> 1], g < 2 ? zero16 : n1); else n0 = MFMA32(kcur, qr[g >> 1], g < 2 ? zero16 : n0); }
            SBAR();
        }
        lrun += ls;
        float mx = -INFINITY;
        bf16x8 vf = vfrag(cs, 0);
        SBAR();
#pragma unroll
        for (int g = 0; g < 8; ++g) {
            const bf16x8 vcur = vf;
            if (g + 1 < 8) vf = vfrag(cs, g + 1);
            SBAR();
            if (has_next) {
                if (g < 4) mx = fmaxf(fmaxf(mx, fmaxf(n0[4 * g], n0[4 * g + 1])), fmaxf(n0[4 * g + 2], n0[4 * g + 3]));
                else mx = fmaxf(fmaxf(mx, fmaxf(n1[4 * (g - 4)], n1[4 * (g - 4) + 1])), fmaxf(n1[4 * (g - 4) + 2], n1[4 * (g - 4) + 3]));
                PINV(mx);
            }
            SBAR();
            const bf16x8 pf = __builtin_bit_cast(bf16x8, pw[g >> 1]);
            if (g & 1) o1 = MFMA32(vcur, pf, o1); else o0 = MFMA32(vcur, pf, o0);
            SBAR();
        }
        if (has_next) {
            const float gr_ = xhalf_max(mx) - mref;
            if (__any(gr_ > ATT_THR)) {
                const float d = fmaxf(gr_, 0.f), a = __builtin_amdgcn_exp2f(-d);
                mref += d; lrun *= a;
#pragma unroll
                for (int r = 0; r < 16; ++r) { o0[r] *= a; o1[r] *= a; }
            }
        }
        asm volatile("s_waitcnt vmcnt(0) lgkmcnt(0)" ::: "memory");
        __builtin_amdgcn_s_barrier();
    };
    {   const std::integral_constant<bool, true> yes; const std::integral_constant<bool, false> no;
        int t = 0;
        for (; t + 2 < ntiles; t += 2) { step(yes, sA0, sA1, sB0, sB1, t); step(yes, sB0, sB1, sA0, sA1, t + 1); }
        step(yes, sA0, sA1, sB0, sB1, t); step(no, sB0, sB1, sA0, sA1, t + 1); }
    const float inv = 1.0f / xhalf_sum(lrun);
    bf16_t* op = O + (size_t)(wid * 32 + r32) * 512 + 4 * hi;
#pragma unroll
    for (int rg = 0; rg < 4; ++rg) {
        uint2 a; a.x = pack2(o0[4 * rg] * inv, o0[4 * rg + 1] * inv); a.y = pack2(o0[4 * rg + 2] * inv, o0[4 * rg + 3] * inv);
        uint2 b; b.x = pack2(o1[4 * rg] * inv, o1[4 * rg + 1] * inv); b.y = pack2(o1[4 * rg + 2] * inv, o1[4 * rg + 3] * inv);
        *(uint2*)(op + 8 * rg) = a; *(uint2*)(op + 32 + 8 * rg) = b;
    }
}
constexpr int A3_K = 0, A3_KR = 16384, A3_V = 24576, A3_BYTES = 24576 + 3 * 8192;
template <int DQK>
__device__ __forceinline__ void attn_item3(const bf16_t* Q, int qpitch, const bf16_t* KA, int kapitch, const bf16_t* KB, int kbpitch,
                                           const bf16_t* V, int vpitch, int ntiles, bf16_t* O, char* lds) {
    const int tid = opaque_tid(), lane = tid & 63, wid = tid >> 6, r32 = lane & 31, hi = lane >> 5;
    const bool grpB = __builtin_amdgcn_readfirstlane(wid) >= 4;
    constexpr int ND0 = DQK / 16;
    bf16x8 qr[ND0];
    { const bf16_t* qp = Q + (size_t)(wid * 32 + r32) * qpitch + hi * 8;
#pragma unroll
      for (int d0 = 0; d0 < ND0; ++d0) qr[d0] = *(const bf16x8*)(qp + d0 * 16); }
    const int srow = tid >> 3, sch = tid & 7;
    const bf16_t* gk = KA + (size_t)srow * kapitch + sch * 8;
    const bf16_t* gv = V + (size_t)srow * vpitch + sch * 8;
    const bf16_t* gr = (DQK > 64) ? (KB + (size_t)(tid >> 2) * kbpitch + (tid & 3) * 8) : nullptr;
    const int sk_off = A3_K + srow * 128 + ((sch ^ ((srow >> 1) & 7)) << 4);
    const int sv_off = A3_V + (sch >> 2) * 4096 + srow * 64 + (sch & 3) * 16;
    const int sr_off = A3_KR + (tid >> 2) * 64 + (((tid & 3) ^ (((tid >> 2) >> 2) & 3)) << 4);
    const bool do_r = (DQK > 64) && (tid < 256);
    const int kf_off = A3_K + r32 * 128, ksw = (r32 >> 1) & 7;
    const int rf_off = A3_KR + r32 * 64, rsw = (r32 >> 2) & 3;
    const int vf_off = A3_V + (4 * hi + ((lane & 15) >> 2)) * 64 + ((lane >> 4) & 1) * 32 + (lane & 3) * 8;
    uint4 rk, rv, rr; rr = make_uint4(0, 0, 0, 0);
    rk = *(const uint4*)gk; rv = *(const uint4*)gv; if (do_r) rr = *(const uint4*)gr;
    *(uint4*)(lds + sk_off) = rk; *(uint4*)(lds + sv_off) = rv; if (do_r) *(uint4*)(lds + sr_off) = rr;
    __syncthreads();
    f32x16 o0, o1, p0, p1;
#pragma unroll
    for (int r = 0; r < 16; ++r) { o0[r] = 0.f; o1[r] = 0.f; p0[r] = 0.f; p1[r] = 0.f; }
    float mrun = -INFINITY, lrun = 0.f;
    auto H1 = [&](int t) __attribute__((always_inline)) {
        const char* ks = lds + (t & 1) * 8192; const char* rs = lds + (t & 1) * 4096;
#pragma unroll
        for (int r = 0; r < 16; ++r) { p0[r] = 0.f; p1[r] = 0.f; }
#pragma unroll
        for (int d0 = 0; d0 < 4; ++d0) {
            const int co = ((2 * d0 + hi) ^ ksw) << 4;
            const bf16x8 k0 = *(const bf16x8*)(ks + kf_off + co), k1 = *(const bf16x8*)(ks + kf_off + 32 * 128 + co);
            p0 = MFMA32(k0, qr[d0], p0); p1 = MFMA32(k1, qr[d0], p1);
        }
        if (DQK > 64) {
#pragma unroll
            for (int d0 = 4; d0 < ND0; ++d0) {
                const int co = ((2 * (d0 - 4) + hi) ^ rsw) << 4;
                const bf16x8 k0 = *(const bf16x8*)(rs + rf_off + co), k1 = *(const bf16x8*)(rs + rf_off + 32 * 64 + co);
                p0 = MFMA32(k0, qr[d0], p0); p1 = MFMA32(k1, qr[d0], p1);
            }
        }
        float mx = fmaxf(p0[0], p1[0]);
#pragma unroll
        for (int r = 1; r < 16; ++r) mx = fmaxf(mx, fmaxf(p0[r], p1[r]));
        mx = xhalf_max(mx);
        if (__any(mx > mrun + ATT_THR)) {
            const float mnew = fmaxf(mrun, mx), alpha = __builtin_amdgcn_exp2f(mrun - mnew);
            lrun *= alpha;
#pragma unroll
            for (int r = 0; r < 16; ++r) { o0[r] *= alpha; o1[r] *= alpha; }
            mrun = mnew;
        }
    };
    auto H2 = [&](int t) __attribute__((always_inline)) {
        const char* vs = lds + (t % 3) * 8192;
        float ls = 0.f;
#pragma unroll
        for (int r = 0; r < 16; ++r) { p0[r] = __builtin_amdgcn_exp2f(p0[r] - mrun); p1[r] = __builtin_amdgcn_exp2f(p1[r] - mrun); ls += p0[r] + p1[r]; }
        lrun += ls;
#pragma unroll
        for (int s = 0; s < 4; ++s) {
            bf16x8 pf;
            {   unsigned w0, w1, w2, w3;
                if (s < 2) { w0 = cvtpk(p0[8 * s], p0[8 * s + 1]); w1 = cvtpk(p0[8 * s + 2], p0[8 * s + 3]); w2 = cvtpk(p0[8 * s + 4], p0[8 * s + 5]); w3 = cvtpk(p0[8 * s + 6], p0[8 * s + 7]); }
                else { const int s2 = s - 2; w0 = cvtpk(p1[8 * s2], p1[8 * s2 + 1]); w1 = cvtpk(p1[8 * s2 + 2], p1[8 * s2 + 3]); w2 = cvtpk(p1[8 * s2 + 4], p1[8 * s2 + 5]); w3 = cvtpk(p1[8 * s2 + 6], p1[8 * s2 + 7]); }
                u32x4 u = {w0, w1, w2, w3}; pf = __builtin_bit_cast(bf16x8, u); }
            const lds_cptr vb = (lds_cptr)vs + vf_off + s * 1024;
            const s16x4 a0 = vtr(vb), a1 = vtr(vb + 512), b0 = vtr(vb + 4096), b1 = vtr(vb + 4096 + 512);
            const bf16x8 v0 = (bf16x8){a0[0], a0[1], a0[2], a0[3], a1[0], a1[1], a1[2], a1[3]};
            const bf16x8 v1 = (bf16x8){b0[0], b0[1], b0[2], b0[3], b1[0], b1[1], b1[2], b1[3]};
            o0 = MFMA32(v0, pf, o0); o1 = MFMA32(v1, pf, o1);
        }
    };
#define A3_LOAD(t) do { rk = *(const uint4*)(gk + (size_t)((t) + 1) * 64 * kapitch); rv = *(const uint4*)(gv + (size_t)((t) + 1) * 64 * vpitch); if (do_r) rr = *(const uint4*)(gr + (size_t)((t) + 1) * 64 * kbpitch); } while (0)
#define A3_WRITE(t) do { const int kn = ((t) + 1) & 1, vn = ((t) + 1) % 3; *(uint4*)(lds + kn * 8192 + sk_off) = rk; *(uint4*)(lds + vn * 8192 + sv_off) = rv; if (do_r) *(uint4*)(lds + kn * 4096 + sr_off) = rr; } while (0)
    if (grpB) {
        { const bool more = (1 < ntiles); if (more) A3_LOAD(0); H1(0); if (more) A3_WRITE(0); __syncthreads(); }
        for (int t = 1; t < ntiles; ++t) {
            const bool more = (t + 1 < ntiles);
            if (more) A3_LOAD(t);
            H2(t - 1); H1(t);
            if (more) A3_WRITE(t);
            __syncthreads();
        }
    } else {
        for (int t = 0; t < ntiles; ++t) {
            const bool more = (t + 1 < ntiles);
            if (more) A3_LOAD(t);
            H1(t); H2(t);
            if (more) A3_WRITE(t);
            __syncthreads();
        }
    }
#undef A3_LOAD
#undef A3_WRITE
    if (grpB) H2(ntiles - 1);
    const float inv = 1.0f / xhalf_sum(lrun);
    bf16_t* op = O + (size_t)(wid * 32 + r32) * 512 + 4 * hi;
#pragma unroll
    for (int rg = 0; rg < 4; ++rg) {
        uint2 a; a.x = pack2(o0[4 * rg] * inv, o0[4 * rg + 1] * inv); a.y = pack2(o0[4 * rg + 2] * inv, o0[4 * rg + 3] * inv);
        uint2 b; b.x = pack2(o1[4 * rg] * inv, o1[4 * rg + 1] * inv); b.y = pack2(o1[4 * rg + 2] * inv, o1[4 * rg + 3] * inv);
        *(uint2*)(op + 8 * rg) = a; *(uint2*)(op + 32 + 8 * rg) = b;
    }
    __syncthreads();
}
template <int DQK>
__device__ __forceinline__ void attn_item4(const bf16_t* Q, int qpitch, const bf16_t* KA, int kapitch, const bf16_t* KB, int kbpitch,
                                           const bf16_t* V, int vpitch, int ntiles, float ref_const, float kmax2, bf16_t* O, char* lds) {
    const int tid = opaque_tid(), lane = tid & 63, wid = tid >> 6, r32 = lane & 31, hi = lane >> 5;
    constexpr int ND0 = DQK / 16;
    bf16x8 qr[ND0];
    { const bf16_t* qp = Q + (size_t)(wid * 32 + r32) * qpitch + hi * 8;
#pragma unroll
      for (int d0 = 0; d0 < ND0; ++d0) qr[d0] = *(const bf16x8*)(qp + d0 * 16); }
    float mref = ref_const;
    if (DQK > 64) {
        float qn2 = 0.f;
#pragma unroll
        for (int d0 = 0; d0 < ND0; ++d0)
#pragma unroll
            for (int j = 0; j < 8; ++j) { const float v = bf2f((bf16_t)qr[d0][j]); qn2 = fmaf(v, v, qn2); }
        qn2 = xhalf_sum(qn2);
        mref = sqrtf(qn2 * kmax2) * 1.01f + 0.01f;
    }
    f32x16 negm;
#pragma unroll
    for (int r = 0; r < 16; ++r) negm[r] = -mref;
    const int srow = tid >> 3, sch = tid & 7;
    const bf16_t* gk = KA + (size_t)srow * kapitch + sch * 8;
    const bf16_t* gv = V + (size_t)srow * vpitch + sch * 8;
    const bf16_t* gr = (DQK > 64) ? (KB + (size_t)(tid >> 2) * kbpitch + (tid & 3) * 8) : nullptr;
    const int sk_off = AT_K + srow * 128 + ((sch ^ ((srow >> 1) & 7)) << 4);
    const int sv_off = AT_V + (sch >> 2) * 4096 + srow * 64 + (sch & 3) * 16;
    const int sr_off = AT_KR + (tid >> 2) * 64 + (((tid & 3) ^ (((tid >> 2) >> 2) & 3)) << 4);
    const bool do_r = (DQK > 64) && (tid < 256);
    const int kf_off = AT_K + r32 * 128, ksw = (r32 >> 1) & 7;
    const int rf_off = AT_KR + r32 * 64, rsw = (r32 >> 2) & 3;
    const int vf_off = AT_V + (4 * hi + ((lane & 15) >> 2)) * 64 + ((lane >> 4) & 1) * 32 + (lane & 3) * 8;
    uint4 rk, rv, rr; rr = make_uint4(0, 0, 0, 0);
    rk = *(const uint4*)gk; rv = *(const uint4*)gv; if (do_r) rr = *(const uint4*)gr;
    *(uint4*)(lds + sk_off) = rk; *(uint4*)(lds + sv_off) = rv; if (do_r) *(uint4*)(lds + sr_off) = rr;
    __syncthreads();
    f32x16 o0, o1;
#pragma unroll
    for (int r = 0; r < 16; ++r) { o0[r] = 0.f; o1[r] = 0.f; }
    float lrun = 0.f;
#pragma unroll 1
    for (int t = 0; t < ntiles; ++t) {
        const char* cur = lds + (t & 1) * AT_BUF; char* nxt = lds + ((t + 1) & 1) * AT_BUF;
        const bool more = (t + 1 < ntiles);
        if (more) { rk = *(const uint4*)(gk + (size_t)(t + 1) * 64 * kapitch); rv = *(const uint4*)(gv + (size_t)(t + 1) * 64 * vpitch); if (do_r) rr = *(const uint4*)(gr + (size_t)(t + 1) * 64 * kbpitch); }
        bf16x8 kf[8];
#pragma unroll
        for (int d0 = 0; d0 < 4; ++d0) { const int co = ((2 * d0 + hi) ^ ksw) << 4; kf[2 * d0] = *(const bf16x8*)(cur + kf_off + co); kf[2 * d0 + 1] = *(const bf16x8*)(cur + kf_off + 32 * 128 + co); }
        f32x16 p0, p1;
        p0 = MFMA32(kf[0], qr[0], negm); p1 = MFMA32(kf[1], qr[0], negm);
        p0 = MFMA32(kf[2], qr[1], p0); p1 = MFMA32(kf[3], qr[1], p1);
        if (DQK > 64) {
            __builtin_amdgcn_sched_barrier(0);
#pragma unroll
            for (int d0 = 4; d0 < ND0; ++d0) { const int co = ((2 * (d0 - 4) + hi) ^ rsw) << 4; kf[2 * (d0 - 4)] = *(const bf16x8*)(cur + rf_off + co); kf[2 * (d0 - 4) + 1] = *(const bf16x8*)(cur + rf_off + 32 * 64 + co); }
        }
        p0 = MFMA32(kf[4], qr[2], p0); p1 = MFMA32(kf[5], qr[2], p1);
        p0 = MFMA32(kf[6], qr[3], p0); p1 = MFMA32(kf[7], qr[3], p1);
        if (DQK > 64) {
#pragma unroll
            for (int d0 = 4; d0 < ND0; ++d0) { p0 = MFMA32(kf[2 * (d0 - 4)], qr[d0], p0); p1 = MFMA32(kf[2 * (d0 - 4) + 1], qr[d0], p1); }
        }
        bf16x8 vf[8];
        auto vload = [&](int s) __attribute__((always_inline)) {
            const lds_cptr vb = (lds_cptr)cur + vf_off + s * 1024;
            const s16x4 a0 = vtr(vb), a1 = vtr(vb + 512), b0 = vtr(vb + 4096), b1 = vtr(vb + 4096 + 512);
            vf[2 * s] = (bf16x8){a0[0], a0[1], a0[2], a0[3], a1[0], a1[1], a1[2], a1[3]};
            vf[2 * s + 1] = (bf16x8){b0[0], b0[1], b0[2], b0[3], b1[0], b1[1], b1[2], b1[3]};
        };
        vload(0); vload(1);
        float ls = 0.f;
#pragma unroll
        for (int s = 0; s < 4; ++s) {
            float e[8];
#pragma unroll
            for (int j = 0; j < 8; ++j) e[j] = __builtin_amdgcn_exp2f(s < 2 ? p0[8 * s + j] : p1[8 * (s - 2) + j]);
            ls += ((e[0] + e[1]) + (e[2] + e[3])) + ((e[4] + e[5]) + (e[6] + e[7]));
            u32x4 u = {cvtpk(e[0], e[1]), cvtpk(e[2], e[3]), cvtpk(e[4], e[5]), cvtpk(e[6], e[7])};
            const bf16x8 pf = __builtin_bit_cast(bf16x8, u);
            if (s + 2 < 4) vload(s + 2);
            o0 = MFMA32(vf[2 * s], pf, o0); o1 = MFMA32(vf[2 * s + 1], pf, o1);
        }
        lrun += ls;
        if (more) { *(uint4*)(nxt + sk_off) = rk; *(uint4*)(nxt + sv_off) = rv; if (do_r) *(uint4*)(nxt + sr_off) = rr; }
        __syncthreads();
    }
    const float inv = 1.0f / xhalf_sum(lrun);
    bf16_t* op = O + (size_t)(wid * 32 + r32) * 512 + 4 * hi;
#pragma unroll
    for (int rg = 0; rg < 4; ++rg) {
        uint2 a; a.x = pack2(o0[4 * rg] * inv, o0[4 * rg + 1] * inv); a.y = pack2(o0[4 * rg + 2] * inv, o0[4 * rg + 3] * inv);
        uint2 b; b.x = pack2(o1[4 * rg] * inv, o1[4 * rg + 1] * inv); b.y = pack2(o1[4 * rg + 2] * inv, o1[4 * rg + 3] * inv);
        *(uint2*)(op + 8 * rg) = a; *(uint2*)(op + 32 + 8 * rg) = b;
    }
}
constexpr int A7_K = 0, A7_V = 8192, A7_KR = 16384, A7_BUF = 20480;
template <int DQK>
__device__ __forceinline__ void attn_item7(const bf16_t* Q, int qpitch, const bf16_t* KA, int kapitch, const bf16_t* KB, int kbpitch,
                                           const bf16_t* V, int vpitch, int ntiles, float ref_const, float kmax2, bf16_t* O, char* lds) {
    const int tid = opaque_tid(), lane = tid & 63, wid = tid >> 6, fr = lane & 15, g = lane >> 4;
    constexpr int NKS = DQK / 32;
    bf16x8 qr[2][NKS];
#pragma unroll
    for (int qi = 0; qi < 2; ++qi) { const bf16_t* qp = Q + (size_t)(wid * 32 + 16 * qi + fr) * qpitch + 8 * g;
#pragma unroll
        for (int ks = 0; ks < NKS; ++ks) qr[qi][ks] = *(const bf16x8*)(qp + 32 * ks); }
    f32x4 negm[2];
#pragma unroll
    for (int qi = 0; qi < 2; ++qi) {
        float mref = ref_const;
        if (DQK > 64) {
            float qn2 = 0.f;
#pragma unroll
            for (int ks = 0; ks < NKS; ++ks)
#pragma unroll
                for (int j = 0; j < 8; ++j) { const float v = bf2f((bf16_t)qr[qi][ks][j]); qn2 = fmaf(v, v, qn2); }
            qn2 += __shfl_xor(qn2, 16); qn2 += __shfl_xor(qn2, 32);
            mref = sqrtf(qn2 * kmax2) * 1.01f + 0.01f;
        }
        negm[qi][0] = -mref; negm[qi][1] = -mref; negm[qi][2] = -mref; negm[qi][3] = -mref;
    }
    const int srow = tid >> 3, sch = tid & 7;
    const bf16_t* gk = KA + (size_t)srow * kapitch + sch * 8;
    const bf16_t* gv = V + (size_t)srow * vpitch + sch * 8;
    const bf16_t* gr = (DQK > 64) ? (KB + (size_t)(tid >> 2) * kbpitch + (tid & 3) * 8) : nullptr;
    const int sk_off = A7_K + srow * 128 + ((sch ^ ((srow >> 1) & 7)) << 4);
    const int sv_off = A7_V + (sch >> 1) * 2048 + srow * 32 + (sch & 1) * 16;
    const int sr_off = A7_KR + (tid >> 2) * 64 + ((((tid & 3) + 2 * ((tid >> 2) >> 2)) & 3) << 4);
    const bool do_r = (DQK > 64) && (tid < 256);
    const int kf_off = A7_K + fr * 128, ksw = (fr >> 1) & 7;
    const int rf_off = A7_KR + fr * 64 + (((g + 2 * (fr >> 2)) & 3) << 4);
    const int vf_off = A7_V + (4 * g + (fr >> 2)) * 32 + (fr & 3) * 8;
    uint4 rk, rv, rr; rr = make_uint4(0, 0, 0, 0);
    rk = *(const uint4*)gk; rv = *(const uint4*)gv; if (do_r) rr = *(const uint4*)gr;
    *(uint4*)(lds + sk_off) = rk; *(uint4*)(lds + sv_off) = rv; if (do_r) *(uint4*)(lds + sr_off) = rr;
    __syncthreads();
    f32x4 o[4][2]; float lsum[2] = {0.f, 0.f};
#pragma unroll
    for (int di = 0; di < 4; ++di)
#pragma unroll
        for (int qi = 0; qi < 2; ++qi) { o[di][qi][0] = 0.f; o[di][qi][1] = 0.f; o[di][qi][2] = 0.f; o[di][qi][3] = 0.f; }
#pragma unroll 1
    for (int t = 0; t < ntiles; ++t) {
        const char* cur = lds + (t & 1) * A7_BUF; char* nxt = lds + ((t + 1) & 1) * A7_BUF;
        const bool more = (t + 1 < ntiles);
        if (more) { rk = *(const uint4*)(gk + (size_t)(t + 1) * 64 * kapitch); rv = *(const uint4*)(gv + (size_t)(t + 1) * 64 * vpitch); if (do_r) rr = *(const uint4*)(gr + (size_t)(t + 1) * 64 * kbpitch); }
        f32x4 s[4][2];
#pragma unroll
        for (int ks = 0; ks < NKS; ++ks) {
            bf16x8 kf[4];
#pragma unroll
            for (int kj = 0; kj < 4; ++kj)
                kf[kj] = (ks < 2) ? *(const bf16x8*)(cur + kf_off + kj * 2048 + (((4 * ks + g) ^ ksw) << 4)) : *(const bf16x8*)(cur + rf_off + kj * 1024);
#pragma unroll
            for (int kj = 0; kj < 4; ++kj)
#pragma unroll
                for (int qi = 0; qi < 2; ++qi) s[kj][qi] = MFMA16(kf[kj], qr[qi][ks], ks == 0 ? negm[qi] : s[kj][qi]);
        }
#pragma unroll
        for (int kk = 0; kk < 2; ++kk) {
            bf16x8 vf[4];
#pragma unroll
            for (int di = 0; di < 4; ++di) {
                const lds_cptr vb = (lds_cptr)cur + vf_off + di * 2048 + kk * 1024;
                const s16x4 a0 = vtr(vb), a1 = vtr(vb + 512);
                vf[di] = (bf16x8){a0[0], a0[1], a0[2], a0[3], a1[0], a1[1], a1[2], a1[3]};
            }
            bf16x8 pf[2];
#pragma unroll
            for (int qi = 0; qi < 2; ++qi) {
                float e[8];
#pragma unroll
                for (int j = 0; j < 4; ++j) { e[j] = __builtin_amdgcn_exp2f(s[2 * kk][qi][j]); e[4 + j] = __builtin_amdgcn_exp2f(s[2 * kk + 1][qi][j]); }
                lsum[qi] += ((e[0] + e[1]) + (e[2] + e[3])) + ((e[4] + e[5]) + (e[6] + e[7]));
                u32x4 u = {cvtpk(e[0], e[1]), cvtpk(e[2], e[3]), cvtpk(e[4], e[5]), cvtpk(e[6], e[7])};
                pf[qi] = __builtin_bit_cast(bf16x8, u);
            }
#pragma unroll
            for (int di = 0; di < 4; ++di) { o[di][0] = MFMA16(vf[di], pf[0], o[di][0]); o[di][1] = MFMA16(vf[di], pf[1], o[di][1]); }
        }
        if (more) { *(uint4*)(nxt + sk_off) = rk; *(uint4*)(nxt + sv_off) = rv; if (do_r) *(uint4*)(nxt + sr_off) = rr; }
        __syncthreads();
    }
#pragma unroll
    for (int qi = 0; qi < 2; ++qi) {
        float l = lsum[qi]; l += __shfl_xor(l, 16); l += __shfl_xor(l, 32);
        const float inv = 1.0f / l;
        bf16_t* op = O + (size_t)(wid * 32 + 16 * qi + fr) * 512 + 4 * g;
#pragma unroll
        for (int di = 0; di < 4; ++di) *(uint2*)(op + 16 * di) = pack4(o[di][qi] * inv);
    }
}
__device__ __forceinline__ void attn_dispatch(const KP& p, int ty, int h, int qt, float gqa_ref, char* lds) {
    const bf16_t* P = WSP(bf16_t, OFF_P); const bf16_t* Qm = WSP(bf16_t, OFF_H); const bf16_t* Kn = WSP(bf16_t, OFF_KN); const bf16_t* Vm = WSP(bf16_t, OFF_V);
    const int ntiles = (qt == 0) ? (LC / 64) : (T / 64);
    const size_t r0 = (size_t)qt * 256;
    bf16_t* Om = WSP(bf16_t, OFF_OM); bf16_t* Og = WSP(bf16_t, OFF_OG);
    if (ty == 0) {
        const float kmax2 = __uint_as_float(WSP(unsigned, OFF_CNT)[32 + h]);
        attn_item7<96>(Qm + r0 * 768 + h * 96, 768, Kn + h * 64, 512, P + C_KR, PP, Vm + h * 64, 512, ntiles, 0.f, kmax2, Om + r0 * 512 + h * 64, lds);
    } else
        attn_item7<64>(P + r0 * PP + C_GQ + h * 64, PP, P + C_GK + (h >> 2) * 64, PP, nullptr, 0, P + C_GV + (h >> 2) * 64, PP, ntiles, gqa_ref, 0.f, Og + r0 * 512 + h * 64, lds);
}
__device__ __forceinline__ void st_attn(const KP& p, int l, int bid, int nb, char* lds) {
    const int tidx = opaque_tid();
    float gq = fabsf(p.in(I_GQN)[l * 64 + (tidx & 63)]), gk = fabsf(p.in(I_GKN)[l * 64 + (tidx & 63)]);
#pragma unroll
    for (int o = 32; o > 0; o >>= 1) { gq = fmaxf(gq, __shfl_xor(gq, o)); gk = fmaxf(gk, __shfl_xor(gk, o)); }
    const float gqa_ref = 64.0f * SC_GQA * gq * gk * 1.02f + 0.01f;
    for (int ty = 0; ty < 2; ++ty)
        for (int u = bid; u < 512; u += nb) attn_dispatch(p, ty, u & 7, 1 + (u >> 3), gqa_ref, lds);
    for (int u = bid; u < 16; u += nb) attn_dispatch(p, u >> 3, u & 7, 0, gqa_ref, lds);
}

__device__ __forceinline__ void st_merge(const KP& p, int l, int bid, int nb, char* lds) {
    const int tidx = opaque_tid();
    const bf16_t* P = WSP(bf16_t, OFF_P); bf16_t* Mb = WSP(bf16_t, OFF_H);
    const bf16_t* Wb = WSP(bf16_t, OFF_WB + WB_BR);
    int mt, nt;
    for (int it = 0; dense_tile(it, 8, l + 1 < NL, bid, nb, mt, nt); ++it) {
        acc_t tot; acc_zero(tot);
#pragma unroll 1
        for (int b = 0; b < 3; ++b) {
            const bf16_t* Ob = b == 1 ? P + C_SSM : WSP(bf16_t, b == 0 ? OFF_OM : OFF_OG); const int opitch = b == 1 ? PP : 512;
            acc_t acc; acc_zero(acc);
            gemm_core(acc, [&](int r) { return Ob + (size_t)(mt * 256 + r) * opitch; }, [&](int r) { return Wb + ((size_t)b * 1024 + nt * 128 + r) * 512; }, 512, lds);
            acc_visit_add(acc, tot, [&](int ml, int nl, f32x4 v) {
                const int wm_ = ml >> 6, im_ = (ml >> 4) & 3, fr_ = ml & 15, G_ = b * 64 + nt * 8 + (nl >> 4), g_ = (nl >> 2) & 3;
                const uint2 gr = *(const uint2*)(WSP(bf16_t, OFF_GS) + (((((size_t)(mt * 192 + G_) * 4 + wm_) * 4 + im_) * 64) + g_ * 16 + fr_) * 4);
                f32x4 r; r[0] = bflo(gr.x) * v[0]; r[1] = bfhi(gr.x) * v[1]; r[2] = bflo(gr.y) * v[2]; r[3] = bfhi(gr.y) * v[3];
                return r; });
        }
        acc_visit(tot, [&](int ml, int nl, f32x4 v) { *(uint2*)(Mb + (size_t)(mt * 256 + ml) * 1024 + nt * 128 + nl) = pack4(v); });
    }
}
__device__ __forceinline__ void st_wout(const KP& p, int l, int bid, int nb, char* lds) {
    const int tidx = opaque_tid();
    const bf16_t* Mb = WSP(bf16_t, OFF_H); const bf16_t* Wt = WSP(bf16_t, OFF_WB + WB_OUT); float* Y = WSP(float, OFF_Y);
    int mt, nt;
    for (int it = 0; dense_tile(it, 4, l + 1 < NL, bid, nb, mt, nt); ++it) {
        acc_t acc[2]; acc_zero(acc[0]); acc_zero(acc[1]);
        gemm_core256_dense(acc, Mb + (size_t)mt * 256 * 1024, 1024, Wt + (size_t)nt * 256 * 1024, 1024, 1024, lds);
#pragma unroll
        for (int nh = 0; nh < 2; ++nh)
            acc_visit2(acc[nh], [&](int ml, int nl, f32x4 v) { *(f32x4*)(Y + (size_t)(mt * 256 + ml) * 1024 + nt * 256 + nh * 128 + nl) = v; });
    }
    int* sltok = WSP(int, OFF_SLTOK); float* slw = WSP(float, OFF_SLW); int* cnt = WSP(int, OFF_CNT);
#pragma unroll 1
    for (int i = bid * NTH + tidx; i < TP; i += nb * NTH) { sltok[i] = 0; slw[i] = 0.f; asm volatile("" : "+v"(i)); }
    if (bid == 0 && tidx < 32) cnt[tidx] = 0;
}

__device__ __forceinline__ void st_postmix(const KP& p, int l, int bid, int nb, char* lds) {
    const int tidx = opaque_tid();
    const int lane = tidx & 63, wid = tidx >> 6;
    const float* Y = WSP(float, OFF_Y); bf16_t* H2 = WSP(bf16_t, OFF_H);
    const float* gpost = p.in(I_GPOSTMIX) + l * D; const float* gpre = p.in(I_GPREFFN) + l * D;
    int* toke = WSP(int, OFF_TOKE); float* tokw = WSP(float, OFF_TOKW); int* cnt = WSP(int, OFF_CNT);
    float* wl = (float*)lds; int* hist = (int*)(lds + 20 * 1024 * 4);
    {   const float* wg = p.in(I_WGROUP) + (size_t)l * D * 4; const float* wr = p.in(I_WROUTER) + (size_t)l * D * 16;
        for (int k = tidx; k < 1024; k += NTH) {
            const float4 g4 = *(const float4*)(wg + (size_t)k * 4);
            wl[0 * 1024 + k] = g4.x; wl[1 * 1024 + k] = g4.y; wl[2 * 1024 + k] = g4.z; wl[3 * 1024 + k] = g4.w;
#pragma unroll
            for (int e4 = 0; e4 < 4; ++e4) { const float4 r4 = *(const float4*)(wr + (size_t)k * 16 + e4 * 4);
                wl[(4 + e4 * 4 + 0) * 1024 + k] = r4.x; wl[(4 + e4 * 4 + 1) * 1024 + k] = r4.y; wl[(4 + e4 * 4 + 2) * 1024 + k] = r4.z; wl[(4 + e4 * 4 + 3) * 1024 + k] = r4.w; }
        }
        if (tidx < 16) hist[tidx] = 0;
        __syncthreads(); }
    auto ld = [&](int r, float4 (&y)[4], float4 (&x)[4]) __attribute__((always_inline)) {
        const float* xs = l == 0 ? xrow_in(p, r) : xrow_c(p, r);
#pragma unroll
        for (int i = 0; i < 4; ++i) { y[i] = *(const float4*)(Y + (size_t)r * D + i * 256 + lane * 4); x[i] = *(const float4*)(xs + i * 256 + lane * 4); }
    };
    auto proc = [&](int r, float4 (&y)[4], float4 (&x)[4]) __attribute__((always_inline)) {
        float* xr = xrow(p, r);
        const float* md = WSP(float, OFF_MOD) + (size_t)(l * 2 + (r < LC ? 1 : 0)) * 6144;
        float ss = 0.f;
#pragma unroll
        for (int i = 0; i < 4; ++i) ss += y[i].x * y[i].x + y[i].y * y[i].y + y[i].z * y[i].z + y[i].w * y[i].w;

        ss = wave_sum(ss);
        const float rstd = rsqrtf(ss * (1.0f / D) + EPS);
        float ss2 = 0.f;
#pragma unroll
        for (int i = 0; i < 4; ++i) { const int c = i * 256 + lane * 4;
            const float4 gg = *(const float4*)(gpost + c), ga = *(const float4*)(md + 2048 + c);
            x[i].x += ga.x * y[i].x * rstd * gg.x; x[i].y += ga.y * y[i].y * rstd * gg.y; x[i].z += ga.z * y[i].z * rstd * gg.z; x[i].w += ga.w * y[i].w * rstd * gg.w;
            *(float4*)(xr + c) = x[i];
            ss2 += x[i].x * x[i].x + x[i].y * x[i].y + x[i].z * x[i].z + x[i].w * x[i].w; }
        ss2 = wave_sum(ss2);
        const float rstd2 = rsqrtf(ss2 * (1.0f / D) + EPS);
        float lg[4] = {0.f, 0.f, 0.f, 0.f}, le[16];
#pragma unroll
        for (int e = 0; e < 16; ++e) le[e] = 0.f;
#pragma unroll
        for (int i = 0; i < 4; ++i) { const int c = i * 256 + lane * 4;
            const float4 gg = *(const float4*)(gpre + c), sh = *(const float4*)(md + 3072 + c), sc = *(const float4*)(md + 4096 + c);
            float h[4];
            h[0] = x[i].x * rstd2 * gg.x * (1.f + sc.x) + sh.x; h[1] = x[i].y * rstd2 * gg.y * (1.f + sc.y) + sh.y;
            h[2] = x[i].z * rstd2 * gg.z * (1.f + sc.z) + sh.z; h[3] = x[i].w * rstd2 * gg.w * (1.f + sc.w) + sh.w;
            uint2 o; o.x = pack2(h[0], h[1]); o.y = pack2(h[2], h[3]);
            *(uint2*)(H2 + (size_t)r * D + c) = o;
#pragma unroll
            for (int e = 0; e < 4; ++e) { const float4 w4 = *(const float4*)(wl + e * 1024 + c);
                lg[e] = fmaf(h[0], w4.x, lg[e]); lg[e] = fmaf(h[1], w4.y, lg[e]); lg[e] = fmaf(h[2], w4.z, lg[e]); lg[e] = fmaf(h[3], w4.w, lg[e]); }
#pragma unroll
            for (int e = 0; e < 16; ++e) { const float4 w4 = *(const float4*)(wl + (4 + e) * 1024 + c);
                le[e] = fmaf(h[0], w4.x, le[e]); le[e] = fmaf(h[1], w4.y, le[e]); le[e] = fmaf(h[2], w4.z, le[e]); le[e] = fmaf(h[3], w4.w, le[e]); }
        }
#pragma unroll
        for (int g = 0; g < 4; ++g) lg[g] = wave_sum(lg[g]) + p.in(I_BGROUP)[l * 4 + g];
        const float myle = transpose_reduce16(le, lane) + p.in(I_BROUTER)[l * 16 + (lane & 15)];
        int gs = 0; float gm = lg[0];
#pragma unroll
        for (int g = 1; g < 4; ++g) if (lg[g] > gm) { gm = lg[g]; gs = g; }
        float ls[4];
#pragma unroll
        for (int i = 0; i < 4; ++i) ls[i] = __shfl(myle, gs * 4 + i);
        if (lane == 0) {
            float den = 0.f;
#pragma unroll
            for (int g = 0; g < 4; ++g) den += __expf(lg[g] - gm);
            const float pg = 1.0f / den;
            int i0 = 0; float m0 = ls[0];
#pragma unroll
            for (int i = 1; i < 4; ++i) if (ls[i] > m0) { m0 = ls[i]; i0 = i; }
            int i1 = -1; float m1 = -INFINITY;
#pragma unroll
            for (int i = 0; i < 4; ++i) if (i != i0 && ls[i] > m1) { m1 = ls[i]; i1 = i; }
            const float e1 = __expf(m1 - m0), w0 = pg / (1.f + e1), w1 = pg * e1 / (1.f + e1);
            const int ex0 = gs * 4 + i0, ex1 = gs * 4 + i1;
            toke[r * 2] = ex0; toke[r * 2 + 1] = ex1; tokw[r * 2] = w0; tokw[r * 2 + 1] = w1;
            atomicAdd(&hist[ex0], 1); atomicAdd(&hist[ex1], 1);
        }
        };
    {   const int r0 = (l + 1 < NL ? 0 : LC) + bid * NWV + wid, rs = nb * NWV;
        float4 ya[4], xa[4], yb[4], xb[4];
        if (r0 < T) ld(r0, ya, xa);
        for (int r = r0; r < T; r += 2 * rs) {
            if (r + rs < T) ld(r + rs, yb, xb);
            proc(r, ya, xa);
            if (r + rs < T) { if (r + 2 * rs < T) ld(r + 2 * rs, ya, xa); proc(r + rs, yb, xb); }
        } }
    __syncthreads();
    if (tidx < 16 && hist[tidx] != 0) atomicAdd(&cnt[tidx], hist[tidx]);
}

__device__ __forceinline__ void moe_offsets(const int* cnt, int* off) {
    int a = 0;
#pragma unroll
    for (int e = 0; e < 16; ++e) { off[e] = a; a += (cnt[e] + 255) & ~255; }
    off[16] = a;
}
__device__ __forceinline__ int moe_expert_of(const int* off, int j) {
    int e = 0;
#pragma unroll
    for (int k = 1; k < 16; ++k) e += (j >= off[k]) ? 1 : 0;
    return e;
}
__device__ __forceinline__ void st_moe_build(const KP& p, int l, int bid, int nb, char* lds) {
    const int tidx = opaque_tid();
    int* cnt = WSP(int, OFF_CNT); int* cnt2 = cnt + 16;
    const int* toke = WSP(int, OFF_TOKE); const float* tokw = WSP(float, OFF_TOKW); int* toks = WSP(int, OFF_TOKS);
    int* sltok = WSP(int, OFF_SLTOK); float* slw = WSP(float, OFF_SLW);
    int* lcnt = (int*)lds; int* lbase = lcnt + 16;
    int off[17]; moe_offsets(cnt, off);
    const int first = (l + 1 < NL ? 0 : 2 * LC), total = 2 * T - first, per = (total + nb - 1) / nb;
    const int beg = first + bid * per, end = min(beg + per, 2 * T);
    __syncthreads();
    if (tidx < 16) lcnt[tidx] = 0;
    __syncthreads();
    const int idx = beg + tidx; const bool act = (tidx < per) && (idx < end);
    int e = 0, rank = 0;
    if (act) { e = toke[idx]; rank = atomicAdd(&lcnt[e], 1); }
    __syncthreads();
    if (tidx < 16) lbase[tidx] = lcnt[tidx] ? atomicAdd(&cnt2[tidx], lcnt[tidx]) : 0;
    __syncthreads();
    if (act) {
        int o = 0;
#pragma unroll
        for (int k = 0; k < 16; ++k) o = (e == k) ? off[k] : o;
        const int pos = o + lbase[e] + rank;
        sltok[pos] = idx >> 1; slw[pos] = tokw[idx]; toks[idx] = pos;
    }
}
__device__ __forceinline__ bool moe_tile(int r, int M2, int bid, int nb, int& mt, int& pn) {
    const int x = bid & 7, j = bid >> 3, q = nb >> 5;
    mt = (r * 8 + x) * q + (j % q); pn = j / q;
    return mt < M2 && pn < 4;
}
__device__ __forceinline__ void st_moe_up(const KP& p, int bid, int nb, char* lds) {
    const int tidx = opaque_tid();
    const int* cnt = WSP(int, OFF_CNT); const int* sltok = WSP(int, OFF_SLTOK);
    const bf16_t* H2 = WSP(bf16_t, OFF_H); const bf16_t* Wg = WSP(bf16_t, OFF_WB + WB_EG); bf16_t* Hid = WSP(bf16_t, OFF_HID);
    int off[17]; moe_offsets(cnt, off);
    const int M2 = off[16] >> 8;
    const int srow = tidx >> 3, gch = (tidx & 7) ^ ((srow >> 1) & 7);
    auto upin = [](const char* q) { const unsigned long long v = (unsigned long long)q; const unsigned lo = __builtin_amdgcn_readfirstlane((unsigned)v), hi = __builtin_amdgcn_readfirstlane((unsigned)(v >> 32)); return (const char*)(((unsigned long long)hi << 32) | lo); };
    const unsigned vw = (unsigned)(((srow >> 4) & 1) ? (unsigned)(WB_EU - WB_EG) : 0u) + (unsigned)(((((srow >> 5) & 1) * 16 + (srow & 15)) * 1024 + gch * 8) * 2);
    int mt, pn;
    for (int r = 0; r * 8 * (nb >> 5) < M2; ++r) {
        if (!moe_tile(r, M2, bid, nb, mt, pn)) continue;
        const int e = __builtin_amdgcn_readfirstlane(moe_expert_of(off, mt * 256));
        unsigned xo[2][2];
#pragma unroll
        for (int h = 0; h < 2; ++h)
#pragma unroll
            for (int i = 0; i < 2; ++i) xo[h][i] = (unsigned)sltok[mt * 256 + h * 128 + srow + 64 * i] * 2048u + (unsigned)gch * 16u;
        acc_t acc[2]; acc_zero(acc[0]); acc_zero(acc[1]);
        gemm_core256(acc, [&](int h, int i, int kt) { return (const bf16_t*)(upin((const char*)H2 + kt * 128) + xo[h][i]); },
                     [&](int h, int i, int kt) { return (const bf16_t*)(upin((const char*)Wg + ((size_t)(e * 512 + (2 * pn + h) * 64 + i * 32) * 1024 + kt * 64) * 2) + vw); }, 16, lds);
        const int lane = tidx & 63, wid = tidx >> 6, wr = wid >> 2, wc = wid & 3, fr = lane & 15, g = lane >> 4;
#pragma unroll
        for (int nh = 0; nh < 2; ++nh)
#pragma unroll
            for (int im = 0; im < 4; ++im)
#pragma unroll
                for (int q = 0; q < 2; ++q) {
                    const f32x4 gt = acc[nh][2 * q][im], up = acc[nh][2 * q + 1][im];
                    uint2 o; o.x = pack2(siluf_(gt[0]) * up[0], siluf_(gt[1]) * up[1]); o.y = pack2(siluf_(gt[2]) * up[2], siluf_(gt[3]) * up[3]);
                    *(uint2*)(Hid + (size_t)(mt * 256 + (im >> 1) * 128 + wc * 32 + (im & 1) * 16 + fr) * 512 + (2 * pn + nh) * 64 + wr * 32 + 16 * q + 4 * g) = o;
                }
    }
}
__device__ __forceinline__ void st_moe_down(const KP& p, int bid, int nb, char* lds) {
    const int tidx = opaque_tid();
    const int* cnt = WSP(int, OFF_CNT); const float* slw = WSP(float, OFF_SLW);
    const bf16_t* Hid = WSP(bf16_t, OFF_HID); const bf16_t* Wd = WSP(bf16_t, OFF_WB + WB_ED); bf16_t* Sl = WSP(bf16_t, OFF_SLOTS);
    int off[17]; moe_offsets(cnt, off);
    const int M2 = off[16] >> 8;
    int mt, pn;
    for (int r = 0; r * 8 * (nb >> 5) < M2; ++r) {
        if (!moe_tile(r, M2, bid, nb, mt, pn)) continue;
        const int e = __builtin_amdgcn_readfirstlane(moe_expert_of(off, mt * 256));
        acc_t acc[2]; acc_zero(acc[0]); acc_zero(acc[1]);
        gemm_core256_dense(acc, Hid + (size_t)mt * 256 * 512, 512, Wd + ((size_t)e * 1024 + pn * 256) * 512, 512, 512, lds);
#pragma unroll
        for (int nh = 0; nh < 2; ++nh)
            acc_visit2(acc[nh], [&](int ml, int nl, f32x4 v) {
                const float w = slw[mt * 256 + ml];
                *(uint2*)(Sl + (size_t)(mt * 256 + ml) * 1024 + pn * 256 + nh * 128 + nl) = pack4(v * w); });
    }
}
__device__ __forceinline__ void st_postffn(const KP& p, int l, int bid, int nb) {
    const int tidx = opaque_tid();
    const int lane = tidx & 63, wid = tidx >> 6;
    const bf16_t* Sl = WSP(bf16_t, OFF_SLOTS); const int* toks = WSP(int, OFF_TOKS);
    const float* gpost = p.in(I_GPOSTFFN) + l * D;
    const bool next = (l + 1 < NL);
    bf16_t* Hb = WSP(bf16_t, OFF_H); const float* gpre = p.in(I_GPREMIX) + (next ? l + 1 : l) * D;
    auto ld = [&](int r, uint2 (&a)[4], uint2 (&b)[4], float4 (&x)[4]) __attribute__((always_inline)) {
        const bf16_t* s0 = Sl + (size_t)toks[r * 2] * 1024; const bf16_t* s1 = Sl + (size_t)toks[r * 2 + 1] * 1024; const float* xs = xrow_c(p, r);
#pragma unroll
        for (int i = 0; i < 4; ++i) { const int c = i * 256 + lane * 4; a[i] = *(const uint2*)(s0 + c); b[i] = *(const uint2*)(s1 + c); x[i] = *(const float4*)(xs + c); }
    };
    auto proc = [&](int r, uint2 (&a)[4], uint2 (&b)[4], float4 (&xq)[4]) __attribute__((always_inline)) {
        float* xr = xrow(p, r);
        const float* md = WSP(float, OFF_MOD) + (size_t)(l * 2 + (r < LC ? 1 : 0)) * 6144;
        float v[16]; float ss = 0.f;
#pragma unroll
        for (int i = 0; i < 4; ++i) {
            v[4 * i] = bflo(a[i].x) + bflo(b[i].x); v[4 * i + 1] = bfhi(a[i].x) + bfhi(b[i].x); v[4 * i + 2] = bflo(a[i].y) + bflo(b[i].y); v[4 * i + 3] = bfhi(a[i].y) + bfhi(b[i].y);
            ss += v[4 * i] * v[4 * i] + v[4 * i + 1] * v[4 * i + 1] + v[4 * i + 2] * v[4 * i + 2] + v[4 * i + 3] * v[4 * i + 3]; }
        ss = wave_sum(ss);
        const float rstd = rsqrtf(ss * (1.0f / D) + EPS);
        float4 xs[4]; float ss2 = 0.f;
#pragma unroll
        for (int i = 0; i < 4; ++i) { const int c = i * 256 + lane * 4;
            const float4 gg = *(const float4*)(gpost + c), ga = *(const float4*)(md + 5120 + c); float4 x = xq[i];
            x.x += ga.x * v[4 * i] * rstd * gg.x; x.y += ga.y * v[4 * i + 1] * rstd * gg.y; x.z += ga.z * v[4 * i + 2] * rstd * gg.z; x.w += ga.w * v[4 * i + 3] * rstd * gg.w;
            *(float4*)(xr + c) = x; xs[i] = x; ss2 += x.x * x.x + x.y * x.y + x.z * x.z + x.w * x.w; }
        if (next) {
            ss2 = wave_sum(ss2);
            const float rstd2 = rsqrtf(ss2 * (1.0f / D) + EPS);
            const float* md2 = WSP(float, OFF_MOD) + (size_t)((l + 1) * 2 + (r < LC ? 1 : 0)) * 6144;
#pragma unroll
            for (int i = 0; i < 4; ++i) { const int c = i * 256 + lane * 4;
                const float4 gg = *(const float4*)(gpre + c), sh = *(const float4*)(md2 + c), sc = *(const float4*)(md2 + 1024 + c);
                uint2 o; o.x = pack2(xs[i].x * rstd2 * gg.x * (1.f + sc.x) + sh.x, xs[i].y * rstd2 * gg.y * (1.f + sc.y) + sh.y);
                o.y = pack2(xs[i].z * rstd2 * gg.z * (1.f + sc.z) + sh.z, xs[i].w * rstd2 * gg.w * (1.f + sc.w) + sh.w);
                *(uint2*)(Hb + (size_t)r * D + c) = o; }
        }
    };
    {   const int r0 = (l + 1 < NL ? 0 : LC) + bid * NWV + wid, rs = nb * NWV;
        uint2 aa[4], ab[4], ba[4], bb[4]; float4 xa[4], xb[4];
        if (r0 < T) ld(r0, aa, ab, xa);
        for (int r = r0; r < T; r += 2 * rs) {
            if (r + rs < T) ld(r + rs, ba, bb, xb);
            proc(r, aa, ab, xa);
            if (r + rs < T) { if (r + 2 * rs < T) ld(r + 2 * rs, aa, ab, xa); proc(r + rs, ba, bb, xb); }
        } }
}

__device__ __forceinline__ void gsync(unsigned* bar, unsigned epoch) {
    asm volatile("s_waitcnt vmcnt(0) lgkmcnt(0)" ::: "memory");
    unsigned x = __builtin_amdgcn_readfirstlane(blockIdx.x & 7), nbk = __builtin_amdgcn_readfirstlane(gridDim.x); asm volatile("" : "+s"(x), "+s"(nbk));
    const unsigned gsz = (nbk - x + 7) >> 3, ngrp = nbk < 8 ? nbk : 8;
    __syncthreads();
    if (threadIdx.x == 0) {
        __builtin_amdgcn_fence(__ATOMIC_RELEASE, "agent");
        asm volatile("s_waitcnt vmcnt(0)" ::: "memory");
        const unsigned old = __hip_atomic_fetch_add(bar + 64 * (1 + x), 1u, __ATOMIC_RELAXED, __HIP_MEMORY_SCOPE_AGENT);
        if (old + 1 == epoch * gsz) __hip_atomic_fetch_add(bar, 1u, __ATOMIC_RELAXED, __HIP_MEMORY_SCOPE_AGENT);
        const unsigned target = epoch * ngrp;
        while (__hip_atomic_load(bar, __ATOMIC_RELAXED, __HIP_MEMORY_SCOPE_AGENT) < target) __builtin_amdgcn_s_sleep(1);
        __builtin_amdgcn_fence(__ATOMIC_ACQUIRE, "agent");
        asm volatile("s_waitcnt vmcnt(0)" ::: "memory");
    }
    __syncthreads();
}

__global__ void __launch_bounds__(NTH) k_mega(Params p_unused) {
    KP p; p.k = (kparams_t)__builtin_amdgcn_kernarg_segment_ptr();
    __shared__ __attribute__((aligned(16))) char lds[LDS_BYTES]; float* smem = (float*)lds;
    cg::grid_group grid = cg::this_grid();
    grid.sync();
    const int bid = blockIdx.x, nb = gridDim.x;
    unsigned* bar = WSP(unsigned, OFF_BAR);
#define GS(k) gsync(bar, (unsigned)(k))
    st_prologue(p, bid, nb, smem); st_conv(p, 0, bid, nb, smem); st_s5_tables(p, 0, bid, nb, lds); GS(1);
    st_modulate(p, 0, bid, nb); GS(2);
#pragma unroll 1
    for (int l = 0; l < NL; ++l) {
        st_gemm_in(p, l, bid, nb, lds); GS(2 + 12 * l + 1);
        st_s5_local(p, l, bid, nb); st_s5_fgemm(p, bid, nb, lds); GS(2 + 12 * l + 2);
        st_s5_carry(p, l, bid, nb, lds); st_proj2<0>(p, l, bid, nb, lds); GS(2 + 12 * l + 3);
        st_s5_ygemm(p, l, bid, nb, lds); st_s5_ctx_y(p, l, bid, nb); st_ropeq(p, bid, nb, lds); GS(2 + 12 * l + 4);
        st_proj2<1>(p, l, bid, nb, lds); st_attn(p, l, bid, nb, lds); GS(2 + 12 * l + 5);
        st_merge(p, l, bid, nb, lds); GS(2 + 12 * l + 6);
        st_wout(p, l, bid, nb, lds);
        if (l + 1 < NL && nb > 8) { if (bid >= 4) st_conv_experts(p, l, bid - 4, nb - 4, smem); } else st_conv_experts(p, l, bid, nb, smem); GS(2 + 12 * l + 7);
        st_postmix(p, l, bid, nb, lds); GS(2 + 12 * l + 8);
        st_moe_build(p, l, bid, nb, lds); GS(2 + 12 * l + 9);
        st_moe_up(p, bid, nb, lds); GS(2 + 12 * l + 10);
        st_moe_down(p, bid, nb, lds); GS(2 + 12 * l + 11);
        st_postffn(p, l, bid, nb);
        if (l + 1 < NL) { st_conv(p, l + 1, bid, nb, smem); st_s5_tables(p, l + 1, bid, nb, lds); }
        GS(2 + 12 * l + 12);
    }
#undef GS
}

extern "C" void kernel_launch(void* const* d_in, const int* in_sizes, int n_in, void* d_out, int out_size, void* d_ws, size_t ws_size, hipStream_t stream) {
    Params p{};
    for (int i = 0; i < N_IN; ++i) p.in[i] = (const float*)d_in[i];
    p.out = (float*)d_out; p.ws = (char*)d_ws;
    if (ws_size < WS_NEED) { fprintf(stderr, "workspace too small: %zu < %zu\n", ws_size, (size_t)WS_NEED); return; }
    static int grid_blocks = 0;
    if (!grid_blocks) {
        int dev = 0, cus = 0, per_cu = 0;
        hipGetDevice(&dev);
        hipDeviceGetAttribute(&cus, hipDeviceAttributeMultiprocessorCount, dev);
        hipOccupancyMaxActiveBlocksPerMultiprocessor(&per_cu, k_mega, NTH, 0);
        if (per_cu > 1) per_cu = 1;
        if (per_cu < 1) per_cu = 1;
        grid_blocks = cus * per_cu;
    }
    hipMemsetAsync((char*)d_ws + OFF_BAR, 0, BAR_BYTES, stream);
    void* args[] = { &p };
    hipError_t e = hipLaunchCooperativeKernel((void*)k_mega, dim3(grid_blocks), dim3(NTH), args, 0, stream);
    if (e != hipSuccess) fprintf(stderr, "cooperative launch failed: %s (grid %d)\n", hipGetErrorString(e), grid_blocks);
}
```

```cpp
#include <hip/hip_runtime.h>
#include <hip/hip_cooperative_groups.h>
#include <cstdio>
#include <cstdint>
#include <type_traits>
namespace cg = cooperative_groups;


typedef unsigned short bf16_t;
typedef short bf16x8 __attribute__((ext_vector_type(8)));
typedef float f32x16 __attribute__((ext_vector_type(16)));
typedef float f32x4 __attribute__((ext_vector_type(4)));
typedef unsigned u32x4 __attribute__((ext_vector_type(4)));
constexpr int NTH = 512, NWV = 8;
#ifndef REP_CONV
#define REP_CONV 1
#endif
#ifndef REP_G1
#define REP_G1 1
#endif
#ifndef REP_G2
#define REP_G2 1
#endif
#ifndef REP_G3
#define REP_G3 1
#endif
#ifndef REP_S5
#define REP_S5 1
#endif
#ifndef REP_ATTN
#define REP_ATTN 1
#endif

constexpr int D = 1024, S = 16384, LC = 256, T = S + LC, NL = 2;
constexpr int NIN = 4768, NINP = 4864;
constexpr int PP = 1696;
constexpr int C_GQ = 0, C_GK = 512, C_GV = 640, C_CQ = 768, C_CKV = 1024, C_KR = 1152, C_SSM = 1184, C_GATE = 1696;
__host__ __device__ constexpr int win_col_old(int n) {
    return n < 512 ? 928 + n : n < 640 ? 1440 + (n - 512) : n < 768 ? 1568 + (n - 640) : n < 1024 ? (n - 768) : n < 1152 ? 256 + (n - 1024) : n < 1184 ? 384 + (n - 1152) : n < 1696 ? 416 + (n - 1184) : n;
}
constexpr int TP = 2 * T + 16 * 256;
constexpr float EPS = 1e-6f;
constexpr float LOG2E = 1.4426950408889634f;
constexpr float SC_MLA = 0.10206207261596575f * LOG2E, SC_GQA = 0.125f * LOG2E;

enum { I_X = 0, I_C, I_CTX, I_CCTX, I_WMOD, I_BMOD, I_GPREMIX, I_GPOSTMIX, I_GPREFFN, I_GPOSTFFN, I_WIN, I_GCQ, I_GCKV, I_WUQ, I_WUKV,
       I_GQN, I_GKN, I_ARE, I_AIM, I_LOGDT, I_BRE, I_BIM, I_CRE, I_CIM, I_SSMD, I_WGLU, I_BGLU, I_WBRM, I_WBRS, I_WBRG, I_WOUT,
       I_WGROUP, I_BGROUP, I_WROUTER, I_BROUTER, I_WEG, I_WEU, I_WED, N_IN };

constexpr size_t al256(size_t x) { return (x + 255) & ~(size_t)255; }
constexpr size_t WB_IN = 0;
constexpr size_t WB_UQ = WB_IN + (size_t)NINP * 1024 * 2;
constexpr size_t WB_UKV = WB_UQ + (size_t)768 * 256 * 2;
constexpr size_t WB_GLU = WB_UKV + (size_t)1024 * 128 * 2;
constexpr size_t WB_BR = WB_GLU + (size_t)512 * 512 * 2;
constexpr size_t WB_OUT = WB_BR + (size_t)3 * 1024 * 512 * 2;
constexpr size_t WB_EG = WB_OUT + (size_t)1024 * 1024 * 2;
constexpr size_t WB_EU = WB_EG + (size_t)16 * 512 * 1024 * 2;
constexpr size_t WB_ED = WB_EU + (size_t)16 * 512 * 1024 * 2;
constexpr size_t WB_BYTES = WB_ED + (size_t)16 * 1024 * 512 * 2;

constexpr size_t OFF_WB = 0;
constexpr size_t OFF_P = al256(OFF_WB + WB_BYTES);
constexpr size_t P_BYTES = (size_t)T * NIN * 2;
constexpr size_t OFF_GS = OFF_P + (size_t)T * PP * 2;
constexpr size_t OFF_Y = OFF_P;
constexpr size_t OFF_SLOTS = OFF_P;
constexpr size_t OFF_HID = OFF_P + (size_t)TP * 1024 * 2;
constexpr size_t OFF_H = al256(OFF_P + P_BYTES);
constexpr size_t OFF_KN = al256(OFF_H + (size_t)T * 1024 * 2);
constexpr size_t OFF_V = al256(OFF_KN + (size_t)T * 512 * 2);
constexpr size_t OFF_OM = al256(OFF_V + (size_t)T * 512 * 2);
constexpr size_t OFF_OG = OFF_OM + (size_t)T * 512 * 2;
constexpr size_t OFF_OS = OFF_OG + (size_t)T * 512 * 2;
constexpr size_t OFF_XC = al256(OFF_OS + (size_t)T * 512 * 2);
constexpr size_t OFF_MOD = al256(OFF_XC + (size_t)LC * 1024 * 4);
constexpr size_t OFF_TOKE = al256(OFF_MOD + (size_t)NL * 2 * 6144 * 4);
constexpr size_t OFF_TOKW = al256(OFF_TOKE + (size_t)T * 2 * 4);
constexpr size_t OFF_TOKS = al256(OFF_TOKW + (size_t)T * 2 * 4);
constexpr size_t OFF_SLTOK = al256(OFF_TOKS + (size_t)T * 2 * 4);
constexpr size_t OFF_SLW = al256(OFF_SLTOK + (size_t)TP * 4);
constexpr size_t OFF_CNT = al256(OFF_SLW + (size_t)TP * 4);
constexpr size_t OFF_S5 = al256(OFF_CNT + 256);
constexpr size_t OFF_ROPE = al256(OFF_S5 + (size_t)(T / 64) * 4096 * 8);
constexpr size_t OFF_SSQ = al256(OFF_ROPE + 256 * 24 * 8);
constexpr size_t OFF_SSMG = al256(OFF_SSQ + (size_t)T * 8 * 4);
constexpr size_t OFF_BAR = al256(OFF_SSMG + (size_t)32 * T * 16 * 2);
constexpr size_t BAR_BYTES = 4096;
constexpr size_t OFF_S5B = al256(OFF_BAR + BAR_BYTES);
constexpr size_t WS_NEED = al256(OFF_S5B + (size_t)(T / 64) * 4096 * 8);
static_assert(OFF_HID + (size_t)TP * 512 * 2 <= OFF_P + P_BYTES, "overlay");
static_assert((size_t)T * 1024 * 4 <= P_BYTES, "overlay Y");
static_assert(WS_NEED < 384000000ull, "ws");

struct Params {
    const float* in[N_IN];
    float* out;
    char* ws;
};
typedef const __attribute__((address_space(4))) Params* kparams_t;
struct KP {
    kparams_t k;
    __device__ __forceinline__ const float* in(int i) const { return *(const float* const volatile __attribute__((address_space(4)))*)(&k->in[i]); }
    __device__ __forceinline__ float* out() const { return *(float* const volatile __attribute__((address_space(4)))*)(&k->out); }
    __device__ __forceinline__ char* ws() const { return *(char* const volatile __attribute__((address_space(4)))*)(&k->ws); }
};

__device__ __forceinline__ float bf2f(bf16_t v) { return __uint_as_float(((unsigned)v) << 16); }
typedef __bf16 bf16x2_t __attribute__((ext_vector_type(2)));
__device__ __forceinline__ bf16_t f2bf(float f) { const __bf16 b = (__bf16)f; return __builtin_bit_cast(bf16_t, b); }
__device__ __forceinline__ float bflo(unsigned u) { return __uint_as_float(u << 16); }
__device__ __forceinline__ float bfhi(unsigned u) { return __uint_as_float(u & 0xFFFF0000u); }
__device__ __forceinline__ unsigned pack2(float lo, float hi) { bf16x2_t v; v[0] = (__bf16)lo; v[1] = (__bf16)hi; return __builtin_bit_cast(unsigned, v); }
template <int CTRL, int ROWMASK>
__device__ __forceinline__ float dpp0(float v) { return __uint_as_float(__builtin_amdgcn_update_dpp(0u, __float_as_uint(v), CTRL, ROWMASK, 0xF, false)); }
__device__ __forceinline__ float wave_sum(float v) {
    v += dpp0<0xB1, 0xF>(v);
    v += dpp0<0x4E, 0xF>(v);
    v += dpp0<0x141, 0xF>(v);
    v += dpp0<0x140, 0xF>(v);
    v += dpp0<0x142, 0xA>(v);
    v += dpp0<0x143, 0xC>(v);
    return __uint_as_float(__builtin_amdgcn_readlane(__float_as_uint(v), 63));
}
__device__ __forceinline__ float xhalf_max(float m) { auto rr = __builtin_amdgcn_permlane32_swap(__float_as_uint(m), __float_as_uint(m), false, false); return fmaxf(__uint_as_float(rr[0]), __uint_as_float(rr[1])); }
__device__ __forceinline__ float xhalf_sum(float m) { auto rr = __builtin_amdgcn_permlane32_swap(__float_as_uint(m), __float_as_uint(m), false, false); return __uint_as_float(rr[0]) + __uint_as_float(rr[1]); }
__device__ __forceinline__ void rope_tab(float& a, float& b, float2 cs) { const float na = a * cs.x - b * cs.y, nb_ = a * cs.y + b * cs.x; a = na; b = nb_; }
__device__ __forceinline__ float transpose_reduce16(const float (&t16)[16], int lane) {
    float t8[8], t4[4], t2[2];
#pragma unroll
    for (int i = 0; i < 8; ++i) { const float a = t16[2 * i], b = t16[2 * i + 1]; const bool o = lane & 1; const float keep = o ? b : a, send = o ? a : b; t8[i] = keep + __shfl_xor(send, 1); }
#pragma unroll
    for (int i = 0; i < 4; ++i) { const float a = t8[2 * i], b = t8[2 * i + 1]; const bool o = lane & 2; const float keep = o ? b : a, send = o ? a : b; t4[i] = keep + __shfl_xor(send, 2); }
#pragma unroll
    for (int i = 0; i < 2; ++i) { const float a = t4[2 * i], b = t4[2 * i + 1]; const bool o = lane & 4; const float keep = o ? b : a, send = o ? a : b; t2[i] = keep + __shfl_xor(send, 4); }
    float y; { const float a = t2[0], b = t2[1]; const bool o = lane & 8; const float keep = o ? b : a, send = o ? a : b; y = keep + __shfl_xor(send, 8); }
    y += __shfl_xor(y, 16); y += __shfl_xor(y, 32);
    return y;
}
__device__ __forceinline__ float sigmoidf_(float x) { return __builtin_amdgcn_rcpf(1.0f + __builtin_amdgcn_exp2f(-LOG2E * x)); }
__device__ __forceinline__ float siluf_(float x) { return x * __builtin_amdgcn_rcpf(1.0f + __builtin_amdgcn_exp2f(-LOG2E * x)); }
__device__ __forceinline__ float gelu_tanh(float x) {
    const float u = 0.7978845608028654f * (x + 0.044715f * x * x * x);
    return x * __builtin_amdgcn_rcpf(1.0f + __builtin_amdgcn_exp2f(-2.0f * LOG2E * u));
}
__device__ __forceinline__ float dot8(uint4 a, uint4 b, float acc) {
    acc = fmaf(bflo(a.x), bflo(b.x), acc); acc = fmaf(bfhi(a.x), bfhi(b.x), acc);
    acc = fmaf(bflo(a.y), bflo(b.y), acc); acc = fmaf(bfhi(a.y), bfhi(b.y), acc);
    acc = fmaf(bflo(a.z), bflo(b.z), acc); acc = fmaf(bfhi(a.z), bfhi(b.z), acc);
    acc = fmaf(bflo(a.w), bflo(b.w), acc); acc = fmaf(bfhi(a.w), bfhi(b.w), acc);
    return acc;
}
__device__ __forceinline__ float dotrow(const bf16_t* a, const bf16_t* b, int K) {
    float acc = 0.f;
    const uint4* a4 = (const uint4*)a; const uint4* b4 = (const uint4*)b;
    for (int k = 0; k < K / 8; ++k) acc = dot8(a4[k], b4[k], acc);
    return acc;
}

__device__ __forceinline__ int opaque_tid() { int t = threadIdx.x; asm volatile("" : "+v"(t)); return t; }
#define WSP(type, off) ((type*)(p.ws() + (off)))
#define SSMU(g, r) (WSP(const bf16_t, OFF_SSMG) + ((size_t)(g) * T + (r)) * 16)

template <class AF, class BF, class EF>
__device__ __forceinline__ void gemm_naive(int M, int N, int K, AF arow, BF brow, EF epi, int bid, int nb) {
    const int tidx = opaque_tid();
    const long total = (long)M * N;
    for (long idx = (long)bid * NTH + tidx; idx < total; idx += (long)nb * NTH) {
        const int m = (int)(idx / N), n = (int)(idx % N);
        const float acc = dotrow(arow(m), brow(m, n), K);
        epi(m, n, acc);
    }
}

constexpr int G_A_BYTES = 256 * 128, G_W_BYTES = 128 * 128, G_BUF = G_A_BYTES + G_W_BYTES;
constexpr int LDS_BYTES = 131072 + 8 * 2304;
static_assert(LDS_BYTES >= 3 * G_BUF, "lds");
constexpr int LDS_STRIP = 131072;
#define MFMA32(a, b, c) __builtin_amdgcn_mfma_f32_32x32x16_bf16(a, b, c, 0, 0, 0)

#define GLDS16(gptr, lptr) __builtin_amdgcn_global_load_lds((const __attribute__((address_space(1))) void*)(gptr), (__attribute__((address_space(3))) void*)(lptr), 16, 0, 0)
typedef f32x4 acc_t[4][4];
#define MFMA16(a, b, c) __builtin_amdgcn_mfma_f32_16x16x32_bf16(a, b, c, 0, 0, 0)
template <class APTR, class WPTR>
__device__ __forceinline__ void gemm_core_g(acc_t& acc, APTR aptr, WPTR wptr, int nk, char* lds) {
    const int tidx = opaque_tid();
    const int tid = tidx, lane = tid & 63, wid = tid >> 6, wm = wid >> 1, wn = wid & 1, fr = lane & 15, g = lane >> 4;
    const int wu = __builtin_amdgcn_readfirstlane(wid);
    char* sdst = lds + wu * 1024;
    const int xoff = (wm * 64 + fr) * 128, woff = G_A_BYTES + (wn * 64 + fr) * 128, sw7 = (fr >> 1) & 7;
    asm volatile("s_waitcnt vmcnt(0)" ::: "memory");
#pragma unroll
    for (int i = 0; i < 4; ++i) GLDS16(aptr(i, 0), sdst + i * 8192);
#pragma unroll
    for (int i = 0; i < 2; ++i) GLDS16(wptr(i, 0), sdst + G_A_BYTES + i * 8192);
    if (nk > 1) {
#pragma unroll
        for (int i = 0; i < 4; ++i) GLDS16(aptr(i, 1), sdst + G_BUF + i * 8192);
#pragma unroll
        for (int i = 0; i < 2; ++i) GLDS16(wptr(i, 1), sdst + G_BUF + G_A_BYTES + i * 8192);
        asm volatile("s_waitcnt vmcnt(6)" ::: "memory");
    } else asm volatile("s_waitcnt vmcnt(0)" ::: "memory");
    __builtin_amdgcn_s_barrier();
    int slot = 0;
    for (int kt = 0; kt < nk; ++kt) {
        const char* cur = lds + slot * G_BUF;
        const int s2 = slot >= 1 ? slot - 1 : 2;
        const bool more2 = (kt + 2 < nk);
        char* nxt = sdst + s2 * G_BUF;
#pragma unroll
        for (int ks = 0; ks < 2; ++ks) {
            const int co = ((ks * 4 + g) ^ sw7) << 4;
            bf16x8 x[4], w[4];
#pragma unroll
            for (int i = 0; i < 4; ++i) { x[i] = *(const bf16x8*)(cur + xoff + i * 16 * 128 + co); w[i] = *(const bf16x8*)(cur + woff + i * 16 * 128 + co); }
#pragma unroll
            for (int in = 0; in < 4; ++in)
#pragma unroll
                for (int im = 0; im < 4; ++im) acc[in][im] = MFMA16(w[in], x[im], acc[in][im]);
            __builtin_amdgcn_sched_barrier(0);
            if (more2) {
                if (ks == 0) { GLDS16(aptr(0, kt + 2), nxt); GLDS16(aptr(1, kt + 2), nxt + 8192); GLDS16(aptr(2, kt + 2), nxt + 2 * 8192); }
                else { GLDS16(aptr(3, kt + 2), nxt + 3 * 8192); GLDS16(wptr(0, kt + 2), nxt + G_A_BYTES); GLDS16(wptr(1, kt + 2), nxt + G_A_BYTES + 8192); }
            }
            __builtin_amdgcn_sched_barrier(0);
        }
        if (more2) asm volatile("s_waitcnt vmcnt(6) lgkmcnt(0)" ::: "memory");
        else asm volatile("s_waitcnt vmcnt(0) lgkmcnt(0)" ::: "memory");
        __builtin_amdgcn_s_barrier();
        slot = slot == 2 ? 0 : slot + 1;
    }
}
template <class APTR, class WPTR, class H0, class H1>
__device__ __forceinline__ void gemm_core_hook(acc_t& acc, APTR aptr, WPTR wptr, int nk, char* lds, H0 h0, H1 h1) {
    const int tidx = opaque_tid();
    const int tid = tidx, lane = tid & 63, wid = tid >> 6, wm = wid >> 1, wn = wid & 1, fr = lane & 15, g = lane >> 4;
    const int wu = __builtin_amdgcn_readfirstlane(wid);
    char* sdst = lds + wu * 1024;
    const int xoff = (wm * 64 + fr) * 128, woff = G_A_BYTES + (wn * 64 + fr) * 128, sw7 = (fr >> 1) & 7;
    asm volatile("s_waitcnt vmcnt(0)" ::: "memory");
#pragma unroll
    for (int i = 0; i < 4; ++i) GLDS16(aptr(i, 0), sdst + i * 8192);
#pragma unroll
    for (int i = 0; i < 2; ++i) GLDS16(wptr(i, 0), sdst + G_A_BYTES + i * 8192);
#pragma unroll
    for (int i = 0; i < 4; ++i) GLDS16(aptr(i, 1), sdst + G_BUF + i * 8192);
#pragma unroll
    for (int i = 0; i < 2; ++i) GLDS16(wptr(i, 1), sdst + G_BUF + G_A_BYTES + i * 8192);
    asm volatile("s_waitcnt vmcnt(6)" ::: "memory");
    __builtin_amdgcn_s_barrier();
    int slot = 0;
#pragma unroll 1
    for (int kt = 0; kt < nk; ++kt) {
        const char* cur = lds + slot * G_BUF;
        const int s2 = slot >= 1 ? slot - 1 : 2;
        const bool more2 = (kt + 2 < nk);
        char* nxt = sdst + s2 * G_BUF;
        h0(kt);
        __builtin_amdgcn_sched_barrier(0);
#pragma unroll
        for (int ks = 0; ks < 2; ++ks) {
            const int co = ((ks * 4 + g) ^ sw7) << 4;
            bf16x8 x[4], w[4];
#pragma unroll
            for (int i = 0; i < 4; ++i) { x[i] = *(const bf16x8*)(cur + xoff + i * 16 * 128 + co); w[i] = *(const bf16x8*)(cur + woff + i * 16 * 128 + co); }
#pragma unroll
            for (int in = 0; in < 4; ++in)
#pragma unroll
                for (int im = 0; im < 4; ++im) acc[in][im] = MFMA16(w[in], x[im], acc[in][im]);
            __builtin_amdgcn_sched_barrier(0);
            if (more2) {
                if (ks == 0) { GLDS16(aptr(0, kt + 2), nxt); GLDS16(aptr(1, kt + 2), nxt + 8192); GLDS16(aptr(2, kt + 2), nxt + 2 * 8192); }
                else { GLDS16(aptr(3, kt + 2), nxt + 3 * 8192); GLDS16(wptr(0, kt + 2), nxt + G_A_BYTES); GLDS16(wptr(1, kt + 2), nxt + G_A_BYTES + 8192); }
            }
            __builtin_amdgcn_sched_barrier(0);
        }
        h1(kt);
        __builtin_amdgcn_sched_barrier(0);
        if (more2) asm volatile("s_waitcnt vmcnt(6) lgkmcnt(0)" ::: "memory");
        else asm volatile("s_waitcnt vmcnt(0) lgkmcnt(0)" ::: "memory");
        __builtin_amdgcn_s_barrier();
        slot = slot == 2 ? 0 : slot + 1;
    }
}
template <class AROW, class WROW>
__device__ __forceinline__ void gemm_core(acc_t& acc, AROW arow, WROW wrow, int K, char* lds) {
    const int tidx = opaque_tid();
    const int srow = tidx >> 3, gch = (tidx & 7) ^ ((srow >> 1) & 7);
    const bf16_t* pa[4]; const bf16_t* pw[2];
#pragma unroll
    for (int i = 0; i < 4; ++i) pa[i] = arow(srow + 64 * i) + gch * 8;
#pragma unroll
    for (int i = 0; i < 2; ++i) pw[i] = wrow(srow + 64 * i) + gch * 8;
    gemm_core_g(acc, [&](int i, int kt) { return pa[i] + kt * 64; }, [&](int i, int kt) { return pw[i] + kt * 64; }, K >> 6, lds);
}
__device__ __forceinline__ void acc_zero(acc_t& acc) {
#pragma unroll
    for (int a = 0; a < 4; ++a)
#pragma unroll
        for (int b = 0; b < 4; ++b) { acc[a][b][0] = 0.f; acc[a][b][1] = 0.f; acc[a][b][2] = 0.f; acc[a][b][3] = 0.f; }
}
template <class F>
__device__ __forceinline__ void acc_visit(const acc_t& acc, F f) {
    const int tidx = opaque_tid();
    const int lane = tidx & 63, wid = tidx >> 6, wm = wid >> 1, wn = wid & 1, fr = lane & 15, g = lane >> 4;
#pragma unroll
    for (int in = 0; in < 4; ++in)
#pragma unroll
        for (int im = 0; im < 4; ++im) f(wm * 64 + 16 * im + fr, wn * 64 + 16 * in + 4 * g, acc[in][im]);
}
template <class F>
__device__ __forceinline__ void acc_visit_add(const acc_t& acc, acc_t& tot, F f) {
    const int tidx = opaque_tid();
    const int lane = tidx & 63, wid = tidx >> 6, wm = wid >> 1, wn = wid & 1, fr = lane & 15, g = lane >> 4;
#pragma unroll
    for (int in = 0; in < 4; ++in)
#pragma unroll
        for (int im = 0; im < 4; ++im) tot[in][im] += f(wm * 64 + 16 * im + fr, wn * 64 + 16 * in + 4 * g, acc[in][im]);
}
template <class APTR, class WPTR>
__device__ __forceinline__ void gemm_core256(acc_t (&acc)[2], APTR aptr, WPTR wptr, int nt, char* lds) {
    const int tid = opaque_tid(), lane = tid & 63, wid = tid >> 6, wr = wid >> 2, wc = wid & 3, fr = lane & 15, g = lane >> 4;
    const int wu = __builtin_amdgcn_readfirstlane(wid);
    char* sdst = lds + wu * 1024;
    const int sw7 = (fr >> 1) & 7;
    typedef const __attribute__((address_space(3))) char* l3p; typedef const __attribute__((address_space(3))) bf16x8* l3v;
    l3p wf0 = (l3p)lds + (wr * 64 + fr) * 128 + ((g ^ sw7) << 4); l3p wf1 = (l3p)lds + (wr * 64 + fr) * 128 + (((4 + g) ^ sw7) << 4);
    l3p xf0 = (l3p)lds + 4 * 16384 + (wc * 32 + fr) * 128 + ((g ^ sw7) << 4); l3p xf1 = (l3p)lds + 4 * 16384 + (wc * 32 + fr) * 128 + (((4 + g) ^ sw7) << 4);
    asm volatile("" : "+v"(wf0), "+v"(wf1), "+v"(xf0), "+v"(xf1));
#define C2_SW(b, h) (((b) * 2 + (h)) * 16384)
#define C2_STG_W(b, h, kt) do { GLDS16(wptr(h, 0, kt), sdst + C2_SW(b, h)); GLDS16(wptr(h, 1, kt), sdst + C2_SW(b, h) + 8192); } while (0)
#define C2_STG_X(b, h, kt) do { GLDS16(aptr(h, 0, kt), sdst + 4 * 16384 + C2_SW(b, h)); GLDS16(aptr(h, 1, kt), sdst + 4 * 16384 + C2_SW(b, h) + 8192); } while (0)
#define C2_LDW(b, h) do { _Pragma("unroll") for (int m = 0; m < 4; ++m) { Wt[m][0] = *(l3v)(wf0 + C2_SW(b, h) + m * 2048); Wt[m][1] = *(l3v)(wf1 + C2_SW(b, h) + m * 2048); } } while (0)
#define C2_LDX(dst, b, h) do { _Pragma("unroll") for (int n = 0; n < 2; ++n) { dst[n][0] = *(l3v)(xf0 + C2_SW(b, h) + n * 2048); dst[n][1] = *(l3v)(xf1 + C2_SW(b, h) + n * 2048); } } while (0)
#define C2_MMA(nh, mh, Xf) do { __builtin_amdgcn_s_setprio(1); \
        _Pragma("unroll") for (int m = 0; m < 4; ++m) _Pragma("unroll") for (int n = 0; n < 2; ++n) _Pragma("unroll") for (int k = 0; k < 2; ++k) \
            acc[nh][m][2 * (mh) + n] = MFMA16(Wt[m][k], Xf[n][k], acc[nh][m][2 * (mh) + n]); \
        __builtin_amdgcn_s_setprio(0); } while (0)
#define C2_WV(n) asm volatile("s_waitcnt vmcnt(" #n ")" ::: "memory")
#define C2_WL(n) asm volatile("s_waitcnt lgkmcnt(" #n ")" ::: "memory")
#define C2_BAR __builtin_amdgcn_s_barrier()
#define C2_SCHED __builtin_amdgcn_sched_barrier(0)
    bf16x8 Wt[4][2], X0[2][2], X1[2][2];
    C2_WV(0);
    C2_STG_X(0, 0, 0); C2_STG_W(0, 0, 0); C2_STG_X(0, 1, 0); C2_STG_W(0, 1, 0);
    if (wu >= 4) C2_BAR;
    C2_WV(4); C2_BAR;
    C2_STG_X(1, 0, 1); C2_STG_W(1, 0, 1); C2_STG_X(1, 1, 1);
    C2_WV(6); C2_BAR;
#pragma unroll 1
    for (int t = 0; t < nt - 2; t += 2) {
        C2_LDX(X0, 0, 0); C2_SCHED; C2_LDW(0, 0); C2_STG_W(1, 1, t + 1);
        C2_WL(8); C2_BAR; C2_WL(0); C2_MMA(0, 0, X0); C2_BAR; C2_SCHED;
        C2_LDX(X1, 0, 1); C2_STG_X(0, 0, t + 2);
        C2_BAR; C2_WL(0); C2_MMA(0, 1, X1); C2_BAR;
        C2_LDW(0, 1); C2_STG_W(0, 0, t + 2);
        C2_BAR; C2_WL(0); C2_MMA(1, 0, X0); C2_BAR; C2_SCHED;
        C2_STG_X(0, 1, t + 2);
        C2_WV(6); C2_BAR; C2_MMA(1, 1, X1); C2_BAR;
        C2_LDX(X0, 1, 0); C2_SCHED; C2_LDW(1, 0); C2_STG_W(0, 1, t + 2);
        C2_WL(8); C2_BAR; C2_WL(0); C2_MMA(0, 0, X0); C2_BAR; C2_SCHED;
        C2_LDX(X1, 1, 1); C2_STG_X(1, 0, t + 3);
        C2_BAR; C2_WL(0); C2_MMA(0, 1, X1); C2_BAR;
        C2_LDW(1, 1); C2_STG_W(1, 0, t + 3);
        C2_BAR; C2_WL(0); C2_MMA(1, 0, X0); C2_BAR; C2_SCHED;
        C2_STG_X(1, 1, t + 3);
        C2_WV(6); C2_BAR; C2_MMA(1, 1, X1); C2_BAR;
    }
    {   C2_LDX(X0, 0, 0); C2_LDW(0, 0); C2_STG_W(1, 1, nt - 1);
        C2_BAR; C2_WL(0); C2_MMA(0, 0, X0); C2_BAR;
        C2_LDX(X1, 0, 1); C2_BAR; C2_WL(0); C2_MMA(0, 1, X1); C2_BAR;
        C2_LDW(0, 1); C2_WV(4); C2_BAR; C2_WL(0); C2_MMA(1, 0, X0); C2_MMA(1, 1, X1); C2_BAR; }
    {   C2_LDX(X0, 1, 0); C2_LDW(1, 0); C2_WV(2); C2_BAR; C2_WL(0); C2_MMA(0, 0, X0); C2_BAR;
        C2_LDX(X1, 1, 1); C2_WV(0); C2_BAR; C2_WL(0); C2_MMA(0, 1, X1); C2_BAR;
        C2_LDW(1, 1); C2_BAR; C2_WL(0); C2_MMA(1, 0, X0); C2_MMA(1, 1, X1); C2_BAR; }
    if (wu < 4) C2_BAR;
}
__device__ __forceinline__ void gemm_core256_dense(acc_t (&acc)[2], const bf16_t* xb, int xpitch, const bf16_t* wb, int wpitch, int K, char* lds) {
    const int tidx = opaque_tid();
    const int srow = tidx >> 3, gch = (tidx & 7) ^ ((srow >> 1) & 7);
    const unsigned vx = (unsigned)(srow * xpitch + gch * 8) * 2u, vw = (unsigned)(srow * wpitch + gch * 8) * 2u;
    auto upin = [](const char* q) { const unsigned long long v = (unsigned long long)q; const unsigned lo = __builtin_amdgcn_readfirstlane((unsigned)v), hi = __builtin_amdgcn_readfirstlane((unsigned)(v >> 32)); return (const char*)(((unsigned long long)hi << 32) | lo); };
    int nk = K >> 6; asm volatile("" : "+s"(nk));
    gemm_core256(acc, [&](int h, int i, int kt) { return (const bf16_t*)(upin((const char*)xb + ((size_t)(h * 128 + i * 64) * xpitch + kt * 64) * 2) + vx); },
                 [&](int h, int i, int kt) { return (const bf16_t*)(upin((const char*)wb + ((size_t)(h * 128 + i * 64) * wpitch + kt * 64) * 2) + vw); }, nk, lds);
}
template <class F>
__device__ __forceinline__ void acc_visit2(const acc_t& acc, F f) {
    const int tidx = opaque_tid();
    const int lane = tidx & 63, wid = tidx >> 6, wr = wid >> 2, wc = wid & 3, fr = lane & 15, g = lane >> 4;
#pragma unroll
    for (int in = 0; in < 4; ++in)
#pragma unroll
        for (int im = 0; im < 4; ++im) f((im >> 1) * 128 + wc * 32 + (im & 1) * 16 + fr, wr * 64 + 16 * in + 4 * g, acc[in][im]);
}
__device__ __forceinline__ uint2 pack4(f32x4 v) { uint2 o; o.x = pack2(v[0], v[1]); o.y = pack2(v[2], v[3]); return o; }
__device__ __forceinline__ void store_block16x64(char* wstrip, const uint2 (&v)[4], bf16_t* dst, int pitch, int lane) {
    const int fr = lane & 15, g = lane >> 4;
#pragma unroll
    for (int in = 0; in < 4; ++in) *(uint2*)(wstrip + fr * 144 + in * 32 + g * 8) = v[in];
    const uint4 a = *(const uint4*)(wstrip + (lane >> 3) * 144 + (lane & 7) * 16), b = *(const uint4*)(wstrip + (8 + (lane >> 3)) * 144 + (lane & 7) * 16);
    *(uint4*)(dst + (size_t)(lane >> 3) * pitch + (lane & 7) * 8) = a;
    *(uint4*)(dst + (size_t)(8 + (lane >> 3)) * pitch + (lane & 7) * 8) = b;
    asm volatile("" ::: "memory");
}
__device__ __forceinline__ void store_block16x32(char* wstrip, const uint2 (&v)[2], bf16_t* dst, int pitch, int lane) {
    const int fr = lane & 15, g = lane >> 4;
#pragma unroll
    for (int q = 0; q < 2; ++q) *(uint2*)(wstrip + fr * 80 + q * 32 + g * 8) = v[q];
    asm volatile("s_waitcnt lgkmcnt(0)" ::: "memory");
    const uint4 a = *(const uint4*)(wstrip + (lane >> 2) * 80 + (lane & 3) * 16);
    *(uint4*)(dst + (size_t)(lane >> 2) * pitch + (lane & 3) * 8) = a;
    asm volatile("s_waitcnt lgkmcnt(0)" ::: "memory");
}
__device__ __forceinline__ void store_row_bf16(char* wstrip, const uint2 (&o)[4], bf16_t* rowptr, int lane) {
#pragma unroll
    for (int i = 0; i < 4; ++i) *(uint2*)(wstrip + i * 512 + lane * 8) = o[i];
    const uint4 a = *(const uint4*)(wstrip + lane * 16), b = *(const uint4*)(wstrip + 1024 + lane * 16);
    *(uint4*)(rowptr + lane * 8) = a; *(uint4*)(rowptr + 512 + lane * 8) = b;
    asm volatile("" ::: "memory");
}
__device__ __forceinline__ bool dense_tile(int it, int NT, bool with_ctx, int bid, int nb, int& mt, int& nt) {
    const int x = bid & 7, j = bid >> 3, jb = nb >> 3;
    int v = it * jb + j;
    if (v < 8 * NT) { mt = 1 + x * 8 + (v & 7); nt = v >> 3; return true; }
    if (!with_ctx) return false;
    v -= 8 * NT; nt = x + 8 * v; mt = 0;
    return nt < NT;
}

__device__ __forceinline__ void st_prologue(const KP& p, int bid, int nb, float* smem) {
    const int tidx = opaque_tid();
    const int tid = tidx;
    {   float2* t16 = WSP(float2, OFF_ROPE); float2* t8 = t16 + 256 * 16;
        for (int idx = bid * NTH + tid; idx < 256 * 24; idx += nb * NTH) {
            const bool big = idx < 256 * 16; const int j = big ? idx : idx - 256 * 16, half = big ? 16 : 8, pos = j / half, i = j % half;
            const float ang = (float)pos * powf(10000.0f, -(float)i / (float)half);
            float sn, cs; sincosf(ang, &sn, &cs);
            (big ? t16 : t8)[j] = make_float2(cs, sn);
        } }
    for (int k = tid; k < 1024; k += NTH) { smem[k] = siluf_(p.in(I_C)[k]); smem[1024 + k] = siluf_(p.in(I_CCTX)[k]); }
    __syncthreads();
    float* mod = WSP(float, OFF_MOD);
    float4* red = (float4*)(smem + 2048);
    for (int jb = bid; jb < 256; jb += nb) {
        const int l = jb >> 7, j0 = (jb & 127) * 48, jj = tid % 12, kk = tid / 12;
        float4 a0 = make_float4(0.f, 0.f, 0.f, 0.f), a1 = a0;
        if (kk < 42) {
            const float* w = p.in(I_WMOD) + (size_t)l * 1024 * 6144 + j0 + jj * 4;
            for (int k = kk; k < 1024; k += 42) { const float4 wv = *(const float4*)(w + (size_t)k * 6144); const float s0 = smem[k], s1 = smem[1024 + k];
                a0.x = fmaf(s0, wv.x, a0.x); a0.y = fmaf(s0, wv.y, a0.y); a0.z = fmaf(s0, wv.z, a0.z); a0.w = fmaf(s0, wv.w, a0.w);
                a1.x = fmaf(s1, wv.x, a1.x); a1.y = fmaf(s1, wv.y, a1.y); a1.z = fmaf(s1, wv.z, a1.z); a1.w = fmaf(s1, wv.w, a1.w); }
            red[(kk * 12 + jj) * 2] = a0; red[(kk * 12 + jj) * 2 + 1] = a1;
        }
        __syncthreads();
        if (tid < 24) {
            const int cj = tid >> 1, cond = tid & 1;
            float4 s = make_float4(0.f, 0.f, 0.f, 0.f);
            for (int q = 0; q < 42; ++q) { const float4 v = red[(q * 12 + cj) * 2 + cond]; s.x += v.x; s.y += v.y; s.z += v.z; s.w += v.w; }
            const float4 b = *(const float4*)(p.in(I_BMOD) + l * 6144 + j0 + cj * 4);
            s.x += b.x; s.y += b.y; s.z += b.z; s.w += b.w;
            *(float4*)(mod + (size_t)(l * 2 + cond) * 6144 + j0 + cj * 4) = s;
        }
        __syncthreads();
    }
}

template <bool IDN, class COLF, class KSF>
__device__ __forceinline__ void conv_t_g(const float* W, bf16_t* Wt, int K, int N, int Npad, int nmat, int bid, int nb, float* smem, COLF colf, KSF ksf) {
    const int tidx = opaque_tid();
    const int tid = tidx;
    const int tn = Npad / 64, tk = K / 64;
    const int ntile = tn * tk * nmat;
    for (int t = bid; t < ntile; t += nb) {
        const int mat = t / (tn * tk), r = t % (tn * tk), n0 = (r / tk) * 64, k0 = (r % tk) * 64;
        const float* Wm = W + (size_t)mat * K * N; bf16_t* Wtm = Wt + (size_t)mat * Npad * K;
        __syncthreads();
        {
            const int kk = tid >> 4, c4 = (tid & 15) * 4; const bool ok = (n0 + c4 < N); const int sc = ok ? colf(n0 + c4) : 0;
#pragma unroll
            for (int i = 0; i < 2; ++i) { float4 v = make_float4(0.f, 0.f, 0.f, 0.f); if (ok) v = *(const float4*)(Wm + (size_t)(k0 + kk + 32 * i) * N + sc); const float s = ksf(k0 + kk + 32 * i);
                float* d = smem + (kk + 32 * i) * 65 + c4; d[0] = v.x * s; d[1] = v.y * s; d[2] = v.z * s; d[3] = v.w * s; }
        }
        __syncthreads();
        {   const int nn = tid >> 3, kc = (tid & 7) * 8;
            float e[8];
#pragma unroll
            for (int j = 0; j < 8; ++j) e[j] = smem[(kc + j) * 65 + nn];
            uint4 o; o.x = pack2(e[0], e[1]); o.y = pack2(e[2], e[3]); o.z = pack2(e[4], e[5]); o.w = pack2(e[6], e[7]);
            *(uint4*)(Wtm + (size_t)(n0 + nn) * K + k0 + kc) = o; }
    }
    __syncthreads();
}
__device__ __forceinline__ void conv_t(const float* W, bf16_t* Wt, int K, int N, int Npad, int nmat, int bid, int nb, float* smem) {
    conv_t_g<true>(W, Wt, K, N, Npad, nmat, bid, nb, smem, [](int n) { return n; }, [](int) { return 1.0f; });
}
__device__ __forceinline__ void st_conv(const KP& p, int l, int bid, int nb, float* smem) {
    const int tidx = opaque_tid(); (void)tidx;
    bf16_t* wb = WSP(bf16_t, OFF_WB);
    conv_t_g<false>(p.in(I_WIN) + (size_t)l * 1024 * NIN, (bf16_t*)((char*)wb + WB_IN), 1024, NIN, NINP, 1, bid, nb, smem, [](int n) { return win_col_old(n); }, [](int) { return 1.0f; });
    {   const float* gcq = p.in(I_GCQ) + l * 256; const float* gckv = p.in(I_GCKV) + l * 128;
        conv_t_g<true>(p.in(I_WUQ) + (size_t)l * 256 * 768, (bf16_t*)((char*)wb + WB_UQ), 256, 768, 768, 1, bid, nb, smem, [](int n) { return n; }, [&](int k) { return gcq[k]; });
        conv_t_g<true>(p.in(I_WUKV) + (size_t)l * 128 * 1024, (bf16_t*)((char*)wb + WB_UKV), 128, 1024, 1024, 1, bid, nb, smem, [](int n) { return n; }, [&](int k) { return gckv[k]; }); }
    conv_t(p.in(I_WGLU) + (size_t)l * 512 * 512, (bf16_t*)((char*)wb + WB_GLU), 512, 512, 512, 1, bid, nb, smem);
    conv_t(p.in(I_WBRM) + (size_t)l * 512 * 1024, (bf16_t*)((char*)wb + WB_BR), 512, 1024, 1024, 1, bid, nb, smem);
    conv_t(p.in(I_WBRS) + (size_t)l * 512 * 1024, (bf16_t*)((char*)wb + WB_BR + (size_t)1024 * 512 * 2), 512, 1024, 1024, 1, bid, nb, smem);
    conv_t(p.in(I_WBRG) + (size_t)l * 512 * 1024, (bf16_t*)((char*)wb + WB_BR + (size_t)2 * 1024 * 512 * 2), 512, 1024, 1024, 1, bid, nb, smem);
    conv_t(p.in(I_WOUT) + (size_t)l * 1024 * 1024, (bf16_t*)((char*)wb + WB_OUT), 1024, 1024, 1024, 1, bid, nb, smem);
}
__device__ __forceinline__ void st_conv_experts(const KP& p, int l, int bid, int nb, float* smem) {
    const int tidx = opaque_tid(); (void)tidx;
    bf16_t* wb = WSP(bf16_t, OFF_WB);
    conv_t(p.in(I_WEG) + (size_t)l * 16 * 1024 * 512, (bf16_t*)((char*)wb + WB_EG), 1024, 512, 512, 16, bid, nb, smem);
    conv_t(p.in(I_WEU) + (size_t)l * 16 * 1024 * 512, (bf16_t*)((char*)wb + WB_EU), 1024, 512, 512, 16, bid, nb, smem);
    conv_t(p.in(I_WED) + (size_t)l * 16 * 512 * 1024, (bf16_t*)((char*)wb + WB_ED), 512, 1024, 1024, 16, bid, nb, smem);
}

__device__ __forceinline__ const float* xrow_c(const KP& p, int r) { return (r < LC) ? (WSP(float, OFF_XC) + (size_t)r * D) : (p.out() + (size_t)(r - LC) * D); }
__device__ __forceinline__ const float* xrow_in(const KP& p, int r) { return (r < LC) ? (p.in(I_CTX) + (size_t)r * D) : (p.in(I_X) + (size_t)(r - LC) * D); }
__device__ __forceinline__ float* xrow(const KP& p, int r) { return (r < LC) ? (WSP(float, OFF_XC) + (size_t)r * D) : (p.out() + (size_t)(r - LC) * D); }
__device__ __forceinline__ void st_modulate(const KP& p, int l, int bid, int nb, char* lds) {
    const int tidx = opaque_tid();
    const int lane = tidx & 63, wid = tidx >> 6;
    bf16_t* Hb = WSP(bf16_t, OFF_H);
    const float* g = p.in(I_GPREMIX) + l * D;
    auto ld = [&](int r, float4 (&v)[4]) __attribute__((always_inline)) {
        const float* xr = l == 0 ? xrow_in(p, r) : xrow_c(p, r);
#pragma unroll
        for (int i = 0; i < 4; ++i) v[i] = *(const float4*)(xr + i * 256 + lane * 4);
    };
    auto proc = [&](int r, float4 (&v)[4]) __attribute__((always_inline)) {
        const float* md = WSP(float, OFF_MOD) + (size_t)(l * 2 + (r < LC ? 1 : 0)) * 6144;
        float ss = 0.f;
#pragma unroll
        for (int i = 0; i < 4; ++i) ss += v[i].x * v[i].x + v[i].y * v[i].y + v[i].z * v[i].z + v[i].w * v[i].w;
        ss = wave_sum(ss);
        const float rstd = rsqrtf(ss * (1.0f / D) + EPS);
        uint2 ov[4];
#pragma unroll
        for (int i = 0; i < 4; ++i) {
            const int c = i * 256 + lane * 4;
            const float4 gg = *(const float4*)(g + c), sh = *(const float4*)(md + c), sc = *(const float4*)(md + 1024 + c);
            const float h0 = v[i].x * rstd * gg.x * (1.f + sc.x) + sh.x, h1 = v[i].y * rstd * gg.y * (1.f + sc.y) + sh.y;
            const float h2 = v[i].z * rstd * gg.z * (1.f + sc.z) + sh.z, h3 = v[i].w * rstd * gg.w * (1.f + sc.w) + sh.w;
            ov[i].x = pack2(h0, h1); ov[i].y = pack2(h2, h3);
        }
        store_row_bf16(lds + LDS_STRIP + wid * 2304, ov, Hb + (size_t)r * D, lane);
    };
    {   const int r0 = bid * NWV + wid, rs = nb * NWV;
        float4 va[4], vb[4];
        if (r0 < T) ld(r0, va);
        for (int r = r0; r < T; r += 2 * rs) {
            if (r + rs < T) ld(r + rs, vb);
            proc(r, va);
            if (r + rs < T) { if (r + 2 * rs < T) ld(r + 2 * rs, va); proc(r + rs, vb); }
        } }
}

__device__ __forceinline__ void st_gemm_in(const KP& p, int l, int bid, int nb, char* lds) {
    const int tidx = opaque_tid();
    if (bid == 0 && tidx < 8) WSP(unsigned, OFF_CNT)[32 + tidx] = 0u;
    const bf16_t* Hb = WSP(bf16_t, OFF_H); const bf16_t* Wt = WSP(bf16_t, OFF_WB + WB_IN); bf16_t* P = WSP(bf16_t, OFF_P);
    float* ssq = WSP(float, OFF_SSQ); const float2* t16 = WSP(float2, OFF_ROPE); const float2* t8 = t16 + 256 * 16;
    const float* gqn = p.in(I_GQN) + l * 64; const float* gkn = p.in(I_GKN) + l * 64;
    int mt, pn;
    for (int it = 0; dense_tile(it, NINP / 256, true, bid, nb, mt, pn); ++it) {
        acc_t acc2[2]; acc_zero(acc2[0]); acc_zero(acc2[1]);
        gemm_core256_dense(acc2, Hb + (size_t)mt * 256 * 1024, 1024, Wt + (size_t)pn * 256 * 1024, 1024, 1024, lds);
        const int tid2 = opaque_tid(), lane = tid2 & 63, wid = tid2 >> 6, wn = wid >> 2, wc = wid & 3, fr = lane & 15, g = lane >> 4;
#pragma unroll
      for (int nh = 0; nh < 2; ++nh) {
        const int nt = 2 * pn + nh; const acc_t& acc = acc2[nh];
#pragma unroll
        for (int im = 0; im < 4; ++im) {
            const int ml = (im >> 1) * 128 + wc * 32 + (im & 1) * 16 + fr, row = mt * 256 + ml;
            bf16_t* prow_ = P + (size_t)row * PP + nt * 128 + wn * 64 + 4 * g;
            const bool lat = row >= LC; const int tpos = row - LC, prow = lat ? (tpos >> 6) : 0, pcol = lat ? (tpos & 63) : 0;
            f32x4 v[4];
#pragma unroll
            for (int in = 0; in < 4; ++in) v[in] = acc[in][im];
            if (nt <= 4) {
                float ss = 0.f;
#pragma unroll
                for (int in = 0; in < 4; ++in) ss += (v[in][0] * v[in][0] + v[in][1] * v[in][1]) + (v[in][2] * v[in][2] + v[in][3] * v[in][3]);
                ss += __shfl_xor(ss, 16); ss += __shfl_xor(ss, 32);
                const float sc = rsqrtf(ss * (1.0f / 64.0f) + EPS) * (nt < 4 ? SC_GQA : 1.0f);
                const float* gg = (nt < 4 ? gqn : gkn) + 4 * g;
#pragma unroll
                for (int in = 0; in < 4; ++in) { const float4 g4 = *(const float4*)(gg + 16 * in); v[in][0] *= sc * g4.x; v[in][1] *= sc * g4.y; v[in][2] *= sc * g4.z; v[in][3] *= sc * g4.w; }
                if (lat) {
#pragma unroll
                    for (int hlf = 0; hlf < 2; ++hlf) {
                        const float4* cs = (const float4*)(t16 + (hlf == 0 ? prow : pcol) * 16 + 4 * g);
                        const float4 c01 = cs[0], c23 = cs[1];
                        const f32x4 cc = {c01.x, c01.z, c23.x, c23.z}, sn = {c01.y, c01.w, c23.y, c23.w}, a = v[2 * hlf], b = v[2 * hlf + 1];
                        v[2 * hlf] = a * cc - b * sn; v[2 * hlf + 1] = a * sn + b * cc; }
                }
            } else if (nt >= 6 && nt <= 8) {
                float ss = 0.f;
#pragma unroll
                for (int in = 0; in < 4; ++in) ss += (v[in][0] * v[in][0] + v[in][1] * v[in][1]) + (v[in][2] * v[in][2] + v[in][3] * v[in][3]);
                ss += __shfl_xor(ss, 16); ss += __shfl_xor(ss, 32);
                if (g == 0) ssq[(size_t)row * 8 + (nt - 6) * 2 + wn] = ss;
            } else if (nt == 9 && wn == 0) {
#pragma unroll
                for (int in = 0; in < 2; ++in) {
                    f32x4 o; o[0] = __shfl_xor(v[in][0], 32); o[1] = __shfl_xor(v[in][1], 32); o[2] = __shfl_xor(v[in][2], 32); o[3] = __shfl_xor(v[in][3], 32);
                    if (lat) { const float4* cs = (const float4*)(t8 + (in == 0 ? prow : pcol) * 8 + 4 * (g & 1));
                        const float4 c01 = cs[0], c23 = cs[1];
                        if (g < 2) { v[in][0] = v[in][0] * c01.x - o[0] * c01.y; v[in][1] = v[in][1] * c01.z - o[1] * c01.w; v[in][2] = v[in][2] * c23.x - o[2] * c23.y; v[in][3] = v[in][3] * c23.z - o[3] * c23.w; }
                        else { v[in][0] = o[0] * c01.y + v[in][0] * c01.x; v[in][1] = o[1] * c01.w + v[in][1] * c01.z; v[in][2] = o[2] * c23.y + v[in][2] * c23.x; v[in][3] = o[3] * c23.w + v[in][3] * c23.z; } }
                }
            }
            if (nt <= 8) {
                uint2 vv[4];
#pragma unroll
                for (int in = 0; in < 4; ++in) vv[in] = pack4(v[in]);
                store_block16x64(lds + LDS_STRIP + wid * 2304, vv, P + (size_t)(row - fr) * PP + nt * 128 + wn * 64, PP, lane);
            } else
#pragma unroll
            for (int q = 0; q < 2; ++q) {
                const int G0 = nt * 8 + wn * 4 + 2 * q;
                if (G0 >= 106) {
                    if (G0 < 298) {
                        uint4 o; o.x = pack2(sigmoidf_(v[2 * q][0]), sigmoidf_(v[2 * q][1])); o.y = pack2(sigmoidf_(v[2 * q][2]), sigmoidf_(v[2 * q][3]));
                        o.z = pack2(sigmoidf_(v[2 * q + 1][0]), sigmoidf_(v[2 * q + 1][1])); o.w = pack2(sigmoidf_(v[2 * q + 1][2]), sigmoidf_(v[2 * q + 1][3]));
                        *(uint4*)(WSP(bf16_t, OFF_GS) + ((((size_t)(mt * 96 + ((G0 - 106) >> 1)) * 16 + (ml >> 4)) * 64) + lane) * 8) = o; }
                } else {
#pragma unroll
                    for (int in = 2 * q; in < 2 * q + 2; ++in) {
                        const int G = nt * 8 + wn * 4 + in;
                        if (G >= 74) *(uint2*)(WSP(bf16_t, OFF_SSMG) + ((size_t)(G - 74) * T + row) * 16 + 4 * g) = pack4(v[in]);
                        else *(uint2*)(prow_ + 16 * in) = pack4(v[in]);
                    }
                }
            }
        }
      }
    }
}

__device__ __forceinline__ void rope_pair(float& a, float& b, int pos, int i, int half) {
    const float freq = powf(10000.0f, -(float)i / (float)half);
    const float ang = (float)pos * freq;
    float sn, cs; sincosf(ang, &sn, &cs);
    const float na = a * cs - b * sn, nb_ = a * sn + b * cs; a = na; b = nb_;
}

constexpr int S5C = 64, NCH = T / S5C;
constexpr size_t S5_ZERO = OFF_WB + WB_EG;
constexpr size_t S5_KTAB = S5_ZERO + 256;
constexpr size_t S5_FTAB = S5_KTAB + (size_t)64 * 64 * 256 * 2;
constexpr size_t S5_GTAB = S5_FTAB + (size_t)64 * 128 * 1024 * 2;
constexpr size_t S5_SINB = S5_GTAB + (size_t)64 * 1024 * 128 * 2;
static_assert(S5_SINB + (size_t)NCH * 64 * 128 * 2 <= OFF_WB + WB_BYTES, "s5 tables overlay");
__device__ __forceinline__ int s5_row(int dir, int j) { return dir == 0 ? j : (j < LC ? LC - 1 - j : T + LC - 1 - j); }
__device__ __forceinline__ void s5_consts(const KP& p, int l, int dir, int g, int lane, float& lr, float& li, float (&bbr)[16], float (&bbi)[16]) {
    const int gi = (l * 2 + dir) * 32 + g, pi = gi * 64 + lane;
    const float are = p.in(I_ARE)[pi], aim = p.in(I_AIM)[pi], dt = expf(p.in(I_LOGDT)[gi]);
    const float mag = expf(are * dt); float sn, cs; sincosf(aim * dt, &sn, &cs);
    lr = mag * cs; li = mag * sn; const float den = are * are + aim * aim;
    const float cr = ((lr - 1.0f) * are + li * aim) / den, ci = (li * are - (lr - 1.0f) * aim) / den;
    const float4* br4 = (const float4*)(p.in(I_BRE) + (size_t)pi * 16); const float4* bi4 = (const float4*)(p.in(I_BIM) + (size_t)pi * 16);
#pragma unroll
    for (int q = 0; q < 4; ++q) { const float4 br = br4[q], bi = bi4[q];
        bbr[4 * q] = cr * br.x - ci * bi.x; bbi[4 * q] = cr * bi.x + ci * br.x; bbr[4 * q + 1] = cr * br.y - ci * bi.y; bbi[4 * q + 1] = cr * bi.y + ci * br.y;
        bbr[4 * q + 2] = cr * br.z - ci * bi.z; bbi[4 * q + 2] = cr * bi.z + ci * br.z; bbr[4 * q + 3] = cr * br.w - ci * bi.w; bbi[4 * q + 3] = cr * bi.w + ci * br.w; }
}
__device__ __forceinline__ void s5_unpack(uint4 a, uint4 b, float (&u)[16]) {
    u[0] = bflo(a.x); u[1] = bfhi(a.x); u[2] = bflo(a.y); u[3] = bfhi(a.y); u[4] = bflo(a.z); u[5] = bfhi(a.z); u[6] = bflo(a.w); u[7] = bfhi(a.w);
    u[8] = bflo(b.x); u[9] = bfhi(b.x); u[10] = bflo(b.y); u[11] = bfhi(b.y); u[12] = bflo(b.z); u[13] = bfhi(b.z); u[14] = bflo(b.w); u[15] = bfhi(b.w);
}
__device__ __forceinline__ void st_s5_local(const KP& p, int l, int bid, int nb) {
    const int tidx = opaque_tid();
    const int lane = tidx & 63, wid = tidx >> 6;
    const bf16_t* P = WSP(bf16_t, OFF_P); float2* F = WSP(float2, OFF_S5);
    const int gw = bid * NWV + wid, nw = nb * NWV;
    if (gw >= (nw / 64) * 64) return;
    const int gd = gw & 63, dir = gd >> 5, g = gd & 31, part = gw >> 6, nparts = nw >> 6;
    if (part >= 4) return;
    float lr, li, bbr[16], bbi[16]; s5_consts(p, l, dir, g, lane, lr, li, bbr, bbi);
    for (int c = part; c < 4; c += nparts) {
        float sr = 0.f, si = 0.f;
        for (int j0 = 0; j0 < S5C; j0 += 8) {
            uint4 ua[8], ub[8];
#pragma unroll
            for (int q = 0; q < 8; ++q) { const int r = s5_row(dir, c * S5C + j0 + q); const uint4* up = (const uint4*)SSMU(g, r); ua[q] = up[0]; ub[q] = up[1]; }
#pragma unroll
            for (int q = 0; q < 8; ++q) { float u[16]; s5_unpack(ua[q], ub[q], u);
                float bur = 0.f, bui = 0.f;
#pragma unroll
                for (int cc = 0; cc < 16; ++cc) { bur = fmaf(bbr[cc], u[cc], bur); bui = fmaf(bbi[cc], u[cc], bui); }
                const float nsr = lr * sr - li * si + bur, nsi = lr * si + li * sr + bui; sr = nsr; si = nsi; }
        }
        F[((size_t)(c * 2 + dir) * 32 + g) * 64 + lane] = make_float2(sr, si);
    }
}
__device__ __forceinline__ void st_s5_carry(const KP& p, int l, int bid, int nb, char* lds) {
    const int tidx = opaque_tid();
    float2* F = WSP(float2, OFF_S5); bf16_t* SB = WSP(bf16_t, S5_SINB);
    float4* comp = (float4*)lds;
    constexpr int RUN = 9;
    for (int cb = bid; cb < 256; cb += nb) {
        const int chl = tidx & 15, seg = tidx >> 4, idx = cb * 16 + chl;
        const int gi = l * 64 + (idx >> 6);
        const float are = p.in(I_ARE)[gi * 64 + (idx & 63)], aim = p.in(I_AIM)[gi * 64 + (idx & 63)], dt = expf(p.in(I_LOGDT)[gi]);
        const float mag = expf(are * dt); float sn, cs; sincosf(aim * dt, &sn, &cs);
        float pr = mag * cs, pi_ = mag * sn;
#pragma unroll
        for (int q = 0; q < 6; ++q) { const float nr = pr * pr - pi_ * pi_, ni = 2.f * pr * pi_; pr = nr; pi_ = ni; asm volatile("" : "+v"(pr), "+v"(pi_)); }
        const int c0 = seg * RUN;
        float2 f[RUN]; float ar = 1.f, ai = 0.f, br = 0.f, bi = 0.f;
#pragma unroll
        for (int q = 0; q < RUN; ++q) { const int c = c0 + q; f[q] = (c < NCH) ? F[(size_t)c * 4096 + idx] : make_float2(0.f, 0.f);
            if (c >= 4 && c < NCH) { const float2 f2 = WSP(float2, OFF_S5B)[(size_t)c * 4096 + idx]; f[q].x += f2.x; f[q].y += f2.y; }
            if (c < NCH) { const float nbr = pr * br - pi_ * bi + f[q].x, nbi = pr * bi + pi_ * br + f[q].y; br = nbr; bi = nbi;
                           const float nar = pr * ar - pi_ * ai, nai = pr * ai + pi_ * ar; ar = nar; ai = nai; } }
        __syncthreads();
        comp[chl * 32 + seg] = make_float4(ar, ai, br, bi);
        __syncthreads();
        float sr = 0.f, si = 0.f;
        for (int j = 0; j < seg; ++j) { const float4 cj = comp[chl * 32 + j]; const float nr = cj.x * sr - cj.y * si + cj.z, ni = cj.x * si + cj.y * sr + cj.w; sr = nr; si = ni; }
#pragma unroll
        for (int q = 0; q < RUN; ++q) { const int c = c0 + q;
            if (c < NCH) {
                bf16_t* sb = SB + ((size_t)c * 64 + (idx >> 6)) * 128 + (idx & 63); sb[0] = f2bf(sr); sb[64] = f2bf(si);
                const float nr = pr * sr - pi_ * si + f[q].x, ni = pr * si + pi_ * sr + f[q].y; sr = nr; si = ni; } }
    }
    __syncthreads();
}
__device__ __forceinline__ void st_s5_scan(const KP& p, int l, int bid, int nb) {
    const int tidx = opaque_tid();
    const int lane = tidx & 63, wid = tidx >> 6;
    const bf16_t* P = WSP(bf16_t, OFF_P); const float2* F = WSP(float2, OFF_S5);
    const int gw = bid * NWV + wid, nw = nb * NWV;
    if (gw >= (nw / 64) * 64) return;
    const int gd = gw & 63, dir = gd >> 5, g = gd & 31, part = gw >> 6, nparts = nw >> 6;
    if (part >= 4) return;
    float* Yo = dir == 0 ? WSP(float, OFF_OM) : WSP(float, OFF_H);
    float lr, li, bbr[16], bbi[16]; s5_consts(p, l, dir, g, lane, lr, li, bbr, bbi);
    const int gi = (l * 2 + dir) * 32 + g;
    float cre[16], cim[16];
#pragma unroll
    for (int cc = 0; cc < 16; ++cc) { cre[cc] = p.in(I_CRE)[((size_t)gi * 16 + cc) * 64 + lane]; cim[cc] = p.in(I_CIM)[((size_t)gi * 16 + cc) * 64 + lane]; }
    const float dsk = p.in(I_SSMD)[l * 512 + g * 16 + (lane & 15)];
    for (int c = part; c < 4; c += nparts) {
        const float2 s0 = F[((size_t)(c * 2 + dir) * 32 + g) * 64 + lane];
        float sr = s0.x, si = s0.y;
        for (int j0 = 0; j0 < S5C; j0 += 8) {
            uint4 ua[8], ub[8];
#pragma unroll
            for (int q = 0; q < 8; ++q) { const int r = s5_row(dir, c * S5C + j0 + q); const uint4* up = (const uint4*)SSMU(g, r); ua[q] = up[0]; ub[q] = up[1]; }
#pragma unroll
            for (int q = 0; q < 8; ++q) { const int r = s5_row(dir, c * S5C + j0 + q);
                float u[16]; s5_unpack(ua[q], ub[q], u);
                float bur = 0.f, bui = 0.f;
#pragma unroll
                for (int cc = 0; cc < 16; ++cc) { bur = fmaf(bbr[cc], u[cc], bur); bui = fmaf(bbi[cc], u[cc], bui); }
                const float nsr = lr * sr - li * si + bur, nsi = lr * si + li * sr + bui; sr = nsr; si = nsi;
                float t16[16];
#pragma unroll
                for (int cc = 0; cc < 16; ++cc) t16[cc] = cre[cc] * sr - cim[cc] * si;
                float y = transpose_reduce16(t16, lane);
                if (lane < 16) {
                    if (dir == 0) y += dsk * bf2f(SSMU(g, r)[lane]);
                    Yo[(size_t)r * 512 + g * 16 + lane] = y; }
            }
        }
    }
}

__device__ __forceinline__ void st_s5_tables(const KP& p, int l, int bid, int nb, char* lds) {
    const int tidx = opaque_tid();
    float* pwr = (float*)lds; float* pwi = pwr + 65 * 64; float* bbr = pwi + 65 * 64; float* bbi = bbr + 1024; float* cre = bbi + 1024; float* cim = cre + 1024;
    bf16_t* Ktab = WSP(bf16_t, S5_KTAB); bf16_t* Ftab = WSP(bf16_t, S5_FTAB); bf16_t* Gtab = WSP(bf16_t, S5_GTAB);
    if (bid == 0 && tidx < 64) WSP(unsigned, S5_ZERO)[tidx] = 0u;
    for (int item = bid; item < 256; item += nb) {
        const int gd = item >> 2, q = item & 3, dir = gd >> 5, g = gd & 31, gi = (l * 2 + dir) * 32 + g;
        __syncthreads();
        if (tidx < 64) {
            const int pp = tidx, pi = gi * 64 + pp;
            const float are = p.in(I_ARE)[pi], aim = p.in(I_AIM)[pi], dt = expf(p.in(I_LOGDT)[gi]);
            const float mag = expf(are * dt); float sn, cs; sincosf(aim * dt, &sn, &cs);
            float lr = mag * cs, li = mag * sn, den = are * are + aim * aim;
            asm volatile("" : "+v"(lr), "+v"(li), "+v"(den));
            float cr = ((lr - 1.0f) * are + li * aim) / den; asm volatile("" : "+v"(cr)); float ci = (li * are - (lr - 1.0f) * aim) / den; asm volatile("" : "+v"(ci));
            for (int c = 0; c < 16; ++c) { const float br = p.in(I_BRE)[(size_t)pi * 16 + c], bi = p.in(I_BIM)[(size_t)pi * 16 + c];
                bbr[pp * 16 + c] = cr * br - ci * bi; bbi[pp * 16 + c] = cr * bi + ci * br; }
            float ar = 1.f, ai = 0.f;
#pragma unroll 1
            for (int n = 0; n <= 64; ++n) { pwr[n * 64 + pp] = ar; pwi[n * 64 + pp] = ai; const float nr = ar * lr - ai * li, ni = ar * li + ai * lr; ar = nr; ai = ni; asm volatile("" : "+v"(ar), "+v"(ai)); }
        } else {
            for (int i = tidx - 64; i < 1024; i += NTH - 64) { cre[i] = p.in(I_CRE)[(size_t)gi * 1024 + i]; cim[i] = p.in(I_CIM)[(size_t)gi * 1024 + i]; }
        }
        __syncthreads();
        for (int e = 0; e < 8; ++e) {
            const int idx = tidx + NTH * e, tau = 16 * q + (idx >> 8), c = (idx >> 4) & 15, c2 = idx & 15;
            float s = 0.f;
            for (int pp = 0; pp < 64; ++pp) {
                const float xr = cre[c * 64 + pp], xi = cim[c * 64 + pp], wr = pwr[tau * 64 + pp], wi = pwi[tau * 64 + pp];
                const float zr = xr * wr - xi * wi, zi = xr * wi + xi * wr;
                s += zr * bbr[pp * 16 + c2] - zi * bbi[pp * 16 + c2];
            }
            Ktab[(((size_t)gd * 64 + tau) * 16 + c) * 16 + c2] = f2bf(s);
        }
        for (int e = 0; e < 32; ++e) {
            const int idx2 = tidx + NTH * e, n = 32 * q + (idx2 >> 9), k = (idx2 & 511) * 2, pp = n >> 1, comp = n & 1, i = k >> 4, c2 = k & 15;
            const float wr = pwr[(63 - i) * 64 + pp], wi = pwi[(63 - i) * 64 + pp];
            const float b0r = bbr[pp * 16 + c2], b0i = bbi[pp * 16 + c2], b1r = bbr[pp * 16 + c2 + 1], b1i = bbi[pp * 16 + c2 + 1];
            const float v0 = comp ? (wr * b0i + wi * b0r) : (wr * b0r - wi * b0i), v1 = comp ? (wr * b1i + wi * b1r) : (wr * b1r - wi * b1i);
            *(unsigned*)(Ftab + ((size_t)gd * 128 + n) * 1024 + k) = pack2(v0, v1);
        }
        for (int e = 0; e < 32; ++e) {
            const int idx2 = tidx + NTH * e, row = 256 * q + (idx2 >> 6), n = (idx2 & 63) * 2, t = row >> 4, c = row & 15, comp = n >> 6, pp = n & 63;
            float v[2];
#pragma unroll
            for (int h = 0; h < 2; ++h) { const float xr = cre[c * 64 + pp + h], xi = cim[c * 64 + pp + h], wr = pwr[(t + 1) * 64 + pp + h], wi = pwi[(t + 1) * 64 + pp + h];
                v[h] = comp ? -(xr * wi + xi * wr) : (xr * wr - xi * wi); }
            *(unsigned*)(Gtab + ((size_t)gd * 1024 + row) * 128 + n) = pack2(v[0], v[1]);
        }
    }
    __syncthreads();
}
__device__ __forceinline__ void st_s5_fgemm(const KP& p, int bid, int nb, char* lds) {
    const int tidx = opaque_tid();
    const bf16_t* P = WSP(bf16_t, OFF_P); const bf16_t* Ftab = WSP(bf16_t, S5_FTAB); float* F = WSP(float, OFF_S5);
    const int srow = tidx >> 3, gch = (tidx & 7) ^ ((srow >> 1) & 7);
    for (int u = bid; u < 128; u += nb) {
        const int gd = u >> 1, kh = u & 1, dir = gd >> 5, g = gd & 31;
        float* Fo = kh == 0 ? F : WSP(float, OFF_S5B);
        acc_t acc; acc_zero(acc);
        gemm_core_g(acc,
            [&](int i, int kt) { const int m = srow + 64 * i, tok = (kt + 8 * kh) * 4 + (gch >> 1); return SSMU(g, s5_row(dir, 64 * (4 + m) + tok)) + 8 * (gch & 1); },
            [&](int i, int kt) { return Ftab + ((size_t)gd * 128 + srow + 64 * i) * 1024 + (kt + 8 * kh) * 64 + gch * 8; }, 8, lds);
        acc_visit(acc, [&](int ml, int nl, f32x4 v) {
            *(f32x4*)(Fo + (((size_t)(4 + ml) * 2 + dir) * 32 + g) * 128 + nl) = v; });
    }
}
__device__ __forceinline__ void st_s5_ygemm(const KP& p, int l, int bid, int nb, char* lds) {
    const int tidx = opaque_tid();
    const bf16_t* P = WSP(bf16_t, OFF_P); const bf16_t* Ktab = WSP(bf16_t, S5_KTAB); const bf16_t* Gtab = WSP(bf16_t, S5_GTAB);
    const bf16_t* Sinb = WSP(bf16_t, S5_SINB); const bf16_t* Zero = WSP(bf16_t, S5_ZERO); bf16_t* Y1 = WSP(bf16_t, OFF_OS);
    const int srow = tidx >> 3, gch = (tidx & 7) ^ ((srow >> 1) & 7);
    for (int u = bid; u < 256; u += nb) {
        const int g = u >> 3, nt = u & 7;
        acc_t acc; acc_zero(acc);
        {   const int gd = g, nkt = 2 * (nt + 1);
            gemm_core_g(acc,
                [&](int i, int kt) { const int m = srow + 64 * i;
                    if (kt < nkt) { const int tok = kt * 4 + (gch >> 1); return SSMU(g, 64 * (4 + m) + tok) + 8 * (gch & 1); }
                    return Sinb + ((size_t)(4 + m) * 64 + gd) * 128 + (kt - nkt) * 64 + gch * 8; },
                [&](int i, int kt) { const int n = nt * 128 + srow + 64 * i, t = n >> 4, c = n & 15;
                    if (kt < nkt) { const int tau = t - (kt * 4 + (gch >> 1)); return tau >= 0 ? Ktab + (((size_t)gd * 64 + tau) * 16 + c) * 16 + 8 * (gch & 1) : Zero; }
                    return Gtab + ((size_t)gd * 1024 + n) * 128 + (kt - nkt) * 64 + gch * 8; }, nkt + 2, lds); }
        {   const int gd = 32 + g, nkt = 2 * (8 - nt);
            gemm_core_g(acc,
                [&](int i, int kt) { const int m = srow + 64 * i, cx = 259 - m;
                    if (kt < nkt) { const int tok = kt * 4 + (gch >> 1); return SSMU(g, T + LC - 1 - (64 * cx + tok)) + 8 * (gch & 1); }
                    return Sinb + ((size_t)cx * 64 + gd) * 128 + (kt - nkt) * 64 + gch * 8; },
                [&](int i, int kt) { const int n = nt * 128 + srow + 64 * i, t = 63 - (n >> 4), c = n & 15;
                    if (kt < nkt) { const int tau = t - (kt * 4 + (gch >> 1)); return tau >= 0 ? Ktab + (((size_t)gd * 64 + tau) * 16 + c) * 16 + 8 * (gch & 1) : Zero; }
                    return Gtab + ((size_t)gd * 1024 + t * 16 + c) * 128 + (kt - nkt) * 64 + gch * 8; }, nkt + 2, lds); }
        acc_visit(acc, [&](int ml, int nl, f32x4 v) {
            const int n = nt * 128 + nl, t = n >> 4, c0 = n & 15, r = 64 * (4 + ml) + t;
            const float4 dsk = *(const float4*)(p.in(I_SSMD) + l * 512 + g * 16 + c0); const uint2 ur = *(const uint2*)(SSMU(g, r) + c0);
            uint2 o; o.x = pack2(gelu_tanh(v[0] + dsk.x * bflo(ur.x)), gelu_tanh(v[1] + dsk.y * bfhi(ur.x))); o.y = pack2(gelu_tanh(v[2] + dsk.z * bflo(ur.y)), gelu_tanh(v[3] + dsk.w * bfhi(ur.y)));
            *(uint2*)(Y1 + (size_t)r * 512 + g * 16 + c0) = o; });
    }
}
__device__ __forceinline__ void st_s5_ctx_y(const KP& p, int l, int bid, int nb) {
    const int tidx = opaque_tid();
    const int lane = tidx & 63, wid = tidx >> 6, fr = lane & 15, g8 = lane >> 4;
    const bf16_t* Ktab = WSP(bf16_t, S5_KTAB); const bf16_t* Gtab = WSP(bf16_t, S5_GTAB); const bf16_t* Sinb = WSP(bf16_t, S5_SINB); bf16_t* Y1 = WSP(bf16_t, OFF_OS);
    const bf16x8 zero8 = {0, 0, 0, 0, 0, 0, 0, 0};
    for (int w = bid * NWV + wid; w < 2048; w += nb * NWV) {
        const int g = w >> 6, t = w & 63;
        f32x4 acc = {0.f, 0.f, 0.f, 0.f};
#pragma unroll 1
        for (int dir = 0; dir < 2; ++dir) {
            const int gd = dir * 32 + g, td = dir == 0 ? t : 63 - t, cxd = dir == 0 ? fr : 3 - fr, nks = (td >> 1) + 1;
#pragma unroll 1
            for (int k0 = 0; k0 < nks; k0 += 8) {
                bf16x8 wf[8], xf[8];
#pragma unroll
                for (int j = 0; j < 8; ++j) {
                    const int kt = k0 + j, i = 2 * kt + (g8 >> 1), tau = td - i;
                    wf[j] = zero8; xf[j] = zero8;
                    if (kt < nks) {
                        if (tau >= 0) wf[j] = *(const bf16x8*)(Ktab + (((size_t)gd * 64 + tau) * 16 + fr) * 16 + (g8 & 1) * 8);
                        if (fr < 4) { const int jp = 64 * cxd + i, row = dir == 0 ? jp : LC - 1 - jp; xf[j] = *(const bf16x8*)(SSMU(g, row) + (g8 & 1) * 8); }
                    }
                }
#pragma unroll
                for (int j = 0; j < 8; ++j) acc = MFMA16(wf[j], xf[j], acc);
            }
            {   bf16x8 wf[4], xf[4];
#pragma unroll
                for (int ks = 0; ks < 4; ++ks) {
                    wf[ks] = *(const bf16x8*)(Gtab + ((size_t)gd * 1024 + td * 16 + fr) * 128 + ks * 32 + g8 * 8);
                    xf[ks] = zero8; if (fr < 4) xf[ks] = *(const bf16x8*)(Sinb + ((size_t)cxd * 64 + gd) * 128 + ks * 32 + g8 * 8);
                }
#pragma unroll
                for (int ks = 0; ks < 4; ++ks) acc = MFMA16(wf[ks], xf[ks], acc);
            }
        }
        if (fr < 4) {
            const int r = 64 * fr + t, c0 = 4 * g8;
            const float4 dsk = *(const float4*)(p.in(I_SSMD) + l * 512 + g * 16 + c0); const uint2 ur = *(const uint2*)(SSMU(g, r) + c0);
            uint2 o; o.x = pack2(gelu_tanh(acc[0] + dsk.x * bflo(ur.x)), gelu_tanh(acc[1] + dsk.y * bfhi(ur.x))); o.y = pack2(gelu_tanh(acc[2] + dsk.z * bflo(ur.y)), gelu_tanh(acc[3] + dsk.w * bfhi(ur.y)));
            *(uint2*)(Y1 + (size_t)r * 512 + g * 16 + c0) = o;
        }
    }
}
__device__ __forceinline__ void st_s5_fin(const KP& p, int bid, int nb) {
    const int tidx = opaque_tid();
    const float* Yf = WSP(float, OFF_OM); const float* Yb = WSP(float, OFF_H); bf16_t* P = WSP(bf16_t, OFF_P);
    for (long idx = (long)bid * NTH + tidx; idx < (long)T * 512; idx += (long)nb * NTH) {
        const int r = (int)(idx >> 9), c = (int)(idx & 511);
        P[(size_t)r * PP + C_SSM + c] = f2bf(gelu_tanh(Yf[idx] + Yb[idx]));
    }
}

template <int SET>
__device__ __forceinline__ void st_proj2(const KP& p, int l, int bid, int nb, char* lds) {
    const int tidx = opaque_tid();
    bf16_t* P = WSP(bf16_t, OFF_P);
    if (SET == 0) {
        const bf16_t* Wuq = WSP(bf16_t, OFF_WB + WB_UQ); bf16_t* Qm = WSP(bf16_t, OFF_H);
        const bf16_t* Wukv = WSP(bf16_t, OFF_WB + WB_UKV); bf16_t* Kn = WSP(bf16_t, OFF_KN); bf16_t* Vm = WSP(bf16_t, OFF_V);
        int mt, ntv;
        for (int it = 0; dense_tile(it, 7, true, bid, nb, mt, ntv); ++it) {
            const bool isq = ntv < 3; const int pn = isq ? ntv : ntv - 3, K = isq ? 256 : 128;
            acc_t acc2[2]; acc_zero(acc2[0]); acc_zero(acc2[1]);
            gemm_core256_dense(acc2, P + (size_t)mt * 256 * PP + (isq ? C_CQ : C_CKV), PP, (isq ? Wuq : Wukv) + (size_t)pn * 256 * K, K, K, lds);
            const int tid2 = opaque_tid(), lane_ = tid2 & 63, wid_ = tid2 >> 6, wn_ = wid_ >> 2, wc_ = wid_ & 3, fr_ = lane_ & 15, g_ = lane_ >> 4;
            const float* ssq = WSP(float, OFF_SSQ);
            char* wstrip = lds + LDS_STRIP + wid_ * 2304;
            if (isq) {
                const float2* t8 = WSP(float2, OFF_ROPE) + 256 * 16;
#pragma unroll
                for (int nh = 0; nh < 2; ++nh) {
                    const int nt = 2 * pn + nh;
#pragma unroll
                    for (int im = 0; im < 4; ++im) {
                        const int row = mt * 256 + (im >> 1) * 128 + wc_ * 32 + (im & 1) * 16 + fr_;
                        const float4 s4 = *(const float4*)(ssq + (size_t)row * 8);
                        const float sc = rsqrtf(((s4.x + s4.y) + (s4.z + s4.w)) * (1.0f / 256.0f) + EPS) * SC_MLA;
                        const bool lat = row >= LC; const int tpos = row - LC, prow = lat ? (tpos >> 6) : 0, pcol = lat ? (tpos & 63) : 0;
                        uint2 vv[4];
#pragma unroll
                        for (int in = 0; in < 4; ++in) {
                            f32x4 v = acc2[nh][in][im] * sc;
                            if (((nt * 4 + wn_ * 2 + (in >> 1)) % 3) == 2) {
                                f32x4 o; o[0] = __shfl_xor(v[0], 32); o[1] = __shfl_xor(v[1], 32); o[2] = __shfl_xor(v[2], 32); o[3] = __shfl_xor(v[3], 32);
                                if (lat) { const float4* cs = (const float4*)(t8 + ((in & 1) == 0 ? prow : pcol) * 8 + 4 * (g_ & 1));
                                    const float4 c01 = cs[0], c23 = cs[1];
                                    if (g_ < 2) { v[0] = v[0] * c01.x - o[0] * c01.y; v[1] = v[1] * c01.z - o[1] * c01.w; v[2] = v[2] * c23.x - o[2] * c23.y; v[3] = v[3] * c23.z - o[3] * c23.w; }
                                    else { v[0] = o[0] * c01.y + v[0] * c01.x; v[1] = o[1] * c01.w + v[1] * c01.z; v[2] = o[2] * c23.y + v[2] * c23.x; v[3] = o[3] * c23.w + v[3] * c23.z; } }
                            }
                            vv[in] = pack4(v);
                        }
                        store_block16x64(wstrip, vv, Qm + (size_t)(row - fr_) * 768 + nt * 128 + wn_ * 64, 768, lane_);
                    }
                }
            } else {
#pragma unroll
                for (int nh = 0; nh < 2; ++nh) {
                    const int nt = 2 * pn + nh;
#pragma unroll
                    for (int im = 0; im < 4; ++im) {
                        const int row0 = mt * 256 + (im >> 1) * 128 + wc_ * 32 + (im & 1) * 16;
                        const float2 s2 = *(const float2*)(ssq + (size_t)(row0 + fr_) * 8 + 4);
                        const float sc = rsqrtf((s2.x + s2.y) * (1.0f / 128.0f) + EPS);
                        uint2 vv[4];
#pragma unroll
                        for (int in = 0; in < 4; ++in) vv[in] = pack4(acc2[nh][in][im] * sc);
                        store_block16x64(wstrip, vv, (wn_ == 0 ? Kn : Vm) + (size_t)row0 * 512 + nt * 64, 512, lane_);
                    }
                }
            }
        }
    } else {
        const bf16_t* Wglu = WSP(bf16_t, OFF_WB + WB_GLU); bf16_t* Os = WSP(bf16_t, OFF_OS); const float* bg = p.in(I_BGLU) + l * 512;
        int mt, nt;
        for (int it = 0; dense_tile(it, 4, l + 1 < NL, bid, nb, mt, nt); ++it) {
            acc_t acc; acc_zero(acc);
            gemm_core(acc, [&](int r) { return (const bf16_t*)Os + (size_t)(mt * 256 + r) * 512; }, [&](int r) { return Wglu + (size_t)(nt * 128 + r) * 512; }, 512, lds);
            {   const int tid2 = opaque_tid(), lane2 = tid2 & 63, wid2 = tid2 >> 6, wm2 = wid2 >> 1, wn2 = wid2 & 1, fr2 = lane2 & 15, g2 = lane2 >> 4;
                char* wstrip = lds + 2 * G_BUF + wid2 * 2304;
#pragma unroll
                for (int im = 0; im < 4; ++im) {
                    const int row0 = mt * 256 + wm2 * 64 + 16 * im;
                    uint2 vv[4];
#pragma unroll
                    for (int in = 0; in < 4; ++in) {
                        const int n = nt * 128 + wn2 * 64 + 16 * in + 4 * g2; const f32x4 v = acc[in][im];
                        const uint2 yr = *(const uint2*)(Os + (size_t)(row0 + fr2) * 512 + n); const float4 b4 = *(const float4*)(bg + n);
                        vv[in].x = pack2(bflo(yr.x) * sigmoidf_(v[0] + b4.x), bfhi(yr.x) * sigmoidf_(v[1] + b4.y));
                        vv[in].y = pack2(bflo(yr.y) * sigmoidf_(v[2] + b4.z), bfhi(yr.y) * sigmoidf_(v[3] + b4.w));
                    }
                    store_block16x64(wstrip, vv, P + (size_t)row0 * PP + C_SSM + nt * 128 + wn2 * 64, PP, lane2);
                }
            }
        }
    }
}
__device__ __forceinline__ void st_ropeq(const KP& p, int bid, int nb, char* lds) {
    const int tidx = opaque_tid();
    {   const int lane = tidx & 63, wid = tidx >> 6;
        const bf16_t* Kn = WSP(bf16_t, OFF_KN); const bf16_t* P = WSP(bf16_t, OFF_P);
        float runmax = 0.f;
        const int rs = nb * NWV;
        for (int r0 = bid * NWV + wid; r0 < T; r0 += 4 * rs) {
            uint4 kv[4], rv[4];
#pragma unroll
            for (int j = 0; j < 4; ++j) { const int r = r0 + j * rs; kv[j] = make_uint4(0, 0, 0, 0); rv[j] = make_uint4(0, 0, 0, 0);
                if (r < T) { kv[j] = *(const uint4*)(Kn + (size_t)r * 512 + lane * 8); if (lane < 4) rv[j] = *(const uint4*)(P + (size_t)r * PP + C_KR + lane * 8); } }
#pragma unroll
            for (int j = 0; j < 4; ++j) {
                const uint4 k4 = kv[j], r4 = rv[j];
                float s = bflo(k4.x) * bflo(k4.x) + bfhi(k4.x) * bfhi(k4.x) + bflo(k4.y) * bflo(k4.y) + bfhi(k4.y) * bfhi(k4.y)
                        + bflo(k4.z) * bflo(k4.z) + bfhi(k4.z) * bfhi(k4.z) + bflo(k4.w) * bflo(k4.w) + bfhi(k4.w) * bfhi(k4.w);
                s += __shfl_xor(s, 1); s += __shfl_xor(s, 2); s += __shfl_xor(s, 4);
                float sr = bflo(r4.x) * bflo(r4.x) + bfhi(r4.x) * bfhi(r4.x) + bflo(r4.y) * bflo(r4.y) + bfhi(r4.y) * bfhi(r4.y)
                         + bflo(r4.z) * bflo(r4.z) + bfhi(r4.z) * bfhi(r4.z) + bflo(r4.w) * bflo(r4.w) + bfhi(r4.w) * bfhi(r4.w);
                sr += __shfl_xor(sr, 1); sr += __shfl_xor(sr, 2);
                sr = __shfl(sr, 0);
                runmax = fmaxf(runmax, s + sr);
            }
        }
        unsigned* lmax = (unsigned*)lds;
        __syncthreads();
        if (tidx < 8) lmax[tidx] = 0u;
        __syncthreads();
        if ((lane & 7) == 0) atomicMax(&lmax[lane >> 3], __float_as_uint(runmax));
        __syncthreads();
        if (tidx < 8) atomicMax(WSP(unsigned, OFF_CNT) + 32 + tidx, lmax[tidx]);
    }
}

typedef short s16x4 __attribute__((ext_vector_type(4)));
typedef short v4i16_t __attribute__((ext_vector_type(4)));
typedef __attribute__((address_space(3))) const char* lds_cptr;
__device__ __forceinline__ s16x4 vtr(lds_cptr q) { return __builtin_bit_cast(s16x4, __builtin_amdgcn_ds_read_tr16_b64_v4i16((__attribute__((address_space(3))) v4i16_t*)q)); }
__device__ __forceinline__ unsigned cvtpk(float lo, float hi) { return pack2(lo, hi); }
constexpr int AT_K = 0, AT_V = 8192, AT_KR = 16384, AT_BUF = 20480;

template <int DQK, int VAR = 0>
__device__ __forceinline__ void attn_item(const bf16_t* Q, int qpitch, const bf16_t* KA, int kapitch, const bf16_t* KB, int kbpitch,
                                          const bf16_t* V, int vpitch, int ntiles, float C, bf16_t* O, char* lds) {
    const int tid = opaque_tid(), lane = tid & 63, wid = tid >> 6, r32 = lane & 31, hi = lane >> 5;
    constexpr int ND0 = DQK / 16;
    bf16x8 qr[ND0];
    { const bf16_t* qp = Q + (size_t)(wid * 32 + r32) * qpitch + hi * 8;
#pragma unroll
      for (int d0 = 0; d0 < ND0; ++d0) qr[d0] = *(const bf16x8*)(qp + d0 * 16); }
    const int srow = tid >> 3, sch = tid & 7;
    const bf16_t* gk = KA + (size_t)srow * kapitch + sch * 8;
    const bf16_t* gv = V + (size_t)srow * vpitch + sch * 8;
    const bf16_t* gr = (DQK > 64) ? (KB + (size_t)(tid >> 2) * kbpitch + (tid & 3) * 8) : nullptr;
    const int sk_off = AT_K + srow * 128 + ((sch ^ ((srow >> 1) & 7)) << 4);
    const int sv_off = AT_V + (sch >> 2) * 4096 + srow * 64 + (sch & 3) * 16;
    const int sr_off = AT_KR + (tid >> 2) * 64 + (((tid & 3) ^ (((tid >> 2) >> 2) & 3)) << 4);
    const bool do_r = (DQK > 64) && (tid < 256);
    const int kf_off = AT_K + r32 * 128, ksw = (r32 >> 1) & 7;
    const int rf_off = AT_KR + r32 * 64, rsw = (r32 >> 2) & 3;
    const int vf_off = AT_V + (4 * hi + ((lane & 15) >> 2)) * 64 + ((lane >> 4) & 1) * 32 + (lane & 3) * 8;
    uint4 rk, rv, rr; rr = make_uint4(0, 0, 0, 0);
    rk = *(const uint4*)gk; rv = *(const uint4*)gv; if (do_r) rr = *(const uint4*)gr;
    *(uint4*)(lds + sk_off) = rk; *(uint4*)(lds + sv_off) = rv; if (do_r) *(uint4*)(lds + sr_off) = rr;
    __syncthreads();
    f32x16 o0, o1;
#pragma unroll
    for (int r = 0; r < 16; ++r) { o0[r] = 0.f; o1[r] = 0.f; }
    float mrun = -INFINITY, lrun = 0.f;
    for (int t = 0; t < ntiles; ++t) {
        const char* cur = lds + (VAR == 2 ? 0 : (t & 1)) * AT_BUF; char* nxt = lds + ((t + 1) & 1) * AT_BUF;
        const bool more = (t + 1 < ntiles);
        if (more && VAR != 2) { rk = *(const uint4*)(gk + (size_t)(t + 1) * 64 * kapitch); rv = *(const uint4*)(gv + (size_t)(t + 1) * 64 * vpitch); if (do_r) rr = *(const uint4*)(gr + (size_t)(t + 1) * 64 * kbpitch); }
        f32x16 p0, p1;
#pragma unroll
        for (int r = 0; r < 16; ++r) { p0[r] = 0.f; p1[r] = 0.f; }
#pragma unroll
        for (int d0 = 0; d0 < 4; ++d0) {
            const int co = ((2 * d0 + hi) ^ ksw) << 4;
            const bf16x8 k0 = *(const bf16x8*)(cur + kf_off + co), k1 = *(const bf16x8*)(cur + kf_off + 32 * 128 + co);
            p0 = MFMA32(k0, qr[d0], p0); p1 = MFMA32(k1, qr[d0], p1);
        }
        if (DQK > 64) {
#pragma unroll
            for (int d0 = 4; d0 < ND0; ++d0) {
                const int co = ((2 * (d0 - 4) + hi) ^ rsw) << 4;
                const bf16x8 k0 = *(const bf16x8*)(cur + rf_off + co), k1 = *(const bf16x8*)(cur + rf_off + 32 * 64 + co);
                p0 = MFMA32(k0, qr[d0], p0); p1 = MFMA32(k1, qr[d0], p1);
            }
        }
        if (VAR != 1) {
        float mx = fmaxf(p0[0], p1[0]);
#pragma unroll
        for (int r = 1; r < 16; ++r) mx = fmaxf(mx, fmaxf(p0[r], p1[r]));
        mx = xhalf_max(mx) * C;
        const float mnew = fmaxf(mrun, mx);
        if (__any(mnew > mrun)) {
            const float alpha = __builtin_amdgcn_exp2f(mrun - mnew);
            lrun *= alpha;
#pragma unroll
            for (int r = 0; r < 16; ++r) { o0[r] *= alpha; o1[r] *= alpha; }
            mrun = mnew;
        }
        const float nm = -mrun;
        float ls = 0.f;
#pragma unroll
        for (int r = 0; r < 16; ++r) { p0[r] = __builtin_amdgcn_exp2f(fmaf(p0[r], C, nm)); p1[r] = __builtin_amdgcn_exp2f(fmaf(p1[r], C, nm)); ls += p0[r] + p1[r]; }
        lrun += ls;
        }
#pragma unroll
        for (int s = 0; s < 4; ++s) {
            bf16x8 pf;
            {   unsigned w0, w1, w2, w3;
                if (s < 2) { w0 = cvtpk(p0[8 * s], p0[8 * s + 1]); w1 = cvtpk(p0[8 * s + 2], p0[8 * s + 3]); w2 = cvtpk(p0[8 * s + 4], p0[8 * s + 5]); w3 = cvtpk(p0[8 * s + 6], p0[8 * s + 7]); }
                else { const int s2 = s - 2; w0 = cvtpk(p1[8 * s2], p1[8 * s2 + 1]); w1 = cvtpk(p1[8 * s2 + 2], p1[8 * s2 + 3]); w2 = cvtpk(p1[8 * s2 + 4], p1[8 * s2 + 5]); w3 = cvtpk(p1[8 * s2 + 6], p1[8 * s2 + 7]); }
                uint4 u = make_uint4(w0, w1, w2, w3); pf = __builtin_bit_cast(bf16x8, u); }
            const lds_cptr vb = (lds_cptr)cur + vf_off + s * 1024;
            const s16x4 a0 = vtr(vb), a1 = vtr(vb + 512), b0 = vtr(vb + 4096), b1 = vtr(vb + 4096 + 512);
            const bf16x8 v0 = (bf16x8){a0[0], a0[1], a0[2], a0[3], a1[0], a1[1], a1[2], a1[3]};
            const bf16x8 v1 = (bf16x8){b0[0], b0[1], b0[2], b0[3], b1[0], b1[1], b1[2], b1[3]};
            o0 = MFMA32(v0, pf, o0); o1 = MFMA32(v1, pf, o1);
        }
        if (VAR != 2) { if (more) { *(uint4*)(nxt + sk_off) = rk; *(uint4*)(nxt + sv_off) = rv; if (do_r) *(uint4*)(nxt + sr_off) = rr; }
        __syncthreads(); }
    }
    const float inv = 1.0f / xhalf_sum(lrun);
    bf16_t* op = O + (size_t)(wid * 32 + r32) * 512 + 4 * hi;
#pragma unroll
    for (int rg = 0; rg < 4; ++rg) {
        uint2 a; a.x = pack2(o0[4 * rg] * inv, o0[4 * rg + 1] * inv); a.y = pack2(o0[4 * rg + 2] * inv, o0[4 * rg + 3] * inv);
        uint2 b; b.x = pack2(o1[4 * rg] * inv, o1[4 * rg + 1] * inv); b.y = pack2(o1[4 * rg + 2] * inv, o1[4 * rg + 3] * inv);
        *(uint2*)(op + 8 * rg) = a; *(uint2*)(op + 32 + 8 * rg) = b;
    }
}
#define SBAR() __builtin_amdgcn_sched_barrier(0)
#define PINV(x) asm volatile("" : "+v"(x))
constexpr float ATT_THR = 6.0f;
template <int DQK>
__device__ __forceinline__ void attn_item2(const bf16_t* Q, int qpitch, const bf16_t* KA, int kapitch, const bf16_t* KB, int kbpitch,
                                           const bf16_t* V, int vpitch, int ntiles, bf16_t* O, char* lds) {
    const int tid = opaque_tid(), lane = tid & 63, wid = tid >> 6, r32 = lane & 31, hi = lane >> 5;
    const int wu = __builtin_amdgcn_readfirstlane(wid);
    constexpr int ND0 = DQK / 16, NQK = 2 * ND0;
    constexpr bool ROPE = DQK > 64;
    const int krow = 8 * wu + (lane >> 3);
    const bf16_t* gk = KA + (size_t)krow * kapitch + (((lane & 7) ^ ((krow >> 1) & 7)) << 3);
    const bf16_t* gv = V + (size_t)(16 * (wu & 3) + (lane >> 2)) * vpitch + (wu >> 2) * 32 + (lane & 3) * 8;
    const int rrow = 16 * (wu & 3) + (lane >> 2);
    const bf16_t* gr = ROPE ? (KB + (size_t)rrow * kbpitch + (((lane & 3) ^ ((rrow >> 2) & 3)) << 3)) : nullptr;
    char* dk = lds + AT_K + wu * 1024; char* dv = lds + AT_V + wu * 1024; char* dr = lds + AT_KR + (wu & 3) * 1024;
    auto issue = [&](int t, int slot) {
        GLDS16(gk + (size_t)t * 64 * kapitch, dk + slot * AT_BUF); GLDS16(gv + (size_t)t * 64 * vpitch, dv + slot * AT_BUF);
        if (ROPE) GLDS16(gr + (size_t)t * 64 * kbpitch, dr + slot * AT_BUF);
    };
    asm volatile("s_waitcnt vmcnt(0)" ::: "memory");
    issue(0, 0);
    if (ntiles > 1) issue(1, 1);
    bf16x8 qr[ND0];
    { const bf16_t* qp = Q + (size_t)(wid * 32 + r32) * qpitch + hi * 8;
#pragma unroll
      for (int d0 = 0; d0 < ND0; ++d0) qr[d0] = *(const bf16x8*)(qp + d0 * 16); }
    const int kf_off = AT_K + r32 * 128, ksw = (r32 >> 1) & 7;
    const int rf_off = AT_KR + r32 * 64, rsw = (r32 >> 2) & 3;
    const int vf_off = AT_V + (4 * hi + ((lane & 15) >> 2)) * 64 + ((lane >> 4) & 1) * 32 + (lane & 3) * 8;
    auto kfrag = [&](const char* slot, int g) -> bf16x8 {
        const int d0 = g >> 1, n = g & 1;
        if (d0 < 4) return *(const bf16x8*)(slot + kf_off + n * 32 * 128 + (((2 * d0 + hi) ^ ksw) << 4));
        return *(const bf16x8*)(slot + rf_off + n * 32 * 64 + (((2 * (d0 - 4) + hi) ^ rsw) << 4));
    };
    auto vfrag = [&](const char* slot, int g) -> bf16x8 {
        const lds_cptr vb = (lds_cptr)slot + vf_off + (g >> 1) * 1024 + (g & 1) * 4096;
        const s16x4 a0 = vtr(vb), a1 = vtr(vb + 512);
        return (bf16x8){a0[0], a0[1], a0[2], a0[3], a1[0], a1[1], a1[2], a1[3]};
    };
    f32x16 o0, o1, sA0, sA1, sB0, sB1;
    const f32x16 zero16 = {0.f, 0.f, 0.f, 0.f, 0.f, 0.f, 0.f, 0.f, 0.f, 0.f, 0.f, 0.f, 0.f, 0.f, 0.f, 0.f};
#pragma unroll
    for (int r = 0; r < 16; ++r) { o0[r] = 0.f; o1[r] = 0.f; }
    float mref, lrun = 0.f;
    if (ntiles > 1) asm volatile("s_waitcnt vmcnt(%0)" :: "n"(ROPE ? 3 : 2) : "memory"); else asm volatile("s_waitcnt vmcnt(0)" ::: "memory");
    __builtin_amdgcn_s_barrier();
    {
#pragma unroll
        for (int g = 0; g < NQK; ++g) { const bf16x8 kf = kfrag(lds, g);
            if (g & 1) sA1 = MFMA32(kf, qr[g >> 1], g < 2 ? zero16 : sA1); else sA0 = MFMA32(kf, qr[g >> 1], g < 2 ? zero16 : sA0); }
        float mx = fmaxf(sA0[0], sA1[0]);
#pragma unroll
        for (int r = 1; r < 16; ++r) mx = fmaxf(mx, fmaxf(sA0[r], sA1[r]));
        mref = xhalf_max(mx);
    }
    asm volatile("s_waitcnt vmcnt(0) lgkmcnt(0)" ::: "memory");
    __builtin_amdgcn_s_barrier();
    auto step = [&](auto HN, f32x16& c0, f32x16& c1, f32x16& n0, f32x16& n1, int t) __attribute__((always_inline)) {
        const int sl = t % 3, sl1 = (t + 1) % 3, sl2 = (t + 2) % 3;
        const char* cs = lds + sl * AT_BUF; const char* ns = lds + sl1 * AT_BUF;
        constexpr bool has_next = decltype(HN)::value;
        if (t + 2 < ntiles) issue(t + 2, sl2);
        u32x4 pw[4];
        float ls = 0.f;
        bf16x8 kf;
        if (has_next) kf = kfrag(ns, 0);
        SBAR();
#pragma unroll
        for (int g = 0; g < (NQK > 8 ? NQK : 8); ++g) {
            bf16x8 kcur = kf;
            if (has_next && g + 1 < NQK) kf = kfrag(ns, g + 1);
            SBAR();
            if (g < 8) {
                float e0, e1, e2, e3;
                if (g < 4) { e0 = __builtin_amdgcn_exp2f(c0[4 * g] - mref); e1 = __builtin_amdgcn_exp2f(c0[4 * g + 1] - mref); e2 = __builtin_amdgcn_exp2f(c0[4 * g + 2] - mref); e3 = __builtin_amdgcn_exp2f(c0[4 * g + 3] - mref); }
                else { e0 = __builtin_amdgcn_exp2f(c1[4 * (g - 4)] - mref); e1 = __builtin_amdgcn_exp2f(c1[4 * (g - 4) + 1] - mref); e2 = __builtin_amdgcn_exp2f(c1[4 * (g - 4) + 2] - mref); e3 = __builtin_amdgcn_exp2f(c1[4 * (g - 4) + 3] - mref); }
                ls += (e0 + e1) + (e2 + e3);
                const unsigned w0 = cvtpk(e0, e1), w1 = cvtpk(e2, e3);
                if ((g & 1) == 0) { pw[g >> 1][0] = w0; pw[g >> 1][1] = w1; } else { pw[g >> 1][2] = w0; pw[g >> 1][3] = w1; }
                PINV(ls); PINV(pw[g >> 1]);
            }
            SBAR();
            if (has_next && g < NQK) { if (g & 1) n1 = MFMA32(kcur, qr[g >> 1], g < 2 ? zero16 : n1); else n0 = MFMA32(kcur, qr[g >> 1], g < 2 ? zero16 : n0); }
            SBAR();
        }
        lrun += ls;
        float mx = -INFINITY;
        bf16x8 vf = vfrag(cs, 0);
        SBAR();
#pragma unroll
        for (int g = 0; g < 8; ++g) {
            const bf16x8 vcur = vf;
            if (g + 1 < 8) vf = vfrag(cs, g + 1);
            SBAR();
            if (has_next) {
                if (g < 4) mx = fmaxf(fmaxf(mx, fmaxf(n0[4 * g], n0[4 * g + 1])), fmaxf(n0[4 * g + 2], n0[4 * g + 3]));
                else mx = fmaxf(fmaxf(mx, fmaxf(n1[4 * (g - 4)], n1[4 * (g - 4) + 1])), fmaxf(n1[4 * (g - 4) + 2], n1[4 * (g - 4) + 3]));
                PINV(mx);
            }
            SBAR();
            const bf16x8 pf = __builtin_bit_cast(bf16x8, pw[g >> 1]);
            if (g & 1) o1 = MFMA32(vcur, pf, o1); else o0 = MFMA32(vcur, pf, o0);
            SBAR();
        }
        if (has_next) {
            const float gr_ = xhalf_max(mx) - mref;
            if (__any(gr_ > ATT_THR)) {
                const float d = fmaxf(gr_, 0.f), a = __builtin_amdgcn_exp2f(-d);
                mref += d; lrun *= a;
#pragma unroll
                for (int r = 0; r < 16; ++r) { o0[r] *= a; o1[r] *= a; }
            }
        }
        asm volatile("s_waitcnt vmcnt(0) lgkmcnt(0)" ::: "memory");
        __builtin_amdgcn_s_barrier();
    };
    {   const std::integral_constant<bool, true> yes; const std::integral_constant<bool, false> no;
        int t = 0;
        for (; t + 2 < ntiles; t += 2) { step(yes, sA0, sA1, sB0, sB1, t); step(yes, sB0, sB1, sA0, sA1, t + 1); }
        step(yes, sA0, sA1, sB0, sB1, t); step(no, sB0, sB1, sA0, sA1, t + 1); }
    const float inv = 1.0f / xhalf_sum(lrun);
    bf16_t* op = O + (size_t)(wid * 32 + r32) * 512 + 4 * hi;
#pragma unroll
    for (int rg = 0; rg < 4; ++rg) {
        uint2 a; a.x = pack2(o0[4 * rg] * inv, o0[4 * rg + 1] * inv); a.y = pack2(o0[4 * rg + 2] * inv, o0[4 * rg + 3] * inv);
        uint2 b; b.x = pack2(o1[4 * rg] * inv, o1[4 * rg + 1] * inv); b.y = pack2(o1[4 * rg + 2] * inv, o1[4 * rg + 3] * inv);
        *(uint2*)(op + 8 * rg) = a; *(uint2*)(op + 32 + 8 * rg) = b;
    }
}
constexpr int A3_K = 0, A3_KR = 16384, A3_V = 24576, A3_BYTES = 24576 + 3 * 8192;
template <int DQK>
__device__ __forceinline__ void attn_item3(const bf16_t* Q, int qpitch, const bf16_t* KA, int kapitch, const bf16_t* KB, int kbpitch,
                                           const bf16_t* V, int vpitch, int ntiles, bf16_t* O, char* lds) {
    const int tid = opaque_tid(), lane = tid & 63, wid = tid >> 6, r32 = lane & 31, hi = lane >> 5;
    const bool grpB = __builtin_amdgcn_readfirstlane(wid) >= 4;
    constexpr int ND0 = DQK / 16;
    bf16x8 qr[ND0];
    { const bf16_t* qp = Q + (size_t)(wid * 32 + r32) * qpitch + hi * 8;
#pragma unroll
      for (int d0 = 0; d0 < ND0; ++d0) qr[d0] = *(const bf16x8*)(qp + d0 * 16); }
    const int srow = tid >> 3, sch = tid & 7;
    const bf16_t* gk = KA + (size_t)srow * kapitch + sch * 8;
    const bf16_t* gv = V + (size_t)srow * vpitch + sch * 8;
    const bf16_t* gr = (DQK > 64) ? (KB + (size_t)(tid >> 2) * kbpitch + (tid & 3) * 8) : nullptr;
    const int sk_off = A3_K + srow * 128 + ((sch ^ ((srow >> 1) & 7)) << 4);
    const int sv_off = A3_V + (sch >> 2) * 4096 + srow * 64 + (sch & 3) * 16;
    const int sr_off = A3_KR + (tid >> 2) * 64 + (((tid & 3) ^ (((tid >> 2) >> 2) & 3)) << 4);
    const bool do_r = (DQK > 64) && (tid < 256);
    const int kf_off = A3_K + r32 * 128, ksw = (r32 >> 1) & 7;
    const int rf_off = A3_KR + r32 * 64, rsw = (r32 >> 2) & 3;
    const int vf_off = A3_V + (4 * hi + ((lane & 15) >> 2)) * 64 + ((lane >> 4) & 1) * 32 + (lane & 3) * 8;
    uint4 rk, rv, rr; rr = make_uint4(0, 0, 0, 0);
    rk = *(const uint4*)gk; rv = *(const uint4*)gv; if (do_r) rr = *(const uint4*)gr;
    *(uint4*)(lds + sk_off) = rk; *(uint4*)(lds + sv_off) = rv; if (do_r) *(uint4*)(lds + sr_off) = rr;
    __syncthreads();
    f32x16 o0, o1, p0, p1;
#pragma unroll
    for (int r = 0; r < 16; ++r) { o0[r] = 0.f; o1[r] = 0.f; p0[r] = 0.f; p1[r] = 0.f; }
    float mrun = -INFINITY, lrun = 0.f;
    auto H1 = [&](int t) __attribute__((always_inline)) {
        const char* ks = lds + (t & 1) * 8192; const char* rs = lds + (t & 1) * 4096;
#pragma unroll
        for (int r = 0; r < 16; ++r) { p0[r] = 0.f; p1[r] = 0.f; }
#pragma unroll
        for (int d0 = 0; d0 < 4; ++d0) {
            const int co = ((2 * d0 + hi) ^ ksw) << 4;
            const bf16x8 k0 = *(const bf16x8*)(ks + kf_off + co), k1 = *(const bf16x8*)(ks + kf_off + 32 * 128 + co);
            p0 = MFMA32(k0, qr[d0], p0); p1 = MFMA32(k1, qr[d0], p1);
        }
        if (DQK > 64) {
#pragma unroll
            for (int d0 = 4; d0 < ND0; ++d0) {
                const int co = ((2 * (d0 - 4) + hi) ^ rsw) << 4;
                const bf16x8 k0 = *(const bf16x8*)(rs + rf_off + co), k1 = *(const bf16x8*)(rs + rf_off + 32 * 64 + co);
                p0 = MFMA32(k0, qr[d0], p0); p1 = MFMA32(k1, qr[d0], p1);
            }
        }
        float mx = fmaxf(p0[0], p1[0]);
#pragma unroll
        for (int r = 1; r < 16; ++r) mx = fmaxf(mx, fmaxf(p0[r], p1[r]));
        mx = xhalf_max(mx);
        if (__any(mx > mrun + ATT_THR)) {
            const float mnew = fmaxf(mrun, mx), alpha = __builtin_amdgcn_exp2f(mrun - mnew);
            lrun *= alpha;
#pragma unroll
            for (int r = 0; r < 16; ++r) { o0[r] *= alpha; o1[r] *= alpha; }
            mrun = mnew;
        }
    };
    auto H2 = [&](int t) __attribute__((always_inline)) {
        const char* vs = lds + (t % 3) * 8192;
        float ls = 0.f;
#pragma unroll
        for (int r = 0; r < 16; ++r) { p0[r] = __builtin_amdgcn_exp2f(p0[r] - mrun); p1[r] = __builtin_amdgcn_exp2f(p1[r] - mrun); ls += p0[r] + p1[r]; }
        lrun += ls;
#pragma unroll
        for (int s = 0; s < 4; ++s) {
            bf16x8 pf;
            {   unsigned w0, w1, w2, w3;
                if (s < 2) { w0 = cvtpk(p0[8 * s], p0[8 * s + 1]); w1 = cvtpk(p0[8 * s + 2], p0[8 * s + 3]); w2 = cvtpk(p0[8 * s + 4], p0[8 * s + 5]); w3 = cvtpk(p0[8 * s + 6], p0[8 * s + 7]); }
                else { const int s2 = s - 2; w0 = cvtpk(p1[8 * s2], p1[8 * s2 + 1]); w1 = cvtpk(p1[8 * s2 + 2], p1[8 * s2 + 3]); w2 = cvtpk(p1[8 * s2 + 4], p1[8 * s2 + 5]); w3 = cvtpk(p1[8 * s2 + 6], p1[8 * s2 + 7]); }
                u32x4 u = {w0, w1, w2, w3}; pf = __builtin_bit_cast(bf16x8, u); }
            const lds_cptr vb = (lds_cptr)vs + vf_off + s * 1024;
            const s16x4 a0 = vtr(vb), a1 = vtr(vb + 512), b0 = vtr(vb + 4096), b1 = vtr(vb + 4096 + 512);
            const bf16x8 v0 = (bf16x8){a0[0], a0[1], a0[2], a0[3], a1[0], a1[1], a1[2], a1[3]};
            const bf16x8 v1 = (bf16x8){b0[0], b0[1], b0[2], b0[3], b1[0], b1[1], b1[2], b1[3]};
            o0 = MFMA32(v0, pf, o0); o1 = MFMA32(v1, pf, o1);
        }
    };
#define A3_LOAD(t) do { rk = *(const uint4*)(gk + (size_t)((t) + 1) * 64 * kapitch); rv = *(const uint4*)(gv + (size_t)((t) + 1) * 64 * vpitch); if (do_r) rr = *(const uint4*)(gr + (size_t)((t) + 1) * 64 * kbpitch); } while (0)
#define A3_WRITE(t) do { const int kn = ((t) + 1) & 1, vn = ((t) + 1) % 3; *(uint4*)(lds + kn * 8192 + sk_off) = rk; *(uint4*)(lds + vn * 8192 + sv_off) = rv; if (do_r) *(uint4*)(lds + kn * 4096 + sr_off) = rr; } while (0)
    if (grpB) {
        { const bool more = (1 < ntiles); if (more) A3_LOAD(0); H1(0); if (more) A3_WRITE(0); __syncthreads(); }
        for (int t = 1; t < ntiles; ++t) {
            const bool more = (t + 1 < ntiles);
            if (more) A3_LOAD(t);
            H2(t - 1); H1(t);
            if (more) A3_WRITE(t);
            __syncthreads();
        }
    } else {
        for (int t = 0; t < ntiles; ++t) {
            const bool more = (t + 1 < ntiles);
            if (more) A3_LOAD(t);
            H1(t); H2(t);
            if (more) A3_WRITE(t);
            __syncthreads();
        }
    }
#undef A3_LOAD
#undef A3_WRITE
    if (grpB) H2(ntiles - 1);
    const float inv = 1.0f / xhalf_sum(lrun);
    bf16_t* op = O + (size_t)(wid * 32 + r32) * 512 + 4 * hi;
#pragma unroll
    for (int rg = 0; rg < 4; ++rg) {
        uint2 a; a.x = pack2(o0[4 * rg] * inv, o0[4 * rg + 1] * inv); a.y = pack2(o0[4 * rg + 2] * inv, o0[4 * rg + 3] * inv);
        uint2 b; b.x = pack2(o1[4 * rg] * inv, o1[4 * rg + 1] * inv); b.y = pack2(o1[4 * rg + 2] * inv, o1[4 * rg + 3] * inv);
        *(uint2*)(op + 8 * rg) = a; *(uint2*)(op + 32 + 8 * rg) = b;
    }
    __syncthreads();
}
template <int DQK>
__device__ __forceinline__ void attn_item4(const bf16_t* Q, int qpitch, const bf16_t* KA, int kapitch, const bf16_t* KB, int kbpitch,
                                           const bf16_t* V, int vpitch, int ntiles, float ref_const, float kmax2, bf16_t* O, char* lds) {
    const int tid = opaque_tid(), lane = tid & 63, wid = tid >> 6, r32 = lane & 31, hi = lane >> 5;
    constexpr int ND0 = DQK / 16;
    bf16x8 qr[ND0];
    { const bf16_t* qp = Q + (size_t)(wid * 32 + r32) * qpitch + hi * 8;
#pragma unroll
      for (int d0 = 0; d0 < ND0; ++d0) qr[d0] = *(const bf16x8*)(qp + d0 * 16); }
    float mref = ref_const;
    if (DQK > 64) {
        float qn2 = 0.f;
#pragma unroll
        for (int d0 = 0; d0 < ND0; ++d0)
#pragma unroll
            for (int j = 0; j < 8; ++j) { const float v = bf2f((bf16_t)qr[d0][j]); qn2 = fmaf(v, v, qn2); }
        qn2 = xhalf_sum(qn2);
        mref = sqrtf(qn2 * kmax2) * 1.01f + 0.01f;
    }
    f32x16 negm;
#pragma unroll
    for (int r = 0; r < 16; ++r) negm[r] = -mref;
    const int srow = tid >> 3, sch = tid & 7;
    const bf16_t* gk = KA + (size_t)srow * kapitch + sch * 8;
    const bf16_t* gv = V + (size_t)srow * vpitch + sch * 8;
    const bf16_t* gr = (DQK > 64) ? (KB + (size_t)(tid >> 2) * kbpitch + (tid & 3) * 8) : nullptr;
    const int sk_off = AT_K + srow * 128 + ((sch ^ ((srow >> 1) & 7)) << 4);
    const int sv_off = AT_V + (sch >> 2) * 4096 + srow * 64 + (sch & 3) * 16;
    const int sr_off = AT_KR + (tid >> 2) * 64 + (((tid & 3) ^ (((tid >> 2) >> 2) & 3)) << 4);
    const bool do_r = (DQK > 64) && (tid < 256);
    const int kf_off = AT_K + r32 * 128, ksw = (r32 >> 1) & 7;
    const int rf_off = AT_KR + r32 * 64, rsw = (r32 >> 2) & 3;
    const int vf_off = AT_V + (4 * hi + ((lane & 15) >> 2)) * 64 + ((lane >> 4) & 1) * 32 + (lane & 3) * 8;
    uint4 rk, rv, rr; rr = make_uint4(0, 0, 0, 0);
    rk = *(const uint4*)gk; rv = *(const uint4*)gv; if (do_r) rr = *(const uint4*)gr;
    *(uint4*)(lds + sk_off) = rk; *(uint4*)(lds + sv_off) = rv; if (do_r) *(uint4*)(lds + sr_off) = rr;
    __syncthreads();
    f32x16 o0, o1;
#pragma unroll
    for (int r = 0; r < 16; ++r) { o0[r] = 0.f; o1[r] = 0.f; }
    float lrun = 0.f;
#pragma unroll 1
    for (int t = 0; t < ntiles; ++t) {
        const char* cur = lds + (t & 1) * AT_BUF; char* nxt = lds + ((t + 1) & 1) * AT_BUF;
        const bool more = (t + 1 < ntiles);
        if (more) { rk = *(const uint4*)(gk + (size_t)(t + 1) * 64 * kapitch); rv = *(const uint4*)(gv + (size_t)(t + 1) * 64 * vpitch); if (do_r) rr = *(const uint4*)(gr + (size_t)(t + 1) * 64 * kbpitch); }
        bf16x8 kf[8];
#pragma unroll
        for (int d0 = 0; d0 < 4; ++d0) { const int co = ((2 * d0 + hi) ^ ksw) << 4; kf[2 * d0] = *(const bf16x8*)(cur + kf_off + co); kf[2 * d0 + 1] = *(const bf16x8*)(cur + kf_off + 32 * 128 + co); }
        f32x16 p0, p1;
        p0 = MFMA32(kf[0], qr[0], negm); p1 = MFMA32(kf[1], qr[0], negm);
        p0 = MFMA32(kf[2], qr[1], p0); p1 = MFMA32(kf[3], qr[1], p1);
        if (DQK > 64) {
            __builtin_amdgcn_sched_barrier(0);
#pragma unroll
            for (int d0 = 4; d0 < ND0; ++d0) { const int co = ((2 * (d0 - 4) + hi) ^ rsw) << 4; kf[2 * (d0 - 4)] = *(const bf16x8*)(cur + rf_off + co); kf[2 * (d0 - 4) + 1] = *(const bf16x8*)(cur + rf_off + 32 * 64 + co); }
        }
        p0 = MFMA32(kf[4], qr[2], p0); p1 = MFMA32(kf[5], qr[2], p1);
        p0 = MFMA32(kf[6], qr[3], p0); p1 = MFMA32(kf[7], qr[3], p1);
        if (DQK > 64) {
#pragma unroll
            for (int d0 = 4; d0 < ND0; ++d0) { p0 = MFMA32(kf[2 * (d0 - 4)], qr[d0], p0); p1 = MFMA32(kf[2 * (d0 - 4) + 1], qr[d0], p1); }
        }
        bf16x8 vf[8];
        auto vload = [&](int s) __attribute__((always_inline)) {
            const lds_cptr vb = (lds_cptr)cur + vf_off + s * 1024;
            const s16x4 a0 = vtr(vb), a1 = vtr(vb + 512), b0 = vtr(vb + 4096), b1 = vtr(vb + 4096 + 512);
            vf[2 * s] = (bf16x8){a0[0], a0[1], a0[2], a0[3], a1[0], a1[1], a1[2], a1[3]};
            vf[2 * s + 1] = (bf16x8){b0[0], b0[1], b0[2], b0[3], b1[0], b1[1], b1[2], b1[3]};
        };
        vload(0); vload(1);
        float ls = 0.f;
#pragma unroll
        for (int s = 0; s < 4; ++s) {
            float e[8];
#pragma unroll
            for (int j = 0; j < 8; ++j) e[j] = __builtin_amdgcn_exp2f(s < 2 ? p0[8 * s + j] : p1[8 * (s - 2) + j]);
            ls += ((e[0] + e[1]) + (e[2] + e[3])) + ((e[4] + e[5]) + (e[6] + e[7]));
            u32x4 u = {cvtpk(e[0], e[1]), cvtpk(e[2], e[3]), cvtpk(e[4], e[5]), cvtpk(e[6], e[7])};
            const bf16x8 pf = __builtin_bit_cast(bf16x8, u);
            if (s + 2 < 4) vload(s + 2);
            o0 = MFMA32(vf[2 * s], pf, o0); o1 = MFMA32(vf[2 * s + 1], pf, o1);
        }
        lrun += ls;
        if (more) { *(uint4*)(nxt + sk_off) = rk; *(uint4*)(nxt + sv_off) = rv; if (do_r) *(uint4*)(nxt + sr_off) = rr; }
        __syncthreads();
    }
    const float inv = 1.0f / xhalf_sum(lrun);
    bf16_t* op = O + (size_t)(wid * 32 + r32) * 512 + 4 * hi;
#pragma unroll
    for (int rg = 0; rg < 4; ++rg) {
        uint2 a; a.x = pack2(o0[4 * rg] * inv, o0[4 * rg + 1] * inv); a.y = pack2(o0[4 * rg + 2] * inv, o0[4 * rg + 3] * inv);
        uint2 b; b.x = pack2(o1[4 * rg] * inv, o1[4 * rg + 1] * inv); b.y = pack2(o1[4 * rg + 2] * inv, o1[4 * rg + 3] * inv);
        *(uint2*)(op + 8 * rg) = a; *(uint2*)(op + 32 + 8 * rg) = b;
    }
}
constexpr int A7_K = 0, A7_V = 8192, A7_KR = 16384, A7_BUF = 20480;
template <int DQK>
__device__ __forceinline__ void attn_item7(const bf16_t* Q, int qpitch, const bf16_t* KA, int kapitch, const bf16_t* KB, int kbpitch,
                                           const bf16_t* V, int vpitch, int ntiles, float ref_const, float kmax2, bf16_t* O, char* lds) {
    const int tid = opaque_tid(), lane = tid & 63, wid = tid >> 6, fr = lane & 15, g = lane >> 4;
    constexpr int NKS = DQK / 32;
    bf16x8 qr[2][NKS];
#pragma unroll
    for (int qi = 0; qi < 2; ++qi) { const bf16_t* qp = Q + (size_t)(wid * 32 + 16 * qi + fr) * qpitch + 8 * g;
#pragma unroll
        for (int ks = 0; ks < NKS; ++ks) qr[qi][ks] = *(const bf16x8*)(qp + 32 * ks); }
    f32x4 negm[2];
#pragma unroll
    for (int qi = 0; qi < 2; ++qi) {
        float mref = ref_const;
        if (DQK > 64) {
            float qn2 = 0.f;
#pragma unroll
            for (int ks = 0; ks < NKS; ++ks)
#pragma unroll
                for (int j = 0; j < 8; ++j) { const float v = bf2f((bf16_t)qr[qi][ks][j]); qn2 = fmaf(v, v, qn2); }
            qn2 += __shfl_xor(qn2, 16); qn2 += __shfl_xor(qn2, 32);
            mref = sqrtf(qn2 * kmax2) * 1.01f + 0.01f;
        }
        negm[qi][0] = -mref; negm[qi][1] = -mref; negm[qi][2] = -mref; negm[qi][3] = -mref;
    }
    const int srow = tid >> 3, sch = tid & 7;
    const bf16_t* gk = KA + (size_t)srow * kapitch + sch * 8;
    const bf16_t* gv = V + (size_t)srow * vpitch + sch * 8;
    const bf16_t* gr = (DQK > 64) ? (KB + (size_t)(tid >> 2) * kbpitch + (tid & 3) * 8) : nullptr;
    const int sk_off = A7_K + srow * 128 + ((sch ^ ((srow >> 1) & 7)) << 4);
    const int sv_off = A7_V + (sch >> 1) * 2048 + srow * 32 + (sch & 1) * 16;
    const int sr_off = A7_KR + (tid >> 2) * 64 + ((((tid & 3) + 2 * ((tid >> 2) >> 2)) & 3) << 4);
    const bool do_r = (DQK > 64) && (tid < 256);
    const int kf_off = A7_K + fr * 128, ksw = (fr >> 1) & 7;
    const int rf_off = A7_KR + fr * 64 + (((g + 2 * (fr >> 2)) & 3) << 4);
    const int vf_off = A7_V + (4 * g + (fr >> 2)) * 32 + (fr & 3) * 8;
    uint4 rk, rv, rr; rr = make_uint4(0, 0, 0, 0);
    rk = *(const uint4*)gk; rv = *(const uint4*)gv; if (do_r) rr = *(const uint4*)gr;
    *(uint4*)(lds + sk_off) = rk; *(uint4*)(lds + sv_off) = rv; if (do_r) *(uint4*)(lds + sr_off) = rr;
    __syncthreads();
    f32x4 o[4][2]; float lsum[2] = {0.f, 0.f};
#pragma unroll
    for (int di = 0; di < 4; ++di)
#pragma unroll
        for (int qi = 0; qi < 2; ++qi) { o[di][qi][0] = 0.f; o[di][qi][1] = 0.f; o[di][qi][2] = 0.f; o[di][qi][3] = 0.f; }
#pragma unroll 1
    for (int t = 0; t < ntiles; ++t) {
        const char* cur = lds + (t & 1) * A7_BUF; char* nxt = lds + ((t + 1) & 1) * A7_BUF;
        const bool more = (t + 1 < ntiles);
        if (more) { rk = *(const uint4*)(gk + (size_t)(t + 1) * 64 * kapitch); rv = *(const uint4*)(gv + (size_t)(t + 1) * 64 * vpitch); if (do_r) rr = *(const uint4*)(gr + (size_t)(t + 1) * 64 * kbpitch); }
        f32x4 s[4][2];
#pragma unroll
        for (int ks = 0; ks < NKS; ++ks) {
            bf16x8 kf[4];
#pragma unroll
            for (int kj = 0; kj < 4; ++kj)
                kf[kj] = (ks < 2) ? *(const bf16x8*)(cur + kf_off + kj * 2048 + (((4 * ks + g) ^ ksw) << 4)) : *(const bf16x8*)(cur + rf_off + kj * 1024);
#pragma unroll
            for (int kj = 0; kj < 4; ++kj)
#pragma unroll
                for (int qi = 0; qi < 2; ++qi) s[kj][qi] = MFMA16(kf[kj], qr[qi][ks], ks == 0 ? negm[qi] : s[kj][qi]);
        }
#pragma unroll
        for (int kk = 0; kk < 2; ++kk) {
            bf16x8 vf[4];
#pragma unroll
            for (int di = 0; di < 4; ++di) {
                const lds_cptr vb = (lds_cptr)cur + vf_off + di * 2048 + kk * 1024;
                const s16x4 a0 = vtr(vb), a1 = vtr(vb + 512);
                vf[di] = (bf16x8){a0[0], a0[1], a0[2], a0[3], a1[0], a1[1], a1[2], a1[3]};
            }
            bf16x8 pf[2];
#pragma unroll
            for (int qi = 0; qi < 2; ++qi) {
                float e[8];
#pragma unroll
                for (int j = 0; j < 4; ++j) { e[j] = __builtin_amdgcn_exp2f(s[2 * kk][qi][j]); e[4 + j] = __builtin_amdgcn_exp2f(s[2 * kk + 1][qi][j]); }
                lsum[qi] += ((e[0] + e[1]) + (e[2] + e[3])) + ((e[4] + e[5]) + (e[6] + e[7]));
                u32x4 u = {cvtpk(e[0], e[1]), cvtpk(e[2], e[3]), cvtpk(e[4], e[5]), cvtpk(e[6], e[7])};
                pf[qi] = __builtin_bit_cast(bf16x8, u);
            }
#pragma unroll
            for (int di = 0; di < 4; ++di) { o[di][0] = MFMA16(vf[di], pf[0], o[di][0]); o[di][1] = MFMA16(vf[di], pf[1], o[di][1]); }
        }
        if (more) { *(uint4*)(nxt + sk_off) = rk; *(uint4*)(nxt + sv_off) = rv; if (do_r) *(uint4*)(nxt + sr_off) = rr; }
        __syncthreads();
    }
#pragma unroll
    for (int qi = 0; qi < 2; ++qi) {
        float l = lsum[qi]; l += __shfl_xor(l, 16); l += __shfl_xor(l, 32);
        const float inv = 1.0f / l;
        bf16_t* op = O + (size_t)(wid * 32 + 16 * qi + fr) * 512 + 4 * g;
#pragma unroll
        for (int di = 0; di < 4; ++di) *(uint2*)(op + 16 * di) = pack4(o[di][qi] * inv);
    }
}
constexpr int A8_K = 0, A8_V = 16384, A8_KR = 32768, A8_BUF = 40960;
template <int DQK>
__device__ __forceinline__ void attn_item8(const bf16_t* Q, int qpitch, const bf16_t* KA, int kapitch, const bf16_t* KB, int kbpitch,
                                           const bf16_t* V, int vpitch, int ntiles64, float ref_const, float kmax2, bf16_t* O, char* lds) {
    const int tid = opaque_tid(), lane = tid & 63, wid = tid >> 6, fr = lane & 15, g = lane >> 4;
    constexpr int NKS = DQK / 32;
    const int ntiles = ntiles64 >> 1;
    bf16x8 qr[2][NKS];
#pragma unroll
    for (int qi = 0; qi < 2; ++qi) { const bf16_t* qp = Q + (size_t)(wid * 32 + 16 * qi + fr) * qpitch + 8 * g;
#pragma unroll
        for (int ks = 0; ks < NKS; ++ks) qr[qi][ks] = *(const bf16x8*)(qp + 32 * ks); }
    f32x4 negm[2];
#pragma unroll
    for (int qi = 0; qi < 2; ++qi) {
        float mref = ref_const;
        if (DQK > 64) {
            float qn2 = 0.f;
#pragma unroll
            for (int ks = 0; ks < NKS; ++ks)
#pragma unroll
                for (int j = 0; j < 8; ++j) { const float v = bf2f((bf16_t)qr[qi][ks][j]); qn2 = fmaf(v, v, qn2); }
            qn2 += __shfl_xor(qn2, 16); qn2 += __shfl_xor(qn2, 32);
            mref = sqrtf(qn2 * kmax2) * 1.01f + 0.01f;
        }
        negm[qi][0] = -mref; negm[qi][1] = -mref; negm[qi][2] = -mref; negm[qi][3] = -mref;
    }
    const int srow = tid >> 3, sch = tid & 7, rrow = tid >> 2;
    const bf16_t* gk = KA + (size_t)srow * kapitch + sch * 8;
    const bf16_t* gv = V + (size_t)srow * vpitch + sch * 8;
    const bf16_t* gr = (DQK > 64) ? (KB + (size_t)rrow * kbpitch + (tid & 3) * 8) : nullptr;
    const int sk_off = A8_K + srow * 128 + ((sch ^ ((srow >> 1) & 7)) << 4);
    const int sv_off = A8_V + (sch >> 1) * 4096 + srow * 32 + (sch & 1) * 16;
    const int sr_off = A8_KR + rrow * 64 + ((((tid & 3) + 2 * (rrow >> 2)) & 3) << 4);
    const int kf_off = A8_K + fr * 128, ksw = (fr >> 1) & 7;
    const int rf_off = A8_KR + fr * 64 + (((g + 2 * (fr >> 2)) & 3) << 4);
    const int vf_off = A8_V + (4 * g + (fr >> 2)) * 32 + (fr & 3) * 8;
    uint4 rk0, rk1, rv0, rv1, rr; rr = make_uint4(0, 0, 0, 0);
#define A8_LOAD(t) do { const bf16_t* k_ = gk + (size_t)(t) * 128 * kapitch; const bf16_t* v_ = gv + (size_t)(t) * 128 * vpitch; \
        rk0 = *(const uint4*)k_; rk1 = *(const uint4*)(k_ + (size_t)64 * kapitch); rv0 = *(const uint4*)v_; rv1 = *(const uint4*)(v_ + (size_t)64 * vpitch); \
        if (DQK > 64) rr = *(const uint4*)(gr + (size_t)(t) * 128 * kbpitch); } while (0)
#define A8_WRITE(buf) do { char* d_ = lds + (buf) * A8_BUF; *(uint4*)(d_ + sk_off) = rk0; *(uint4*)(d_ + sk_off + 64 * 128) = rk1; *(uint4*)(d_ + sv_off) = rv0; *(uint4*)(d_ + sv_off + 64 * 32) = rv1; \
        if (DQK > 64) *(uint4*)(d_ + sr_off) = rr; } while (0)
    A8_LOAD(0); A8_WRITE(0);
    __syncthreads();
    f32x4 o[4][2]; float lsum[2] = {0.f, 0.f};
#pragma unroll
    for (int di = 0; di < 4; ++di)
#pragma unroll
        for (int qi = 0; qi < 2; ++qi) { o[di][qi][0] = 0.f; o[di][qi][1] = 0.f; o[di][qi][2] = 0.f; o[di][qi][3] = 0.f; }
#pragma unroll 1
    for (int t = 0; t < ntiles; ++t) {
        const char* cur = lds + (t & 1) * A8_BUF;
        const bool more = (t + 1 < ntiles);
        if (more) A8_LOAD(t + 1);
#pragma unroll
        for (int sub = 0; sub < 2; ++sub) {
            const char* ck = cur + sub * 64 * 128; const char* cr = cur + sub * 64 * 64; const char* cv = cur + sub * 64 * 32;
            f32x4 s[4][2];
#pragma unroll
            for (int ks = 0; ks < NKS; ++ks) {
                bf16x8 kf[4];
#pragma unroll
                for (int kj = 0; kj < 4; ++kj)
                    kf[kj] = (ks < 2) ? *(const bf16x8*)(ck + kf_off + kj * 2048 + (((4 * ks + g) ^ ksw) << 4)) : *(const bf16x8*)(cr + rf_off + kj * 1024);
#pragma unroll
                for (int kj = 0; kj < 4; ++kj)
#pragma unroll
                    for (int qi = 0; qi < 2; ++qi) s[kj][qi] = MFMA16(kf[kj], qr[qi][ks], ks == 0 ? negm[qi] : s[kj][qi]);
            }
#pragma unroll
            for (int kk = 0; kk < 2; ++kk) {
                bf16x8 vf[4];
#pragma unroll
                for (int di = 0; di < 4; ++di) {
                    const lds_cptr vb = (lds_cptr)cv + vf_off + di * 4096 + kk * 1024;
                    const s16x4 a0 = vtr(vb), a1 = vtr(vb + 512);
                    vf[di] = (bf16x8){a0[0], a0[1], a0[2], a0[3], a1[0], a1[1], a1[2], a1[3]};
                }
                bf16x8 pf[2];
#pragma unroll
                for (int qi = 0; qi < 2; ++qi) {
                    float e[8];
#pragma unroll
                    for (int j = 0; j < 4; ++j) { e[j] = __builtin_amdgcn_exp2f(s[2 * kk][qi][j]); e[4 + j] = __builtin_amdgcn_exp2f(s[2 * kk + 1][qi][j]); }
                    lsum[qi] += ((e[0] + e[1]) + (e[2] + e[3])) + ((e[4] + e[5]) + (e[6] + e[7]));
                    u32x4 u = {cvtpk(e[0], e[1]), cvtpk(e[2], e[3]), cvtpk(e[4], e[5]), cvtpk(e[6], e[7])};
                    pf[qi] = __builtin_bit_cast(bf16x8, u);
                }
#pragma unroll
                for (int di = 0; di < 4; ++di) { o[di][0] = MFMA16(vf[di], pf[0], o[di][0]); o[di][1] = MFMA16(vf[di], pf[1], o[di][1]); }
            }
        }
        if (more) A8_WRITE((t + 1) & 1);
        __syncthreads();
    }
#undef A8_LOAD
#undef A8_WRITE
#pragma unroll
    for (int qi = 0; qi < 2; ++qi) {
        float l = lsum[qi]; l += __shfl_xor(l, 16); l += __shfl_xor(l, 32);
        const float inv = 1.0f / l;
        uint2 vv[4];
#pragma unroll
        for (int di = 0; di < 4; ++di) vv[di] = pack4(o[di][qi] * inv);
        store_block16x64(lds + LDS_STRIP + wid * 2304, vv, O + (size_t)(wid * 32 + 16 * qi) * 512, 512, lane);
    }
}
__device__ __forceinline__ void attn_dispatch(const KP& p, int ty, int h, int qt, float gqa_ref, char* lds) {
    const bf16_t* P = WSP(bf16_t, OFF_P); const bf16_t* Qm = WSP(bf16_t, OFF_H); const bf16_t* Kn = WSP(bf16_t, OFF_KN); const bf16_t* Vm = WSP(bf16_t, OFF_V);
    const int ntiles = (qt == 0) ? (LC / 64) : (T / 64);
    const size_t r0 = (size_t)qt * 256;
    bf16_t* Om = WSP(bf16_t, OFF_OM); bf16_t* Og = WSP(bf16_t, OFF_OG);
    if (ty == 0) {
        const float kmax2 = __uint_as_float(WSP(unsigned, OFF_CNT)[32 + h]);
        attn_item8<96>(Qm + r0 * 768 + h * 96, 768, Kn + h * 64, 512, P + C_KR, PP, Vm + h * 64, 512, ntiles, 0.f, kmax2, Om + r0 * 512 + h * 64, lds);
    } else
        attn_item8<64>(P + r0 * PP + C_GQ + h * 64, PP, P + C_GK + (h >> 2) * 64, PP, nullptr, 0, P + C_GV + (h >> 2) * 64, PP, ntiles, gqa_ref, 0.f, Og + r0 * 512 + h * 64, lds);
}
__device__ __forceinline__ void st_attn(const KP& p, int l, int bid, int nb, char* lds) {
    const int tidx = opaque_tid();
    float gq = fabsf(p.in(I_GQN)[l * 64 + (tidx & 63)]), gk = fabsf(p.in(I_GKN)[l * 64 + (tidx & 63)]);
#pragma unroll
    for (int o = 32; o > 0; o >>= 1) { gq = fmaxf(gq, __shfl_xor(gq, o)); gk = fmaxf(gk, __shfl_xor(gk, o)); }
    const float gqa_ref = 64.0f * SC_GQA * gq * gk * 1.02f + 0.01f;
    for (int ty = 0; ty < 2; ++ty)
        for (int u = bid; u < 512; u += nb) attn_dispatch(p, ty, u & 7, 1 + (u >> 3), gqa_ref, lds);
    if (l + 1 < NL) { const int sh = nb >= 32 ? 16 : 0; for (int u = bid - sh; u >= 0 && u < 16; u += nb) attn_dispatch(p, u >> 3, u & 7, 0, gqa_ref, lds); }
}

__device__ __forceinline__ void st_merge(const KP& p, int l, int bid, int nb, char* lds) {
    const int tidx = opaque_tid();
    const bf16_t* P = WSP(bf16_t, OFF_P); bf16_t* Mb = WSP(bf16_t, OFF_H);
    const bf16_t* Wb = WSP(bf16_t, OFF_WB + WB_BR); const bf16_t* GSb = WSP(bf16_t, OFF_GS);
    const int srow = tidx >> 3, gch = (tidx & 7) ^ ((srow >> 1) & 7);
    const unsigned o512 = (unsigned)(srow * 512 + gch * 8) * 2u, oPP = (unsigned)(srow * PP + gch * 8) * 2u;
    const int lane = tidx & 63, wid = tidx >> 6, wm = wid >> 1, wn = wid & 1;
    int mt, nt;
    for (int it = 0; dense_tile(it, 8, l + 1 < NL, bid, nb, mt, nt); ++it) {
        acc_t acc, tot; acc_zero(acc); acc_zero(tot);
        uint2 gr[4][4];
#pragma unroll
        for (int a = 0; a < 4; ++a)
#pragma unroll
            for (int c = 0; c < 4; ++c) gr[a][c] = make_uint2(0u, 0u);
        const char* a0 = (const char*)(WSP(bf16_t, OFF_OM) + (size_t)mt * 256 * 512); const char* a1 = (const char*)(P + (size_t)mt * 256 * PP + C_SSM); const char* a2 = (const char*)(WSP(bf16_t, OFF_OG) + (size_t)mt * 256 * 512);
        const char* w0 = (const char*)(Wb + (size_t)nt * 128 * 512);
        gemm_core_hook(acc,
            [&](int i, int kt) { const int b = kt >> 3, kk = kt & 7; const char* ab = b == 0 ? a0 : (b == 1 ? a1 : a2);
                return (const bf16_t*)(ab + (size_t)(i * 64) * (b == 1 ? PP : 512) * 2 + kk * 128 + (b == 1 ? oPP : o512)); },
            [&](int i, int kt) { const int b = kt >> 3, kk = kt & 7; return (const bf16_t*)(w0 + ((size_t)b * 1024 + i * 64) * 1024 + kk * 128 + o512); },
            24, lds,
            [&](int kt) {
                if ((kt & 7) == 1) { const int b = kt >> 3;
#pragma unroll
                    for (int q = 0; q < 2; ++q)
#pragma unroll
                        for (int im = 0; im < 4; ++im) {
                            const uint4 q4 = *(const uint4*)(GSb + ((((size_t)(mt * 96 + b * 32 + nt * 4 + wn * 2 + q) * 16 + wm * 4 + im) * 64) + lane) * 8);
                            gr[2 * q][im] = make_uint2(q4.x, q4.y); gr[2 * q + 1][im] = make_uint2(q4.z, q4.w); } } },
            [&](int kt) {
                if ((kt & 7) == 7) {
#pragma unroll
                    for (int in = 0; in < 4; ++in)
#pragma unroll
                        for (int im = 0; im < 4; ++im) { const uint2 q = gr[in][im]; const f32x4 v = acc[in][im];
                            tot[in][im][0] += bflo(q.x) * v[0]; tot[in][im][1] += bfhi(q.x) * v[1]; tot[in][im][2] += bflo(q.y) * v[2]; tot[in][im][3] += bfhi(q.y) * v[3];
                            acc[in][im][0] = 0.f; acc[in][im][1] = 0.f; acc[in][im][2] = 0.f; acc[in][im][3] = 0.f; } } });
        {   const int tid2 = opaque_tid(), lane2 = tid2 & 63, wid2 = tid2 >> 6, wm2 = wid2 >> 1, wn2 = wid2 & 1;
            char* wstrip = lds + 2 * G_BUF + wid2 * 2304;
#pragma unroll
            for (int im = 0; im < 4; ++im) {
                uint2 v[4];
#pragma unroll
                for (int in = 0; in < 4; ++in) v[in] = pack4(tot[in][im]);
                store_block16x64(wstrip, v, Mb + (size_t)(mt * 256 + wm2 * 64 + 16 * im) * 1024 + nt * 128 + wn2 * 64, 1024, lane2);
            }
        }
    }
}
__device__ __forceinline__ void st_wout(const KP& p, int l, int bid, int nb, char* lds) {
    const int tidx = opaque_tid();
    const bf16_t* Mb = WSP(bf16_t, OFF_H); const bf16_t* Wt = WSP(bf16_t, OFF_WB + WB_OUT); bf16_t* Y = WSP(bf16_t, OFF_Y);
    int mt, nt;
    for (int it = 0; dense_tile(it, 4, l + 1 < NL, bid, nb, mt, nt); ++it) {
        acc_t acc[2]; acc_zero(acc[0]); acc_zero(acc[1]);
        gemm_core256_dense(acc, Mb + (size_t)mt * 256 * 1024, 1024, Wt + (size_t)nt * 256 * 1024, 1024, 1024, lds);
        {   const int tid2 = opaque_tid(), lane = tid2 & 63, wid = tid2 >> 6, wr = wid >> 2, wc = wid & 3;
            char* wstrip = lds + LDS_STRIP + wid * 2304;
#pragma unroll
            for (int nh = 0; nh < 2; ++nh)
#pragma unroll
                for (int im = 0; im < 4; ++im) {
                    const int row0 = mt * 256 + (im >> 1) * 128 + wc * 32 + (im & 1) * 16;
                    uint2 v[4];
#pragma unroll
                    for (int in = 0; in < 4; ++in) v[in] = pack4(acc[nh][in][im]);
                    store_block16x64(wstrip, v, Y + (size_t)row0 * 1024 + nt * 256 + nh * 128 + wr * 64, 1024, lane);
                }
        }
    }
    int* sltok = WSP(int, OFF_SLTOK); float* slw = WSP(float, OFF_SLW); int* cnt = WSP(int, OFF_CNT);
    const int tidz = opaque_tid();
#pragma unroll 1
    for (int i = bid * NTH + tidz; i < TP; i += nb * NTH) { sltok[i] = 0; slw[i] = 0.f; asm volatile("" : "+v"(i)); }
    if (bid == 0 && tidz < 32) cnt[tidz] = 0;
}

__device__ __forceinline__ void st_postmix(const KP& p, int l, int bid, int nb, char* lds) {
    const int tidx = opaque_tid();
    const int lane = tidx & 63, wid = tidx >> 6;
    const bf16_t* Y = WSP(bf16_t, OFF_Y); bf16_t* H2 = WSP(bf16_t, OFF_H);
    const float* gpost = p.in(I_GPOSTMIX) + l * D; const float* gpre = p.in(I_GPREFFN) + l * D;
    int* toke = WSP(int, OFF_TOKE); float* tokw = WSP(float, OFF_TOKW); int* cnt = WSP(int, OFF_CNT);
    float* wl = (float*)lds; int* hist = (int*)(lds + 20 * 1024 * 4);
    {   const float* wg = p.in(I_WGROUP) + (size_t)l * D * 4; const float* wr = p.in(I_WROUTER) + (size_t)l * D * 16;
        for (int k = tidx; k < 1024; k += NTH) {
            const float4 g4 = *(const float4*)(wg + (size_t)k * 4);
            wl[0 * 1024 + k] = g4.x; wl[1 * 1024 + k] = g4.y; wl[2 * 1024 + k] = g4.z; wl[3 * 1024 + k] = g4.w;
#pragma unroll
            for (int e4 = 0; e4 < 4; ++e4) { const float4 r4 = *(const float4*)(wr + (size_t)k * 16 + e4 * 4);
                wl[(4 + e4 * 4 + 0) * 1024 + k] = r4.x; wl[(4 + e4 * 4 + 1) * 1024 + k] = r4.y; wl[(4 + e4 * 4 + 2) * 1024 + k] = r4.z; wl[(4 + e4 * 4 + 3) * 1024 + k] = r4.w; }
        }
        if (tidx < 16) hist[tidx] = 0;
        __syncthreads(); }
    auto ld = [&](int r, float4 (&y)[4], float4 (&x)[4]) __attribute__((always_inline)) {
        const float* xs = l == 0 ? xrow_in(p, r) : xrow_c(p, r);
#pragma unroll
        for (int i = 0; i < 4; ++i) { const uint2 yb = *(const uint2*)(Y + (size_t)r * D + i * 256 + lane * 4); y[i] = make_float4(bflo(yb.x), bfhi(yb.x), bflo(yb.y), bfhi(yb.y)); x[i] = *(const float4*)(xs + i * 256 + lane * 4); }
    };
    auto proc = [&](int r, float4 (&y)[4], float4 (&x)[4]) __attribute__((always_inline)) {
        float* xr = xrow(p, r);
        const float* md = WSP(float, OFF_MOD) + (size_t)(l * 2 + (r < LC ? 1 : 0)) * 6144;
        float ss = 0.f;
#pragma unroll
        for (int i = 0; i < 4; ++i) ss += y[i].x * y[i].x + y[i].y * y[i].y + y[i].z * y[i].z + y[i].w * y[i].w;

        ss = wave_sum(ss);
        const float rstd = rsqrtf(ss * (1.0f / D) + EPS);
        float ss2 = 0.f;
#pragma unroll
        for (int i = 0; i < 4; ++i) { const int c = i * 256 + lane * 4;
            const float4 gg = *(const float4*)(gpost + c), ga = *(const float4*)(md + 2048 + c);
            x[i].x += ga.x * y[i].x * rstd * gg.x; x[i].y += ga.y * y[i].y * rstd * gg.y; x[i].z += ga.z * y[i].z * rstd * gg.z; x[i].w += ga.w * y[i].w * rstd * gg.w;
            *(float4*)(xr + c) = x[i];
            ss2 += x[i].x * x[i].x + x[i].y * x[i].y + x[i].z * x[i].z + x[i].w * x[i].w; }
        ss2 = wave_sum(ss2);
        const float rstd2 = rsqrtf(ss2 * (1.0f / D) + EPS);
        float lg[4] = {0.f, 0.f, 0.f, 0.f}, le[16];
#pragma unroll
        for (int e = 0; e < 16; ++e) le[e] = 0.f;
        uint2 ov[4];
#pragma unroll
        for (int i = 0; i < 4; ++i) { const int c = i * 256 + lane * 4;
            const float4 gg = *(const float4*)(gpre + c), sh = *(const float4*)(md + 3072 + c), sc = *(const float4*)(md + 4096 + c);
            float h[4];
            h[0] = x[i].x * rstd2 * gg.x * (1.f + sc.x) + sh.x; h[1] = x[i].y * rstd2 * gg.y * (1.f + sc.y) + sh.y;
            h[2] = x[i].z * rstd2 * gg.z * (1.f + sc.z) + sh.z; h[3] = x[i].w * rstd2 * gg.w * (1.f + sc.w) + sh.w;
            ov[i].x = pack2(h[0], h[1]); ov[i].y = pack2(h[2], h[3]);
#pragma unroll
            for (int e = 0; e < 4; ++e) { const float4 w4 = *(const float4*)(wl + e * 1024 + c);
                lg[e] = fmaf(h[0], w4.x, lg[e]); lg[e] = fmaf(h[1], w4.y, lg[e]); lg[e] = fmaf(h[2], w4.z, lg[e]); lg[e] = fmaf(h[3], w4.w, lg[e]); }
#pragma unroll
            for (int e = 0; e < 16; ++e) { const float4 w4 = *(const float4*)(wl + (4 + e) * 1024 + c);
                le[e] = fmaf(h[0], w4.x, le[e]); le[e] = fmaf(h[1], w4.y, le[e]); le[e] = fmaf(h[2], w4.z, le[e]); le[e] = fmaf(h[3], w4.w, le[e]); }
        }
        store_row_bf16(lds + LDS_STRIP + wid * 2304, ov, H2 + (size_t)r * D, lane);
#pragma unroll
        for (int g = 0; g < 4; ++g) lg[g] = wave_sum(lg[g]) + p.in(I_BGROUP)[l * 4 + g];
        const float myle = transpose_reduce16(le, lane) + p.in(I_BROUTER)[l * 16 + (lane & 15)];
        int gs = 0; float gm = lg[0];
#pragma unroll
        for (int g = 1; g < 4; ++g) if (lg[g] > gm) { gm = lg[g]; gs = g; }
        float ls[4];
#pragma unroll
        for (int i = 0; i < 4; ++i) ls[i] = __shfl(myle, gs * 4 + i);
        if (lane == 0) {
            float den = 0.f;
#pragma unroll
            for (int g = 0; g < 4; ++g) den += __expf(lg[g] - gm);
            const float pg = 1.0f / den;
            int i0 = 0; float m0 = ls[0];
#pragma unroll
            for (int i = 1; i < 4; ++i) if (ls[i] > m0) { m0 = ls[i]; i0 = i; }
            int i1 = -1; float m1 = -INFINITY;
#pragma unroll
            for (int i = 0; i < 4; ++i) if (i != i0 && ls[i] > m1) { m1 = ls[i]; i1 = i; }
            const float e1 = __expf(m1 - m0), w0 = pg / (1.f + e1), w1 = pg * e1 / (1.f + e1);
            const int ex0 = gs * 4 + i0, ex1 = gs * 4 + i1;
            toke[r * 2] = ex0; toke[r * 2 + 1] = ex1; tokw[r * 2] = w0; tokw[r * 2 + 1] = w1;
            atomicAdd(&hist[ex0], 1); atomicAdd(&hist[ex1], 1);
        }
        };
    {   const int r0 = (l + 1 < NL ? 0 : LC) + bid * NWV + wid, rs = nb * NWV;
        float4 ya[4], xa[4], yb[4], xb[4];
        if (r0 < T) ld(r0, ya, xa);
        for (int r = r0; r < T; r += 2 * rs) {
            if (r + rs < T) ld(r + rs, yb, xb);
            proc(r, ya, xa);
            if (r + rs < T) { if (r + 2 * rs < T) ld(r + 2 * rs, ya, xa); proc(r + rs, yb, xb); }
        } }
    __syncthreads();
    if (tidx < 16 && hist[tidx] != 0) atomicAdd(&cnt[tidx], hist[tidx]);
}

__device__ __forceinline__ void moe_offsets(const int* cnt, int* off) {
    int a = 0;
#pragma unroll
    for (int e = 0; e < 16; ++e) { off[e] = a; a += (cnt[e] + 255) & ~255; }
    off[16] = a;
}
__device__ __forceinline__ int moe_expert_of(const int* off, int j) {
    int e = 0;
#pragma unroll
    for (int k = 1; k < 16; ++k) e += (j >= off[k]) ? 1 : 0;
    return e;
}
__device__ __forceinline__ void st_moe_build(const KP& p, int l, int bid, int nb, char* lds) {
    const int tidx = opaque_tid();
    int* cnt = WSP(int, OFF_CNT); int* cnt2 = cnt + 16;
    const int* toke = WSP(int, OFF_TOKE); const float* tokw = WSP(float, OFF_TOKW); int* toks = WSP(int, OFF_TOKS);
    int* sltok = WSP(int, OFF_SLTOK); float* slw = WSP(float, OFF_SLW);
    int* lcnt = (int*)lds; int* lbase = lcnt + 16;
    int off[17]; moe_offsets(cnt, off);
    const int first = (l + 1 < NL ? 0 : 2 * LC), total = 2 * T - first, per = (total + nb - 1) / nb;
    const int beg = first + bid * per, end = min(beg + per, 2 * T);
    __syncthreads();
    if (tidx < 16) lcnt[tidx] = 0;
    __syncthreads();
    const int idx = beg + tidx; const bool act = (tidx < per) && (idx < end);
    int e = 0, rank = 0;
    if (act) { e = toke[idx]; rank = atomicAdd(&lcnt[e], 1); }
    __syncthreads();
    if (tidx < 16) lbase[tidx] = lcnt[tidx] ? atomicAdd(&cnt2[tidx], lcnt[tidx]) : 0;
    __syncthreads();
    if (act) {
        int o = 0;
#pragma unroll
        for (int k = 0; k < 16; ++k) o = (e == k) ? off[k] : o;
        const int pos = o + lbase[e] + rank;
        sltok[pos] = idx >> 1; slw[pos] = tokw[idx]; toks[idx] = pos;
    }
}
__device__ __forceinline__ bool moe_tile(int r, int M2, int bid, int nb, int& mt, int& pn) {
    const int x = bid & 7, j = bid >> 3, q = nb >> 5;
    mt = (r * 8 + x) * q + (j % q); pn = j / q;
    return mt < M2 && pn < 4;
}
__device__ __forceinline__ void st_moe_up(const KP& p, int bid, int nb, char* lds) {
    const int tidx = opaque_tid();
    const int* cnt = WSP(int, OFF_CNT); const int* sltok = WSP(int, OFF_SLTOK);
    const bf16_t* H2 = WSP(bf16_t, OFF_H); const bf16_t* Wg = WSP(bf16_t, OFF_WB + WB_EG); bf16_t* Hid = WSP(bf16_t, OFF_HID);
    int off[17]; moe_offsets(cnt, off);
    const int M2 = off[16] >> 8;
    const int srow = tidx >> 3, gch = (tidx & 7) ^ ((srow >> 1) & 7);
    auto upin = [](const char* q) { const unsigned long long v = (unsigned long long)q; const unsigned lo = __builtin_amdgcn_readfirstlane((unsigned)v), hi = __builtin_amdgcn_readfirstlane((unsigned)(v >> 32)); return (const char*)(((unsigned long long)hi << 32) | lo); };
    const unsigned vw = (unsigned)(((srow >> 4) & 1) ? (unsigned)(WB_EU - WB_EG) : 0u) + (unsigned)(((((srow >> 5) & 1) * 16 + (srow & 15)) * 1024 + gch * 8) * 2);
    int mt, pn;
    for (int r = 0; r * 8 * (nb >> 5) < M2; ++r) {
        if (!moe_tile(r, M2, bid, nb, mt, pn)) continue;
        const int e = __builtin_amdgcn_readfirstlane(moe_expert_of(off, mt * 256));
        unsigned xo[2][2];
#pragma unroll
        for (int h = 0; h < 2; ++h)
#pragma unroll
            for (int i = 0; i < 2; ++i) xo[h][i] = (unsigned)sltok[mt * 256 + h * 128 + srow + 64 * i] * 2048u + (unsigned)gch * 16u;
        acc_t acc[2]; acc_zero(acc[0]); acc_zero(acc[1]);
        gemm_core256(acc, [&](int h, int i, int kt) { return (const bf16_t*)(upin((const char*)H2 + kt * 128) + xo[h][i]); },
                     [&](int h, int i, int kt) { return (const bf16_t*)(upin((const char*)Wg + ((size_t)(e * 512 + pn * 128 + i * 64 + h * 32) * 1024 + kt * 64) * 2) + vw); }, 16, lds);
        const int tid2 = opaque_tid(), lane = tid2 & 63, wid = tid2 >> 6, wr = wid >> 2, wc = wid & 3, fr = lane & 15, g = lane >> 4;
        char* wstrip = lds + LDS_STRIP + wid * 2304;
#pragma unroll
        for (int im = 0; im < 4; ++im) {
            uint2 ov[4];
#pragma unroll
            for (int nh = 0; nh < 2; ++nh)
#pragma unroll
                for (int q = 0; q < 2; ++q) {
                    const f32x4 gt = acc[nh][2 * q][im], up = acc[nh][2 * q + 1][im];
                    ov[2 * nh + q].x = pack2(siluf_(gt[0]) * up[0], siluf_(gt[1]) * up[1]); ov[2 * nh + q].y = pack2(siluf_(gt[2]) * up[2], siluf_(gt[3]) * up[3]);
                }
            store_block16x64(wstrip, ov, Hid + (size_t)(mt * 256 + (im >> 1) * 128 + wc * 32 + (im & 1) * 16) * 512 + pn * 128 + wr * 64, 512, lane);
        }
        (void)fr; (void)g;
    }
}
__device__ __forceinline__ void st_moe_down(const KP& p, int bid, int nb, char* lds) {
    const int tidx = opaque_tid();
    const int* cnt = WSP(int, OFF_CNT); const float* slw = WSP(float, OFF_SLW);
    const bf16_t* Hid = WSP(bf16_t, OFF_HID); const bf16_t* Wd = WSP(bf16_t, OFF_WB + WB_ED); bf16_t* Sl = WSP(bf16_t, OFF_SLOTS);
    int off[17]; moe_offsets(cnt, off);
    const int M2 = off[16] >> 8;
    int mt, pn;
    for (int r = 0; r * 8 * (nb >> 5) < M2; ++r) {
        if (!moe_tile(r, M2, bid, nb, mt, pn)) continue;
        const int e = __builtin_amdgcn_readfirstlane(moe_expert_of(off, mt * 256));
        acc_t acc[2]; acc_zero(acc[0]); acc_zero(acc[1]);
        gemm_core256_dense(acc, Hid + (size_t)mt * 256 * 512, 512, Wd + ((size_t)e * 1024 + pn * 256) * 512, 512, 512, lds);
        {   const int tid2 = opaque_tid(), lane = tid2 & 63, wid = tid2 >> 6, wr = wid >> 2, wc = wid & 3, fr = lane & 15;
            char* wstrip = lds + LDS_STRIP + wid * 2304;
#pragma unroll
            for (int nh = 0; nh < 2; ++nh)
#pragma unroll
                for (int im = 0; im < 4; ++im) {
                    const int row0 = mt * 256 + (im >> 1) * 128 + wc * 32 + (im & 1) * 16;
                    const float w = slw[row0 + fr];
                    uint2 v[4];
#pragma unroll
                    for (int in = 0; in < 4; ++in) v[in] = pack4(acc[nh][in][im] * w);
                    store_block16x64(wstrip, v, Sl + (size_t)row0 * 1024 + pn * 256 + nh * 128 + wr * 64, 1024, lane);
                }
        }
    }
}
__device__ __forceinline__ void st_postffn(const KP& p, int l, int bid, int nb, char* lds) {
    const int tidx = opaque_tid();
    const int lane = tidx & 63, wid = tidx >> 6;
    const bf16_t* Sl = WSP(bf16_t, OFF_SLOTS); const int* toks = WSP(int, OFF_TOKS);
    const float* gpost = p.in(I_GPOSTFFN) + l * D;
    const bool next = (l + 1 < NL);
    bf16_t* Hb = WSP(bf16_t, OFF_H); const float* gpre = p.in(I_GPREMIX) + (next ? l + 1 : l) * D;
    auto ld = [&](int r, uint2 (&a)[4], uint2 (&b)[4], float4 (&x)[4]) __attribute__((always_inline)) {
        const bf16_t* s0 = Sl + (size_t)toks[r * 2] * 1024; const bf16_t* s1 = Sl + (size_t)toks[r * 2 + 1] * 1024; const float* xs = xrow_c(p, r);
#pragma unroll
        for (int i = 0; i < 4; ++i) { const int c = i * 256 + lane * 4; a[i] = *(const uint2*)(s0 + c); b[i] = *(const uint2*)(s1 + c); x[i] = *(const float4*)(xs + c); }
    };
    auto proc = [&](int r, uint2 (&a)[4], uint2 (&b)[4], float4 (&xq)[4]) __attribute__((always_inline)) {
        float* xr = xrow(p, r);
        const float* md = WSP(float, OFF_MOD) + (size_t)(l * 2 + (r < LC ? 1 : 0)) * 6144;
        float v[16]; float ss = 0.f;
#pragma unroll
        for (int i = 0; i < 4; ++i) {
            v[4 * i] = bflo(a[i].x) + bflo(b[i].x); v[4 * i + 1] = bfhi(a[i].x) + bfhi(b[i].x); v[4 * i + 2] = bflo(a[i].y) + bflo(b[i].y); v[4 * i + 3] = bfhi(a[i].y) + bfhi(b[i].y);
            ss += v[4 * i] * v[4 * i] + v[4 * i + 1] * v[4 * i + 1] + v[4 * i + 2] * v[4 * i + 2] + v[4 * i + 3] * v[4 * i + 3]; }
        ss = wave_sum(ss);
        const float rstd = rsqrtf(ss * (1.0f / D) + EPS);
        float4 xs[4]; float ss2 = 0.f;
#pragma unroll
        for (int i = 0; i < 4; ++i) { const int c = i * 256 + lane * 4;
            const float4 gg = *(const float4*)(gpost + c), ga = *(const float4*)(md + 5120 + c); float4 x = xq[i];
            x.x += ga.x * v[4 * i] * rstd * gg.x; x.y += ga.y * v[4 * i + 1] * rstd * gg.y; x.z += ga.z * v[4 * i + 2] * rstd * gg.z; x.w += ga.w * v[4 * i + 3] * rstd * gg.w;
            *(float4*)(xr + c) = x; xs[i] = x; ss2 += x.x * x.x + x.y * x.y + x.z * x.z + x.w * x.w; }
        if (next) {
            ss2 = wave_sum(ss2);
            const float rstd2 = rsqrtf(ss2 * (1.0f / D) + EPS);
            const float* md2 = WSP(float, OFF_MOD) + (size_t)((l + 1) * 2 + (r < LC ? 1 : 0)) * 6144;
            uint2 ov[4];
#pragma unroll
            for (int i = 0; i < 4; ++i) { const int c = i * 256 + lane * 4;
                const float4 gg = *(const float4*)(gpre + c), sh = *(const float4*)(md2 + c), sc = *(const float4*)(md2 + 1024 + c);
                ov[i].x = pack2(xs[i].x * rstd2 * gg.x * (1.f + sc.x) + sh.x, xs[i].y * rstd2 * gg.y * (1.f + sc.y) + sh.y);
                ov[i].y = pack2(xs[i].z * rstd2 * gg.z * (1.f + sc.z) + sh.z, xs[i].w * rstd2 * gg.w * (1.f + sc.w) + sh.w); }
            store_row_bf16(lds + LDS_STRIP + wid * 2304, ov, Hb + (size_t)r * D, lane);
        }
    };
    {   const int r0 = (l + 1 < NL ? 0 : LC) + bid * NWV + wid, rs = nb * NWV;
        uint2 aa[4], ab[4], ba[4], bb[4]; float4 xa[4], xb[4];
        if (r0 < T) ld(r0, aa, ab, xa);
        for (int r = r0; r < T; r += 2 * rs) {
            if (r + rs < T) ld(r + rs, ba, bb, xb);
            proc(r, aa, ab, xa);
            if (r + rs < T) { if (r + 2 * rs < T) ld(r + 2 * rs, aa, ab, xa); proc(r + rs, ba, bb, xb); }
        } }
}

__device__ __forceinline__ void gsync(unsigned* bar, unsigned epoch) {
    asm volatile("s_waitcnt vmcnt(0) lgkmcnt(0)" ::: "memory");
    unsigned x = __builtin_amdgcn_readfirstlane(blockIdx.x & 7), nbk = __builtin_amdgcn_readfirstlane(gridDim.x); asm volatile("" : "+s"(x), "+s"(nbk));
    const unsigned gsz = (nbk - x + 7) >> 3, ngrp = nbk < 8 ? nbk : 8;
    __syncthreads();
    if (threadIdx.x == 0) {
        __builtin_amdgcn_fence(__ATOMIC_RELEASE, "agent");
        asm volatile("s_waitcnt vmcnt(0)" ::: "memory");
        const unsigned old = __hip_atomic_fetch_add(bar + 64 * (1 + x), 1u, __ATOMIC_RELAXED, __HIP_MEMORY_SCOPE_AGENT);
        if (old + 1 == epoch * gsz) __hip_atomic_fetch_add(bar, 1u, __ATOMIC_RELAXED, __HIP_MEMORY_SCOPE_AGENT);
        const unsigned target = epoch * ngrp;
        while (__hip_atomic_load(bar, __ATOMIC_RELAXED, __HIP_MEMORY_SCOPE_AGENT) < target) __builtin_amdgcn_s_sleep(1);
        __builtin_amdgcn_fence(__ATOMIC_ACQUIRE, "agent");
        asm volatile("s_waitcnt vmcnt(0)" ::: "memory");
    }
    __syncthreads();
}

__global__ void __launch_bounds__(NTH) k_mega(Params p_unused) {
    KP p; p.k = (kparams_t)__builtin_amdgcn_kernarg_segment_ptr();
    __shared__ __attribute__((aligned(16))) char lds[LDS_BYTES]; float* smem = (float*)lds;
    cg::grid_group grid = cg::this_grid();
    grid.sync();
    const int bid = blockIdx.x, nb = gridDim.x;
    unsigned* bar = WSP(unsigned, OFF_BAR);
#define GS(k) gsync(bar, (unsigned)(k))
    st_prologue(p, bid, nb, smem); st_conv(p, 0, bid, nb, smem); st_s5_tables(p, 0, bid, nb, lds); GS(1);
    st_modulate(p, 0, bid, nb, lds); GS(2);
#pragma unroll 1
    for (int l = 0; l < NL; ++l) {
        st_gemm_in(p, l, bid, nb, lds); GS(2 + 12 * l + 1);
        st_s5_local(p, l, bid, nb); st_s5_fgemm(p, bid, nb, lds); GS(2 + 12 * l + 2);
        st_s5_carry(p, l, bid, nb, lds); st_proj2<0>(p, l, bid, nb, lds); GS(2 + 12 * l + 3);
        st_s5_ygemm(p, l, bid, nb, lds); st_s5_ctx_y(p, l, bid, nb); st_ropeq(p, bid, nb, lds); GS(2 + 12 * l + 4);
        st_proj2<1>(p, l, bid, nb, lds); st_attn(p, l, bid, nb, lds); GS(2 + 12 * l + 5);
        st_merge(p, l, bid, nb, lds); GS(2 + 12 * l + 6);
        st_wout(p, l, bid, nb, lds);
        if (l + 1 < NL && nb > 8) { if (bid >= 4) st_conv_experts(p, l, bid - 4, nb - 4, smem); } else st_conv_experts(p, l, bid, nb, smem); GS(2 + 12 * l + 7);
        st_postmix(p, l, bid, nb, lds); GS(2 + 12 * l + 8);
        st_moe_build(p, l, bid, nb, lds); GS(2 + 12 * l + 9);
        st_moe_up(p, bid, nb, lds); GS(2 + 12 * l + 10);
        st_moe_down(p, bid, nb, lds); GS(2 + 12 * l + 11);
        st_postffn(p, l, bid, nb, lds);
        if (l + 1 < NL) { st_conv(p, l + 1, bid, nb, smem); st_s5_tables(p, l + 1, bid, nb, lds); }
        GS(2 + 12 * l + 12);
    }
#undef GS
}

extern "C" void kernel_launch(void* const* d_in, const int* in_sizes, int n_in, void* d_out, int out_size, void* d_ws, size_t ws_size, hipStream_t stream) {
    Params p{};
    for (int i = 0; i < N_IN; ++i) p.in[i] = (const float*)d_in[i];
    p.out = (float*)d_out; p.ws = (char*)d_ws;
    if (ws_size < WS_NEED) { fprintf(stderr, "workspace too small: %zu < %zu\n", ws_size, (size_t)WS_NEED); return; }
    static int grid_blocks = 0;
    if (!grid_blocks) {
        int dev = 0, cus = 0, per_cu = 0;
        hipGetDevice(&dev);
        hipDeviceGetAttribute(&cus, hipDeviceAttributeMultiprocessorCount, dev);
        hipOccupancyMaxActiveBlocksPerMultiprocessor(&per_cu, k_mega, NTH, 0);
        if (per_cu > 1) per_cu = 1;
        if (per_cu < 1) per_cu = 1;
        grid_blocks = cus * per_cu;
    }
    hipMemsetAsync((char*)d_ws + OFF_BAR, 0, BAR_BYTES, stream);
    void* args[] = { &p };
    hipError_t e = hipLaunchCooperativeKernel((void*)k_mega, dim3(grid_blocks), dim3(NTH), args, 0, stream);
    if (e != hipSuccess) fprintf(stderr, "cooperative launch failed: %s (grid %d)\n", hipGetErrorString(e), grid_blocks);
}
```
